# Optimizing an MI355X kernel written in HIP

```python
import math
import jax, jax.numpy as jnp
from jax import lax
import numpy as np

D_MODEL = 1024
BATCH = 2
SEQ = 16384
DEPTH = 2

HEAD_DIM = 64
N_HEADS_A = 8
N_HEADS_B = 8
D_A = N_HEADS_A * HEAD_DIM
D_B = N_HEADS_B * HEAD_DIM
N_IDX_HEADS = 8
IDX_DIM = 64
D_RNN = 512
N_RNN_BLOCKS = 8
RNN_BLOCK = D_RNN // N_RNN_BLOCKS
CONV_WIDTH = 4
LRU_C = 8.0
D_FF = 4 * D_MODEL
MOBA_BLOCK = 256
MOBA_TOPK = 3
DSA_MAX_TOPK = 256
Q_BLOCK = 128
N_BUCKETS = 32
MAX_DISTANCE = 128
N_BRANCHES = 3
N_ATTN_HEADS = N_HEADS_A + N_HEADS_B
EPS = 1e-6
NEG = -1e30

IN_SPLITS = (D_A, D_A, D_A,
             D_B, D_B, D_B,
             N_IDX_HEADS * IDX_DIM,
             IDX_DIM,
             N_IDX_HEADS,
             D_RNN, D_RNN,
             N_BRANCHES * D_MODEL)
D_IN = sum(IN_SPLITS)
IN_OFFSETS = tuple(int(o) for o in np.cumsum(IN_SPLITS)[:-1])

kernel_name = "hybrid_moba_dsa_rglru_block"


def rms_norm(x, g):
    xf = x.astype(jnp.float32)
    y = xf * lax.rsqrt(jnp.mean(xf * xf, axis=-1, keepdims=True) + EPS)
    return (y * g.astype(jnp.float32)).astype(x.dtype)


def t5_bucket(dist):
    n = jnp.maximum(dist, 0)
    max_exact = N_BUCKETS // 2
    nf = jnp.maximum(n, 1).astype(jnp.float32)
    large = max_exact + (jnp.log(nf / max_exact) / math.log(MAX_DISTANCE / max_exact)
                         * (N_BUCKETS - max_exact)).astype(jnp.int32)
    large = jnp.minimum(large, N_BUCKETS - 1)
    return jnp.where(n < max_exact, n, large)


def moba_attention(q, k, v, bias_tab):
    B, S, H, dh = q.shape
    nb = -(-S // MOBA_BLOCK)
    pad = nb * MOBA_BLOCK - S
    kp = jnp.pad(k, ((0, 0), (0, pad), (0, 0), (0, 0)))
    vp = jnp.pad(v, ((0, 0), (0, pad), (0, 0), (0, 0)))
    kblk = kp.reshape(B, nb, MOBA_BLOCK, H, dh).transpose(0, 3, 1, 2, 4)
    vblk = vp.reshape(B, nb, MOBA_BLOCK, H, dh).transpose(0, 3, 1, 2, 4)
    kmean = jnp.mean(kblk, axis=3)
    n_sel = min(MOBA_TOPK, nb)
    scale = dh ** -0.5
    b_ix = jnp.arange(B)[:, None, None, None]
    h_ix = jnp.arange(H)[None, None, :, None]
    blk_ids = jnp.arange(nb)
    bias_t = bias_tab.T

    def one_block(qb):
        t0 = qb * Q_BLOCK
        cur = t0 // MOBA_BLOCK
        t = t0 + jnp.arange(Q_BLOCK)
        qq = lax.dynamic_slice_in_dim(q, t0, Q_BLOCK, axis=1)
        gate = jnp.einsum('bqhd,bhnd->bqhn', qq, kmean).astype(jnp.float32)
        gate = jnp.where(blk_ids < cur, gate, NEG)
        _, sel = lax.top_k(gate, n_sel)
        sel_ok = sel < cur
        kg = kblk[b_ix, h_ix, sel]
        vg = vblk[b_ix, h_ix, sel]
        s_past = jnp.einsum('bqhd,bqhnkd->bqhnk', qq, kg).astype(jnp.float32) * scale
        pos_past = sel[..., None] * MOBA_BLOCK + jnp.arange(MOBA_BLOCK)
        bias_past = bias_t[h_ix[..., None], t5_bucket(t[None, :, None, None, None] - pos_past)]
        s_past = jnp.where(sel_ok[..., None], s_past + bias_past, NEG)
        k_own = lax.dynamic_slice_in_dim(kp, cur * MOBA_BLOCK, MOBA_BLOCK, axis=1)
        v_own = lax.dynamic_slice_in_dim(vp, cur * MOBA_BLOCK, MOBA_BLOCK, axis=1)
        rel = t[:, None] - (cur * MOBA_BLOCK + jnp.arange(MOBA_BLOCK))[None, :]
        bias_own = bias_tab[t5_bucket(rel)].transpose(0, 2, 1)[None]
        s_own = jnp.einsum('bqhd,bkhd->bqhk', qq, k_own).astype(jnp.float32) * scale + bias_own
        s_own = jnp.where((rel >= 0)[None, :, None, :], s_own, NEG)
        logits = jnp.concatenate([s_past.reshape(B, Q_BLOCK, H, n_sel * MOBA_BLOCK), s_own], axis=-1)
        p = jax.nn.softmax(logits, axis=-1).astype(v.dtype)
        p_past = p[..., :n_sel * MOBA_BLOCK].reshape(B, Q_BLOCK, H, n_sel, MOBA_BLOCK)
        p_own = p[..., n_sel * MOBA_BLOCK:]
        return (jnp.einsum('bqhnk,bqhnkd->bqhd', p_past, vg)
                + jnp.einsum('bqhk,bkhd->bqhd', p_own, v_own))

    out = lax.map(one_block, jnp.arange(S // Q_BLOCK))
    return out.transpose(1, 0, 2, 3, 4).reshape(B, S, H * dh)


def dsa_attention(q, k, v, qi, ki, wi, bias_tab):
    B, S, H, dh = q.shape
    n_keep = min(DSA_MAX_TOPK, S // 4)
    scale = dh ** -0.5
    idx_scale = (N_IDX_HEADS ** -0.5) * (IDX_DIM ** -0.5)
    s_all = jnp.arange(S)

    def one_block(qb):
        t0 = qb * Q_BLOCK
        t = t0 + jnp.arange(Q_BLOCK)
        qq = lax.dynamic_slice_in_dim(q, t0, Q_BLOCK, axis=1)
        qiq = lax.dynamic_slice_in_dim(qi, t0, Q_BLOCK, axis=1)
        wq = lax.dynamic_slice_in_dim(wi, t0, Q_BLOCK, axis=1)
        dots = jnp.einsum('bqhd,bsd->bqhs', qiq, ki)
        score = jnp.einsum('bqh,bqhs->bqs', wq, jax.nn.relu(dots)).astype(jnp.float32) * idx_scale
        score = jnp.where((s_all[None, :] <= t[:, None])[None], score, NEG)
        _, idx = lax.top_k(score, n_keep)
        ok = idx <= t[None, :, None]
        kg = jax.vmap(lambda kk, ii: kk[ii])(k, idx)
        vg = jax.vmap(lambda vv, ii: vv[ii])(v, idx)
        bias = bias_tab[t5_bucket(t[None, :, None] - idx)].transpose(0, 1, 3, 2)
        logits = jnp.einsum('bqhd,bqkhd->bqhk', qq, kg).astype(jnp.float32) * scale + bias
        logits = jnp.where(ok[:, :, None, :], logits, NEG)
        p = jax.nn.softmax(logits, axis=-1).astype(v.dtype)
        return jnp.einsum('bqhk,bqkhd->bqhd', p, vg)

    out = lax.map(one_block, jnp.arange(S // Q_BLOCK))
    return out.transpose(1, 0, 2, 3, 4).reshape(B, S, H * dh)


def causal_depthwise_conv(x, w, b):
    S = x.shape[1]
    xp = jnp.pad(x, ((0, 0), (CONV_WIDTH - 1, 0), (0, 0)))
    y = b
    for i in range(CONV_WIDTH):
        y = y + w[i] * xp[:, i:i + S]
    return y


def rg_lru(x, w_r, b_r, w_i, b_i, lam):
    B, S, C = x.shape
    xb = x.reshape(B, S, N_RNN_BLOCKS, RNN_BLOCK)
    r = jax.nn.sigmoid(jnp.einsum('bsnc,ncd->bsnd', xb, w_r).reshape(B, S, C) + b_r)
    i = jax.nn.sigmoid(jnp.einsum('bsnc,ncd->bsnd', xb, w_i).reshape(B, S, C) + b_i)
    log_a = -LRU_C * r.astype(jnp.float32) * jax.nn.softplus(-lam.astype(jnp.float32))
    a = jnp.exp(log_a)
    u = jnp.sqrt(-jnp.expm1(2.0 * log_a)) * (i * x).astype(jnp.float32)

    def combine(left, right):
        a1, b1 = left
        a2, b2 = right
        return a1 * a2, a2 * b1 + b2

    _, h = lax.associative_scan(combine, (a, u), axis=1)
    return h.astype(x.dtype)


def token_mixer(xn, w_in, conv_w, conv_b, w_r, b_r, w_i, b_i, lam, w_pa, w_pb, w_pc, w_o, rel_bias):
    B, S, _ = xn.shape
    proj = xn @ w_in
    (qa, ka, va, qb, kb, vb, qi, ki, wi, xc, yc, gates) = jnp.split(proj, IN_OFFSETS, axis=-1)
    heads_a = lambda z: z.reshape(B, S, N_HEADS_A, HEAD_DIM)
    heads_b = lambda z: z.reshape(B, S, N_HEADS_B, HEAD_DIM)
    y_a = moba_attention(heads_a(qa), heads_a(ka), heads_a(va), rel_bias[:, :N_HEADS_A])
    y_b = dsa_attention(heads_b(qb), heads_b(kb), heads_b(vb),
                        qi.reshape(B, S, N_IDX_HEADS, IDX_DIM), ki, wi, rel_bias[:, N_HEADS_A:])
    y_c = rg_lru(causal_depthwise_conv(xc, conv_w, conv_b), w_r, b_r, w_i, b_i, lam) * jax.nn.gelu(yc)
    g = jax.nn.sigmoid(gates).reshape(B, S, N_BRANCHES, D_MODEL)
    merged = g[:, :, 0] * (y_a @ w_pa) + g[:, :, 1] * (y_b @ w_pb) + g[:, :, 2] * (y_c @ w_pc)
    return merged @ w_o


def squared_relu_mlp(xn, w_up, w_down):
    return jnp.square(jax.nn.relu(xn @ w_up)) @ w_down


def setup_inputs(seed: int = 0) -> dict:
    key = jax.random.key(seed)
    ks = jax.random.split(key, 20)
    f32 = jnp.float32
    nrm = lambda k, shape, s: jax.random.normal(k, shape, f32) * s
    u = jax.random.uniform(ks[10], (DEPTH, D_RNN), f32, minval=0.9, maxval=0.999)
    a = u ** (1.0 / LRU_C)
    lam = jnp.log(a) - jnp.log1p(-a)
    return {
        "x": nrm(ks[0], (BATCH, SEQ, D_MODEL), 1.0),
        "rel_bias": nrm(ks[1], (N_BUCKETS, N_ATTN_HEADS), 0.5),
        "norm_mix_g": 1.0 + nrm(ks[2], (DEPTH, D_MODEL), 0.05),
        "w_in": nrm(ks[3], (DEPTH, D_MODEL, D_IN), D_MODEL ** -0.5),
        "conv_w": nrm(ks[4], (DEPTH, CONV_WIDTH, D_RNN), CONV_WIDTH ** -0.5),
        "conv_b": nrm(ks[5], (DEPTH, D_RNN), 0.02),
        "w_r": nrm(ks[6], (DEPTH, N_RNN_BLOCKS, RNN_BLOCK, RNN_BLOCK), RNN_BLOCK ** -0.5),
        "b_r": nrm(ks[7], (DEPTH, D_RNN), 0.1),
        "w_i": nrm(ks[8], (DEPTH, N_RNN_BLOCKS, RNN_BLOCK, RNN_BLOCK), RNN_BLOCK ** -0.5),
        "b_i": nrm(ks[9], (DEPTH, D_RNN), 0.1),
        "lru_lambda": lam,
        "w_pa": nrm(ks[11], (DEPTH, D_A, D_MODEL), D_A ** -0.5),
        "w_pb": nrm(ks[12], (DEPTH, D_B, D_MODEL), D_B ** -0.5),
        "w_pc": nrm(ks[13], (DEPTH, D_RNN, D_MODEL), D_RNN ** -0.5),
        "w_o": nrm(ks[14], (DEPTH, D_MODEL, D_MODEL), D_MODEL ** -0.5),
        "norm_mlp_g": 1.0 + nrm(ks[15], (DEPTH, D_MODEL), 0.05),
        "w_up": nrm(ks[16], (DEPTH, D_MODEL, D_FF), D_MODEL ** -0.5),
        "w_down": nrm(ks[17], (DEPTH, D_FF, D_MODEL), D_FF ** -0.5),
        "final_norm_g": 1.0 + nrm(ks[18], (D_MODEL,), 0.05),
    }


def reference(x, rel_bias, norm_mix_g, w_in, conv_w, conv_b, w_r, b_r, w_i, b_i, lru_lambda,
              w_pa, w_pb, w_pc, w_o, norm_mlp_g, w_up, w_down, final_norm_g):
    for l in range(DEPTH):
        x = x + token_mixer(rms_norm(x, norm_mix_g[l]), w_in[l], conv_w[l], conv_b[l],
                            w_r[l], b_r[l], w_i[l], b_i[l], lru_lambda[l],
                            w_pa[l], w_pb[l], w_pc[l], w_o[l], rel_bias)
        x = x + squared_relu_mlp(rms_norm(x, norm_mlp_g[l]), w_up[l], w_down[l])
    return rms_norm(x, final_norm_g)
```

```cpp
#include <hip/hip_runtime.h>
#include <cstdio>
#include <cstdint>

#ifndef MK_ONE_LAUNCH
#define MK_ONE_LAUNCH 1
#endif

constexpr int BATCH = 2, SEQ = 16384, DM = 1024, T = BATCH * SEQ;
constexpr int DIN = 7752, DFF = 4096, DH = 512;
constexpr int NIN_T = 4864;
constexpr int NBLK = SEQ / 256;
constexpr float EPS = 1e-6f;

namespace pg8 {
#define PG8_LAS __attribute__((address_space(3)))
typedef unsigned short bf16_t;
typedef short bf16x8 __attribute__((ext_vector_type(8)));
typedef float f32x4 __attribute__((ext_vector_type(4)));
typedef unsigned u32x4 __attribute__((ext_vector_type(4)));
constexpr int BM = 256, BK = 64, HALF = 128, HTB = HALF * BK * 2  , STAGE_BYTES = 8 * HTB, NXCD = 8, WGM = 8;

__host__ __device__ __forceinline__ int lds_byte(int r, int c) { const int st = (r >> 4) * 2 + (c >> 5), rr = r & 15, cc = c & 31, ob = rr * 64 + cc * 2; return st * 1024 + (ob ^ (((ob >> 9) & 1) << 5)); }
__host__ __device__ __forceinline__ void stage_rc(int b, int& R, int& C) { const int st = b / 1024, sb = b % 1024, swz = sb ^ (((sb >> 9) & 1) << 5); R = (st >> 1) * 16 + swz / 64; C = (st & 1) * 32 + (swz % 64) / 2; }
__host__ __device__ __forceinline__ int perm32(int rho) { const int n = rho >> 4, i = rho & 15; return 8 * (i >> 2) + 4 * n + (i & 3); }

struct Unit { int pm, pn; };
struct Gemm { const bf16_t* A; const bf16_t* Bt; int M, N, K; };

struct StaticOrder {
    int nM, nN, nwg, G, c;
    __host__ __device__ void init(int M, int N, int G_, int c_) { nM = M / BM; nN = N / BM; nwg = nM * nN; G = G_; c = c_; }
    __host__ __device__ bool next(int i, Unit& u) const {
        const long L = (long)i * G + c; if (L >= nwg) return false;
        int wgid = (int)L; { const int q = nwg / NXCD, r = nwg % NXCD, xcd = wgid % NXCD, off = wgid / NXCD; wgid = (xcd < r ? xcd * (q + 1) : r * (q + 1) + (xcd - r) * q) + off; }
        const int nig = WGM * nN, gid = wgid / nig, fm = gid * WGM, gsz = (nM - fm) < WGM ? (nM - fm) : WGM;
        u.pm = fm + ((wgid % nig) % gsz); u.pn = (wgid % nig) / gsz; return true;
    }
    __device__ __forceinline__ void a_ready(const Unit&) const {}
    __device__ __forceinline__ void done(const Unit&) const {}
};

typedef float f32x2_t __attribute__((ext_vector_type(2))); typedef __bf16 bf16x2_t __attribute__((ext_vector_type(2)));
__device__ __forceinline__ unsigned cvt_pk_bf16(float lo, float hi) { f32x2_t v = {lo, hi}; bf16x2_t b = __builtin_convertvector(v, bf16x2_t); return __builtin_bit_cast(unsigned, b); }
__device__ __forceinline__ float bf_lo(unsigned w) { return __uint_as_float(w << 16); }
__device__ __forceinline__ float bf_hi(unsigned w) { return __uint_as_float(w & 0xffff0000u); }

struct EpiInproj {
    static constexpr bool PERM = true, AFTER_DRAIN = false;
    bf16_t* base; bf16_t* ki; float* wi; const float* rstd  ; float* km2;
    __device__ __forceinline__ void operator()(const f32x4 (&acc)[2][2][4][2], const Unit& u, int wr, int wc, int fr, int fq) const {
        const int row0 = u.pm * BM + wr * 64 + fr;
        if (u.pn < 18) {
            bf16_t* dst = base + (size_t)(u.pn >> 1) * ((size_t)T * 512) + (u.pn & 1) * 256 + wc * 32 + 8 * fq;
            const bool ksum = (u.pn >> 1) == 3;
            f32x4 cs[2][2] = {{{0.f, 0.f, 0.f, 0.f}, {0.f, 0.f, 0.f, 0.f}}, {{0.f, 0.f, 0.f, 0.f}, {0.f, 0.f, 0.f, 0.f}}};
#pragma unroll
            for (int ai = 0; ai < 2; ++ai)
#pragma unroll
                for (int m = 0; m < 4; ++m) { const int row = row0 + ai * HALF + m * 16; const float rs = __builtin_amdgcn_rsqf(rstd[row] * (1.0f / 1024.0f) + EPS); bf16_t* rowp = dst + (size_t)row * 512;
#pragma unroll
                    for (int bj = 0; bj < 2; ++bj) { const f32x4 v0 = acc[ai][bj][m][0] * rs, v1 = acc[ai][bj][m][1] * rs;
                        if (ksum) { cs[bj][0] += v0; cs[bj][1] += v1; }
                        u32x4 w; w.x = cvt_pk_bf16(v0[0], v0[1]); w.y = cvt_pk_bf16(v0[2], v0[3]); w.z = cvt_pk_bf16(v1[0], v1[1]); w.w = cvt_pk_bf16(v1[2], v1[3]);
                        *(u32x4*)(rowp + bj * HALF) = w; } }
            if (ksum) {
#pragma unroll
                for (int bj = 0; bj < 2; ++bj)
#pragma unroll
                    for (int n = 0; n < 2; ++n)
#pragma unroll
                        for (int j = 0; j < 4; ++j) { float v = cs[bj][n][j]; v += __shfl_xor(v, 1); v += __shfl_xor(v, 2); v += __shfl_xor(v, 4); v += __shfl_xor(v, 8); cs[bj][n][j] = v; }
                if (fr == 0) { float* kd = km2 + ((size_t)u.pm * 2 + wr) * 512 + (u.pn & 1) * 256 + wc * 32 + 8 * fq;
#pragma unroll
                    for (int bj = 0; bj < 2; ++bj) { *(f32x4*)(kd + bj * HALF) = cs[bj][0]; *(f32x4*)(kd + bj * HALF + 4) = cs[bj][1]; } }
            }
        } else {
#pragma unroll
            for (int ai = 0; ai < 2; ++ai)
#pragma unroll
                for (int m = 0; m < 4; ++m) { const int row = row0 + ai * HALF + m * 16; const float rs = __builtin_amdgcn_rsqf(rstd[row] * (1.0f / 1024.0f) + EPS);
                    const f32x4 v0 = acc[ai][0][m][0] * rs, v1 = acc[ai][0][m][1] * rs;
                    if (wc < 2) { u32x4 w; w.x = cvt_pk_bf16(v0[0], v0[1]); w.y = cvt_pk_bf16(v0[2], v0[3]); w.z = cvt_pk_bf16(v1[0], v1[1]); w.w = cvt_pk_bf16(v1[2], v1[3]);
                        *(u32x4*)(ki + (size_t)row * 64 + wc * 32 + 8 * fq) = w; }
                    else if (wc == 2 && fq == 0) { *(f32x4*)(wi + (size_t)row * 8) = v0; *(f32x4*)(wi + (size_t)row * 8 + 4) = v1; } }
        }
    }
};
struct EpiGates {
    static constexpr bool PERM = true, AFTER_DRAIN = false;
    bf16_t* O; const float* rstd;
    __device__ __forceinline__ void operator()(const f32x4 (&acc)[2][2][4][2], const Unit& u, int wr, int wc, int fr, int fq) const {
        const int row0 = u.pm * BM + wr * 64 + fr; const int tsel = u.pn >> 2;
        bf16_t* dst = O + (size_t)tsel * ((size_t)T * 1024) + (u.pn & 3) * 256 + wc * 32 + 8 * fq;
#pragma unroll
        for (int ai = 0; ai < 2; ++ai)
#pragma unroll
            for (int m = 0; m < 4; ++m) { const int row = row0 + ai * HALF + m * 16; const float rs = __builtin_amdgcn_rsqf(rstd[row] * (1.0f / 1024.0f) + EPS); bf16_t* rowp = dst + (size_t)row * 1024;
#pragma unroll
                for (int bj = 0; bj < 2; ++bj) { float v[8];
#pragma unroll
                    for (int j = 0; j < 4; ++j) { v[j] = acc[ai][bj][m][0][j] * rs; v[4 + j] = acc[ai][bj][m][1][j] * rs; }
#pragma unroll
                    for (int j = 0; j < 8; ++j) v[j] = __builtin_amdgcn_rcpf(1.0f + __builtin_amdgcn_exp2f(-1.4426950408889634f * v[j]));
                    u32x4 w; w.x = cvt_pk_bf16(v[0], v[1]); w.y = cvt_pk_bf16(v[2], v[3]); w.z = cvt_pk_bf16(v[4], v[5]); w.w = cvt_pk_bf16(v[6], v[7]);
                    *(u32x4*)(rowp + bj * HALF) = w; } }
    }
};
template <bool FIRST> struct EpiMerge {
    static constexpr bool PERM = true, AFTER_DRAIN = false;
    const bf16_t* G; bf16_t* Mg;
    __device__ __forceinline__ void operator()(const f32x4 (&acc)[2][2][4][2], const Unit& u, int wr, int wc, int fr, int fq) const {
        const int row0 = u.pm * BM + wr * 64 + fr; const int col0 = u.pn * BM + wc * 32 + 8 * fq;
#pragma unroll
        for (int ai = 0; ai < 2; ++ai)
#pragma unroll
            for (int m = 0; m < 4; ++m) { const size_t off = (size_t)(row0 + ai * HALF + m * 16) * 1024 + col0;
#pragma unroll
                for (int bj = 0; bj < 2; ++bj) { const u32x4 g = *(const u32x4*)(G + off + bj * HALF); const f32x4 a0 = acc[ai][bj][m][0], a1 = acc[ai][bj][m][1];
                    float v[8] = { bf_lo(g.x) * a0[0], bf_hi(g.x) * a0[1], bf_lo(g.y) * a0[2], bf_hi(g.y) * a0[3], bf_lo(g.z) * a1[0], bf_hi(g.z) * a1[1], bf_lo(g.w) * a1[2], bf_hi(g.w) * a1[3] };
                    if (!FIRST) { const u32x4 o = *(const u32x4*)(Mg + off + bj * HALF);
                        v[0] += bf_lo(o.x); v[1] += bf_hi(o.x); v[2] += bf_lo(o.y); v[3] += bf_hi(o.y); v[4] += bf_lo(o.z); v[5] += bf_hi(o.z); v[6] += bf_lo(o.w); v[7] += bf_hi(o.w); }
                    u32x4 w; w.x = cvt_pk_bf16(v[0], v[1]); w.y = cvt_pk_bf16(v[2], v[3]); w.z = cvt_pk_bf16(v[4], v[5]); w.w = cvt_pk_bf16(v[6], v[7]);
                    *(u32x4*)(Mg + off + bj * HALF) = w; }
                asm volatile("" ::: "memory"); }
    }
};
struct EpiResid {
    static constexpr bool PERM = false, AFTER_DRAIN = false;
    const float* src; float* out; bf16_t* xb; float* ssq;
    __device__ __forceinline__ void operator()(const f32x4 (&acc)[2][2][4][2], const Unit& u, int wr, int wc, int fr, int fq) const {
        const int row0 = u.pm * BM + wr * 64 + fr, col0 = u.pn * BM + wc * 32 + 4 * fq;
#pragma unroll
        for (int ai = 0; ai < 2; ++ai)
#pragma unroll
            for (int m = 0; m < 4; ++m) { const int row = row0 + ai * HALF + m * 16; const size_t off = (size_t)row * 1024 + col0; float sq = 0.f;
#pragma unroll
                for (int bj = 0; bj < 2; ++bj)
#pragma unroll
                    for (int n = 0; n < 2; ++n) { const f32x4 s = *(const f32x4*)(src + off + bj * HALF + n * 16); const f32x4 v = s + acc[ai][bj][m][n]; *(f32x4*)(out + off + bj * HALF + n * 16) = v;
                        if (xb) { typedef unsigned u32x2v __attribute__((ext_vector_type(2))); u32x2v w; w.x = cvt_pk_bf16(v[0], v[1]); w.y = cvt_pk_bf16(v[2], v[3]); *(u32x2v*)(xb + off + bj * HALF + n * 16) = w;
                            sq += (v[0] * v[0] + v[1] * v[1]) + (v[2] * v[2] + v[3] * v[3]); } }
                if (xb) { sq += __shfl_xor(sq, 16); sq += __shfl_xor(sq, 32); if (fq == 0) unsafeAtomicAdd(ssq + row, sq); } }
    }
};
struct EpiUp {
    static constexpr bool PERM = true, AFTER_DRAIN = false;
    bf16_t* O; const float* rstd;
    __device__ __forceinline__ void operator()(const f32x4 (&acc)[2][2][4][2], const Unit& u, int wr, int wc, int fr, int fq) const {
        const int row0 = u.pm * BM + wr * 64 + fr; const int col0 = u.pn * BM + wc * 32 + 8 * fq;
#pragma unroll
        for (int ai = 0; ai < 2; ++ai)
#pragma unroll
            for (int m = 0; m < 4; ++m) { const int row = row0 + ai * HALF + m * 16; const float rs = __builtin_amdgcn_rsqf(rstd[row] * (1.0f / 1024.0f) + EPS); bf16_t* rowp = O + (size_t)row * DFF + col0;
#pragma unroll
                for (int bj = 0; bj < 2; ++bj) { float v[8];
#pragma unroll
                    for (int j = 0; j < 4; ++j) { v[j] = fmaxf(acc[ai][bj][m][0][j] * rs, 0.f); v[4 + j] = fmaxf(acc[ai][bj][m][1][j] * rs, 0.f); }
#pragma unroll
                    for (int j = 0; j < 8; ++j) v[j] = v[j] * v[j];
                    u32x4 w; w.x = cvt_pk_bf16(v[0], v[1]); w.y = cvt_pk_bf16(v[2], v[3]); w.z = cvt_pk_bf16(v[4], v[5]); w.w = cvt_pk_bf16(v[6], v[7]);
                    *(u32x4*)(rowp + bj * HALF) = w; } }
    }
};

template <class Epi, class Sched, bool ALIGN_EPI = false, bool SP2 = false>
__device__ __forceinline__ void gemm_phase(PG8_LAS unsigned char* lds, const Gemm g, const Sched& S, const Epi& E, int tid_in) {
    int tid_ = tid_in; asm volatile("" : "+v"(tid_));
    const int tid = tid_, wid = __builtin_amdgcn_readfirstlane(tid >> 6), lane = tid & 63, wr = wid >> 2, wc = wid & 3, fr = lane & 15, fq = lane >> 4;
    const int K = g.K, nt = K / BK;
    unsigned voffA[2], voffB[2];
#pragma unroll
    for (int i = 0; i < 2; ++i) { int R, C; stage_rc(tid * 16 + i * 8192, R, C); const int Rb = Epi::PERM ? ((R & ~31) + perm32(R & 31)) : R;
        voffA[i] = (unsigned)(R * K + C) * 2u; voffB[i] = (unsigned)(Rb * K + C) * 2u; }
    const size_t kstep = (size_t)(BK * 2);
    const size_t hstep = (size_t)HALF * K * 2;
    const size_t tstep = 2 * hstep;
    const unsigned ldsw = (unsigned)wid * 1024u;
    const int aoff = lds_byte(wr * 64 + fr, fq * 8), boff = lds_byte(wc * 32 + fr, fq * 8);
#define PG8_SA(b, h) (((b) * 2 + (h)) * HTB)
#define PG8_SB(b, h) ((4 + (b) * 2 + (h)) * HTB)
#define PG8_STAGE(bufoff, gbase, voff) do { _Pragma("unroll") for (int _i = 0; _i < 2; ++_i) \
        __builtin_amdgcn_global_load_lds((const unsigned*)((const char*)(gbase) + (voff)[_i]), (PG8_LAS unsigned*)(lds + (bufoff) + ldsw + _i * 8192), 16, 0, 0); } while (0)
#define PG8_LDA(dst, b, h) do { _Pragma("unroll") for (int m = 0; m < 4; ++m) _Pragma("unroll") for (int k = 0; k < 2; ++k) dst[m][k] = *(const PG8_LAS bf16x8*)(lds + PG8_SA(b, h) + aoff + m * 2048 + k * 1024); } while (0)
#define PG8_LDB(dst, b, h) do { _Pragma("unroll") for (int n = 0; n < 2; ++n) _Pragma("unroll") for (int k = 0; k < 2; ++k) dst[n][k] = *(const PG8_LAS bf16x8*)(lds + PG8_SB(b, h) + boff + n * 2048 + k * 1024); } while (0)
#define PG8_MMA(ai, bj, At, Bt) do { __builtin_amdgcn_s_setprio(1); _Pragma("unroll") for (int m = 0; m < 4; ++m) _Pragma("unroll") for (int n = 0; n < 2; ++n) _Pragma("unroll") for (int k = 0; k < 2; ++k) \
        acc[ai][bj][m][n] = __builtin_amdgcn_mfma_f32_16x16x32_bf16(Bt[n][k], At[m][k], acc[ai][bj][m][n], 0, 0, 0); __builtin_amdgcn_s_setprio(0); } while (0)
#define PG8_WAIT_V(n) asm volatile("s_waitcnt vmcnt(" #n ")" ::: "memory")
#define PG8_WAIT_L(n) asm volatile("s_waitcnt lgkmcnt(" #n ")" ::: "memory")
#define PG8_BAR __builtin_amdgcn_s_barrier()
#define PG8_SCHED __builtin_amdgcn_sched_barrier(0)
    Unit cur, nxt; int ui = 0;
    if (!S.next(0, cur)) return;
    f32x4 acc[2][2][4][2];
#pragma unroll
    for (int a = 0; a < 2; ++a)
#pragma unroll
        for (int b = 0; b < 2; ++b)
#pragma unroll
            for (int m = 0; m < 4; ++m)
#pragma unroll
                for (int n = 0; n < 2; ++n) acc[a][b][m][n] = (f32x4){0.f, 0.f, 0.f, 0.f};
    bf16x8 At[4][2], B0[2][2], B1[2][2];
    const char* cA = (const char*)g.A + (size_t)cur.pm * tstep; const char* cB = (const char*)g.Bt + (size_t)cur.pn * tstep;
    S.a_ready(cur);
    if constexpr (SP2) {
        PG8_STAGE(PG8_SB(0, 0), cB, voffB); PG8_STAGE(PG8_SB(0, 1), cB + hstep, voffB); PG8_STAGE(PG8_SA(0, 0), cA, voffA); PG8_STAGE(PG8_SA(0, 1), cA + hstep, voffA);
        if (wr == 1) PG8_BAR;
        PG8_WAIT_V(2); PG8_BAR;
        PG8_STAGE(PG8_SB(1, 0), cB + kstep, voffB); PG8_STAGE(PG8_SA(1, 0), cA + kstep, voffA); PG8_STAGE(PG8_SB(1, 1), cB + hstep + kstep, voffB);
        PG8_WAIT_V(6); PG8_BAR;
    } else {
        PG8_STAGE(PG8_SB(0, 0), cB, voffB); PG8_STAGE(PG8_SA(0, 0), cA, voffA); PG8_STAGE(PG8_SB(0, 1), cB + hstep, voffB); PG8_STAGE(PG8_SA(0, 1), cA + hstep, voffA);
        if (wr == 1) PG8_BAR;
        PG8_WAIT_V(4); PG8_BAR;
        PG8_STAGE(PG8_SB(1, 0), cB + kstep, voffB); PG8_STAGE(PG8_SA(1, 0), cA + kstep, voffA); PG8_STAGE(PG8_SB(1, 1), cB + hstep + kstep, voffB);
        PG8_WAIT_V(6); PG8_BAR;
    }
    for (;;) {
        const bool has_next = S.next(ui + 1, nxt);
        const char* nA = has_next ? (const char*)g.A + (size_t)nxt.pm * tstep : cA; const char* nB = has_next ? (const char*)g.Bt + (size_t)nxt.pn * tstep : cB;
        for (int t = 0; t < nt; t += 2) {
            const bool last = (t == nt - 2);
            const char* a1 = cA + (size_t)(t + 1) * kstep;
            const char* a2 = last ? nA : cA + (size_t)(t + 2) * kstep; const char* b2 = last ? nB : cB + (size_t)(t + 2) * kstep;
            const char* a3 = a2 + kstep; const char* b3 = b2 + kstep;
            if (last && has_next) S.a_ready(nxt);
            if constexpr (SP2) {
            PG8_LDB(B0, 0, 0); PG8_LDB(B1, 0, 1); PG8_SCHED; PG8_LDA(At, 0, 0); PG8_STAGE(PG8_SA(1, 1), a1 + hstep, voffA);
            PG8_WAIT_V(8); PG8_WAIT_L(0); PG8_BAR; PG8_MMA(0, 0, At, B0); PG8_MMA(0, 1, At, B1); PG8_BAR; PG8_SCHED;
            PG8_LDA(At, 0, 1); PG8_STAGE(PG8_SB(0, 0), b2, voffB); PG8_STAGE(PG8_SB(0, 1), b2 + hstep, voffB); PG8_STAGE(PG8_SA(0, 0), a2, voffA);
            PG8_WAIT_V(8); PG8_WAIT_L(0); PG8_BAR; PG8_MMA(1, 0, At, B0); PG8_MMA(1, 1, At, B1); PG8_BAR; PG8_SCHED;
            PG8_LDB(B0, 1, 0); PG8_LDB(B1, 1, 1); PG8_SCHED; PG8_LDA(At, 1, 0); PG8_STAGE(PG8_SA(0, 1), a2 + hstep, voffA);
            PG8_WAIT_V(8); PG8_WAIT_L(0); PG8_BAR; PG8_MMA(0, 0, At, B0); PG8_MMA(0, 1, At, B1); PG8_BAR; PG8_SCHED;
            PG8_LDA(At, 1, 1); PG8_STAGE(PG8_SB(1, 0), b3, voffB); PG8_STAGE(PG8_SB(1, 1), b3 + hstep, voffB); PG8_STAGE(PG8_SA(1, 0), a3, voffA);
            PG8_WAIT_V(8); PG8_WAIT_L(0); PG8_BAR; PG8_MMA(1, 0, At, B0); PG8_MMA(1, 1, At, B1); PG8_BAR; PG8_SCHED;
            } else {
            PG8_LDB(B0, 0, 0); PG8_SCHED; PG8_LDA(At, 0, 0); PG8_STAGE(PG8_SA(1, 1), a1 + hstep, voffA);
            PG8_WAIT_L(8); PG8_BAR; PG8_WAIT_L(0); PG8_MMA(0, 0, At, B0); PG8_BAR; PG8_SCHED;
            PG8_LDB(B1, 0, 1); PG8_STAGE(PG8_SB(0, 0), b2, voffB);
            PG8_BAR; PG8_WAIT_L(0); PG8_MMA(0, 1, At, B1); PG8_BAR;
            PG8_LDA(At, 0, 1); PG8_STAGE(PG8_SA(0, 0), a2, voffA);
            PG8_BAR; PG8_WAIT_L(0); PG8_MMA(1, 0, At, B0); PG8_BAR; PG8_SCHED;
            PG8_STAGE(PG8_SB(0, 1), b2 + hstep, voffB);
            PG8_WAIT_V(6); PG8_BAR; PG8_MMA(1, 1, At, B1); PG8_BAR;
            PG8_LDB(B0, 1, 0); PG8_SCHED; PG8_LDA(At, 1, 0); PG8_STAGE(PG8_SA(0, 1), a2 + hstep, voffA);
            PG8_WAIT_L(8); PG8_BAR; PG8_WAIT_L(0); PG8_MMA(0, 0, At, B0); PG8_BAR; PG8_SCHED;
            PG8_LDB(B1, 1, 1); PG8_STAGE(PG8_SB(1, 0), b3, voffB);
            PG8_BAR; PG8_WAIT_L(0); PG8_MMA(0, 1, At, B1); PG8_BAR;
            PG8_LDA(At, 1, 1); PG8_STAGE(PG8_SA(1, 0), a3, voffA);
            PG8_BAR; PG8_WAIT_L(0); PG8_MMA(1, 0, At, B0); PG8_BAR; PG8_SCHED;
            PG8_STAGE(PG8_SB(1, 1), b3 + hstep, voffB);
            PG8_WAIT_V(6); PG8_BAR; PG8_MMA(1, 1, At, B1); PG8_BAR;
            }
        }
        if constexpr (ALIGN_EPI) { if (wr == 0) PG8_BAR; }
        if constexpr (!Epi::AFTER_DRAIN) { E(acc, cur, wr, wc, fr, fq); S.done(cur); }
        if (!has_next) break;
#pragma unroll
        for (int a = 0; a < 2; ++a)
#pragma unroll
            for (int b = 0; b < 2; ++b)
#pragma unroll
                for (int m = 0; m < 4; ++m)
#pragma unroll
                    for (int n = 0; n < 2; ++n) acc[a][b][m][n] = (f32x4){0.f, 0.f, 0.f, 0.f};
        cur = nxt; cA = nA; cB = nB; ++ui;
        if constexpr (ALIGN_EPI) { if (wr == 1) PG8_BAR; }
    }
    PG8_WAIT_V(0);
    if constexpr (!ALIGN_EPI) { if (wr == 0) PG8_BAR; }
    PG8_BAR;
    if constexpr (Epi::AFTER_DRAIN) { E.fused(acc, cur, wr, wc, fr, fq, lds, wid, lane); S.done(cur); }
#undef PG8_SA
#undef PG8_SB
#undef PG8_STAGE
#undef PG8_LDA
#undef PG8_LDB
#undef PG8_MMA
#undef PG8_WAIT_V
#undef PG8_WAIT_L
#undef PG8_BAR
#undef PG8_SCHED
}
}

#ifndef FAST_MOBA
#define FAST_MOBA 2
#endif
#ifndef PG8_SP2
#define PG8_SP2 true
#endif
#ifndef PROBE_SEL
#define PROBE_SEL 0
#endif
constexpr int NWAVES = 8;
constexpr int PH_PER_LAYER = 11;
constexpr int N_PHASES = 2 * PH_PER_LAYER + 1;
constexpr bool ONE_LAUNCH = (MK_ONE_LAUNCH != 0);
static_assert(ONE_LAUNCH, "build with MK_ONE_LAUNCH=1 (build.sh 1): the FIN phase needs its in-phase grid barrier");

constexpr size_t MiB = 1u << 20;
constexpr size_t WS_CTL = 0, CTL_ZERO_BYTES = 1 * MiB;
constexpr size_t WS_W_IN = 1 * MiB;
constexpr size_t WS_W_G = 11 * MiB;
constexpr size_t WS_W_PA = 17 * MiB, WS_W_PB = 18 * MiB, WS_W_PC = 19 * MiB;
constexpr size_t WS_W_O = 20 * MiB;
constexpr size_t WS_W_UP = 22 * MiB;
constexpr size_t WS_W_DN = 30 * MiB;
constexpr size_t WS_XB = 40 * MiB;
constexpr size_t WS_RSTD = 104 * MiB;
constexpr int CW_SSQ = 32768;
static_assert((CW_SSQ + 3 * T) * 4 <= (int)CTL_ZERO_BYTES, "ssq arrays inside the memset region");
constexpr size_t WS_KMEAN = 104 * MiB + 256 * 1024;
constexpr size_t WS_RGA = 104 * MiB + 256 * 1024;
constexpr size_t WS_RGH = 10 * MiB + 512 * 1024;
constexpr int RGC = 128;
constexpr size_t WS_WI = 105 * MiB;
constexpr size_t WS_KI = 106 * MiB;
constexpr size_t WS_ACT = 112 * MiB;
constexpr size_t ACT_STRIDE = (size_t)T * 512 * 2;
constexpr size_t WS_QA = WS_ACT, WS_QB = WS_ACT + ACT_STRIDE, WS_YC = WS_ACT + 2 * ACT_STRIDE, WS_KA = WS_ACT + 3 * ACT_STRIDE, WS_VA = WS_ACT + 4 * ACT_STRIDE,
                 WS_KB = WS_ACT + 5 * ACT_STRIDE, WS_VB = WS_ACT + 6 * ACT_STRIDE, WS_QI = WS_ACT + 7 * ACT_STRIDE, WS_XC = WS_ACT + 8 * ACT_STRIDE;
constexpr size_t WS_G = WS_KA;
constexpr size_t WS_MASK = 400 * MiB;
constexpr size_t WS_MERGED = 400 * MiB;
constexpr size_t WS_H = WS_ACT;
constexpr size_t WS_END = 512 * MiB;
static_assert(WS_XC + ACT_STRIDE == 400 * MiB && WS_G + (size_t)3 * T * 1024 * 2 == 400 * MiB && WS_H + (size_t)T * DFF * 2 <= 400 * MiB, "d_ws map");
constexpr int CW_DYN = 12288;
constexpr int CW_BAR = 4096;

constexpr int RING_OFF = 0, RING_BYTES = 131072;
constexpr int LDSCTL_OFF = RING_BYTES, MISC_OFF = LDSCTL_OFF + 320;
constexpr int LDS_BYTES = 147456;
constexpr int GL_SKEY = 0, GL_QIF = 65536, GL_WQ = GL_QIF + 2048, GL_HIST = GL_WQ + 64, GL_SEL = GL_HIST + 1024, GL_MISC = GL_SEL + 1024, GL_QS = 70656, GL_PS = 73728;
static_assert(GL_MISC + 64 <= GL_QS && GL_QS + 8 * 256 <= GL_PS && GL_PS + 8 * 4096 <= RING_BYTES, "golden LDS map");

#define GAS __attribute__((address_space(1)))
#define LAS __attribute__((address_space(3)))
typedef unsigned short bf16;
typedef unsigned v4u __attribute__((ext_vector_type(4)));
typedef float f32x4 __attribute__((ext_vector_type(4)));
typedef GAS unsigned gu32;
#define RLX_AGENT __ATOMIC_RELAXED, __HIP_MEMORY_SCOPE_AGENT
#define LDS_WAIT() asm volatile("s_waitcnt lgkmcnt(0)" ::: "memory")
#define VM_WAIT() asm volatile("s_waitcnt vmcnt(0)" ::: "memory")
__device__ __forceinline__ float bf2f(bf16 v) { return __uint_as_float(((unsigned)v) << 16); }
__device__ __forceinline__ unsigned pk2(float lo, float hi) { return pg8::cvt_pk_bf16(lo, hi); }
__device__ __forceinline__ unsigned f2bf(float f) { return pg8::cvt_pk_bf16(f, 0.f) & 0xffffu; }
__device__ __forceinline__ float wave_sum(float v) {
#pragma unroll
    for (int o = 1; o < 64; o <<= 1) v += __shfl_xor(v, o);
    return v;
}
__device__ __forceinline__ float wave_max(float v) {
#pragma unroll
    for (int o = 1; o < 64; o <<= 1) v = fmaxf(v, __shfl_xor(v, o));
    return v;
}
__device__ __forceinline__ int t5_bucket(int n) {
    if (n < 16) return n;
    if (n >= 113) return 31;
    return 16 + (n >= 19) + (n >= 21) + (n >= 24) + (n >= 27) + (n >= 31) + (n >= 35) + (n >= 40) + (n >= 46) + (n >= 52) + (n >= 59) + (n >= 67) + (n >= 77) + (n >= 87) + (n >= 99);
}

#define XB_TMO      128
#define XB_XCNT(j)  (256  + 64 * (j))
#define XB_XSUB(j)  (1280 + 64 * (j))
#define XB_XGEN(j)  (2304 + 64 * (j))
#define XB_TOP      3328
#define XB_TOPGEN   3392
#define XCD_BAR_WORDS 3456
#define XB_SPIN_CAP (1u << 22)

__device__ __forceinline__ unsigned xb_ld(unsigned* p)              { return __hip_atomic_load(p, __ATOMIC_RELAXED, __HIP_MEMORY_SCOPE_AGENT); }
__device__ __forceinline__ unsigned xb_add(unsigned* p, unsigned v) { return __hip_atomic_fetch_add(p, v, __ATOMIC_RELAXED, __HIP_MEMORY_SCOPE_AGENT); }
__device__ __forceinline__ unsigned xb_xcc_id() { return (unsigned)__builtin_amdgcn_s_getreg((3 << 11) | 20) & 0xFu; }
#define XB_SPIN(cond, bar) do { unsigned _sp = 0; while (cond) { __builtin_amdgcn_s_sleep(1); \
    if ((++_sp & 255u) == 0u) { if (xb_ld(&(bar)[XB_TMO])) break; if (_sp > XB_SPIN_CAP) { atomicAdd(&(bar)[XB_TMO], 1u); break; } } } } while (0)

struct XcdBarrier { unsigned* bar; unsigned x; volatile LAS unsigned* st; };

__device__ __forceinline__ XcdBarrier xcd_barrier_post(unsigned* bar, volatile LAS unsigned* st) {
    XcdBarrier b; b.bar = bar; b.x = xb_xcc_id(); b.st = st;
    if (threadIdx.x == 0) (void)xb_add(&bar[XB_XCNT(b.x)], 1u);
    return b;
}
__device__ __forceinline__ void xcd_barrier_complete(unsigned* bar, unsigned x, unsigned& nloc, unsigned& nx) {
    const unsigned G = gridDim.x * gridDim.y * gridDim.z;
    unsigned sum, cnt, mine, sp = 0u;
    for (;;) {
        sum = 0u; cnt = 0u; mine = 0u;
#pragma unroll
        for (unsigned j = 0; j < 16; ++j) { const unsigned c = xb_ld(&bar[XB_XCNT(j)]); sum += c; cnt += (c > 0u) ? 1u : 0u; }
        mine = xb_ld(&bar[XB_XCNT(x)]);
        if (sum == G) break;
        __builtin_amdgcn_s_sleep(1);
        if ((++sp & 255u) == 0u) { if (xb_ld(&bar[XB_TMO])) break; if (sp > XB_SPIN_CAP) { atomicAdd(&bar[XB_TMO], 1u); break; } }
    }
    nloc = mine > 0u ? mine : 1u; nx = cnt > 0u ? cnt : 1u;
}
__device__ __forceinline__ void xcd_barrier(const XcdBarrier& b) {
    asm volatile("s_waitcnt vmcnt(0)" ::: "memory");
    __syncthreads();
    if (threadIdx.x == 0) {
        unsigned* bar = b.bar;
        __builtin_amdgcn_s_waitcnt(0);
        unsigned nloc = b.st[0], nx = b.st[1];
        if (nloc == 0u) { xcd_barrier_complete(bar, b.x, nloc, nx); b.st[0] = nloc; b.st[1] = nx; }
        const unsigned old = xb_add(&bar[XB_XSUB(b.x)], 1u);
        const unsigned gen = old / nloc;
        if (old + 1u == (gen + 1u) * nloc) {
            __builtin_amdgcn_fence(__ATOMIC_RELEASE, "agent");
            asm volatile("s_waitcnt vmcnt(0)" ::: "memory");
            const unsigned og = xb_add(&bar[XB_TOP], 1u);
            const unsigned tg = og / nx;
            if (og + 1u == (tg + 1u) * nx) xb_add(&bar[XB_TOPGEN], 1u);
            else XB_SPIN(xb_ld(&bar[XB_TOPGEN]) == tg, bar);
            __builtin_amdgcn_fence(__ATOMIC_ACQUIRE, "agent");
            xb_add(&bar[XB_XGEN(b.x)], 1u);
            asm volatile("s_waitcnt vmcnt(0)" ::: "memory");
        } else {
            XB_SPIN(xb_ld(&bar[XB_XGEN(b.x)]) == gen, bar);
            __builtin_amdgcn_fence(__ATOMIC_ACQUIRE, "agent");
            asm volatile("s_waitcnt vmcnt(0)" ::: "memory");
        }
    }
    __syncthreads();
}

struct Args { const float* in[19]; float* out; unsigned char* ws; int ph_lo, ph_hi; };
struct Frame {
    LAS unsigned char* lds;
    int tid, lane, wave, G, bid;
    int gw;
    const __attribute__((address_space(4))) Args* a;
    unsigned char* ws; float* out;
};
#define WSB(off) ((bf16*)(F.ws + (off)))
#define WSF(off) ((float*)(F.ws + (off)))
#define INP(i) (F.a->in[i])
#define SSQ_MIX(l) ((l) == 0 ? WSF(WS_RSTD) : (float*)(F.ws + WS_CTL) + CW_SSQ + T)
#define SSQ_MLP(l) ((float*)(F.ws + WS_CTL) + CW_SSQ + ((l) == 0 ? 0 : 2 * T))
enum { I_X = 0, I_RELB, I_NMG, I_WIN, I_CONVW, I_CONVB, I_WR, I_BR, I_WI, I_BI, I_LAM, I_WPA, I_WPB, I_WPC, I_WO, I_NLG, I_WUP, I_WDN, I_FNG };

template <class P> __device__ __forceinline__ P* launder_u(P* p) { unsigned lo = (unsigned)(uintptr_t)p, hi = (unsigned)((uintptr_t)p >> 32); asm volatile("" : "+v"(lo), "+v"(hi));
    lo = __builtin_amdgcn_readfirstlane(lo); hi = __builtin_amdgcn_readfirstlane(hi); return (P*)(((uintptr_t)hi << 32) | (uintptr_t)lo); }
__device__ __forceinline__ int launder_i(int v) { asm volatile("" : "+v"(v)); return __builtin_amdgcn_readfirstlane(v); }

__device__ __forceinline__ void transpose_item(const float* W, int ld, int K, int ncol_valid, const float* gain, bf16* WT, LAS float* scr, int item, int nblk, int lane) {
    const int kb = item / nblk, nb = item % nblk, k0 = 64 * kb, n0 = 32 * nb;
    const float gv = gain ? gain[k0 + lane] : 1.0f;
#pragma unroll 8
    for (int i = 0; i < 32; ++i) { const int kk = 2 * i + (lane >> 5); const int n = n0 + (lane & 31);
        float v = (n < ncol_valid) ? W[(size_t)(k0 + kk) * ld + n] : 0.f; v *= __shfl(gv, kk); scr[kk * 33 + (lane & 31)] = v; }
    LDS_WAIT(); asm volatile("" ::: "memory");
    const int c = lane & 7;
#pragma unroll
    for (int j = 0; j < 4; ++j) { const int n = (lane >> 3) + 8 * j; const LAS float* s = scr + (8 * c) * 33 + n;
        v4u o; o.x = pk2(s[0 * 33], s[1 * 33]); o.y = pk2(s[2 * 33], s[3 * 33]); o.z = pk2(s[4 * 33], s[5 * 33]); o.w = pk2(s[6 * 33], s[7 * 33]);
        *(GAS v4u*)(WT + (size_t)(n0 + n) * K + k0 + 8 * c) = o; }
    LDS_WAIT(); asm volatile("" ::: "memory");
}
__device__ __forceinline__ void norm_row(const float* xrow, bf16* orow, float* rstd_out, int lane) {
    const GAS f32x4* xr = (const GAS f32x4*)xrow + lane;
    f32x4 v[4]; float s = 0.f;
#pragma unroll
    for (int j = 0; j < 4; ++j) { v[j] = xr[64 * j]; s += (v[j].x * v[j].x + v[j].y * v[j].y) + (v[j].z * v[j].z + v[j].w * v[j].w); }
    const float ss = wave_sum(s);
    GAS unsigned long long* o8 = (GAS unsigned long long*)orow + lane;
#pragma unroll
    for (int j = 0; j < 4; ++j) o8[64 * j] = (unsigned long long)pk2(v[j].x, v[j].y) | ((unsigned long long)pk2(v[j].z, v[j].w) << 32);
    if (lane == 0) *rstd_out = ss;
}
__device__ __forceinline__ void p_prologue(Frame& F, int l) {
    LAS float* scr = (LAS float*)(F.lds + RING_OFF + F.wave * 16384);
    const int gw = F.bid * NWAVES + F.wave, NGW = F.G * NWAVES;
    const float* w_in = INP(I_WIN) + (size_t)l * DM * DIN; const float* g1 = INP(I_NMG) + l * DM; const float* g2 = INP(I_NLG) + l * DM;
    constexpr int I_BLK = 16 * 16;
    constexpr int I_SP = 16 * 3;
    constexpr int I_G = 16 * 96;
    constexpr int I_P = 8 * 32;
    constexpr int I_O = 16 * 32;
    constexpr int I_UP = 16 * 128;
    constexpr int I_DN = 64 * 32;
    constexpr int NITEMS = 9 * I_BLK + I_SP + I_G + 3 * I_P + I_O + I_UP + I_DN;
    for (int it = gw; it < NITEMS; it += NGW) {
        int r = it;
        if (r < 9 * I_BLK) { const int blk = r / I_BLK; r -= blk * I_BLK;
            const int c0 = blk == 0 ? 0 : blk == 1 ? 1536 : blk == 2 ? 4168 : blk == 3 ? 512 : blk == 4 ? 1024 : blk == 5 ? 2048 : blk == 6 ? 2560 : blk == 7 ? 3072 : 3656;
            transpose_item(w_in + c0, DIN, DM, 512, g1, WSB(WS_W_IN) + (size_t)blk * 512 * DM, scr, r, 16, F.lane); continue; }
        r -= 9 * I_BLK;
        if (r < I_SP) { transpose_item(w_in + 3584, DIN, DM, 72, g1, WSB(WS_W_IN) + (size_t)4608 * DM, scr, r, 3, F.lane); continue; } r -= I_SP;
        if (r < I_G) { transpose_item(w_in + 4680, DIN, DM, 3072, g1, WSB(WS_W_G), scr, r, 96, F.lane); continue; } r -= I_G;
        if (r < I_P) { transpose_item(INP(I_WPA) + (size_t)l * DH * DM, DM, DH, 1024, nullptr, WSB(WS_W_PA), scr, r, 32, F.lane); continue; } r -= I_P;
        if (r < I_P) { transpose_item(INP(I_WPB) + (size_t)l * DH * DM, DM, DH, 1024, nullptr, WSB(WS_W_PB), scr, r, 32, F.lane); continue; } r -= I_P;
        if (r < I_P) { transpose_item(INP(I_WPC) + (size_t)l * DH * DM, DM, DH, 1024, nullptr, WSB(WS_W_PC), scr, r, 32, F.lane); continue; } r -= I_P;
        if (r < I_O) { transpose_item(INP(I_WO) + (size_t)l * DM * DM, DM, DM, 1024, nullptr, WSB(WS_W_O), scr, r, 32, F.lane); continue; } r -= I_O;
        if (r < I_UP) { transpose_item(INP(I_WUP) + (size_t)l * DM * DFF, DFF, DM, DFF, g2, WSB(WS_W_UP), scr, r, 128, F.lane); continue; } r -= I_UP;
        transpose_item(INP(I_WDN) + (size_t)l * DFF * DM, DM, DFF, 1024, nullptr, WSB(WS_W_DN), scr, r, 32, F.lane);
    }
    { GAS v4u* z = (GAS v4u*)(WSB(WS_W_IN) + (size_t)(4608 + 96) * DM); const int gt = F.bid * (NWAVES * 64) + F.tid;
      unsigned zz = 0u; asm volatile("" : "+v"(zz));
      for (int i = gt; i < 160 * DM / 8; i += F.G * NWAVES * 64) z[i] = (v4u){zz, zz, zz, zz}; }
    if (l == 0) for (int m = gw; m < T; m += NGW) norm_row(INP(I_X) + (size_t)m * DM, WSB(WS_XB) + (size_t)m * DM, WSF(WS_RSTD) + m, F.lane);
}
__device__ __forceinline__ void p_norm2(Frame& F) {
    const int gw = F.bid * NWAVES + F.wave, NGW = F.G * NWAVES;
    for (int m = gw; m < T; m += NGW) norm_row(F.out + (size_t)m * DM, WSB(WS_XB) + (size_t)m * DM, WSF(WS_RSTD) + m, F.lane);
}
__device__ __forceinline__ void p_final(Frame& F) {
    const int gw = F.bid * NWAVES + F.wave, NGW = F.G * NWAVES;
    for (int m = gw; m < T; m += NGW) {
        GAS f32x4* xr = (GAS f32x4*)(F.out + (size_t)m * DM) + F.lane; const GAS f32x4* gr = (const GAS f32x4*)INP(I_FNG) + F.lane;
        f32x4 v[4]; float s = 0.f;
#pragma unroll
        for (int j = 0; j < 4; ++j) { v[j] = xr[64 * j]; s += (v[j].x * v[j].x + v[j].y * v[j].y) + (v[j].z * v[j].z + v[j].w * v[j].w); }
        const float rstd = 1.0f / sqrtf(wave_sum(s) * (1.0f / DM) + EPS);
#pragma unroll
        for (int j = 0; j < 4; ++j) xr[64 * j] = v[j] * rstd * gr[64 * j];
    }
}

__device__ __forceinline__ void kmean_unit(Frame& F, int b, int n) {
    const bf16* kp = WSB(WS_KA) + ((size_t)b * SEQ + (size_t)n * 256) * 512 + F.tid; float s = 0.f;
#pragma unroll 8
    for (int j = 0; j < 256; ++j) s += bf2f(kp[(size_t)j * 512]);
    WSF(WS_KMEAN)[((size_t)b * NBLK + n) * 512 + F.tid] = s * (1.0f / 256.0f);
}
__device__ __forceinline__ float sigmoidf_(float v) { return 1.0f / (1.0f + __expf(-v)); }
typedef short bf16x8_t __attribute__((ext_vector_type(8)));
constexpr int RG_XB_STRIDE = 72;
constexpr int RG_XRAW = 0, RG_YRAW = 2048, RG_XB = 4096, RG_PR = RG_XB + 16 * RG_XB_STRIDE * 2, RG_PI = RG_PR + 16 * 64 * 4, RG_WAVE_LDS = RG_PI + 16 * 64 * 4;
static_assert(8 * RG_WAVE_LDS <= RING_BYTES, "rg LDS");
template <bool P2> __device__ __forceinline__ void rg_unit(Frame& F, int l, int b, int c) {
    int d_ = F.lane; asm volatile("" : "+v"(d_));
    const int n = F.wave, d = d_, ch = n * 64 + d;
    LAS unsigned char* wl = F.lds + RING_OFF + n * RG_WAVE_LDS;
    LAS bf16* xraw = (LAS bf16*)(wl + RG_XRAW); LAS bf16* yraw = (LAS bf16*)(wl + RG_YRAW); LAS bf16* xb = (LAS bf16*)(wl + RG_XB); LAS float* prl = (LAS float*)(wl + RG_PR); LAS float* pil = (LAS float*)(wl + RG_PI);
    const int col = d & 15, kq = d >> 4;
    bf16x8_t wfr[2][4], wfi[2][4];
    { const GAS float* prs = (const GAS float*)INP(I_WR) + (((size_t)l * 8 + n) * 64) * 64 + (8 * kq * 64 + col); const GAS float* pis = (const GAS float*)INP(I_WI) + (((size_t)l * 8 + n) * 64) * 64 + (8 * kq * 64 + col);
#pragma unroll
      for (int ks = 0; ks < 2; ++ks)
#pragma unroll
        for (int nb = 0; nb < 4; ++nb) { float tr[8], ti[8];
#pragma unroll
            for (int j = 0; j < 8; ++j) { const int o = (32 * ks + j) * 64 + 16 * nb; tr[j] = prs[o]; ti[j] = pis[o]; }
            union { bf16x8_t v; unsigned u[4]; } ur, ui;
#pragma unroll
            for (int j = 0; j < 4; ++j) { ur.u[j] = pk2(tr[2 * j], tr[2 * j + 1]); ui.u[j] = pk2(ti[2 * j], ti[2 * j + 1]); }
            wfr[ks][nb] = ur.v; wfi[ks][nb] = ui.v; } }
    const float br = ((const GAS float*)INP(I_BR) + l * 512)[ch], bi = ((const GAS float*)INP(I_BI) + l * 512)[ch];
    const float lamv = ((const GAS float*)INP(I_LAM) + l * 512)[ch]; const float sp = log1pf(__expf(-lamv));
    const GAS float* cwp = (const GAS float*)INP(I_CONVW) + (size_t)l * 4 * 512;
    const float cw0 = cwp[ch], cw1 = cwp[512 + ch], cw2 = cwp[1024 + ch], cw3 = cwp[1536 + ch];
    const float cb = ((const GAS float*)INP(I_CONVB) + l * 512)[ch];
    float h = 0.f, A = 1.f;
    if (P2) { const GAS float* ra = (const GAS float*)WSF(WS_RGA) + (size_t)b * RGC * 512; const GAS float* rh = (const GAS float*)WSF(WS_RGH) + (size_t)b * RGC * 512;
        const GAS float* rap = ra + ch; const GAS float* rhp = rh + ch;
        int j = 0;
#pragma unroll 1
        for (; j + 4 <= c; j += 4) { const float a0 = rap[0], a1 = rap[512], a2 = rap[1024], a3 = rap[1536], h0 = rhp[0], h1 = rhp[512], h2 = rhp[1024], h3 = rhp[1536];
            h = a0 * h + h0; h = a1 * h + h1; h = a2 * h + h2; h = a3 * h + h3; rap += 2048; rhp += 2048; }
#pragma unroll 1
        for (; j < c; ++j) { h = rap[0] * h + rhp[0]; rap += 512; rhp += 512; } }
    const int t0 = c * (SEQ / RGC);
    const GAS bf16* xcs = (const GAS bf16*)WSB(WS_XC) + ((size_t)b * SEQ + t0) * 512;
    GAS bf16* ycs = (GAS bf16*)WSB(WS_YC) + ((size_t)b * SEQ + t0) * 512;
    float x1 = 0.f, x2 = 0.f, x3 = 0.f;
    if (t0 > 0) { const GAS bf16* xm = xcs - 3 * 512; x3 = bf2f(xm[ch]); x2 = bf2f(xm[512 + ch]); x1 = bf2f(xm[1024 + ch]); }
    const int tokA = d >> 3, chk = d & 7;
    const size_t goff = (size_t)tokA * 512 + n * 64 + chk * 8;
    const int loff = tokA * 64 + chk * 8;
#pragma unroll 1
    for (int tile = 0; tile < SEQ / RGC / 16; ++tile) {
        const GAS bf16* xt = xcs + (size_t)tile * 16 * 512 + goff; GAS bf16* yt = ycs + (size_t)tile * 16 * 512 + goff;
        { const v4u a0 = *(const GAS v4u*)xt, a1 = *(const GAS v4u*)(xt + 8 * 512); *(LAS v4u*)(xraw + loff) = a0; *(LAS v4u*)(xraw + loff + 8 * 64) = a1; }
        if (P2) { const v4u a0 = *(const GAS v4u*)yt, a1 = *(const GAS v4u*)(yt + 8 * 512); *(LAS v4u*)(yraw + loff) = a0; *(LAS v4u*)(yraw + loff + 8 * 64) = a1; }
        LDS_WAIT(); asm volatile("" ::: "memory");
        float xc[16];
#pragma unroll
        for (int i = 0; i < 16; ++i) { const float xv = bf2f(xraw[i * 64 + d]); xc[i] = cb + cw0 * x3 + cw1 * x2 + cw2 * x1 + cw3 * xv; x3 = x2; x2 = x1; x1 = xv; }
#pragma unroll
        for (int i = 0; i < 16; ++i) xb[i * RG_XB_STRIDE + d] = (bf16)f2bf(xc[i]);
        LDS_WAIT(); asm volatile("" ::: "memory");
        bf16x8_t af[2];
#pragma unroll
        for (int ks = 0; ks < 2; ++ks) af[ks] = *(const LAS bf16x8_t*)(xb + col * RG_XB_STRIDE + 32 * ks + 8 * kq);
        f32x4 ar[4], ai[4];
#pragma unroll
        for (int nb = 0; nb < 4; ++nb) { ar[nb] = (f32x4){0.f, 0.f, 0.f, 0.f}; ai[nb] = (f32x4){0.f, 0.f, 0.f, 0.f};
#pragma unroll
            for (int ks = 0; ks < 2; ++ks) { ar[nb] = __builtin_amdgcn_mfma_f32_16x16x32_bf16(af[ks], wfr[ks][nb], ar[nb], 0, 0, 0); ai[nb] = __builtin_amdgcn_mfma_f32_16x16x32_bf16(af[ks], wfi[ks][nb], ai[nb], 0, 0, 0); } }
        asm volatile("s_nop 15\n\ts_nop 15" : "+v"(ar[0]), "+v"(ar[1]), "+v"(ar[2]), "+v"(ar[3]), "+v"(ai[0]), "+v"(ai[1]), "+v"(ai[2]), "+v"(ai[3]));
#pragma unroll
        for (int nb = 0; nb < 4; ++nb)
#pragma unroll
            for (int r = 0; r < 4; ++r) { prl[(4 * kq + r) * 64 + 16 * nb + col] = ar[nb][r]; pil[(4 * kq + r) * 64 + 16 * nb + col] = ai[nb][r]; }
        LDS_WAIT(); asm volatile("" ::: "memory");
#pragma unroll
        for (int i = 0; i < 16; ++i) {
            const float r = __builtin_amdgcn_rcpf(1.0f + __expf(-(prl[i * 64 + d] + br))), ig = __builtin_amdgcn_rcpf(1.0f + __expf(-(pil[i * 64 + d] + bi)));
            const float la = -8.0f * r * sp; const float a = __expf(la);
            const float x2a = 2.0f * la;
            const float om = (x2a > -0.05f) ? -x2a * (1.0f + x2a * (0.5f + x2a * (0.16666667f + x2a * 0.041666668f))) : 1.0f - a * a;
            const float u = __builtin_amdgcn_sqrtf(om) * (ig * xc[i]);
            h = a * h + u;
            if (!P2) A *= a;
            else { const float y = bf2f(yraw[i * 64 + d]); const float z = 0.7978845608028654f * (y + 0.044715f * y * y * y);
                const float th = 1.0f - 2.0f * __builtin_amdgcn_rcpf(1.0f + __expf(2.0f * z));
                yraw[i * 64 + d] = (bf16)f2bf(h * (0.5f * y * (1.0f + th))); }
        }
        LDS_WAIT(); asm volatile("" ::: "memory");
        if (P2) { const v4u a0 = *(const LAS v4u*)(yraw + loff), a1 = *(const LAS v4u*)(yraw + loff + 8 * 64); *(GAS v4u*)yt = a0; *(GAS v4u*)(yt + 8 * 512) = a1; }
        LDS_WAIT(); asm volatile("" ::: "memory");
    }
    if (!P2) { const size_t o = ((size_t)b * RGC + c) * 512; ((GAS float*)WSF(WS_RGA) + o)[ch] = A; ((GAS float*)WSF(WS_RGH) + o)[ch] = h; }
    __syncthreads();
}

__device__ __forceinline__ float dot64(const LAS float* qs, const bf16* krow) {
    const v4u* kr = (const v4u*)krow; float s = 0.f;
#pragma unroll
    for (int c = 0; c < 8; ++c) { const v4u w = kr[c]; const f32x4 q0 = *(const LAS f32x4*)(qs + c * 8), q1 = *(const LAS f32x4*)(qs + c * 8 + 4);
        s += q0.x * __uint_as_float(w.x << 16) + q0.y * __uint_as_float(w.x & 0xffff0000u) + q0.z * __uint_as_float(w.y << 16) + q0.w * __uint_as_float(w.y & 0xffff0000u)
           + q1.x * __uint_as_float(w.z << 16) + q1.y * __uint_as_float(w.z & 0xffff0000u) + q1.z * __uint_as_float(w.w << 16) + q1.w * __uint_as_float(w.w & 0xffff0000u); }
    return s;
}
__device__ __forceinline__ void moba_unit(Frame& F, int b, int t) {
    const int h = F.wave, lane = F.lane, cur = t >> 8;
    LAS float* qs = (LAS float*)(F.lds + GL_QS) + h * 64; LAS float* ps = (LAS float*)(F.lds + GL_PS) + h * 1024;
    const size_t row = (size_t)b * SEQ + t;
    bf16* qrow = WSB(WS_QA) + row * 512 + h * 64;
    qs[lane] = bf2f(qrow[lane]);
    LDS_WAIT(); asm volatile("" ::: "memory");
    float g = -1e30f;
    if (lane < cur) { const float* km = WSF(WS_KMEAN) + ((size_t)b * NBLK + lane) * 512 + h * 64; float s = 0.f;
#pragma unroll
        for (int d4 = 0; d4 < 16; ++d4) { const f32x4 kv = *(const f32x4*)(km + d4 * 4); const f32x4 qv = *(const LAS f32x4*)(qs + d4 * 4); s += kv.x * qv.x + kv.y * qv.y + kv.z * qv.z + kv.w * qv.w; }
        g = s; }
    int blk[4]; bool ok[4];
#pragma unroll
    for (int i = 0; i < 3; ++i) { const float m = wave_max(g); const unsigned long long bal = __ballot(g == m); const int sel = __ffsll((long long)bal) - 1; blk[i] = sel; ok[i] = sel < cur; if (lane == sel) g = -INFINITY; }
    blk[3] = cur; ok[3] = true;
    const bf16* Kh = WSB(WS_KA) + ((size_t)b * SEQ) * 512 + h * 64; const bf16* Vh = WSB(WS_VA) + ((size_t)b * SEQ) * 512 + h * 64;
    float lg[16];
#pragma unroll
    for (int i = 0; i < 16; ++i) { const int bi = i >> 2; const int pos = blk[bi] * 256 + (i & 3) * 64 + lane; const bool valid = ok[bi] && pos <= t;
        float s = -1e30f;
        if (valid) s = dot64(qs, Kh + (size_t)pos * 512) * 0.125f + INP(I_RELB)[t5_bucket(t - pos) * 16 + h];
        lg[i] = s; if ((i & 3) == 3) asm volatile("" ::: "memory"); }
    float m = lg[0];
#pragma unroll
    for (int i = 1; i < 16; ++i) m = fmaxf(m, lg[i]);
    m = wave_max(m); float sum = 0.f;
#pragma unroll
    for (int i = 0; i < 16; ++i) { const float e = __expf(lg[i] - m); sum += e; ps[i * 64 + lane] = e; }
    sum = wave_sum(sum);
    LDS_WAIT(); asm volatile("" ::: "memory");
    float acc = 0.f;
#pragma unroll
    for (int bi = 0; bi < 4; ++bi) {
        if (!ok[bi]) continue;
        const int base = blk[bi] * 256; const int nk = (bi == 3) ? (t - base + 1) : 256;
        const bf16* vp = Vh + (size_t)base * 512 + lane; const LAS float* pp = ps + bi * 256;
        int kk = 0;
        for (; kk + 8 <= nk; kk += 8) { float pv[8], vv[8];
#pragma unroll
            for (int j = 0; j < 8; ++j) { pv[j] = pp[kk + j]; vv[j] = bf2f(vp[(size_t)(kk + j) * 512]); }
#pragma unroll
            for (int j = 0; j < 8; ++j) acc += pv[j] * vv[j]; }
        for (; kk < nk; ++kk) acc += pp[kk] * bf2f(vp[(size_t)kk * 512]);
    }
    qrow[lane] = (bf16)f2bf(acc / sum);
}
__device__ __forceinline__ void dsa_unit(Frame& F, int b, int t) {
    const int tid = F.tid, lane = F.lane, h = F.wave;
    LAS unsigned* skey = (LAS unsigned*)(F.lds + GL_SKEY); LAS float* qif = (LAS float*)(F.lds + GL_QIF); LAS float* wq = (LAS float*)(F.lds + GL_WQ);
    LAS unsigned* hist = (LAS unsigned*)(F.lds + GL_HIST); LAS int* sel = (LAS int*)(F.lds + GL_SEL); LAS unsigned* misc = (LAS unsigned*)(F.lds + GL_MISC);
    const size_t row = (size_t)b * SEQ + t; const int n = t + 1;
    __syncthreads();
    qif[tid] = bf2f(WSB(WS_QI)[row * 512 + tid]);
    if (tid < 8) wq[tid] = WSF(WS_WI)[row * 8 + tid];
    if (tid < 16) misc[tid] = 0u;
    __syncthreads();
    if (n > 256) {
        const bf16* kib = WSB(WS_KI) + ((size_t)b * SEQ) * 64;
        for (int s = tid; s < n; s += NWAVES * 64) {
            float kf[64];
            { const v4u* kr = (const v4u*)(kib + (size_t)s * 64);
#pragma unroll
              for (int c = 0; c < 8; ++c) { const v4u w = kr[c]; kf[c * 8 + 0] = __uint_as_float(w.x << 16); kf[c * 8 + 1] = __uint_as_float(w.x & 0xffff0000u); kf[c * 8 + 2] = __uint_as_float(w.y << 16); kf[c * 8 + 3] = __uint_as_float(w.y & 0xffff0000u);
                  kf[c * 8 + 4] = __uint_as_float(w.z << 16); kf[c * 8 + 5] = __uint_as_float(w.z & 0xffff0000u); kf[c * 8 + 6] = __uint_as_float(w.w << 16); kf[c * 8 + 7] = __uint_as_float(w.w & 0xffff0000u); } }
            float score = 0.f;
#pragma unroll 1
            for (int hh = 0; hh < 8; ++hh) { float dsum = 0.f;
#pragma unroll
                for (int d4 = 0; d4 < 16; ++d4) { const f32x4 q = *(const LAS f32x4*)(qif + hh * 64 + d4 * 4); dsum += q.x * kf[d4 * 4] + q.y * kf[d4 * 4 + 1] + q.z * kf[d4 * 4 + 2] + q.w * kf[d4 * 4 + 3]; }
                score += wq[hh] * fmaxf(dsum, 0.f); asm volatile("" ::: "memory"); }
            score *= 0.04419417382415922f;
            if (score == 0.f) score = 0.f;
            const unsigned u = __float_as_uint(score);
            skey[s] = (u & 0x80000000u) ? ~u : (u | 0x80000000u);
        }
        __syncthreads();
        unsigned prefix = 0u; unsigned kneed = 256u, neq = 0u;
#pragma unroll
        for (int pass = 0; pass < 4; ++pass) {
            const int shift = 24 - 8 * pass;
            if (tid < 256) hist[tid] = 0u;
            __syncthreads();
            for (int s = tid; s < n; s += NWAVES * 64) { const unsigned key = skey[s]; const bool match = (pass == 0) ? true : ((key >> ((shift + 8) & 31)) == prefix);
                if (match) __hip_atomic_fetch_add(hist + ((key >> shift) & 255u), 1u, __ATOMIC_RELAXED, __HIP_MEMORY_SCOPE_WORKGROUP); }
            __syncthreads();
            if (h == 0) {
                const unsigned c0 = hist[4 * lane], c1 = hist[4 * lane + 1], c2 = hist[4 * lane + 2], c3 = hist[4 * lane + 3]; const unsigned tot = c0 + c1 + c2 + c3;
                unsigned S = tot;
#pragma unroll
                for (int o = 1; o < 64; o <<= 1) { const unsigned v = __shfl_down(S, o); if (lane + o < 64) S += v; }
                const unsigned above = S - tot;
                if (above < kneed && kneed <= S) { unsigned a = above; unsigned bsel, cnt;
                    if (a + c3 >= kneed) { bsel = 3; cnt = c3; } else { a += c3; if (a + c2 >= kneed) { bsel = 2; cnt = c2; } else { a += c2; if (a + c1 >= kneed) { bsel = 1; cnt = c1; } else { a += c1; bsel = 0; cnt = c0; } } }
                    misc[0] = 4u * lane + bsel; misc[1] = kneed - a; misc[2] = cnt; }
            }
            __syncthreads();
            prefix = (prefix << 8) | misc[0]; kneed = misc[1]; neq = misc[2];
            __syncthreads();
        }
        const unsigned Tk = prefix;
        for (int s = tid; s < n; s += NWAVES * 64) { const unsigned key = skey[s];
            if (key > Tk || (key == Tk && neq == kneed)) { const unsigned idx = __hip_atomic_fetch_add(misc + 8, 1u, __ATOMIC_RELAXED, __HIP_MEMORY_SCOPE_WORKGROUP); if (idx < 256u) sel[idx] = s; } }
        __syncthreads();
        if (neq != kneed && tid == 0) { unsigned c = misc[8]; unsigned need = kneed; for (int s = 0; s < n && need > 0u && c < 256u; ++s) if (skey[s] == Tk) { sel[c++] = s; --need; } }
    } else {
        if (tid < 256) sel[tid] = (tid <= t) ? tid : -1;
    }
    __syncthreads();
    LAS float* qs = (LAS float*)(F.lds + GL_QS) + h * 64; LAS float* ps = (LAS float*)(F.lds + GL_PS) + h * 1024;
    bf16* qrow = WSB(WS_QB) + row * 512 + h * 64;
    qs[lane] = bf2f(qrow[lane]);
    LDS_WAIT(); asm volatile("" ::: "memory");
    const bf16* Kh = WSB(WS_KB) + ((size_t)b * SEQ) * 512 + h * 64; const bf16* Vh = WSB(WS_VB) + ((size_t)b * SEQ) * 512 + h * 64;
    float lg[4];
#pragma unroll
    for (int i = 0; i < 4; ++i) { const int pos = sel[i * 64 + lane]; float s = -1e30f;
        if (pos >= 0) s = dot64(qs, Kh + (size_t)pos * 512) * 0.125f + INP(I_RELB)[t5_bucket(t - pos) * 16 + 8 + h];
        lg[i] = s; }
    float m = wave_max(fmaxf(fmaxf(lg[0], lg[1]), fmaxf(lg[2], lg[3]))); float sum = 0.f;
#pragma unroll
    for (int i = 0; i < 4; ++i) { const float e = __expf(lg[i] - m); sum += e; ps[i * 64 + lane] = e; }
    sum = wave_sum(sum);
    LDS_WAIT(); asm volatile("" ::: "memory");
    float acc = 0.f; const int nk = n < 256 ? n : 256;
    int kk = 0;
    for (; kk + 8 <= nk; kk += 8) { float pv[8], vv[8];
#pragma unroll
        for (int j = 0; j < 8; ++j) { const int pos = sel[kk + j]; pv[j] = ps[kk + j]; vv[j] = bf2f(Vh[(size_t)pos * 512 + lane]); }
#pragma unroll
        for (int j = 0; j < 8; ++j) acc += pv[j] * vv[j]; }
    for (; kk < nk; ++kk) { const int pos = sel[kk]; acc += ps[kk] * bf2f(Vh[(size_t)pos * 512 + lane]); }
    qrow[lane] = (bf16)f2bf(acc / sum);
}

typedef float f32x16 __attribute__((ext_vector_type(16)));
constexpr int AT_KROW = 144, AT_VROW = 136;
constexpr int AT_KBUF = 64 * AT_KROW, AT_VBUF = 64 * AT_VROW;
constexpr int AT_K0 = 0, AT_V0 = 2 * AT_KBUF, AT_BT = 36864, AT_OST = 40960;
constexpr float AT_C2 = 0.125f * 1.4426950408889634f;
constexpr float AT_THR = 8.0f;
constexpr float LOG2E = 1.4426950408889634f;
__device__ __forceinline__ int crow_(int r, int hi) { return (r & 3) + 8 * (r >> 2) + 4 * hi; }
#define MFMA_FENCE2(a, b) asm volatile("s_nop 15\n\ts_nop 15" : "+v"(a), "+v"(b))

__device__ __forceinline__ void at_load(const GAS bf16* Kh, const GAS bf16* Vh, int tile, int tid, v4u& kr, v4u& vr) {
    kr = *(const GAS v4u*)(Kh + (size_t)(tile * 64 + (tid >> 3)) * 512 + (tid & 7) * 8);
    vr = *(const GAS v4u*)(Vh + (size_t)(tile * 64 + (tid >> 3)) * 512 + (tid & 7) * 8);
}
__device__ __forceinline__ void at_store_vt(LAS unsigned char* vb, int tid, const v4u vr) {
    const bool even = ((tid >> 3) & 1) == 0;
    const unsigned s0 = even ? vr.z : vr.x, s1 = even ? vr.w : vr.y;
    const unsigned r0 = (unsigned)__builtin_amdgcn_update_dpp(0, (int)s0, 0x128, 0xf, 0xf, false), r1 = (unsigned)__builtin_amdgcn_update_dpp(0, (int)s1, 0x128, 0xf, 0xf, false);
    const unsigned o0 = even ? vr.x : vr.z, o1 = even ? vr.y : vr.w;
    const unsigned e0 = even ? o0 : r0, e1 = even ? o1 : r1, q0 = even ? r0 : o0, q1 = even ? r1 : o1;
    LAS unsigned* vt = (LAS unsigned*)(vb + ((tid & 7) * 8 + (even ? 0 : 4)) * AT_VROW + ((tid >> 3) & ~1) * 2);
    constexpr int RS = AT_VROW / 4;
    vt[0 * RS] = __builtin_amdgcn_perm(q0, e0, 0x05040100u); vt[1 * RS] = __builtin_amdgcn_perm(q0, e0, 0x07060302u);
    vt[2 * RS] = __builtin_amdgcn_perm(q1, e1, 0x05040100u); vt[3 * RS] = __builtin_amdgcn_perm(q1, e1, 0x07060302u);
}
__device__ __forceinline__ void at_store(LAS unsigned char* kb, LAS unsigned char* vb, int tid, const v4u kr, const v4u vr) {
    *(LAS v4u*)(kb + (tid >> 3) * AT_KROW + (tid & 7) * 16) = kr;
    at_store_vt(vb, tid, vr);
}
__device__ __forceinline__ void at_qk(f32x16& p0, f32x16& p1, const LAS unsigned char* kb, const bf16x8_t (&qf)[4], int r32, int hi) {
    const LAS unsigned char* kp = kb + r32 * AT_KROW + hi * 16;
    bf16x8_t k0[4], k1[4];
#pragma unroll
    for (int s = 0; s < 4; ++s) { k0[s] = *(const LAS bf16x8_t*)(kp + s * 32); k1[s] = *(const LAS bf16x8_t*)(kp + 32 * AT_KROW + s * 32); }
    asm volatile("s_waitcnt lgkmcnt(0)" : "+v"(k0[0]), "+v"(k0[1]), "+v"(k0[2]), "+v"(k0[3]), "+v"(k1[0]), "+v"(k1[1]), "+v"(k1[2]), "+v"(k1[3]) :: "memory");
#pragma unroll
    for (int s = 0; s < 4; ++s) { p0 = __builtin_amdgcn_mfma_f32_32x32x16_bf16(k0[s], qf[s], p0, 0, 0, 0); p1 = __builtin_amdgcn_mfma_f32_32x32x16_bf16(k1[s], qf[s], p1, 0, 0, 0); }
}
__device__ __forceinline__ void at_qk_m(f32x16& p0, f32x16& p1, const LAS unsigned char* kb, const bf16x8_t (&qf)[4], const bf16x8_t oneA, const bf16x8_t mB, int r32, int hi) {
    const LAS unsigned char* kp = kb + r32 * AT_KROW + hi * 16;
    bf16x8_t k0[4], k1[4];
#pragma unroll
    for (int s = 0; s < 4; ++s) { k0[s] = *(const LAS bf16x8_t*)(kp + s * 32); k1[s] = *(const LAS bf16x8_t*)(kp + 32 * AT_KROW + s * 32); }
    p0 = __builtin_amdgcn_mfma_f32_32x32x16_bf16(oneA, mB, p0, 0, 0, 0); p1 = __builtin_amdgcn_mfma_f32_32x32x16_bf16(oneA, mB, p1, 0, 0, 0);
    asm volatile("s_waitcnt lgkmcnt(0)" : "+v"(k0[0]), "+v"(k0[1]), "+v"(k0[2]), "+v"(k0[3]), "+v"(k1[0]), "+v"(k1[1]), "+v"(k1[2]), "+v"(k1[3]) :: "memory");
#pragma unroll
    for (int s = 0; s < 4; ++s) { p0 = __builtin_amdgcn_mfma_f32_32x32x16_bf16(k0[s], qf[s], p0, 0, 0, 0); p1 = __builtin_amdgcn_mfma_f32_32x32x16_bf16(k1[s], qf[s], p1, 0, 0, 0); }
}
__device__ __forceinline__ void at_pv(f32x16& o0, f32x16& o1, const LAS unsigned char* vb, const bf16x8_t (&pb)[4], int r32, int hi) {
    const LAS unsigned char* vp = vb + r32 * AT_VROW + hi * 8;
    union U { bf16x8_t v; unsigned long long u[2]; }; U a0[4], a1[4];
#pragma unroll
    for (int sg = 0; sg < 4; ++sg) { const int kvo = (32 * (sg >> 1) + 16 * (sg & 1)) * 2;
        a0[sg].u[0] = *(const LAS unsigned long long*)(vp + kvo); a0[sg].u[1] = *(const LAS unsigned long long*)(vp + kvo + 16);
        a1[sg].u[0] = *(const LAS unsigned long long*)(vp + 32 * AT_VROW + kvo); a1[sg].u[1] = *(const LAS unsigned long long*)(vp + 32 * AT_VROW + kvo + 16); }
    asm volatile("s_waitcnt lgkmcnt(0)" : "+v"(a0[0].v), "+v"(a0[1].v), "+v"(a0[2].v), "+v"(a0[3].v), "+v"(a1[0].v), "+v"(a1[1].v), "+v"(a1[2].v), "+v"(a1[3].v) :: "memory");
#pragma unroll
    for (int sg = 0; sg < 4; ++sg) { o0 = __builtin_amdgcn_mfma_f32_32x32x16_bf16(a0[sg].v, pb[sg], o0, 0, 0, 0); o1 = __builtin_amdgcn_mfma_f32_32x32x16_bf16(a1[sg].v, pb[sg], o1, 0, 0, 0); }
}
__device__ __forceinline__ float max3_(float a, float b, float c) { float r; asm("v_max3_f32 %0, %1, %2, %3" : "=v"(r) : "v"(a), "v"(b), "v"(c)); return r; }
__device__ __forceinline__ unsigned and_sel(float p, unsigned w, int bit) { int t; asm("v_bfe_i32 %0, %1, %2, 1" : "=v"(t) : "v"(w), "n"(bit)); return __float_as_uint(p) & (unsigned)t; }

template <int MODE  , bool DRY = false  >
__device__ __forceinline__ void attn_unit(Frame& F, int b, int h, int qt) {
    int tid_ = F.tid; asm volatile("" : "+v"(tid_));
    const int tid = tid_, lane = tid & 63, wave = F.wave, r32 = lane & 31, hi = lane >> 5;
    LAS unsigned char* L = F.lds + RING_OFF;
    LAS float* bt = (LAS float*)(L + AT_BT);
    const GAS bf16* Qg = (const GAS bf16*)WSB(MODE == 0 ? WS_QA : WS_QB); const GAS bf16* Kg = (const GAS bf16*)WSB(MODE == 0 ? WS_KA : WS_KB); const GAS bf16* Vg = (const GAS bf16*)WSB(MODE == 0 ? WS_VA : WS_VB);
    const size_t rowb = (size_t)b * SEQ;
    const GAS bf16* Kh = Kg + rowb * 512 + h * 64; const GAS bf16* Vh = Vg + rowb * 512 + h * 64;
    const int q0w = qt * 256 + wave * 32, q = q0w + r32;
    const int NT = 4 * qt + 4;
    __syncthreads();
    if (tid < 128) { const GAS float* rb = (const GAS float*)INP(I_RELB) + (MODE * 8 + h); bt[tid] = (rb[t5_bucket(tid) * 16] - rb[31 * 16]) * LOG2E; }
    bf16x8_t qf[4];
    { const GAS bf16* qp = Qg + (rowb + q) * 512 + h * 64 + hi * 8;
#pragma unroll
      for (int s = 0; s < 4; ++s) qf[s] = *(const GAS bf16x8_t*)(qp + s * 16); }
    unsigned mlo = 0u, mhi = 0u;
    if (MODE == 0) {
        { const int n = tid >> 3, c8 = (tid & 7) * 8; const GAS float* km = (const GAS float*)WSF(WS_KMEAN) + ((size_t)b * NBLK + n) * 512 + h * 64 + c8;
          const f32x4 a = *(const GAS f32x4*)km, c = *(const GAS f32x4*)(km + 4);
          const unsigned h0 = pk2(a.x, a.y), h1 = pk2(a.z, a.w), h2 = pk2(c.x, c.y), h3 = pk2(c.z, c.w);
          const unsigned l0 = pk2(a.x - __uint_as_float(h0 << 16), a.y - __uint_as_float(h0 & 0xffff0000u)), l1 = pk2(a.z - __uint_as_float(h1 << 16), a.w - __uint_as_float(h1 & 0xffff0000u)),
                         l2 = pk2(c.x - __uint_as_float(h2 << 16), c.y - __uint_as_float(h2 & 0xffff0000u)), l3 = pk2(c.z - __uint_as_float(h3 << 16), c.w - __uint_as_float(h3 & 0xffff0000u));
          *(LAS v4u*)(L + AT_K0 + n * AT_KROW + (tid & 7) * 16) = (v4u){h0, h1, h2, h3}; *(LAS v4u*)(L + AT_K0 + AT_KBUF + n * AT_KROW + (tid & 7) * 16) = (v4u){l0, l1, l2, l3}; }
        __syncthreads();
        f32x16 g0 = {0.f, 0.f, 0.f, 0.f, 0.f, 0.f, 0.f, 0.f, 0.f, 0.f, 0.f, 0.f, 0.f, 0.f, 0.f, 0.f}, g1 = g0;
        at_qk(g0, g1, L + AT_K0, qf, r32, hi); at_qk(g0, g1, L + AT_K0 + AT_KBUF, qf, r32, hi);
        MFMA_FENCE2(g0, g1);
#pragma unroll
        for (int r = 0; r < 16; ++r) { if (crow_(r, hi) >= qt) g0[r] = -INFINITY; if (32 + crow_(r, hi) >= qt) g1[r] = -INFINITY; }
#pragma unroll
        for (int it = 0; it < 3; ++it) {
            float bv = -INFINITY; int bn = 64;
#pragma unroll
            for (int r = 0; r < 16; ++r) if (g0[r] > bv) { bv = g0[r]; bn = crow_(r, hi); }
#pragma unroll
            for (int r = 0; r < 16; ++r) if (g1[r] > bv) { bv = g1[r]; bn = 32 + crow_(r, hi); }
            const float pv = __shfl_xor(bv, 32); const int pn = __shfl_xor(bn, 32);
            const bool tp = (pv > bv) || (pv == bv && pn < bn);
            const float wv = tp ? pv : bv; const int wn = tp ? pn : bn;
            if (wv > -INFINITY) { if (wn < 32) mlo |= 1u << wn; else mhi |= 1u << (wn - 32); }
#pragma unroll
            for (int r = 0; r < 16; ++r) { if (crow_(r, hi) == wn) g0[r] = -INFINITY; if (32 + crow_(r, hi) == wn) g1[r] = -INFINITY; }
        }
        __syncthreads();
    }
    v4u krA, vrA, krB, vrB; unsigned wlA = 0u, whA = 0u, wlB = 0u, whB = 0u;
    const GAS unsigned* mrow = (const GAS unsigned*)(F.ws + WS_MASK) + (rowb + q) * 512;
    at_load(Kh, Vh, 0, tid, krA, vrA);
    unsigned wl_c = 0u, wh_c = 0u;
    if (MODE == 1) { wl_c = mrow[0]; wh_c = mrow[1]; }
    at_store(L + AT_K0, L + AT_V0, tid, krA, vrA);
    at_load(Kh, Vh, 1, tid, krA, vrA);
    if (MODE == 1) { wlA = mrow[2]; whA = mrow[3]; }
    __syncthreads();
    float m = -1e30f, lsum = 0.f;
    f32x16 o0 = {0.f, 0.f, 0.f, 0.f, 0.f, 0.f, 0.f, 0.f, 0.f, 0.f, 0.f, 0.f, 0.f, 0.f, 0.f, 0.f}, o1 = o0;
    auto step = [&](int t, v4u& krS, v4u& vrS, unsigned& wlS, unsigned& whS, v4u& krN, v4u& vrN, unsigned& wlN, unsigned& whN) __attribute__((always_inline)) {
        const int cur = t & 1;
        unsigned wlo = wl_c, whi = wh_c;
        if (t + 2 < NT) { at_load(Kh, Vh, t + 2, tid, krN, vrN); if (MODE == 1) { wlN = mrow[2 * (t + 2)]; whN = mrow[2 * (t + 2) + 1]; } }
        if (MODE == 0) {
            if (t < 4 * qt) { const int blk = t >> 2; const unsigned bit = (blk < 32 ? (mlo >> blk) : (mhi >> (blk - 32))) & 1u; wlo = whi = bit ? 0xffffffffu : 0u; }
            else { const int nall = q - t * 64 + 1;
                wlo = nall >= 32 ? 0xffffffffu : (nall <= 0 ? 0u : ((1u << nall) - 1u)); whi = nall >= 64 ? 0xffffffffu : (nall <= 32 ? 0u : ((1u << (nall - 32)) - 1u)); }
        }
        if (__any((wlo | whi) != 0u)) {
            const LAS unsigned char* kb = L + AT_K0 + cur * AT_KBUF; const LAS unsigned char* vb = L + AT_V0 + cur * AT_VBUF;
            const bool and_mask = (MODE == 1) || (t >= 4 * qt);
            const float ci = (!and_mask && wlo == 0u) ? -1e9f : 0.f;
            f32x16 p0 = {ci, ci, ci, ci, ci, ci, ci, ci, ci, ci, ci, ci, ci, ci, ci, ci}, p1 = p0;
            at_qk(p0, p1, kb, qf, r32, hi);
            MFMA_FENCE2(p0, p1);
            const bool near = (t * 64 + 191 > q0w);
            float mx; float sc = AT_C2;
            if (near) {
#pragma unroll
                for (int r = 0; r < 16; ++r) { const int d0 = q - (t * 64 + crow_(r, hi)), d1 = d0 - 32;
                    const float b0 = ((unsigned)d0 < 128u) ? bt[d0] : 0.f, b1 = ((unsigned)d1 < 128u) ? bt[d1] : 0.f;
                    p0[r] = p0[r] * AT_C2 + b0; p1[r] = p1[r] * AT_C2 + b1; }
                sc = 1.0f;
            }
            { float ma = max3_(p0[0], p1[0], p0[1]), mb = max3_(p1[1], p0[2], p1[2]), mc = max3_(p0[3], p1[3], p0[4]), md = max3_(p1[4], p0[5], p1[5]);
              ma = max3_(ma, p0[6], p1[6]); mb = max3_(mb, p0[7], p1[7]); mc = max3_(mc, p0[8], p1[8]); md = max3_(md, p0[9], p1[9]);
              ma = max3_(ma, p0[10], p1[10]); mb = max3_(mb, p0[11], p1[11]); mc = max3_(mc, p0[12], p1[12]); md = max3_(md, p0[13], p1[13]);
              ma = max3_(ma, p0[14], p1[14]); mb = max3_(mb, p0[15], p1[15]); mx = max3_(ma, mb, mc); mx = max3_(mx, md, md); }
            mx = max3_(mx, __shfl_xor(mx, 32), mx) * sc;
            if (__any(mx > m + AT_THR)) {
                const float mn = fmaxf(m, mx); const float al = __builtin_amdgcn_exp2f(m - mn);
                MFMA_FENCE2(o0, o1);
#pragma unroll
                for (int r = 0; r < 16; ++r) { o0[r] *= al; o1[r] *= al; }
                lsum *= al; m = mn;
            }
            float ls = 0.f;
            if (and_mask) {
                const unsigned wl = wlo >> (4 * hi), wh = whi >> (4 * hi);
                float lq[4] = {0.f, 0.f, 0.f, 0.f};
#pragma unroll
                for (int r = 0; r < 16; ++r) { const int cb = (r & 3) + 8 * (r >> 2);
                    const float e0 = __uint_as_float(and_sel(__builtin_amdgcn_exp2f(__builtin_fmaf(p0[r], sc, -m)), wl, cb)), e1 = __uint_as_float(and_sel(__builtin_amdgcn_exp2f(__builtin_fmaf(p1[r], sc, -m)), wh, cb));
                    p0[r] = e0; p1[r] = e1; lq[r & 1] += e0; lq[2 + (r & 1)] += e1; }
                ls = (lq[0] + lq[1]) + (lq[2] + lq[3]);
            } else {
#pragma unroll
                for (int r = 0; r < 16; ++r) { const float e0 = __builtin_amdgcn_exp2f(__builtin_fmaf(p0[r], sc, -m)), e1 = __builtin_amdgcn_exp2f(__builtin_fmaf(p1[r], sc, -m));
                    p0[r] = e0; p1[r] = e1; ls += e0 + e1; }
            }
            lsum += ls;
            bf16x8_t pb[4];
#pragma unroll
            for (int sg = 0; sg < 4; ++sg) { union { bf16x8_t v; unsigned u[4]; } pk;
#pragma unroll
                for (int j = 0; j < 4; ++j) { const int r = 8 * (sg & 1) + 2 * j; pk.u[j] = (sg < 2) ? pg8::cvt_pk_bf16(p0[r], p0[r + 1]) : pg8::cvt_pk_bf16(p1[r], p1[r + 1]); }
                pb[sg] = pk.v; }
            at_pv(o0, o1, vb, pb, r32, hi);
        }
        if (t + 1 < NT) at_store(L + AT_K0 + (cur ^ 1) * AT_KBUF, L + AT_V0 + (cur ^ 1) * AT_VBUF, tid, krS, vrS);
        wl_c = wlS; wh_c = whS;
        __syncthreads();
    };
#pragma unroll 1
    for (int t = 0; t < NT; t += 2) {
        step(t, krA, vrA, wlA, whA, krB, vrB, wlB, whB);
        step(t + 1, krB, vrB, wlB, whB, krA, vrA, wlA, whA);
    }
    MFMA_FENCE2(o0, o1);
    lsum += __shfl_xor(lsum, 32);
    const float inv = 1.0f / lsum;
    LAS bf16* ost = (LAS bf16*)(L + AT_OST + wave * 4096);
#pragma unroll
    for (int r = 0; r < 16; ++r) { ost[r32 * 64 + crow_(r, hi)] = (bf16)f2bf(o0[r] * inv); ost[r32 * 64 + 32 + crow_(r, hi)] = (bf16)f2bf(o1[r] * inv); }
    LDS_WAIT(); asm volatile("" ::: "memory");
    GAS bf16* Og = (GAS bf16*)WSB(MODE == 0 ? WS_QA : WS_QB) + (rowb + q0w) * 512 + h * 64;
#pragma unroll
    for (int i = 0; i < 4; ++i) { const int c = i * 64 + lane, row = c >> 3, ch = c & 7; const v4u ov = *(const LAS v4u*)(ost + row * 64 + ch * 8); if (!DRY) *(GAS v4u*)(Og + (size_t)row * 512 + ch * 8) = ov; else if (ov.x == 0x12345678u && ov.y == 0x9abcdef0u) *(GAS v4u*)(Og + (size_t)row * 512 + ch * 8) = ov; }
}

constexpr int DA_K0 = 0, DA_V0 = 3 * AT_KBUF, DA_BT = DA_V0 + 2 * AT_VBUF, DA_OST = 49152;
static_assert(DA_BT + 512 <= DA_OST && DA_OST + 8 * 4096 <= RING_BYTES, "dsa attention LDS map");
__device__ __forceinline__ v4u at_load_k(const GAS bf16* Kh, int tile, int tid) { return *(const GAS v4u*)(Kh + (size_t)(tile * 64 + (tid >> 3)) * 512 + (tid & 7) * 8); }
__device__ __forceinline__ v4u at_load_v(const GAS bf16* Vh, int tile, int tid) { return *(const GAS v4u*)(Vh + (size_t)(tile * 64 + (tid & 63)) * 512 + (tid >> 6) * 8); }
__device__ __forceinline__ void at_store_k(LAS unsigned char* kb, int tid, const v4u kr) { *(LAS v4u*)(kb + (tid >> 3) * AT_KROW + (tid & 7) * 16) = kr; }
__device__ __forceinline__ void at_store_v(LAS unsigned char* vb, int tid, const v4u vr) {
    LAS bf16* vt = (LAS bf16*)(vb + ((tid >> 6) * 8) * AT_VROW) + (tid & 63); constexpr int RS = AT_VROW / 2;
    vt[0 * RS] = (bf16)(vr.x & 0xffffu); vt[1 * RS] = (bf16)(vr.x >> 16); vt[2 * RS] = (bf16)(vr.y & 0xffffu); vt[3 * RS] = (bf16)(vr.y >> 16);
    vt[4 * RS] = (bf16)(vr.z & 0xffffu); vt[5 * RS] = (bf16)(vr.z >> 16); vt[6 * RS] = (bf16)(vr.w & 0xffffu); vt[7 * RS] = (bf16)(vr.w >> 16);
}
struct DsaState { float m, lsum; f32x16 o0, o1; unsigned wc_lo, wc_hi, wn_lo, wn_hi; };
__device__ __forceinline__ void dsa_step(DsaState& S, f32x16& P0, f32x16& P1, f32x16& Pn0, f32x16& Pn1, int t, int NT, LAS unsigned char* L, const LAS float* bt, const bf16x8_t (&qf)[4],
                                         const GAS bf16* Kh, const GAS bf16* Vh, const GAS unsigned* mrow, int tid, int r32, int hi, int q, int q0w) {
    v4u krn, vrn; unsigned wq_lo = 0u, wq_hi = 0u;
    const bool has1 = (t + 1 < NT), has2 = (t + 2 < NT);
    if (has2) { krn = at_load_k(Kh, t + 2, tid); wq_lo = mrow[2 * (t + 2)]; wq_hi = mrow[2 * (t + 2) + 1]; }
    if (has1) vrn = at_load_v(Vh, t + 1, tid);
    if (has1 && __any((S.wn_lo | S.wn_hi) != 0u)) {
        Pn0 = (f32x16){0.f, 0.f, 0.f, 0.f, 0.f, 0.f, 0.f, 0.f, 0.f, 0.f, 0.f, 0.f, 0.f, 0.f, 0.f, 0.f}; Pn1 = Pn0;
        at_qk(Pn0, Pn1, L + DA_K0 + ((t + 1) % 3) * AT_KBUF, qf, r32, hi);
    }
    if (__any((S.wc_lo | S.wc_hi) != 0u)) {
        const LAS unsigned char* vb = L + DA_V0 + (t & 1) * AT_VBUF;
        MFMA_FENCE2(P0, P1);
        const bool near = (t * 64 + 191 > q0w);
        float sc = AT_C2;
        if (near) {
#pragma unroll
            for (int r = 0; r < 16; ++r) { const int d0 = q - (t * 64 + crow_(r, hi)), d1 = d0 - 32;
                const float b0 = ((unsigned)d0 < 128u) ? bt[d0] : 0.f, b1 = ((unsigned)d1 < 128u) ? bt[d1] : 0.f;
                P0[r] = P0[r] * AT_C2 + b0; P1[r] = P1[r] * AT_C2 + b1; }
            sc = 1.0f;
        }
        float mx = max3_(P0[0], P1[0], P0[1]), mx2 = max3_(P1[1], P0[2], P1[2]);
#pragma unroll
        for (int r = 3; r < 15; r += 2) { mx = max3_(mx, P0[r], P1[r]); mx2 = max3_(mx2, P0[r + 1], P1[r + 1]); }
        mx = max3_(mx, P0[15], P1[15]); mx = max3_(mx, mx2, mx2);
        mx = max3_(mx, __shfl_xor(mx, 32), mx) * sc;
        if (__any(mx > S.m + AT_THR)) {
            const float mn = fmaxf(S.m, mx); const float al = __builtin_amdgcn_exp2f(S.m - mn);
            MFMA_FENCE2(S.o0, S.o1);
#pragma unroll
            for (int r = 0; r < 16; ++r) { S.o0[r] *= al; S.o1[r] *= al; }
            S.lsum *= al; S.m = mn;
        }
        const unsigned wl = S.wc_lo >> (4 * hi), wh = S.wc_hi >> (4 * hi); const float m = S.m;
        float ls = 0.f;
#pragma unroll
        for (int r = 0; r < 16; ++r) { const int cb = (r & 3) + 8 * (r >> 2);
            const float e0 = __uint_as_float(and_sel(__builtin_amdgcn_exp2f(__builtin_fmaf(P0[r], sc, -m)), wl, cb)), e1 = __uint_as_float(and_sel(__builtin_amdgcn_exp2f(__builtin_fmaf(P1[r], sc, -m)), wh, cb));
            P0[r] = e0; P1[r] = e1; ls += e0 + e1; }
        S.lsum += ls;
        bf16x8_t pb[4];
#pragma unroll
        for (int sg = 0; sg < 4; ++sg) { union { bf16x8_t v; unsigned u[4]; } pk;
#pragma unroll
            for (int j = 0; j < 4; ++j) { const int r = 8 * (sg & 1) + 2 * j; pk.u[j] = (sg < 2) ? pg8::cvt_pk_bf16(P0[r], P0[r + 1]) : pg8::cvt_pk_bf16(P1[r], P1[r + 1]); }
            pb[sg] = pk.v; }
        at_pv(S.o0, S.o1, vb, pb, r32, hi);
    }
    if (has2) at_store_k(L + DA_K0 + ((t + 2) % 3) * AT_KBUF, tid, krn);
    if (has1) at_store_v(L + DA_V0 + ((t + 1) & 1) * AT_VBUF, tid, vrn);
    S.wc_lo = S.wn_lo; S.wc_hi = S.wn_hi; S.wn_lo = wq_lo; S.wn_hi = wq_hi;
    __syncthreads();
}
template <bool DRY = false> __device__ __forceinline__ void dsa_attn_unit(Frame& F, int b, int h, int qt) {
    int tid_ = F.tid; asm volatile("" : "+v"(tid_));
    const int tid = tid_, lane = tid & 63, wave = F.wave, r32 = lane & 31, hi = lane >> 5;
    LAS unsigned char* L = F.lds + RING_OFF;
    LAS float* bt = (LAS float*)(L + DA_BT);
    const size_t rowb = (size_t)b * SEQ;
    const GAS bf16* Kh = (const GAS bf16*)WSB(WS_KB) + rowb * 512 + h * 64; const GAS bf16* Vh = (const GAS bf16*)WSB(WS_VB) + rowb * 512 + h * 64;
    const int q0w = qt * 256 + wave * 32, q = q0w + r32;
    const int NT = 4 * qt + 4;
    __syncthreads();
    if (tid < 128) { const GAS float* rb = (const GAS float*)INP(I_RELB) + (8 + h); bt[tid] = (rb[t5_bucket(tid) * 16] - rb[31 * 16]) * LOG2E; }
    bf16x8_t qf[4];
    { const GAS bf16* qp = (const GAS bf16*)WSB(WS_QB) + (rowb + q) * 512 + h * 64 + hi * 8;
#pragma unroll
      for (int s = 0; s < 4; ++s) qf[s] = *(const GAS bf16x8_t*)(qp + s * 16); }
    const GAS unsigned* mrow = (const GAS unsigned*)(F.ws + WS_MASK) + (rowb + q) * 512;
    DsaState S; S.m = -1e30f; S.lsum = 0.f; S.o0 = (f32x16){0.f, 0.f, 0.f, 0.f, 0.f, 0.f, 0.f, 0.f, 0.f, 0.f, 0.f, 0.f, 0.f, 0.f, 0.f, 0.f}; S.o1 = S.o0;
    S.wc_lo = mrow[0]; S.wc_hi = mrow[1]; S.wn_lo = mrow[2]; S.wn_hi = mrow[3];
    { const v4u k0 = at_load_k(Kh, 0, tid), v0 = at_load_v(Vh, 0, tid), k1 = at_load_k(Kh, 1, tid);
      at_store_k(L + DA_K0, tid, k0); at_store_v(L + DA_V0, tid, v0); at_store_k(L + DA_K0 + AT_KBUF, tid, k1); }
    __syncthreads();
    f32x16 pA0 = {0.f, 0.f, 0.f, 0.f, 0.f, 0.f, 0.f, 0.f, 0.f, 0.f, 0.f, 0.f, 0.f, 0.f, 0.f, 0.f}, pA1 = pA0, pB0 = pA0, pB1 = pA0;
    if (__any((S.wc_lo | S.wc_hi) != 0u)) at_qk(pA0, pA1, L + DA_K0, qf, r32, hi);
#pragma unroll 1
    for (int t = 0; t < NT; t += 2) {
        dsa_step(S, pA0, pA1, pB0, pB1, t, NT, L, bt, qf, Kh, Vh, mrow, tid, r32, hi, q, q0w);
        dsa_step(S, pB0, pB1, pA0, pA1, t + 1, NT, L, bt, qf, Kh, Vh, mrow, tid, r32, hi, q, q0w);
    }
    MFMA_FENCE2(S.o0, S.o1);
    float lsum = S.lsum; lsum += __shfl_xor(lsum, 32);
    const float inv = 1.0f / lsum;
    LAS bf16* ost = (LAS bf16*)(L + DA_OST + wave * 4096);
#pragma unroll
    for (int r = 0; r < 16; ++r) { ost[r32 * 64 + crow_(r, hi)] = (bf16)f2bf(S.o0[r] * inv); ost[r32 * 64 + 32 + crow_(r, hi)] = (bf16)f2bf(S.o1[r] * inv); }
    LDS_WAIT(); asm volatile("" ::: "memory");
    GAS bf16* Og = (GAS bf16*)WSB(WS_QB) + (rowb + q0w) * 512 + h * 64;
#pragma unroll
    for (int i = 0; i < 4; ++i) { const int c = i * 64 + lane, row = c >> 3, ch = c & 7; const v4u ov = *(const LAS v4u*)(ost + row * 64 + ch * 8); if (!DRY) *(GAS v4u*)(Og + (size_t)row * 512 + ch * 8) = ov; else if (ov.x == 0x12345678u && ov.y == 0x9abcdef0u) *(GAS v4u*)(Og + (size_t)row * 512 + ch * 8) = ov; }
}

constexpr int D2_K = 0, D2_V = 4 * AT_KBUF, D2_BT = D2_V + 4 * AT_VBUF, D2_OST = 73728;
static_assert(D2_BT + 512 <= D2_OST && D2_OST + 8 * 4096 <= RING_BYTES, "dsa2 LDS map");
struct KV2 { v4u k0, v0, k1, v1; };
template <bool DRY = false> __device__ __forceinline__ void dsa_attn2_unit(Frame& F, int b, int h, int qt) {
    int tid_ = F.tid; asm volatile("" : "+v"(tid_));
    const int tid = tid_, lane = tid & 63, wave = F.wave, r32 = lane & 31, hi = lane >> 5;
    LAS unsigned char* L = F.lds + RING_OFF;
    LAS float* bt = (LAS float*)(L + D2_BT);
    const size_t rowb = (size_t)b * SEQ;
    const GAS bf16* Kh = (const GAS bf16*)WSB(WS_KB) + rowb * 512 + h * 64; const GAS bf16* Vh = (const GAS bf16*)WSB(WS_VB) + rowb * 512 + h * 64;
    const int q0w = qt * 256 + wave * 32, q = q0w + r32;
    const int NS = 2 * qt + 2;
    __syncthreads();
    if (tid < 128) { const GAS float* rb = (const GAS float*)INP(I_RELB) + (8 + h); bt[tid] = (rb[t5_bucket(tid) * 16] - rb[31 * 16]) * LOG2E; }
    bf16x8_t qf[4];
    { const GAS bf16* qp = (const GAS bf16*)WSB(WS_QB) + (rowb + q) * 512 + h * 64 + hi * 8;
#pragma unroll
      for (int s = 0; s < 4; ++s) qf[s] = *(const GAS bf16x8_t*)(qp + s * 16); }
#pragma unroll
    for (int s = 0; s < 4; ++s) { union { bf16x8_t v; unsigned u[4]; } x; x.v = qf[s];
#pragma unroll
        for (int jj = 0; jj < 4; ++jj) x.u[jj] = pg8::cvt_pk_bf16(pg8::bf_lo(x.u[jj]) * AT_C2, pg8::bf_hi(x.u[jj]) * AT_C2);
        qf[s] = x.v; }
    bf16x8_t oneA, mB;
    { union { bf16x8_t v; unsigned u[4]; } x; x.u[0] = hi == 0 ? 0x3f80u : 0u; x.u[1] = x.u[2] = x.u[3] = 0u; oneA = x.v; x.u[0] = 0u; mB = x.v; }
    bool fresh = true;
    const GAS unsigned* mrow = (const GAS unsigned*)(F.ws + WS_MASK) + (rowb + q) * 512;
    auto load2 = [&](int s, KV2& R) __attribute__((always_inline)) {
        at_load(Kh, Vh, 2 * s, tid, R.k0, R.v0); at_load(Kh, Vh, 2 * s + 1, tid, R.k1, R.v1); };
    auto store2 = [&](int set, const KV2& R) __attribute__((always_inline)) {
        at_store(L + D2_K + (2 * set) * AT_KBUF, L + D2_V + (2 * set) * AT_VBUF, tid, R.k0, R.v0); at_store(L + D2_K + (2 * set + 1) * AT_KBUF, L + D2_V + (2 * set + 1) * AT_VBUF, tid, R.k1, R.v1); };
    KV2 RA;
    load2(0, RA); store2(0, RA);
    unsigned wc[4] = { mrow[0], mrow[1], mrow[2], mrow[3] };
    __syncthreads();
    float m = 0.f, lsum = 0.f;
    f32x16 o0 = {0.f, 0.f, 0.f, 0.f, 0.f, 0.f, 0.f, 0.f, 0.f, 0.f, 0.f, 0.f, 0.f, 0.f, 0.f, 0.f}, o1 = o0;
    auto step = [&](int s, KV2& RS) __attribute__((always_inline)) {
        const int set = s & 1;
        if (s + 1 < NS) load2(s + 1, RS);
        unsigned wn[4] = {0u, 0u, 0u, 0u};
        if (s + 1 < NS) { const GAS unsigned* mp = mrow + 4 * (s + 1); wn[0] = mp[0]; wn[1] = mp[1]; wn[2] = mp[2]; wn[3] = mp[3]; }
        if (__any((wc[0] | wc[1] | wc[2] | wc[3]) != 0u)) {
            const LAS unsigned char* kb = L + D2_K + (2 * set) * AT_KBUF; const LAS unsigned char* vb = L + D2_V + (2 * set) * AT_VBUF;
            f32x16 p0 = {0.f, 0.f, 0.f, 0.f, 0.f, 0.f, 0.f, 0.f, 0.f, 0.f, 0.f, 0.f, 0.f, 0.f, 0.f, 0.f}, p1 = p0, p2 = p0, p3 = p0;
            at_qk_m(p0, p1, kb, qf, oneA, mB, r32, hi); at_qk_m(p2, p3, kb + AT_KBUF, qf, oneA, mB, r32, hi);
            asm volatile("s_nop 15\n\ts_nop 15" : "+v"(p0), "+v"(p1), "+v"(p2), "+v"(p3));
            const int t0 = 2 * s;
            const bool near = ((t0 + 1) * 64 + 191 > q0w);
            if (near) {
#pragma unroll
                for (int r = 0; r < 16; ++r) { const int d0 = q - (t0 * 64 + crow_(r, hi)), d1 = d0 - 32, d2 = d0 - 64, d3 = d0 - 96;
                    const float b0 = ((unsigned)d0 < 128u) ? bt[d0] : 0.f, b1 = ((unsigned)d1 < 128u) ? bt[d1] : 0.f, b2 = ((unsigned)d2 < 128u) ? bt[d2] : 0.f, b3 = ((unsigned)d3 < 128u) ? bt[d3] : 0.f;
                    p0[r] += b0; p1[r] += b1; p2[r] += b2; p3[r] += b3; }
            }
            float mx;
            { float ma = max3_(p0[0], p1[0], p2[0]), mb = max3_(p3[0], p0[1], p1[1]), mc = max3_(p2[1], p3[1], p0[2]), md = max3_(p1[2], p2[2], p3[2]);
#pragma unroll
              for (int r = 3; r < 15; r += 2) { ma = max3_(ma, p0[r], p1[r]); mb = max3_(mb, p2[r], p3[r]); mc = max3_(mc, p0[r + 1], p1[r + 1]); md = max3_(md, p2[r + 1], p3[r + 1]); }
              ma = max3_(ma, p0[15], p1[15]); mb = max3_(mb, p2[15], p3[15]); mx = max3_(ma, mb, mc); mx = max3_(mx, md, md); }
            mx = max3_(mx, __shfl_xor(mx, 32), mx);
            if (fresh || __any(mx > AT_THR)) {
                const float d = fresh ? mx : fmaxf(mx, 0.f);
                const float mn = __uint_as_float(pg8::cvt_pk_bf16(0.f, m + d) & 0xffff0000u);
                const float dl = mn - m; const float al = __builtin_amdgcn_exp2f(-dl);
                MFMA_FENCE2(o0, o1);
#pragma unroll
                for (int r = 0; r < 16; ++r) { o0[r] *= al; o1[r] *= al; p0[r] -= dl; p1[r] -= dl; p2[r] -= dl; p3[r] -= dl; }
                lsum *= al; m = mn; fresh = false;
                { union { bf16x8_t v; unsigned u[4]; } x; x.u[0] = hi == 0 ? ((__float_as_uint(m) >> 16) ^ 0x8000u) : 0u; x.u[1] = x.u[2] = x.u[3] = 0u; mB = x.v; }
            }
            const unsigned w0 = wc[0] >> (4 * hi), w1 = wc[1] >> (4 * hi), w2 = wc[2] >> (4 * hi), w3 = wc[3] >> (4 * hi);
            float lq[4] = {0.f, 0.f, 0.f, 0.f};
#pragma unroll
            for (int r = 0; r < 16; ++r) { const int cb = (r & 3) + 8 * (r >> 2);
                const float e0 = __uint_as_float(and_sel(__builtin_amdgcn_exp2f(p0[r]), w0, cb)), e1 = __uint_as_float(and_sel(__builtin_amdgcn_exp2f(p1[r]), w1, cb));
                const float e2 = __uint_as_float(and_sel(__builtin_amdgcn_exp2f(p2[r]), w2, cb)), e3 = __uint_as_float(and_sel(__builtin_amdgcn_exp2f(p3[r]), w3, cb));
                p0[r] = e0; p1[r] = e1; p2[r] = e2; p3[r] = e3; lq[0] += e0; lq[1] += e1; lq[2] += e2; lq[3] += e3; }
            lsum += (lq[0] + lq[1]) + (lq[2] + lq[3]);
            bf16x8_t pb[4], pc[4];
#pragma unroll
            for (int sg = 0; sg < 4; ++sg) { union { bf16x8_t v; unsigned u[4]; } pk, pl;
#pragma unroll
                for (int j = 0; j < 4; ++j) { const int r = 8 * (sg & 1) + 2 * j; pk.u[j] = (sg < 2) ? pg8::cvt_pk_bf16(p0[r], p0[r + 1]) : pg8::cvt_pk_bf16(p1[r], p1[r + 1]);
                    pl.u[j] = (sg < 2) ? pg8::cvt_pk_bf16(p2[r], p2[r + 1]) : pg8::cvt_pk_bf16(p3[r], p3[r + 1]); }
                pb[sg] = pk.v; pc[sg] = pl.v; }
            at_pv(o0, o1, vb, pb, r32, hi); at_pv(o0, o1, vb + AT_VBUF, pc, r32, hi);
        }
        if (s + 1 < NS) store2(set ^ 1, RS);
        wc[0] = wn[0]; wc[1] = wn[1]; wc[2] = wn[2]; wc[3] = wn[3];
        __syncthreads();
    };
#pragma unroll 1
    for (int s = 0; s < NS; ++s) step(s, RA);
    MFMA_FENCE2(o0, o1);
    lsum += __shfl_xor(lsum, 32);
    const float inv = 1.0f / lsum;
    LAS bf16* ost = (LAS bf16*)(L + D2_OST + wave * 4096);
#pragma unroll
    for (int r = 0; r < 16; ++r) { ost[r32 * 64 + crow_(r, hi)] = (bf16)f2bf(o0[r] * inv); ost[r32 * 64 + 32 + crow_(r, hi)] = (bf16)f2bf(o1[r] * inv); }
    LDS_WAIT(); asm volatile("" ::: "memory");
    GAS bf16* Og = (GAS bf16*)WSB(WS_QB) + (rowb + q0w) * 512 + h * 64;
#pragma unroll
    for (int i = 0; i < 4; ++i) { const int c = i * 64 + lane, row = c >> 3, ch = c & 7; const v4u ov = *(const LAS v4u*)(ost + row * 64 + ch * 8); if (!DRY) *(GAS v4u*)(Og + (size_t)row * 512 + ch * 8) = ov; else if (ov.x == 0x12345678u && ov.y == 0x9abcdef0u) *(GAS v4u*)(Og + (size_t)row * 512 + ch * 8) = ov; }
}
constexpr int IX_CAP = 768;
constexpr int IX_HIST = 0, IX_CAND = 0, IX_BM = 98304;
constexpr int IX_W = LDSCTL_OFF + 1024;
constexpr int IX_ST = LDSCTL_OFF + 1536;
constexpr int IX_SUB = LDSCTL_OFF + 2048, IX_L2 = IX_SUB + 8 * 1024, IX_C2 = IX_L2 + 8 * 512;
static_assert(IX_C2 + 64 <= LDS_BYTES, "idx sub-histogram LDS");
static_assert(IX_BM + 16 * 512 * 4 <= RING_BYTES && 16 * IX_CAP * 8 <= IX_BM && IX_ST + 6 * 64 <= LDS_BYTES, "idx LDS map");
#define MFMA_FENCE1(a) asm volatile("s_nop 15\n\ts_nop 15" : "+v"(a))
__device__ __forceinline__ float relu_(float x, float) { float r; asm("v_max_f32 %0, 0, %1" : "=v"(r) : "v"(x)); return r; }
__device__ __forceinline__ unsigned mono_key(float s) { const unsigned u = __float_as_uint(s + 0.0f); return u ^ ((unsigned)((int)u >> 31) | 0x80000000u); }

template <int MODE, bool LEVEL0, bool LAST, int HALF> __device__ __forceinline__ void idx_vec(const f32x16 (&accs)[2], const f32x4 (&wv)[4][4], LAS unsigned* hist, LAS unsigned long long* cand, LAS unsigned* bm, LAS unsigned* st,
                                                                                    const unsigned (&psh)[8], const unsigned (&ppre)[8], const bool (&pact)[8], int key, int t0, int hi, int lane, int w32, int shn, unsigned fmask, bool allsel) {
#pragma unroll
    for (int rb = 2 * HALF; rb < 2 * HALF + 2; ++rb) {
        const f32x16 acc = accs[rb - 2 * HALF];
        const int qla = 4 * rb + 2 * hi;
        const f32x4 w0 = wv[rb][0], w1 = wv[rb][1], w2 = wv[rb][2], w3 = wv[rb][3];
        float sa = w0.x * relu_(acc[0], 0.f), sa2 = w0.y * relu_(acc[1], 0.f); sa += w0.z * relu_(acc[2], 0.f); sa2 += w0.w * relu_(acc[3], 0.f);
        sa += w1.x * relu_(acc[4], 0.f); sa2 += w1.y * relu_(acc[5], 0.f); sa += w1.z * relu_(acc[6], 0.f); sa2 += w1.w * relu_(acc[7], 0.f);
        float sb = w2.x * relu_(acc[8], 0.f), sb2 = w2.y * relu_(acc[9], 0.f); sb += w2.z * relu_(acc[10], 0.f); sb2 += w2.w * relu_(acc[11], 0.f);
        sb += w3.x * relu_(acc[12], 0.f); sb2 += w3.y * relu_(acc[13], 0.f); sb += w3.z * relu_(acc[14], 0.f); sb2 += w3.w * relu_(acc[15], 0.f);
        sa += sa2; sb += sb2;
        const unsigned ua = mono_key(sa), ub = mono_key(sb);
        const bool va = !LAST || key <= t0 + qla, vb = !LAST || key <= t0 + qla + 1;
        if (MODE == 0) {
            const bool ma = va && (LEVEL0 || (pact[2 * rb] && (ua >> psh[2 * rb]) == ppre[2 * rb]));
            const bool mb = vb && (LEVEL0 || (pact[2 * rb + 1] && (ub >> psh[2 * rb + 1]) == ppre[2 * rb + 1]));
            const unsigned ba = LEVEL0 ? (ua >> 21) : ((ua >> shn) & fmask), bb = LEVEL0 ? (ub >> 21) : ((ub >> shn) & fmask);
            if (ma) __hip_atomic_fetch_add(hist + qla * 2048 + ba, 1u, __ATOMIC_RELAXED, __HIP_MEMORY_SCOPE_WORKGROUP);
            if (mb) __hip_atomic_fetch_add(hist + (qla + 1) * 2048 + bb, 1u, __ATOMIC_RELAXED, __HIP_MEMORY_SCOPE_WORKGROUP);
        } else {
            const unsigned pa = ua >> psh[2 * rb], pb = ub >> psh[2 * rb + 1];
            const bool sela = va && (allsel || pa > ppre[2 * rb]), selb = vb && (allsel || pb > ppre[2 * rb + 1]);
            const bool ca = va && !allsel && pa == ppre[2 * rb], cb = vb && !allsel && pb == ppre[2 * rb + 1];
            const unsigned long long bala = __ballot(sela), balb = __ballot(selb);
            if (lane == 0) { bm[(4 * rb + 0) * 512 + w32] = (unsigned)bala; bm[(4 * rb + 2) * 512 + w32] = (unsigned)(bala >> 32);
                             bm[(4 * rb + 1) * 512 + w32] = (unsigned)balb; bm[(4 * rb + 3) * 512 + w32] = (unsigned)(balb >> 32); }
            if (ca) { const unsigned slot = __hip_atomic_fetch_add(st + qla, 1u, __ATOMIC_RELAXED, __HIP_MEMORY_SCOPE_WORKGROUP);
                if (slot < (unsigned)IX_CAP) cand[qla * IX_CAP + slot] = ((unsigned long long)ua << 32) | (unsigned)(0xffff - key); }
            if (cb) { const unsigned slot = __hip_atomic_fetch_add(st + qla + 1, 1u, __ATOMIC_RELAXED, __HIP_MEMORY_SCOPE_WORKGROUP);
                if (slot < (unsigned)IX_CAP) cand[(qla + 1) * IX_CAP + slot] = ((unsigned long long)ub << 32) | (unsigned)(0xffff - key); }
        }
    }
}
template <int MODE, bool LEVEL0> __device__ __forceinline__ void idx_pass(Frame& F, const bf16x8_t (&qa)[4][4], const GAS bf16* kib, int t0, int nst, int wave, int lane,
                                                             int shn, unsigned fmask, bool allsel) {
    const int n = lane & 31, hi = lane >> 5;
    LAS unsigned char* L = F.lds + RING_OFF;
    LAS unsigned* hist = (LAS unsigned*)(L + IX_HIST); LAS unsigned long long* cand = (LAS unsigned long long*)(L + IX_CAND); LAS unsigned* bm = (LAS unsigned*)(L + IX_BM);
    const LAS float* wl = (const LAS float*)(F.lds + IX_W); LAS unsigned* st = (LAS unsigned*)(F.lds + IX_ST);
    unsigned psh[8], ppre[8]; bool pact[8];
#pragma unroll
    for (int i = 0; i < 8; ++i) { const int ql = 4 * (i >> 1) + 2 * hi + (i & 1); psh[i] = st[16 + ql]; ppre[i] = st[32 + ql]; pact[i] = (st[80 + ql] != 0u); }
    f32x4 wv[4][4];
#pragma unroll
    for (int rb = 0; rb < 4; ++rb)
#pragma unroll
        for (int j = 0; j < 4; ++j) wv[rb][j] = *(const LAS f32x4*)(wl + (4 * rb + 2 * hi) * 8 + 4 * j);
    bf16x8_t kf[4];
    const GAS bf16* kp = kib + (size_t)(wave * 32 + n) * 64 + hi * 8;
#pragma unroll
    for (int s = 0; s < 4; ++s) kf[s] = *(const GAS bf16x8_t*)(kp + s * 16);
#pragma unroll 1
    for (int stile = 0; stile < nst; ++stile) {
        const int key = stile * 256 + wave * 32 + n;
        const int w32 = stile * 8 + wave;
        const bool lastt = (stile + 1 == nst);
        f32x16 accs[2];
#pragma unroll
        for (int rb = 0; rb < 2; ++rb) { accs[rb] = (f32x16){0.f, 0.f, 0.f, 0.f, 0.f, 0.f, 0.f, 0.f, 0.f, 0.f, 0.f, 0.f, 0.f, 0.f, 0.f, 0.f};
#pragma unroll
            for (int s = 0; s < 4; ++s) accs[rb] = __builtin_amdgcn_mfma_f32_32x32x16_bf16(qa[rb][s], kf[s], accs[rb], 0, 0, 0); }
        asm volatile("s_nop 15\n\ts_nop 15" : "+v"(accs[0]), "+v"(accs[1]));
        if (!lastt) idx_vec<MODE, LEVEL0, false, 0>(accs, wv, hist, cand, bm, st, psh, ppre, pact, key, t0, hi, lane, w32, shn, fmask, allsel);
        else idx_vec<MODE, LEVEL0, true, 0>(accs, wv, hist, cand, bm, st, psh, ppre, pact, key, t0, hi, lane, w32, shn, fmask, allsel);
#pragma unroll
        for (int rb = 0; rb < 2; ++rb) { accs[rb] = (f32x16){0.f, 0.f, 0.f, 0.f, 0.f, 0.f, 0.f, 0.f, 0.f, 0.f, 0.f, 0.f, 0.f, 0.f, 0.f, 0.f};
#pragma unroll
            for (int s = 0; s < 4; ++s) accs[rb] = __builtin_amdgcn_mfma_f32_32x32x16_bf16(qa[2 + rb][s], kf[s], accs[rb], 0, 0, 0); }
        asm volatile("s_nop 15\n\ts_nop 15" : "+v"(accs[0]), "+v"(accs[1]), "+v"(kf[0]), "+v"(kf[1]), "+v"(kf[2]), "+v"(kf[3]));
        if (!lastt) { kp += (size_t)256 * 64;
#pragma unroll
            for (int s = 0; s < 4; ++s) kf[s] = *(const GAS bf16x8_t*)(kp + s * 16); }
        if (!lastt) idx_vec<MODE, LEVEL0, false, 1>(accs, wv, hist, cand, bm, st, psh, ppre, pact, key, t0, hi, lane, w32, shn, fmask, allsel);
        else idx_vec<MODE, LEVEL0, true, 1>(accs, wv, hist, cand, bm, st, psh, ppre, pact, key, t0, hi, lane, w32, shn, fmask, allsel);
    }
}

__device__ __forceinline__ void idx_unit(Frame& F, int b, int t0) {
    int tid_ = F.tid; asm volatile("" : "+v"(tid_));
    const int tid = tid_, lane = tid & 63, wave = F.wave, r32 = lane & 31, hh = lane >> 5;
    LAS unsigned char* L = F.lds + RING_OFF;
    LAS unsigned* hist = (LAS unsigned*)(L + IX_HIST); LAS unsigned long long* cand = (LAS unsigned long long*)(L + IX_CAND); LAS unsigned* bm = (LAS unsigned*)(L + IX_BM);
    LAS float* wl = (LAS float*)(F.lds + IX_W); LAS unsigned* st = (LAS unsigned*)(F.lds + IX_ST);
    const size_t rowb = (size_t)b * SEQ; const int nst = (t0 >> 8) + 1; const bool allsel = (t0 < 256);
    const GAS bf16* kib = (const GAS bf16*)WSB(WS_KI) + rowb * 64;
    __syncthreads();
    if (tid < 128) wl[tid] = ((const GAS float*)WSF(WS_WI) + (rowb + t0) * 8)[tid];
    if (tid < 16) { st[tid] = 0u; st[16 + tid] = 21u; st[32 + tid] = 0u; st[48 + tid] = 256u; st[64 + tid] = 0u; st[80 + tid] = 1u; }
    bf16x8_t qa[4][4];
    { const int qloc = 2 * ((r32 >> 2) & 1) + (r32 >> 4), head = (r32 & 3) + 4 * ((r32 >> 3) & 1);
      const GAS bf16* qp = (const GAS bf16*)WSB(WS_QI) + (rowb + t0 + qloc) * 512 + head * 64 + hh * 8;
#pragma unroll
      for (int rb = 0; rb < 4; ++rb)
#pragma unroll
        for (int s = 0; s < 4; ++s) qa[rb][s] = *(const GAS bf16x8_t*)(qp + (size_t)rb * 4 * 512 + s * 16); }
    __syncthreads();
    if (!allsel) {
#pragma unroll 1
        for (int level = 0; level < 3; ++level) {
            const int shn = level == 0 ? 21 : (level == 1 ? 10 : 0); const unsigned fmask = level == 2 ? 0x3ffu : 0x7ffu; const int nd = level == 2 ? 1024 : 2048;
            for (int i = tid; i < 16 * 2048 / 4; i += NWAVES * 64) ((LAS v4u*)hist)[i] = (v4u){0u, 0u, 0u, 0u};
            __syncthreads();
            { if (level == 0) idx_pass<0, true>(F, qa, kib, t0, nst, wave, lane, shn, fmask, false); else idx_pass<0, false>(F, qa, kib, t0, nst, wave, lane, shn, fmask, false); }
            __syncthreads();
            if (PROBE_SEL & 8) { for (int i = tid; i < 16 * 2048; i += NWAVES * 64) hist[i] = 0u; __syncthreads(); { if (level == 0) idx_pass<0, true>(F, qa, kib, t0, nst, wave, lane, shn, fmask, false); else idx_pass<0, false>(F, qa, kib, t0, nst, wave, lane, shn, fmask, false); } __syncthreads(); }
#pragma unroll 1
            for (int qq = 0; qq < 2; ++qq) { const int ql = 2 * wave + qq;
                if (st[80 + ql] == 0u) continue;
                const unsigned kneed = st[48 + ql]; const int D = nd >> 6; const LAS unsigned* hq = hist + ql * 2048 + lane * D;
                unsigned tot = 0u;
                for (int dd = 0; dd < D; ++dd) tot += hq[dd];
                unsigned S = tot;
#pragma unroll
                for (int o = 1; o < 64; o <<= 1) { const unsigned v = __shfl_down(S, o); if (lane + o < 64) S += v; }
                const unsigned above = S - tot;
                if (above < kneed && kneed <= S) { unsigned a = above; int bsel = 0; unsigned cb = 0u;
                    for (int dd = D - 1; dd >= 0; --dd) { const unsigned v = hq[dd];
                        if (a + v >= kneed) { bsel = lane * D + dd; cb = v; break; } a += v; }
                    const unsigned opre = st[32 + ql];
                    st[32 + ql] = (level == 0) ? (unsigned)bsel : ((opre << (level == 1 ? 11 : 10)) | (unsigned)bsel);
                    st[16 + ql] = (unsigned)shn; st[48 + ql] = kneed - a; st[64 + ql] = cb;
                    st[80 + ql] = (cb > (unsigned)IX_CAP && level < 2) ? 1u : 0u; }
            }
            __syncthreads();
            unsigned more = 0u;
#pragma unroll
            for (int i = 0; i < 16; ++i) more |= st[80 + i];
            __syncthreads();
            if (more == 0u) break;
        }
    }
    if (PROBE_SEL & 16) { idx_pass<1, false>(F, qa, kib, t0, nst, wave, lane, 0, 0u, allsel); __syncthreads(); if (tid < 16) st[tid] = 0u; __syncthreads(); }
    idx_pass<1, false>(F, qa, kib, t0, nst, wave, lane, 0, 0u, allsel);
    __syncthreads();
    if (!allsel) {
#pragma unroll 1
        for (int qq = 0; qq < 2; ++qq) { const int ql = 2 * wave + qq;
            const int nc = (int)(st[ql] < (unsigned)IX_CAP ? st[ql] : (unsigned)IX_CAP); int need = (int)st[48 + ql]; const int vbits = 16 + (int)st[16 + ql];
            if (need >= nc) {
                for (int k = lane; k < nc; k += 64) { const int key = 0xffff - (int)(cand[ql * IX_CAP + k] & 0xffffull); __hip_atomic_fetch_or(bm + ql * 512 + (key >> 5), 1u << (key & 31), __ATOMIC_RELAXED, __HIP_MEMORY_SCOPE_WORKGROUP); }
                continue; }
            const int shq = (int)st[16 + ql];
            if (shq >= 8) {
                LAS unsigned* sh2 = (LAS unsigned*)(F.lds + IX_SUB + wave * 1024); LAS unsigned long long* l2 = (LAS unsigned long long*)(F.lds + IX_L2 + wave * 512); LAS unsigned* c2p = (LAS unsigned*)(F.lds + IX_C2 + wave * 4);
#pragma unroll
                for (int i = 0; i < 4; ++i) sh2[4 * lane + i] = 0u;
                if (lane == 0) *c2p = 0u;
                LDS_WAIT(); asm volatile("" ::: "memory");
                const int fsh = 32 + shq - 8;
                for (int k = lane; k < nc; k += 64) { const unsigned f = (unsigned)(cand[ql * IX_CAP + k] >> fsh) & 0xffu; __hip_atomic_fetch_add(sh2 + f, 1u, __ATOMIC_RELAXED, __HIP_MEMORY_SCOPE_WORKGROUP); }
                LDS_WAIT(); asm volatile("" ::: "memory");
                const unsigned c0 = sh2[4 * lane], c1 = sh2[4 * lane + 1], c2 = sh2[4 * lane + 2], c3 = sh2[4 * lane + 3]; const unsigned tot = c0 + c1 + c2 + c3;
                unsigned S = tot;
#pragma unroll
                for (int o = 1; o < 64; o <<= 1) { const unsigned v = __shfl_down(S, o); if (lane + o < 64) S += v; }
                const unsigned above = S - tot; const unsigned needu = (unsigned)need;
                const bool found = above < needu && needu <= S;
                unsigned a = above; unsigned bsel = 0u, cbin = 0u;
                if (a + c3 >= needu) { bsel = 3u; cbin = c3; } else { a += c3; if (a + c2 >= needu) { bsel = 2u; cbin = c2; } else { a += c2; if (a + c1 >= needu) { bsel = 1u; cbin = c1; } else { a += c1; bsel = 0u; cbin = c0; } } }
                const int src = __ffsll((long long)__ballot(found)) - 1;
                const unsigned b2 = (unsigned)__shfl((int)(4u * lane + bsel), src), need2 = (unsigned)__shfl((int)(needu - a), src), cnt2 = (unsigned)__shfl((int)cbin, src);
                if (cnt2 <= 64u) {
                    for (int k = lane; k < nc; k += 64) { const unsigned long long ckk = cand[ql * IX_CAP + k]; const unsigned f = (unsigned)(ckk >> fsh) & 0xffu;
                        if (f > b2) { const int key = 0xffff - (int)(ckk & 0xffffull); __hip_atomic_fetch_or(bm + ql * 512 + (key >> 5), 1u << (key & 31), __ATOMIC_RELAXED, __HIP_MEMORY_SCOPE_WORKGROUP); }
                        else if (f == b2) { const unsigned slot = __hip_atomic_fetch_add(c2p, 1u, __ATOMIC_RELAXED, __HIP_MEMORY_SCOPE_WORKGROUP); l2[slot] = ckk; } }
                    LDS_WAIT(); asm volatile("" ::: "memory");
                    if (lane < (int)cnt2) { const unsigned long long mine = l2[lane]; unsigned rank = 0u;
                        for (unsigned j = 0; j < cnt2; ++j) rank += (l2[j] > mine) ? 1u : 0u;
                        if (rank < need2) { const int key = 0xffff - (int)(mine & 0xffffull); __hip_atomic_fetch_or(bm + ql * 512 + (key >> 5), 1u << (key & 31), __ATOMIC_RELAXED, __HIP_MEMORY_SCOPE_WORKGROUP); } }
                    LDS_WAIT(); asm volatile("" ::: "memory");
                    continue;
                }
            }
            unsigned long long ck[12]; unsigned alive = 0u, selm = 0u;
#pragma unroll
            for (int c = 0; c < 12; ++c) { const int k = c * 64 + lane; ck[c] = (k < nc) ? cand[ql * IX_CAP + k] : 0ull; if (k < nc) alive |= 1u << c; }
#pragma unroll 1
            for (int bit = vbits - 1 + 16; bit >= 0; --bit) {
                if (bit >= 16 && bit < 32) continue;
                unsigned ones = 0u; int cnt1 = 0;
#pragma unroll
                for (int c = 0; c < 12; ++c) { if (c * 64 < nc) { const bool o = ((alive >> c) & 1u) && ((ck[c] >> bit) & 1ull); cnt1 += __popcll(__ballot(o)); if (o) ones |= 1u << c; } }
                if (cnt1 >= need) alive &= ones;
                else { selm |= ones; alive &= ~ones; need -= cnt1; }
            }
            selm |= alive;
#pragma unroll
            for (int c = 0; c < 12; ++c) if ((selm >> c) & 1u) { const int key = 0xffff - (int)(ck[c] & 0xffffull); __hip_atomic_fetch_or(bm + ql * 512 + (key >> 5), 1u << (key & 31), __ATOMIC_RELAXED, __HIP_MEMORY_SCOPE_WORKGROUP); }
        }
    }
    __syncthreads();
    { GAS unsigned* mg = (GAS unsigned*)(F.ws + WS_MASK) + (rowb + t0) * 512; const int nw = nst * 8;
      for (int i = tid; i < 16 * nw; i += NWAVES * 64) { const int ql = i / nw, w = i - ql * nw; mg[(size_t)ql * 512 + w] = bm[ql * 512 + w]; } }
}
typedef __bf16 bf2_t __attribute__((ext_vector_type(2)));
constexpr size_t WS_KM2 = 110 * MiB;
constexpr size_t WS_MREF = 111 * MiB;
constexpr size_t WS_LACC = 38 * MiB;
constexpr size_t WS_PO = 464 * MiB;
constexpr size_t WS_PJ0 = WS_QI, WS_PJ1 = WS_XB, WS_PJ2 = WS_XB + 32 * MiB;
__device__ __forceinline__ unsigned char* pj_base(Frame& F, int l, int j) {
    if (j == 0) return F.ws + WS_PJ0;
    return (l == 0 ? (unsigned char*)F.out : F.ws + WS_PJ1) + (size_t)(j - 1) * (32 * MiB);
}
constexpr size_t WS_LJ = WS_KI;
constexpr size_t WS_LISTS = 496 * MiB;
constexpr int CW_LCNT = 16384;
static_assert((CW_LCNT + 2 * 1024) * 4 <= (int)CTL_ZERO_BYTES, "list counters inside the memset region");
__device__ __forceinline__ int list_off(int n) { return 256 * (63 * n - (n * (n - 1)) / 2); }
constexpr int IT_K = 0, IT_V = 4 * AT_KBUF, IT_BT = IT_V + 4 * AT_VBUF, IT_QP = IT_BT + 512, IT_OST = 73728;
static_assert(IT_QP + 8 * 128 <= IT_OST && IT_OST + 8 * 4096 <= RING_BYTES, "item LDS map");

template <bool DRY = false> __device__ __forceinline__ void moba_own_unit(Frame& F, int l, int b, int h, int qt) {
    int tid_ = F.tid; asm volatile("" : "+v"(tid_));
    const int tid = tid_, lane = tid & 63, wave = F.wave, r32 = lane & 31, hi = lane >> 5;
    LAS unsigned char* L = F.lds + RING_OFF;
    LAS float* bt = (LAS float*)(L + AT_BT);
    const GAS bf16* Qg = (const GAS bf16*)WSB(WS_QA);
    const size_t rowb = (size_t)b * SEQ;
    const GAS bf16* Kh = (const GAS bf16*)WSB(WS_KA) + rowb * 512 + h * 64; const GAS bf16* Vh = (const GAS bf16*)WSB(WS_VA) + rowb * 512 + h * 64;
    const int q0w = qt * 256 + wave * 32, q = q0w + r32;
    __syncthreads();
    if (tid < 128) { const GAS float* rb = (const GAS float*)INP(I_RELB) + h; bt[tid] = (rb[t5_bucket(tid) * 16] - rb[31 * 16]) * LOG2E; }
    bf16x8_t qf[4];
    { const GAS bf16* qp = Qg + (rowb + q) * 512 + h * 64 + hi * 8;
#pragma unroll
      for (int s = 0; s < 4; ++s) qf[s] = *(const GAS bf16x8_t*)(qp + s * 16); }
    { const int n = tid >> 3, c8 = (tid & 7) * 8; const GAS float* km = (const GAS float*)WSF(WS_KM2) + (((size_t)b * NBLK + n) * 2) * 512 + h * 64 + c8;
      f32x4 a = *(const GAS f32x4*)km + *(const GAS f32x4*)(km + 512), c = *(const GAS f32x4*)(km + 4) + *(const GAS f32x4*)(km + 516);
      a = a * (1.0f / 256.0f); c = c * (1.0f / 256.0f);
      const unsigned h0 = pk2(a.x, a.y), h1 = pk2(a.z, a.w), h2 = pk2(c.x, c.y), h3 = pk2(c.z, c.w);
      const unsigned l0 = pk2(a.x - __uint_as_float(h0 << 16), a.y - __uint_as_float(h0 & 0xffff0000u)), l1 = pk2(a.z - __uint_as_float(h1 << 16), a.w - __uint_as_float(h1 & 0xffff0000u)),
                     l2 = pk2(c.x - __uint_as_float(h2 << 16), c.y - __uint_as_float(h2 & 0xffff0000u)), l3 = pk2(c.z - __uint_as_float(h3 << 16), c.w - __uint_as_float(h3 & 0xffff0000u));
      *(LAS v4u*)(L + AT_K0 + n * AT_KROW + (tid & 7) * 16) = (v4u){h0, h1, h2, h3}; *(LAS v4u*)(L + AT_K0 + AT_KBUF + n * AT_KROW + (tid & 7) * 16) = (v4u){l0, l1, l2, l3}; }
    __syncthreads();
    unsigned mlo = 0u, mhi = 0u;
    if (qt > 0) {
        f32x16 g0 = {0.f, 0.f, 0.f, 0.f, 0.f, 0.f, 0.f, 0.f, 0.f, 0.f, 0.f, 0.f, 0.f, 0.f, 0.f, 0.f}, g1 = g0;
        at_qk(g0, g1, L + AT_K0, qf, r32, hi); at_qk(g0, g1, L + AT_K0 + AT_KBUF, qf, r32, hi);
        MFMA_FENCE2(g0, g1);
#pragma unroll
        for (int r = 0; r < 16; ++r) { if (crow_(r, hi) >= qt) g0[r] = -INFINITY; if (32 + crow_(r, hi) >= qt) g1[r] = -INFINITY; }
#pragma unroll
        for (int it = 0; it < 3; ++it) {
            float bv = -INFINITY; int bn = 64;
#pragma unroll
            for (int r = 0; r < 16; ++r) if (g0[r] > bv) { bv = g0[r]; bn = crow_(r, hi); }
#pragma unroll
            for (int r = 0; r < 16; ++r) if (g1[r] > bv) { bv = g1[r]; bn = 32 + crow_(r, hi); }
            const float pv = __shfl_xor(bv, 32); const int pn = __shfl_xor(bn, 32);
            const bool tp = (pv > bv) || (pv == bv && pn < bn);
            const float wv = tp ? pv : bv; const int wn = tp ? pn : bn;
            if (wv > -INFINITY) { if (wn < 32) mlo |= 1u << wn; else mhi |= 1u << (wn - 32);
                if (hi == 0 && !DRY) { GAS unsigned* cnt = (GAS unsigned*)(F.ws + WS_CTL) + CW_LCNT + ((l * 2 + b) * 8 + h) * 64 + wn;
                    const unsigned slot = __hip_atomic_fetch_add(cnt, 1u, __ATOMIC_RELAXED, __HIP_MEMORY_SCOPE_AGENT);
                    ((GAS unsigned short*)(F.ws + WS_LISTS) + ((size_t)(b * 8 + h) << 19))[list_off(wn) + slot] = (unsigned short)(q | (it << 14)); } }
#pragma unroll
            for (int r = 0; r < 16; ++r) { if (crow_(r, hi) == wn) g0[r] = -INFINITY; if (32 + crow_(r, hi) == wn) g1[r] = -INFINITY; }
        }
    }
    __syncthreads();
    v4u kr, vr;
    at_load(Kh, Vh, 4 * qt, tid, kr, vr);
    at_store(L + AT_K0, L + AT_V0, tid, kr, vr);
    __syncthreads();
    float m = -1e30f, lsum = 0.f;
    f32x16 o0 = {0.f, 0.f, 0.f, 0.f, 0.f, 0.f, 0.f, 0.f, 0.f, 0.f, 0.f, 0.f, 0.f, 0.f, 0.f, 0.f}, o1 = o0;
#pragma unroll 1
    for (int tt = 0; tt < 4; ++tt) {
        const int t = 4 * qt + tt, cur = tt & 1;
        if (tt + 1 < 4) at_load(Kh, Vh, t + 1, tid, kr, vr);
        const int nall = q - t * 64 + 1;
        const unsigned wlo = nall >= 32 ? 0xffffffffu : (nall <= 0 ? 0u : ((1u << nall) - 1u)), whi = nall >= 64 ? 0xffffffffu : (nall <= 32 ? 0u : ((1u << (nall - 32)) - 1u));
        if (__any((wlo | whi) != 0u)) {
            const LAS unsigned char* kb = L + AT_K0 + cur * AT_KBUF; const LAS unsigned char* vb = L + AT_V0 + cur * AT_VBUF;
            f32x16 p0 = {0.f, 0.f, 0.f, 0.f, 0.f, 0.f, 0.f, 0.f, 0.f, 0.f, 0.f, 0.f, 0.f, 0.f, 0.f, 0.f}, p1 = p0;
            at_qk(p0, p1, kb, qf, r32, hi);
            MFMA_FENCE2(p0, p1);
#pragma unroll
            for (int r = 0; r < 16; ++r) { const int d0 = q - (t * 64 + crow_(r, hi)), d1 = d0 - 32;
                const float b0 = ((unsigned)d0 < 128u) ? bt[d0] : 0.f, b1 = ((unsigned)d1 < 128u) ? bt[d1] : 0.f;
                p0[r] = p0[r] * AT_C2 + b0; p1[r] = p1[r] * AT_C2 + b1; }
            float mx;
            { float ma = max3_(p0[0], p1[0], p0[1]), mb = max3_(p1[1], p0[2], p1[2]), mc = max3_(p0[3], p1[3], p0[4]), md = max3_(p1[4], p0[5], p1[5]);
              ma = max3_(ma, p0[6], p1[6]); mb = max3_(mb, p0[7], p1[7]); mc = max3_(mc, p0[8], p1[8]); md = max3_(md, p0[9], p1[9]);
              ma = max3_(ma, p0[10], p1[10]); mb = max3_(mb, p0[11], p1[11]); mc = max3_(mc, p0[12], p1[12]); md = max3_(md, p0[13], p1[13]);
              ma = max3_(ma, p0[14], p1[14]); mb = max3_(mb, p0[15], p1[15]); mx = max3_(ma, mb, mc); mx = max3_(mx, md, md); }
            mx = max3_(mx, __shfl_xor(mx, 32), mx);
            if (__any(mx > m + AT_THR)) {
                const float mn = fmaxf(m, mx); const float al = __builtin_amdgcn_exp2f(m - mn);
                MFMA_FENCE2(o0, o1);
#pragma unroll
                for (int r = 0; r < 16; ++r) { o0[r] *= al; o1[r] *= al; }
                lsum *= al; m = mn;
            }
            const unsigned wl = wlo >> (4 * hi), wh = whi >> (4 * hi);
            float lq[4] = {0.f, 0.f, 0.f, 0.f};
#pragma unroll
            for (int r = 0; r < 16; ++r) { const int cb = (r & 3) + 8 * (r >> 2);
                const float e0 = __uint_as_float(and_sel(__builtin_amdgcn_exp2f(p0[r] - m), wl, cb)), e1 = __uint_as_float(and_sel(__builtin_amdgcn_exp2f(p1[r] - m), wh, cb));
                p0[r] = e0; p1[r] = e1; lq[r & 1] += e0; lq[2 + (r & 1)] += e1; }
            lsum += (lq[0] + lq[1]) + (lq[2] + lq[3]);
            bf16x8_t pb[4];
#pragma unroll
            for (int sg = 0; sg < 4; ++sg) { union { bf16x8_t v; unsigned u[4]; } pk;
#pragma unroll
                for (int j = 0; j < 4; ++j) { const int r = 8 * (sg & 1) + 2 * j; pk.u[j] = (sg < 2) ? pg8::cvt_pk_bf16(p0[r], p0[r + 1]) : pg8::cvt_pk_bf16(p1[r], p1[r + 1]); }
                pb[sg] = pk.v; }
            at_pv(o0, o1, vb, pb, r32, hi);
        }
        if (tt + 1 < 4) at_store(L + AT_K0 + (cur ^ 1) * AT_KBUF, L + AT_V0 + (cur ^ 1) * AT_VBUF, tid, kr, vr);
        __syncthreads();
    }
    MFMA_FENCE2(o0, o1);
    lsum += __shfl_xor(lsum, 32);
    if (hi == 0 && !DRY) { ((GAS float*)WSF(WS_MREF))[(rowb + q) * 8 + h] = m; ((GAS float*)WSF(WS_LACC))[(rowb + q) * 8 + h] = lsum; }
    LAS bf16* ost = (LAS bf16*)(L + AT_OST + wave * 4096);
#pragma unroll
    for (int r = 0; r < 16; ++r) { ost[r32 * 64 + crow_(r, hi)] = (bf16)f2bf(o0[r]); ost[r32 * 64 + 32 + crow_(r, hi)] = (bf16)f2bf(o1[r]); }
    LDS_WAIT(); asm volatile("" ::: "memory");
    GAS bf16* Og = (GAS bf16*)WSB(WS_PO) + (rowb + q0w) * 512 + h * 64;
#pragma unroll
    for (int i = 0; i < 4; ++i) { const int c = i * 64 + lane, row = c >> 3, ch = c & 7; const v4u ov = *(const LAS v4u*)(ost + row * 64 + ch * 8); if (!DRY || (ov.x == 0x12345678u && ov.y == 0x9abcdef0u)) *(GAS v4u*)(Og + (size_t)row * 512 + ch * 8) = ov; }
}

template <bool DRY = false> __device__ __forceinline__ void moba_item_unit(Frame& F, int l, int b, int h, int n) {
    int tid_ = F.tid; asm volatile("" : "+v"(tid_));
    const int tid = tid_, lane = tid & 63, wave = F.wave, r32 = lane & 31, hi = lane >> 5;
    LAS unsigned char* L = F.lds + RING_OFF;
    LAS float* bt = (LAS float*)(L + IT_BT);
    const size_t rowb = (size_t)b * SEQ;
    const int cnt = (int)((const GAS unsigned*)(F.ws + WS_CTL))[CW_LCNT + ((l * 2 + b) * 8 + h) * 64 + n];
    if (cnt == 0) return;
    const GAS bf16* Kh = (const GAS bf16*)WSB(WS_KA) + rowb * 512 + h * 64; const GAS bf16* Vh = (const GAS bf16*)WSB(WS_VA) + rowb * 512 + h * 64;
    __syncthreads();
    if (tid < 128) { const GAS float* rb = (const GAS float*)INP(I_RELB) + h; bt[tid] = (rb[t5_bucket(tid) * 16] - rb[31 * 16]) * LOG2E; }
#pragma unroll
    for (int t = 0; t < 4; ++t) { v4u kr, vr; at_load(Kh, Vh, 4 * n + t, tid, kr, vr); at_store(L + IT_K + t * AT_KBUF, L + IT_V + t * AT_VBUF, tid, kr, vr); }
    __syncthreads();
    const GAS unsigned short* lst = (const GAS unsigned short*)(F.ws + WS_LISTS) + ((size_t)(b * 8 + h) << 19) + list_off(n);
    LAS int* qpl = (LAS int*)(L + IT_QP + wave * 128);
    LAS float* ostf = (LAS float*)(L + IT_OST + wave * 4096);
    const int ngrp = (cnt + 31) >> 5;
#pragma unroll 1
    for (int g = wave; g < ngrp; g += NWAVES) {
        const int li = g * 32 + r32; const bool valid = li < cnt;
        const int ent = valid ? (int)lst[li] : (int)lst[g * 32];
        const int q = ent & 0x3fff;
        if (hi == 0) qpl[r32] = valid ? ent : -1;
        bf16x8_t qf[4];
        { const GAS bf16* qp = (const GAS bf16*)WSB(WS_QA) + (rowb + q) * 512 + h * 64 + hi * 8;
#pragma unroll
          for (int s = 0; s < 4; ++s) qf[s] = *(const GAS bf16x8_t*)(qp + s * 16); }
        const float mref = ((const GAS float*)WSF(WS_MREF))[(rowb + q) * 8 + h];
        const bool near = __any(q < 256 * (n + 1) + 128);
        float lsum = 0.f;
        f32x16 o0 = {0.f, 0.f, 0.f, 0.f, 0.f, 0.f, 0.f, 0.f, 0.f, 0.f, 0.f, 0.f, 0.f, 0.f, 0.f, 0.f}, o1 = o0;
#pragma unroll 1
        for (int t = 0; t < 4; ++t) {
            const LAS unsigned char* kb = L + IT_K + t * AT_KBUF; const LAS unsigned char* vb = L + IT_V + t * AT_VBUF;
            f32x16 p0 = {0.f, 0.f, 0.f, 0.f, 0.f, 0.f, 0.f, 0.f, 0.f, 0.f, 0.f, 0.f, 0.f, 0.f, 0.f, 0.f}, p1 = p0;
            at_qk(p0, p1, kb, qf, r32, hi);
            MFMA_FENCE2(p0, p1);
            float lq[4] = {0.f, 0.f, 0.f, 0.f};
            if (near) {
#pragma unroll
                for (int r = 0; r < 16; ++r) { const int d0 = q - ((4 * n + t) * 64 + crow_(r, hi)), d1 = d0 - 32;
                    const float b0 = ((unsigned)d0 < 128u) ? bt[d0] : 0.f, b1 = ((unsigned)d1 < 128u) ? bt[d1] : 0.f;
                    const float e0 = __builtin_amdgcn_exp2f(fminf(p0[r] * AT_C2 + b0 - mref, 60.f)), e1 = __builtin_amdgcn_exp2f(fminf(p1[r] * AT_C2 + b1 - mref, 60.f));
                    p0[r] = e0; p1[r] = e1; lq[r & 1] += e0; lq[2 + (r & 1)] += e1; }
            } else {
#pragma unroll
                for (int r = 0; r < 16; ++r) { const float e0 = __builtin_amdgcn_exp2f(fminf(__builtin_fmaf(p0[r], AT_C2, -mref), 60.f)), e1 = __builtin_amdgcn_exp2f(fminf(__builtin_fmaf(p1[r], AT_C2, -mref), 60.f));
                    p0[r] = e0; p1[r] = e1; lq[r & 1] += e0; lq[2 + (r & 1)] += e1; }
            }
            lsum += (lq[0] + lq[1]) + (lq[2] + lq[3]);
            bf16x8_t pb[4];
#pragma unroll
            for (int sg = 0; sg < 4; ++sg) { union { bf16x8_t v; unsigned u[4]; } pk;
#pragma unroll
                for (int j = 0; j < 4; ++j) { const int r = 8 * (sg & 1) + 2 * j; pk.u[j] = (sg < 2) ? pg8::cvt_pk_bf16(p0[r], p0[r + 1]) : pg8::cvt_pk_bf16(p1[r], p1[r + 1]); }
                pb[sg] = pk.v; }
            at_pv(o0, o1, vb, pb, r32, hi);
        }
        MFMA_FENCE2(o0, o1);
        lsum += __shfl_xor(lsum, 32);
        if (hi == 0 && valid && !DRY) ((GAS float*)WSF(WS_LJ))[((size_t)(ent >> 14) * T + rowb + q) * 8 + h] = lsum;
        LAS bf16* ost = (LAS bf16*)ostf;
#pragma unroll
        for (int r = 0; r < 16; ++r) { ost[r32 * 64 + crow_(r, hi)] = (bf16)f2bf(o0[r]); ost[r32 * 64 + 32 + crow_(r, hi)] = (bf16)f2bf(o1[r]); }
        LDS_WAIT(); asm volatile("" ::: "memory");
#pragma unroll
        for (int i = 0; i < 4; ++i) { const int c = i * 64 + lane, row = c >> 3, ch = c & 7; const int er = qpl[row];
            if (er >= 0 && !DRY) { const int j = er >> 14; GAS bf16* pj = (GAS bf16*)pj_base(F, l, j);
                *(GAS v4u*)(pj + (rowb + (er & 0x3fff)) * 512 + h * 64 + ch * 8) = *(const LAS v4u*)(ost + row * 64 + ch * 8); } }
        LDS_WAIT(); asm volatile("" ::: "memory");
    }
}
__device__ __forceinline__ void moba_fin_row(Frame& F, int layer, int m, int lane) {
    const int nsel = ((m & (SEQ - 1)) >> 8) < 3 ? ((m & (SEQ - 1)) >> 8) : 3;
    const int hd = lane >> 3;
    float l = ((const GAS float*)WSF(WS_LACC))[(size_t)m * 8 + hd];
    v4u v = ((const GAS v4u*)((const GAS bf16*)WSB(WS_PO) + (size_t)m * 512))[lane];
    float acc[8] = { __uint_as_float(v.x << 16), __uint_as_float(v.x & 0xffff0000u), __uint_as_float(v.y << 16), __uint_as_float(v.y & 0xffff0000u),
                     __uint_as_float(v.z << 16), __uint_as_float(v.z & 0xffff0000u), __uint_as_float(v.w << 16), __uint_as_float(v.w & 0xffff0000u) };
#pragma unroll
    for (int j = 0; j < 3; ++j) if (j < nsel) {
        l += ((const GAS float*)WSF(WS_LJ))[((size_t)j * T + m) * 8 + hd];
        const v4u w = ((const GAS v4u*)((const GAS bf16*)pj_base(F, layer, j) + (size_t)m * 512))[lane];
        acc[0] += __uint_as_float(w.x << 16); acc[1] += __uint_as_float(w.x & 0xffff0000u); acc[2] += __uint_as_float(w.y << 16); acc[3] += __uint_as_float(w.y & 0xffff0000u);
        acc[4] += __uint_as_float(w.z << 16); acc[5] += __uint_as_float(w.z & 0xffff0000u); acc[6] += __uint_as_float(w.w << 16); acc[7] += __uint_as_float(w.w & 0xffff0000u); }
    const float inv = 1.0f / l;
    v4u o; o.x = pk2(acc[0] * inv, acc[1] * inv); o.y = pk2(acc[2] * inv, acc[3] * inv); o.z = pk2(acc[4] * inv, acc[5] * inv); o.w = pk2(acc[6] * inv, acc[7] * inv);
    ((GAS v4u*)((GAS bf16*)WSB(WS_QA) + (size_t)m * 512))[lane] = o;
}
__global__ void __launch_bounds__(NWAVES * 64, 2) fwd(Args args) {
    extern __shared__ __attribute__((aligned(16))) unsigned char lds[];
    Frame F;
    F.lds = (LAS unsigned char*)lds;
        F.tid = threadIdx.x; F.lane = F.tid & 63; F.wave = __builtin_amdgcn_readfirstlane(F.tid >> 6);
    F.G = gridDim.x; F.bid = blockIdx.x;
    F.a = (const __attribute__((address_space(4))) Args*)__builtin_amdgcn_kernarg_segment_ptr(); F.ws = args.ws; F.out = args.out;
    unsigned char* ws = args.ws;
    for (int u = F.tid; u < (LDS_BYTES - LDSCTL_OFF) / 4; u += NWAVES * 64) ((LAS unsigned*)(F.lds + LDSCTL_OFF))[u] = 0u;
    __syncthreads();
    {
        volatile LAS unsigned* pw = (volatile LAS unsigned*)(F.lds + MISC_OFF) + 64;
        const unsigned hw = __builtin_amdgcn_s_getreg((4 << 0) | (4 << 6) | (1 << 11));
        if (F.lane == 0) pw[F.wave] = hw & 3u;
        __syncthreads();
        const unsigned my = pw[F.wave]; unsigned cnts = 0, rank = 0;
#pragma unroll
        for (int w = 0; w < NWAVES; ++w) { const unsigned s = pw[w]; cnts += 1u << (8 * s); if (w < F.wave && s == my) ++rank; }
#ifdef BAD_ROLES
        F.gw = __builtin_amdgcn_readfirstlane((cnts == 0x02020202u) ? (int)((my >> 1) * 4 + (my & 1) * 2 + rank) : F.wave);
#else
        F.gw = __builtin_amdgcn_readfirstlane((cnts == 0x02020202u) ? (int)(rank * 4 + my) : F.wave);
#endif
        __syncthreads();
    }
    XcdBarrier bar; bar.bar = (unsigned*)(ws + WS_CTL) + CW_BAR; bar.x = 0; bar.st = nullptr;
    if (ONE_LAUNCH) bar = xcd_barrier_post((unsigned*)(ws + WS_CTL) + CW_BAR, (volatile LAS unsigned*)(F.lds + MISC_OFF) + 8);
#define GRID_BAR() do { if (ONE_LAUNCH) xcd_barrier(bar); } while (0)
    const int lo = args.ph_lo, hi = args.ph_hi;
#ifndef PH_MASK
#define PH_MASK 0xfff
#endif
#define IN(k) (((PH_MASK >> ((k) % PH_PER_LAYER == 0 && (k) == 2 * PH_PER_LAYER ? 11 : (k) % PH_PER_LAYER)) & 1) && lo <= (k) && (k) < hi)
#define BOTH(k) (IN(k) && IN((k) + 1))
#define GEMM_TID ((F.gw << 6) | F.lane)
#define DYN_CTR(k) ((unsigned*)(F.ws + WS_CTL) + CW_DYN + 32 * (k))
#define DYN_FETCH(dst, k) do { __syncthreads(); if (F.tid == 0) *((volatile LAS unsigned*)(F.lds + MISC_OFF) + 32) = atomicAdd(DYN_CTR(k), 1u); __syncthreads(); \
        dst = (int)__builtin_amdgcn_readfirstlane(*((volatile LAS unsigned*)(F.lds + MISC_OFF) + 32)); } while (0)
#define LAUNDER() do { asm volatile("" : "+v"(F.tid)); F.lane = F.tid & 63; F.wave = __builtin_amdgcn_readfirstlane(F.tid >> 6); F.ws = launder_u(F.ws); F.out = launder_u(F.out); F.a = launder_u(F.a); F.bid = launder_i(F.bid); F.G = launder_i(F.G); F.gw = launder_i(F.gw); } while (0)
    LAS unsigned char* ring = F.lds + RING_OFF;
    for (int l = 0; l < 2; ++l) {
        const int P = l * PH_PER_LAYER;
#ifdef DBG_DUMP
        if (lo == DBG_PHASE && l == 0) { for (int u = F.bid; u < T; u += F.G) { F.out[(size_t)u * DM + F.tid] = bf2f(WSB(DBG_DUMP)[(size_t)u * DBG_PITCH + F.tid]); F.out[(size_t)u * DM + 512 + F.tid] = 0.f; } }
        if (lo >= DBG_PHASE && lo < 2 * PH_PER_LAYER) continue;
#endif
        if (IN(P + 0)) { LAUNDER(); p_prologue(F, l); if (PROBE_SEL & 128) { VM_WAIT(); __syncthreads(); p_prologue(F, l); } if (BOTH(P + 0)) GRID_BAR(); }
        if (IN(P + 1)) { LAUNDER();
            pg8::Gemm g{WSB(WS_XB), WSB(WS_W_IN), T, NIN_T, DM}; pg8::StaticOrder S; S.init(T, NIN_T, F.G, F.bid);
            pg8::EpiInproj E{WSB(WS_QA), WSB(WS_KI), WSF(WS_WI), SSQ_MIX(l), WSF(WS_KM2)};
            pg8::gemm_phase<pg8::EpiInproj, pg8::StaticOrder, true, PG8_SP2>(ring, g, S, E, GEMM_TID);
            if (PROBE_SEL & 32) { VM_WAIT(); __syncthreads(); LAUNDER(); pg8::gemm_phase<pg8::EpiInproj, pg8::StaticOrder, true, PG8_SP2>(ring, g, S, E, GEMM_TID); }
            if (BOTH(P + 1)) GRID_BAR();
        }
        if (IN(P + 2)) { LAUNDER();
#ifndef FAST_DSA
#define FAST_DSA 1
#endif
            if ((PROBE_SEL & 1024) && F.bid < 256) { for (int r = 0; r < 4; ++r) { const int i = r * 256 + F.bid; moba_own_unit<true>(F, l, (i & 15) >> 3, i & 7, i >> 4); } __syncthreads(); }
            if (FAST_MOBA == 2 && F.bid < 256) { for (int r = 0; r < 4; ++r) { const int i = r * 256 + F.bid; moba_own_unit<false>(F, l, (i & 15) >> 3, i & 7, i >> 4); } __syncthreads(); }
            for (int rep = 0; rep < ((PROBE_SEL & 64) ? 2 : 1); ++rep)
            for (int u = F.bid; u < 2 * RGC; u += F.G) rg_unit<false>(F, l, u / RGC, u % RGC);
            if (FAST_DSA) {
                for (;;) { int i; DYN_FETCH(i, 2 * l); if (i >= 2048) break; const int stt = 63 - (i >> 5), j = i & 31; idx_unit(F, j >> 4, stt * 256 + (j & 15) * 16); }
                __syncthreads();
            }
            if (BOTH(P + 2)) GRID_BAR();
        }
        if (IN(P + 3)) { LAUNDER();
            #ifndef MIX2_SEL
#define MIX2_SEL 7
#endif
            if (MIX2_SEL & 1) for (int u = F.bid; u < 2 * RGC; u += F.G) rg_unit<true>(F, l, u / RGC, u % RGC);
            if (FAST_MOBA == 2 && F.bid < 256) {
                if (PROBE_SEL & 2048) for (int r = 0; r < 4; ++r) { const int g = F.bid; const int i = r * 256 + ((r & 1) ? 255 - g : g); moba_item_unit<true>(F, l, (i & 15) >> 3, i & 7, i >> 4); }
                for (int r = 0; r < 4; ++r) { const int g = F.bid; const int i = r * 256 + ((r & 1) ? 255 - g : g); moba_item_unit<false>(F, l, (i & 15) >> 3, i & 7, i >> 4); }
                __syncthreads();
            }
            if (FAST_MOBA == 1 && (MIX2_SEL & 2)) {
                if (PROBE_SEL & 1) { for (int r = 0; r < 4; ++r) { const int g = F.bid % 256; const int i = r * 256 + ((r & 1) ? 255 - g : g); if (F.bid >= 256) break;
                    const int qt = 63 - (i >> 4), bh = i & 15; attn_unit<0, true>(F, bh >> 3, bh & 7, qt); } }
                for (int r = 0; r < 4; ++r) { const int g = F.bid % 256; const int i = r * 256 + ((r & 1) ? 255 - g : g); if (F.bid >= 256) break;
                    const int qt = 63 - (i >> 4), bh = i & 15; attn_unit<0>(F, bh >> 3, bh & 7, qt); }
                __syncthreads();
            }
            if (FAST_DSA && (MIX2_SEL & 4)) {
                if (PROBE_SEL & 2) { for (int r = 0; r < 4; ++r) { const int g = F.bid % 256; const int i = r * 256 + ((r & 1) ? 255 - g : g); if (F.bid >= 256) break;
                    const int qt = 63 - (i >> 4), bh = i & 15; dsa_attn2_unit<true>(F, bh >> 3, bh & 7, qt); } }
                for (;;) { int i; DYN_FETCH(i, 2 * l + 1); if (i >= 1024) break;
                    const int qt = 63 - (i >> 4), bh = i & 15; dsa_attn2_unit<false>(F, bh >> 3, bh & 7, qt); }
                __syncthreads();
            }
            if (!(FAST_MOBA && FAST_DSA)) for (int u = F.bid; u < T; u += F.G) { const int b = u & 1, t = u >> 1; if (FAST_MOBA == 0 && (MIX2_SEL & 2)) moba_unit(F, b, t); if (!FAST_DSA && (MIX2_SEL & 4)) dsa_unit(F, b, t); }
            for (int u = F.bid; u < T; u += F.G) { if (!(MIX2_SEL & 2)) WSB(WS_QA)[(size_t)u * 512 + F.tid] = 0; if (!(MIX2_SEL & 4)) WSB(WS_QB)[(size_t)u * 512 + F.tid] = 0; if (!(MIX2_SEL & 1)) WSB(WS_YC)[(size_t)u * 512 + F.tid] = 0; }
            if (BOTH(P + 3)) GRID_BAR();
        }

        if (IN(P + 4)) { LAUNDER();
            if (FAST_MOBA == 2) { const int gw = F.bid * NWAVES + F.wave, NGW = F.G * NWAVES; const float* xin = (l == 0) ? INP(I_X) : (const float*)F.out;
                for (int m = gw; m < T; m += NGW) moba_fin_row(F, l, m, F.lane);
                if (l != 0) {
                    GRID_BAR();
                    for (int m = gw; m < T; m += NGW) norm_row(xin + (size_t)m * DM, WSB(WS_XB) + (size_t)m * DM, SSQ_MIX(l) + m, F.lane); } }
            if (BOTH(P + 4)) GRID_BAR();
        }
        if (IN(P + 5)) { LAUNDER();
            pg8::Gemm g{WSB(WS_XB), WSB(WS_W_G), T, 3072, DM}; pg8::StaticOrder S; S.init(T, 3072, F.G, F.bid);
            pg8::EpiGates E{WSB(WS_G), SSQ_MIX(l)};
            pg8::gemm_phase<pg8::EpiGates, pg8::StaticOrder, true, PG8_SP2>(ring, g, S, E, GEMM_TID);
            if (PROBE_SEL & 32) { VM_WAIT(); __syncthreads(); LAUNDER(); pg8::gemm_phase<pg8::EpiGates, pg8::StaticOrder, true, PG8_SP2>(ring, g, S, E, GEMM_TID); }
            if (BOTH(P + 5)) GRID_BAR();
        }
        if (IN(P + 6)) { LAUNDER();
            pg8::StaticOrder S; S.init(T, DM, F.G, F.bid);
            { pg8::Gemm g{WSB(WS_QA), WSB(WS_W_PA), T, DM, DH}; pg8::EpiMerge<true> E{WSB(WS_G), WSB(WS_MERGED)}; pg8::gemm_phase<pg8::EpiMerge<true>, pg8::StaticOrder, true, PG8_SP2>(ring, g, S, E, GEMM_TID); }
#ifndef MERGE_CALLS
#define MERGE_CALLS 3
#endif
            VM_WAIT(); __syncthreads(); LAUNDER();
            if (MERGE_CALLS >= 2) { pg8::Gemm g{WSB(WS_QB), WSB(WS_W_PB), T, DM, DH}; pg8::EpiMerge<false> E{WSB(WS_G) + (size_t)T * 1024, WSB(WS_MERGED)}; pg8::gemm_phase<pg8::EpiMerge<false>, pg8::StaticOrder, true, PG8_SP2>(ring, g, S, E, GEMM_TID); }
            VM_WAIT(); __syncthreads(); LAUNDER();
            if (MERGE_CALLS >= 3) { pg8::Gemm g{WSB(WS_YC), WSB(WS_W_PC), T, DM, DH}; pg8::EpiMerge<false> E{WSB(WS_G) + (size_t)2 * T * 1024, WSB(WS_MERGED)}; pg8::gemm_phase<pg8::EpiMerge<false>, pg8::StaticOrder, true, PG8_SP2>(ring, g, S, E, GEMM_TID); }
            if (BOTH(P + 6)) GRID_BAR();
        }
        if (IN(P + 7)) { LAUNDER();
            pg8::Gemm g{WSB(WS_MERGED), WSB(WS_W_O), T, DM, DM}; pg8::StaticOrder S; S.init(T, DM, F.G, F.bid);
            pg8::EpiResid E{(l == 0) ? INP(I_X) : (const float*)F.out, F.out, WSB(WS_XB), SSQ_MLP(l)};
            pg8::gemm_phase<pg8::EpiResid, pg8::StaticOrder, true, PG8_SP2>(ring, g, S, E, GEMM_TID);
            if (BOTH(P + 7)) GRID_BAR();
        }
        if (IN(P + 8)) {   }
        if (IN(P + 9)) { LAUNDER();
            pg8::Gemm g{WSB(WS_XB), WSB(WS_W_UP), T, DFF, DM}; pg8::StaticOrder S; S.init(T, DFF, F.G, F.bid);
            pg8::EpiUp E{WSB(WS_H), SSQ_MLP(l)};
            pg8::gemm_phase<pg8::EpiUp, pg8::StaticOrder, true, PG8_SP2>(ring, g, S, E, GEMM_TID);
            if (PROBE_SEL & 32) { VM_WAIT(); __syncthreads(); LAUNDER(); pg8::gemm_phase<pg8::EpiUp, pg8::StaticOrder, true, PG8_SP2>(ring, g, S, E, GEMM_TID); }
            if (BOTH(P + 9)) GRID_BAR();
        }
        if (IN(P + 10)) { LAUNDER();
            pg8::Gemm g{WSB(WS_H), WSB(WS_W_DN), T, DM, DFF}; pg8::StaticOrder S; S.init(T, DM, F.G, F.bid);
            pg8::EpiResid E{(const float*)F.out, F.out, (l == 0) ? WSB(WS_XB) : (bf16*)nullptr, (float*)(F.ws + WS_CTL) + CW_SSQ + T};
            pg8::gemm_phase<pg8::EpiResid, pg8::StaticOrder, true, PG8_SP2>(ring, g, S, E, GEMM_TID);
            if (BOTH(P + 10)) GRID_BAR();
        }
    }
    if (IN(2 * PH_PER_LAYER)) { LAUNDER(); p_final(F); }
#undef IN
#undef BOTH
#undef GRID_BAR
}

extern "C" void kernel_launch(void* const* d_in, const int* in_sizes, int n_in, void* d_out, int out_size, void* d_ws, size_t ws_size, hipStream_t stream) {
    static int grid = 0;
    if (grid == 0) {
        if (n_in != 19 || in_sizes[0] != T * DM || out_size != T * DM || ws_size < WS_END) { fprintf(stderr, "kernel_launch: unexpected shapes (n_in %d, in0 %d, out %d, ws %zu)\n", n_in, n_in > 0 ? in_sizes[0] : -1, out_size, ws_size); grid = -1; return; }
        int dev = 0, cus = 0, per_cu = 0;
        if (hipGetDevice(&dev) != hipSuccess || hipDeviceGetAttribute(&cus, hipDeviceAttributeMultiprocessorCount, dev) != hipSuccess) { grid = -1; return; }
        if (hipFuncSetAttribute((const void*)fwd, hipFuncAttributeMaxDynamicSharedMemorySize, LDS_BYTES) != hipSuccess) { fprintf(stderr, "kernel_launch: hipFuncSetAttribute failed\n"); grid = -1; return; }
        if (hipOccupancyMaxActiveBlocksPerMultiprocessor(&per_cu, (const void*)fwd, NWAVES * 64, LDS_BYTES) != hipSuccess || per_cu < 1) { fprintf(stderr, "kernel_launch: occupancy query says %d\n", per_cu); }
        (void)hipGetLastError();
        grid = cus;
    }
    if (grid < 0) return;
    if (hipMemsetAsync((char*)d_ws + WS_CTL, 0, CTL_ZERO_BYTES, stream) != hipSuccess) return;
    Args a{};
    for (int i = 0; i < 19; ++i) a.in[i] = (const float*)d_in[i];
    a.out = (float*)d_out; a.ws = (unsigned char*)d_ws;
    if (ONE_LAUNCH) { a.ph_lo = 0; a.ph_hi = N_PHASES; hipLaunchKernelGGL(fwd, dim3(grid), dim3(NWAVES * 64), LDS_BYTES, stream, a); }
    else for (int p = 0; p < N_PHASES; ++p) { a.ph_lo = p; a.ph_hi = p + 1; hipLaunchKernelGGL(fwd, dim3(grid), dim3(NWAVES * 64), LDS_BYTES, stream, a); }
}
```

```cpp
#include <hip/hip_runtime.h>
#include <cstdio>
#include <cstdint>

#ifndef MK_ONE_LAUNCH
#define MK_ONE_LAUNCH 1
#endif

constexpr int BATCH = 2, SEQ = 16384, DM = 1024, T = BATCH * SEQ;
constexpr int DIN = 7752, DFF = 4096, DH = 512;
constexpr int NIN_T = 4864;
constexpr int NBLK = SEQ / 256;
constexpr float EPS = 1e-6f;

namespace pg8 {
#define PG8_LAS __attribute__((address_space(3)))
typedef unsigned short bf16_t;
typedef short bf16x8 __attribute__((ext_vector_type(8)));
typedef float f32x4 __attribute__((ext_vector_type(4)));
typedef unsigned u32x4 __attribute__((ext_vector_type(4)));
constexpr int BM = 256, BK = 64, HALF = 128, HTB = HALF * BK * 2  , STAGE_BYTES = 8 * HTB, NXCD = 8, WGM = 8;

__host__ __device__ __forceinline__ int lds_byte(int r, int c) { const int st = (r >> 4) * 2 + (c >> 5), rr = r & 15, cc = c & 31, ob = rr * 64 + cc * 2; return st * 1024 + (ob ^ (((ob >> 9) & 1) << 5)); }
__host__ __device__ __forceinline__ void stage_rc(int b, int& R, int& C) { const int st = b / 1024, sb = b % 1024, swz = sb ^ (((sb >> 9) & 1) << 5); R = (st >> 1) * 16 + swz / 64; C = (st & 1) * 32 + (swz % 64) / 2; }
__host__ __device__ __forceinline__ int perm32(int rho) { const int n = rho >> 4, i = rho & 15; return 8 * (i >> 2) + 4 * n + (i & 3); }

struct Unit { int pm, pn; };
struct Gemm { const bf16_t* A; const bf16_t* Bt; int M, N, K; };

struct StaticOrder {
    int nM, nN, nwg, G, c;
    __host__ __device__ void init(int M, int N, int G_, int c_) { nM = M / BM; nN = N / BM; nwg = nM * nN; G = G_; c = c_; }
    __host__ __device__ bool next(int i, Unit& u) const {
        const long L = (long)i * G + c; if (L >= nwg) return false;
        int wgid = (int)L; { const int q = nwg / NXCD, r = nwg % NXCD, xcd = wgid % NXCD, off = wgid / NXCD; wgid = (xcd < r ? xcd * (q + 1) : r * (q + 1) + (xcd - r) * q) + off; }
        const int nig = WGM * nN, gid = wgid / nig, fm = gid * WGM, gsz = (nM - fm) < WGM ? (nM - fm) : WGM;
        u.pm = fm + ((wgid % nig) % gsz); u.pn = (wgid % nig) / gsz; return true;
    }
    __device__ __forceinline__ void a_ready(const Unit&) const {}
    __device__ __forceinline__ void done(const Unit&) const {}
};

typedef float f32x2_t __attribute__((ext_vector_type(2))); typedef __bf16 bf16x2_t __attribute__((ext_vector_type(2)));
__device__ __forceinline__ unsigned cvt_pk_bf16(float lo, float hi) { f32x2_t v = {lo, hi}; bf16x2_t b = __builtin_convertvector(v, bf16x2_t); return __builtin_bit_cast(unsigned, b); }
__device__ __forceinline__ float bf_lo(unsigned w) { return __uint_as_float(w << 16); }
__device__ __forceinline__ float bf_hi(unsigned w) { return __uint_as_float(w & 0xffff0000u); }

struct EpiInproj {
    static constexpr bool PERM = true, AFTER_DRAIN = false;
    bf16_t* base; bf16_t* ki; float* wi; const float* rstd  ; float* km2;
    __device__ __forceinline__ void operator()(const f32x4 (&acc)[2][2][4][2], const Unit& u, int wr, int wc, int fr, int fq) const {
        const int row0 = u.pm * BM + wr * 64 + fr;
        if (u.pn < 18) {
            bf16_t* dst = base + (size_t)(u.pn >> 1) * ((size_t)T * 512) + (u.pn & 1) * 256 + wc * 32 + 8 * fq;
            const bool ksum = (u.pn >> 1) == 3;
            f32x4 cs[2][2] = {{{0.f, 0.f, 0.f, 0.f}, {0.f, 0.f, 0.f, 0.f}}, {{0.f, 0.f, 0.f, 0.f}, {0.f, 0.f, 0.f, 0.f}}};
#pragma unroll
            for (int ai = 0; ai < 2; ++ai)
#pragma unroll
                for (int m = 0; m < 4; ++m) { const int row = row0 + ai * HALF + m * 16; const float rs = __builtin_amdgcn_rsqf(rstd[row] * (1.0f / 1024.0f) + EPS); bf16_t* rowp = dst + (size_t)row * 512;
#pragma unroll
                    for (int bj = 0; bj < 2; ++bj) { const f32x4 v0 = acc[ai][bj][m][0] * rs, v1 = acc[ai][bj][m][1] * rs;
                        if (ksum) { cs[bj][0] += v0; cs[bj][1] += v1; }
                        u32x4 w; w.x = cvt_pk_bf16(v0[0], v0[1]); w.y = cvt_pk_bf16(v0[2], v0[3]); w.z = cvt_pk_bf16(v1[0], v1[1]); w.w = cvt_pk_bf16(v1[2], v1[3]);
                        *(u32x4*)(rowp + bj * HALF) = w; } }
            if (ksum) {
#pragma unroll
                for (int bj = 0; bj < 2; ++bj)
#pragma unroll
                    for (int n = 0; n < 2; ++n)
#pragma unroll
                        for (int j = 0; j < 4; ++j) { float v = cs[bj][n][j]; v += __shfl_xor(v, 1); v += __shfl_xor(v, 2); v += __shfl_xor(v, 4); v += __shfl_xor(v, 8); cs[bj][n][j] = v; }
                if (fr == 0) { float* kd = km2 + ((size_t)u.pm * 2 + wr) * 512 + (u.pn & 1) * 256 + wc * 32 + 8 * fq;
#pragma unroll
                    for (int bj = 0; bj < 2; ++bj) { *(f32x4*)(kd + bj * HALF) = cs[bj][0]; *(f32x4*)(kd + bj * HALF + 4) = cs[bj][1]; } }
            }
        } else {
#pragma unroll
            for (int ai = 0; ai < 2; ++ai)
#pragma unroll
                for (int m = 0; m < 4; ++m) { const int row = row0 + ai * HALF + m * 16; const float rs = __builtin_amdgcn_rsqf(rstd[row] * (1.0f / 1024.0f) + EPS);
                    const f32x4 v0 = acc[ai][0][m][0] * rs, v1 = acc[ai][0][m][1] * rs;
                    if (wc < 2) { u32x4 w; w.x = cvt_pk_bf16(v0[0], v0[1]); w.y = cvt_pk_bf16(v0[2], v0[3]); w.z = cvt_pk_bf16(v1[0], v1[1]); w.w = cvt_pk_bf16(v1[2], v1[3]);
                        *(u32x4*)(ki + (size_t)row * 64 + wc * 32 + 8 * fq) = w; }
                    else if (wc == 2 && fq == 0) { *(f32x4*)(wi + (size_t)row * 8) = v0; *(f32x4*)(wi + (size_t)row * 8 + 4) = v1; } }
        }
    }
};
struct EpiGates {
    static constexpr bool PERM = true, AFTER_DRAIN = false;
    bf16_t* O; const float* rstd;
    __device__ __forceinline__ void operator()(const f32x4 (&acc)[2][2][4][2], const Unit& u, int wr, int wc, int fr, int fq) const {
        const int row0 = u.pm * BM + wr * 64 + fr; const int tsel = u.pn >> 2;
        bf16_t* dst = O + (size_t)tsel * ((size_t)T * 1024) + (u.pn & 3) * 256 + wc * 32 + 8 * fq;
#pragma unroll
        for (int ai = 0; ai < 2; ++ai)
#pragma unroll
            for (int m = 0; m < 4; ++m) { const int row = row0 + ai * HALF + m * 16; const float rs = __builtin_amdgcn_rsqf(rstd[row] * (1.0f / 1024.0f) + EPS); bf16_t* rowp = dst + (size_t)row * 1024;
#pragma unroll
                for (int bj = 0; bj < 2; ++bj) { float v[8];
#pragma unroll
                    for (int j = 0; j < 4; ++j) { v[j] = acc[ai][bj][m][0][j] * rs; v[4 + j] = acc[ai][bj][m][1][j] * rs; }
#pragma unroll
                    for (int j = 0; j < 8; ++j) v[j] = __builtin_amdgcn_rcpf(1.0f + __builtin_amdgcn_exp2f(-1.4426950408889634f * v[j]));
                    u32x4 w; w.x = cvt_pk_bf16(v[0], v[1]); w.y = cvt_pk_bf16(v[2], v[3]); w.z = cvt_pk_bf16(v[4], v[5]); w.w = cvt_pk_bf16(v[6], v[7]);
                    *(u32x4*)(rowp + bj * HALF) = w; } }
    }
};
template <bool FIRST> struct EpiMerge {
    static constexpr bool PERM = true, AFTER_DRAIN = false;
    const bf16_t* G; bf16_t* Mg;
    __device__ __forceinline__ void operator()(const f32x4 (&acc)[2][2][4][2], const Unit& u, int wr, int wc, int fr, int fq) const {
        const int row0 = u.pm * BM + wr * 64 + fr; const int col0 = u.pn * BM + wc * 32 + 8 * fq;
#pragma unroll
        for (int ai = 0; ai < 2; ++ai)
#pragma unroll
            for (int m = 0; m < 4; ++m) { const size_t off = (size_t)(row0 + ai * HALF + m * 16) * 1024 + col0;
#pragma unroll
                for (int bj = 0; bj < 2; ++bj) { const u32x4 g = *(const u32x4*)(G + off + bj * HALF); const f32x4 a0 = acc[ai][bj][m][0], a1 = acc[ai][bj][m][1];
                    float v[8] = { bf_lo(g.x) * a0[0], bf_hi(g.x) * a0[1], bf_lo(g.y) * a0[2], bf_hi(g.y) * a0[3], bf_lo(g.z) * a1[0], bf_hi(g.z) * a1[1], bf_lo(g.w) * a1[2], bf_hi(g.w) * a1[3] };
                    if (!FIRST) { const u32x4 o = *(const u32x4*)(Mg + off + bj * HALF);
                        v[0] += bf_lo(o.x); v[1] += bf_hi(o.x); v[2] += bf_lo(o.y); v[3] += bf_hi(o.y); v[4] += bf_lo(o.z); v[5] += bf_hi(o.z); v[6] += bf_lo(o.w); v[7] += bf_hi(o.w); }
                    u32x4 w; w.x = cvt_pk_bf16(v[0], v[1]); w.y = cvt_pk_bf16(v[2], v[3]); w.z = cvt_pk_bf16(v[4], v[5]); w.w = cvt_pk_bf16(v[6], v[7]);
                    *(u32x4*)(Mg + off + bj * HALF) = w; }
                if ((m & 3) == 3) asm volatile("" ::: "memory"); }
    }
};
struct EpiResid {
    static constexpr bool PERM = false, AFTER_DRAIN = false;
    const float* src; float* out; bf16_t* xb; float* ssq;
    __device__ __forceinline__ void operator()(const f32x4 (&acc)[2][2][4][2], const Unit& u, int wr, int wc, int fr, int fq) const {
        const int row0 = u.pm * BM + wr * 64 + fr, col0 = u.pn * BM + wc * 32 + 4 * fq;
#pragma unroll
        for (int ai = 0; ai < 2; ++ai)
#pragma unroll
            for (int m = 0; m < 4; ++m) { const int row = row0 + ai * HALF + m * 16; const size_t off = (size_t)row * 1024 + col0; float sq = 0.f;
#pragma unroll
                for (int bj = 0; bj < 2; ++bj)
#pragma unroll
                    for (int n = 0; n < 2; ++n) { const f32x4 s = *(const f32x4*)(src + off + bj * HALF + n * 16); const f32x4 v = s + acc[ai][bj][m][n]; *(f32x4*)(out + off + bj * HALF + n * 16) = v;
                        if (xb) { typedef unsigned u32x2v __attribute__((ext_vector_type(2))); u32x2v w; w.x = cvt_pk_bf16(v[0], v[1]); w.y = cvt_pk_bf16(v[2], v[3]); *(u32x2v*)(xb + off + bj * HALF + n * 16) = w;
                            sq += (v[0] * v[0] + v[1] * v[1]) + (v[2] * v[2] + v[3] * v[3]); } }
                if (xb) { sq += __shfl_xor(sq, 16); sq += __shfl_xor(sq, 32); if (fq == 0) unsafeAtomicAdd(ssq + row, sq); } }
    }
};
struct EpiUp {
    static constexpr bool PERM = true, AFTER_DRAIN = false;
    bf16_t* O; const float* rstd;
    __device__ __forceinline__ void operator()(const f32x4 (&acc)[2][2][4][2], const Unit& u, int wr, int wc, int fr, int fq) const {
        const int row0 = u.pm * BM + wr * 64 + fr; const int col0 = u.pn * BM + wc * 32 + 8 * fq;
#pragma unroll
        for (int ai = 0; ai < 2; ++ai)
#pragma unroll
            for (int m = 0; m < 4; ++m) { const int row = row0 + ai * HALF + m * 16; const float rs = __builtin_amdgcn_rsqf(rstd[row] * (1.0f / 1024.0f) + EPS); bf16_t* rowp = O + (size_t)row * DFF + col0;
#pragma unroll
                for (int bj = 0; bj < 2; ++bj) { float v[8];
#pragma unroll
                    for (int j = 0; j < 4; ++j) { v[j] = fmaxf(acc[ai][bj][m][0][j] * rs, 0.f); v[4 + j] = fmaxf(acc[ai][bj][m][1][j] * rs, 0.f); }
#pragma unroll
                    for (int j = 0; j < 8; ++j) v[j] = v[j] * v[j];
                    u32x4 w; w.x = cvt_pk_bf16(v[0], v[1]); w.y = cvt_pk_bf16(v[2], v[3]); w.z = cvt_pk_bf16(v[4], v[5]); w.w = cvt_pk_bf16(v[6], v[7]);
                    *(u32x4*)(rowp + bj * HALF) = w; } }
    }
};

template <class Epi, class Sched, bool ALIGN_EPI = false, bool SP2 = false>
__device__ __forceinline__ void gemm_phase(PG8_LAS unsigned char* lds, const Gemm g, const Sched& S, const Epi& E, int tid_in) {
    int tid_ = tid_in; asm volatile("" : "+v"(tid_));
    const int tid = tid_, wid = __builtin_amdgcn_readfirstlane(tid >> 6), lane = tid & 63, wr = wid >> 2, wc = wid & 3, fr = lane & 15, fq = lane >> 4;
    const int K = g.K, nt = K / BK;
    unsigned voffA[2], voffB[2];
#pragma unroll
    for (int i = 0; i < 2; ++i) { int R, C; stage_rc(tid * 16 + i * 8192, R, C); const int Rb = Epi::PERM ? ((R & ~31) + perm32(R & 31)) : R;
        voffA[i] = (unsigned)(R * K + C) * 2u; voffB[i] = (unsigned)(Rb * K + C) * 2u; }
    const size_t kstep = (size_t)(BK * 2);
    const size_t hstep = (size_t)HALF * K * 2;
    const size_t tstep = 2 * hstep;
    const unsigned ldsw = (unsigned)wid * 1024u;
    const int aoff = lds_byte(wr * 64 + fr, fq * 8), boff = lds_byte(wc * 32 + fr, fq * 8);
#define PG8_SA(b, h) (((b) * 2 + (h)) * HTB)
#define PG8_SB(b, h) ((4 + (b) * 2 + (h)) * HTB)
#define PG8_STAGE(bufoff, gbase, voff) do { _Pragma("unroll") for (int _i = 0; _i < 2; ++_i) \
        __builtin_amdgcn_global_load_lds((const unsigned*)((const char*)(gbase) + (voff)[_i]), (PG8_LAS unsigned*)(lds + (bufoff) + ldsw + _i * 8192), 16, 0, 0); } while (0)
#define PG8_LDA(dst, b, h) do { _Pragma("unroll") for (int m = 0; m < 4; ++m) _Pragma("unroll") for (int k = 0; k < 2; ++k) dst[m][k] = *(const PG8_LAS bf16x8*)(lds + PG8_SA(b, h) + aoff + m * 2048 + k * 1024); } while (0)
#define PG8_LDB(dst, b, h) do { _Pragma("unroll") for (int n = 0; n < 2; ++n) _Pragma("unroll") for (int k = 0; k < 2; ++k) dst[n][k] = *(const PG8_LAS bf16x8*)(lds + PG8_SB(b, h) + boff + n * 2048 + k * 1024); } while (0)
#define PG8_MMA(ai, bj, At, Bt) do { __builtin_amdgcn_s_setprio(1); _Pragma("unroll") for (int m = 0; m < 4; ++m) _Pragma("unroll") for (int n = 0; n < 2; ++n) _Pragma("unroll") for (int k = 0; k < 2; ++k) \
        acc[ai][bj][m][n] = __builtin_amdgcn_mfma_f32_16x16x32_bf16(Bt[n][k], At[m][k], acc[ai][bj][m][n], 0, 0, 0); __builtin_amdgcn_s_setprio(0); } while (0)
#define PG8_WAIT_V(n) asm volatile("s_waitcnt vmcnt(" #n ")" ::: "memory")
#define PG8_WAIT_L(n) asm volatile("s_waitcnt lgkmcnt(" #n ")" ::: "memory")
#define PG8_BAR __builtin_amdgcn_s_barrier()
#define PG8_SCHED __builtin_amdgcn_sched_barrier(0)
    Unit cur, nxt; int ui = 0;
    if (!S.next(0, cur)) return;
    f32x4 acc[2][2][4][2];
#pragma unroll
    for (int a = 0; a < 2; ++a)
#pragma unroll
        for (int b = 0; b < 2; ++b)
#pragma unroll
            for (int m = 0; m < 4; ++m)
#pragma unroll
                for (int n = 0; n < 2; ++n) acc[a][b][m][n] = (f32x4){0.f, 0.f, 0.f, 0.f};
    bf16x8 At[4][2], B0[2][2], B1[2][2];
    const char* cA = (const char*)g.A + (size_t)cur.pm * tstep; const char* cB = (const char*)g.Bt + (size_t)cur.pn * tstep;
    S.a_ready(cur);
    if constexpr (SP2) {
        PG8_STAGE(PG8_SB(0, 0), cB, voffB); PG8_STAGE(PG8_SB(0, 1), cB + hstep, voffB); PG8_STAGE(PG8_SA(0, 0), cA, voffA); PG8_STAGE(PG8_SA(0, 1), cA + hstep, voffA);
        if (wr == 1) PG8_BAR;
        PG8_WAIT_V(2); PG8_BAR;
        PG8_STAGE(PG8_SB(1, 0), cB + kstep, voffB); PG8_STAGE(PG8_SA(1, 0), cA + kstep, voffA); PG8_STAGE(PG8_SB(1, 1), cB + hstep + kstep, voffB);
        PG8_WAIT_V(6); PG8_BAR;
    } else {
        PG8_STAGE(PG8_SB(0, 0), cB, voffB); PG8_STAGE(PG8_SA(0, 0), cA, voffA); PG8_STAGE(PG8_SB(0, 1), cB + hstep, voffB); PG8_STAGE(PG8_SA(0, 1), cA + hstep, voffA);
        if (wr == 1) PG8_BAR;
        PG8_WAIT_V(4); PG8_BAR;
        PG8_STAGE(PG8_SB(1, 0), cB + kstep, voffB); PG8_STAGE(PG8_SA(1, 0), cA + kstep, voffA); PG8_STAGE(PG8_SB(1, 1), cB + hstep + kstep, voffB);
        PG8_WAIT_V(6); PG8_BAR;
    }
    for (;;) {
        const bool has_next = S.next(ui + 1, nxt);
        const char* nA = has_next ? (const char*)g.A + (size_t)nxt.pm * tstep : cA; const char* nB = has_next ? (const char*)g.Bt + (size_t)nxt.pn * tstep : cB;
        for (int t = 0; t < nt; t += 2) {
            const bool last = (t == nt - 2);
            const char* a1 = cA + (size_t)(t + 1) * kstep;
            const char* a2 = last ? nA : cA + (size_t)(t + 2) * kstep; const char* b2 = last ? nB : cB + (size_t)(t + 2) * kstep;
            const char* a3 = a2 + kstep; const char* b3 = b2 + kstep;
            if (last && has_next) S.a_ready(nxt);
            if constexpr (SP2) {
            PG8_LDB(B0, 0, 0); PG8_LDB(B1, 0, 1); PG8_SCHED; PG8_LDA(At, 0, 0); PG8_STAGE(PG8_SA(1, 1), a1 + hstep, voffA);
            PG8_WAIT_V(8); PG8_WAIT_L(0); PG8_BAR; PG8_MMA(0, 0, At, B0); PG8_MMA(0, 1, At, B1); PG8_BAR; PG8_SCHED;
            PG8_LDA(At, 0, 1); PG8_STAGE(PG8_SB(0, 0), b2, voffB); PG8_STAGE(PG8_SB(0, 1), b2 + hstep, voffB); PG8_STAGE(PG8_SA(0, 0), a2, voffA);
            PG8_WAIT_V(8); PG8_WAIT_L(0); PG8_BAR; PG8_MMA(1, 0, At, B0); PG8_MMA(1, 1, At, B1); PG8_BAR; PG8_SCHED;
            PG8_LDB(B0, 1, 0); PG8_LDB(B1, 1, 1); PG8_SCHED; PG8_LDA(At, 1, 0); PG8_STAGE(PG8_SA(0, 1), a2 + hstep, voffA);
            PG8_WAIT_V(8); PG8_WAIT_L(0); PG8_BAR; PG8_MMA(0, 0, At, B0); PG8_MMA(0, 1, At, B1); PG8_BAR; PG8_SCHED;
            PG8_LDA(At, 1, 1); PG8_STAGE(PG8_SB(1, 0), b3, voffB); PG8_STAGE(PG8_SB(1, 1), b3 + hstep, voffB); PG8_STAGE(PG8_SA(1, 0), a3, voffA);
            PG8_WAIT_V(8); PG8_WAIT_L(0); PG8_BAR; PG8_MMA(1, 0, At, B0); PG8_MMA(1, 1, At, B1); PG8_BAR; PG8_SCHED;
            } else {
            PG8_LDB(B0, 0, 0); PG8_SCHED; PG8_LDA(At, 0, 0); PG8_STAGE(PG8_SA(1, 1), a1 + hstep, voffA);
            PG8_WAIT_L(8); PG8_BAR; PG8_WAIT_L(0); PG8_MMA(0, 0, At, B0); PG8_BAR; PG8_SCHED;
            PG8_LDB(B1, 0, 1); PG8_STAGE(PG8_SB(0, 0), b2, voffB);
            PG8_BAR; PG8_WAIT_L(0); PG8_MMA(0, 1, At, B1); PG8_BAR;
            PG8_LDA(At, 0, 1); PG8_STAGE(PG8_SA(0, 0), a2, voffA);
            PG8_BAR; PG8_WAIT_L(0); PG8_MMA(1, 0, At, B0); PG8_BAR; PG8_SCHED;
            PG8_STAGE(PG8_SB(0, 1), b2 + hstep, voffB);
            PG8_WAIT_V(6); PG8_BAR; PG8_MMA(1, 1, At, B1); PG8_BAR;
            PG8_LDB(B0, 1, 0); PG8_SCHED; PG8_LDA(At, 1, 0); PG8_STAGE(PG8_SA(0, 1), a2 + hstep, voffA);
            PG8_WAIT_L(8); PG8_BAR; PG8_WAIT_L(0); PG8_MMA(0, 0, At, B0); PG8_BAR; PG8_SCHED;
            PG8_LDB(B1, 1, 1); PG8_STAGE(PG8_SB(1, 0), b3, voffB);
            PG8_BAR; PG8_WAIT_L(0); PG8_MMA(0, 1, At, B1); PG8_BAR;
            PG8_LDA(At, 1, 1); PG8_STAGE(PG8_SA(1, 0), a3, voffA);
            PG8_BAR; PG8_WAIT_L(0); PG8_MMA(1, 0, At, B0); PG8_BAR; PG8_SCHED;
            PG8_STAGE(PG8_SB(1, 1), b3 + hstep, voffB);
            PG8_WAIT_V(6); PG8_BAR; PG8_MMA(1, 1, At, B1); PG8_BAR;
            }
        }
        if constexpr (ALIGN_EPI) { if (wr == 0) PG8_BAR; }
        if constexpr (!Epi::AFTER_DRAIN) { E(acc, cur, wr, wc, fr, fq); S.done(cur); }
        if (!has_next) break;
#pragma unroll
        for (int a = 0; a < 2; ++a)
#pragma unroll
            for (int b = 0; b < 2; ++b)
#pragma unroll
                for (int m = 0; m < 4; ++m)
#pragma unroll
                    for (int n = 0; n < 2; ++n) acc[a][b][m][n] = (f32x4){0.f, 0.f, 0.f, 0.f};
        cur = nxt; cA = nA; cB = nB; ++ui;
        if constexpr (ALIGN_EPI) { if (wr == 1) PG8_BAR; }
    }
    PG8_WAIT_V(0);
    if constexpr (!ALIGN_EPI) { if (wr == 0) PG8_BAR; }
    PG8_BAR;
    if constexpr (Epi::AFTER_DRAIN) { E.fused(acc, cur, wr, wc, fr, fq, lds, wid, lane); S.done(cur); }
#undef PG8_SA
#undef PG8_SB
#undef PG8_STAGE
#undef PG8_LDA
#undef PG8_LDB
#undef PG8_MMA
#undef PG8_WAIT_V
#undef PG8_WAIT_L
#undef PG8_BAR
#undef PG8_SCHED
}
}

#ifndef FAST_MOBA
#define FAST_MOBA 2
#endif
#ifndef PG8_SP2
#define PG8_SP2 true
#endif
#ifndef PROBE_SEL
#define PROBE_SEL 0
#endif
constexpr int NWAVES = 8;
constexpr int PH_PER_LAYER = 11;
constexpr int N_PHASES = 2 * PH_PER_LAYER + 1;
constexpr bool ONE_LAUNCH = (MK_ONE_LAUNCH != 0);
static_assert(ONE_LAUNCH, "build with MK_ONE_LAUNCH=1 (build.sh 1): the FIN phase needs its in-phase grid barrier");

constexpr size_t MiB = 1u << 20;
constexpr size_t WS_CTL = 0, CTL_ZERO_BYTES = 1 * MiB;
constexpr size_t WS_W_IN = 1 * MiB;
constexpr size_t WS_W_G = 11 * MiB;
constexpr size_t WS_W_PA = 17 * MiB, WS_W_PB = 18 * MiB, WS_W_PC = 19 * MiB;
constexpr size_t WS_W_O = 20 * MiB;
constexpr size_t WS_W_UP = 22 * MiB;
constexpr size_t WS_W_DN = 30 * MiB;
constexpr size_t WS_XB = 40 * MiB;
constexpr size_t WS_RSTD = 104 * MiB;
constexpr int CW_SSQ = 32768;
static_assert((CW_SSQ + 3 * T) * 4 <= (int)CTL_ZERO_BYTES, "ssq arrays inside the memset region");
constexpr size_t WS_KMEAN = 104 * MiB + 256 * 1024;
constexpr size_t WS_RGA = 104 * MiB + 256 * 1024;
constexpr size_t WS_RGH = 10 * MiB + 512 * 1024;
constexpr int RGC = 128;
constexpr size_t WS_WI = 105 * MiB;
constexpr size_t WS_KI = 106 * MiB;
constexpr size_t WS_ACT = 112 * MiB;
constexpr size_t ACT_STRIDE = (size_t)T * 512 * 2;
constexpr size_t WS_QA = WS_ACT, WS_QB = WS_ACT + ACT_STRIDE, WS_YC = WS_ACT + 2 * ACT_STRIDE, WS_KA = WS_ACT + 3 * ACT_STRIDE, WS_VA = WS_ACT + 4 * ACT_STRIDE,
                 WS_KB = WS_ACT + 5 * ACT_STRIDE, WS_VB = WS_ACT + 6 * ACT_STRIDE, WS_QI = WS_ACT + 7 * ACT_STRIDE, WS_XC = WS_ACT + 8 * ACT_STRIDE;
constexpr size_t WS_G = WS_KA;
constexpr size_t WS_MASK = 400 * MiB;
constexpr size_t WS_MERGED = 400 * MiB;
constexpr size_t WS_H = WS_ACT;
constexpr size_t WS_END = 512 * MiB;
static_assert(WS_XC + ACT_STRIDE == 400 * MiB && WS_G + (size_t)3 * T * 1024 * 2 == 400 * MiB && WS_H + (size_t)T * DFF * 2 <= 400 * MiB, "d_ws map");
constexpr int CW_DYN = 12288;
constexpr int CW_BAR = 4096;

constexpr int RING_OFF = 0, RING_BYTES = 131072;
constexpr int LDSCTL_OFF = RING_BYTES, MISC_OFF = LDSCTL_OFF + 320;
constexpr int LDS_BYTES = 147456;
constexpr int GL_SKEY = 0, GL_QIF = 65536, GL_WQ = GL_QIF + 2048, GL_HIST = GL_WQ + 64, GL_SEL = GL_HIST + 1024, GL_MISC = GL_SEL + 1024, GL_QS = 70656, GL_PS = 73728;
static_assert(GL_MISC + 64 <= GL_QS && GL_QS + 8 * 256 <= GL_PS && GL_PS + 8 * 4096 <= RING_BYTES, "golden LDS map");

#define GAS __attribute__((address_space(1)))
#define LAS __attribute__((address_space(3)))
typedef unsigned short bf16;
typedef unsigned v4u __attribute__((ext_vector_type(4)));
typedef float f32x4 __attribute__((ext_vector_type(4)));
typedef GAS unsigned gu32;
#define RLX_AGENT __ATOMIC_RELAXED, __HIP_MEMORY_SCOPE_AGENT
#define LDS_WAIT() asm volatile("s_waitcnt lgkmcnt(0)" ::: "memory")
#define VM_WAIT() asm volatile("s_waitcnt vmcnt(0)" ::: "memory")
__device__ __forceinline__ float bf2f(bf16 v) { return __uint_as_float(((unsigned)v) << 16); }
__device__ __forceinline__ unsigned pk2(float lo, float hi) { return pg8::cvt_pk_bf16(lo, hi); }
__device__ __forceinline__ unsigned f2bf(float f) { return pg8::cvt_pk_bf16(f, 0.f) & 0xffffu; }
__device__ __forceinline__ float wave_sum(float v) {
#pragma unroll
    for (int o = 1; o < 64; o <<= 1) v += __shfl_xor(v, o);
    return v;
}
__device__ __forceinline__ float wave_max(float v) {
#pragma unroll
    for (int o = 1; o < 64; o <<= 1) v = fmaxf(v, __shfl_xor(v, o));
    return v;
}
__device__ __forceinline__ int t5_bucket(int n) {
    if (n < 16) return n;
    if (n >= 113) return 31;
    return 16 + (n >= 19) + (n >= 21) + (n >= 24) + (n >= 27) + (n >= 31) + (n >= 35) + (n >= 40) + (n >= 46) + (n >= 52) + (n >= 59) + (n >= 67) + (n >= 77) + (n >= 87) + (n >= 99);
}

#define XB_TMO      128
#define XB_XCNT(j)  (256  + 64 * (j))
#define XB_XSUB(j)  (1280 + 64 * (j))
#define XB_XGEN(j)  (2304 + 64 * (j))
#define XB_TOP      3328
#define XB_TOPGEN   3392
#define XCD_BAR_WORDS 3456
#define XB_SPIN_CAP (1u << 22)

__device__ __forceinline__ unsigned xb_ld(unsigned* p)              { return __hip_atomic_load(p, __ATOMIC_RELAXED, __HIP_MEMORY_SCOPE_AGENT); }
__device__ __forceinline__ unsigned xb_add(unsigned* p, unsigned v) { return __hip_atomic_fetch_add(p, v, __ATOMIC_RELAXED, __HIP_MEMORY_SCOPE_AGENT); }
__device__ __forceinline__ unsigned xb_xcc_id() { return (unsigned)__builtin_amdgcn_s_getreg((3 << 11) | 20) & 0xFu; }
#define XB_SPIN(cond, bar) do { unsigned _sp = 0; while (cond) { __builtin_amdgcn_s_sleep(1); \
    if ((++_sp & 255u) == 0u) { if (xb_ld(&(bar)[XB_TMO])) break; if (_sp > XB_SPIN_CAP) { atomicAdd(&(bar)[XB_TMO], 1u); break; } } } } while (0)

struct XcdBarrier { unsigned* bar; unsigned x; volatile LAS unsigned* st; };

__device__ __forceinline__ XcdBarrier xcd_barrier_post(unsigned* bar, volatile LAS unsigned* st) {
    XcdBarrier b; b.bar = bar; b.x = xb_xcc_id(); b.st = st;
    if (threadIdx.x == 0) (void)xb_add(&bar[XB_XCNT(b.x)], 1u);
    return b;
}
__device__ __forceinline__ void xcd_barrier_complete(unsigned* bar, unsigned x, unsigned& nloc, unsigned& nx) {
    const unsigned G = gridDim.x * gridDim.y * gridDim.z;
    unsigned sum, cnt, mine, sp = 0u;
    for (;;) {
        sum = 0u; cnt = 0u; mine = 0u;
#pragma unroll
        for (unsigned j = 0; j < 16; ++j) { const unsigned c = xb_ld(&bar[XB_XCNT(j)]); sum += c; cnt += (c > 0u) ? 1u : 0u; }
        mine = xb_ld(&bar[XB_XCNT(x)]);
        if (sum == G) break;
        __builtin_amdgcn_s_sleep(1);
        if ((++sp & 255u) == 0u) { if (xb_ld(&bar[XB_TMO])) break; if (sp > XB_SPIN_CAP) { atomicAdd(&bar[XB_TMO], 1u); break; } }
    }
    nloc = mine > 0u ? mine : 1u; nx = cnt > 0u ? cnt : 1u;
}
__device__ __forceinline__ void xcd_barrier(const XcdBarrier& b) {
    asm volatile("s_waitcnt vmcnt(0)" ::: "memory");
    __syncthreads();
    if (threadIdx.x == 0) {
        unsigned* bar = b.bar;
        __builtin_amdgcn_s_waitcnt(0);
        unsigned nloc = b.st[0], nx = b.st[1];
        if (nloc == 0u) { xcd_barrier_complete(bar, b.x, nloc, nx); b.st[0] = nloc; b.st[1] = nx; }
        const unsigned old = xb_add(&bar[XB_XSUB(b.x)], 1u);
        const unsigned gen = old / nloc;
        if (old + 1u == (gen + 1u) * nloc) {
            __builtin_amdgcn_fence(__ATOMIC_RELEASE, "agent");
            asm volatile("s_waitcnt vmcnt(0)" ::: "memory");
            const unsigned og = xb_add(&bar[XB_TOP], 1u);
            const unsigned tg = og / nx;
            if (og + 1u == (tg + 1u) * nx) xb_add(&bar[XB_TOPGEN], 1u);
            else XB_SPIN(xb_ld(&bar[XB_TOPGEN]) == tg, bar);
            __builtin_amdgcn_fence(__ATOMIC_ACQUIRE, "agent");
            xb_add(&bar[XB_XGEN(b.x)], 1u);
            asm volatile("s_waitcnt vmcnt(0)" ::: "memory");
        } else {
            XB_SPIN(xb_ld(&bar[XB_XGEN(b.x)]) == gen, bar);
            __builtin_amdgcn_fence(__ATOMIC_ACQUIRE, "agent");
            asm volatile("s_waitcnt vmcnt(0)" ::: "memory");
        }
    }
    __syncthreads();
}

struct Args { const float* in[19]; float* out; unsigned char* ws; int ph_lo, ph_hi; };
struct Frame {
    LAS unsigned char* lds;
    int tid, lane, wave, G, bid;
    int gw;
    const __attribute__((address_space(4))) Args* a;
    unsigned char* ws; float* out;
};
#define WSB(off) ((bf16*)(F.ws + (off)))
#define WSF(off) ((float*)(F.ws + (off)))
#define INP(i) (F.a->in[i])
#define SSQ_MIX(l) ((l) == 0 ? WSF(WS_RSTD) : (float*)(F.ws + WS_CTL) + CW_SSQ + T)
#define SSQ_MLP(l) ((float*)(F.ws + WS_CTL) + CW_SSQ + ((l) == 0 ? 0 : 2 * T))
enum { I_X = 0, I_RELB, I_NMG, I_WIN, I_CONVW, I_CONVB, I_WR, I_BR, I_WI, I_BI, I_LAM, I_WPA, I_WPB, I_WPC, I_WO, I_NLG, I_WUP, I_WDN, I_FNG };

template <class P> __device__ __forceinline__ P* launder_u(P* p) { unsigned lo = (unsigned)(uintptr_t)p, hi = (unsigned)((uintptr_t)p >> 32); asm volatile("" : "+v"(lo), "+v"(hi));
    lo = __builtin_amdgcn_readfirstlane(lo); hi = __builtin_amdgcn_readfirstlane(hi); return (P*)(((uintptr_t)hi << 32) | (uintptr_t)lo); }
__device__ __forceinline__ int launder_i(int v) { asm volatile("" : "+v"(v)); return __builtin_amdgcn_readfirstlane(v); }

__device__ __forceinline__ void transpose_item(const float* W, int ld, int K, int ncol_valid, const float* gain, bf16* WT, LAS float* scr, int item, int nblk, int lane) {
    const int kb = item / nblk, nb = item % nblk, k0 = 64 * kb, n0 = 32 * nb;
    const float gv = gain ? gain[k0 + lane] : 1.0f;
#pragma unroll 8
    for (int i = 0; i < 32; ++i) { const int kk = 2 * i + (lane >> 5); const int n = n0 + (lane & 31);
        float v = (n < ncol_valid) ? W[(size_t)(k0 + kk) * ld + n] : 0.f; v *= __shfl(gv, kk); scr[kk * 33 + (lane & 31)] = v; }
    LDS_WAIT(); asm volatile("" ::: "memory");
    const int c = lane & 7;
#pragma unroll
    for (int j = 0; j < 4; ++j) { const int n = (lane >> 3) + 8 * j; const LAS float* s = scr + (8 * c) * 33 + n;
        v4u o; o.x = pk2(s[0 * 33], s[1 * 33]); o.y = pk2(s[2 * 33], s[3 * 33]); o.z = pk2(s[4 * 33], s[5 * 33]); o.w = pk2(s[6 * 33], s[7 * 33]);
        *(GAS v4u*)(WT + (size_t)(n0 + n) * K + k0 + 8 * c) = o; }
    LDS_WAIT(); asm volatile("" ::: "memory");
}
__device__ __forceinline__ void norm_row(const float* xrow, bf16* orow, float* rstd_out, int lane) {
    const GAS f32x4* xr = (const GAS f32x4*)xrow + lane;
    f32x4 v[4]; float s = 0.f;
#pragma unroll
    for (int j = 0; j < 4; ++j) { v[j] = xr[64 * j]; s += (v[j].x * v[j].x + v[j].y * v[j].y) + (v[j].z * v[j].z + v[j].w * v[j].w); }
    const float ss = wave_sum(s);
    GAS unsigned long long* o8 = (GAS unsigned long long*)orow + lane;
#pragma unroll
    for (int j = 0; j < 4; ++j) o8[64 * j] = (unsigned long long)pk2(v[j].x, v[j].y) | ((unsigned long long)pk2(v[j].z, v[j].w) << 32);
    if (lane == 0) *rstd_out = ss;
}
__device__ __forceinline__ void p_prologue(Frame& F, int l) {
    LAS float* scr = (LAS float*)(F.lds + RING_OFF + F.wave * 16384);
    const int gw = F.bid * NWAVES + F.wave, NGW = F.G * NWAVES;
    const float* w_in = INP(I_WIN) + (size_t)l * DM * DIN; const float* g1 = INP(I_NMG) + l * DM; const float* g2 = INP(I_NLG) + l * DM;
    constexpr int I_BLK = 16 * 16;
    constexpr int I_SP = 16 * 3;
    constexpr int I_G = 16 * 96;
    constexpr int I_P = 8 * 32;
    constexpr int I_O = 16 * 32;
    constexpr int I_UP = 16 * 128;
    constexpr int I_DN = 64 * 32;
    constexpr int NITEMS = 9 * I_BLK + I_SP + I_G + 3 * I_P + I_O + I_UP + I_DN;
    for (int it = gw; it < NITEMS; it += NGW) {
        int r = it;
        if (r < 9 * I_BLK) { const int blk = r / I_BLK; r -= blk * I_BLK;
            const int c0 = blk == 0 ? 0 : blk == 1 ? 1536 : blk == 2 ? 4168 : blk == 3 ? 512 : blk == 4 ? 1024 : blk == 5 ? 2048 : blk == 6 ? 2560 : blk == 7 ? 3072 : 3656;
            transpose_item(w_in + c0, DIN, DM, 512, g1, WSB(WS_W_IN) + (size_t)blk * 512 * DM, scr, r, 16, F.lane); continue; }
        r -= 9 * I_BLK;
        if (r < I_SP) { transpose_item(w_in + 3584, DIN, DM, 72, g1, WSB(WS_W_IN) + (size_t)4608 * DM, scr, r, 3, F.lane); continue; } r -= I_SP;
        if (r < I_G) { transpose_item(w_in + 4680, DIN, DM, 3072, g1, WSB(WS_W_G), scr, r, 96, F.lane); continue; } r -= I_G;
        if (r < I_P) { transpose_item(INP(I_WPA) + (size_t)l * DH * DM, DM, DH, 1024, nullptr, WSB(WS_W_PA), scr, r, 32, F.lane); continue; } r -= I_P;
        if (r < I_P) { transpose_item(INP(I_WPB) + (size_t)l * DH * DM, DM, DH, 1024, nullptr, WSB(WS_W_PB), scr, r, 32, F.lane); continue; } r -= I_P;
        if (r < I_P) { transpose_item(INP(I_WPC) + (size_t)l * DH * DM, DM, DH, 1024, nullptr, WSB(WS_W_PC), scr, r, 32, F.lane); continue; } r -= I_P;
        if (r < I_O) { transpose_item(INP(I_WO) + (size_t)l * DM * DM, DM, DM, 1024, nullptr, WSB(WS_W_O), scr, r, 32, F.lane); continue; } r -= I_O;
        if (r < I_UP) { transpose_item(INP(I_WUP) + (size_t)l * DM * DFF, DFF, DM, DFF, g2, WSB(WS_W_UP), scr, r, 128, F.lane); continue; } r -= I_UP;
        transpose_item(INP(I_WDN) + (size_t)l * DFF * DM, DM, DFF, 1024, nullptr, WSB(WS_W_DN), scr, r, 32, F.lane);
    }
    { GAS v4u* z = (GAS v4u*)(WSB(WS_W_IN) + (size_t)(4608 + 96) * DM); const int gt = F.bid * (NWAVES * 64) + F.tid;
      unsigned zz = 0u; asm volatile("" : "+v"(zz));
      for (int i = gt; i < 160 * DM / 8; i += F.G * NWAVES * 64) z[i] = (v4u){zz, zz, zz, zz}; }
    if (l == 0) for (int m = gw; m < T; m += NGW) norm_row(INP(I_X) + (size_t)m * DM, WSB(WS_XB) + (size_t)m * DM, WSF(WS_RSTD) + m, F.lane);
}
__device__ __forceinline__ void p_norm2(Frame& F) {
    const int gw = F.bid * NWAVES + F.wave, NGW = F.G * NWAVES;
    for (int m = gw; m < T; m += NGW) norm_row(F.out + (size_t)m * DM, WSB(WS_XB) + (size_t)m * DM, WSF(WS_RSTD) + m, F.lane);
}
__device__ __forceinline__ void p_final(Frame& F) {
    const int gw = F.bid * NWAVES + F.wave, NGW = F.G * NWAVES;
    for (int m = gw; m < T; m += NGW) {
        GAS f32x4* xr = (GAS f32x4*)(F.out + (size_t)m * DM) + F.lane; const GAS f32x4* gr = (const GAS f32x4*)INP(I_FNG) + F.lane;
        f32x4 v[4]; float s = 0.f;
#pragma unroll
        for (int j = 0; j < 4; ++j) { v[j] = xr[64 * j]; s += (v[j].x * v[j].x + v[j].y * v[j].y) + (v[j].z * v[j].z + v[j].w * v[j].w); }
        const float rstd = 1.0f / sqrtf(wave_sum(s) * (1.0f / DM) + EPS);
#pragma unroll
        for (int j = 0; j < 4; ++j) xr[64 * j] = v[j] * rstd * gr[64 * j];
    }
}

__device__ __forceinline__ void kmean_unit(Frame& F, int b, int n) {
    const bf16* kp = WSB(WS_KA) + ((size_t)b * SEQ + (size_t)n * 256) * 512 + F.tid; float s = 0.f;
#pragma unroll 8
    for (int j = 0; j < 256; ++j) s += bf2f(kp[(size_t)j * 512]);
    WSF(WS_KMEAN)[((size_t)b * NBLK + n) * 512 + F.tid] = s * (1.0f / 256.0f);
}
__device__ __forceinline__ float sigmoidf_(float v) { return 1.0f / (1.0f + __expf(-v)); }
typedef short bf16x8_t __attribute__((ext_vector_type(8)));
constexpr int RG_XB_STRIDE = 72;
constexpr int RG_XRAW = 0, RG_YRAW = 2048, RG_XB = 4096, RG_PR = RG_XB + 16 * RG_XB_STRIDE * 2, RG_PI = RG_PR + 16 * 64 * 4, RG_WAVE_LDS = RG_PI + 16 * 64 * 4;
static_assert(8 * RG_WAVE_LDS <= RING_BYTES, "rg LDS");
template <bool P2> __device__ __forceinline__ void rg_unit(Frame& F, int l, int b, int c) {
    int d_ = F.lane; asm volatile("" : "+v"(d_));
    const int n = F.wave, d = d_, ch = n * 64 + d;
    LAS unsigned char* wl = F.lds + RING_OFF + n * RG_WAVE_LDS;
    LAS bf16* xraw = (LAS bf16*)(wl + RG_XRAW); LAS bf16* yraw = (LAS bf16*)(wl + RG_YRAW); LAS bf16* xb = (LAS bf16*)(wl + RG_XB); LAS float* prl = (LAS float*)(wl + RG_PR); LAS float* pil = (LAS float*)(wl + RG_PI);
    const int col = d & 15, kq = d >> 4;
    bf16x8_t wfr[2][4], wfi[2][4];
    { const GAS float* prs = (const GAS float*)INP(I_WR) + (((size_t)l * 8 + n) * 64) * 64 + (8 * kq * 64 + col); const GAS float* pis = (const GAS float*)INP(I_WI) + (((size_t)l * 8 + n) * 64) * 64 + (8 * kq * 64 + col);
#pragma unroll
      for (int ks = 0; ks < 2; ++ks)
#pragma unroll
        for (int nb = 0; nb < 4; ++nb) { float tr[8], ti[8];
#pragma unroll
            for (int j = 0; j < 8; ++j) { const int o = (32 * ks + j) * 64 + 16 * nb; tr[j] = prs[o]; ti[j] = pis[o]; }
            union { bf16x8_t v; unsigned u[4]; } ur, ui;
#pragma unroll
            for (int j = 0; j < 4; ++j) { ur.u[j] = pk2(tr[2 * j], tr[2 * j + 1]); ui.u[j] = pk2(ti[2 * j], ti[2 * j + 1]); }
            wfr[ks][nb] = ur.v; wfi[ks][nb] = ui.v; } }
    const float br = ((const GAS float*)INP(I_BR) + l * 512)[ch], bi = ((const GAS float*)INP(I_BI) + l * 512)[ch];
    const float lamv = ((const GAS float*)INP(I_LAM) + l * 512)[ch]; const float sp = log1pf(__expf(-lamv));
    const GAS float* cwp = (const GAS float*)INP(I_CONVW) + (size_t)l * 4 * 512;
    const float cw0 = cwp[ch], cw1 = cwp[512 + ch], cw2 = cwp[1024 + ch], cw3 = cwp[1536 + ch];
    const float cb = ((const GAS float*)INP(I_CONVB) + l * 512)[ch];
    float h = 0.f, A = 1.f;
    if (P2) { const GAS float* ra = (const GAS float*)WSF(WS_RGA) + (size_t)b * RGC * 512; const GAS float* rh = (const GAS float*)WSF(WS_RGH) + (size_t)b * RGC * 512;
        const GAS float* rap = ra + ch; const GAS float* rhp = rh + ch;
        int j = 0;
#pragma unroll 1
        for (; j + 4 <= c; j += 4) { const float a0 = rap[0], a1 = rap[512], a2 = rap[1024], a3 = rap[1536], h0 = rhp[0], h1 = rhp[512], h2 = rhp[1024], h3 = rhp[1536];
            h = a0 * h + h0; h = a1 * h + h1; h = a2 * h + h2; h = a3 * h + h3; rap += 2048; rhp += 2048; }
#pragma unroll 1
        for (; j < c; ++j) { h = rap[0] * h + rhp[0]; rap += 512; rhp += 512; } }
    const int t0 = c * (SEQ / RGC);
    const GAS bf16* xcs = (const GAS bf16*)WSB(WS_XC) + ((size_t)b * SEQ + t0) * 512;
    GAS bf16* ycs = (GAS bf16*)WSB(WS_YC) + ((size_t)b * SEQ + t0) * 512;
    float x1 = 0.f, x2 = 0.f, x3 = 0.f;
    if (t0 > 0) { const GAS bf16* xm = xcs - 3 * 512; x3 = bf2f(xm[ch]); x2 = bf2f(xm[512 + ch]); x1 = bf2f(xm[1024 + ch]); }
    const int tokA = d >> 3, chk = d & 7;
    const size_t goff = (size_t)tokA * 512 + n * 64 + chk * 8;
    const int loff = tokA * 64 + chk * 8;
#pragma unroll 1
    for (int tile = 0; tile < SEQ / RGC / 16; ++tile) {
        const GAS bf16* xt = xcs + (size_t)tile * 16 * 512 + goff; GAS bf16* yt = ycs + (size_t)tile * 16 * 512 + goff;
        { const v4u a0 = *(const GAS v4u*)xt, a1 = *(const GAS v4u*)(xt + 8 * 512); *(LAS v4u*)(xraw + loff) = a0; *(LAS v4u*)(xraw + loff + 8 * 64) = a1; }
        if (P2) { const v4u a0 = *(const GAS v4u*)yt, a1 = *(const GAS v4u*)(yt + 8 * 512); *(LAS v4u*)(yraw + loff) = a0; *(LAS v4u*)(yraw + loff + 8 * 64) = a1; }
        LDS_WAIT(); asm volatile("" ::: "memory");
        float xc[16];
#pragma unroll
        for (int i = 0; i < 16; ++i) { const float xv = bf2f(xraw[i * 64 + d]); xc[i] = cb + cw0 * x3 + cw1 * x2 + cw2 * x1 + cw3 * xv; x3 = x2; x2 = x1; x1 = xv; }
#pragma unroll
        for (int i = 0; i < 16; ++i) xb[i * RG_XB_STRIDE + d] = (bf16)f2bf(xc[i]);
        LDS_WAIT(); asm volatile("" ::: "memory");
        bf16x8_t af[2];
#pragma unroll
        for (int ks = 0; ks < 2; ++ks) af[ks] = *(const LAS bf16x8_t*)(xb + col * RG_XB_STRIDE + 32 * ks + 8 * kq);
        f32x4 ar[4], ai[4];
#pragma unroll
        for (int nb = 0; nb < 4; ++nb) { ar[nb] = (f32x4){0.f, 0.f, 0.f, 0.f}; ai[nb] = (f32x4){0.f, 0.f, 0.f, 0.f};
#pragma unroll
            for (int ks = 0; ks < 2; ++ks) { ar[nb] = __builtin_amdgcn_mfma_f32_16x16x32_bf16(af[ks], wfr[ks][nb], ar[nb], 0, 0, 0); ai[nb] = __builtin_amdgcn_mfma_f32_16x16x32_bf16(af[ks], wfi[ks][nb], ai[nb], 0, 0, 0); } }
        asm volatile("s_nop 15\n\ts_nop 15" : "+v"(ar[0]), "+v"(ar[1]), "+v"(ar[2]), "+v"(ar[3]), "+v"(ai[0]), "+v"(ai[1]), "+v"(ai[2]), "+v"(ai[3]));
#pragma unroll
        for (int nb = 0; nb < 4; ++nb)
#pragma unroll
            for (int r = 0; r < 4; ++r) { prl[(4 * kq + r) * 64 + 16 * nb + col] = ar[nb][r]; pil[(4 * kq + r) * 64 + 16 * nb + col] = ai[nb][r]; }
        LDS_WAIT(); asm volatile("" ::: "memory");
#pragma unroll
        for (int i = 0; i < 16; ++i) {
            const float r = __builtin_amdgcn_rcpf(1.0f + __expf(-(prl[i * 64 + d] + br))), ig = __builtin_amdgcn_rcpf(1.0f + __expf(-(pil[i * 64 + d] + bi)));
            const float la = -8.0f * r * sp; const float a = __expf(la);
            const float x2a = 2.0f * la;
            const float om = (x2a > -0.05f) ? -x2a * (1.0f + x2a * (0.5f + x2a * (0.16666667f + x2a * 0.041666668f))) : 1.0f - a * a;
            const float u = __builtin_amdgcn_sqrtf(om) * (ig * xc[i]);
            h = a * h + u;
            if (!P2) A *= a;
            else { const float y = bf2f(yraw[i * 64 + d]); const float z = 0.7978845608028654f * (y + 0.044715f * y * y * y);
                const float th = 1.0f - 2.0f * __builtin_amdgcn_rcpf(1.0f + __expf(2.0f * z));
                yraw[i * 64 + d] = (bf16)f2bf(h * (0.5f * y * (1.0f + th))); }
        }
        LDS_WAIT(); asm volatile("" ::: "memory");
        if (P2) { const v4u a0 = *(const LAS v4u*)(yraw + loff), a1 = *(const LAS v4u*)(yraw + loff + 8 * 64); *(GAS v4u*)yt = a0; *(GAS v4u*)(yt + 8 * 512) = a1; }
        LDS_WAIT(); asm volatile("" ::: "memory");
    }
    if (!P2) { const size_t o = ((size_t)b * RGC + c) * 512; ((GAS float*)WSF(WS_RGA) + o)[ch] = A; ((GAS float*)WSF(WS_RGH) + o)[ch] = h; }
    __syncthreads();
}

__device__ __forceinline__ float dot64(const LAS float* qs, const bf16* krow) {
    const v4u* kr = (const v4u*)krow; float s = 0.f;
#pragma unroll
    for (int c = 0; c < 8; ++c) { const v4u w = kr[c]; const f32x4 q0 = *(const LAS f32x4*)(qs + c * 8), q1 = *(const LAS f32x4*)(qs + c * 8 + 4);
        s += q0.x * __uint_as_float(w.x << 16) + q0.y * __uint_as_float(w.x & 0xffff0000u) + q0.z * __uint_as_float(w.y << 16) + q0.w * __uint_as_float(w.y & 0xffff0000u)
           + q1.x * __uint_as_float(w.z << 16) + q1.y * __uint_as_float(w.z & 0xffff0000u) + q1.z * __uint_as_float(w.w << 16) + q1.w * __uint_as_float(w.w & 0xffff0000u); }
    return s;
}
__device__ __forceinline__ void moba_unit(Frame& F, int b, int t) {
    const int h = F.wave, lane = F.lane, cur = t >> 8;
    LAS float* qs = (LAS float*)(F.lds + GL_QS) + h * 64; LAS float* ps = (LAS float*)(F.lds + GL_PS) + h * 1024;
    const size_t row = (size_t)b * SEQ + t;
    bf16* qrow = WSB(WS_QA) + row * 512 + h * 64;
    qs[lane] = bf2f(qrow[lane]);
    LDS_WAIT(); asm volatile("" ::: "memory");
    float g = -1e30f;
    if (lane < cur) { const float* km = WSF(WS_KMEAN) + ((size_t)b * NBLK + lane) * 512 + h * 64; float s = 0.f;
#pragma unroll
        for (int d4 = 0; d4 < 16; ++d4) { const f32x4 kv = *(const f32x4*)(km + d4 * 4); const f32x4 qv = *(const LAS f32x4*)(qs + d4 * 4); s += kv.x * qv.x + kv.y * qv.y + kv.z * qv.z + kv.w * qv.w; }
        g = s; }
    int blk[4]; bool ok[4];
#pragma unroll
    for (int i = 0; i < 3; ++i) { const float m = wave_max(g); const unsigned long long bal = __ballot(g == m); const int sel = __ffsll((long long)bal) - 1; blk[i] = sel; ok[i] = sel < cur; if (lane == sel) g = -INFINITY; }
    blk[3] = cur; ok[3] = true;
    const bf16* Kh = WSB(WS_KA) + ((size_t)b * SEQ) * 512 + h * 64; const bf16* Vh = WSB(WS_VA) + ((size_t)b * SEQ) * 512 + h * 64;
    float lg[16];
#pragma unroll
    for (int i = 0; i < 16; ++i) { const int bi = i >> 2; const int pos = blk[bi] * 256 + (i & 3) * 64 + lane; const bool valid = ok[bi] && pos <= t;
        float s = -1e30f;
        if (valid) s = dot64(qs, Kh + (size_t)pos * 512) * 0.125f + INP(I_RELB)[t5_bucket(t - pos) * 16 + h];
        lg[i] = s; if ((i & 3) == 3) asm volatile("" ::: "memory"); }
    float m = lg[0];
#pragma unroll
    for (int i = 1; i < 16; ++i) m = fmaxf(m, lg[i]);
    m = wave_max(m); float sum = 0.f;
#pragma unroll
    for (int i = 0; i < 16; ++i) { const float e = __expf(lg[i] - m); sum += e; ps[i * 64 + lane] = e; }
    sum = wave_sum(sum);
    LDS_WAIT(); asm volatile("" ::: "memory");
    float acc = 0.f;
#pragma unroll
    for (int bi = 0; bi < 4; ++bi) {
        if (!ok[bi]) continue;
        const int base = blk[bi] * 256; const int nk = (bi == 3) ? (t - base + 1) : 256;
        const bf16* vp = Vh + (size_t)base * 512 + lane; const LAS float* pp = ps + bi * 256;
        int kk = 0;
        for (; kk + 8 <= nk; kk += 8) { float pv[8], vv[8];
#pragma unroll
            for (int j = 0; j < 8; ++j) { pv[j] = pp[kk + j]; vv[j] = bf2f(vp[(size_t)(kk + j) * 512]); }
#pragma unroll
            for (int j = 0; j < 8; ++j) acc += pv[j] * vv[j]; }
        for (; kk < nk; ++kk) acc += pp[kk] * bf2f(vp[(size_t)kk * 512]);
    }
    qrow[lane] = (bf16)f2bf(acc / sum);
}
__device__ __forceinline__ void dsa_unit(Frame& F, int b, int t) {
    const int tid = F.tid, lane = F.lane, h = F.wave;
    LAS unsigned* skey = (LAS unsigned*)(F.lds + GL_SKEY); LAS float* qif = (LAS float*)(F.lds + GL_QIF); LAS float* wq = (LAS float*)(F.lds + GL_WQ);
    LAS unsigned* hist = (LAS unsigned*)(F.lds + GL_HIST); LAS int* sel = (LAS int*)(F.lds + GL_SEL); LAS unsigned* misc = (LAS unsigned*)(F.lds + GL_MISC);
    const size_t row = (size_t)b * SEQ + t; const int n = t + 1;
    __syncthreads();
    qif[tid] = bf2f(WSB(WS_QI)[row * 512 + tid]);
    if (tid < 8) wq[tid] = WSF(WS_WI)[row * 8 + tid];
    if (tid < 16) misc[tid] = 0u;
    __syncthreads();
    if (n > 256) {
        const bf16* kib = WSB(WS_KI) + ((size_t)b * SEQ) * 64;
        for (int s = tid; s < n; s += NWAVES * 64) {
            float kf[64];
            { const v4u* kr = (const v4u*)(kib + (size_t)s * 64);
#pragma unroll
              for (int c = 0; c < 8; ++c) { const v4u w = kr[c]; kf[c * 8 + 0] = __uint_as_float(w.x << 16); kf[c * 8 + 1] = __uint_as_float(w.x & 0xffff0000u); kf[c * 8 + 2] = __uint_as_float(w.y << 16); kf[c * 8 + 3] = __uint_as_float(w.y & 0xffff0000u);
                  kf[c * 8 + 4] = __uint_as_float(w.z << 16); kf[c * 8 + 5] = __uint_as_float(w.z & 0xffff0000u); kf[c * 8 + 6] = __uint_as_float(w.w << 16); kf[c * 8 + 7] = __uint_as_float(w.w & 0xffff0000u); } }
            float score = 0.f;
#pragma unroll 1
            for (int hh = 0; hh < 8; ++hh) { float dsum = 0.f;
#pragma unroll
                for (int d4 = 0; d4 < 16; ++d4) { const f32x4 q = *(const LAS f32x4*)(qif + hh * 64 + d4 * 4); dsum += q.x * kf[d4 * 4] + q.y * kf[d4 * 4 + 1] + q.z * kf[d4 * 4 + 2] + q.w * kf[d4 * 4 + 3]; }
                score += wq[hh] * fmaxf(dsum, 0.f); asm volatile("" ::: "memory"); }
            score *= 0.04419417382415922f;
            if (score == 0.f) score = 0.f;
            const unsigned u = __float_as_uint(score);
            skey[s] = (u & 0x80000000u) ? ~u : (u | 0x80000000u);
        }
        __syncthreads();
        unsigned prefix = 0u; unsigned kneed = 256u, neq = 0u;
#pragma unroll
        for (int pass = 0; pass < 4; ++pass) {
            const int shift = 24 - 8 * pass;
            if (tid < 256) hist[tid] = 0u;
            __syncthreads();
            for (int s = tid; s < n; s += NWAVES * 64) { const unsigned key = skey[s]; const bool match = (pass == 0) ? true : ((key >> ((shift + 8) & 31)) == prefix);
                if (match) __hip_atomic_fetch_add(hist + ((key >> shift) & 255u), 1u, __ATOMIC_RELAXED, __HIP_MEMORY_SCOPE_WORKGROUP); }
            __syncthreads();
            if (h == 0) {
                const unsigned c0 = hist[4 * lane], c1 = hist[4 * lane + 1], c2 = hist[4 * lane + 2], c3 = hist[4 * lane + 3]; const unsigned tot = c0 + c1 + c2 + c3;
                unsigned S = tot;
#pragma unroll
                for (int o = 1; o < 64; o <<= 1) { const unsigned v = __shfl_down(S, o); if (lane + o < 64) S += v; }
                const unsigned above = S - tot;
                if (above < kneed && kneed <= S) { unsigned a = above; unsigned bsel, cnt;
                    if (a + c3 >= kneed) { bsel = 3; cnt = c3; } else { a += c3; if (a + c2 >= kneed) { bsel = 2; cnt = c2; } else { a += c2; if (a + c1 >= kneed) { bsel = 1; cnt = c1; } else { a += c1; bsel = 0; cnt = c0; } } }
                    misc[0] = 4u * lane + bsel; misc[1] = kneed - a; misc[2] = cnt; }
            }
            __syncthreads();
            prefix = (prefix << 8) | misc[0]; kneed = misc[1]; neq = misc[2];
            __syncthreads();
        }
        const unsigned Tk = prefix;
        for (int s = tid; s < n; s += NWAVES * 64) { const unsigned key = skey[s];
            if (key > Tk || (key == Tk && neq == kneed)) { const unsigned idx = __hip_atomic_fetch_add(misc + 8, 1u, __ATOMIC_RELAXED, __HIP_MEMORY_SCOPE_WORKGROUP); if (idx < 256u) sel[idx] = s; } }
        __syncthreads();
        if (neq != kneed && tid == 0) { unsigned c = misc[8]; unsigned need = kneed; for (int s = 0; s < n && need > 0u && c < 256u; ++s) if (skey[s] == Tk) { sel[c++] = s; --need; } }
    } else {
        if (tid < 256) sel[tid] = (tid <= t) ? tid : -1;
    }
    __syncthreads();
    LAS float* qs = (LAS float*)(F.lds + GL_QS) + h * 64; LAS float* ps = (LAS float*)(F.lds + GL_PS) + h * 1024;
    bf16* qrow = WSB(WS_QB) + row * 512 + h * 64;
    qs[lane] = bf2f(qrow[lane]);
    LDS_WAIT(); asm volatile("" ::: "memory");
    const bf16* Kh = WSB(WS_KB) + ((size_t)b * SEQ) * 512 + h * 64; const bf16* Vh = WSB(WS_VB) + ((size_t)b * SEQ) * 512 + h * 64;
    float lg[4];
#pragma unroll
    for (int i = 0; i < 4; ++i) { const int pos = sel[i * 64 + lane]; float s = -1e30f;
        if (pos >= 0) s = dot64(qs, Kh + (size_t)pos * 512) * 0.125f + INP(I_RELB)[t5_bucket(t - pos) * 16 + 8 + h];
        lg[i] = s; }
    float m = wave_max(fmaxf(fmaxf(lg[0], lg[1]), fmaxf(lg[2], lg[3]))); float sum = 0.f;
#pragma unroll
    for (int i = 0; i < 4; ++i) { const float e = __expf(lg[i] - m); sum += e; ps[i * 64 + lane] = e; }
    sum = wave_sum(sum);
    LDS_WAIT(); asm volatile("" ::: "memory");
    float acc = 0.f; const int nk = n < 256 ? n : 256;
    int kk = 0;
    for (; kk + 8 <= nk; kk += 8) { float pv[8], vv[8];
#pragma unroll
        for (int j = 0; j < 8; ++j) { const int pos = sel[kk + j]; pv[j] = ps[kk + j]; vv[j] = bf2f(Vh[(size_t)pos * 512 + lane]); }
#pragma unroll
        for (int j = 0; j < 8; ++j) acc += pv[j] * vv[j]; }
    for (; kk < nk; ++kk) { const int pos = sel[kk]; acc += ps[kk] * bf2f(Vh[(size_t)pos * 512 + lane]); }
    qrow[lane] = (bf16)f2bf(acc / sum);
}

typedef float f32x16 __attribute__((ext_vector_type(16)));
constexpr int AT_KROW = 144, AT_VROW = 136;
constexpr int AT_KBUF = 64 * AT_KROW, AT_VBUF = 64 * AT_VROW;
constexpr int AT_K0 = 0, AT_V0 = 2 * AT_KBUF, AT_BT = 36864, AT_OST = 40960;
constexpr float AT_C2 = 0.125f * 1.4426950408889634f;
constexpr float AT_THR = 8.0f;
constexpr float LOG2E = 1.4426950408889634f;
__device__ __forceinline__ int crow_(int r, int hi) { return (r & 3) + 8 * (r >> 2) + 4 * hi; }
#define MFMA_FENCE2(a, b) asm volatile("s_nop 15\n\ts_nop 15" : "+v"(a), "+v"(b))

__device__ __forceinline__ void at_load(const GAS bf16* Kh, const GAS bf16* Vh, int tile, int tid, v4u& kr, v4u& vr) {
    kr = *(const GAS v4u*)(Kh + (size_t)(tile * 64 + (tid >> 3)) * 512 + (tid & 7) * 8);
    vr = *(const GAS v4u*)(Vh + (size_t)(tile * 64 + (tid >> 3)) * 512 + (tid & 7) * 8);
}
__device__ __forceinline__ void at_store(LAS unsigned char* kb, LAS unsigned char* vb, int tid, const v4u kr, const v4u vr) {
    *(LAS v4u*)(kb + (tid >> 3) * AT_KROW + (tid & 7) * 16) = kr;
    LAS bf16* vt = (LAS bf16*)(vb + ((tid & 7) * 8) * AT_VROW) + (tid >> 3);
    constexpr int RS = AT_VROW / 2;
    vt[0 * RS] = (bf16)(vr.x & 0xffffu); vt[1 * RS] = (bf16)(vr.x >> 16); vt[2 * RS] = (bf16)(vr.y & 0xffffu); vt[3 * RS] = (bf16)(vr.y >> 16);
    vt[4 * RS] = (bf16)(vr.z & 0xffffu); vt[5 * RS] = (bf16)(vr.z >> 16); vt[6 * RS] = (bf16)(vr.w & 0xffffu); vt[7 * RS] = (bf16)(vr.w >> 16);
}
__device__ __forceinline__ void at_qk(f32x16& p0, f32x16& p1, const LAS unsigned char* kb, const bf16x8_t (&qf)[4], int r32, int hi) {
    const LAS unsigned char* kp = kb + r32 * AT_KROW + hi * 16;
    bf16x8_t k0[4], k1[4];
#pragma unroll
    for (int s = 0; s < 4; ++s) { k0[s] = *(const LAS bf16x8_t*)(kp + s * 32); k1[s] = *(const LAS bf16x8_t*)(kp + 32 * AT_KROW + s * 32); }
    asm volatile("s_waitcnt lgkmcnt(0)" : "+v"(k0[0]), "+v"(k0[1]), "+v"(k0[2]), "+v"(k0[3]), "+v"(k1[0]), "+v"(k1[1]), "+v"(k1[2]), "+v"(k1[3]) :: "memory");
#pragma unroll
    for (int s = 0; s < 4; ++s) { p0 = __builtin_amdgcn_mfma_f32_32x32x16_bf16(k0[s], qf[s], p0, 0, 0, 0); p1 = __builtin_amdgcn_mfma_f32_32x32x16_bf16(k1[s], qf[s], p1, 0, 0, 0); }
}
__device__ __forceinline__ void at_qk_m(f32x16& p0, f32x16& p1, const LAS unsigned char* kb, const bf16x8_t (&qf)[4], const bf16x8_t oneA, const bf16x8_t mB, int r32, int hi) {
    const LAS unsigned char* kp = kb + r32 * AT_KROW + hi * 16;
    bf16x8_t k0[4], k1[4];
#pragma unroll
    for (int s = 0; s < 4; ++s) { k0[s] = *(const LAS bf16x8_t*)(kp + s * 32); k1[s] = *(const LAS bf16x8_t*)(kp + 32 * AT_KROW + s * 32); }
    p0 = __builtin_amdgcn_mfma_f32_32x32x16_bf16(oneA, mB, p0, 0, 0, 0); p1 = __builtin_amdgcn_mfma_f32_32x32x16_bf16(oneA, mB, p1, 0, 0, 0);
    asm volatile("s_waitcnt lgkmcnt(0)" : "+v"(k0[0]), "+v"(k0[1]), "+v"(k0[2]), "+v"(k0[3]), "+v"(k1[0]), "+v"(k1[1]), "+v"(k1[2]), "+v"(k1[3]) :: "memory");
#pragma unroll
    for (int s = 0; s < 4; ++s) { p0 = __builtin_amdgcn_mfma_f32_32x32x16_bf16(k0[s], qf[s], p0, 0, 0, 0); p1 = __builtin_amdgcn_mfma_f32_32x32x16_bf16(k1[s], qf[s], p1, 0, 0, 0); }
}
__device__ __forceinline__ void at_pv(f32x16& o0, f32x16& o1, const LAS unsigned char* vb, const bf16x8_t (&pb)[4], int r32, int hi) {
    const LAS unsigned char* vp = vb + r32 * AT_VROW + hi * 8;
    union U { bf16x8_t v; unsigned long long u[2]; }; U a0[4], a1[4];
#pragma unroll
    for (int sg = 0; sg < 4; ++sg) { const int kvo = (32 * (sg >> 1) + 16 * (sg & 1)) * 2;
        a0[sg].u[0] = *(const LAS unsigned long long*)(vp + kvo); a0[sg].u[1] = *(const LAS unsigned long long*)(vp + kvo + 16);
        a1[sg].u[0] = *(const LAS unsigned long long*)(vp + 32 * AT_VROW + kvo); a1[sg].u[1] = *(const LAS unsigned long long*)(vp + 32 * AT_VROW + kvo + 16); }
    asm volatile("s_waitcnt lgkmcnt(0)" : "+v"(a0[0].v), "+v"(a0[1].v), "+v"(a0[2].v), "+v"(a0[3].v), "+v"(a1[0].v), "+v"(a1[1].v), "+v"(a1[2].v), "+v"(a1[3].v) :: "memory");
#pragma unroll
    for (int sg = 0; sg < 4; ++sg) { o0 = __builtin_amdgcn_mfma_f32_32x32x16_bf16(a0[sg].v, pb[sg], o0, 0, 0, 0); o1 = __builtin_amdgcn_mfma_f32_32x32x16_bf16(a1[sg].v, pb[sg], o1, 0, 0, 0); }
}
__device__ __forceinline__ float max3_(float a, float b, float c) { float r; asm("v_max3_f32 %0, %1, %2, %3" : "=v"(r) : "v"(a), "v"(b), "v"(c)); return r; }
__device__ __forceinline__ unsigned and_sel(float p, unsigned w, int bit) { int t; asm("v_bfe_i32 %0, %1, %2, 1" : "=v"(t) : "v"(w), "n"(bit)); return __float_as_uint(p) & (unsigned)t; }

template <int MODE  , bool DRY = false  >
__device__ __forceinline__ void attn_unit(Frame& F, int b, int h, int qt) {
    int tid_ = F.tid; asm volatile("" : "+v"(tid_));
    const int tid = tid_, lane = tid & 63, wave = F.wave, r32 = lane & 31, hi = lane >> 5;
    LAS unsigned char* L = F.lds + RING_OFF;
    LAS float* bt = (LAS float*)(L + AT_BT);
    const GAS bf16* Qg = (const GAS bf16*)WSB(MODE == 0 ? WS_QA : WS_QB); const GAS bf16* Kg = (const GAS bf16*)WSB(MODE == 0 ? WS_KA : WS_KB); const GAS bf16* Vg = (const GAS bf16*)WSB(MODE == 0 ? WS_VA : WS_VB);
    const size_t rowb = (size_t)b * SEQ;
    const GAS bf16* Kh = Kg + rowb * 512 + h * 64; const GAS bf16* Vh = Vg + rowb * 512 + h * 64;
    const int q0w = qt * 256 + wave * 32, q = q0w + r32;
    const int NT = 4 * qt + 4;
    __syncthreads();
    if (tid < 128) { const GAS float* rb = (const GAS float*)INP(I_RELB) + (MODE * 8 + h); bt[tid] = (rb[t5_bucket(tid) * 16] - rb[31 * 16]) * LOG2E; }
    bf16x8_t qf[4];
    { const GAS bf16* qp = Qg + (rowb + q) * 512 + h * 64 + hi * 8;
#pragma unroll
      for (int s = 0; s < 4; ++s) qf[s] = *(const GAS bf16x8_t*)(qp + s * 16); }
    unsigned mlo = 0u, mhi = 0u;
    if (MODE == 0) {
        { const int n = tid >> 3, c8 = (tid & 7) * 8; const GAS float* km = (const GAS float*)WSF(WS_KMEAN) + ((size_t)b * NBLK + n) * 512 + h * 64 + c8;
          const f32x4 a = *(const GAS f32x4*)km, c = *(const GAS f32x4*)(km + 4);
          const unsigned h0 = pk2(a.x, a.y), h1 = pk2(a.z, a.w), h2 = pk2(c.x, c.y), h3 = pk2(c.z, c.w);
          const unsigned l0 = pk2(a.x - __uint_as_float(h0 << 16), a.y - __uint_as_float(h0 & 0xffff0000u)), l1 = pk2(a.z - __uint_as_float(h1 << 16), a.w - __uint_as_float(h1 & 0xffff0000u)),
                         l2 = pk2(c.x - __uint_as_float(h2 << 16), c.y - __uint_as_float(h2 & 0xffff0000u)), l3 = pk2(c.z - __uint_as_float(h3 << 16), c.w - __uint_as_float(h3 & 0xffff0000u));
          *(LAS v4u*)(L + AT_K0 + n * AT_KROW + (tid & 7) * 16) = (v4u){h0, h1, h2, h3}; *(LAS v4u*)(L + AT_K0 + AT_KBUF + n * AT_KROW + (tid & 7) * 16) = (v4u){l0, l1, l2, l3}; }
        __syncthreads();
        f32x16 g0 = {0.f, 0.f, 0.f, 0.f, 0.f, 0.f, 0.f, 0.f, 0.f, 0.f, 0.f, 0.f, 0.f, 0.f, 0.f, 0.f}, g1 = g0;
        at_qk(g0, g1, L + AT_K0, qf, r32, hi); at_qk(g0, g1, L + AT_K0 + AT_KBUF, qf, r32, hi);
        MFMA_FENCE2(g0, g1);
#pragma unroll
        for (int r = 0; r < 16; ++r) { if (crow_(r, hi) >= qt) g0[r] = -INFINITY; if (32 + crow_(r, hi) >= qt) g1[r] = -INFINITY; }
#pragma unroll
        for (int it = 0; it < 3; ++it) {
            float bv = -INFINITY; int bn = 64;
#pragma unroll
            for (int r = 0; r < 16; ++r) if (g0[r] > bv) { bv = g0[r]; bn = crow_(r, hi); }
#pragma unroll
            for (int r = 0; r < 16; ++r) if (g1[r] > bv) { bv = g1[r]; bn = 32 + crow_(r, hi); }
            const float pv = __shfl_xor(bv, 32); const int pn = __shfl_xor(bn, 32);
            const bool tp = (pv > bv) || (pv == bv && pn < bn);
            const float wv = tp ? pv : bv; const int wn = tp ? pn : bn;
            if (wv > -INFINITY) { if (wn < 32) mlo |= 1u << wn; else mhi |= 1u << (wn - 32); }
#pragma unroll
            for (int r = 0; r < 16; ++r) { if (crow_(r, hi) == wn) g0[r] = -INFINITY; if (32 + crow_(r, hi) == wn) g1[r] = -INFINITY; }
        }
        __syncthreads();
    }
    v4u krA, vrA, krB, vrB; unsigned wlA = 0u, whA = 0u, wlB = 0u, whB = 0u;
    const GAS unsigned* mrow = (const GAS unsigned*)(F.ws + WS_MASK) + (rowb + q) * 512;
    at_load(Kh, Vh, 0, tid, krA, vrA);
    unsigned wl_c = 0u, wh_c = 0u;
    if (MODE == 1) { wl_c = mrow[0]; wh_c = mrow[1]; }
    at_store(L + AT_K0, L + AT_V0, tid, krA, vrA);
    at_load(Kh, Vh, 1, tid, krA, vrA);
    if (MODE == 1) { wlA = mrow[2]; whA = mrow[3]; }
    __syncthreads();
    float m = -1e30f, lsum = 0.f;
    f32x16 o0 = {0.f, 0.f, 0.f, 0.f, 0.f, 0.f, 0.f, 0.f, 0.f, 0.f, 0.f, 0.f, 0.f, 0.f, 0.f, 0.f}, o1 = o0;
    auto step = [&](int t, v4u& krS, v4u& vrS, unsigned& wlS, unsigned& whS, v4u& krN, v4u& vrN, unsigned& wlN, unsigned& whN) __attribute__((always_inline)) {
        const int cur = t & 1;
        unsigned wlo = wl_c, whi = wh_c;
        if (t + 2 < NT) { at_load(Kh, Vh, t + 2, tid, krN, vrN); if (MODE == 1) { wlN = mrow[2 * (t + 2)]; whN = mrow[2 * (t + 2) + 1]; } }
        if (MODE == 0) {
            if (t < 4 * qt) { const int blk = t >> 2; const unsigned bit = (blk < 32 ? (mlo >> blk) : (mhi >> (blk - 32))) & 1u; wlo = whi = bit ? 0xffffffffu : 0u; }
            else { const int nall = q - t * 64 + 1;
                wlo = nall >= 32 ? 0xffffffffu : (nall <= 0 ? 0u : ((1u << nall) - 1u)); whi = nall >= 64 ? 0xffffffffu : (nall <= 32 ? 0u : ((1u << (nall - 32)) - 1u)); }
        }
        if (__any((wlo | whi) != 0u)) {
            const LAS unsigned char* kb = L + AT_K0 + cur * AT_KBUF; const LAS unsigned char* vb = L + AT_V0 + cur * AT_VBUF;
            const bool and_mask = (MODE == 1) || (t >= 4 * qt);
            const float ci = (!and_mask && wlo == 0u) ? -1e9f : 0.f;
            f32x16 p0 = {ci, ci, ci, ci, ci, ci, ci, ci, ci, ci, ci, ci, ci, ci, ci, ci}, p1 = p0;
            at_qk(p0, p1, kb, qf, r32, hi);
            MFMA_FENCE2(p0, p1);
            const bool near = (t * 64 + 191 > q0w);
            float mx; float sc = AT_C2;
            if (near) {
#pragma unroll
                for (int r = 0; r < 16; ++r) { const int d0 = q - (t * 64 + crow_(r, hi)), d1 = d0 - 32;
                    const float b0 = ((unsigned)d0 < 128u) ? bt[d0] : 0.f, b1 = ((unsigned)d1 < 128u) ? bt[d1] : 0.f;
                    p0[r] = p0[r] * AT_C2 + b0; p1[r] = p1[r] * AT_C2 + b1; }
                sc = 1.0f;
            }
            { float ma = max3_(p0[0], p1[0], p0[1]), mb = max3_(p1[1], p0[2], p1[2]), mc = max3_(p0[3], p1[3], p0[4]), md = max3_(p1[4], p0[5], p1[5]);
              ma = max3_(ma, p0[6], p1[6]); mb = max3_(mb, p0[7], p1[7]); mc = max3_(mc, p0[8], p1[8]); md = max3_(md, p0[9], p1[9]);
              ma = max3_(ma, p0[10], p1[10]); mb = max3_(mb, p0[11], p1[11]); mc = max3_(mc, p0[12], p1[12]); md = max3_(md, p0[13], p1[13]);
              ma = max3_(ma, p0[14], p1[14]); mb = max3_(mb, p0[15], p1[15]); mx = max3_(ma, mb, mc); mx = max3_(mx, md, md); }
            mx = max3_(mx, __shfl_xor(mx, 32), mx) * sc;
            if (__any(mx > m + AT_THR)) {
                const float mn = fmaxf(m, mx); const float al = __builtin_amdgcn_exp2f(m - mn);
                MFMA_FENCE2(o0, o1);
#pragma unroll
                for (int r = 0; r < 16; ++r) { o0[r] *= al; o1[r] *= al; }
                lsum *= al; m = mn;
            }
            float ls = 0.f;
            if (and_mask) {
                const unsigned wl = wlo >> (4 * hi), wh = whi >> (4 * hi);
                float lq[4] = {0.f, 0.f, 0.f, 0.f};
#pragma unroll
                for (int r = 0; r < 16; ++r) { const int cb = (r & 3) + 8 * (r >> 2);
                    const float e0 = __uint_as_float(and_sel(__builtin_amdgcn_exp2f(__builtin_fmaf(p0[r], sc, -m)), wl, cb)), e1 = __uint_as_float(and_sel(__builtin_amdgcn_exp2f(__builtin_fmaf(p1[r], sc, -m)), wh, cb));
                    p0[r] = e0; p1[r] = e1; lq[r & 1] += e0; lq[2 + (r & 1)] += e1; }
                ls = (lq[0] + lq[1]) + (lq[2] + lq[3]);
            } else {
#pragma unroll
                for (int r = 0; r < 16; ++r) { const float e0 = __builtin_amdgcn_exp2f(__builtin_fmaf(p0[r], sc, -m)), e1 = __builtin_amdgcn_exp2f(__builtin_fmaf(p1[r], sc, -m));
                    p0[r] = e0; p1[r] = e1; ls += e0 + e1; }
            }
            lsum += ls;
            bf16x8_t pb[4];
#pragma unroll
            for (int sg = 0; sg < 4; ++sg) { union { bf16x8_t v; unsigned u[4]; } pk;
#pragma unroll
                for (int j = 0; j < 4; ++j) { const int r = 8 * (sg & 1) + 2 * j; pk.u[j] = (sg < 2) ? pg8::cvt_pk_bf16(p0[r], p0[r + 1]) : pg8::cvt_pk_bf16(p1[r], p1[r + 1]); }
                pb[sg] = pk.v; }
            at_pv(o0, o1, vb, pb, r32, hi);
        }
        if (t + 1 < NT) at_store(L + AT_K0 + (cur ^ 1) * AT_KBUF, L + AT_V0 + (cur ^ 1) * AT_VBUF, tid, krS, vrS);
        wl_c = wlS; wh_c = whS;
        __syncthreads();
    };
#pragma unroll 1
    for (int t = 0; t < NT; t += 2) {
        step(t, krA, vrA, wlA, whA, krB, vrB, wlB, whB);
        step(t + 1, krB, vrB, wlB, whB, krA, vrA, wlA, whA);
    }
    MFMA_FENCE2(o0, o1);
    lsum += __shfl_xor(lsum, 32);
    const float inv = 1.0f / lsum;
    LAS bf16* ost = (LAS bf16*)(L + AT_OST + wave * 4096);
#pragma unroll
    for (int r = 0; r < 16; ++r) { ost[r32 * 64 + crow_(r, hi)] = (bf16)f2bf(o0[r] * inv); ost[r32 * 64 + 32 + crow_(r, hi)] = (bf16)f2bf(o1[r] * inv); }
    LDS_WAIT(); asm volatile("" ::: "memory");
    GAS bf16* Og = (GAS bf16*)WSB(MODE == 0 ? WS_QA : WS_QB) + (rowb + q0w) * 512 + h * 64;
#pragma unroll
    for (int i = 0; i < 4; ++i) { const int c = i * 64 + lane, row = c >> 3, ch = c & 7; const v4u ov = *(const LAS v4u*)(ost + row * 64 + ch * 8); if (!DRY) *(GAS v4u*)(Og + (size_t)row * 512 + ch * 8) = ov; else if (ov.x == 0x12345678u && ov.y == 0x9abcdef0u) *(GAS v4u*)(Og + (size_t)row * 512 + ch * 8) = ov; }
}

constexpr int DA_K0 = 0, DA_V0 = 3 * AT_KBUF, DA_BT = DA_V0 + 2 * AT_VBUF, DA_OST = 49152;
static_assert(DA_BT + 512 <= DA_OST && DA_OST + 8 * 4096 <= RING_BYTES, "dsa attention LDS map");
__device__ __forceinline__ v4u at_load_k(const GAS bf16* Kh, int tile, int tid) { return *(const GAS v4u*)(Kh + (size_t)(tile * 64 + (tid >> 3)) * 512 + (tid & 7) * 8); }
__device__ __forceinline__ v4u at_load_v(const GAS bf16* Vh, int tile, int tid) { return *(const GAS v4u*)(Vh + (size_t)(tile * 64 + (tid & 63)) * 512 + (tid >> 6) * 8); }
__device__ __forceinline__ void at_store_k(LAS unsigned char* kb, int tid, const v4u kr) { *(LAS v4u*)(kb + (tid >> 3) * AT_KROW + (tid & 7) * 16) = kr; }
__device__ __forceinline__ void at_store_v(LAS unsigned char* vb, int tid, const v4u vr) {
    LAS bf16* vt = (LAS bf16*)(vb + ((tid >> 6) * 8) * AT_VROW) + (tid & 63); constexpr int RS = AT_VROW / 2;
    vt[0 * RS] = (bf16)(vr.x & 0xffffu); vt[1 * RS] = (bf16)(vr.x >> 16); vt[2 * RS] = (bf16)(vr.y & 0xffffu); vt[3 * RS] = (bf16)(vr.y >> 16);
    vt[4 * RS] = (bf16)(vr.z & 0xffffu); vt[5 * RS] = (bf16)(vr.z >> 16); vt[6 * RS] = (bf16)(vr.w & 0xffffu); vt[7 * RS] = (bf16)(vr.w >> 16);
}
struct DsaState { float m, lsum; f32x16 o0, o1; unsigned wc_lo, wc_hi, wn_lo, wn_hi; };
__device__ __forceinline__ void dsa_step(DsaState& S, f32x16& P0, f32x16& P1, f32x16& Pn0, f32x16& Pn1, int t, int NT, LAS unsigned char* L, const LAS float* bt, const bf16x8_t (&qf)[4],
                                         const GAS bf16* Kh, const GAS bf16* Vh, const GAS unsigned* mrow, int tid, int r32, int hi, int q, int q0w) {
    v4u krn, vrn; unsigned wq_lo = 0u, wq_hi = 0u;
    const bool has1 = (t + 1 < NT), has2 = (t + 2 < NT);
    if (has2) { krn = at_load_k(Kh, t + 2, tid); wq_lo = mrow[2 * (t + 2)]; wq_hi = mrow[2 * (t + 2) + 1]; }
    if (has1) vrn = at_load_v(Vh, t + 1, tid);
    if (has1 && __any((S.wn_lo | S.wn_hi) != 0u)) {
        Pn0 = (f32x16){0.f, 0.f, 0.f, 0.f, 0.f, 0.f, 0.f, 0.f, 0.f, 0.f, 0.f, 0.f, 0.f, 0.f, 0.f, 0.f}; Pn1 = Pn0;
        at_qk(Pn0, Pn1, L + DA_K0 + ((t + 1) % 3) * AT_KBUF, qf, r32, hi);
    }
    if (__any((S.wc_lo | S.wc_hi) != 0u)) {
        const LAS unsigned char* vb = L + DA_V0 + (t & 1) * AT_VBUF;
        MFMA_FENCE2(P0, P1);
        const bool near = (t * 64 + 191 > q0w);
        float sc = AT_C2;
        if (near) {
#pragma unroll
            for (int r = 0; r < 16; ++r) { const int d0 = q - (t * 64 + crow_(r, hi)), d1 = d0 - 32;
                const float b0 = ((unsigned)d0 < 128u) ? bt[d0] : 0.f, b1 = ((unsigned)d1 < 128u) ? bt[d1] : 0.f;
                P0[r] = P0[r] * AT_C2 + b0; P1[r] = P1[r] * AT_C2 + b1; }
            sc = 1.0f;
        }
        float mx = max3_(P0[0], P1[0], P0[1]), mx2 = max3_(P1[1], P0[2], P1[2]);
#pragma unroll
        for (int r = 3; r < 15; r += 2) { mx = max3_(mx, P0[r], P1[r]); mx2 = max3_(mx2, P0[r + 1], P1[r + 1]); }
        mx = max3_(mx, P0[15], P1[15]); mx = max3_(mx, mx2, mx2);
        mx = max3_(mx, __shfl_xor(mx, 32), mx) * sc;
        if (__any(mx > S.m + AT_THR)) {
            const float mn = fmaxf(S.m, mx); const float al = __builtin_amdgcn_exp2f(S.m - mn);
            MFMA_FENCE2(S.o0, S.o1);
#pragma unroll
            for (int r = 0; r < 16; ++r) { S.o0[r] *= al; S.o1[r] *= al; }
            S.lsum *= al; S.m = mn;
        }
        const unsigned wl = S.wc_lo >> (4 * hi), wh = S.wc_hi >> (4 * hi); const float m = S.m;
        float ls = 0.f;
#pragma unroll
        for (int r = 0; r < 16; ++r) { const int cb = (r & 3) + 8 * (r >> 2);
            const float e0 = __uint_as_float(and_sel(__builtin_amdgcn_exp2f(__builtin_fmaf(P0[r], sc, -m)), wl, cb)), e1 = __uint_as_float(and_sel(__builtin_amdgcn_exp2f(__builtin_fmaf(P1[r], sc, -m)), wh, cb));
            P0[r] = e0; P1[r] = e1; ls += e0 + e1; }
        S.lsum += ls;
        bf16x8_t pb[4];
#pragma unroll
        for (int sg = 0; sg < 4; ++sg) { union { bf16x8_t v; unsigned u[4]; } pk;
#pragma unroll
            for (int j = 0; j < 4; ++j) { const int r = 8 * (sg & 1) + 2 * j; pk.u[j] = (sg < 2) ? pg8::cvt_pk_bf16(P0[r], P0[r + 1]) : pg8::cvt_pk_bf16(P1[r], P1[r + 1]); }
            pb[sg] = pk.v; }
        at_pv(S.o0, S.o1, vb, pb, r32, hi);
    }
    if (has2) at_store_k(L + DA_K0 + ((t + 2) % 3) * AT_KBUF, tid, krn);
    if (has1) at_store_v(L + DA_V0 + ((t + 1) & 1) * AT_VBUF, tid, vrn);
    S.wc_lo = S.wn_lo; S.wc_hi = S.wn_hi; S.wn_lo = wq_lo; S.wn_hi = wq_hi;
    __syncthreads();
}
template <bool DRY = false> __device__ __forceinline__ void dsa_attn_unit(Frame& F, int b, int h, int qt) {
    int tid_ = F.tid; asm volatile("" : "+v"(tid_));
    const int tid = tid_, lane = tid & 63, wave = F.wave, r32 = lane & 31, hi = lane >> 5;
    LAS unsigned char* L = F.lds + RING_OFF;
    LAS float* bt = (LAS float*)(L + DA_BT);
    const size_t rowb = (size_t)b * SEQ;
    const GAS bf16* Kh = (const GAS bf16*)WSB(WS_KB) + rowb * 512 + h * 64; const GAS bf16* Vh = (const GAS bf16*)WSB(WS_VB) + rowb * 512 + h * 64;
    const int q0w = qt * 256 + wave * 32, q = q0w + r32;
    const int NT = 4 * qt + 4;
    __syncthreads();
    if (tid < 128) { const GAS float* rb = (const GAS float*)INP(I_RELB) + (8 + h); bt[tid] = (rb[t5_bucket(tid) * 16] - rb[31 * 16]) * LOG2E; }
    bf16x8_t qf[4];
    { const GAS bf16* qp = (const GAS bf16*)WSB(WS_QB) + (rowb + q) * 512 + h * 64 + hi * 8;
#pragma unroll
      for (int s = 0; s < 4; ++s) qf[s] = *(const GAS bf16x8_t*)(qp + s * 16); }
    const GAS unsigned* mrow = (const GAS unsigned*)(F.ws + WS_MASK) + (rowb + q) * 512;
    DsaState S; S.m = -1e30f; S.lsum = 0.f; S.o0 = (f32x16){0.f, 0.f, 0.f, 0.f, 0.f, 0.f, 0.f, 0.f, 0.f, 0.f, 0.f, 0.f, 0.f, 0.f, 0.f, 0.f}; S.o1 = S.o0;
    S.wc_lo = mrow[0]; S.wc_hi = mrow[1]; S.wn_lo = mrow[2]; S.wn_hi = mrow[3];
    { const v4u k0 = at_load_k(Kh, 0, tid), v0 = at_load_v(Vh, 0, tid), k1 = at_load_k(Kh, 1, tid);
      at_store_k(L + DA_K0, tid, k0); at_store_v(L + DA_V0, tid, v0); at_store_k(L + DA_K0 + AT_KBUF, tid, k1); }
    __syncthreads();
    f32x16 pA0 = {0.f, 0.f, 0.f, 0.f, 0.f, 0.f, 0.f, 0.f, 0.f, 0.f, 0.f, 0.f, 0.f, 0.f, 0.f, 0.f}, pA1 = pA0, pB0 = pA0, pB1 = pA0;
    if (__any((S.wc_lo | S.wc_hi) != 0u)) at_qk(pA0, pA1, L + DA_K0, qf, r32, hi);
#pragma unroll 1
    for (int t = 0; t < NT; t += 2) {
        dsa_step(S, pA0, pA1, pB0, pB1, t, NT, L, bt, qf, Kh, Vh, mrow, tid, r32, hi, q, q0w);
        dsa_step(S, pB0, pB1, pA0, pA1, t + 1, NT, L, bt, qf, Kh, Vh, mrow, tid, r32, hi, q, q0w);
    }
    MFMA_FENCE2(S.o0, S.o1);
    float lsum = S.lsum; lsum += __shfl_xor(lsum, 32);
    const float inv = 1.0f / lsum;
    LAS bf16* ost = (LAS bf16*)(L + DA_OST + wave * 4096);
#pragma unroll
    for (int r = 0; r < 16; ++r) { ost[r32 * 64 + crow_(r, hi)] = (bf16)f2bf(S.o0[r] * inv); ost[r32 * 64 + 32 + crow_(r, hi)] = (bf16)f2bf(S.o1[r] * inv); }
    LDS_WAIT(); asm volatile("" ::: "memory");
    GAS bf16* Og = (GAS bf16*)WSB(WS_QB) + (rowb + q0w) * 512 + h * 64;
#pragma unroll
    for (int i = 0; i < 4; ++i) { const int c = i * 64 + lane, row = c >> 3, ch = c & 7; const v4u ov = *(const LAS v4u*)(ost + row * 64 + ch * 8); if (!DRY) *(GAS v4u*)(Og + (size_t)row * 512 + ch * 8) = ov; else if (ov.x == 0x12345678u && ov.y == 0x9abcdef0u) *(GAS v4u*)(Og + (size_t)row * 512 + ch * 8) = ov; }
}

constexpr int D2_K = 0, D2_V = 4 * AT_KBUF, D2_BT = D2_V + 4 * AT_VBUF, D2_OST = 73728;
static_assert(D2_BT + 512 <= D2_OST && D2_OST + 8 * 4096 <= RING_BYTES, "dsa2 LDS map");
struct KV2 { v4u k0, v0, k1, v1; };
template <bool DRY = false> __device__ __forceinline__ void dsa_attn2_unit(Frame& F, int b, int h, int qt) {
    int tid_ = F.tid; asm volatile("" : "+v"(tid_));
    const int tid = tid_, lane = tid & 63, wave = F.wave, r32 = lane & 31, hi = lane >> 5;
    LAS unsigned char* L = F.lds + RING_OFF;
    LAS float* bt = (LAS float*)(L + D2_BT);
    const size_t rowb = (size_t)b * SEQ;
    const GAS bf16* Kh = (const GAS bf16*)WSB(WS_KB) + rowb * 512 + h * 64; const GAS bf16* Vh = (const GAS bf16*)WSB(WS_VB) + rowb * 512 + h * 64;
    const int q0w = qt * 256 + wave * 32, q = q0w + r32;
    const int NS = 2 * qt + 2;
    __syncthreads();
    if (tid < 128) { const GAS float* rb = (const GAS float*)INP(I_RELB) + (8 + h); bt[tid] = (rb[t5_bucket(tid) * 16] - rb[31 * 16]) * LOG2E; }
    bf16x8_t qf[4];
    { const GAS bf16* qp = (const GAS bf16*)WSB(WS_QB) + (rowb + q) * 512 + h * 64 + hi * 8;
#pragma unroll
      for (int s = 0; s < 4; ++s) qf[s] = *(const GAS bf16x8_t*)(qp + s * 16); }
#pragma unroll
    for (int s = 0; s < 4; ++s) { union { bf16x8_t v; unsigned u[4]; } x; x.v = qf[s];
#pragma unroll
        for (int jj = 0; jj < 4; ++jj) x.u[jj] = pg8::cvt_pk_bf16(pg8::bf_lo(x.u[jj]) * AT_C2, pg8::bf_hi(x.u[jj]) * AT_C2);
        qf[s] = x.v; }
    bf16x8_t oneA, mB;
    { union { bf16x8_t v; unsigned u[4]; } x; x.u[0] = hi == 0 ? 0x3f80u : 0u; x.u[1] = x.u[2] = x.u[3] = 0u; oneA = x.v; x.u[0] = 0u; mB = x.v; }
    bool fresh = true;
    const GAS unsigned* mrow = (const GAS unsigned*)(F.ws + WS_MASK) + (rowb + q) * 512;
    auto load2 = [&](int s, KV2& R) __attribute__((always_inline)) {
        at_load(Kh, Vh, 2 * s, tid, R.k0, R.v0); at_load(Kh, Vh, 2 * s + 1, tid, R.k1, R.v1); };
    auto store2 = [&](int set, const KV2& R) __attribute__((always_inline)) {
        at_store(L + D2_K + (2 * set) * AT_KBUF, L + D2_V + (2 * set) * AT_VBUF, tid, R.k0, R.v0); at_store(L + D2_K + (2 * set + 1) * AT_KBUF, L + D2_V + (2 * set + 1) * AT_VBUF, tid, R.k1, R.v1); };
    KV2 RA;
    load2(0, RA); store2(0, RA);
    unsigned wc[4] = { mrow[0], mrow[1], mrow[2], mrow[3] };
    __syncthreads();
    float m = 0.f, lsum = 0.f;
    f32x16 o0 = {0.f, 0.f, 0.f, 0.f, 0.f, 0.f, 0.f, 0.f, 0.f, 0.f, 0.f, 0.f, 0.f, 0.f, 0.f, 0.f}, o1 = o0;
    auto step = [&](int s, KV2& RS) __attribute__((always_inline)) {
        const int set = s & 1;
        if (s + 1 < NS) load2(s + 1, RS);
        unsigned wn[4] = {0u, 0u, 0u, 0u};
        if (s + 1 < NS) { const GAS unsigned* mp = mrow + 4 * (s + 1); wn[0] = mp[0]; wn[1] = mp[1]; wn[2] = mp[2]; wn[3] = mp[3]; }
        if (__any((wc[0] | wc[1] | wc[2] | wc[3]) != 0u)) {
            const LAS unsigned char* kb = L + D2_K + (2 * set) * AT_KBUF; const LAS unsigned char* vb = L + D2_V + (2 * set) * AT_VBUF;
            f32x16 p0 = {0.f, 0.f, 0.f, 0.f, 0.f, 0.f, 0.f, 0.f, 0.f, 0.f, 0.f, 0.f, 0.f, 0.f, 0.f, 0.f}, p1 = p0, p2 = p0, p3 = p0;
            at_qk_m(p0, p1, kb, qf, oneA, mB, r32, hi); at_qk_m(p2, p3, kb + AT_KBUF, qf, oneA, mB, r32, hi);
            asm volatile("s_nop 15\n\ts_nop 15" : "+v"(p0), "+v"(p1), "+v"(p2), "+v"(p3));
            const int t0 = 2 * s;
            const bool near = ((t0 + 1) * 64 + 191 > q0w);
            if (near) {
#pragma unroll
                for (int r = 0; r < 16; ++r) { const int d0 = q - (t0 * 64 + crow_(r, hi)), d1 = d0 - 32, d2 = d0 - 64, d3 = d0 - 96;
                    const float b0 = ((unsigned)d0 < 128u) ? bt[d0] : 0.f, b1 = ((unsigned)d1 < 128u) ? bt[d1] : 0.f, b2 = ((unsigned)d2 < 128u) ? bt[d2] : 0.f, b3 = ((unsigned)d3 < 128u) ? bt[d3] : 0.f;
                    p0[r] += b0; p1[r] += b1; p2[r] += b2; p3[r] += b3; }
            }
            float mx;
            { float ma = max3_(p0[0], p1[0], p2[0]), mb = max3_(p3[0], p0[1], p1[1]), mc = max3_(p2[1], p3[1], p0[2]), md = max3_(p1[2], p2[2], p3[2]);
#pragma unroll
              for (int r = 3; r < 15; r += 2) { ma = max3_(ma, p0[r], p1[r]); mb = max3_(mb, p2[r], p3[r]); mc = max3_(mc, p0[r + 1], p1[r + 1]); md = max3_(md, p2[r + 1], p3[r + 1]); }
              ma = max3_(ma, p0[15], p1[15]); mb = max3_(mb, p2[15], p3[15]); mx = max3_(ma, mb, mc); mx = max3_(mx, md, md); }
            mx = max3_(mx, __shfl_xor(mx, 32), mx);
            if (fresh || __any(mx > AT_THR)) {
                const float d = fresh ? mx : fmaxf(mx, 0.f);
                const float mn = __uint_as_float(pg8::cvt_pk_bf16(0.f, m + d) & 0xffff0000u);
                const float dl = mn - m; const float al = __builtin_amdgcn_exp2f(-dl);
                MFMA_FENCE2(o0, o1);
#pragma unroll
                for (int r = 0; r < 16; ++r) { o0[r] *= al; o1[r] *= al; p0[r] -= dl; p1[r] -= dl; p2[r] -= dl; p3[r] -= dl; }
                lsum *= al; m = mn; fresh = false;
                { union { bf16x8_t v; unsigned u[4]; } x; x.u[0] = hi == 0 ? ((__float_as_uint(m) >> 16) ^ 0x8000u) : 0u; x.u[1] = x.u[2] = x.u[3] = 0u; mB = x.v; }
            }
            const unsigned w0 = wc[0] >> (4 * hi), w1 = wc[1] >> (4 * hi), w2 = wc[2] >> (4 * hi), w3 = wc[3] >> (4 * hi);
            float lq[4] = {0.f, 0.f, 0.f, 0.f};
#pragma unroll
            for (int r = 0; r < 16; ++r) { const int cb = (r & 3) + 8 * (r >> 2);
                const float e0 = __uint_as_float(and_sel(__builtin_amdgcn_exp2f(p0[r]), w0, cb)), e1 = __uint_as_float(and_sel(__builtin_amdgcn_exp2f(p1[r]), w1, cb));
                const float e2 = __uint_as_float(and_sel(__builtin_amdgcn_exp2f(p2[r]), w2, cb)), e3 = __uint_as_float(and_sel(__builtin_amdgcn_exp2f(p3[r]), w3, cb));
                p0[r] = e0; p1[r] = e1; p2[r] = e2; p3[r] = e3; lq[0] += e0; lq[1] += e1; lq[2] += e2; lq[3] += e3; }
            lsum += (lq[0] + lq[1]) + (lq[2] + lq[3]);
            bf16x8_t pb[4], pc[4];
#pragma unroll
            for (int sg = 0; sg < 4; ++sg) { union { bf16x8_t v; unsigned u[4]; } pk, pl;
#pragma unroll
                for (int j = 0; j < 4; ++j) { const int r = 8 * (sg & 1) + 2 * j; pk.u[j] = (sg < 2) ? pg8::cvt_pk_bf16(p0[r], p0[r + 1]) : pg8::cvt_pk_bf16(p1[r], p1[r + 1]);
                    pl.u[j] = (sg < 2) ? pg8::cvt_pk_bf16(p2[r], p2[r + 1]) : pg8::cvt_pk_bf16(p3[r], p3[r + 1]); }
                pb[sg] = pk.v; pc[sg] = pl.v; }
            at_pv(o0, o1, vb, pb, r32, hi); at_pv(o0, o1, vb + AT_VBUF, pc, r32, hi);
        }
        if (s + 1 < NS) store2(set ^ 1, RS);
        wc[0] = wn[0]; wc[1] = wn[1]; wc[2] = wn[2]; wc[3] = wn[3];
        __syncthreads();
    };
#pragma unroll 1
    for (int s = 0; s < NS; ++s) step(s, RA);
    MFMA_FENCE2(o0, o1);
    lsum += __shfl_xor(lsum, 32);
    const float inv = 1.0f / lsum;
    LAS bf16* ost = (LAS bf16*)(L + D2_OST + wave * 4096);
#pragma unroll
    for (int r = 0; r < 16; ++r) { ost[r32 * 64 + crow_(r, hi)] = (bf16)f2bf(o0[r] * inv); ost[r32 * 64 + 32 + crow_(r, hi)] = (bf16)f2bf(o1[r] * inv); }
    LDS_WAIT(); asm volatile("" ::: "memory");
    GAS bf16* Og = (GAS bf16*)WSB(WS_QB) + (rowb + q0w) * 512 + h * 64;
#pragma unroll
    for (int i = 0; i < 4; ++i) { const int c = i * 64 + lane, row = c >> 3, ch = c & 7; const v4u ov = *(const LAS v4u*)(ost + row * 64 + ch * 8); if (!DRY) *(GAS v4u*)(Og + (size_t)row * 512 + ch * 8) = ov; else if (ov.x == 0x12345678u && ov.y == 0x9abcdef0u) *(GAS v4u*)(Og + (size_t)row * 512 + ch * 8) = ov; }
}
constexpr int IX_CAP = 768;
constexpr int IX_HIST = 0, IX_CAND = 0, IX_BM = 98304;
constexpr int IX_W = LDSCTL_OFF + 1024;
constexpr int IX_ST = LDSCTL_OFF + 1536;
constexpr int IX_SUB = LDSCTL_OFF + 2048, IX_L2 = IX_SUB + 8 * 1024, IX_C2 = IX_L2 + 8 * 512;
static_assert(IX_C2 + 64 <= LDS_BYTES, "idx sub-histogram LDS");
static_assert(IX_BM + 16 * 512 * 4 <= RING_BYTES && 16 * IX_CAP * 8 <= IX_BM && IX_ST + 6 * 64 <= LDS_BYTES, "idx LDS map");
#define MFMA_FENCE1(a) asm volatile("s_nop 15\n\ts_nop 15" : "+v"(a))
__device__ __forceinline__ float relu_(float x, float) { float r; asm("v_max_f32 %0, 0, %1" : "=v"(r) : "v"(x)); return r; }
__device__ __forceinline__ unsigned mono_key(float s) { const unsigned u = __float_as_uint(s + 0.0f); return u ^ ((unsigned)((int)u >> 31) | 0x80000000u); }

template <int MODE, bool LEVEL0, bool LAST, int HALF> __device__ __forceinline__ void idx_vec(const f32x16 (&accs)[2], const f32x4 (&wv)[4][4], LAS unsigned* hist, LAS unsigned long long* cand, LAS unsigned* bm, LAS unsigned* st,
                                                                                    const unsigned (&psh)[8], const unsigned (&ppre)[8], const bool (&pact)[8], int key, int t0, int hi, int lane, int w32, int shn, unsigned fmask, bool allsel) {
#pragma unroll
    for (int rb = 2 * HALF; rb < 2 * HALF + 2; ++rb) {
        const f32x16 acc = accs[rb - 2 * HALF];
        const int qla = 4 * rb + 2 * hi;
        const f32x4 w0 = wv[rb][0], w1 = wv[rb][1], w2 = wv[rb][2], w3 = wv[rb][3];
        float sa = w0.x * relu_(acc[0], 0.f), sa2 = w0.y * relu_(acc[1], 0.f); sa += w0.z * relu_(acc[2], 0.f); sa2 += w0.w * relu_(acc[3], 0.f);
        sa += w1.x * relu_(acc[4], 0.f); sa2 += w1.y * relu_(acc[5], 0.f); sa += w1.z * relu_(acc[6], 0.f); sa2 += w1.w * relu_(acc[7], 0.f);
        float sb = w2.x * relu_(acc[8], 0.f), sb2 = w2.y * relu_(acc[9], 0.f); sb += w2.z * relu_(acc[10], 0.f); sb2 += w2.w * relu_(acc[11], 0.f);
        sb += w3.x * relu_(acc[12], 0.f); sb2 += w3.y * relu_(acc[13], 0.f); sb += w3.z * relu_(acc[14], 0.f); sb2 += w3.w * relu_(acc[15], 0.f);
        sa += sa2; sb += sb2;
        const unsigned ua = mono_key(sa), ub = mono_key(sb);
        const bool va = !LAST || key <= t0 + qla, vb = !LAST || key <= t0 + qla + 1;
        if (MODE == 0) {
            const bool ma = va && (LEVEL0 || (pact[2 * rb] && (ua >> psh[2 * rb]) == ppre[2 * rb]));
            const bool mb = vb && (LEVEL0 || (pact[2 * rb + 1] && (ub >> psh[2 * rb + 1]) == ppre[2 * rb + 1]));
            const unsigned ba = LEVEL0 ? (ua >> 21) : ((ua >> shn) & fmask), bb = LEVEL0 ? (ub >> 21) : ((ub >> shn) & fmask);
            if (ma) __hip_atomic_fetch_add(hist + qla * 2048 + ba, 1u, __ATOMIC_RELAXED, __HIP_MEMORY_SCOPE_WORKGROUP);
            if (mb) __hip_atomic_fetch_add(hist + (qla + 1) * 2048 + bb, 1u, __ATOMIC_RELAXED, __HIP_MEMORY_SCOPE_WORKGROUP);
        } else {
            const unsigned pa = ua >> psh[2 * rb], pb = ub >> psh[2 * rb + 1];
            const bool sela = va && (allsel || pa > ppre[2 * rb]), selb = vb && (allsel || pb > ppre[2 * rb + 1]);
            const bool ca = va && !allsel && pa == ppre[2 * rb], cb = vb && !allsel && pb == ppre[2 * rb + 1];
            const unsigned long long bala = __ballot(sela), balb = __ballot(selb);
            if (lane == 0) { bm[(4 * rb + 0) * 512 + w32] = (unsigned)bala; bm[(4 * rb + 2) * 512 + w32] = (unsigned)(bala >> 32);
                             bm[(4 * rb + 1) * 512 + w32] = (unsigned)balb; bm[(4 * rb + 3) * 512 + w32] = (unsigned)(balb >> 32); }
            if (ca) { const unsigned slot = __hip_atomic_fetch_add(st + qla, 1u, __ATOMIC_RELAXED, __HIP_MEMORY_SCOPE_WORKGROUP);
                if (slot < (unsigned)IX_CAP) cand[qla * IX_CAP + slot] = ((unsigned long long)ua << 32) | (unsigned)(0xffff - key); }
            if (cb) { const unsigned slot = __hip_atomic_fetch_add(st + qla + 1, 1u, __ATOMIC_RELAXED, __HIP_MEMORY_SCOPE_WORKGROUP);
                if (slot < (unsigned)IX_CAP) cand[(qla + 1) * IX_CAP + slot] = ((unsigned long long)ub << 32) | (unsigned)(0xffff - key); }
        }
    }
}
template <int MODE, bool LEVEL0> __device__ __forceinline__ void idx_pass(Frame& F, const bf16x8_t (&qa)[4][4], const GAS bf16* kib, int t0, int nst, int wave, int lane,
                                                             int shn, unsigned fmask, bool allsel) {
    const int n = lane & 31, hi = lane >> 5;
    LAS unsigned char* L = F.lds + RING_OFF;
    LAS unsigned* hist = (LAS unsigned*)(L + IX_HIST); LAS unsigned long long* cand = (LAS unsigned long long*)(L + IX_CAND); LAS unsigned* bm = (LAS unsigned*)(L + IX_BM);
    const LAS float* wl = (const LAS float*)(F.lds + IX_W); LAS unsigned* st = (LAS unsigned*)(F.lds + IX_ST);
    unsigned psh[8], ppre[8]; bool pact[8];
#pragma unroll
    for (int i = 0; i < 8; ++i) { const int ql = 4 * (i >> 1) + 2 * hi + (i & 1); psh[i] = st[16 + ql]; ppre[i] = st[32 + ql]; pact[i] = (st[80 + ql] != 0u); }
    f32x4 wv[4][4];
#pragma unroll
    for (int rb = 0; rb < 4; ++rb)
#pragma unroll
        for (int j = 0; j < 4; ++j) wv[rb][j] = *(const LAS f32x4*)(wl + (4 * rb + 2 * hi) * 8 + 4 * j);
    bf16x8_t kf[4];
    const GAS bf16* kp = kib + (size_t)(wave * 32 + n) * 64 + hi * 8;
#pragma unroll
    for (int s = 0; s < 4; ++s) kf[s] = *(const GAS bf16x8_t*)(kp + s * 16);
#pragma unroll 1
    for (int stile = 0; stile < nst; ++stile) {
        const int key = stile * 256 + wave * 32 + n;
        const int w32 = stile * 8 + wave;
        const bool lastt = (stile + 1 == nst);
        f32x16 accs[2];
#pragma unroll
        for (int rb = 0; rb < 2; ++rb) { accs[rb] = (f32x16){0.f, 0.f, 0.f, 0.f, 0.f, 0.f, 0.f, 0.f, 0.f, 0.f, 0.f, 0.f, 0.f, 0.f, 0.f, 0.f};
#pragma unroll
            for (int s = 0; s < 4; ++s) accs[rb] = __builtin_amdgcn_mfma_f32_32x32x16_bf16(qa[rb][s], kf[s], accs[rb], 0, 0, 0); }
        asm volatile("s_nop 15\n\ts_nop 15" : "+v"(accs[0]), "+v"(accs[1]));
        if (!lastt) idx_vec<MODE, LEVEL0, false, 0>(accs, wv, hist, cand, bm, st, psh, ppre, pact, key, t0, hi, lane, w32, shn, fmask, allsel);
        else idx_vec<MODE, LEVEL0, true, 0>(accs, wv, hist, cand, bm, st, psh, ppre, pact, key, t0, hi, lane, w32, shn, fmask, allsel);
#pragma unroll
        for (int rb = 0; rb < 2; ++rb) { accs[rb] = (f32x16){0.f, 0.f, 0.f, 0.f, 0.f, 0.f, 0.f, 0.f, 0.f, 0.f, 0.f, 0.f, 0.f, 0.f, 0.f, 0.f};
#pragma unroll
            for (int s = 0; s < 4; ++s) accs[rb] = __builtin_amdgcn_mfma_f32_32x32x16_bf16(qa[2 + rb][s], kf[s], accs[rb], 0, 0, 0); }
        asm volatile("s_nop 15\n\ts_nop 15" : "+v"(accs[0]), "+v"(accs[1]), "+v"(kf[0]), "+v"(kf[1]), "+v"(kf[2]), "+v"(kf[3]));
        if (!lastt) { kp += (size_t)256 * 64;
#pragma unroll
            for (int s = 0; s < 4; ++s) kf[s] = *(const GAS bf16x8_t*)(kp + s * 16); }
        if (!lastt) idx_vec<MODE, LEVEL0, false, 1>(accs, wv, hist, cand, bm, st, psh, ppre, pact, key, t0, hi, lane, w32, shn, fmask, allsel);
        else idx_vec<MODE, LEVEL0, true, 1>(accs, wv, hist, cand, bm, st, psh, ppre, pact, key, t0, hi, lane, w32, shn, fmask, allsel);
    }
}

__device__ __forceinline__ void idx_unit(Frame& F, int b, int t0) {
    int tid_ = F.tid; asm volatile("" : "+v"(tid_));
    const int tid = tid_, lane = tid & 63, wave = F.wave, r32 = lane & 31, hh = lane >> 5;
    LAS unsigned char* L = F.lds + RING_OFF;
    LAS unsigned* hist = (LAS unsigned*)(L + IX_HIST); LAS unsigned long long* cand = (LAS unsigned long long*)(L + IX_CAND); LAS unsigned* bm = (LAS unsigned*)(L + IX_BM);
    LAS float* wl = (LAS float*)(F.lds + IX_W); LAS unsigned* st = (LAS unsigned*)(F.lds + IX_ST);
    const size_t rowb = (size_t)b * SEQ; const int nst = (t0 >> 8) + 1; const bool allsel = (t0 < 256);
    const GAS bf16* kib = (const GAS bf16*)WSB(WS_KI) + rowb * 64;
    __syncthreads();
    if (tid < 128) wl[tid] = ((const GAS float*)WSF(WS_WI) + (rowb + t0) * 8)[tid];
    if (tid < 16) { st[tid] = 0u; st[16 + tid] = 21u; st[32 + tid] = 0u; st[48 + tid] = 256u; st[64 + tid] = 0u; st[80 + tid] = 1u; }
    bf16x8_t qa[4][4];
    { const int qloc = 2 * ((r32 >> 2) & 1) + (r32 >> 4), head = (r32 & 3) + 4 * ((r32 >> 3) & 1);
      const GAS bf16* qp = (const GAS bf16*)WSB(WS_QI) + (rowb + t0 + qloc) * 512 + head * 64 + hh * 8;
#pragma unroll
      for (int rb = 0; rb < 4; ++rb)
#pragma unroll
        for (int s = 0; s < 4; ++s) qa[rb][s] = *(const GAS bf16x8_t*)(qp + (size_t)rb * 4 * 512 + s * 16); }
    __syncthreads();
    if (!allsel) {
#pragma unroll 1
        for (int level = 0; level < 3; ++level) {
            const int shn = level == 0 ? 21 : (level == 1 ? 10 : 0); const unsigned fmask = level == 2 ? 0x3ffu : 0x7ffu; const int nd = level == 2 ? 1024 : 2048;
            for (int i = tid; i < 16 * 2048 / 4; i += NWAVES * 64) ((LAS v4u*)hist)[i] = (v4u){0u, 0u, 0u, 0u};
            __syncthreads();
            { if (level == 0) idx_pass<0, true>(F, qa, kib, t0, nst, wave, lane, shn, fmask, false); else idx_pass<0, false>(F, qa, kib, t0, nst, wave, lane, shn, fmask, false); }
            __syncthreads();
            if (PROBE_SEL & 8) { for (int i = tid; i < 16 * 2048; i += NWAVES * 64) hist[i] = 0u; __syncthreads(); { if (level == 0) idx_pass<0, true>(F, qa, kib, t0, nst, wave, lane, shn, fmask, false); else idx_pass<0, false>(F, qa, kib, t0, nst, wave, lane, shn, fmask, false); } __syncthreads(); }
#pragma unroll 1
            for (int qq = 0; qq < 2; ++qq) { const int ql = 2 * wave + qq;
                if (st[80 + ql] == 0u) continue;
                const unsigned kneed = st[48 + ql]; const int D = nd >> 6; const LAS unsigned* hq = hist + ql * 2048 + lane * D;
                unsigned tot = 0u;
                for (int dd = 0; dd < D; ++dd) tot += hq[dd];
                unsigned S = tot;
#pragma unroll
                for (int o = 1; o < 64; o <<= 1) { const unsigned v = __shfl_down(S, o); if (lane + o < 64) S += v; }
                const unsigned above = S - tot;
                if (above < kneed && kneed <= S) { unsigned a = above; int bsel = 0; unsigned cb = 0u;
                    for (int dd = D - 1; dd >= 0; --dd) { const unsigned v = hq[dd];
                        if (a + v >= kneed) { bsel = lane * D + dd; cb = v; break; } a += v; }
                    const unsigned opre = st[32 + ql];
                    st[32 + ql] = (level == 0) ? (unsigned)bsel : ((opre << (level == 1 ? 11 : 10)) | (unsigned)bsel);
                    st[16 + ql] = (unsigned)shn; st[48 + ql] = kneed - a; st[64 + ql] = cb;
                    st[80 + ql] = (cb > (unsigned)IX_CAP && level < 2) ? 1u : 0u; }
            }
            __syncthreads();
            unsigned more = 0u;
#pragma unroll
            for (int i = 0; i < 16; ++i) more |= st[80 + i];
            __syncthreads();
            if (more == 0u) break;
        }
    }
    if (PROBE_SEL & 16) { idx_pass<1, false>(F, qa, kib, t0, nst, wave, lane, 0, 0u, allsel); __syncthreads(); if (tid < 16) st[tid] = 0u; __syncthreads(); }
    idx_pass<1, false>(F, qa, kib, t0, nst, wave, lane, 0, 0u, allsel);
    __syncthreads();
    if (!allsel) {
#pragma unroll 1
        for (int qq = 0; qq < 2; ++qq) { const int ql = 2 * wave + qq;
            const int nc = (int)(st[ql] < (unsigned)IX_CAP ? st[ql] : (unsigned)IX_CAP); int need = (int)st[48 + ql]; const int vbits = 16 + (int)st[16 + ql];
            if (need >= nc) {
                for (int k = lane; k < nc; k += 64) { const int key = 0xffff - (int)(cand[ql * IX_CAP + k] & 0xffffull); __hip_atomic_fetch_or(bm + ql * 512 + (key >> 5), 1u << (key & 31), __ATOMIC_RELAXED, __HIP_MEMORY_SCOPE_WORKGROUP); }
                continue; }
            const int shq = (int)st[16 + ql];
            if (shq >= 8) {
                LAS unsigned* sh2 = (LAS unsigned*)(F.lds + IX_SUB + wave * 1024); LAS unsigned long long* l2 = (LAS unsigned long long*)(F.lds + IX_L2 + wave * 512); LAS unsigned* c2p = (LAS unsigned*)(F.lds + IX_C2 + wave * 4);
#pragma unroll
                for (int i = 0; i < 4; ++i) sh2[4 * lane + i] = 0u;
                if (lane == 0) *c2p = 0u;
                LDS_WAIT(); asm volatile("" ::: "memory");
                const int fsh = 32 + shq - 8;
                for (int k = lane; k < nc; k += 64) { const unsigned f = (unsigned)(cand[ql * IX_CAP + k] >> fsh) & 0xffu; __hip_atomic_fetch_add(sh2 + f, 1u, __ATOMIC_RELAXED, __HIP_MEMORY_SCOPE_WORKGROUP); }
                LDS_WAIT(); asm volatile("" ::: "memory");
                const unsigned c0 = sh2[4 * lane], c1 = sh2[4 * lane + 1], c2 = sh2[4 * lane + 2], c3 = sh2[4 * lane + 3]; const unsigned tot = c0 + c1 + c2 + c3;
                unsigned S = tot;
#pragma unroll
                for (int o = 1; o < 64; o <<= 1) { const unsigned v = __shfl_down(S, o); if (lane + o < 64) S += v; }
                const unsigned above = S - tot; const unsigned needu = (unsigned)need;
                const bool found = above < needu && needu <= S;
                unsigned a = above; unsigned bsel = 0u, cbin = 0u;
                if (a + c3 >= needu) { bsel = 3u; cbin = c3; } else { a += c3; if (a + c2 >= needu) { bsel = 2u; cbin = c2; } else { a += c2; if (a + c1 >= needu) { bsel = 1u; cbin = c1; } else { a += c1; bsel = 0u; cbin = c0; } } }
                const int src = __ffsll((long long)__ballot(found)) - 1;
                const unsigned b2 = (unsigned)__shfl((int)(4u * lane + bsel), src), need2 = (unsigned)__shfl((int)(needu - a), src), cnt2 = (unsigned)__shfl((int)cbin, src);
                if (cnt2 <= 64u) {
                    for (int k = lane; k < nc; k += 64) { const unsigned long long ckk = cand[ql * IX_CAP + k]; const unsigned f = (unsigned)(ckk >> fsh) & 0xffu;
                        if (f > b2) { const int key = 0xffff - (int)(ckk & 0xffffull); __hip_atomic_fetch_or(bm + ql * 512 + (key >> 5), 1u << (key & 31), __ATOMIC_RELAXED, __HIP_MEMORY_SCOPE_WORKGROUP); }
                        else if (f == b2) { const unsigned slot = __hip_atomic_fetch_add(c2p, 1u, __ATOMIC_RELAXED, __HIP_MEMORY_SCOPE_WORKGROUP); l2[slot] = ckk; } }
                    LDS_WAIT(); asm volatile("" ::: "memory");
                    if (lane < (int)cnt2) { const unsigned long long mine = l2[lane]; unsigned rank = 0u;
                        for (unsigned j = 0; j < cnt2; ++j) rank += (l2[j] > mine) ? 1u : 0u;
                        if (rank < need2) { const int key = 0xffff - (int)(mine & 0xffffull); __hip_atomic_fetch_or(bm + ql * 512 + (key >> 5), 1u << (key & 31), __ATOMIC_RELAXED, __HIP_MEMORY_SCOPE_WORKGROUP); } }
                    LDS_WAIT(); asm volatile("" ::: "memory");
                    continue;
                }
            }
            unsigned long long ck[12]; unsigned alive = 0u, selm = 0u;
#pragma unroll
            for (int c = 0; c < 12; ++c) { const int k = c * 64 + lane; ck[c] = (k < nc) ? cand[ql * IX_CAP + k] : 0ull; if (k < nc) alive |= 1u << c; }
#pragma unroll 1
            for (int bit = vbits - 1 + 16; bit >= 0; --bit) {
                if (bit >= 16 && bit < 32) continue;
                unsigned ones = 0u; int cnt1 = 0;
#pragma unroll
                for (int c = 0; c < 12; ++c) { if (c * 64 < nc) { const bool o = ((alive >> c) & 1u) && ((ck[c] >> bit) & 1ull); cnt1 += __popcll(__ballot(o)); if (o) ones |= 1u << c; } }
                if (cnt1 >= need) alive &= ones;
                else { selm |= ones; alive &= ~ones; need -= cnt1; }
            }
            selm |= alive;
#pragma unroll
            for (int c = 0; c < 12; ++c) if ((selm >> c) & 1u) { const int key = 0xffff - (int)(ck[c] & 0xffffull); __hip_atomic_fetch_or(bm + ql * 512 + (key >> 5), 1u << (key & 31), __ATOMIC_RELAXED, __HIP_MEMORY_SCOPE_WORKGROUP); }
        }
    }
    __syncthreads();
    { GAS unsigned* mg = (GAS unsigned*)(F.ws + WS_MASK) + (rowb + t0) * 512; const int nw = nst * 8;
      for (int i = tid; i < 16 * nw; i += NWAVES * 64) { const int ql = i / nw, w = i - ql * nw; mg[(size_t)ql * 512 + w] = bm[ql * 512 + w]; } }
}
typedef __bf16 bf2_t __attribute__((ext_vector_type(2)));
constexpr size_t WS_KM2 = 110 * MiB;
constexpr size_t WS_MREF = 111 * MiB;
constexpr size_t WS_LACC = 38 * MiB;
constexpr size_t WS_PO = 464 * MiB;
constexpr size_t WS_PJ0 = WS_QI, WS_PJ1 = WS_XB, WS_PJ2 = WS_XB + 32 * MiB;
__device__ __forceinline__ unsigned char* pj_base(Frame& F, int l, int j) {
    if (j == 0) return F.ws + WS_PJ0;
    return (l == 0 ? (unsigned char*)F.out : F.ws + WS_PJ1) + (size_t)(j - 1) * (32 * MiB);
}
constexpr size_t WS_LJ = WS_KI;
constexpr size_t WS_LISTS = 496 * MiB;
constexpr int CW_LCNT = 16384;
static_assert((CW_LCNT + 2 * 1024) * 4 <= (int)CTL_ZERO_BYTES, "list counters inside the memset region");
__device__ __forceinline__ int list_off(int n) { return 256 * (63 * n - (n * (n - 1)) / 2); }
constexpr int IT_K = 0, IT_V = 4 * AT_KBUF, IT_BT = IT_V + 4 * AT_VBUF, IT_QP = IT_BT + 512, IT_OST = 73728;
static_assert(IT_QP + 8 * 128 <= IT_OST && IT_OST + 8 * 4096 <= RING_BYTES, "item LDS map");

template <bool DRY = false> __device__ __forceinline__ void moba_own_unit(Frame& F, int l, int b, int h, int qt) {
    int tid_ = F.tid; asm volatile("" : "+v"(tid_));
    const int tid = tid_, lane = tid & 63, wave = F.wave, r32 = lane & 31, hi = lane >> 5;
    LAS unsigned char* L = F.lds + RING_OFF;
    LAS float* bt = (LAS float*)(L + AT_BT);
    const GAS bf16* Qg = (const GAS bf16*)WSB(WS_QA);
    const size_t rowb = (size_t)b * SEQ;
    const GAS bf16* Kh = (const GAS bf16*)WSB(WS_KA) + rowb * 512 + h * 64; const GAS bf16* Vh = (const GAS bf16*)WSB(WS_VA) + rowb * 512 + h * 64;
    const int q0w = qt * 256 + wave * 32, q = q0w + r32;
    __syncthreads();
    if (tid < 128) { const GAS float* rb = (const GAS float*)INP(I_RELB) + h; bt[tid] = (rb[t5_bucket(tid) * 16] - rb[31 * 16]) * LOG2E; }
    bf16x8_t qf[4];
    { const GAS bf16* qp = Qg + (rowb + q) * 512 + h * 64 + hi * 8;
#pragma unroll
      for (int s = 0; s < 4; ++s) qf[s] = *(const GAS bf16x8_t*)(qp + s * 16); }
    { const int n = tid >> 3, c8 = (tid & 7) * 8; const GAS float* km = (const GAS float*)WSF(WS_KM2) + (((size_t)b * NBLK + n) * 2) * 512 + h * 64 + c8;
      f32x4 a = *(const GAS f32x4*)km + *(const GAS f32x4*)(km + 512), c = *(const GAS f32x4*)(km + 4) + *(const GAS f32x4*)(km + 516);
      a = a * (1.0f / 256.0f); c = c * (1.0f / 256.0f);
      const unsigned h0 = pk2(a.x, a.y), h1 = pk2(a.z, a.w), h2 = pk2(c.x, c.y), h3 = pk2(c.z, c.w);
      const unsigned l0 = pk2(a.x - __uint_as_float(h0 << 16), a.y - __uint_as_float(h0 & 0xffff0000u)), l1 = pk2(a.z - __uint_as_float(h1 << 16), a.w - __uint_as_float(h1 & 0xffff0000u)),
                     l2 = pk2(c.x - __uint_as_float(h2 << 16), c.y - __uint_as_float(h2 & 0xffff0000u)), l3 = pk2(c.z - __uint_as_float(h3 << 16), c.w - __uint_as_float(h3 & 0xffff0000u));
      *(LAS v4u*)(L + AT_K0 + n * AT_KROW + (tid & 7) * 16) = (v4u){h0, h1, h2, h3}; *(LAS v4u*)(L + AT_K0 + AT_KBUF + n * AT_KROW + (tid & 7) * 16) = (v4u){l0, l1, l2, l3}; }
    __syncthreads();
    unsigned mlo = 0u, mhi = 0u;
    if (qt > 0) {
        f32x16 g0 = {0.f, 0.f, 0.f, 0.f, 0.f, 0.f, 0.f, 0.f, 0.f, 0.f, 0.f, 0.f, 0.f, 0.f, 0.f, 0.f}, g1 = g0;
        at_qk(g0, g1, L + AT_K0, qf, r32, hi); at_qk(g0, g1, L + AT_K0 + AT_KBUF, qf, r32, hi);
        MFMA_FENCE2(g0, g1);
#pragma unroll
        for (int r = 0; r < 16; ++r) { if (crow_(r, hi) >= qt) g0[r] = -INFINITY; if (32 + crow_(r, hi) >= qt) g1[r] = -INFINITY; }
#pragma unroll
        for (int it = 0; it < 3; ++it) {
            float bv = -INFINITY; int bn = 64;
#pragma unroll
            for (int r = 0; r < 16; ++r) if (g0[r] > bv) { bv = g0[r]; bn = crow_(r, hi); }
#pragma unroll
            for (int r = 0; r < 16; ++r) if (g1[r] > bv) { bv = g1[r]; bn = 32 + crow_(r, hi); }
            const float pv = __shfl_xor(bv, 32); const int pn = __shfl_xor(bn, 32);
            const bool tp = (pv > bv) || (pv == bv && pn < bn);
            const float wv = tp ? pv : bv; const int wn = tp ? pn : bn;
            if (wv > -INFINITY) { if (wn < 32) mlo |= 1u << wn; else mhi |= 1u << (wn - 32);
                if (hi == 0 && !DRY) { GAS unsigned* cnt = (GAS unsigned*)(F.ws + WS_CTL) + CW_LCNT + ((l * 2 + b) * 8 + h) * 64 + wn;
                    const unsigned slot = __hip_atomic_fetch_add(cnt, 1u, __ATOMIC_RELAXED, __HIP_MEMORY_SCOPE_AGENT);
                    ((GAS unsigned short*)(F.ws + WS_LISTS) + ((size_t)(b * 8 + h) << 19))[list_off(wn) + slot] = (unsigned short)(q | (it << 14)); } }
#pragma unroll
            for (int r = 0; r < 16; ++r) { if (crow_(r, hi) == wn) g0[r] = -INFINITY; if (32 + crow_(r, hi) == wn) g1[r] = -INFINITY; }
        }
    }
    __syncthreads();
    v4u kr, vr;
    at_load(Kh, Vh, 4 * qt, tid, kr, vr);
    at_store(L + AT_K0, L + AT_V0, tid, kr, vr);
    __syncthreads();
    float m = -1e30f, lsum = 0.f;
    f32x16 o0 = {0.f, 0.f, 0.f, 0.f, 0.f, 0.f, 0.f, 0.f, 0.f, 0.f, 0.f, 0.f, 0.f, 0.f, 0.f, 0.f}, o1 = o0;
#pragma unroll 1
    for (int tt = 0; tt < 4; ++tt) {
        const int t = 4 * qt + tt, cur = tt & 1;
        if (tt + 1 < 4) at_load(Kh, Vh, t + 1, tid, kr, vr);
        const int nall = q - t * 64 + 1;
        const unsigned wlo = nall >= 32 ? 0xffffffffu : (nall <= 0 ? 0u : ((1u << nall) - 1u)), whi = nall >= 64 ? 0xffffffffu : (nall <= 32 ? 0u : ((1u << (nall - 32)) - 1u));
        if (__any((wlo | whi) != 0u)) {
            const LAS unsigned char* kb = L + AT_K0 + cur * AT_KBUF; const LAS unsigned char* vb = L + AT_V0 + cur * AT_VBUF;
            f32x16 p0 = {0.f, 0.f, 0.f, 0.f, 0.f, 0.f, 0.f, 0.f, 0.f, 0.f, 0.f, 0.f, 0.f, 0.f, 0.f, 0.f}, p1 = p0;
            at_qk(p0, p1, kb, qf, r32, hi);
            MFMA_FENCE2(p0, p1);
#pragma unroll
            for (int r = 0; r < 16; ++r) { const int d0 = q - (t * 64 + crow_(r, hi)), d1 = d0 - 32;
                const float b0 = ((unsigned)d0 < 128u) ? bt[d0] : 0.f, b1 = ((unsigned)d1 < 128u) ? bt[d1] : 0.f;
                p0[r] = p0[r] * AT_C2 + b0; p1[r] = p1[r] * AT_C2 + b1; }
            float mx;
            { float ma = max3_(p0[0], p1[0], p0[1]), mb = max3_(p1[1], p0[2], p1[2]), mc = max3_(p0[3], p1[3], p0[4]), md = max3_(p1[4], p0[5], p1[5]);
              ma = max3_(ma, p0[6], p1[6]); mb = max3_(mb, p0[7], p1[7]); mc = max3_(mc, p0[8], p1[8]); md = max3_(md, p0[9], p1[9]);
              ma = max3_(ma, p0[10], p1[10]); mb = max3_(mb, p0[11], p1[11]); mc = max3_(mc, p0[12], p1[12]); md = max3_(md, p0[13], p1[13]);
              ma = max3_(ma, p0[14], p1[14]); mb = max3_(mb, p0[15], p1[15]); mx = max3_(ma, mb, mc); mx = max3_(mx, md, md); }
            mx = max3_(mx, __shfl_xor(mx, 32), mx);
            if (__any(mx > m + AT_THR)) {
                const float mn = fmaxf(m, mx); const float al = __builtin_amdgcn_exp2f(m - mn);
                MFMA_FENCE2(o0, o1);
#pragma unroll
                for (int r = 0; r < 16; ++r) { o0[r] *= al; o1[r] *= al; }
                lsum *= al; m = mn;
            }
            const unsigned wl = wlo >> (4 * hi), wh = whi >> (4 * hi);
            float lq[4] = {0.f, 0.f, 0.f, 0.f};
#pragma unroll
            for (int r = 0; r < 16; ++r) { const int cb = (r & 3) + 8 * (r >> 2);
                const float e0 = __uint_as_float(and_sel(__builtin_amdgcn_exp2f(p0[r] - m), wl, cb)), e1 = __uint_as_float(and_sel(__builtin_amdgcn_exp2f(p1[r] - m), wh, cb));
                p0[r] = e0; p1[r] = e1; lq[r & 1] += e0; lq[2 + (r & 1)] += e1; }
            lsum += (lq[0] + lq[1]) + (lq[2] + lq[3]);
            bf16x8_t pb[4];
#pragma unroll
            for (int sg = 0; sg < 4; ++sg) { union { bf16x8_t v; unsigned u[4]; } pk;
#pragma unroll
                for (int j = 0; j < 4; ++j) { const int r = 8 * (sg & 1) + 2 * j; pk.u[j] = (sg < 2) ? pg8::cvt_pk_bf16(p0[r], p0[r + 1]) : pg8::cvt_pk_bf16(p1[r], p1[r + 1]); }
                pb[sg] = pk.v; }
            at_pv(o0, o1, vb, pb, r32, hi);
        }
        if (tt + 1 < 4) at_store(L + AT_K0 + (cur ^ 1) * AT_KBUF, L + AT_V0 + (cur ^ 1) * AT_VBUF, tid, kr, vr);
        __syncthreads();
    }
    MFMA_FENCE2(o0, o1);
    lsum += __shfl_xor(lsum, 32);
    if (hi == 0 && !DRY) { ((GAS float*)WSF(WS_MREF))[(rowb + q) * 8 + h] = m; ((GAS float*)WSF(WS_LACC))[(rowb + q) * 8 + h] = lsum; }
    LAS bf16* ost = (LAS bf16*)(L + AT_OST + wave * 4096);
#pragma unroll
    for (int r = 0; r < 16; ++r) { ost[r32 * 64 + crow_(r, hi)] = (bf16)f2bf(o0[r]); ost[r32 * 64 + 32 + crow_(r, hi)] = (bf16)f2bf(o1[r]); }
    LDS_WAIT(); asm volatile("" ::: "memory");
    GAS bf16* Og = (GAS bf16*)WSB(WS_PO) + (rowb + q0w) * 512 + h * 64;
#pragma unroll
    for (int i = 0; i < 4; ++i) { const int c = i * 64 + lane, row = c >> 3, ch = c & 7; const v4u ov = *(const LAS v4u*)(ost + row * 64 + ch * 8); if (!DRY || (ov.x == 0x12345678u && ov.y == 0x9abcdef0u)) *(GAS v4u*)(Og + (size_t)row * 512 + ch * 8) = ov; }
}

template <bool DRY = false> __device__ __forceinline__ void moba_item_unit(Frame& F, int l, int b, int h, int n) {
    int tid_ = F.tid; asm volatile("" : "+v"(tid_));
    const int tid = tid_, lane = tid & 63, wave = F.wave, r32 = lane & 31, hi = lane >> 5;
    LAS unsigned char* L = F.lds + RING_OFF;
    LAS float* bt = (LAS float*)(L + IT_BT);
    const size_t rowb = (size_t)b * SEQ;
    const int cnt = (int)((const GAS unsigned*)(F.ws + WS_CTL))[CW_LCNT + ((l * 2 + b) * 8 + h) * 64 + n];
    if (cnt == 0) return;
    const GAS bf16* Kh = (const GAS bf16*)WSB(WS_KA) + rowb * 512 + h * 64; const GAS bf16* Vh = (const GAS bf16*)WSB(WS_VA) + rowb * 512 + h * 64;
    __syncthreads();
    if (tid < 128) { const GAS float* rb = (const GAS float*)INP(I_RELB) + h; bt[tid] = (rb[t5_bucket(tid) * 16] - rb[31 * 16]) * LOG2E; }
#pragma unroll
    for (int t = 0; t < 4; ++t) { v4u kr, vr; at_load(Kh, Vh, 4 * n + t, tid, kr, vr); at_store(L + IT_K + t * AT_KBUF, L + IT_V + t * AT_VBUF, tid, kr, vr); }
    __syncthreads();
    const GAS unsigned short* lst = (const GAS unsigned short*)(F.ws + WS_LISTS) + ((size_t)(b * 8 + h) << 19) + list_off(n);
    LAS int* qpl = (LAS int*)(L + IT_QP + wave * 128);
    LAS float* ostf = (LAS float*)(L + IT_OST + wave * 4096);
    const int ngrp = (cnt + 31) >> 5;
#pragma unroll 1
    for (int g = wave; g < ngrp; g += NWAVES) {
        const int li = g * 32 + r32; const bool valid = li < cnt;
        const int ent = valid ? (int)lst[li] : (int)lst[g * 32];
        const int q = ent & 0x3fff;
        if (hi == 0) qpl[r32] = valid ? ent : -1;
        bf16x8_t qf[4];
        { const GAS bf16* qp = (const GAS bf16*)WSB(WS_QA) + (rowb + q) * 512 + h * 64 + hi * 8;
#pragma unroll
          for (int s = 0; s < 4; ++s) qf[s] = *(const GAS bf16x8_t*)(qp + s * 16); }
        const float mref = ((const GAS float*)WSF(WS_MREF))[(rowb + q) * 8 + h];
        const bool near = __any(q < 256 * (n + 1) + 128);
        float lsum = 0.f;
        f32x16 o0 = {0.f, 0.f, 0.f, 0.f, 0.f, 0.f, 0.f, 0.f, 0.f, 0.f, 0.f, 0.f, 0.f, 0.f, 0.f, 0.f}, o1 = o0;
#pragma unroll 1
        for (int t = 0; t < 4; ++t) {
            const LAS unsigned char* kb = L + IT_K + t * AT_KBUF; const LAS unsigned char* vb = L + IT_V + t * AT_VBUF;
            f32x16 p0 = {0.f, 0.f, 0.f, 0.f, 0.f, 0.f, 0.f, 0.f, 0.f, 0.f, 0.f, 0.f, 0.f, 0.f, 0.f, 0.f}, p1 = p0;
            at_qk(p0, p1, kb, qf, r32, hi);
            MFMA_FENCE2(p0, p1);
            float lq[4] = {0.f, 0.f, 0.f, 0.f};
            if (near) {
#pragma unroll
                for (int r = 0; r < 16; ++r) { const int d0 = q - ((4 * n + t) * 64 + crow_(r, hi)), d1 = d0 - 32;
                    const float b0 = ((unsigned)d0 < 128u) ? bt[d0] : 0.f, b1 = ((unsigned)d1 < 128u) ? bt[d1] : 0.f;
                    const float e0 = __builtin_amdgcn_exp2f(fminf(p0[r] * AT_C2 + b0 - mref, 60.f)), e1 = __builtin_amdgcn_exp2f(fminf(p1[r] * AT_C2 + b1 - mref, 60.f));
                    p0[r] = e0; p1[r] = e1; lq[r & 1] += e0; lq[2 + (r & 1)] += e1; }
            } else {
#pragma unroll
                for (int r = 0; r < 16; ++r) { const float e0 = __builtin_amdgcn_exp2f(fminf(__builtin_fmaf(p0[r], AT_C2, -mref), 60.f)), e1 = __builtin_amdgcn_exp2f(fminf(__builtin_fmaf(p1[r], AT_C2, -mref), 60.f));
                    p0[r] = e0; p1[r] = e1; lq[r & 1] += e0; lq[2 + (r & 1)] += e1; }
            }
            lsum += (lq[0] + lq[1]) + (lq[2] + lq[3]);
            bf16x8_t pb[4];
#pragma unroll
            for (int sg = 0; sg < 4; ++sg) { union { bf16x8_t v; unsigned u[4]; } pk;
#pragma unroll
                for (int j = 0; j < 4; ++j) { const int r = 8 * (sg & 1) + 2 * j; pk.u[j] = (sg < 2) ? pg8::cvt_pk_bf16(p0[r], p0[r + 1]) : pg8::cvt_pk_bf16(p1[r], p1[r + 1]); }
                pb[sg] = pk.v; }
            at_pv(o0, o1, vb, pb, r32, hi);
        }
        MFMA_FENCE2(o0, o1);
        lsum += __shfl_xor(lsum, 32);
        if (hi == 0 && valid && !DRY) ((GAS float*)WSF(WS_LJ))[((size_t)(ent >> 14) * T + rowb + q) * 8 + h] = lsum;
        LAS bf16* ost = (LAS bf16*)ostf;
#pragma unroll
        for (int r = 0; r < 16; ++r) { ost[r32 * 64 + crow_(r, hi)] = (bf16)f2bf(o0[r]); ost[r32 * 64 + 32 + crow_(r, hi)] = (bf16)f2bf(o1[r]); }
        LDS_WAIT(); asm volatile("" ::: "memory");
#pragma unroll
        for (int i = 0; i < 4; ++i) { const int c = i * 64 + lane, row = c >> 3, ch = c & 7; const int er = qpl[row];
            if (er >= 0 && !DRY) { const int j = er >> 14; GAS bf16* pj = (GAS bf16*)pj_base(F, l, j);
                *(GAS v4u*)(pj + (rowb + (er & 0x3fff)) * 512 + h * 64 + ch * 8) = *(const LAS v4u*)(ost + row * 64 + ch * 8); } }
        LDS_WAIT(); asm volatile("" ::: "memory");
    }
}
__device__ __forceinline__ void moba_fin_row(Frame& F, int layer, int m, int lane) {
    const int nsel = ((m & (SEQ - 1)) >> 8) < 3 ? ((m & (SEQ - 1)) >> 8) : 3;
    const int hd = lane >> 3;
    float l = ((const GAS float*)WSF(WS_LACC))[(size_t)m * 8 + hd];
    v4u v = ((const GAS v4u*)((const GAS bf16*)WSB(WS_PO) + (size_t)m * 512))[lane];
    float acc[8] = { __uint_as_float(v.x << 16), __uint_as_float(v.x & 0xffff0000u), __uint_as_float(v.y << 16), __uint_as_float(v.y & 0xffff0000u),
                     __uint_as_float(v.z << 16), __uint_as_float(v.z & 0xffff0000u), __uint_as_float(v.w << 16), __uint_as_float(v.w & 0xffff0000u) };
#pragma unroll
    for (int j = 0; j < 3; ++j) if (j < nsel) {
        l += ((const GAS float*)WSF(WS_LJ))[((size_t)j * T + m) * 8 + hd];
        const v4u w = ((const GAS v4u*)((const GAS bf16*)pj_base(F, layer, j) + (size_t)m * 512))[lane];
        acc[0] += __uint_as_float(w.x << 16); acc[1] += __uint_as_float(w.x & 0xffff0000u); acc[2] += __uint_as_float(w.y << 16); acc[3] += __uint_as_float(w.y & 0xffff0000u);
        acc[4] += __uint_as_float(w.z << 16); acc[5] += __uint_as_float(w.z & 0xffff0000u); acc[6] += __uint_as_float(w.w << 16); acc[7] += __uint_as_float(w.w & 0xffff0000u); }
    const float inv = 1.0f / l;
    v4u o; o.x = pk2(acc[0] * inv, acc[1] * inv); o.y = pk2(acc[2] * inv, acc[3] * inv); o.z = pk2(acc[4] * inv, acc[5] * inv); o.w = pk2(acc[6] * inv, acc[7] * inv);
    ((GAS v4u*)((GAS bf16*)WSB(WS_QA) + (size_t)m * 512))[lane] = o;
}
__global__ void __launch_bounds__(NWAVES * 64, 2) fwd(Args args) {
    extern __shared__ __attribute__((aligned(16))) unsigned char lds[];
    Frame F;
    F.lds = (LAS unsigned char*)lds;
        F.tid = threadIdx.x; F.lane = F.tid & 63; F.wave = __builtin_amdgcn_readfirstlane(F.tid >> 6);
    F.G = gridDim.x; F.bid = blockIdx.x;
    F.a = (const __attribute__((address_space(4))) Args*)__builtin_amdgcn_kernarg_segment_ptr(); F.ws = args.ws; F.out = args.out;
    unsigned char* ws = args.ws;
    for (int u = F.tid; u < (LDS_BYTES - LDSCTL_OFF) / 4; u += NWAVES * 64) ((LAS unsigned*)(F.lds + LDSCTL_OFF))[u] = 0u;
    __syncthreads();
    {
        volatile LAS unsigned* pw = (volatile LAS unsigned*)(F.lds + MISC_OFF) + 64;
        const unsigned hw = __builtin_amdgcn_s_getreg((4 << 0) | (4 << 6) | (1 << 11));
        if (F.lane == 0) pw[F.wave] = hw & 3u;
        __syncthreads();
        const unsigned my = pw[F.wave]; unsigned cnts = 0, rank = 0;
#pragma unroll
        for (int w = 0; w < NWAVES; ++w) { const unsigned s = pw[w]; cnts += 1u << (8 * s); if (w < F.wave && s == my) ++rank; }
#ifdef BAD_ROLES
        F.gw = __builtin_amdgcn_readfirstlane((cnts == 0x02020202u) ? (int)((my >> 1) * 4 + (my & 1) * 2 + rank) : F.wave);
#else
        F.gw = __builtin_amdgcn_readfirstlane((cnts == 0x02020202u) ? (int)(rank * 4 + my) : F.wave);
#endif
        __syncthreads();
    }
    XcdBarrier bar; bar.bar = (unsigned*)(ws + WS_CTL) + CW_BAR; bar.x = 0; bar.st = nullptr;
    if (ONE_LAUNCH) bar = xcd_barrier_post((unsigned*)(ws + WS_CTL) + CW_BAR, (volatile LAS unsigned*)(F.lds + MISC_OFF) + 8);
#define GRID_BAR() do { if (ONE_LAUNCH) xcd_barrier(bar); } while (0)
    const int lo = args.ph_lo, hi = args.ph_hi;
#ifndef PH_MASK
#define PH_MASK 0xfff
#endif
#define IN(k) (((PH_MASK >> ((k) % PH_PER_LAYER == 0 && (k) == 2 * PH_PER_LAYER ? 11 : (k) % PH_PER_LAYER)) & 1) && lo <= (k) && (k) < hi)
#define BOTH(k) (IN(k) && IN((k) + 1))
#define GEMM_TID ((F.gw << 6) | F.lane)
#define DYN_CTR(k) ((unsigned*)(F.ws + WS_CTL) + CW_DYN + 32 * (k))
#define DYN_FETCH(dst, k) do { __syncthreads(); if (F.tid == 0) *((volatile LAS unsigned*)(F.lds + MISC_OFF) + 32) = atomicAdd(DYN_CTR(k), 1u); __syncthreads(); \
        dst = (int)__builtin_amdgcn_readfirstlane(*((volatile LAS unsigned*)(F.lds + MISC_OFF) + 32)); } while (0)
#define LAUNDER() do { asm volatile("" : "+v"(F.tid)); F.lane = F.tid & 63; F.wave = __builtin_amdgcn_readfirstlane(F.tid >> 6); F.ws = launder_u(F.ws); F.out = launder_u(F.out); F.a = launder_u(F.a); F.bid = launder_i(F.bid); F.G = launder_i(F.G); F.gw = launder_i(F.gw); } while (0)
    LAS unsigned char* ring = F.lds + RING_OFF;
    for (int l = 0; l < 2; ++l) {
        const int P = l * PH_PER_LAYER;
#ifdef DBG_DUMP
        if (lo == DBG_PHASE && l == 0) { for (int u = F.bid; u < T; u += F.G) { F.out[(size_t)u * DM + F.tid] = bf2f(WSB(DBG_DUMP)[(size_t)u * DBG_PITCH + F.tid]); F.out[(size_t)u * DM + 512 + F.tid] = 0.f; } }
        if (lo >= DBG_PHASE && lo < 2 * PH_PER_LAYER) continue;
#endif
        if (IN(P + 0)) { LAUNDER(); p_prologue(F, l); if (PROBE_SEL & 128) { VM_WAIT(); __syncthreads(); p_prologue(F, l); } if (BOTH(P + 0)) GRID_BAR(); }
        if (IN(P + 1)) { LAUNDER();
            pg8::Gemm g{WSB(WS_XB), WSB(WS_W_IN), T, NIN_T, DM}; pg8::StaticOrder S; S.init(T, NIN_T, F.G, F.bid);
            pg8::EpiInproj E{WSB(WS_QA), WSB(WS_KI), WSF(WS_WI), SSQ_MIX(l), WSF(WS_KM2)};
            pg8::gemm_phase<pg8::EpiInproj, pg8::StaticOrder, true, PG8_SP2>(ring, g, S, E, GEMM_TID);
            if (PROBE_SEL & 32) { VM_WAIT(); __syncthreads(); LAUNDER(); pg8::gemm_phase<pg8::EpiInproj, pg8::StaticOrder, true, PG8_SP2>(ring, g, S, E, GEMM_TID); }
            if (BOTH(P + 1)) GRID_BAR();
        }
        if (IN(P + 2)) { LAUNDER();
#ifndef FAST_DSA
#define FAST_DSA 1
#endif
            if ((PROBE_SEL & 1024) && F.bid < 256) { for (int r = 0; r < 4; ++r) { const int i = r * 256 + F.bid; moba_own_unit<true>(F, l, (i & 15) >> 3, i & 7, i >> 4); } __syncthreads(); }
            if (FAST_MOBA == 2 && F.bid < 256) { for (int r = 0; r < 4; ++r) { const int i = r * 256 + F.bid; moba_own_unit<false>(F, l, (i & 15) >> 3, i & 7, i >> 4); } __syncthreads(); }
            for (int rep = 0; rep < ((PROBE_SEL & 64) ? 2 : 1); ++rep)
            for (int u = F.bid; u < 2 * RGC; u += F.G) rg_unit<false>(F, l, u / RGC, u % RGC);
            if (FAST_DSA) {
                for (;;) { int i; DYN_FETCH(i, 2 * l); if (i >= 2048) break; const int stt = 63 - (i >> 5), j = i & 31; idx_unit(F, j >> 4, stt * 256 + (j & 15) * 16); }
                __syncthreads();
            }
            if (BOTH(P + 2)) GRID_BAR();
        }
        if (IN(P + 3)) { LAUNDER();
            #ifndef MIX2_SEL
#define MIX2_SEL 7
#endif
            if (MIX2_SEL & 1) for (int u = F.bid; u < 2 * RGC; u += F.G) rg_unit<true>(F, l, u / RGC, u % RGC);
            if (FAST_MOBA == 2 && F.bid < 256) {
                if (PROBE_SEL & 2048) for (int r = 0; r < 4; ++r) { const int g = F.bid; const int i = r * 256 + ((r & 1) ? 255 - g : g); moba_item_unit<true>(F, l, (i & 15) >> 3, i & 7, i >> 4); }
                for (int r = 0; r < 4; ++r) { const int g = F.bid; const int i = r * 256 + ((r & 1) ? 255 - g : g); moba_item_unit<false>(F, l, (i & 15) >> 3, i & 7, i >> 4); }
                __syncthreads();
            }
            if (FAST_MOBA == 1 && (MIX2_SEL & 2)) {
                if (PROBE_SEL & 1) { for (int r = 0; r < 4; ++r) { const int g = F.bid % 256; const int i = r * 256 + ((r & 1) ? 255 - g : g); if (F.bid >= 256) break;
                    const int qt = 63 - (i >> 4), bh = i & 15; attn_unit<0, true>(F, bh >> 3, bh & 7, qt); } }
                for (int r = 0; r < 4; ++r) { const int g = F.bid % 256; const int i = r * 256 + ((r & 1) ? 255 - g : g); if (F.bid >= 256) break;
                    const int qt = 63 - (i >> 4), bh = i & 15; attn_unit<0>(F, bh >> 3, bh & 7, qt); }
                __syncthreads();
            }
            if (FAST_DSA && (MIX2_SEL & 4)) {
                if (PROBE_SEL & 2) { for (int r = 0; r < 4; ++r) { const int g = F.bid % 256; const int i = r * 256 + ((r & 1) ? 255 - g : g); if (F.bid >= 256) break;
                    const int qt = 63 - (i >> 4), bh = i & 15; dsa_attn2_unit<true>(F, bh >> 3, bh & 7, qt); } }
                for (;;) { int i; DYN_FETCH(i, 2 * l + 1); if (i >= 1024) break;
                    const int qt = 63 - (i >> 4), bh = i & 15; dsa_attn2_unit<false>(F, bh >> 3, bh & 7, qt); }
                __syncthreads();
            }
            if (!(FAST_MOBA && FAST_DSA)) for (int u = F.bid; u < T; u += F.G) { const int b = u & 1, t = u >> 1; if (FAST_MOBA == 0 && (MIX2_SEL & 2)) moba_unit(F, b, t); if (!FAST_DSA && (MIX2_SEL & 4)) dsa_unit(F, b, t); }
            for (int u = F.bid; u < T; u += F.G) { if (!(MIX2_SEL & 2)) WSB(WS_QA)[(size_t)u * 512 + F.tid] = 0; if (!(MIX2_SEL & 4)) WSB(WS_QB)[(size_t)u * 512 + F.tid] = 0; if (!(MIX2_SEL & 1)) WSB(WS_YC)[(size_t)u * 512 + F.tid] = 0; }
            if (BOTH(P + 3)) GRID_BAR();
        }

        if (IN(P + 4)) { LAUNDER();
            if (FAST_MOBA == 2) { const int gw = F.bid * NWAVES + F.wave, NGW = F.G * NWAVES; const float* xin = (l == 0) ? INP(I_X) : (const float*)F.out;
                for (int m = gw; m < T; m += NGW) moba_fin_row(F, l, m, F.lane);
                if (l != 0) {
                    GRID_BAR();
                    for (int m = gw; m < T; m += NGW) norm_row(xin + (size_t)m * DM, WSB(WS_XB) + (size_t)m * DM, SSQ_MIX(l) + m, F.lane); } }
            if (BOTH(P + 4)) GRID_BAR();
        }
        if (IN(P + 5)) { LAUNDER();
            pg8::Gemm g{WSB(WS_XB), WSB(WS_W_G), T, 3072, DM}; pg8::StaticOrder S; S.init(T, 3072, F.G, F.bid);
            pg8::EpiGates E{WSB(WS_G), SSQ_MIX(l)};
            pg8::gemm_phase<pg8::EpiGates, pg8::StaticOrder, true, PG8_SP2>(ring, g, S, E, GEMM_TID);
            if (PROBE_SEL & 32) { VM_WAIT(); __syncthreads(); LAUNDER(); pg8::gemm_phase<pg8::EpiGates, pg8::StaticOrder, true, PG8_SP2>(ring, g, S, E, GEMM_TID); }
            if (BOTH(P + 5)) GRID_BAR();
        }
        if (IN(P + 6)) { LAUNDER();
            pg8::StaticOrder S; S.init(T, DM, F.G, F.bid);
            { pg8::Gemm g{WSB(WS_QA), WSB(WS_W_PA), T, DM, DH}; pg8::EpiMerge<true> E{WSB(WS_G), WSB(WS_MERGED)}; pg8::gemm_phase<pg8::EpiMerge<true>, pg8::StaticOrder, true, PG8_SP2>(ring, g, S, E, GEMM_TID); }
#ifndef MERGE_CALLS
#define MERGE_CALLS 3
#endif
            VM_WAIT(); __syncthreads(); LAUNDER();
            if (MERGE_CALLS >= 2) { pg8::Gemm g{WSB(WS_QB), WSB(WS_W_PB), T, DM, DH}; pg8::EpiMerge<false> E{WSB(WS_G) + (size_t)T * 1024, WSB(WS_MERGED)}; pg8::gemm_phase<pg8::EpiMerge<false>, pg8::StaticOrder, true, PG8_SP2>(ring, g, S, E, GEMM_TID); }
            VM_WAIT(); __syncthreads(); LAUNDER();
            if (MERGE_CALLS >= 3) { pg8::Gemm g{WSB(WS_YC), WSB(WS_W_PC), T, DM, DH}; pg8::EpiMerge<false> E{WSB(WS_G) + (size_t)2 * T * 1024, WSB(WS_MERGED)}; pg8::gemm_phase<pg8::EpiMerge<false>, pg8::StaticOrder, true, PG8_SP2>(ring, g, S, E, GEMM_TID); }
            if (BOTH(P + 6)) GRID_BAR();
        }
        if (IN(P + 7)) { LAUNDER();
            pg8::Gemm g{WSB(WS_MERGED), WSB(WS_W_O), T, DM, DM}; pg8::StaticOrder S; S.init(T, DM, F.G, F.bid);
            pg8::EpiResid E{(l == 0) ? INP(I_X) : (const float*)F.out, F.out, WSB(WS_XB), SSQ_MLP(l)};
            pg8::gemm_phase<pg8::EpiResid, pg8::StaticOrder, true, PG8_SP2>(ring, g, S, E, GEMM_TID);
            if (BOTH(P + 7)) GRID_BAR();
        }
        if (IN(P + 8)) {   }
        if (IN(P + 9)) { LAUNDER();
            pg8::Gemm g{WSB(WS_XB), WSB(WS_W_UP), T, DFF, DM}; pg8::StaticOrder S; S.init(T, DFF, F.G, F.bid);
            pg8::EpiUp E{WSB(WS_H), SSQ_MLP(l)};
            pg8::gemm_phase<pg8::EpiUp, pg8::StaticOrder, true, PG8_SP2>(ring, g, S, E, GEMM_TID);
            if (PROBE_SEL & 32) { VM_WAIT(); __syncthreads(); LAUNDER(); pg8::gemm_phase<pg8::EpiUp, pg8::StaticOrder, true, PG8_SP2>(ring, g, S, E, GEMM_TID); }
            if (BOTH(P + 9)) GRID_BAR();
        }
        if (IN(P + 10)) { LAUNDER();
            pg8::Gemm g{WSB(WS_H), WSB(WS_W_DN), T, DM, DFF}; pg8::StaticOrder S; S.init(T, DM, F.G, F.bid);
            pg8::EpiResid E{(const float*)F.out, F.out, (l == 0) ? WSB(WS_XB) : (bf16*)nullptr, (float*)(F.ws + WS_CTL) + CW_SSQ + T};
            pg8::gemm_phase<pg8::EpiResid, pg8::StaticOrder, true, PG8_SP2>(ring, g, S, E, GEMM_TID);
            if (BOTH(P + 10)) GRID_BAR();
        }
    }
    if (IN(2 * PH_PER_LAYER)) { LAUNDER(); p_final(F); }
#undef IN
#undef BOTH
#undef GRID_BAR
}

extern "C" void kernel_launch(void* const* d_in, const int* in_sizes, int n_in, void* d_out, int out_size, void* d_ws, size_t ws_size, hipStream_t stream) {
    static int grid = 0;
    if (grid == 0) {
        if (n_in != 19 || in_sizes[0] != T * DM || out_size != T * DM || ws_size < WS_END) { fprintf(stderr, "kernel_launch: unexpected shapes (n_in %d, in0 %d, out %d, ws %zu)\n", n_in, n_in > 0 ? in_sizes[0] : -1, out_size, ws_size); grid = -1; return; }
        int dev = 0, cus = 0, per_cu = 0;
        if (hipGetDevice(&dev) != hipSuccess || hipDeviceGetAttribute(&cus, hipDeviceAttributeMultiprocessorCount, dev) != hipSuccess) { grid = -1; return; }
        if (hipFuncSetAttribute((const void*)fwd, hipFuncAttributeMaxDynamicSharedMemorySize, LDS_BYTES) != hipSuccess) { fprintf(stderr, "kernel_launch: hipFuncSetAttribute failed\n"); grid = -1; return; }
        if (hipOccupancyMaxActiveBlocksPerMultiprocessor(&per_cu, (const void*)fwd, NWAVES * 64, LDS_BYTES) != hipSuccess || per_cu < 1) { fprintf(stderr, "kernel_launch: occupancy query says %d\n", per_cu); }
        (void)hipGetLastError();
        grid = cus;
    }
    if (grid < 0) return;
    if (hipMemsetAsync((char*)d_ws + WS_CTL, 0, CTL_ZERO_BYTES, stream) != hipSuccess) return;
    Args a{};
    for (int i = 0; i < 19; ++i) a.in[i] = (const float*)d_in[i];
    a.out = (float*)d_out; a.ws = (unsigned char*)d_ws;
    if (ONE_LAUNCH) { a.ph_lo = 0; a.ph_hi = N_PHASES; hipLaunchKernelGGL(fwd, dim3(grid), dim3(NWAVES * 64), LDS_BYTES, stream, a); }
    else for (int p = 0; p < N_PHASES; ++p) { a.ph_lo = p; a.ph_hi = p + 1; hipLaunchKernelGGL(fwd, dim3(grid), dim3(NWAVES * 64), LDS_BYTES, stream, a); }
}
```

```cpp
#include <hip/hip_runtime.h>
#include <cstdio>
#include <cstdint>

#ifndef MK_ONE_LAUNCH
#define MK_ONE_LAUNCH 1
#endif

constexpr int BATCH = 2, SEQ = 16384, DM = 1024, T = BATCH * SEQ;
constexpr int DIN = 7752, DFF = 4096, DH = 512;
constexpr int NIN_T = 4864;
constexpr int NBLK = SEQ / 256;
constexpr float EPS = 1e-6f;

namespace pg8 {
#define PG8_LAS __attribute__((address_space(3)))
typedef unsigned short bf16_t;
typedef short bf16x8 __attribute__((ext_vector_type(8)));
typedef float f32x4 __attribute__((ext_vector_type(4)));
typedef unsigned u32x4 __attribute__((ext_vector_type(4)));
constexpr int BM = 256, BK = 64, HALF = 128, HTB = HALF * BK * 2  , STAGE_BYTES = 8 * HTB, NXCD = 8, WGM = 8;

__host__ __device__ __forceinline__ int lds_byte(int r, int c) { const int st = (r >> 4) * 2 + (c >> 5), rr = r & 15, cc = c & 31, ob = rr * 64 + cc * 2; return st * 1024 + (ob ^ (((ob >> 9) & 1) << 5)); }
__host__ __device__ __forceinline__ void stage_rc(int b, int& R, int& C) { const int st = b / 1024, sb = b % 1024, swz = sb ^ (((sb >> 9) & 1) << 5); R = (st >> 1) * 16 + swz / 64; C = (st & 1) * 32 + (swz % 64) / 2; }
__host__ __device__ __forceinline__ int perm32(int rho) { const int n = rho >> 4, i = rho & 15; return 8 * (i >> 2) + 4 * n + (i & 3); }

struct Unit { int pm, pn; };
struct Gemm { const bf16_t* A; const bf16_t* Bt; int M, N, K; };

struct StaticOrder {
    int nM, nN, nwg, G, c;
    __host__ __device__ void init(int M, int N, int G_, int c_) { nM = M / BM; nN = N / BM; nwg = nM * nN; G = G_; c = c_; }
    __host__ __device__ bool next(int i, Unit& u) const {
        const long L = (long)i * G + c; if (L >= nwg) return false;
        int wgid = (int)L; { const int q = nwg / NXCD, r = nwg % NXCD, xcd = wgid % NXCD, off = wgid / NXCD; wgid = (xcd < r ? xcd * (q + 1) : r * (q + 1) + (xcd - r) * q) + off; }
        const int nig = WGM * nN, gid = wgid / nig, fm = gid * WGM, gsz = (nM - fm) < WGM ? (nM - fm) : WGM;
        u.pm = fm + ((wgid % nig) % gsz); u.pn = (wgid % nig) / gsz; return true;
    }
    __device__ __forceinline__ void a_ready(const Unit&) const {}
    __device__ __forceinline__ void done(const Unit&) const {}
};

typedef float f32x2_t __attribute__((ext_vector_type(2))); typedef __bf16 bf16x2_t __attribute__((ext_vector_type(2)));
__device__ __forceinline__ unsigned cvt_pk_bf16(float lo, float hi) { f32x2_t v = {lo, hi}; bf16x2_t b = __builtin_convertvector(v, bf16x2_t); return __builtin_bit_cast(unsigned, b); }
__device__ __forceinline__ float bf_lo(unsigned w) { return __uint_as_float(w << 16); }
__device__ __forceinline__ float bf_hi(unsigned w) { return __uint_as_float(w & 0xffff0000u); }

struct EpiInproj {
    static constexpr bool PERM = true, AFTER_DRAIN = false;
    bf16_t* base; bf16_t* ki; float* wi; const float* rstd  ; float* km2;
    __device__ __forceinline__ void operator()(const f32x4 (&acc)[2][2][4][2], const Unit& u, int wr, int wc, int fr, int fq) const {
        const int row0 = u.pm * BM + wr * 64 + fr;
        if (u.pn < 18) {
            bf16_t* dst = base + (size_t)(u.pn >> 1) * ((size_t)T * 512) + (u.pn & 1) * 256 + wc * 32 + 8 * fq;
            const bool ksum = (u.pn >> 1) == 3;
            f32x4 cs[2][2] = {{{0.f, 0.f, 0.f, 0.f}, {0.f, 0.f, 0.f, 0.f}}, {{0.f, 0.f, 0.f, 0.f}, {0.f, 0.f, 0.f, 0.f}}};
#pragma unroll
            for (int ai = 0; ai < 2; ++ai)
#pragma unroll
                for (int m = 0; m < 4; ++m) { const int row = row0 + ai * HALF + m * 16; const float rs = __builtin_amdgcn_rsqf(rstd[row] * (1.0f / 1024.0f) + EPS); bf16_t* rowp = dst + (size_t)row * 512;
#pragma unroll
                    for (int bj = 0; bj < 2; ++bj) { const f32x4 v0 = acc[ai][bj][m][0] * rs, v1 = acc[ai][bj][m][1] * rs;
                        if (ksum) { cs[bj][0] += v0; cs[bj][1] += v1; }
                        u32x4 w; w.x = cvt_pk_bf16(v0[0], v0[1]); w.y = cvt_pk_bf16(v0[2], v0[3]); w.z = cvt_pk_bf16(v1[0], v1[1]); w.w = cvt_pk_bf16(v1[2], v1[3]);
                        *(u32x4*)(rowp + bj * HALF) = w; } }
            if (ksum) {
#pragma unroll
                for (int bj = 0; bj < 2; ++bj)
#pragma unroll
                    for (int n = 0; n < 2; ++n)
#pragma unroll
                        for (int j = 0; j < 4; ++j) { float v = cs[bj][n][j]; v += __shfl_xor(v, 1); v += __shfl_xor(v, 2); v += __shfl_xor(v, 4); v += __shfl_xor(v, 8); cs[bj][n][j] = v; }
                if (fr == 0) { float* kd = km2 + ((size_t)u.pm * 2 + wr) * 512 + (u.pn & 1) * 256 + wc * 32 + 8 * fq;
#pragma unroll
                    for (int bj = 0; bj < 2; ++bj) { *(f32x4*)(kd + bj * HALF) = cs[bj][0]; *(f32x4*)(kd + bj * HALF + 4) = cs[bj][1]; } }
            }
        } else {
#pragma unroll
            for (int ai = 0; ai < 2; ++ai)
#pragma unroll
                for (int m = 0; m < 4; ++m) { const int row = row0 + ai * HALF + m * 16; const float rs = __builtin_amdgcn_rsqf(rstd[row] * (1.0f / 1024.0f) + EPS);
                    const f32x4 v0 = acc[ai][0][m][0] * rs, v1 = acc[ai][0][m][1] * rs;
                    if (wc < 2) { u32x4 w; w.x = cvt_pk_bf16(v0[0], v0[1]); w.y = cvt_pk_bf16(v0[2], v0[3]); w.z = cvt_pk_bf16(v1[0], v1[1]); w.w = cvt_pk_bf16(v1[2], v1[3]);
                        *(u32x4*)(ki + (size_t)row * 64 + wc * 32 + 8 * fq) = w; }
                    else if (wc == 2 && fq == 0) { *(f32x4*)(wi + (size_t)row * 8) = v0; *(f32x4*)(wi + (size_t)row * 8 + 4) = v1; } }
        }
    }
};
struct EpiGates {
    static constexpr bool PERM = true, AFTER_DRAIN = false;
    bf16_t* O; const float* rstd;
    __device__ __forceinline__ void operator()(const f32x4 (&acc)[2][2][4][2], const Unit& u, int wr, int wc, int fr, int fq) const {
        const int row0 = u.pm * BM + wr * 64 + fr; const int tsel = u.pn >> 2;
        bf16_t* dst = O + (size_t)tsel * ((size_t)T * 1024) + (u.pn & 3) * 256 + wc * 32 + 8 * fq;
#pragma unroll
        for (int ai = 0; ai < 2; ++ai)
#pragma unroll
            for (int m = 0; m < 4; ++m) { const int row = row0 + ai * HALF + m * 16; const float rs = __builtin_amdgcn_rsqf(rstd[row] * (1.0f / 1024.0f) + EPS); bf16_t* rowp = dst + (size_t)row * 1024;
#pragma unroll
                for (int bj = 0; bj < 2; ++bj) { float v[8];
#pragma unroll
                    for (int j = 0; j < 4; ++j) { v[j] = acc[ai][bj][m][0][j] * rs; v[4 + j] = acc[ai][bj][m][1][j] * rs; }
#pragma unroll
                    for (int j = 0; j < 8; ++j) v[j] = __builtin_amdgcn_rcpf(1.0f + __builtin_amdgcn_exp2f(-1.4426950408889634f * v[j]));
                    u32x4 w; w.x = cvt_pk_bf16(v[0], v[1]); w.y = cvt_pk_bf16(v[2], v[3]); w.z = cvt_pk_bf16(v[4], v[5]); w.w = cvt_pk_bf16(v[6], v[7]);
                    *(u32x4*)(rowp + bj * HALF) = w; } }
    }
};
template <bool FIRST> struct EpiMerge {
    static constexpr bool PERM = true, AFTER_DRAIN = false;
    const bf16_t* G; bf16_t* Mg;
    __device__ __forceinline__ void operator()(const f32x4 (&acc)[2][2][4][2], const Unit& u, int wr, int wc, int fr, int fq) const {
        const int row0 = u.pm * BM + wr * 64 + fr; const int col0 = u.pn * BM + wc * 32 + 8 * fq;
#pragma unroll
        for (int ai = 0; ai < 2; ++ai)
#pragma unroll
            for (int m = 0; m < 4; ++m) { const size_t off = (size_t)(row0 + ai * HALF + m * 16) * 1024 + col0;
#pragma unroll
                for (int bj = 0; bj < 2; ++bj) { const u32x4 g = *(const u32x4*)(G + off + bj * HALF); const f32x4 a0 = acc[ai][bj][m][0], a1 = acc[ai][bj][m][1];
                    float v[8] = { bf_lo(g.x) * a0[0], bf_hi(g.x) * a0[1], bf_lo(g.y) * a0[2], bf_hi(g.y) * a0[3], bf_lo(g.z) * a1[0], bf_hi(g.z) * a1[1], bf_lo(g.w) * a1[2], bf_hi(g.w) * a1[3] };
                    if (!FIRST) { const u32x4 o = *(const u32x4*)(Mg + off + bj * HALF);
                        v[0] += bf_lo(o.x); v[1] += bf_hi(o.x); v[2] += bf_lo(o.y); v[3] += bf_hi(o.y); v[4] += bf_lo(o.z); v[5] += bf_hi(o.z); v[6] += bf_lo(o.w); v[7] += bf_hi(o.w); }
                    u32x4 w; w.x = cvt_pk_bf16(v[0], v[1]); w.y = cvt_pk_bf16(v[2], v[3]); w.z = cvt_pk_bf16(v[4], v[5]); w.w = cvt_pk_bf16(v[6], v[7]);
                    *(u32x4*)(Mg + off + bj * HALF) = w; }
                asm volatile("" ::: "memory"); }
    }
};
struct EpiResid {
    static constexpr bool PERM = false, AFTER_DRAIN = false;
    const float* src; float* out; bf16_t* xb; float* ssq;
    __device__ __forceinline__ void operator()(const f32x4 (&acc)[2][2][4][2], const Unit& u, int wr, int wc, int fr, int fq) const {
        const int row0 = u.pm * BM + wr * 64 + fr, col0 = u.pn * BM + wc * 32 + 4 * fq;
#pragma unroll
        for (int ai = 0; ai < 2; ++ai)
#pragma unroll
            for (int m = 0; m < 4; ++m) { const int row = row0 + ai * HALF + m * 16; const size_t off = (size_t)row * 1024 + col0; float sq = 0.f;
#pragma unroll
                for (int bj = 0; bj < 2; ++bj)
#pragma unroll
                    for (int n = 0; n < 2; ++n) { const f32x4 s = *(const f32x4*)(src + off + bj * HALF + n * 16); const f32x4 v = s + acc[ai][bj][m][n]; *(f32x4*)(out + off + bj * HALF + n * 16) = v;
                        if (xb) { typedef unsigned u32x2v __attribute__((ext_vector_type(2))); u32x2v w; w.x = cvt_pk_bf16(v[0], v[1]); w.y = cvt_pk_bf16(v[2], v[3]); *(u32x2v*)(xb + off + bj * HALF + n * 16) = w;
                            sq += (v[0] * v[0] + v[1] * v[1]) + (v[2] * v[2] + v[3] * v[3]); } }
                if (xb) { sq += __shfl_xor(sq, 16); sq += __shfl_xor(sq, 32); if (fq == 0) unsafeAtomicAdd(ssq + row, sq); } }
    }
};
struct EpiUp {
    static constexpr bool PERM = true, AFTER_DRAIN = false;
    bf16_t* O; const float* rstd;
    __device__ __forceinline__ void operator()(const f32x4 (&acc)[2][2][4][2], const Unit& u, int wr, int wc, int fr, int fq) const {
        const int row0 = u.pm * BM + wr * 64 + fr; const int col0 = u.pn * BM + wc * 32 + 8 * fq;
#pragma unroll
        for (int ai = 0; ai < 2; ++ai)
#pragma unroll
            for (int m = 0; m < 4; ++m) { const int row = row0 + ai * HALF + m * 16; const float rs = __builtin_amdgcn_rsqf(rstd[row] * (1.0f / 1024.0f) + EPS); bf16_t* rowp = O + (size_t)row * DFF + col0;
#pragma unroll
                for (int bj = 0; bj < 2; ++bj) { float v[8];
#pragma unroll
                    for (int j = 0; j < 4; ++j) { v[j] = fmaxf(acc[ai][bj][m][0][j] * rs, 0.f); v[4 + j] = fmaxf(acc[ai][bj][m][1][j] * rs, 0.f); }
#pragma unroll
                    for (int j = 0; j < 8; ++j) v[j] = v[j] * v[j];
                    u32x4 w; w.x = cvt_pk_bf16(v[0], v[1]); w.y = cvt_pk_bf16(v[2], v[3]); w.z = cvt_pk_bf16(v[4], v[5]); w.w = cvt_pk_bf16(v[6], v[7]);
                    *(u32x4*)(rowp + bj * HALF) = w; } }
    }
};

template <class Epi, class Sched, bool ALIGN_EPI = false, bool SP2 = false>
__device__ __forceinline__ void gemm_phase(PG8_LAS unsigned char* lds, const Gemm g, const Sched& S, const Epi& E, int tid_in) {
    int tid_ = tid_in; asm volatile("" : "+v"(tid_));
    const int tid = tid_, wid = __builtin_amdgcn_readfirstlane(tid >> 6), lane = tid & 63, wr = wid >> 2, wc = wid & 3, fr = lane & 15, fq = lane >> 4;
    const int K = g.K, nt = K / BK;
    unsigned voffA[2], voffB[2];
#pragma unroll
    for (int i = 0; i < 2; ++i) { int R, C; stage_rc(tid * 16 + i * 8192, R, C); const int Rb = Epi::PERM ? ((R & ~31) + perm32(R & 31)) : R;
        voffA[i] = (unsigned)(R * K + C) * 2u; voffB[i] = (unsigned)(Rb * K + C) * 2u; }
    const size_t kstep = (size_t)(BK * 2);
    const size_t hstep = (size_t)HALF * K * 2;
    const size_t tstep = 2 * hstep;
    const unsigned ldsw = (unsigned)wid * 1024u;
    const int aoff = lds_byte(wr * 64 + fr, fq * 8), boff = lds_byte(wc * 32 + fr, fq * 8);
#define PG8_SA(b, h) (((b) * 2 + (h)) * HTB)
#define PG8_SB(b, h) ((4 + (b) * 2 + (h)) * HTB)
#define PG8_STAGE(bufoff, gbase, voff) do { _Pragma("unroll") for (int _i = 0; _i < 2; ++_i) \
        __builtin_amdgcn_global_load_lds((const unsigned*)((const char*)(gbase) + (voff)[_i]), (PG8_LAS unsigned*)(lds + (bufoff) + ldsw + _i * 8192), 16, 0, 0); } while (0)
#define PG8_LDA(dst, b, h) do { _Pragma("unroll") for (int m = 0; m < 4; ++m) _Pragma("unroll") for (int k = 0; k < 2; ++k) dst[m][k] = *(const PG8_LAS bf16x8*)(lds + PG8_SA(b, h) + aoff + m * 2048 + k * 1024); } while (0)
#define PG8_LDB(dst, b, h) do { _Pragma("unroll") for (int n = 0; n < 2; ++n) _Pragma("unroll") for (int k = 0; k < 2; ++k) dst[n][k] = *(const PG8_LAS bf16x8*)(lds + PG8_SB(b, h) + boff + n * 2048 + k * 1024); } while (0)
#define PG8_MMA(ai, bj, At, Bt) do { __builtin_amdgcn_s_setprio(1); _Pragma("unroll") for (int m = 0; m < 4; ++m) _Pragma("unroll") for (int n = 0; n < 2; ++n) _Pragma("unroll") for (int k = 0; k < 2; ++k) \
        acc[ai][bj][m][n] = __builtin_amdgcn_mfma_f32_16x16x32_bf16(Bt[n][k], At[m][k], acc[ai][bj][m][n], 0, 0, 0); __builtin_amdgcn_s_setprio(0); } while (0)
#define PG8_WAIT_V(n) asm volatile("s_waitcnt vmcnt(" #n ")" ::: "memory")
#define PG8_WAIT_L(n) asm volatile("s_waitcnt lgkmcnt(" #n ")" ::: "memory")
#define PG8_BAR __builtin_amdgcn_s_barrier()
#define PG8_SCHED __builtin_amdgcn_sched_barrier(0)
    Unit cur, nxt; int ui = 0;
    if (!S.next(0, cur)) return;
    f32x4 acc[2][2][4][2];
#pragma unroll
    for (int a = 0; a < 2; ++a)
#pragma unroll
        for (int b = 0; b < 2; ++b)
#pragma unroll
            for (int m = 0; m < 4; ++m)
#pragma unroll
                for (int n = 0; n < 2; ++n) acc[a][b][m][n] = (f32x4){0.f, 0.f, 0.f, 0.f};
    bf16x8 At[4][2], B0[2][2], B1[2][2];
    const char* cA = (const char*)g.A + (size_t)cur.pm * tstep; const char* cB = (const char*)g.Bt + (size_t)cur.pn * tstep;
    S.a_ready(cur);
    if constexpr (SP2) {
        PG8_STAGE(PG8_SB(0, 0), cB, voffB); PG8_STAGE(PG8_SB(0, 1), cB + hstep, voffB); PG8_STAGE(PG8_SA(0, 0), cA, voffA); PG8_STAGE(PG8_SA(0, 1), cA + hstep, voffA);
        if (wr == 1) PG8_BAR;
        PG8_WAIT_V(2); PG8_BAR;
        PG8_STAGE(PG8_SB(1, 0), cB + kstep, voffB); PG8_STAGE(PG8_SA(1, 0), cA + kstep, voffA); PG8_STAGE(PG8_SB(1, 1), cB + hstep + kstep, voffB);
        PG8_WAIT_V(6); PG8_BAR;
    } else {
        PG8_STAGE(PG8_SB(0, 0), cB, voffB); PG8_STAGE(PG8_SA(0, 0), cA, voffA); PG8_STAGE(PG8_SB(0, 1), cB + hstep, voffB); PG8_STAGE(PG8_SA(0, 1), cA + hstep, voffA);
        if (wr == 1) PG8_BAR;
        PG8_WAIT_V(4); PG8_BAR;
        PG8_STAGE(PG8_SB(1, 0), cB + kstep, voffB); PG8_STAGE(PG8_SA(1, 0), cA + kstep, voffA); PG8_STAGE(PG8_SB(1, 1), cB + hstep + kstep, voffB);
        PG8_WAIT_V(6); PG8_BAR;
    }
    for (;;) {
        const bool has_next = S.next(ui + 1, nxt);
        const char* nA = has_next ? (const char*)g.A + (size_t)nxt.pm * tstep : cA; const char* nB = has_next ? (const char*)g.Bt + (size_t)nxt.pn * tstep : cB;
        for (int t = 0; t < nt; t += 2) {
            const bool last = (t == nt - 2);
            const char* a1 = cA + (size_t)(t + 1) * kstep;
            const char* a2 = last ? nA : cA + (size_t)(t + 2) * kstep; const char* b2 = last ? nB : cB + (size_t)(t + 2) * kstep;
            const char* a3 = a2 + kstep; const char* b3 = b2 + kstep;
            if (last && has_next) S.a_ready(nxt);
            if constexpr (SP2) {
            PG8_LDB(B0, 0, 0); PG8_LDB(B1, 0, 1); PG8_SCHED; PG8_LDA(At, 0, 0); PG8_STAGE(PG8_SA(1, 1), a1 + hstep, voffA);
            PG8_WAIT_V(8); PG8_WAIT_L(0); PG8_BAR; PG8_MMA(0, 0, At, B0); PG8_MMA(0, 1, At, B1); PG8_BAR; PG8_SCHED;
            PG8_LDA(At, 0, 1); PG8_STAGE(PG8_SB(0, 0), b2, voffB); PG8_STAGE(PG8_SB(0, 1), b2 + hstep, voffB); PG8_STAGE(PG8_SA(0, 0), a2, voffA);
            PG8_WAIT_V(8); PG8_WAIT_L(0); PG8_BAR; PG8_MMA(1, 0, At, B0); PG8_MMA(1, 1, At, B1); PG8_BAR; PG8_SCHED;
            PG8_LDB(B0, 1, 0); PG8_LDB(B1, 1, 1); PG8_SCHED; PG8_LDA(At, 1, 0); PG8_STAGE(PG8_SA(0, 1), a2 + hstep, voffA);
            PG8_WAIT_V(8); PG8_WAIT_L(0); PG8_BAR; PG8_MMA(0, 0, At, B0); PG8_MMA(0, 1, At, B1); PG8_BAR; PG8_SCHED;
            PG8_LDA(At, 1, 1); PG8_STAGE(PG8_SB(1, 0), b3, voffB); PG8_STAGE(PG8_SB(1, 1), b3 + hstep, voffB); PG8_STAGE(PG8_SA(1, 0), a3, voffA);
            PG8_WAIT_V(8); PG8_WAIT_L(0); PG8_BAR; PG8_MMA(1, 0, At, B0); PG8_MMA(1, 1, At, B1); PG8_BAR; PG8_SCHED;
            } else {
            PG8_LDB(B0, 0, 0); PG8_SCHED; PG8_LDA(At, 0, 0); PG8_STAGE(PG8_SA(1, 1), a1 + hstep, voffA);
            PG8_WAIT_L(8); PG8_BAR; PG8_WAIT_L(0); PG8_MMA(0, 0, At, B0); PG8_BAR; PG8_SCHED;
            PG8_LDB(B1, 0, 1); PG8_STAGE(PG8_SB(0, 0), b2, voffB);
            PG8_BAR; PG8_WAIT_L(0); PG8_MMA(0, 1, At, B1); PG8_BAR;
            PG8_LDA(At, 0, 1); PG8_STAGE(PG8_SA(0, 0), a2, voffA);
            PG8_BAR; PG8_WAIT_L(0); PG8_MMA(1, 0, At, B0); PG8_BAR; PG8_SCHED;
            PG8_STAGE(PG8_SB(0, 1), b2 + hstep, voffB);
            PG8_WAIT_V(6); PG8_BAR; PG8_MMA(1, 1, At, B1); PG8_BAR;
            PG8_LDB(B0, 1, 0); PG8_SCHED; PG8_LDA(At, 1, 0); PG8_STAGE(PG8_SA(0, 1), a2 + hstep, voffA);
            PG8_WAIT_L(8); PG8_BAR; PG8_WAIT_L(0); PG8_MMA(0, 0, At, B0); PG8_BAR; PG8_SCHED;
            PG8_LDB(B1, 1, 1); PG8_STAGE(PG8_SB(1, 0), b3, voffB);
            PG8_BAR; PG8_WAIT_L(0); PG8_MMA(0, 1, At, B1); PG8_BAR;
            PG8_LDA(At, 1, 1); PG8_STAGE(PG8_SA(1, 0), a3, voffA);
            PG8_BAR; PG8_WAIT_L(0); PG8_MMA(1, 0, At, B0); PG8_BAR; PG8_SCHED;
            PG8_STAGE(PG8_SB(1, 1), b3 + hstep, voffB);
            PG8_WAIT_V(6); PG8_BAR; PG8_MMA(1, 1, At, B1); PG8_BAR;
            }
        }
        if constexpr (ALIGN_EPI) { if (wr == 0) PG8_BAR; }
        if constexpr (!Epi::AFTER_DRAIN) { E(acc, cur, wr, wc, fr, fq); S.done(cur); }
        if (!has_next) break;
#pragma unroll
        for (int a = 0; a < 2; ++a)
#pragma unroll
            for (int b = 0; b < 2; ++b)
#pragma unroll
                for (int m = 0; m < 4; ++m)
#pragma unroll
                    for (int n = 0; n < 2; ++n) acc[a][b][m][n] = (f32x4){0.f, 0.f, 0.f, 0.f};
        cur = nxt; cA = nA; cB = nB; ++ui;
        if constexpr (ALIGN_EPI) { if (wr == 1) PG8_BAR; }
    }
    PG8_WAIT_V(0);
    if constexpr (!ALIGN_EPI) { if (wr == 0) PG8_BAR; }
    PG8_BAR;
    if constexpr (Epi::AFTER_DRAIN) { E.fused(acc, cur, wr, wc, fr, fq, lds, wid, lane); S.done(cur); }
#undef PG8_SA
#undef PG8_SB
#undef PG8_STAGE
#undef PG8_LDA
#undef PG8_LDB
#undef PG8_MMA
#undef PG8_WAIT_V
#undef PG8_WAIT_L
#undef PG8_BAR
#undef PG8_SCHED
}
}

#ifndef FAST_MOBA
#define FAST_MOBA 2
#endif
#ifndef PG8_SP2
#define PG8_SP2 true
#endif
#ifndef PROBE_SEL
#define PROBE_SEL 0
#endif
constexpr int NWAVES = 8;
constexpr int PH_PER_LAYER = 11;
constexpr int N_PHASES = 2 * PH_PER_LAYER + 1;
constexpr bool ONE_LAUNCH = (MK_ONE_LAUNCH != 0);
static_assert(ONE_LAUNCH, "build with MK_ONE_LAUNCH=1 (build.sh 1): the FIN phase needs its in-phase grid barrier");

constexpr size_t MiB = 1u << 20;
constexpr size_t WS_CTL = 0, CTL_ZERO_BYTES = 1 * MiB;
constexpr size_t WS_W_IN = 1 * MiB;
constexpr size_t WS_W_G = 11 * MiB;
constexpr size_t WS_W_PA = 17 * MiB, WS_W_PB = 18 * MiB, WS_W_PC = 19 * MiB;
constexpr size_t WS_W_O = 20 * MiB;
constexpr size_t WS_W_UP = 22 * MiB;
constexpr size_t WS_W_DN = 30 * MiB;
constexpr size_t WS_XB = 40 * MiB;
constexpr size_t WS_RSTD = 104 * MiB;
constexpr int CW_SSQ = 32768;
static_assert((CW_SSQ + 3 * T) * 4 <= (int)CTL_ZERO_BYTES, "ssq arrays inside the memset region");
constexpr size_t WS_KMEAN = 104 * MiB + 256 * 1024;
constexpr size_t WS_RGA = 104 * MiB + 256 * 1024;
constexpr size_t WS_RGH = 10 * MiB + 512 * 1024;
constexpr int RGC = 128;
constexpr size_t WS_WI = 105 * MiB;
constexpr size_t WS_KI = 106 * MiB;
constexpr size_t WS_ACT = 112 * MiB;
constexpr size_t ACT_STRIDE = (size_t)T * 512 * 2;
constexpr size_t WS_QA = WS_ACT, WS_QB = WS_ACT + ACT_STRIDE, WS_YC = WS_ACT + 2 * ACT_STRIDE, WS_KA = WS_ACT + 3 * ACT_STRIDE, WS_VA = WS_ACT + 4 * ACT_STRIDE,
                 WS_KB = WS_ACT + 5 * ACT_STRIDE, WS_VB = WS_ACT + 6 * ACT_STRIDE, WS_QI = WS_ACT + 7 * ACT_STRIDE, WS_XC = WS_ACT + 8 * ACT_STRIDE;
constexpr size_t WS_G = WS_KA;
constexpr size_t WS_MASK = 400 * MiB;
constexpr size_t WS_MERGED = 400 * MiB;
constexpr size_t WS_H = WS_ACT;
constexpr size_t WS_END = 512 * MiB;
static_assert(WS_XC + ACT_STRIDE == 400 * MiB && WS_G + (size_t)3 * T * 1024 * 2 == 400 * MiB && WS_H + (size_t)T * DFF * 2 <= 400 * MiB, "d_ws map");
constexpr int CW_DYN = 12288;
constexpr int CW_BAR = 4096;

constexpr int RING_OFF = 0, RING_BYTES = 131072;
constexpr int LDSCTL_OFF = RING_BYTES, MISC_OFF = LDSCTL_OFF + 320;
constexpr int LDS_BYTES = 147456;
constexpr int GL_SKEY = 0, GL_QIF = 65536, GL_WQ = GL_QIF + 2048, GL_HIST = GL_WQ + 64, GL_SEL = GL_HIST + 1024, GL_MISC = GL_SEL + 1024, GL_QS = 70656, GL_PS = 73728;
static_assert(GL_MISC + 64 <= GL_QS && GL_QS + 8 * 256 <= GL_PS && GL_PS + 8 * 4096 <= RING_BYTES, "golden LDS map");

#define GAS __attribute__((address_space(1)))
#define LAS __attribute__((address_space(3)))
typedef unsigned short bf16;
typedef unsigned v4u __attribute__((ext_vector_type(4)));
typedef float f32x4 __attribute__((ext_vector_type(4)));
typedef GAS unsigned gu32;
#define RLX_AGENT __ATOMIC_RELAXED, __HIP_MEMORY_SCOPE_AGENT
#define LDS_WAIT() asm volatile("s_waitcnt lgkmcnt(0)" ::: "memory")
#define VM_WAIT() asm volatile("s_waitcnt vmcnt(0)" ::: "memory")
__device__ __forceinline__ float bf2f(bf16 v) { return __uint_as_float(((unsigned)v) << 16); }
__device__ __forceinline__ unsigned pk2(float lo, float hi) { return pg8::cvt_pk_bf16(lo, hi); }
__device__ __forceinline__ unsigned f2bf(float f) { return pg8::cvt_pk_bf16(f, 0.f) & 0xffffu; }
__device__ __forceinline__ float wave_sum(float v) {
#pragma unroll
    for (int o = 1; o < 64; o <<= 1) v += __shfl_xor(v, o);
    return v;
}
__device__ __forceinline__ float wave_max(float v) {
#pragma unroll
    for (int o = 1; o < 64; o <<= 1) v = fmaxf(v, __shfl_xor(v, o));
    return v;
}
__device__ __forceinline__ int t5_bucket(int n) {
    if (n < 16) return n;
    if (n >= 113) return 31;
    return 16 + (n >= 19) + (n >= 21) + (n >= 24) + (n >= 27) + (n >= 31) + (n >= 35) + (n >= 40) + (n >= 46) + (n >= 52) + (n >= 59) + (n >= 67) + (n >= 77) + (n >= 87) + (n >= 99);
}

#define XB_TMO      128
#define XB_XCNT(j)  (256  + 64 * (j))
#define XB_XSUB(j)  (1280 + 64 * (j))
#define XB_XGEN(j)  (2304 + 64 * (j))
#define XB_TOP      3328
#define XB_TOPGEN   3392
#define XCD_BAR_WORDS 3456
#define XB_SPIN_CAP (1u << 22)

__device__ __forceinline__ unsigned xb_ld(unsigned* p)              { return __hip_atomic_load(p, __ATOMIC_RELAXED, __HIP_MEMORY_SCOPE_AGENT); }
__device__ __forceinline__ unsigned xb_add(unsigned* p, unsigned v) { return __hip_atomic_fetch_add(p, v, __ATOMIC_RELAXED, __HIP_MEMORY_SCOPE_AGENT); }
__device__ __forceinline__ unsigned xb_xcc_id() { return (unsigned)__builtin_amdgcn_s_getreg((3 << 11) | 20) & 0xFu; }
#define XB_SPIN(cond, bar) do { unsigned _sp = 0; while (cond) { __builtin_amdgcn_s_sleep(1); \
    if ((++_sp & 255u) == 0u) { if (xb_ld(&(bar)[XB_TMO])) break; if (_sp > XB_SPIN_CAP) { atomicAdd(&(bar)[XB_TMO], 1u); break; } } } } while (0)

struct XcdBarrier { unsigned* bar; unsigned x; volatile LAS unsigned* st; };

__device__ __forceinline__ XcdBarrier xcd_barrier_post(unsigned* bar, volatile LAS unsigned* st) {
    XcdBarrier b; b.bar = bar; b.x = xb_xcc_id(); b.st = st;
    if (threadIdx.x == 0) (void)xb_add(&bar[XB_XCNT(b.x)], 1u);
    return b;
}
__device__ __forceinline__ void xcd_barrier_complete(unsigned* bar, unsigned x, unsigned& nloc, unsigned& nx) {
    const unsigned G = gridDim.x * gridDim.y * gridDim.z;
    unsigned sum, cnt, mine, sp = 0u;
    for (;;) {
        sum = 0u; cnt = 0u; mine = 0u;
#pragma unroll
        for (unsigned j = 0; j < 16; ++j) { const unsigned c = xb_ld(&bar[XB_XCNT(j)]); sum += c; cnt += (c > 0u) ? 1u : 0u; }
        mine = xb_ld(&bar[XB_XCNT(x)]);
        if (sum == G) break;
        __builtin_amdgcn_s_sleep(1);
        if ((++sp & 255u) == 0u) { if (xb_ld(&bar[XB_TMO])) break; if (sp > XB_SPIN_CAP) { atomicAdd(&bar[XB_TMO], 1u); break; } }
    }
    nloc = mine > 0u ? mine : 1u; nx = cnt > 0u ? cnt : 1u;
}
__device__ __forceinline__ void xcd_barrier(const XcdBarrier& b) {
    asm volatile("s_waitcnt vmcnt(0)" ::: "memory");
    __syncthreads();
    if (threadIdx.x == 0) {
        unsigned* bar = b.bar;
        __builtin_amdgcn_s_waitcnt(0);
        unsigned nloc = b.st[0], nx = b.st[1];
        if (nloc == 0u) { xcd_barrier_complete(bar, b.x, nloc, nx); b.st[0] = nloc; b.st[1] = nx; }
        const unsigned old = xb_add(&bar[XB_XSUB(b.x)], 1u);
        const unsigned gen = old / nloc;
        if (old + 1u == (gen + 1u) * nloc) {
            __builtin_amdgcn_fence(__ATOMIC_RELEASE, "agent");
            asm volatile("s_waitcnt vmcnt(0)" ::: "memory");
            const unsigned og = xb_add(&bar[XB_TOP], 1u);
            const unsigned tg = og / nx;
            if (og + 1u == (tg + 1u) * nx) xb_add(&bar[XB_TOPGEN], 1u);
            else XB_SPIN(xb_ld(&bar[XB_TOPGEN]) == tg, bar);
            __builtin_amdgcn_fence(__ATOMIC_ACQUIRE, "agent");
            xb_add(&bar[XB_XGEN(b.x)], 1u);
            asm volatile("s_waitcnt vmcnt(0)" ::: "memory");
        } else {
            XB_SPIN(xb_ld(&bar[XB_XGEN(b.x)]) == gen, bar);
            __builtin_amdgcn_fence(__ATOMIC_ACQUIRE, "agent");
            asm volatile("s_waitcnt vmcnt(0)" ::: "memory");
        }
    }
    __syncthreads();
}

struct Args { const float* in[19]; float* out; unsigned char* ws; int ph_lo, ph_hi; };
struct Frame {
    LAS unsigned char* lds;
    int tid, lane, wave, G, bid;
    int gw;
    const __attribute__((address_space(4))) Args* a;
    unsigned char* ws; float* out;
};
#define WSB(off) ((bf16*)(F.ws + (off)))
#define WSF(off) ((float*)(F.ws + (off)))
#define INP(i) (F.a->in[i])
#define SSQ_MIX(l) ((l) == 0 ? WSF(WS_RSTD) : (float*)(F.ws + WS_CTL) + CW_SSQ + T)
#define SSQ_MLP(l) ((float*)(F.ws + WS_CTL) + CW_SSQ + ((l) == 0 ? 0 : 2 * T))
enum { I_X = 0, I_RELB, I_NMG, I_WIN, I_CONVW, I_CONVB, I_WR, I_BR, I_WI, I_BI, I_LAM, I_WPA, I_WPB, I_WPC, I_WO, I_NLG, I_WUP, I_WDN, I_FNG };

template <class P> __device__ __forceinline__ P* launder_u(P* p) { unsigned lo = (unsigned)(uintptr_t)p, hi = (unsigned)((uintptr_t)p >> 32); asm volatile("" : "+v"(lo), "+v"(hi));
    lo = __builtin_amdgcn_readfirstlane(lo); hi = __builtin_amdgcn_readfirstlane(hi); return (P*)(((uintptr_t)hi << 32) | (uintptr_t)lo); }
__device__ __forceinline__ int launder_i(int v) { asm volatile("" : "+v"(v)); return __builtin_amdgcn_readfirstlane(v); }

__device__ __forceinline__ void transpose_item(const float* W, int ld, int K, int ncol_valid, const float* gain, bf16* WT, LAS float* scr, int item, int nblk, int lane) {
    const int kb = item / nblk, nb = item % nblk, k0 = 64 * kb, n0 = 32 * nb;
    const float gv = gain ? gain[k0 + lane] : 1.0f;
#pragma unroll 8
    for (int i = 0; i < 32; ++i) { const int kk = 2 * i + (lane >> 5); const int n = n0 + (lane & 31);
        float v = (n < ncol_valid) ? W[(size_t)(k0 + kk) * ld + n] : 0.f; v *= __shfl(gv, kk); scr[kk * 33 + (lane & 31)] = v; }
    LDS_WAIT(); asm volatile("" ::: "memory");
    const int c = lane & 7;
#pragma unroll
    for (int j = 0; j < 4; ++j) { const int n = (lane >> 3) + 8 * j; const LAS float* s = scr + (8 * c) * 33 + n;
        v4u o; o.x = pk2(s[0 * 33], s[1 * 33]); o.y = pk2(s[2 * 33], s[3 * 33]); o.z = pk2(s[4 * 33], s[5 * 33]); o.w = pk2(s[6 * 33], s[7 * 33]);
        *(GAS v4u*)(WT + (size_t)(n0 + n) * K + k0 + 8 * c) = o; }
    LDS_WAIT(); asm volatile("" ::: "memory");
}
__device__ __forceinline__ void norm_row(const float* xrow, bf16* orow, float* rstd_out, int lane) {
    const GAS f32x4* xr = (const GAS f32x4*)xrow + lane;
    f32x4 v[4]; float s = 0.f;
#pragma unroll
    for (int j = 0; j < 4; ++j) { v[j] = xr[64 * j]; s += (v[j].x * v[j].x + v[j].y * v[j].y) + (v[j].z * v[j].z + v[j].w * v[j].w); }
    const float ss = wave_sum(s);
    GAS unsigned long long* o8 = (GAS unsigned long long*)orow + lane;
#pragma unroll
    for (int j = 0; j < 4; ++j) o8[64 * j] = (unsigned long long)pk2(v[j].x, v[j].y) | ((unsigned long long)pk2(v[j].z, v[j].w) << 32);
    if (lane == 0) *rstd_out = ss;
}
__device__ __forceinline__ void p_prologue(Frame& F, int l) {
    LAS float* scr = (LAS float*)(F.lds + RING_OFF + F.wave * 16384);
    const int gw = F.bid * NWAVES + F.wave, NGW = F.G * NWAVES;
    const float* w_in = INP(I_WIN) + (size_t)l * DM * DIN; const float* g1 = INP(I_NMG) + l * DM; const float* g2 = INP(I_NLG) + l * DM;
    constexpr int I_BLK = 16 * 16;
    constexpr int I_SP = 16 * 3;
    constexpr int I_G = 16 * 96;
    constexpr int I_P = 8 * 32;
    constexpr int I_O = 16 * 32;
    constexpr int I_UP = 16 * 128;
    constexpr int I_DN = 64 * 32;
    constexpr int NITEMS = 9 * I_BLK + I_SP + I_G + 3 * I_P + I_O + I_UP + I_DN;
    for (int it = gw; it < NITEMS; it += NGW) {
        int r = it;
        if (r < 9 * I_BLK) { const int blk = r / I_BLK; r -= blk * I_BLK;
            const int c0 = blk == 0 ? 0 : blk == 1 ? 1536 : blk == 2 ? 4168 : blk == 3 ? 512 : blk == 4 ? 1024 : blk == 5 ? 2048 : blk == 6 ? 2560 : blk == 7 ? 3072 : 3656;
            transpose_item(w_in + c0, DIN, DM, 512, g1, WSB(WS_W_IN) + (size_t)blk * 512 * DM, scr, r, 16, F.lane); continue; }
        r -= 9 * I_BLK;
        if (r < I_SP) { transpose_item(w_in + 3584, DIN, DM, 72, g1, WSB(WS_W_IN) + (size_t)4608 * DM, scr, r, 3, F.lane); continue; } r -= I_SP;
        if (r < I_G) { transpose_item(w_in + 4680, DIN, DM, 3072, g1, WSB(WS_W_G), scr, r, 96, F.lane); continue; } r -= I_G;
        if (r < I_P) { transpose_item(INP(I_WPA) + (size_t)l * DH * DM, DM, DH, 1024, nullptr, WSB(WS_W_PA), scr, r, 32, F.lane); continue; } r -= I_P;
        if (r < I_P) { transpose_item(INP(I_WPB) + (size_t)l * DH * DM, DM, DH, 1024, nullptr, WSB(WS_W_PB), scr, r, 32, F.lane); continue; } r -= I_P;
        if (r < I_P) { transpose_item(INP(I_WPC) + (size_t)l * DH * DM, DM, DH, 1024, nullptr, WSB(WS_W_PC), scr, r, 32, F.lane); continue; } r -= I_P;
        if (r < I_O) { transpose_item(INP(I_WO) + (size_t)l * DM * DM, DM, DM, 1024, nullptr, WSB(WS_W_O), scr, r, 32, F.lane); continue; } r -= I_O;
        if (r < I_UP) { transpose_item(INP(I_WUP) + (size_t)l * DM * DFF, DFF, DM, DFF, g2, WSB(WS_W_UP), scr, r, 128, F.lane); continue; } r -= I_UP;
        transpose_item(INP(I_WDN) + (size_t)l * DFF * DM, DM, DFF, 1024, nullptr, WSB(WS_W_DN), scr, r, 32, F.lane);
    }
    { GAS v4u* z = (GAS v4u*)(WSB(WS_W_IN) + (size_t)(4608 + 96) * DM); const int gt = F.bid * (NWAVES * 64) + F.tid;
      unsigned zz = 0u; asm volatile("" : "+v"(zz));
      for (int i = gt; i < 160 * DM / 8; i += F.G * NWAVES * 64) z[i] = (v4u){zz, zz, zz, zz}; }
    if (l == 0) for (int m = gw; m < T; m += NGW) norm_row(INP(I_X) + (size_t)m * DM, WSB(WS_XB) + (size_t)m * DM, WSF(WS_RSTD) + m, F.lane);
}
__device__ __forceinline__ void p_norm2(Frame& F) {
    const int gw = F.bid * NWAVES + F.wave, NGW = F.G * NWAVES;
    for (int m = gw; m < T; m += NGW) norm_row(F.out + (size_t)m * DM, WSB(WS_XB) + (size_t)m * DM, WSF(WS_RSTD) + m, F.lane);
}
__device__ __forceinline__ void p_final(Frame& F) {
    const int gw = F.bid * NWAVES + F.wave, NGW = F.G * NWAVES;
    for (int m = gw; m < T; m += NGW) {
        GAS f32x4* xr = (GAS f32x4*)(F.out + (size_t)m * DM) + F.lane; const GAS f32x4* gr = (const GAS f32x4*)INP(I_FNG) + F.lane;
        f32x4 v[4]; float s = 0.f;
#pragma unroll
        for (int j = 0; j < 4; ++j) { v[j] = xr[64 * j]; s += (v[j].x * v[j].x + v[j].y * v[j].y) + (v[j].z * v[j].z + v[j].w * v[j].w); }
        const float rstd = 1.0f / sqrtf(wave_sum(s) * (1.0f / DM) + EPS);
#pragma unroll
        for (int j = 0; j < 4; ++j) xr[64 * j] = v[j] * rstd * gr[64 * j];
    }
}

__device__ __forceinline__ void kmean_unit(Frame& F, int b, int n) {
    const bf16* kp = WSB(WS_KA) + ((size_t)b * SEQ + (size_t)n * 256) * 512 + F.tid; float s = 0.f;
#pragma unroll 8
    for (int j = 0; j < 256; ++j) s += bf2f(kp[(size_t)j * 512]);
    WSF(WS_KMEAN)[((size_t)b * NBLK + n) * 512 + F.tid] = s * (1.0f / 256.0f);
}
__device__ __forceinline__ float sigmoidf_(float v) { return 1.0f / (1.0f + __expf(-v)); }
typedef short bf16x8_t __attribute__((ext_vector_type(8)));
constexpr int RG_XB_STRIDE = 72;
constexpr int RG_XRAW = 0, RG_YRAW = 2048, RG_XB = 4096, RG_PR = RG_XB + 16 * RG_XB_STRIDE * 2, RG_PI = RG_PR + 16 * 64 * 4, RG_WAVE_LDS = RG_PI + 16 * 64 * 4;
static_assert(8 * RG_WAVE_LDS <= RING_BYTES, "rg LDS");
template <bool P2> __device__ __forceinline__ void rg_unit(Frame& F, int l, int b, int c) {
    int d_ = F.lane; asm volatile("" : "+v"(d_));
    const int n = F.wave, d = d_, ch = n * 64 + d;
    LAS unsigned char* wl = F.lds + RING_OFF + n * RG_WAVE_LDS;
    LAS bf16* xraw = (LAS bf16*)(wl + RG_XRAW); LAS bf16* yraw = (LAS bf16*)(wl + RG_YRAW); LAS bf16* xb = (LAS bf16*)(wl + RG_XB); LAS float* prl = (LAS float*)(wl + RG_PR); LAS float* pil = (LAS float*)(wl + RG_PI);
    const int col = d & 15, kq = d >> 4;
    bf16x8_t wfr[2][4], wfi[2][4];
    { const GAS float* prs = (const GAS float*)INP(I_WR) + (((size_t)l * 8 + n) * 64) * 64 + (8 * kq * 64 + col); const GAS float* pis = (const GAS float*)INP(I_WI) + (((size_t)l * 8 + n) * 64) * 64 + (8 * kq * 64 + col);
#pragma unroll
      for (int ks = 0; ks < 2; ++ks)
#pragma unroll
        for (int nb = 0; nb < 4; ++nb) { float tr[8], ti[8];
#pragma unroll
            for (int j = 0; j < 8; ++j) { const int o = (32 * ks + j) * 64 + 16 * nb; tr[j] = prs[o]; ti[j] = pis[o]; }
            union { bf16x8_t v; unsigned u[4]; } ur, ui;
#pragma unroll
            for (int j = 0; j < 4; ++j) { ur.u[j] = pk2(tr[2 * j], tr[2 * j + 1]); ui.u[j] = pk2(ti[2 * j], ti[2 * j + 1]); }
            wfr[ks][nb] = ur.v; wfi[ks][nb] = ui.v; } }
    const float br = ((const GAS float*)INP(I_BR) + l * 512)[ch], bi = ((const GAS float*)INP(I_BI) + l * 512)[ch];
    const float lamv = ((const GAS float*)INP(I_LAM) + l * 512)[ch]; const float sp = log1pf(__expf(-lamv));
    const GAS float* cwp = (const GAS float*)INP(I_CONVW) + (size_t)l * 4 * 512;
    const float cw0 = cwp[ch], cw1 = cwp[512 + ch], cw2 = cwp[1024 + ch], cw3 = cwp[1536 + ch];
    const float cb = ((const GAS float*)INP(I_CONVB) + l * 512)[ch];
    float h = 0.f, A = 1.f;
    if (P2) { const GAS float* ra = (const GAS float*)WSF(WS_RGA) + (size_t)b * RGC * 512; const GAS float* rh = (const GAS float*)WSF(WS_RGH) + (size_t)b * RGC * 512;
        const GAS float* rap = ra + ch; const GAS float* rhp = rh + ch;
        int j = 0;
#pragma unroll 1
        for (; j + 4 <= c; j += 4) { const float a0 = rap[0], a1 = rap[512], a2 = rap[1024], a3 = rap[1536], h0 = rhp[0], h1 = rhp[512], h2 = rhp[1024], h3 = rhp[1536];
            h = a0 * h + h0; h = a1 * h + h1; h = a2 * h + h2; h = a3 * h + h3; rap += 2048; rhp += 2048; }
#pragma unroll 1
        for (; j < c; ++j) { h = rap[0] * h + rhp[0]; rap += 512; rhp += 512; } }
    const int t0 = c * (SEQ / RGC);
    const GAS bf16* xcs = (const GAS bf16*)WSB(WS_XC) + ((size_t)b * SEQ + t0) * 512;
    GAS bf16* ycs = (GAS bf16*)WSB(WS_YC) + ((size_t)b * SEQ + t0) * 512;
    float x1 = 0.f, x2 = 0.f, x3 = 0.f;
    if (t0 > 0) { const GAS bf16* xm = xcs - 3 * 512; x3 = bf2f(xm[ch]); x2 = bf2f(xm[512 + ch]); x1 = bf2f(xm[1024 + ch]); }
    const int tokA = d >> 3, chk = d & 7;
    const size_t goff = (size_t)tokA * 512 + n * 64 + chk * 8;
    const int loff = tokA * 64 + chk * 8;
#pragma unroll 1
    for (int tile = 0; tile < SEQ / RGC / 16; ++tile) {
        const GAS bf16* xt = xcs + (size_t)tile * 16 * 512 + goff; GAS bf16* yt = ycs + (size_t)tile * 16 * 512 + goff;
        { const v4u a0 = *(const GAS v4u*)xt, a1 = *(const GAS v4u*)(xt + 8 * 512); *(LAS v4u*)(xraw + loff) = a0; *(LAS v4u*)(xraw + loff + 8 * 64) = a1; }
        if (P2) { const v4u a0 = *(const GAS v4u*)yt, a1 = *(const GAS v4u*)(yt + 8 * 512); *(LAS v4u*)(yraw + loff) = a0; *(LAS v4u*)(yraw + loff + 8 * 64) = a1; }
        LDS_WAIT(); asm volatile("" ::: "memory");
        float xc[16];
#pragma unroll
        for (int i = 0; i < 16; ++i) { const float xv = bf2f(xraw[i * 64 + d]); xc[i] = cb + cw0 * x3 + cw1 * x2 + cw2 * x1 + cw3 * xv; x3 = x2; x2 = x1; x1 = xv; }
#pragma unroll
        for (int i = 0; i < 16; ++i) xb[i * RG_XB_STRIDE + d] = (bf16)f2bf(xc[i]);
        LDS_WAIT(); asm volatile("" ::: "memory");
        bf16x8_t af[2];
#pragma unroll
        for (int ks = 0; ks < 2; ++ks) af[ks] = *(const LAS bf16x8_t*)(xb + col * RG_XB_STRIDE + 32 * ks + 8 * kq);
        f32x4 ar[4], ai[4];
#pragma unroll
        for (int nb = 0; nb < 4; ++nb) { ar[nb] = (f32x4){0.f, 0.f, 0.f, 0.f}; ai[nb] = (f32x4){0.f, 0.f, 0.f, 0.f};
#pragma unroll
            for (int ks = 0; ks < 2; ++ks) { ar[nb] = __builtin_amdgcn_mfma_f32_16x16x32_bf16(af[ks], wfr[ks][nb], ar[nb], 0, 0, 0); ai[nb] = __builtin_amdgcn_mfma_f32_16x16x32_bf16(af[ks], wfi[ks][nb], ai[nb], 0, 0, 0); } }
        asm volatile("s_nop 15\n\ts_nop 15" : "+v"(ar[0]), "+v"(ar[1]), "+v"(ar[2]), "+v"(ar[3]), "+v"(ai[0]), "+v"(ai[1]), "+v"(ai[2]), "+v"(ai[3]));
#pragma unroll
        for (int nb = 0; nb < 4; ++nb)
#pragma unroll
            for (int r = 0; r < 4; ++r) { prl[(4 * kq + r) * 64 + 16 * nb + col] = ar[nb][r]; pil[(4 * kq + r) * 64 + 16 * nb + col] = ai[nb][r]; }
        LDS_WAIT(); asm volatile("" ::: "memory");
#pragma unroll
        for (int i = 0; i < 16; ++i) {
            const float r = __builtin_amdgcn_rcpf(1.0f + __expf(-(prl[i * 64 + d] + br))), ig = __builtin_amdgcn_rcpf(1.0f + __expf(-(pil[i * 64 + d] + bi)));
            const float la = -8.0f * r * sp; const float a = __expf(la);
            const float x2a = 2.0f * la;
            const float om = (x2a > -0.05f) ? -x2a * (1.0f + x2a * (0.5f + x2a * (0.16666667f + x2a * 0.041666668f))) : 1.0f - a * a;
            const float u = __builtin_amdgcn_sqrtf(om) * (ig * xc[i]);
            h = a * h + u;
            if (!P2) A *= a;
            else { const float y = bf2f(yraw[i * 64 + d]); const float z = 0.7978845608028654f * (y + 0.044715f * y * y * y);
                const float th = 1.0f - 2.0f * __builtin_amdgcn_rcpf(1.0f + __expf(2.0f * z));
                yraw[i * 64 + d] = (bf16)f2bf(h * (0.5f * y * (1.0f + th))); }
        }
        LDS_WAIT(); asm volatile("" ::: "memory");
        if (P2) { const v4u a0 = *(const LAS v4u*)(yraw + loff), a1 = *(const LAS v4u*)(yraw + loff + 8 * 64); *(GAS v4u*)yt = a0; *(GAS v4u*)(yt + 8 * 512) = a1; }
        LDS_WAIT(); asm volatile("" ::: "memory");
    }
    if (!P2) { const size_t o = ((size_t)b * RGC + c) * 512; ((GAS float*)WSF(WS_RGA) + o)[ch] = A; ((GAS float*)WSF(WS_RGH) + o)[ch] = h; }
    __syncthreads();
}

__device__ __forceinline__ float dot64(const LAS float* qs, const bf16* krow) {
    const v4u* kr = (const v4u*)krow; float s = 0.f;
#pragma unroll
    for (int c = 0; c < 8; ++c) { const v4u w = kr[c]; const f32x4 q0 = *(const LAS f32x4*)(qs + c * 8), q1 = *(const LAS f32x4*)(qs + c * 8 + 4);
        s += q0.x * __uint_as_float(w.x << 16) + q0.y * __uint_as_float(w.x & 0xffff0000u) + q0.z * __uint_as_float(w.y << 16) + q0.w * __uint_as_float(w.y & 0xffff0000u)
           + q1.x * __uint_as_float(w.z << 16) + q1.y * __uint_as_float(w.z & 0xffff0000u) + q1.z * __uint_as_float(w.w << 16) + q1.w * __uint_as_float(w.w & 0xffff0000u); }
    return s;
}
__device__ __forceinline__ void moba_unit(Frame& F, int b, int t) {
    const int h = F.wave, lane = F.lane, cur = t >> 8;
    LAS float* qs = (LAS float*)(F.lds + GL_QS) + h * 64; LAS float* ps = (LAS float*)(F.lds + GL_PS) + h * 1024;
    const size_t row = (size_t)b * SEQ + t;
    bf16* qrow = WSB(WS_QA) + row * 512 + h * 64;
    qs[lane] = bf2f(qrow[lane]);
    LDS_WAIT(); asm volatile("" ::: "memory");
    float g = -1e30f;
    if (lane < cur) { const float* km = WSF(WS_KMEAN) + ((size_t)b * NBLK + lane) * 512 + h * 64; float s = 0.f;
#pragma unroll
        for (int d4 = 0; d4 < 16; ++d4) { const f32x4 kv = *(const f32x4*)(km + d4 * 4); const f32x4 qv = *(const LAS f32x4*)(qs + d4 * 4); s += kv.x * qv.x + kv.y * qv.y + kv.z * qv.z + kv.w * qv.w; }
        g = s; }
    int blk[4]; bool ok[4];
#pragma unroll
    for (int i = 0; i < 3; ++i) { const float m = wave_max(g); const unsigned long long bal = __ballot(g == m); const int sel = __ffsll((long long)bal) - 1; blk[i] = sel; ok[i] = sel < cur; if (lane == sel) g = -INFINITY; }
    blk[3] = cur; ok[3] = true;
    const bf16* Kh = WSB(WS_KA) + ((size_t)b * SEQ) * 512 + h * 64; const bf16* Vh = WSB(WS_VA) + ((size_t)b * SEQ) * 512 + h * 64;
    float lg[16];
#pragma unroll
    for (int i = 0; i < 16; ++i) { const int bi = i >> 2; const int pos = blk[bi] * 256 + (i & 3) * 64 + lane; const bool valid = ok[bi] && pos <= t;
        float s = -1e30f;
        if (valid) s = dot64(qs, Kh + (size_t)pos * 512) * 0.125f + INP(I_RELB)[t5_bucket(t - pos) * 16 + h];
        lg[i] = s; if ((i & 3) == 3) asm volatile("" ::: "memory"); }
    float m = lg[0];
#pragma unroll
    for (int i = 1; i < 16; ++i) m = fmaxf(m, lg[i]);
    m = wave_max(m); float sum = 0.f;
#pragma unroll
    for (int i = 0; i < 16; ++i) { const float e = __expf(lg[i] - m); sum += e; ps[i * 64 + lane] = e; }
    sum = wave_sum(sum);
    LDS_WAIT(); asm volatile("" ::: "memory");
    float acc = 0.f;
#pragma unroll
    for (int bi = 0; bi < 4; ++bi) {
        if (!ok[bi]) continue;
        const int base = blk[bi] * 256; const int nk = (bi == 3) ? (t - base + 1) : 256;
        const bf16* vp = Vh + (size_t)base * 512 + lane; const LAS float* pp = ps + bi * 256;
        int kk = 0;
        for (; kk + 8 <= nk; kk += 8) { float pv[8], vv[8];
#pragma unroll
            for (int j = 0; j < 8; ++j) { pv[j] = pp[kk + j]; vv[j] = bf2f(vp[(size_t)(kk + j) * 512]); }
#pragma unroll
            for (int j = 0; j < 8; ++j) acc += pv[j] * vv[j]; }
        for (; kk < nk; ++kk) acc += pp[kk] * bf2f(vp[(size_t)kk * 512]);
    }
    qrow[lane] = (bf16)f2bf(acc / sum);
}
__device__ __forceinline__ void dsa_unit(Frame& F, int b, int t) {
    const int tid = F.tid, lane = F.lane, h = F.wave;
    LAS unsigned* skey = (LAS unsigned*)(F.lds + GL_SKEY); LAS float* qif = (LAS float*)(F.lds + GL_QIF); LAS float* wq = (LAS float*)(F.lds + GL_WQ);
    LAS unsigned* hist = (LAS unsigned*)(F.lds + GL_HIST); LAS int* sel = (LAS int*)(F.lds + GL_SEL); LAS unsigned* misc = (LAS unsigned*)(F.lds + GL_MISC);
    const size_t row = (size_t)b * SEQ + t; const int n = t + 1;
    __syncthreads();
    qif[tid] = bf2f(WSB(WS_QI)[row * 512 + tid]);
    if (tid < 8) wq[tid] = WSF(WS_WI)[row * 8 + tid];
    if (tid < 16) misc[tid] = 0u;
    __syncthreads();
    if (n > 256) {
        const bf16* kib = WSB(WS_KI) + ((size_t)b * SEQ) * 64;
        for (int s = tid; s < n; s += NWAVES * 64) {
            float kf[64];
            { const v4u* kr = (const v4u*)(kib + (size_t)s * 64);
#pragma unroll
              for (int c = 0; c < 8; ++c) { const v4u w = kr[c]; kf[c * 8 + 0] = __uint_as_float(w.x << 16); kf[c * 8 + 1] = __uint_as_float(w.x & 0xffff0000u); kf[c * 8 + 2] = __uint_as_float(w.y << 16); kf[c * 8 + 3] = __uint_as_float(w.y & 0xffff0000u);
                  kf[c * 8 + 4] = __uint_as_float(w.z << 16); kf[c * 8 + 5] = __uint_as_float(w.z & 0xffff0000u); kf[c * 8 + 6] = __uint_as_float(w.w << 16); kf[c * 8 + 7] = __uint_as_float(w.w & 0xffff0000u); } }
            float score = 0.f;
#pragma unroll 1
            for (int hh = 0; hh < 8; ++hh) { float dsum = 0.f;
#pragma unroll
                for (int d4 = 0; d4 < 16; ++d4) { const f32x4 q = *(const LAS f32x4*)(qif + hh * 64 + d4 * 4); dsum += q.x * kf[d4 * 4] + q.y * kf[d4 * 4 + 1] + q.z * kf[d4 * 4 + 2] + q.w * kf[d4 * 4 + 3]; }
                score += wq[hh] * fmaxf(dsum, 0.f); asm volatile("" ::: "memory"); }
            score *= 0.04419417382415922f;
            if (score == 0.f) score = 0.f;
            const unsigned u = __float_as_uint(score);
            skey[s] = (u & 0x80000000u) ? ~u : (u | 0x80000000u);
        }
        __syncthreads();
        unsigned prefix = 0u; unsigned kneed = 256u, neq = 0u;
#pragma unroll
        for (int pass = 0; pass < 4; ++pass) {
            const int shift = 24 - 8 * pass;
            if (tid < 256) hist[tid] = 0u;
            __syncthreads();
            for (int s = tid; s < n; s += NWAVES * 64) { const unsigned key = skey[s]; const bool match = (pass == 0) ? true : ((key >> ((shift + 8) & 31)) == prefix);
                if (match) __hip_atomic_fetch_add(hist + ((key >> shift) & 255u), 1u, __ATOMIC_RELAXED, __HIP_MEMORY_SCOPE_WORKGROUP); }
            __syncthreads();
            if (h == 0) {
                const unsigned c0 = hist[4 * lane], c1 = hist[4 * lane + 1], c2 = hist[4 * lane + 2], c3 = hist[4 * lane + 3]; const unsigned tot = c0 + c1 + c2 + c3;
                unsigned S = tot;
#pragma unroll
                for (int o = 1; o < 64; o <<= 1) { const unsigned v = __shfl_down(S, o); if (lane + o < 64) S += v; }
                const unsigned above = S - tot;
                if (above < kneed && kneed <= S) { unsigned a = above; unsigned bsel, cnt;
                    if (a + c3 >= kneed) { bsel = 3; cnt = c3; } else { a += c3; if (a + c2 >= kneed) { bsel = 2; cnt = c2; } else { a += c2; if (a + c1 >= kneed) { bsel = 1; cnt = c1; } else { a += c1; bsel = 0; cnt = c0; } } }
                    misc[0] = 4u * lane + bsel; misc[1] = kneed - a; misc[2] = cnt; }
            }
            __syncthreads();
            prefix = (prefix << 8) | misc[0]; kneed = misc[1]; neq = misc[2];
            __syncthreads();
        }
        const unsigned Tk = prefix;
        for (int s = tid; s < n; s += NWAVES * 64) { const unsigned key = skey[s];
            if (key > Tk || (key == Tk && neq == kneed)) { const unsigned idx = __hip_atomic_fetch_add(misc + 8, 1u, __ATOMIC_RELAXED, __HIP_MEMORY_SCOPE_WORKGROUP); if (idx < 256u) sel[idx] = s; } }
        __syncthreads();
        if (neq != kneed && tid == 0) { unsigned c = misc[8]; unsigned need = kneed; for (int s = 0; s < n && need > 0u && c < 256u; ++s) if (skey[s] == Tk) { sel[c++] = s; --need; } }
    } else {
        if (tid < 256) sel[tid] = (tid <= t) ? tid : -1;
    }
    __syncthreads();
    LAS float* qs = (LAS float*)(F.lds + GL_QS) + h * 64; LAS float* ps = (LAS float*)(F.lds + GL_PS) + h * 1024;
    bf16* qrow = WSB(WS_QB) + row * 512 + h * 64;
    qs[lane] = bf2f(qrow[lane]);
    LDS_WAIT(); asm volatile("" ::: "memory");
    const bf16* Kh = WSB(WS_KB) + ((size_t)b * SEQ) * 512 + h * 64; const bf16* Vh = WSB(WS_VB) + ((size_t)b * SEQ) * 512 + h * 64;
    float lg[4];
#pragma unroll
    for (int i = 0; i < 4; ++i) { const int pos = sel[i * 64 + lane]; float s = -1e30f;
        if (pos >= 0) s = dot64(qs, Kh + (size_t)pos * 512) * 0.125f + INP(I_RELB)[t5_bucket(t - pos) * 16 + 8 + h];
        lg[i] = s; }
    float m = wave_max(fmaxf(fmaxf(lg[0], lg[1]), fmaxf(lg[2], lg[3]))); float sum = 0.f;
#pragma unroll
    for (int i = 0; i < 4; ++i) { const float e = __expf(lg[i] - m); sum += e; ps[i * 64 + lane] = e; }
    sum = wave_sum(sum);
    LDS_WAIT(); asm volatile("" ::: "memory");
    float acc = 0.f; const int nk = n < 256 ? n : 256;
    int kk = 0;
    for (; kk + 8 <= nk; kk += 8) { float pv[8], vv[8];
#pragma unroll
        for (int j = 0; j < 8; ++j) { const int pos = sel[kk + j]; pv[j] = ps[kk + j]; vv[j] = bf2f(Vh[(size_t)pos * 512 + lane]); }
#pragma unroll
        for (int j = 0; j < 8; ++j) acc += pv[j] * vv[j]; }
    for (; kk < nk; ++kk) { const int pos = sel[kk]; acc += ps[kk] * bf2f(Vh[(size_t)pos * 512 + lane]); }
    qrow[lane] = (bf16)f2bf(acc / sum);
}

typedef float f32x16 __attribute__((ext_vector_type(16)));
constexpr int AT_KROW = 144, AT_VROW = 136;
constexpr int AT_KBUF = 64 * AT_KROW, AT_VBUF = 64 * AT_VROW;
constexpr int AT_K0 = 0, AT_V0 = 2 * AT_KBUF, AT_BT = 36864, AT_OST = 40960;
constexpr float AT_C2 = 0.125f * 1.4426950408889634f;
constexpr float AT_THR = 8.0f;
constexpr float LOG2E = 1.4426950408889634f;
__device__ __forceinline__ int crow_(int r, int hi) { return (r & 3) + 8 * (r >> 2) + 4 * hi; }
#define MFMA_FENCE2(a, b) asm volatile("s_nop 15\n\ts_nop 15" : "+v"(a), "+v"(b))

__device__ __forceinline__ void at_load(const GAS bf16* Kh, const GAS bf16* Vh, int tile, int tid, v4u& kr, v4u& vr) {
    kr = *(const GAS v4u*)(Kh + (size_t)(tile * 64 + (tid >> 3)) * 512 + (tid & 7) * 8);
    vr = *(const GAS v4u*)(Vh + (size_t)(tile * 64 + (tid >> 3)) * 512 + (tid & 7) * 8);
}
__device__ __forceinline__ void at_store(LAS unsigned char* kb, LAS unsigned char* vb, int tid, const v4u kr, const v4u vr) {
    *(LAS v4u*)(kb + (tid >> 3) * AT_KROW + (tid & 7) * 16) = kr;
    LAS bf16* vt = (LAS bf16*)(vb + ((tid & 7) * 8) * AT_VROW) + (tid >> 3);
    constexpr int RS = AT_VROW / 2;
    vt[0 * RS] = (bf16)(vr.x & 0xffffu); vt[1 * RS] = (bf16)(vr.x >> 16); vt[2 * RS] = (bf16)(vr.y & 0xffffu); vt[3 * RS] = (bf16)(vr.y >> 16);
    vt[4 * RS] = (bf16)(vr.z & 0xffffu); vt[5 * RS] = (bf16)(vr.z >> 16); vt[6 * RS] = (bf16)(vr.w & 0xffffu); vt[7 * RS] = (bf16)(vr.w >> 16);
}
__device__ __forceinline__ void at_qk(f32x16& p0, f32x16& p1, const LAS unsigned char* kb, const bf16x8_t (&qf)[4], int r32, int hi) {
    const LAS unsigned char* kp = kb + r32 * AT_KROW + hi * 16;
    bf16x8_t k0[4], k1[4];
#pragma unroll
    for (int s = 0; s < 4; ++s) { k0[s] = *(const LAS bf16x8_t*)(kp + s * 32); k1[s] = *(const LAS bf16x8_t*)(kp + 32 * AT_KROW + s * 32); }
    asm volatile("s_waitcnt lgkmcnt(0)" : "+v"(k0[0]), "+v"(k0[1]), "+v"(k0[2]), "+v"(k0[3]), "+v"(k1[0]), "+v"(k1[1]), "+v"(k1[2]), "+v"(k1[3]) :: "memory");
#pragma unroll
    for (int s = 0; s < 4; ++s) { p0 = __builtin_amdgcn_mfma_f32_32x32x16_bf16(k0[s], qf[s], p0, 0, 0, 0); p1 = __builtin_amdgcn_mfma_f32_32x32x16_bf16(k1[s], qf[s], p1, 0, 0, 0); }
}
__device__ __forceinline__ void at_qk_m(f32x16& p0, f32x16& p1, const LAS unsigned char* kb, const bf16x8_t (&qf)[4], const bf16x8_t oneA, const bf16x8_t mB, int r32, int hi) {
    const LAS unsigned char* kp = kb + r32 * AT_KROW + hi * 16;
    bf16x8_t k0[4], k1[4];
#pragma unroll
    for (int s = 0; s < 4; ++s) { k0[s] = *(const LAS bf16x8_t*)(kp + s * 32); k1[s] = *(const LAS bf16x8_t*)(kp + 32 * AT_KROW + s * 32); }
    p0 = __builtin_amdgcn_mfma_f32_32x32x16_bf16(oneA, mB, p0, 0, 0, 0); p1 = __builtin_amdgcn_mfma_f32_32x32x16_bf16(oneA, mB, p1, 0, 0, 0);
    asm volatile("s_waitcnt lgkmcnt(0)" : "+v"(k0[0]), "+v"(k0[1]), "+v"(k0[2]), "+v"(k0[3]), "+v"(k1[0]), "+v"(k1[1]), "+v"(k1[2]), "+v"(k1[3]) :: "memory");
#pragma unroll
    for (int s = 0; s < 4; ++s) { p0 = __builtin_amdgcn_mfma_f32_32x32x16_bf16(k0[s], qf[s], p0, 0, 0, 0); p1 = __builtin_amdgcn_mfma_f32_32x32x16_bf16(k1[s], qf[s], p1, 0, 0, 0); }
}
__device__ __forceinline__ void at_pv(f32x16& o0, f32x16& o1, const LAS unsigned char* vb, const bf16x8_t (&pb)[4], int r32, int hi) {
    const LAS unsigned char* vp = vb + r32 * AT_VROW + hi * 8;
    union U { bf16x8_t v; unsigned long long u[2]; }; U a0[4], a1[4];
#pragma unroll
    for (int sg = 0; sg < 4; ++sg) { const int kvo = (32 * (sg >> 1) + 16 * (sg & 1)) * 2;
        a0[sg].u[0] = *(const LAS unsigned long long*)(vp + kvo); a0[sg].u[1] = *(const LAS unsigned long long*)(vp + kvo + 16);
        a1[sg].u[0] = *(const LAS unsigned long long*)(vp + 32 * AT_VROW + kvo); a1[sg].u[1] = *(const LAS unsigned long long*)(vp + 32 * AT_VROW + kvo + 16); }
    asm volatile("s_waitcnt lgkmcnt(0)" : "+v"(a0[0].v), "+v"(a0[1].v), "+v"(a0[2].v), "+v"(a0[3].v), "+v"(a1[0].v), "+v"(a1[1].v), "+v"(a1[2].v), "+v"(a1[3].v) :: "memory");
#pragma unroll
    for (int sg = 0; sg < 4; ++sg) { o0 = __builtin_amdgcn_mfma_f32_32x32x16_bf16(a0[sg].v, pb[sg], o0, 0, 0, 0); o1 = __builtin_amdgcn_mfma_f32_32x32x16_bf16(a1[sg].v, pb[sg], o1, 0, 0, 0); }
}
__device__ __forceinline__ float max3_(float a, float b, float c) { float r; asm("v_max3_f32 %0, %1, %2, %3" : "=v"(r) : "v"(a), "v"(b), "v"(c)); return r; }
__device__ __forceinline__ unsigned and_sel(float p, unsigned w, int bit) { int t; asm("v_bfe_i32 %0, %1, %2, 1" : "=v"(t) : "v"(w), "n"(bit)); return __float_as_uint(p) & (unsigned)t; }

template <int MODE  , bool DRY = false  >
__device__ __forceinline__ void attn_unit(Frame& F, int b, int h, int qt) {
    int tid_ = F.tid; asm volatile("" : "+v"(tid_));
    const int tid = tid_, lane = tid & 63, wave = F.wave, r32 = lane & 31, hi = lane >> 5;
    LAS unsigned char* L = F.lds + RING_OFF;
    LAS float* bt = (LAS float*)(L + AT_BT);
    const GAS bf16* Qg = (const GAS bf16*)WSB(MODE == 0 ? WS_QA : WS_QB); const GAS bf16* Kg = (const GAS bf16*)WSB(MODE == 0 ? WS_KA : WS_KB); const GAS bf16* Vg = (const GAS bf16*)WSB(MODE == 0 ? WS_VA : WS_VB);
    const size_t rowb = (size_t)b * SEQ;
    const GAS bf16* Kh = Kg + rowb * 512 + h * 64; const GAS bf16* Vh = Vg + rowb * 512 + h * 64;
    const int q0w = qt * 256 + wave * 32, q = q0w + r32;
    const int NT = 4 * qt + 4;
    __syncthreads();
    if (tid < 128) { const GAS float* rb = (const GAS float*)INP(I_RELB) + (MODE * 8 + h); bt[tid] = (rb[t5_bucket(tid) * 16] - rb[31 * 16]) * LOG2E; }
    bf16x8_t qf[4];
    { const GAS bf16* qp = Qg + (rowb + q) * 512 + h * 64 + hi * 8;
#pragma unroll
      for (int s = 0; s < 4; ++s) qf[s] = *(const GAS bf16x8_t*)(qp + s * 16); }
    unsigned mlo = 0u, mhi = 0u;
    if (MODE == 0) {
        { const int n = tid >> 3, c8 = (tid & 7) * 8; const GAS float* km = (const GAS float*)WSF(WS_KMEAN) + ((size_t)b * NBLK + n) * 512 + h * 64 + c8;
          const f32x4 a = *(const GAS f32x4*)km, c = *(const GAS f32x4*)(km + 4);
          const unsigned h0 = pk2(a.x, a.y), h1 = pk2(a.z, a.w), h2 = pk2(c.x, c.y), h3 = pk2(c.z, c.w);
          const unsigned l0 = pk2(a.x - __uint_as_float(h0 << 16), a.y - __uint_as_float(h0 & 0xffff0000u)), l1 = pk2(a.z - __uint_as_float(h1 << 16), a.w - __uint_as_float(h1 & 0xffff0000u)),
                         l2 = pk2(c.x - __uint_as_float(h2 << 16), c.y - __uint_as_float(h2 & 0xffff0000u)), l3 = pk2(c.z - __uint_as_float(h3 << 16), c.w - __uint_as_float(h3 & 0xffff0000u));
          *(LAS v4u*)(L + AT_K0 + n * AT_KROW + (tid & 7) * 16) = (v4u){h0, h1, h2, h3}; *(LAS v4u*)(L + AT_K0 + AT_KBUF + n * AT_KROW + (tid & 7) * 16) = (v4u){l0, l1, l2, l3}; }
        __syncthreads();
        f32x16 g0 = {0.f, 0.f, 0.f, 0.f, 0.f, 0.f, 0.f, 0.f, 0.f, 0.f, 0.f, 0.f, 0.f, 0.f, 0.f, 0.f}, g1 = g0;
        at_qk(g0, g1, L + AT_K0, qf, r32, hi); at_qk(g0, g1, L + AT_K0 + AT_KBUF, qf, r32, hi);
        MFMA_FENCE2(g0, g1);
#pragma unroll
        for (int r = 0; r < 16; ++r) { if (crow_(r, hi) >= qt) g0[r] = -INFINITY; if (32 + crow_(r, hi) >= qt) g1[r] = -INFINITY; }
#pragma unroll
        for (int it = 0; it < 3; ++it) {
            float bv = -INFINITY; int bn = 64;
#pragma unroll
            for (int r = 0; r < 16; ++r) if (g0[r] > bv) { bv = g0[r]; bn = crow_(r, hi); }
#pragma unroll
            for (int r = 0; r < 16; ++r) if (g1[r] > bv) { bv = g1[r]; bn = 32 + crow_(r, hi); }
            const float pv = __shfl_xor(bv, 32); const int pn = __shfl_xor(bn, 32);
            const bool tp = (pv > bv) || (pv == bv && pn < bn);
            const float wv = tp ? pv : bv; const int wn = tp ? pn : bn;
            if (wv > -INFINITY) { if (wn < 32) mlo |= 1u << wn; else mhi |= 1u << (wn - 32); }
#pragma unroll
            for (int r = 0; r < 16; ++r) { if (crow_(r, hi) == wn) g0[r] = -INFINITY; if (32 + crow_(r, hi) == wn) g1[r] = -INFINITY; }
        }
        __syncthreads();
    }
    v4u krA, vrA, krB, vrB; unsigned wlA = 0u, whA = 0u, wlB = 0u, whB = 0u;
    const GAS unsigned* mrow = (const GAS unsigned*)(F.ws + WS_MASK) + (rowb + q) * 512;
    at_load(Kh, Vh, 0, tid, krA, vrA);
    unsigned wl_c = 0u, wh_c = 0u;
    if (MODE == 1) { wl_c = mrow[0]; wh_c = mrow[1]; }
    at_store(L + AT_K0, L + AT_V0, tid, krA, vrA);
    at_load(Kh, Vh, 1, tid, krA, vrA);
    if (MODE == 1) { wlA = mrow[2]; whA = mrow[3]; }
    __syncthreads();
    float m = -1e30f, lsum = 0.f;
    f32x16 o0 = {0.f, 0.f, 0.f, 0.f, 0.f, 0.f, 0.f, 0.f, 0.f, 0.f, 0.f, 0.f, 0.f, 0.f, 0.f, 0.f}, o1 = o0;
    auto step = [&](int t, v4u& krS, v4u& vrS, unsigned& wlS, unsigned& whS, v4u& krN, v4u& vrN, unsigned& wlN, unsigned& whN) __attribute__((always_inline)) {
        const int cur = t & 1;
        unsigned wlo = wl_c, whi = wh_c;
        if (t + 2 < NT) { at_load(Kh, Vh, t + 2, tid, krN, vrN); if (MODE == 1) { wlN = mrow[2 * (t + 2)]; whN = mrow[2 * (t + 2) + 1]; } }
        if (MODE == 0) {
            if (t < 4 * qt) { const int blk = t >> 2; const unsigned bit = (blk < 32 ? (mlo >> blk) : (mhi >> (blk - 32))) & 1u; wlo = whi = bit ? 0xffffffffu : 0u; }
            else { const int nall = q - t * 64 + 1;
                wlo = nall >= 32 ? 0xffffffffu : (nall <= 0 ? 0u : ((1u << nall) - 1u)); whi = nall >= 64 ? 0xffffffffu : (nall <= 32 ? 0u : ((1u << (nall - 32)) - 1u)); }
        }
        if (__any((wlo | whi) != 0u)) {
            const LAS unsigned char* kb = L + AT_K0 + cur * AT_KBUF; const LAS unsigned char* vb = L + AT_V0 + cur * AT_VBUF;
            const bool and_mask = (MODE == 1) || (t >= 4 * qt);
            const float ci = (!and_mask && wlo == 0u) ? -1e9f : 0.f;
            f32x16 p0 = {ci, ci, ci, ci, ci, ci, ci, ci, ci, ci, ci, ci, ci, ci, ci, ci}, p1 = p0;
            at_qk(p0, p1, kb, qf, r32, hi);
            MFMA_FENCE2(p0, p1);
            const bool near = (t * 64 + 191 > q0w);
            float mx; float sc = AT_C2;
            if (near) {
#pragma unroll
                for (int r = 0; r < 16; ++r) { const int d0 = q - (t * 64 + crow_(r, hi)), d1 = d0 - 32;
                    const float b0 = ((unsigned)d0 < 128u) ? bt[d0] : 0.f, b1 = ((unsigned)d1 < 128u) ? bt[d1] : 0.f;
                    p0[r] = p0[r] * AT_C2 + b0; p1[r] = p1[r] * AT_C2 + b1; }
                sc = 1.0f;
            }
            { float ma = max3_(p0[0], p1[0], p0[1]), mb = max3_(p1[1], p0[2], p1[2]), mc = max3_(p0[3], p1[3], p0[4]), md = max3_(p1[4], p0[5], p1[5]);
              ma = max3_(ma, p0[6], p1[6]); mb = max3_(mb, p0[7], p1[7]); mc = max3_(mc, p0[8], p1[8]); md = max3_(md, p0[9], p1[9]);
              ma = max3_(ma, p0[10], p1[10]); mb = max3_(mb, p0[11], p1[11]); mc = max3_(mc, p0[12], p1[12]); md = max3_(md, p0[13], p1[13]);
              ma = max3_(ma, p0[14], p1[14]); mb = max3_(mb, p0[15], p1[15]); mx = max3_(ma, mb, mc); mx = max3_(mx, md, md); }
            mx = max3_(mx, __shfl_xor(mx, 32), mx) * sc;
            if (__any(mx > m + AT_THR)) {
                const float mn = fmaxf(m, mx); const float al = __builtin_amdgcn_exp2f(m - mn);
                MFMA_FENCE2(o0, o1);
#pragma unroll
                for (int r = 0; r < 16; ++r) { o0[r] *= al; o1[r] *= al; }
                lsum *= al; m = mn;
            }
            float ls = 0.f;
            if (and_mask) {
                const unsigned wl = wlo >> (4 * hi), wh = whi >> (4 * hi);
                float lq[4] = {0.f, 0.f, 0.f, 0.f};
#pragma unroll
                for (int r = 0; r < 16; ++r) { const int cb = (r & 3) + 8 * (r >> 2);
                    const float e0 = __uint_as_float(and_sel(__builtin_amdgcn_exp2f(__builtin_fmaf(p0[r], sc, -m)), wl, cb)), e1 = __uint_as_float(and_sel(__builtin_amdgcn_exp2f(__builtin_fmaf(p1[r], sc, -m)), wh, cb));
                    p0[r] = e0; p1[r] = e1; lq[r & 1] += e0; lq[2 + (r & 1)] += e1; }
                ls = (lq[0] + lq[1]) + (lq[2] + lq[3]);
            } else {
#pragma unroll
                for (int r = 0; r < 16; ++r) { const float e0 = __builtin_amdgcn_exp2f(__builtin_fmaf(p0[r], sc, -m)), e1 = __builtin_amdgcn_exp2f(__builtin_fmaf(p1[r], sc, -m));
                    p0[r] = e0; p1[r] = e1; ls += e0 + e1; }
            }
            lsum += ls;
            bf16x8_t pb[4];
#pragma unroll
            for (int sg = 0; sg < 4; ++sg) { union { bf16x8_t v; unsigned u[4]; } pk;
#pragma unroll
                for (int j = 0; j < 4; ++j) { const int r = 8 * (sg & 1) + 2 * j; pk.u[j] = (sg < 2) ? pg8::cvt_pk_bf16(p0[r], p0[r + 1]) : pg8::cvt_pk_bf16(p1[r], p1[r + 1]); }
                pb[sg] = pk.v; }
            at_pv(o0, o1, vb, pb, r32, hi);
        }
        if (t + 1 < NT) at_store(L + AT_K0 + (cur ^ 1) * AT_KBUF, L + AT_V0 + (cur ^ 1) * AT_VBUF, tid, krS, vrS);
        wl_c = wlS; wh_c = whS;
        __syncthreads();
    };
#pragma unroll 1
    for (int t = 0; t < NT; t += 2) {
        step(t, krA, vrA, wlA, whA, krB, vrB, wlB, whB);
        step(t + 1, krB, vrB, wlB, whB, krA, vrA, wlA, whA);
    }
    MFMA_FENCE2(o0, o1);
    lsum += __shfl_xor(lsum, 32);
    const float inv = 1.0f / lsum;
    LAS bf16* ost = (LAS bf16*)(L + AT_OST + wave * 4096);
#pragma unroll
    for (int r = 0; r < 16; ++r) { ost[r32 * 64 + crow_(r, hi)] = (bf16)f2bf(o0[r] * inv); ost[r32 * 64 + 32 + crow_(r, hi)] = (bf16)f2bf(o1[r] * inv); }
    LDS_WAIT(); asm volatile("" ::: "memory");
    GAS bf16* Og = (GAS bf16*)WSB(MODE == 0 ? WS_QA : WS_QB) + (rowb + q0w) * 512 + h * 64;
#pragma unroll
    for (int i = 0; i < 4; ++i) { const int c = i * 64 + lane, row = c >> 3, ch = c & 7; const v4u ov = *(const LAS v4u*)(ost + row * 64 + ch * 8); if (!DRY) *(GAS v4u*)(Og + (size_t)row * 512 + ch * 8) = ov; else if (ov.x == 0x12345678u && ov.y == 0x9abcdef0u) *(GAS v4u*)(Og + (size_t)row * 512 + ch * 8) = ov; }
}

constexpr int DA_K0 = 0, DA_V0 = 3 * AT_KBUF, DA_BT = DA_V0 + 2 * AT_VBUF, DA_OST = 49152;
static_assert(DA_BT + 512 <= DA_OST && DA_OST + 8 * 4096 <= RING_BYTES, "dsa attention LDS map");
__device__ __forceinline__ v4u at_load_k(const GAS bf16* Kh, int tile, int tid) { return *(const GAS v4u*)(Kh + (size_t)(tile * 64 + (tid >> 3)) * 512 + (tid & 7) * 8); }
__device__ __forceinline__ v4u at_load_v(const GAS bf16* Vh, int tile, int tid) { return *(const GAS v4u*)(Vh + (size_t)(tile * 64 + (tid & 63)) * 512 + (tid >> 6) * 8); }
__device__ __forceinline__ void at_store_k(LAS unsigned char* kb, int tid, const v4u kr) { *(LAS v4u*)(kb + (tid >> 3) * AT_KROW + (tid & 7) * 16) = kr; }
__device__ __forceinline__ void at_store_v(LAS unsigned char* vb, int tid, const v4u vr) {
    LAS bf16* vt = (LAS bf16*)(vb + ((tid >> 6) * 8) * AT_VROW) + (tid & 63); constexpr int RS = AT_VROW / 2;
    vt[0 * RS] = (bf16)(vr.x & 0xffffu); vt[1 * RS] = (bf16)(vr.x >> 16); vt[2 * RS] = (bf16)(vr.y & 0xffffu); vt[3 * RS] = (bf16)(vr.y >> 16);
    vt[4 * RS] = (bf16)(vr.z & 0xffffu); vt[5 * RS] = (bf16)(vr.z >> 16); vt[6 * RS] = (bf16)(vr.w & 0xffffu); vt[7 * RS] = (bf16)(vr.w >> 16);
}
struct DsaState { float m, lsum; f32x16 o0, o1; unsigned wc_lo, wc_hi, wn_lo, wn_hi; };
__device__ __forceinline__ void dsa_step(DsaState& S, f32x16& P0, f32x16& P1, f32x16& Pn0, f32x16& Pn1, int t, int NT, LAS unsigned char* L, const LAS float* bt, const bf16x8_t (&qf)[4],
                                         const GAS bf16* Kh, const GAS bf16* Vh, const GAS unsigned* mrow, int tid, int r32, int hi, int q, int q0w) {
    v4u krn, vrn; unsigned wq_lo = 0u, wq_hi = 0u;
    const bool has1 = (t + 1 < NT), has2 = (t + 2 < NT);
    if (has2) { krn = at_load_k(Kh, t + 2, tid); wq_lo = mrow[2 * (t + 2)]; wq_hi = mrow[2 * (t + 2) + 1]; }
    if (has1) vrn = at_load_v(Vh, t + 1, tid);
    if (has1 && __any((S.wn_lo | S.wn_hi) != 0u)) {
        Pn0 = (f32x16){0.f, 0.f, 0.f, 0.f, 0.f, 0.f, 0.f, 0.f, 0.f, 0.f, 0.f, 0.f, 0.f, 0.f, 0.f, 0.f}; Pn1 = Pn0;
        at_qk(Pn0, Pn1, L + DA_K0 + ((t + 1) % 3) * AT_KBUF, qf, r32, hi);
    }
    if (__any((S.wc_lo | S.wc_hi) != 0u)) {
        const LAS unsigned char* vb = L + DA_V0 + (t & 1) * AT_VBUF;
        MFMA_FENCE2(P0, P1);
        const bool near = (t * 64 + 191 > q0w);
        float sc = AT_C2;
        if (near) {
#pragma unroll
            for (int r = 0; r < 16; ++r) { const int d0 = q - (t * 64 + crow_(r, hi)), d1 = d0 - 32;
                const float b0 = ((unsigned)d0 < 128u) ? bt[d0] : 0.f, b1 = ((unsigned)d1 < 128u) ? bt[d1] : 0.f;
                P0[r] = P0[r] * AT_C2 + b0; P1[r] = P1[r] * AT_C2 + b1; }
            sc = 1.0f;
        }
        float mx = max3_(P0[0], P1[0], P0[1]), mx2 = max3_(P1[1], P0[2], P1[2]);
#pragma unroll
        for (int r = 3; r < 15; r += 2) { mx = max3_(mx, P0[r], P1[r]); mx2 = max3_(mx2, P0[r + 1], P1[r + 1]); }
        mx = max3_(mx, P0[15], P1[15]); mx = max3_(mx, mx2, mx2);
        mx = max3_(mx, __shfl_xor(mx, 32), mx) * sc;
        if (__any(mx > S.m + AT_THR)) {
            const float mn = fmaxf(S.m, mx); const float al = __builtin_amdgcn_exp2f(S.m - mn);
            MFMA_FENCE2(S.o0, S.o1);
#pragma unroll
            for (int r = 0; r < 16; ++r) { S.o0[r] *= al; S.o1[r] *= al; }
            S.lsum *= al; S.m = mn;
        }
        const unsigned wl = S.wc_lo >> (4 * hi), wh = S.wc_hi >> (4 * hi); const float m = S.m;
        float ls = 0.f;
#pragma unroll
        for (int r = 0; r < 16; ++r) { const int cb = (r & 3) + 8 * (r >> 2);
            const float e0 = __uint_as_float(and_sel(__builtin_amdgcn_exp2f(__builtin_fmaf(P0[r], sc, -m)), wl, cb)), e1 = __uint_as_float(and_sel(__builtin_amdgcn_exp2f(__builtin_fmaf(P1[r], sc, -m)), wh, cb));
            P0[r] = e0; P1[r] = e1; ls += e0 + e1; }
        S.lsum += ls;
        bf16x8_t pb[4];
#pragma unroll
        for (int sg = 0; sg < 4; ++sg) { union { bf16x8_t v; unsigned u[4]; } pk;
#pragma unroll
            for (int j = 0; j < 4; ++j) { const int r = 8 * (sg & 1) + 2 * j; pk.u[j] = (sg < 2) ? pg8::cvt_pk_bf16(P0[r], P0[r + 1]) : pg8::cvt_pk_bf16(P1[r], P1[r + 1]); }
            pb[sg] = pk.v; }
        at_pv(S.o0, S.o1, vb, pb, r32, hi);
    }
    if (has2) at_store_k(L + DA_K0 + ((t + 2) % 3) * AT_KBUF, tid, krn);
    if (has1) at_store_v(L + DA_V0 + ((t + 1) & 1) * AT_VBUF, tid, vrn);
    S.wc_lo = S.wn_lo; S.wc_hi = S.wn_hi; S.wn_lo = wq_lo; S.wn_hi = wq_hi;
    __syncthreads();
}
template <bool DRY = false> __device__ __forceinline__ void dsa_attn_unit(Frame& F, int b, int h, int qt) {
    int tid_ = F.tid; asm volatile("" : "+v"(tid_));
    const int tid = tid_, lane = tid & 63, wave = F.wave, r32 = lane & 31, hi = lane >> 5;
    LAS unsigned char* L = F.lds + RING_OFF;
    LAS float* bt = (LAS float*)(L + DA_BT);
    const size_t rowb = (size_t)b * SEQ;
    const GAS bf16* Kh = (const GAS bf16*)WSB(WS_KB) + rowb * 512 + h * 64; const GAS bf16* Vh = (const GAS bf16*)WSB(WS_VB) + rowb * 512 + h * 64;
    const int q0w = qt * 256 + wave * 32, q = q0w + r32;
    const int NT = 4 * qt + 4;
    __syncthreads();
    if (tid < 128) { const GAS float* rb = (const GAS float*)INP(I_RELB) + (8 + h); bt[tid] = (rb[t5_bucket(tid) * 16] - rb[31 * 16]) * LOG2E; }
    bf16x8_t qf[4];
    { const GAS bf16* qp = (const GAS bf16*)WSB(WS_QB) + (rowb + q) * 512 + h * 64 + hi * 8;
#pragma unroll
      for (int s = 0; s < 4; ++s) qf[s] = *(const GAS bf16x8_t*)(qp + s * 16); }
    const GAS unsigned* mrow = (const GAS unsigned*)(F.ws + WS_MASK) + (rowb + q) * 512;
    DsaState S; S.m = -1e30f; S.lsum = 0.f; S.o0 = (f32x16){0.f, 0.f, 0.f, 0.f, 0.f, 0.f, 0.f, 0.f, 0.f, 0.f, 0.f, 0.f, 0.f, 0.f, 0.f, 0.f}; S.o1 = S.o0;
    S.wc_lo = mrow[0]; S.wc_hi = mrow[1]; S.wn_lo = mrow[2]; S.wn_hi = mrow[3];
    { const v4u k0 = at_load_k(Kh, 0, tid), v0 = at_load_v(Vh, 0, tid), k1 = at_load_k(Kh, 1, tid);
      at_store_k(L + DA_K0, tid, k0); at_store_v(L + DA_V0, tid, v0); at_store_k(L + DA_K0 + AT_KBUF, tid, k1); }
    __syncthreads();
    f32x16 pA0 = {0.f, 0.f, 0.f, 0.f, 0.f, 0.f, 0.f, 0.f, 0.f, 0.f, 0.f, 0.f, 0.f, 0.f, 0.f, 0.f}, pA1 = pA0, pB0 = pA0, pB1 = pA0;
    if (__any((S.wc_lo | S.wc_hi) != 0u)) at_qk(pA0, pA1, L + DA_K0, qf, r32, hi);
#pragma unroll 1
    for (int t = 0; t < NT; t += 2) {
        dsa_step(S, pA0, pA1, pB0, pB1, t, NT, L, bt, qf, Kh, Vh, mrow, tid, r32, hi, q, q0w);
        dsa_step(S, pB0, pB1, pA0, pA1, t + 1, NT, L, bt, qf, Kh, Vh, mrow, tid, r32, hi, q, q0w);
    }
    MFMA_FENCE2(S.o0, S.o1);
    float lsum = S.lsum; lsum += __shfl_xor(lsum, 32);
    const float inv = 1.0f / lsum;
    LAS bf16* ost = (LAS bf16*)(L + DA_OST + wave * 4096);
#pragma unroll
    for (int r = 0; r < 16; ++r) { ost[r32 * 64 + crow_(r, hi)] = (bf16)f2bf(S.o0[r] * inv); ost[r32 * 64 + 32 + crow_(r, hi)] = (bf16)f2bf(S.o1[r] * inv); }
    LDS_WAIT(); asm volatile("" ::: "memory");
    GAS bf16* Og = (GAS bf16*)WSB(WS_QB) + (rowb + q0w) * 512 + h * 64;
#pragma unroll
    for (int i = 0; i < 4; ++i) { const int c = i * 64 + lane, row = c >> 3, ch = c & 7; const v4u ov = *(const LAS v4u*)(ost + row * 64 + ch * 8); if (!DRY) *(GAS v4u*)(Og + (size_t)row * 512 + ch * 8) = ov; else if (ov.x == 0x12345678u && ov.y == 0x9abcdef0u) *(GAS v4u*)(Og + (size_t)row * 512 + ch * 8) = ov; }
}

constexpr int A2_TILE = 64 * 128;
__device__ __forceinline__ void at2_dma(const GAS bf16* Kh, const GAS bf16* Vh, int tile, int wave, int lane, LAS unsigned char* kb, LAS unsigned char* vb) {
    const int row = 8 * wave + (lane >> 3), p = lane & 7;
    const GAS bf16* kg = Kh + (size_t)(tile * 64 + row) * 512 + ((p ^ ((row >> 1) & 7)) * 8);
    const GAS bf16* vg = Vh + (size_t)(tile * 64 + row) * 512 + ((p ^ (((row >> 1) & 1) * 4)) * 8);
    __builtin_amdgcn_global_load_lds((const unsigned*)kg, (LAS unsigned*)(kb + wave * 1024), 16, 0, 0);
    __builtin_amdgcn_global_load_lds((const unsigned*)vg, (LAS unsigned*)(vb + wave * 1024), 16, 0, 0);
}
__device__ __forceinline__ void at2_qk_m(f32x16& p0, f32x16& p1, const LAS unsigned char* kb, const LAS unsigned char* ones, const bf16x8_t (&qf)[4], const bf16x8_t mB, int r32, int hi) {
    const int f = (r32 >> 1) & 7;
    const LAS unsigned char* kp = kb + r32 * 128;
    bf16x8_t k0[5], k1[5];
#pragma unroll
    for (int s = 0; s < 4; ++s) { const int po = ((2 * s + hi) ^ f) * 16; k0[s] = *(const LAS bf16x8_t*)(kp + po); k1[s] = *(const LAS bf16x8_t*)(kp + 32 * 128 + po); }
    k0[4] = *(const LAS bf16x8_t*)ones; k1[4] = k0[4];
    asm volatile("s_waitcnt lgkmcnt(0)" : "+v"(k0[0]), "+v"(k0[1]), "+v"(k0[2]), "+v"(k0[3]), "+v"(k0[4]), "+v"(k1[0]), "+v"(k1[1]), "+v"(k1[2]), "+v"(k1[3]), "+v"(k1[4]) :: "memory");
    p0 = __builtin_amdgcn_mfma_f32_32x32x16_bf16(k0[4], mB, p0, 0, 0, 0); p1 = __builtin_amdgcn_mfma_f32_32x32x16_bf16(k1[4], mB, p1, 0, 0, 0);
#pragma unroll
    for (int s = 0; s < 4; ++s) { p0 = __builtin_amdgcn_mfma_f32_32x32x16_bf16(k0[s], qf[s], p0, 0, 0, 0); p1 = __builtin_amdgcn_mfma_f32_32x32x16_bf16(k1[s], qf[s], p1, 0, 0, 0); }
}
typedef short s16x4_t __attribute__((ext_vector_type(4)));
__device__ __forceinline__ void at2_pv(f32x16& o0, f32x16& o1, const LAS unsigned char* vb, const bf16x8_t (&pb)[4], int lane) {
    const int g = lane >> 4, q = (lane & 15) >> 2, p = lane & 3;
    const int sw = ((q >> 1) & 1) * 4, c0 = 2 * (g & 1) + (p >> 1);
    const LAS unsigned char* rowp = vb + (4 * (g >> 1) + q) * 128 + 8 * (p & 1);
    const LAS unsigned char* b0 = rowp + ((c0 ^ sw) * 16); const LAS unsigned char* b1 = rowp + (((c0 + 4) ^ sw) * 16);
    union U { bf16x8_t v; s16x4_t h[2]; }; U a0[4], a1[4];
#pragma unroll
    for (int sg = 0; sg < 4; ++sg) { const int ro = (32 * (sg >> 1) + 16 * (sg & 1)) * 128;
        a0[sg].h[0] = __builtin_amdgcn_ds_read_tr16_b64_v4i16((LAS s16x4_t*)(b0 + ro)); a0[sg].h[1] = __builtin_amdgcn_ds_read_tr16_b64_v4i16((LAS s16x4_t*)(b0 + ro + 8 * 128));
        a1[sg].h[0] = __builtin_amdgcn_ds_read_tr16_b64_v4i16((LAS s16x4_t*)(b1 + ro)); a1[sg].h[1] = __builtin_amdgcn_ds_read_tr16_b64_v4i16((LAS s16x4_t*)(b1 + ro + 8 * 128)); }
    asm volatile("s_waitcnt lgkmcnt(0)" : "+v"(a0[0].v), "+v"(a0[1].v), "+v"(a0[2].v), "+v"(a0[3].v), "+v"(a1[0].v), "+v"(a1[1].v), "+v"(a1[2].v), "+v"(a1[3].v) :: "memory");
#pragma unroll
    for (int sg = 0; sg < 4; ++sg) { o0 = __builtin_amdgcn_mfma_f32_32x32x16_bf16(a0[sg].v, pb[sg], o0, 0, 0, 0); o1 = __builtin_amdgcn_mfma_f32_32x32x16_bf16(a1[sg].v, pb[sg], o1, 0, 0, 0); }
}
constexpr int D2_K = 0, D2_V = 4 * A2_TILE, D2_ONES = 8 * A2_TILE, D2_BT = D2_ONES + 64, D2_OST = 73728;
static_assert(D2_BT + 512 <= D2_OST && D2_OST + 8 * 4096 <= RING_BYTES, "dsa2 LDS map");
template <bool DRY = false> __device__ __forceinline__ void dsa_attn2_unit(Frame& F, int b, int h, int qt) {
    int tid_ = F.tid; asm volatile("" : "+v"(tid_));
    const int tid = tid_, lane = tid & 63, wave = F.wave, r32 = lane & 31, hi = lane >> 5;
    LAS unsigned char* L = F.lds + RING_OFF;
    LAS float* bt = (LAS float*)(L + D2_BT);
    const size_t rowb = (size_t)b * SEQ;
    const GAS bf16* Kh = (const GAS bf16*)WSB(WS_KB) + rowb * 512 + h * 64; const GAS bf16* Vh = (const GAS bf16*)WSB(WS_VB) + rowb * 512 + h * 64;
    const int q0w = qt * 256 + wave * 32, q = q0w + r32;
    const int NS = 2 * qt + 2;
    __syncthreads();
    if (tid < 128) { const GAS float* rb = (const GAS float*)INP(I_RELB) + (8 + h); bt[tid] = (rb[t5_bucket(tid) * 16] - rb[31 * 16]) * LOG2E; }
    bf16x8_t qf[4];
    { const GAS bf16* qp = (const GAS bf16*)WSB(WS_QB) + (rowb + q) * 512 + h * 64 + hi * 8;
#pragma unroll
      for (int s = 0; s < 4; ++s) qf[s] = *(const GAS bf16x8_t*)(qp + s * 16); }
#pragma unroll
    for (int s = 0; s < 4; ++s) { union { bf16x8_t v; unsigned u[4]; } x; x.v = qf[s];
#pragma unroll
        for (int jj = 0; jj < 4; ++jj) x.u[jj] = pg8::cvt_pk_bf16(pg8::bf_lo(x.u[jj]) * AT_C2, pg8::bf_hi(x.u[jj]) * AT_C2);
        qf[s] = x.v; }
    bf16x8_t mB;
    { union { bf16x8_t v; unsigned u[4]; } x; x.u[0] = x.u[1] = x.u[2] = x.u[3] = 0u; mB = x.v; }
    if (tid == 0) { unsigned one = 0x3f80u, zz = 0u; asm volatile("" : "+v"(one), "+v"(zz)); *(LAS v4u*)(L + D2_ONES) = (v4u){one, zz, zz, zz}; }
    bool fresh = true;
    const GAS unsigned* mrow = (const GAS unsigned*)(F.ws + WS_MASK) + (rowb + q) * 512;
    auto dma2 = [&](int s) __attribute__((always_inline)) { const int set = s & 1;
        at2_dma(Kh, Vh, 2 * s, wave, lane, L + D2_K + (2 * set) * A2_TILE, L + D2_V + (2 * set) * A2_TILE);
        at2_dma(Kh, Vh, 2 * s + 1, wave, lane, L + D2_K + (2 * set + 1) * A2_TILE, L + D2_V + (2 * set + 1) * A2_TILE); };
    dma2(0);
    unsigned wc[4] = { mrow[0], mrow[1], mrow[2], mrow[3] };
    VM_WAIT(); __syncthreads();
    float m = 0.f, lsum = 0.f;
    f32x16 o0 = {0.f, 0.f, 0.f, 0.f, 0.f, 0.f, 0.f, 0.f, 0.f, 0.f, 0.f, 0.f, 0.f, 0.f, 0.f, 0.f}, o1 = o0;
    auto step = [&](int s) __attribute__((always_inline)) {
        const int set = s & 1;
        if (s + 1 < NS) dma2(s + 1);
        unsigned wn[4] = {0u, 0u, 0u, 0u};
        if (s + 1 < NS) { const GAS unsigned* mp = mrow + 4 * (s + 1); wn[0] = mp[0]; wn[1] = mp[1]; wn[2] = mp[2]; wn[3] = mp[3]; }
        if (__any((wc[0] | wc[1] | wc[2] | wc[3]) != 0u)) {
            const LAS unsigned char* kb = L + D2_K + (2 * set) * A2_TILE; const LAS unsigned char* vb = L + D2_V + (2 * set) * A2_TILE;
            f32x16 p0 = {0.f, 0.f, 0.f, 0.f, 0.f, 0.f, 0.f, 0.f, 0.f, 0.f, 0.f, 0.f, 0.f, 0.f, 0.f, 0.f}, p1 = p0, p2 = p0, p3 = p0;
            at2_qk_m(p0, p1, kb, L + D2_ONES, qf, mB, r32, hi); at2_qk_m(p2, p3, kb + A2_TILE, L + D2_ONES, qf, mB, r32, hi);
            asm volatile("s_nop 15\n\ts_nop 15" : "+v"(p0), "+v"(p1), "+v"(p2), "+v"(p3));
            const int t0 = 2 * s;
            const bool near = ((t0 + 1) * 64 + 191 > q0w);
            if (near) {
#pragma unroll
                for (int r = 0; r < 16; ++r) { const int d0 = q - (t0 * 64 + crow_(r, hi)), d1 = d0 - 32, d2 = d0 - 64, d3 = d0 - 96;
                    const float b0 = ((unsigned)d0 < 128u) ? bt[d0] : 0.f, b1 = ((unsigned)d1 < 128u) ? bt[d1] : 0.f, b2 = ((unsigned)d2 < 128u) ? bt[d2] : 0.f, b3 = ((unsigned)d3 < 128u) ? bt[d3] : 0.f;
                    p0[r] += b0; p1[r] += b1; p2[r] += b2; p3[r] += b3; }
            }
            float mx;
            { float ma = max3_(p0[0], p1[0], p2[0]), mb = max3_(p3[0], p0[1], p1[1]), mc = max3_(p2[1], p3[1], p0[2]), md = max3_(p1[2], p2[2], p3[2]);
#pragma unroll
              for (int r = 3; r < 15; r += 2) { ma = max3_(ma, p0[r], p1[r]); mb = max3_(mb, p2[r], p3[r]); mc = max3_(mc, p0[r + 1], p1[r + 1]); md = max3_(md, p2[r + 1], p3[r + 1]); }
              ma = max3_(ma, p0[15], p1[15]); mb = max3_(mb, p2[15], p3[15]); mx = max3_(ma, mb, mc); mx = max3_(mx, md, md); }
            mx = max3_(mx, __shfl_xor(mx, 32), mx);
            if (fresh || __any(mx > AT_THR)) {
                const float d = fresh ? mx : fmaxf(mx, 0.f);
                const float mn = __uint_as_float(pg8::cvt_pk_bf16(0.f, m + d) & 0xffff0000u);
                const float dl = mn - m; const float al = __builtin_amdgcn_exp2f(-dl);
                MFMA_FENCE2(o0, o1);
#pragma unroll
                for (int r = 0; r < 16; ++r) { o0[r] *= al; o1[r] *= al; p0[r] -= dl; p1[r] -= dl; p2[r] -= dl; p3[r] -= dl; }
                lsum *= al; m = mn; fresh = false;
                { union { bf16x8_t v; unsigned u[4]; } x; x.u[0] = hi == 0 ? ((__float_as_uint(m) >> 16) ^ 0x8000u) : 0u; x.u[1] = x.u[2] = x.u[3] = 0u; mB = x.v; }
            }
            const unsigned w0 = wc[0] >> (4 * hi), w1 = wc[1] >> (4 * hi), w2 = wc[2] >> (4 * hi), w3 = wc[3] >> (4 * hi);
            float lq[4] = {0.f, 0.f, 0.f, 0.f};
#pragma unroll
            for (int r = 0; r < 16; ++r) { const int cb = (r & 3) + 8 * (r >> 2);
                const float e0 = __uint_as_float(and_sel(__builtin_amdgcn_exp2f(p0[r]), w0, cb)), e1 = __uint_as_float(and_sel(__builtin_amdgcn_exp2f(p1[r]), w1, cb));
                const float e2 = __uint_as_float(and_sel(__builtin_amdgcn_exp2f(p2[r]), w2, cb)), e3 = __uint_as_float(and_sel(__builtin_amdgcn_exp2f(p3[r]), w3, cb));
                p0[r] = e0; p1[r] = e1; p2[r] = e2; p3[r] = e3; lq[0] += e0; lq[1] += e1; lq[2] += e2; lq[3] += e3; }
            lsum += (lq[0] + lq[1]) + (lq[2] + lq[3]);
            bf16x8_t pb[4], pc[4];
#pragma unroll
            for (int sg = 0; sg < 4; ++sg) { union { bf16x8_t v; unsigned u[4]; } pk, pl;
#pragma unroll
                for (int j = 0; j < 4; ++j) { const int r = 8 * (sg & 1) + 2 * j; pk.u[j] = (sg < 2) ? pg8::cvt_pk_bf16(p0[r], p0[r + 1]) : pg8::cvt_pk_bf16(p1[r], p1[r + 1]);
                    pl.u[j] = (sg < 2) ? pg8::cvt_pk_bf16(p2[r], p2[r + 1]) : pg8::cvt_pk_bf16(p3[r], p3[r + 1]); }
                pb[sg] = pk.v; pc[sg] = pl.v; }
            at2_pv(o0, o1, vb, pb, lane); at2_pv(o0, o1, vb + A2_TILE, pc, lane);
        }
        wc[0] = wn[0]; wc[1] = wn[1]; wc[2] = wn[2]; wc[3] = wn[3];
        VM_WAIT(); __syncthreads();
    };
#pragma unroll 1
    for (int s = 0; s < NS; ++s) step(s);
    MFMA_FENCE2(o0, o1);
    lsum += __shfl_xor(lsum, 32);
    const float inv = 1.0f / lsum;
    LAS bf16* ost = (LAS bf16*)(L + D2_OST + wave * 4096);
#pragma unroll
    for (int r = 0; r < 16; ++r) { ost[r32 * 64 + crow_(r, hi)] = (bf16)f2bf(o0[r] * inv); ost[r32 * 64 + 32 + crow_(r, hi)] = (bf16)f2bf(o1[r] * inv); }
    LDS_WAIT(); asm volatile("" ::: "memory");
    GAS bf16* Og = (GAS bf16*)WSB(WS_QB) + (rowb + q0w) * 512 + h * 64;
#pragma unroll
    for (int i = 0; i < 4; ++i) { const int c = i * 64 + lane, row = c >> 3, ch = c & 7; const v4u ov = *(const LAS v4u*)(ost + row * 64 + ch * 8); if (!DRY) *(GAS v4u*)(Og + (size_t)row * 512 + ch * 8) = ov; else if (ov.x == 0x12345678u && ov.y == 0x9abcdef0u) *(GAS v4u*)(Og + (size_t)row * 512 + ch * 8) = ov; }
}
constexpr int IX_CAP = 768;
constexpr int IX_HIST = 0, IX_CAND = 0, IX_BM = 98304;
constexpr int IX_W = LDSCTL_OFF + 1024;
constexpr int IX_ST = LDSCTL_OFF + 1536;
constexpr int IX_SUB = LDSCTL_OFF + 2048, IX_L2 = IX_SUB + 8 * 1024, IX_C2 = IX_L2 + 8 * 512;
static_assert(IX_C2 + 64 <= LDS_BYTES, "idx sub-histogram LDS");
static_assert(IX_BM + 16 * 512 * 4 <= RING_BYTES && 16 * IX_CAP * 8 <= IX_BM && IX_ST + 6 * 64 <= LDS_BYTES, "idx LDS map");
#define MFMA_FENCE1(a) asm volatile("s_nop 15\n\ts_nop 15" : "+v"(a))
__device__ __forceinline__ float relu_(float x, float) { float r; asm("v_max_f32 %0, 0, %1" : "=v"(r) : "v"(x)); return r; }
__device__ __forceinline__ unsigned mono_key(float s) { const unsigned u = __float_as_uint(s + 0.0f); return u ^ ((unsigned)((int)u >> 31) | 0x80000000u); }

template <int MODE, bool LEVEL0, bool LAST, int HALF> __device__ __forceinline__ void idx_vec(const f32x16 (&accs)[2], const f32x4 (&wv)[4][4], LAS unsigned* hist, LAS unsigned long long* cand, LAS unsigned* bm, LAS unsigned* st,
                                                                                    const unsigned (&psh)[8], const unsigned (&ppre)[8], const bool (&pact)[8], int key, int t0, int hi, int lane, int w32, int shn, unsigned fmask, bool allsel) {
#pragma unroll
    for (int rb = 2 * HALF; rb < 2 * HALF + 2; ++rb) {
        const f32x16 acc = accs[rb - 2 * HALF];
        const int qla = 4 * rb + 2 * hi;
        const f32x4 w0 = wv[rb][0], w1 = wv[rb][1], w2 = wv[rb][2], w3 = wv[rb][3];
        float sa = w0.x * relu_(acc[0], 0.f), sa2 = w0.y * relu_(acc[1], 0.f); sa += w0.z * relu_(acc[2], 0.f); sa2 += w0.w * relu_(acc[3], 0.f);
        sa += w1.x * relu_(acc[4], 0.f); sa2 += w1.y * relu_(acc[5], 0.f); sa += w1.z * relu_(acc[6], 0.f); sa2 += w1.w * relu_(acc[7], 0.f);
        float sb = w2.x * relu_(acc[8], 0.f), sb2 = w2.y * relu_(acc[9], 0.f); sb += w2.z * relu_(acc[10], 0.f); sb2 += w2.w * relu_(acc[11], 0.f);
        sb += w3.x * relu_(acc[12], 0.f); sb2 += w3.y * relu_(acc[13], 0.f); sb += w3.z * relu_(acc[14], 0.f); sb2 += w3.w * relu_(acc[15], 0.f);
        sa += sa2; sb += sb2;
        const unsigned ua = mono_key(sa), ub = mono_key(sb);
        const bool va = !LAST || key <= t0 + qla, vb = !LAST || key <= t0 + qla + 1;
        if (MODE == 0) {
            const bool ma = va && (LEVEL0 || (pact[2 * rb] && (ua >> psh[2 * rb]) == ppre[2 * rb]));
            const bool mb = vb && (LEVEL0 || (pact[2 * rb + 1] && (ub >> psh[2 * rb + 1]) == ppre[2 * rb + 1]));
            const unsigned ba = LEVEL0 ? (ua >> 21) : ((ua >> shn) & fmask), bb = LEVEL0 ? (ub >> 21) : ((ub >> shn) & fmask);
            if (ma) __hip_atomic_fetch_add(hist + qla * 2048 + ba, 1u, __ATOMIC_RELAXED, __HIP_MEMORY_SCOPE_WORKGROUP);
            if (mb) __hip_atomic_fetch_add(hist + (qla + 1) * 2048 + bb, 1u, __ATOMIC_RELAXED, __HIP_MEMORY_SCOPE_WORKGROUP);
        } else {
            const unsigned pa = ua >> psh[2 * rb], pb = ub >> psh[2 * rb + 1];
            const bool sela = va && (allsel || pa > ppre[2 * rb]), selb = vb && (allsel || pb > ppre[2 * rb + 1]);
            const bool ca = va && !allsel && pa == ppre[2 * rb], cb = vb && !allsel && pb == ppre[2 * rb + 1];
            const unsigned long long bala = __ballot(sela), balb = __ballot(selb);
            if (lane == 0) { bm[(4 * rb + 0) * 512 + w32] = (unsigned)bala; bm[(4 * rb + 2) * 512 + w32] = (unsigned)(bala >> 32);
                             bm[(4 * rb + 1) * 512 + w32] = (unsigned)balb; bm[(4 * rb + 3) * 512 + w32] = (unsigned)(balb >> 32); }
            if (ca) { const unsigned slot = __hip_atomic_fetch_add(st + qla, 1u, __ATOMIC_RELAXED, __HIP_MEMORY_SCOPE_WORKGROUP);
                if (slot < (unsigned)IX_CAP) cand[qla * IX_CAP + slot] = ((unsigned long long)ua << 32) | (unsigned)(0xffff - key); }
            if (cb) { const unsigned slot = __hip_atomic_fetch_add(st + qla + 1, 1u, __ATOMIC_RELAXED, __HIP_MEMORY_SCOPE_WORKGROUP);
                if (slot < (unsigned)IX_CAP) cand[(qla + 1) * IX_CAP + slot] = ((unsigned long long)ub << 32) | (unsigned)(0xffff - key); }
        }
    }
}
template <int MODE, bool LEVEL0> __device__ __forceinline__ void idx_pass(Frame& F, const bf16x8_t (&qa)[4][4], const GAS bf16* kib, int t0, int nst, int wave, int lane,
                                                             int shn, unsigned fmask, bool allsel) {
    const int n = lane & 31, hi = lane >> 5;
    LAS unsigned char* L = F.lds + RING_OFF;
    LAS unsigned* hist = (LAS unsigned*)(L + IX_HIST); LAS unsigned long long* cand = (LAS unsigned long long*)(L + IX_CAND); LAS unsigned* bm = (LAS unsigned*)(L + IX_BM);
    const LAS float* wl = (const LAS float*)(F.lds + IX_W); LAS unsigned* st = (LAS unsigned*)(F.lds + IX_ST);
    unsigned psh[8], ppre[8]; bool pact[8];
#pragma unroll
    for (int i = 0; i < 8; ++i) { const int ql = 4 * (i >> 1) + 2 * hi + (i & 1); psh[i] = st[16 + ql]; ppre[i] = st[32 + ql]; pact[i] = (st[80 + ql] != 0u); }
    f32x4 wv[4][4];
#pragma unroll
    for (int rb = 0; rb < 4; ++rb)
#pragma unroll
        for (int j = 0; j < 4; ++j) wv[rb][j] = *(const LAS f32x4*)(wl + (4 * rb + 2 * hi) * 8 + 4 * j);
    bf16x8_t kf[4];
    const GAS bf16* kp = kib + (size_t)(wave * 32 + n) * 64 + hi * 8;
#pragma unroll
    for (int s = 0; s < 4; ++s) kf[s] = *(const GAS bf16x8_t*)(kp + s * 16);
#pragma unroll 1
    for (int stile = 0; stile < nst; ++stile) {
        const int key = stile * 256 + wave * 32 + n;
        const int w32 = stile * 8 + wave;
        const bool lastt = (stile + 1 == nst);
        f32x16 accs[2];
#pragma unroll
        for (int rb = 0; rb < 2; ++rb) { accs[rb] = (f32x16){0.f, 0.f, 0.f, 0.f, 0.f, 0.f, 0.f, 0.f, 0.f, 0.f, 0.f, 0.f, 0.f, 0.f, 0.f, 0.f};
#pragma unroll
            for (int s = 0; s < 4; ++s) accs[rb] = __builtin_amdgcn_mfma_f32_32x32x16_bf16(qa[rb][s], kf[s], accs[rb], 0, 0, 0); }
        asm volatile("s_nop 15\n\ts_nop 15" : "+v"(accs[0]), "+v"(accs[1]));
        if (!lastt) idx_vec<MODE, LEVEL0, false, 0>(accs, wv, hist, cand, bm, st, psh, ppre, pact, key, t0, hi, lane, w32, shn, fmask, allsel);
        else idx_vec<MODE, LEVEL0, true, 0>(accs, wv, hist, cand, bm, st, psh, ppre, pact, key, t0, hi, lane, w32, shn, fmask, allsel);
#pragma unroll
        for (int rb = 0; rb < 2; ++rb) { accs[rb] = (f32x16){0.f, 0.f, 0.f, 0.f, 0.f, 0.f, 0.f, 0.f, 0.f, 0.f, 0.f, 0.f, 0.f, 0.f, 0.f, 0.f};
#pragma unroll
            for (int s = 0; s < 4; ++s) accs[rb] = __builtin_amdgcn_mfma_f32_32x32x16_bf16(qa[2 + rb][s], kf[s], accs[rb], 0, 0, 0); }
        asm volatile("s_nop 15\n\ts_nop 15" : "+v"(accs[0]), "+v"(accs[1]), "+v"(kf[0]), "+v"(kf[1]), "+v"(kf[2]), "+v"(kf[3]));
        if (!lastt) { kp += (size_t)256 * 64;
#pragma unroll
            for (int s = 0; s < 4; ++s) kf[s] = *(const GAS bf16x8_t*)(kp + s * 16); }
        if (!lastt) idx_vec<MODE, LEVEL0, false, 1>(accs, wv, hist, cand, bm, st, psh, ppre, pact, key, t0, hi, lane, w32, shn, fmask, allsel);
        else idx_vec<MODE, LEVEL0, true, 1>(accs, wv, hist, cand, bm, st, psh, ppre, pact, key, t0, hi, lane, w32, shn, fmask, allsel);
    }
}

__device__ __forceinline__ void idx_unit(Frame& F, int b, int t0) {
    int tid_ = F.tid; asm volatile("" : "+v"(tid_));
    const int tid = tid_, lane = tid & 63, wave = F.wave, r32 = lane & 31, hh = lane >> 5;
    LAS unsigned char* L = F.lds + RING_OFF;
    LAS unsigned* hist = (LAS unsigned*)(L + IX_HIST); LAS unsigned long long* cand = (LAS unsigned long long*)(L + IX_CAND); LAS unsigned* bm = (LAS unsigned*)(L + IX_BM);
    LAS float* wl = (LAS float*)(F.lds + IX_W); LAS unsigned* st = (LAS unsigned*)(F.lds + IX_ST);
    const size_t rowb = (size_t)b * SEQ; const int nst = (t0 >> 8) + 1; const bool allsel = (t0 < 256);
    const GAS bf16* kib = (const GAS bf16*)WSB(WS_KI) + rowb * 64;
    __syncthreads();
    if (tid < 128) wl[tid] = ((const GAS float*)WSF(WS_WI) + (rowb + t0) * 8)[tid];
    if (tid < 16) { st[tid] = 0u; st[16 + tid] = 21u; st[32 + tid] = 0u; st[48 + tid] = 256u; st[64 + tid] = 0u; st[80 + tid] = 1u; }
    bf16x8_t qa[4][4];
    { const int qloc = 2 * ((r32 >> 2) & 1) + (r32 >> 4), head = (r32 & 3) + 4 * ((r32 >> 3) & 1);
      const GAS bf16* qp = (const GAS bf16*)WSB(WS_QI) + (rowb + t0 + qloc) * 512 + head * 64 + hh * 8;
#pragma unroll
      for (int rb = 0; rb < 4; ++rb)
#pragma unroll
        for (int s = 0; s < 4; ++s) qa[rb][s] = *(const GAS bf16x8_t*)(qp + (size_t)rb * 4 * 512 + s * 16); }
    __syncthreads();
    if (!allsel) {
#pragma unroll 1
        for (int level = 0; level < 3; ++level) {
            const int shn = level == 0 ? 21 : (level == 1 ? 10 : 0); const unsigned fmask = level == 2 ? 0x3ffu : 0x7ffu; const int nd = level == 2 ? 1024 : 2048;
            for (int i = tid; i < 16 * 2048 / 4; i += NWAVES * 64) ((LAS v4u*)hist)[i] = (v4u){0u, 0u, 0u, 0u};
            __syncthreads();
            { if (level == 0) idx_pass<0, true>(F, qa, kib, t0, nst, wave, lane, shn, fmask, false); else idx_pass<0, false>(F, qa, kib, t0, nst, wave, lane, shn, fmask, false); }
            __syncthreads();
            if (PROBE_SEL & 8) { for (int i = tid; i < 16 * 2048; i += NWAVES * 64) hist[i] = 0u; __syncthreads(); { if (level == 0) idx_pass<0, true>(F, qa, kib, t0, nst, wave, lane, shn, fmask, false); else idx_pass<0, false>(F, qa, kib, t0, nst, wave, lane, shn, fmask, false); } __syncthreads(); }
#pragma unroll 1
            for (int qq = 0; qq < 2; ++qq) { const int ql = 2 * wave + qq;
                if (st[80 + ql] == 0u) continue;
                const unsigned kneed = st[48 + ql]; const int D = nd >> 6; const LAS unsigned* hq = hist + ql * 2048 + lane * D;
                unsigned tot = 0u;
                for (int dd = 0; dd < D; ++dd) tot += hq[dd];
                unsigned S = tot;
#pragma unroll
                for (int o = 1; o < 64; o <<= 1) { const unsigned v = __shfl_down(S, o); if (lane + o < 64) S += v; }
                const unsigned above = S - tot;
                if (above < kneed && kneed <= S) { unsigned a = above; int bsel = 0; unsigned cb = 0u;
                    for (int dd = D - 1; dd >= 0; --dd) { const unsigned v = hq[dd];
                        if (a + v >= kneed) { bsel = lane * D + dd; cb = v; break; } a += v; }
                    const unsigned opre = st[32 + ql];
                    st[32 + ql] = (level == 0) ? (unsigned)bsel : ((opre << (level == 1 ? 11 : 10)) | (unsigned)bsel);
                    st[16 + ql] = (unsigned)shn; st[48 + ql] = kneed - a; st[64 + ql] = cb;
                    st[80 + ql] = (cb > (unsigned)IX_CAP && level < 2) ? 1u : 0u; }
            }
            __syncthreads();
            unsigned more = 0u;
#pragma unroll
            for (int i = 0; i < 16; ++i) more |= st[80 + i];
            __syncthreads();
            if (more == 0u) break;
        }
    }
    if (PROBE_SEL & 16) { idx_pass<1, false>(F, qa, kib, t0, nst, wave, lane, 0, 0u, allsel); __syncthreads(); if (tid < 16) st[tid] = 0u; __syncthreads(); }
    idx_pass<1, false>(F, qa, kib, t0, nst, wave, lane, 0, 0u, allsel);
    __syncthreads();
    if (!allsel) {
#pragma unroll 1
        for (int qq = 0; qq < 2; ++qq) { const int ql = 2 * wave + qq;
            const int nc = (int)(st[ql] < (unsigned)IX_CAP ? st[ql] : (unsigned)IX_CAP); int need = (int)st[48 + ql]; const int vbits = 16 + (int)st[16 + ql];
            if (need >= nc) {
                for (int k = lane; k < nc; k += 64) { const int key = 0xffff - (int)(cand[ql * IX_CAP + k] & 0xffffull); __hip_atomic_fetch_or(bm + ql * 512 + (key >> 5), 1u << (key & 31), __ATOMIC_RELAXED, __HIP_MEMORY_SCOPE_WORKGROUP); }
                continue; }
            const int shq = (int)st[16 + ql];
            if (shq >= 8) {
                LAS unsigned* sh2 = (LAS unsigned*)(F.lds + IX_SUB + wave * 1024); LAS unsigned long long* l2 = (LAS unsigned long long*)(F.lds + IX_L2 + wave * 512); LAS unsigned* c2p = (LAS unsigned*)(F.lds + IX_C2 + wave * 4);
#pragma unroll
                for (int i = 0; i < 4; ++i) sh2[4 * lane + i] = 0u;
                if (lane == 0) *c2p = 0u;
                LDS_WAIT(); asm volatile("" ::: "memory");
                const int fsh = 32 + shq - 8;
                for (int k = lane; k < nc; k += 64) { const unsigned f = (unsigned)(cand[ql * IX_CAP + k] >> fsh) & 0xffu; __hip_atomic_fetch_add(sh2 + f, 1u, __ATOMIC_RELAXED, __HIP_MEMORY_SCOPE_WORKGROUP); }
                LDS_WAIT(); asm volatile("" ::: "memory");
                const unsigned c0 = sh2[4 * lane], c1 = sh2[4 * lane + 1], c2 = sh2[4 * lane + 2], c3 = sh2[4 * lane + 3]; const unsigned tot = c0 + c1 + c2 + c3;
                unsigned S = tot;
#pragma unroll
                for (int o = 1; o < 64; o <<= 1) { const unsigned v = __shfl_down(S, o); if (lane + o < 64) S += v; }
                const unsigned above = S - tot; const unsigned needu = (unsigned)need;
                const bool found = above < needu && needu <= S;
                unsigned a = above; unsigned bsel = 0u, cbin = 0u;
                if (a + c3 >= needu) { bsel = 3u; cbin = c3; } else { a += c3; if (a + c2 >= needu) { bsel = 2u; cbin = c2; } else { a += c2; if (a + c1 >= needu) { bsel = 1u; cbin = c1; } else { a += c1; bsel = 0u; cbin = c0; } } }
                const int src = __ffsll((long long)__ballot(found)) - 1;
                const unsigned b2 = (unsigned)__shfl((int)(4u * lane + bsel), src), need2 = (unsigned)__shfl((int)(needu - a), src), cnt2 = (unsigned)__shfl((int)cbin, src);
                if (cnt2 <= 64u) {
                    for (int k = lane; k < nc; k += 64) { const unsigned long long ckk = cand[ql * IX_CAP + k]; const unsigned f = (unsigned)(ckk >> fsh) & 0xffu;
                        if (f > b2) { const int key = 0xffff - (int)(ckk & 0xffffull); __hip_atomic_fetch_or(bm + ql * 512 + (key >> 5), 1u << (key & 31), __ATOMIC_RELAXED, __HIP_MEMORY_SCOPE_WORKGROUP); }
                        else if (f == b2) { const unsigned slot = __hip_atomic_fetch_add(c2p, 1u, __ATOMIC_RELAXED, __HIP_MEMORY_SCOPE_WORKGROUP); l2[slot] = ckk; } }
                    LDS_WAIT(); asm volatile("" ::: "memory");
                    if (lane < (int)cnt2) { const unsigned long long mine = l2[lane]; unsigned rank = 0u;
                        for (unsigned j = 0; j < cnt2; ++j) rank += (l2[j] > mine) ? 1u : 0u;
                        if (rank < need2) { const int key = 0xffff - (int)(mine & 0xffffull); __hip_atomic_fetch_or(bm + ql * 512 + (key >> 5), 1u << (key & 31), __ATOMIC_RELAXED, __HIP_MEMORY_SCOPE_WORKGROUP); } }
                    LDS_WAIT(); asm volatile("" ::: "memory");
                    continue;
                }
            }
            unsigned long long ck[12]; unsigned alive = 0u, selm = 0u;
#pragma unroll
            for (int c = 0; c < 12; ++c) { const int k = c * 64 + lane; ck[c] = (k < nc) ? cand[ql * IX_CAP + k] : 0ull; if (k < nc) alive |= 1u << c; }
#pragma unroll 1
            for (int bit = vbits - 1 + 16; bit >= 0; --bit) {
                if (bit >= 16 && bit < 32) continue;
                unsigned ones = 0u; int cnt1 = 0;
#pragma unroll
                for (int c = 0; c < 12; ++c) { if (c * 64 < nc) { const bool o = ((alive >> c) & 1u) && ((ck[c] >> bit) & 1ull); cnt1 += __popcll(__ballot(o)); if (o) ones |= 1u << c; } }
                if (cnt1 >= need) alive &= ones;
                else { selm |= ones; alive &= ~ones; need -= cnt1; }
            }
            selm |= alive;
#pragma unroll
            for (int c = 0; c < 12; ++c) if ((selm >> c) & 1u) { const int key = 0xffff - (int)(ck[c] & 0xffffull); __hip_atomic_fetch_or(bm + ql * 512 + (key >> 5), 1u << (key & 31), __ATOMIC_RELAXED, __HIP_MEMORY_SCOPE_WORKGROUP); }
        }
    }
    __syncthreads();
    { GAS unsigned* mg = (GAS unsigned*)(F.ws + WS_MASK) + (rowb + t0) * 512; const int nw = nst * 8;
      for (int i = tid; i < 16 * nw; i += NWAVES * 64) { const int ql = i / nw, w = i - ql * nw; mg[(size_t)ql * 512 + w] = bm[ql * 512 + w]; } }
}
typedef __bf16 bf2_t __attribute__((ext_vector_type(2)));
constexpr size_t WS_KM2 = 110 * MiB;
constexpr size_t WS_MREF = 111 * MiB;
constexpr size_t WS_LACC = 38 * MiB;
constexpr size_t WS_PO = 464 * MiB;
constexpr size_t WS_PJ0 = WS_QI, WS_PJ1 = WS_XB, WS_PJ2 = WS_XB + 32 * MiB;
__device__ __forceinline__ unsigned char* pj_base(Frame& F, int l, int j) {
    if (j == 0) return F.ws + WS_PJ0;
    return (l == 0 ? (unsigned char*)F.out : F.ws + WS_PJ1) + (size_t)(j - 1) * (32 * MiB);
}
constexpr size_t WS_LJ = WS_KI;
constexpr size_t WS_LISTS = 496 * MiB;
constexpr int CW_LCNT = 16384;
static_assert((CW_LCNT + 2 * 1024) * 4 <= (int)CTL_ZERO_BYTES, "list counters inside the memset region");
__device__ __forceinline__ int list_off(int n) { return 256 * (63 * n - (n * (n - 1)) / 2); }
constexpr int IT_K = 0, IT_V = 4 * AT_KBUF, IT_BT = IT_V + 4 * AT_VBUF, IT_QP = IT_BT + 512, IT_OST = 73728;
static_assert(IT_QP + 8 * 128 <= IT_OST && IT_OST + 8 * 4096 <= RING_BYTES, "item LDS map");

template <bool DRY = false> __device__ __forceinline__ void moba_own_unit(Frame& F, int l, int b, int h, int qt) {
    int tid_ = F.tid; asm volatile("" : "+v"(tid_));
    const int tid = tid_, lane = tid & 63, wave = F.wave, r32 = lane & 31, hi = lane >> 5;
    LAS unsigned char* L = F.lds + RING_OFF;
    LAS float* bt = (LAS float*)(L + AT_BT);
    const GAS bf16* Qg = (const GAS bf16*)WSB(WS_QA);
    const size_t rowb = (size_t)b * SEQ;
    const GAS bf16* Kh = (const GAS bf16*)WSB(WS_KA) + rowb * 512 + h * 64; const GAS bf16* Vh = (const GAS bf16*)WSB(WS_VA) + rowb * 512 + h * 64;
    const int q0w = qt * 256 + wave * 32, q = q0w + r32;
    __syncthreads();
    if (tid < 128) { const GAS float* rb = (const GAS float*)INP(I_RELB) + h; bt[tid] = (rb[t5_bucket(tid) * 16] - rb[31 * 16]) * LOG2E; }
    bf16x8_t qf[4];
    { const GAS bf16* qp = Qg + (rowb + q) * 512 + h * 64 + hi * 8;
#pragma unroll
      for (int s = 0; s < 4; ++s) qf[s] = *(const GAS bf16x8_t*)(qp + s * 16); }
    { const int n = tid >> 3, c8 = (tid & 7) * 8; const GAS float* km = (const GAS float*)WSF(WS_KM2) + (((size_t)b * NBLK + n) * 2) * 512 + h * 64 + c8;
      f32x4 a = *(const GAS f32x4*)km + *(const GAS f32x4*)(km + 512), c = *(const GAS f32x4*)(km + 4) + *(const GAS f32x4*)(km + 516);
      a = a * (1.0f / 256.0f); c = c * (1.0f / 256.0f);
      const unsigned h0 = pk2(a.x, a.y), h1 = pk2(a.z, a.w), h2 = pk2(c.x, c.y), h3 = pk2(c.z, c.w);
      const unsigned l0 = pk2(a.x - __uint_as_float(h0 << 16), a.y - __uint_as_float(h0 & 0xffff0000u)), l1 = pk2(a.z - __uint_as_float(h1 << 16), a.w - __uint_as_float(h1 & 0xffff0000u)),
                     l2 = pk2(c.x - __uint_as_float(h2 << 16), c.y - __uint_as_float(h2 & 0xffff0000u)), l3 = pk2(c.z - __uint_as_float(h3 << 16), c.w - __uint_as_float(h3 & 0xffff0000u));
      *(LAS v4u*)(L + AT_K0 + n * AT_KROW + (tid & 7) * 16) = (v4u){h0, h1, h2, h3}; *(LAS v4u*)(L + AT_K0 + AT_KBUF + n * AT_KROW + (tid & 7) * 16) = (v4u){l0, l1, l2, l3}; }
    __syncthreads();
    unsigned mlo = 0u, mhi = 0u;
    if (qt > 0) {
        f32x16 g0 = {0.f, 0.f, 0.f, 0.f, 0.f, 0.f, 0.f, 0.f, 0.f, 0.f, 0.f, 0.f, 0.f, 0.f, 0.f, 0.f}, g1 = g0;
        at_qk(g0, g1, L + AT_K0, qf, r32, hi); at_qk(g0, g1, L + AT_K0 + AT_KBUF, qf, r32, hi);
        MFMA_FENCE2(g0, g1);
#pragma unroll
        for (int r = 0; r < 16; ++r) { if (crow_(r, hi) >= qt) g0[r] = -INFINITY; if (32 + crow_(r, hi) >= qt) g1[r] = -INFINITY; }
#pragma unroll
        for (int it = 0; it < 3; ++it) {
            float bv = -INFINITY; int bn = 64;
#pragma unroll
            for (int r = 0; r < 16; ++r) if (g0[r] > bv) { bv = g0[r]; bn = crow_(r, hi); }
#pragma unroll
            for (int r = 0; r < 16; ++r) if (g1[r] > bv) { bv = g1[r]; bn = 32 + crow_(r, hi); }
            const float pv = __shfl_xor(bv, 32); const int pn = __shfl_xor(bn, 32);
            const bool tp = (pv > bv) || (pv == bv && pn < bn);
            const float wv = tp ? pv : bv; const int wn = tp ? pn : bn;
            if (wv > -INFINITY) { if (wn < 32) mlo |= 1u << wn; else mhi |= 1u << (wn - 32);
                if (hi == 0 && !DRY) { GAS unsigned* cnt = (GAS unsigned*)(F.ws + WS_CTL) + CW_LCNT + ((l * 2 + b) * 8 + h) * 64 + wn;
                    const unsigned slot = __hip_atomic_fetch_add(cnt, 1u, __ATOMIC_RELAXED, __HIP_MEMORY_SCOPE_AGENT);
                    ((GAS unsigned short*)(F.ws + WS_LISTS) + ((size_t)(b * 8 + h) << 19))[list_off(wn) + slot] = (unsigned short)(q | (it << 14)); } }
#pragma unroll
            for (int r = 0; r < 16; ++r) { if (crow_(r, hi) == wn) g0[r] = -INFINITY; if (32 + crow_(r, hi) == wn) g1[r] = -INFINITY; }
        }
    }
    __syncthreads();
    v4u kr, vr;
    at_load(Kh, Vh, 4 * qt, tid, kr, vr);
    at_store(L + AT_K0, L + AT_V0, tid, kr, vr);
    __syncthreads();
    float m = -1e30f, lsum = 0.f;
    f32x16 o0 = {0.f, 0.f, 0.f, 0.f, 0.f, 0.f, 0.f, 0.f, 0.f, 0.f, 0.f, 0.f, 0.f, 0.f, 0.f, 0.f}, o1 = o0;
#pragma unroll 1
    for (int tt = 0; tt < 4; ++tt) {
        const int t = 4 * qt + tt, cur = tt & 1;
        if (tt + 1 < 4) at_load(Kh, Vh, t + 1, tid, kr, vr);
        const int nall = q - t * 64 + 1;
        const unsigned wlo = nall >= 32 ? 0xffffffffu : (nall <= 0 ? 0u : ((1u << nall) - 1u)), whi = nall >= 64 ? 0xffffffffu : (nall <= 32 ? 0u : ((1u << (nall - 32)) - 1u));
        if (__any((wlo | whi) != 0u)) {
            const LAS unsigned char* kb = L + AT_K0 + cur * AT_KBUF; const LAS unsigned char* vb = L + AT_V0 + cur * AT_VBUF;
            f32x16 p0 = {0.f, 0.f, 0.f, 0.f, 0.f, 0.f, 0.f, 0.f, 0.f, 0.f, 0.f, 0.f, 0.f, 0.f, 0.f, 0.f}, p1 = p0;
            at_qk(p0, p1, kb, qf, r32, hi);
            MFMA_FENCE2(p0, p1);
#pragma unroll
            for (int r = 0; r < 16; ++r) { const int d0 = q - (t * 64 + crow_(r, hi)), d1 = d0 - 32;
                const float b0 = ((unsigned)d0 < 128u) ? bt[d0] : 0.f, b1 = ((unsigned)d1 < 128u) ? bt[d1] : 0.f;
                p0[r] = p0[r] * AT_C2 + b0; p1[r] = p1[r] * AT_C2 + b1; }
            float mx;
            { float ma = max3_(p0[0], p1[0], p0[1]), mb = max3_(p1[1], p0[2], p1[2]), mc = max3_(p0[3], p1[3], p0[4]), md = max3_(p1[4], p0[5], p1[5]);
              ma = max3_(ma, p0[6], p1[6]); mb = max3_(mb, p0[7], p1[7]); mc = max3_(mc, p0[8], p1[8]); md = max3_(md, p0[9], p1[9]);
              ma = max3_(ma, p0[10], p1[10]); mb = max3_(mb, p0[11], p1[11]); mc = max3_(mc, p0[12], p1[12]); md = max3_(md, p0[13], p1[13]);
              ma = max3_(ma, p0[14], p1[14]); mb = max3_(mb, p0[15], p1[15]); mx = max3_(ma, mb, mc); mx = max3_(mx, md, md); }
            mx = max3_(mx, __shfl_xor(mx, 32), mx);
            if (__any(mx > m + AT_THR)) {
                const float mn = fmaxf(m, mx); const float al = __builtin_amdgcn_exp2f(m - mn);
                MFMA_FENCE2(o0, o1);
#pragma unroll
                for (int r = 0; r < 16; ++r) { o0[r] *= al; o1[r] *= al; }
                lsum *= al; m = mn;
            }
            const unsigned wl = wlo >> (4 * hi), wh = whi >> (4 * hi);
            float lq[4] = {0.f, 0.f, 0.f, 0.f};
#pragma unroll
            for (int r = 0; r < 16; ++r) { const int cb = (r & 3) + 8 * (r >> 2);
                const float e0 = __uint_as_float(and_sel(__builtin_amdgcn_exp2f(p0[r] - m), wl, cb)), e1 = __uint_as_float(and_sel(__builtin_amdgcn_exp2f(p1[r] - m), wh, cb));
                p0[r] = e0; p1[r] = e1; lq[r & 1] += e0; lq[2 + (r & 1)] += e1; }
            lsum += (lq[0] + lq[1]) + (lq[2] + lq[3]);
            bf16x8_t pb[4];
#pragma unroll
            for (int sg = 0; sg < 4; ++sg) { union { bf16x8_t v; unsigned u[4]; } pk;
#pragma unroll
                for (int j = 0; j < 4; ++j) { const int r = 8 * (sg & 1) + 2 * j; pk.u[j] = (sg < 2) ? pg8::cvt_pk_bf16(p0[r], p0[r + 1]) : pg8::cvt_pk_bf16(p1[r], p1[r + 1]); }
                pb[sg] = pk.v; }
            at_pv(o0, o1, vb, pb, r32, hi);
        }
        if (tt + 1 < 4) at_store(L + AT_K0 + (cur ^ 1) * AT_KBUF, L + AT_V0 + (cur ^ 1) * AT_VBUF, tid, kr, vr);
        __syncthreads();
    }
    MFMA_FENCE2(o0, o1);
    lsum += __shfl_xor(lsum, 32);
    if (hi == 0 && !DRY) { ((GAS float*)WSF(WS_MREF))[(rowb + q) * 8 + h] = m; ((GAS float*)WSF(WS_LACC))[(rowb + q) * 8 + h] = lsum; }
    LAS bf16* ost = (LAS bf16*)(L + AT_OST + wave * 4096);
#pragma unroll
    for (int r = 0; r < 16; ++r) { ost[r32 * 64 + crow_(r, hi)] = (bf16)f2bf(o0[r]); ost[r32 * 64 + 32 + crow_(r, hi)] = (bf16)f2bf(o1[r]); }
    LDS_WAIT(); asm volatile("" ::: "memory");
    GAS bf16* Og = (GAS bf16*)WSB(WS_PO) + (rowb + q0w) * 512 + h * 64;
#pragma unroll
    for (int i = 0; i < 4; ++i) { const int c = i * 64 + lane, row = c >> 3, ch = c & 7; const v4u ov = *(const LAS v4u*)(ost + row * 64 + ch * 8); if (!DRY || (ov.x == 0x12345678u && ov.y == 0x9abcdef0u)) *(GAS v4u*)(Og + (size_t)row * 512 + ch * 8) = ov; }
}

template <bool DRY = false> __device__ __forceinline__ void moba_item_unit(Frame& F, int l, int b, int h, int n) {
    int tid_ = F.tid; asm volatile("" : "+v"(tid_));
    const int tid = tid_, lane = tid & 63, wave = F.wave, r32 = lane & 31, hi = lane >> 5;
    LAS unsigned char* L = F.lds + RING_OFF;
    LAS float* bt = (LAS float*)(L + IT_BT);
    const size_t rowb = (size_t)b * SEQ;
    const int cnt = (int)((const GAS unsigned*)(F.ws + WS_CTL))[CW_LCNT + ((l * 2 + b) * 8 + h) * 64 + n];
    if (cnt == 0) return;
    const GAS bf16* Kh = (const GAS bf16*)WSB(WS_KA) + rowb * 512 + h * 64; const GAS bf16* Vh = (const GAS bf16*)WSB(WS_VA) + rowb * 512 + h * 64;
    __syncthreads();
    if (tid < 128) { const GAS float* rb = (const GAS float*)INP(I_RELB) + h; bt[tid] = (rb[t5_bucket(tid) * 16] - rb[31 * 16]) * LOG2E; }
#pragma unroll
    for (int t = 0; t < 4; ++t) { v4u kr, vr; at_load(Kh, Vh, 4 * n + t, tid, kr, vr); at_store(L + IT_K + t * AT_KBUF, L + IT_V + t * AT_VBUF, tid, kr, vr); }
    __syncthreads();
    const GAS unsigned short* lst = (const GAS unsigned short*)(F.ws + WS_LISTS) + ((size_t)(b * 8 + h) << 19) + list_off(n);
    LAS int* qpl = (LAS int*)(L + IT_QP + wave * 128);
    LAS float* ostf = (LAS float*)(L + IT_OST + wave * 4096);
    const int ngrp = (cnt + 31) >> 5;
#pragma unroll 1
    for (int g = wave; g < ngrp; g += NWAVES) {
        const int li = g * 32 + r32; const bool valid = li < cnt;
        const int ent = valid ? (int)lst[li] : (int)lst[g * 32];
        const int q = ent & 0x3fff;
        if (hi == 0) qpl[r32] = valid ? ent : -1;
        bf16x8_t qf[4];
        { const GAS bf16* qp = (const GAS bf16*)WSB(WS_QA) + (rowb + q) * 512 + h * 64 + hi * 8;
#pragma unroll
          for (int s = 0; s < 4; ++s) qf[s] = *(const GAS bf16x8_t*)(qp + s * 16); }
        const float mref = ((const GAS float*)WSF(WS_MREF))[(rowb + q) * 8 + h];
        const bool near = __any(q < 256 * (n + 1) + 128);
        float lsum = 0.f;
        f32x16 o0 = {0.f, 0.f, 0.f, 0.f, 0.f, 0.f, 0.f, 0.f, 0.f, 0.f, 0.f, 0.f, 0.f, 0.f, 0.f, 0.f}, o1 = o0;
#pragma unroll 1
        for (int t = 0; t < 4; ++t) {
            const LAS unsigned char* kb = L + IT_K + t * AT_KBUF; const LAS unsigned char* vb = L + IT_V + t * AT_VBUF;
            f32x16 p0 = {0.f, 0.f, 0.f, 0.f, 0.f, 0.f, 0.f, 0.f, 0.f, 0.f, 0.f, 0.f, 0.f, 0.f, 0.f, 0.f}, p1 = p0;
            at_qk(p0, p1, kb, qf, r32, hi);
            MFMA_FENCE2(p0, p1);
            float lq[4] = {0.f, 0.f, 0.f, 0.f};
            if (near) {
#pragma unroll
                for (int r = 0; r < 16; ++r) { const int d0 = q - ((4 * n + t) * 64 + crow_(r, hi)), d1 = d0 - 32;
                    const float b0 = ((unsigned)d0 < 128u) ? bt[d0] : 0.f, b1 = ((unsigned)d1 < 128u) ? bt[d1] : 0.f;
                    const float e0 = __builtin_amdgcn_exp2f(fminf(p0[r] * AT_C2 + b0 - mref, 60.f)), e1 = __builtin_amdgcn_exp2f(fminf(p1[r] * AT_C2 + b1 - mref, 60.f));
                    p0[r] = e0; p1[r] = e1; lq[r & 1] += e0; lq[2 + (r & 1)] += e1; }
            } else {
#pragma unroll
                for (int r = 0; r < 16; ++r) { const float e0 = __builtin_amdgcn_exp2f(fminf(__builtin_fmaf(p0[r], AT_C2, -mref), 60.f)), e1 = __builtin_amdgcn_exp2f(fminf(__builtin_fmaf(p1[r], AT_C2, -mref), 60.f));
                    p0[r] = e0; p1[r] = e1; lq[r & 1] += e0; lq[2 + (r & 1)] += e1; }
            }
            lsum += (lq[0] + lq[1]) + (lq[2] + lq[3]);
            bf16x8_t pb[4];
#pragma unroll
            for (int sg = 0; sg < 4; ++sg) { union { bf16x8_t v; unsigned u[4]; } pk;
#pragma unroll
                for (int j = 0; j < 4; ++j) { const int r = 8 * (sg & 1) + 2 * j; pk.u[j] = (sg < 2) ? pg8::cvt_pk_bf16(p0[r], p0[r + 1]) : pg8::cvt_pk_bf16(p1[r], p1[r + 1]); }
                pb[sg] = pk.v; }
            at_pv(o0, o1, vb, pb, r32, hi);
        }
        MFMA_FENCE2(o0, o1);
        lsum += __shfl_xor(lsum, 32);
        if (hi == 0 && valid && !DRY) ((GAS float*)WSF(WS_LJ))[((size_t)(ent >> 14) * T + rowb + q) * 8 + h] = lsum;
        LAS bf16* ost = (LAS bf16*)ostf;
#pragma unroll
        for (int r = 0; r < 16; ++r) { ost[r32 * 64 + crow_(r, hi)] = (bf16)f2bf(o0[r]); ost[r32 * 64 + 32 + crow_(r, hi)] = (bf16)f2bf(o1[r]); }
        LDS_WAIT(); asm volatile("" ::: "memory");
#pragma unroll
        for (int i = 0; i < 4; ++i) { const int c = i * 64 + lane, row = c >> 3, ch = c & 7; const int er = qpl[row];
            if (er >= 0 && !DRY) { const int j = er >> 14; GAS bf16* pj = (GAS bf16*)pj_base(F, l, j);
                *(GAS v4u*)(pj + (rowb + (er & 0x3fff)) * 512 + h * 64 + ch * 8) = *(const LAS v4u*)(ost + row * 64 + ch * 8); } }
        LDS_WAIT(); asm volatile("" ::: "memory");
    }
}
__device__ __forceinline__ void moba_fin_row(Frame& F, int layer, int m, int lane) {
    const int nsel = ((m & (SEQ - 1)) >> 8) < 3 ? ((m & (SEQ - 1)) >> 8) : 3;
    const int hd = lane >> 3;
    float l = ((const GAS float*)WSF(WS_LACC))[(size_t)m * 8 + hd];
    v4u v = ((const GAS v4u*)((const GAS bf16*)WSB(WS_PO) + (size_t)m * 512))[lane];
    float acc[8] = { __uint_as_float(v.x << 16), __uint_as_float(v.x & 0xffff0000u), __uint_as_float(v.y << 16), __uint_as_float(v.y & 0xffff0000u),
                     __uint_as_float(v.z << 16), __uint_as_float(v.z & 0xffff0000u), __uint_as_float(v.w << 16), __uint_as_float(v.w & 0xffff0000u) };
#pragma unroll
    for (int j = 0; j < 3; ++j) if (j < nsel) {
        l += ((const GAS float*)WSF(WS_LJ))[((size_t)j * T + m) * 8 + hd];
        const v4u w = ((const GAS v4u*)((const GAS bf16*)pj_base(F, layer, j) + (size_t)m * 512))[lane];
        acc[0] += __uint_as_float(w.x << 16); acc[1] += __uint_as_float(w.x & 0xffff0000u); acc[2] += __uint_as_float(w.y << 16); acc[3] += __uint_as_float(w.y & 0xffff0000u);
        acc[4] += __uint_as_float(w.z << 16); acc[5] += __uint_as_float(w.z & 0xffff0000u); acc[6] += __uint_as_float(w.w << 16); acc[7] += __uint_as_float(w.w & 0xffff0000u); }
    const float inv = 1.0f / l;
    v4u o; o.x = pk2(acc[0] * inv, acc[1] * inv); o.y = pk2(acc[2] * inv, acc[3] * inv); o.z = pk2(acc[4] * inv, acc[5] * inv); o.w = pk2(acc[6] * inv, acc[7] * inv);
    ((GAS v4u*)((GAS bf16*)WSB(WS_QA) + (size_t)m * 512))[lane] = o;
}
__global__ void __launch_bounds__(NWAVES * 64, 2) fwd(Args args) {
    extern __shared__ __attribute__((aligned(16))) unsigned char lds[];
    Frame F;
    F.lds = (LAS unsigned char*)lds;
        F.tid = threadIdx.x; F.lane = F.tid & 63; F.wave = __builtin_amdgcn_readfirstlane(F.tid >> 6);
    F.G = gridDim.x; F.bid = blockIdx.x;
    F.a = (const __attribute__((address_space(4))) Args*)__builtin_amdgcn_kernarg_segment_ptr(); F.ws = args.ws; F.out = args.out;
    unsigned char* ws = args.ws;
    for (int u = F.tid; u < (LDS_BYTES - LDSCTL_OFF) / 4; u += NWAVES * 64) ((LAS unsigned*)(F.lds + LDSCTL_OFF))[u] = 0u;
    __syncthreads();
    {
        volatile LAS unsigned* pw = (volatile LAS unsigned*)(F.lds + MISC_OFF) + 64;
        const unsigned hw = __builtin_amdgcn_s_getreg((4 << 0) | (4 << 6) | (1 << 11));
        if (F.lane == 0) pw[F.wave] = hw & 3u;
        __syncthreads();
        const unsigned my = pw[F.wave]; unsigned cnts = 0, rank = 0;
#pragma unroll
        for (int w = 0; w < NWAVES; ++w) { const unsigned s = pw[w]; cnts += 1u << (8 * s); if (w < F.wave && s == my) ++rank; }
#ifdef BAD_ROLES
        F.gw = __builtin_amdgcn_readfirstlane((cnts == 0x02020202u) ? (int)((my >> 1) * 4 + (my & 1) * 2 + rank) : F.wave);
#else
        F.gw = __builtin_amdgcn_readfirstlane((cnts == 0x02020202u) ? (int)(rank * 4 + my) : F.wave);
#endif
        __syncthreads();
    }
    XcdBarrier bar; bar.bar = (unsigned*)(ws + WS_CTL) + CW_BAR; bar.x = 0; bar.st = nullptr;
    if (ONE_LAUNCH) bar = xcd_barrier_post((unsigned*)(ws + WS_CTL) + CW_BAR, (volatile LAS unsigned*)(F.lds + MISC_OFF) + 8);
#define GRID_BAR() do { if (ONE_LAUNCH) xcd_barrier(bar); } while (0)
    const int lo = args.ph_lo, hi = args.ph_hi;
#ifndef PH_MASK
#define PH_MASK 0xfff
#endif
#define IN(k) (((PH_MASK >> ((k) % PH_PER_LAYER == 0 && (k) == 2 * PH_PER_LAYER ? 11 : (k) % PH_PER_LAYER)) & 1) && lo <= (k) && (k) < hi)
#define BOTH(k) (IN(k) && IN((k) + 1))
#define GEMM_TID ((F.gw << 6) | F.lane)
#define DYN_CTR(k) ((unsigned*)(F.ws + WS_CTL) + CW_DYN + 32 * (k))
#define DYN_FETCH(dst, k) do { __syncthreads(); if (F.tid == 0) *((volatile LAS unsigned*)(F.lds + MISC_OFF) + 32) = atomicAdd(DYN_CTR(k), 1u); __syncthreads(); \
        dst = (int)__builtin_amdgcn_readfirstlane(*((volatile LAS unsigned*)(F.lds + MISC_OFF) + 32)); } while (0)
#define LAUNDER() do { asm volatile("" : "+v"(F.tid)); F.lane = F.tid & 63; F.wave = __builtin_amdgcn_readfirstlane(F.tid >> 6); F.ws = launder_u(F.ws); F.out = launder_u(F.out); F.a = launder_u(F.a); F.bid = launder_i(F.bid); F.G = launder_i(F.G); F.gw = launder_i(F.gw); } while (0)
    LAS unsigned char* ring = F.lds + RING_OFF;
    for (int l = 0; l < 2; ++l) {
        const int P = l * PH_PER_LAYER;
#ifdef DBG_DUMP
        if (lo == DBG_PHASE && l == 0) { for (int u = F.bid; u < T; u += F.G) { F.out[(size_t)u * DM + F.tid] = bf2f(WSB(DBG_DUMP)[(size_t)u * DBG_PITCH + F.tid]); F.out[(size_t)u * DM + 512 + F.tid] = 0.f; } }
        if (lo >= DBG_PHASE && lo < 2 * PH_PER_LAYER) continue;
#endif
        if (IN(P + 0)) { LAUNDER(); p_prologue(F, l); if (PROBE_SEL & 128) { VM_WAIT(); __syncthreads(); p_prologue(F, l); } if (BOTH(P + 0)) GRID_BAR(); }
        if (IN(P + 1)) { LAUNDER();
            pg8::Gemm g{WSB(WS_XB), WSB(WS_W_IN), T, NIN_T, DM}; pg8::StaticOrder S; S.init(T, NIN_T, F.G, F.bid);
            pg8::EpiInproj E{WSB(WS_QA), WSB(WS_KI), WSF(WS_WI), SSQ_MIX(l), WSF(WS_KM2)};
            pg8::gemm_phase<pg8::EpiInproj, pg8::StaticOrder, true, PG8_SP2>(ring, g, S, E, GEMM_TID);
            if (PROBE_SEL & 32) { VM_WAIT(); __syncthreads(); LAUNDER(); pg8::gemm_phase<pg8::EpiInproj, pg8::StaticOrder, true, PG8_SP2>(ring, g, S, E, GEMM_TID); }
            if (BOTH(P + 1)) GRID_BAR();
        }
        if (IN(P + 2)) { LAUNDER();
#ifndef FAST_DSA
#define FAST_DSA 1
#endif
            if ((PROBE_SEL & 1024) && F.bid < 256) { for (int r = 0; r < 4; ++r) { const int i = r * 256 + F.bid; moba_own_unit<true>(F, l, (i & 15) >> 3, i & 7, i >> 4); } __syncthreads(); }
            if (FAST_MOBA == 2 && F.bid < 256) { for (int r = 0; r < 4; ++r) { const int i = r * 256 + F.bid; moba_own_unit<false>(F, l, (i & 15) >> 3, i & 7, i >> 4); } __syncthreads(); }
            for (int rep = 0; rep < ((PROBE_SEL & 64) ? 2 : 1); ++rep)
            for (int u = F.bid; u < 2 * RGC; u += F.G) rg_unit<false>(F, l, u / RGC, u % RGC);
            if (FAST_DSA) {
                for (;;) { int i; DYN_FETCH(i, 2 * l); if (i >= 2048) break; const int stt = 63 - (i >> 5), j = i & 31; idx_unit(F, j >> 4, stt * 256 + (j & 15) * 16); }
                __syncthreads();
            }
            if (BOTH(P + 2)) GRID_BAR();
        }
        if (IN(P + 3)) { LAUNDER();
            #ifndef MIX2_SEL
#define MIX2_SEL 7
#endif
            if (MIX2_SEL & 1) for (int u = F.bid; u < 2 * RGC; u += F.G) rg_unit<true>(F, l, u / RGC, u % RGC);
            if (FAST_MOBA == 2 && F.bid < 256) {
                if (PROBE_SEL & 2048) for (int r = 0; r < 4; ++r) { const int g = F.bid; const int i = r * 256 + ((r & 1) ? 255 - g : g); moba_item_unit<true>(F, l, (i & 15) >> 3, i & 7, i >> 4); }
                for (int r = 0; r < 4; ++r) { const int g = F.bid; const int i = r * 256 + ((r & 1) ? 255 - g : g); moba_item_unit<false>(F, l, (i & 15) >> 3, i & 7, i >> 4); }
                __syncthreads();
            }
            if (FAST_MOBA == 1 && (MIX2_SEL & 2)) {
                if (PROBE_SEL & 1) { for (int r = 0; r < 4; ++r) { const int g = F.bid % 256; const int i = r * 256 + ((r & 1) ? 255 - g : g); if (F.bid >= 256) break;
                    const int qt = 63 - (i >> 4), bh = i & 15; attn_unit<0, true>(F, bh >> 3, bh & 7, qt); } }
                for (int r = 0; r < 4; ++r) { const int g = F.bid % 256; const int i = r * 256 + ((r & 1) ? 255 - g : g); if (F.bid >= 256) break;
                    const int qt = 63 - (i >> 4), bh = i & 15; attn_unit<0>(F, bh >> 3, bh & 7, qt); }
                __syncthreads();
            }
            if (FAST_DSA && (MIX2_SEL & 4)) {
                if (PROBE_SEL & 2) { for (int r = 0; r < 4; ++r) { const int g = F.bid % 256; const int i = r * 256 + ((r & 1) ? 255 - g : g); if (F.bid >= 256) break;
                    const int qt = 63 - (i >> 4), bh = i & 15; dsa_attn2_unit<true>(F, bh >> 3, bh & 7, qt); } }
                for (;;) { int i; DYN_FETCH(i, 2 * l + 1); if (i >= 1024) break;
                    const int qt = 63 - (i >> 4), bh = i & 15; dsa_attn2_unit<false>(F, bh >> 3, bh & 7, qt); }
                __syncthreads();
            }
            if (!(FAST_MOBA && FAST_DSA)) for (int u = F.bid; u < T; u += F.G) { const int b = u & 1, t = u >> 1; if (FAST_MOBA == 0 && (MIX2_SEL & 2)) moba_unit(F, b, t); if (!FAST_DSA && (MIX2_SEL & 4)) dsa_unit(F, b, t); }
            for (int u = F.bid; u < T; u += F.G) { if (!(MIX2_SEL & 2)) WSB(WS_QA)[(size_t)u * 512 + F.tid] = 0; if (!(MIX2_SEL & 4)) WSB(WS_QB)[(size_t)u * 512 + F.tid] = 0; if (!(MIX2_SEL & 1)) WSB(WS_YC)[(size_t)u * 512 + F.tid] = 0; }
            if (BOTH(P + 3)) GRID_BAR();
        }

        if (IN(P + 4)) { LAUNDER();
            if (FAST_MOBA == 2) { const int gw = F.bid * NWAVES + F.wave, NGW = F.G * NWAVES; const float* xin = (l == 0) ? INP(I_X) : (const float*)F.out;
                for (int m = gw; m < T; m += NGW) moba_fin_row(F, l, m, F.lane);
                if (l != 0) {
                    GRID_BAR();
                    for (int m = gw; m < T; m += NGW) norm_row(xin + (size_t)m * DM, WSB(WS_XB) + (size_t)m * DM, SSQ_MIX(l) + m, F.lane); } }
            if (BOTH(P + 4)) GRID_BAR();
        }
        if (IN(P + 5)) { LAUNDER();
            pg8::Gemm g{WSB(WS_XB), WSB(WS_W_G), T, 3072, DM}; pg8::StaticOrder S; S.init(T, 3072, F.G, F.bid);
            pg8::EpiGates E{WSB(WS_G), SSQ_MIX(l)};
            pg8::gemm_phase<pg8::EpiGates, pg8::StaticOrder, true, PG8_SP2>(ring, g, S, E, GEMM_TID);
            if (PROBE_SEL & 32) { VM_WAIT(); __syncthreads(); LAUNDER(); pg8::gemm_phase<pg8::EpiGates, pg8::StaticOrder, true, PG8_SP2>(ring, g, S, E, GEMM_TID); }
            if (BOTH(P + 5)) GRID_BAR();
        }
        if (IN(P + 6)) { LAUNDER();
            pg8::StaticOrder S; S.init(T, DM, F.G, F.bid);
            { pg8::Gemm g{WSB(WS_QA), WSB(WS_W_PA), T, DM, DH}; pg8::EpiMerge<true> E{WSB(WS_G), WSB(WS_MERGED)}; pg8::gemm_phase<pg8::EpiMerge<true>, pg8::StaticOrder, true, PG8_SP2>(ring, g, S, E, GEMM_TID); }
#ifndef MERGE_CALLS
#define MERGE_CALLS 3
#endif
            VM_WAIT(); __syncthreads(); LAUNDER();
            if (MERGE_CALLS >= 2) { pg8::Gemm g{WSB(WS_QB), WSB(WS_W_PB), T, DM, DH}; pg8::EpiMerge<false> E{WSB(WS_G) + (size_t)T * 1024, WSB(WS_MERGED)}; pg8::gemm_phase<pg8::EpiMerge<false>, pg8::StaticOrder, true, PG8_SP2>(ring, g, S, E, GEMM_TID); }
            VM_WAIT(); __syncthreads(); LAUNDER();
            if (MERGE_CALLS >= 3) { pg8::Gemm g{WSB(WS_YC), WSB(WS_W_PC), T, DM, DH}; pg8::EpiMerge<false> E{WSB(WS_G) + (size_t)2 * T * 1024, WSB(WS_MERGED)}; pg8::gemm_phase<pg8::EpiMerge<false>, pg8::StaticOrder, true, PG8_SP2>(ring, g, S, E, GEMM_TID); }
            if (BOTH(P + 6)) GRID_BAR();
        }
        if (IN(P + 7)) { LAUNDER();
            pg8::Gemm g{WSB(WS_MERGED), WSB(WS_W_O), T, DM, DM}; pg8::StaticOrder S; S.init(T, DM, F.G, F.bid);
            pg8::EpiResid E{(l == 0) ? INP(I_X) : (const float*)F.out, F.out, WSB(WS_XB), SSQ_MLP(l)};
            pg8::gemm_phase<pg8::EpiResid, pg8::StaticOrder, true, PG8_SP2>(ring, g, S, E, GEMM_TID);
            if (BOTH(P + 7)) GRID_BAR();
        }
        if (IN(P + 8)) {   }
        if (IN(P + 9)) { LAUNDER();
            pg8::Gemm g{WSB(WS_XB), WSB(WS_W_UP), T, DFF, DM}; pg8::StaticOrder S; S.init(T, DFF, F.G, F.bid);
            pg8::EpiUp E{WSB(WS_H), SSQ_MLP(l)};
            pg8::gemm_phase<pg8::EpiUp, pg8::StaticOrder, true, PG8_SP2>(ring, g, S, E, GEMM_TID);
            if (PROBE_SEL & 32) { VM_WAIT(); __syncthreads(); LAUNDER(); pg8::gemm_phase<pg8::EpiUp, pg8::StaticOrder, true, PG8_SP2>(ring, g, S, E, GEMM_TID); }
            if (BOTH(P + 9)) GRID_BAR();
        }
        if (IN(P + 10)) { LAUNDER();
            pg8::Gemm g{WSB(WS_H), WSB(WS_W_DN), T, DM, DFF}; pg8::StaticOrder S; S.init(T, DM, F.G, F.bid);
            pg8::EpiResid E{(const float*)F.out, F.out, (l == 0) ? WSB(WS_XB) : (bf16*)nullptr, (float*)(F.ws + WS_CTL) + CW_SSQ + T};
            pg8::gemm_phase<pg8::EpiResid, pg8::StaticOrder, true, PG8_SP2>(ring, g, S, E, GEMM_TID);
            if (BOTH(P + 10)) GRID_BAR();
        }
    }
    if (IN(2 * PH_PER_LAYER)) { LAUNDER(); p_final(F); }
#undef IN
#undef BOTH
#undef GRID_BAR
}

extern "C" void kernel_launch(void* const* d_in, const int* in_sizes, int n_in, void* d_out, int out_size, void* d_ws, size_t ws_size, hipStream_t stream) {
    static int grid = 0;
    if (grid == 0) {
        if (n_in != 19 || in_sizes[0] != T * DM || out_size != T * DM || ws_size < WS_END) { fprintf(stderr, "kernel_launch: unexpected shapes (n_in %d, in0 %d, out %d, ws %zu)\n", n_in, n_in > 0 ? in_sizes[0] : -1, out_size, ws_size); grid = -1; return; }
        int dev = 0, cus = 0, per_cu = 0;
        if (hipGetDevice(&dev) != hipSuccess || hipDeviceGetAttribute(&cus, hipDeviceAttributeMultiprocessorCount, dev) != hipSuccess) { grid = -1; return; }
        if (hipFuncSetAttribute((const void*)fwd, hipFuncAttributeMaxDynamicSharedMemorySize, LDS_BYTES) != hipSuccess) { fprintf(stderr, "kernel_launch: hipFuncSetAttribute failed\n"); grid = -1; return; }
        if (hipOccupancyMaxActiveBlocksPerMultiprocessor(&per_cu, (const void*)fwd, NWAVES * 64, LDS_BYTES) != hipSuccess || per_cu < 1) { fprintf(stderr, "kernel_launch: occupancy query says %d\n", per_cu); }
        (void)hipGetLastError();
        grid = cus;
    }
    if (grid < 0) return;
    if (hipMemsetAsync((char*)d_ws + WS_CTL, 0, CTL_ZERO_BYTES, stream) != hipSuccess) return;
    Args a{};
    for (int i = 0; i < 19; ++i) a.in[i] = (const float*)d_in[i];
    a.out = (float*)d_out; a.ws = (unsigned char*)d_ws;
    if (ONE_LAUNCH) { a.ph_lo = 0; a.ph_hi = N_PHASES; hipLaunchKernelGGL(fwd, dim3(grid), dim3(NWAVES * 64), LDS_BYTES, stream, a); }
    else for (int p = 0; p < N_PHASES; ++p) { a.ph_lo = p; a.ph_hi = p + 1; hipLaunchKernelGGL(fwd, dim3(grid), dim3(NWAVES * 64), LDS_BYTES, stream, a); }
}
```

```cpp
#include <hip/hip_runtime.h>
#include <cstdio>
#include <cstdint>

#ifndef MK_ONE_LAUNCH
#define MK_ONE_LAUNCH 1
#endif

constexpr int BATCH = 2, SEQ = 16384, DM = 1024, T = BATCH * SEQ;
constexpr int DIN = 7752, DFF = 4096, DH = 512;
constexpr int NIN_T = 4864;
constexpr int NBLK = SEQ / 256;
constexpr float EPS = 1e-6f;

namespace pg8 {
#define PG8_LAS __attribute__((address_space(3)))
typedef unsigned short bf16_t;
typedef short bf16x8 __attribute__((ext_vector_type(8)));
typedef float f32x4 __attribute__((ext_vector_type(4)));
typedef unsigned u32x4 __attribute__((ext_vector_type(4)));
constexpr int BM = 256, BK = 64, HALF = 128, HTB = HALF * BK * 2  , STAGE_BYTES = 8 * HTB, NXCD = 8, WGM = 8;

__host__ __device__ __forceinline__ int lds_byte(int r, int c) { const int st = (r >> 4) * 2 + (c >> 5), rr = r & 15, cc = c & 31, ob = rr * 64 + cc * 2; return st * 1024 + (ob ^ (((ob >> 9) & 1) << 5)); }
__host__ __device__ __forceinline__ void stage_rc(int b, int& R, int& C) { const int st = b / 1024, sb = b % 1024, swz = sb ^ (((sb >> 9) & 1) << 5); R = (st >> 1) * 16 + swz / 64; C = (st & 1) * 32 + (swz % 64) / 2; }
__host__ __device__ __forceinline__ int perm32(int rho) { const int n = rho >> 4, i = rho & 15; return 8 * (i >> 2) + 4 * n + (i & 3); }

struct Unit { int pm, pn; };
struct Gemm { const bf16_t* A; const bf16_t* Bt; int M, N, K; };

struct StaticOrder {
    int nM, nN, nwg, G, c;
    __host__ __device__ void init(int M, int N, int G_, int c_) { nM = M / BM; nN = N / BM; nwg = nM * nN; G = G_; c = c_; }
    __host__ __device__ bool next(int i, Unit& u) const {
        const long L = (long)i * G + c; if (L >= nwg) return false;
        int wgid = (int)L; { const int q = nwg / NXCD, r = nwg % NXCD, xcd = wgid % NXCD, off = wgid / NXCD; wgid = (xcd < r ? xcd * (q + 1) : r * (q + 1) + (xcd - r) * q) + off; }
        const int nig = WGM * nN, gid = wgid / nig, fm = gid * WGM, gsz = (nM - fm) < WGM ? (nM - fm) : WGM;
        u.pm = fm + ((wgid % nig) % gsz); u.pn = (wgid % nig) / gsz; return true;
    }
    __device__ __forceinline__ void a_ready(const Unit&) const {}
    __device__ __forceinline__ void done(const Unit&) const {}
};

typedef float f32x2_t __attribute__((ext_vector_type(2))); typedef __bf16 bf16x2_t __attribute__((ext_vector_type(2)));
__device__ __forceinline__ unsigned cvt_pk_bf16(float lo, float hi) { f32x2_t v = {lo, hi}; bf16x2_t b = __builtin_convertvector(v, bf16x2_t); return __builtin_bit_cast(unsigned, b); }
__device__ __forceinline__ float bf_lo(unsigned w) { return __uint_as_float(w << 16); }
__device__ __forceinline__ float bf_hi(unsigned w) { return __uint_as_float(w & 0xffff0000u); }

struct EpiInproj {
    static constexpr bool PERM = true, AFTER_DRAIN = false;
    bf16_t* base; bf16_t* ki; float* wi; const float* rstd  ; float* km2;
    __device__ __forceinline__ void operator()(const f32x4 (&acc)[2][2][4][2], const Unit& u, int wr, int wc, int fr, int fq) const {
        const int row0 = u.pm * BM + wr * 64 + fr;
        if (u.pn < 18) {
            bf16_t* dst = base + (size_t)(u.pn >> 1) * ((size_t)T * 512) + (u.pn & 1) * 256 + wc * 32 + 8 * fq;
            const bool ksum = (u.pn >> 1) == 3;
            f32x4 cs[2][2] = {{{0.f, 0.f, 0.f, 0.f}, {0.f, 0.f, 0.f, 0.f}}, {{0.f, 0.f, 0.f, 0.f}, {0.f, 0.f, 0.f, 0.f}}};
#pragma unroll
            for (int ai = 0; ai < 2; ++ai)
#pragma unroll
                for (int m = 0; m < 4; ++m) { const int row = row0 + ai * HALF + m * 16; const float rs = __builtin_amdgcn_rsqf(rstd[row] * (1.0f / 1024.0f) + EPS); bf16_t* rowp = dst + (size_t)row * 512;
#pragma unroll
                    for (int bj = 0; bj < 2; ++bj) { const f32x4 v0 = acc[ai][bj][m][0] * rs, v1 = acc[ai][bj][m][1] * rs;
                        if (ksum) { cs[bj][0] += v0; cs[bj][1] += v1; }
                        u32x4 w; w.x = cvt_pk_bf16(v0[0], v0[1]); w.y = cvt_pk_bf16(v0[2], v0[3]); w.z = cvt_pk_bf16(v1[0], v1[1]); w.w = cvt_pk_bf16(v1[2], v1[3]);
                        *(u32x4*)(rowp + bj * HALF) = w; } }
            if (ksum) {
#pragma unroll
                for (int bj = 0; bj < 2; ++bj)
#pragma unroll
                    for (int n = 0; n < 2; ++n)
#pragma unroll
                        for (int j = 0; j < 4; ++j) { float v = cs[bj][n][j]; v += __shfl_xor(v, 1); v += __shfl_xor(v, 2); v += __shfl_xor(v, 4); v += __shfl_xor(v, 8); cs[bj][n][j] = v; }
                if (fr == 0) { float* kd = km2 + ((size_t)u.pm * 2 + wr) * 512 + (u.pn & 1) * 256 + wc * 32 + 8 * fq;
#pragma unroll
                    for (int bj = 0; bj < 2; ++bj) { *(f32x4*)(kd + bj * HALF) = cs[bj][0]; *(f32x4*)(kd + bj * HALF + 4) = cs[bj][1]; } }
            }
        } else {
#pragma unroll
            for (int ai = 0; ai < 2; ++ai)
#pragma unroll
                for (int m = 0; m < 4; ++m) { const int row = row0 + ai * HALF + m * 16; const float rs = __builtin_amdgcn_rsqf(rstd[row] * (1.0f / 1024.0f) + EPS);
                    const f32x4 v0 = acc[ai][0][m][0] * rs, v1 = acc[ai][0][m][1] * rs;
                    if (wc < 2) { u32x4 w; w.x = cvt_pk_bf16(v0[0], v0[1]); w.y = cvt_pk_bf16(v0[2], v0[3]); w.z = cvt_pk_bf16(v1[0], v1[1]); w.w = cvt_pk_bf16(v1[2], v1[3]);
                        *(u32x4*)(ki + (size_t)row * 64 + wc * 32 + 8 * fq) = w; }
                    else if (wc == 2 && fq == 0) { *(f32x4*)(wi + (size_t)row * 8) = v0; *(f32x4*)(wi + (size_t)row * 8 + 4) = v1; } }
        }
    }
};
struct EpiGates {
    static constexpr bool PERM = true, AFTER_DRAIN = false;
    bf16_t* O; const float* rstd;
    __device__ __forceinline__ void operator()(const f32x4 (&acc)[2][2][4][2], const Unit& u, int wr, int wc, int fr, int fq) const {
        const int row0 = u.pm * BM + wr * 64 + fr; const int tsel = u.pn >> 2;
        bf16_t* dst = O + (size_t)tsel * ((size_t)T * 1024) + (u.pn & 3) * 256 + wc * 32 + 8 * fq;
#pragma unroll
        for (int ai = 0; ai < 2; ++ai)
#pragma unroll
            for (int m = 0; m < 4; ++m) { const int row = row0 + ai * HALF + m * 16; const float rs = __builtin_amdgcn_rsqf(rstd[row] * (1.0f / 1024.0f) + EPS); bf16_t* rowp = dst + (size_t)row * 1024;
#pragma unroll
                for (int bj = 0; bj < 2; ++bj) { float v[8];
#pragma unroll
                    for (int j = 0; j < 4; ++j) { v[j] = acc[ai][bj][m][0][j] * rs; v[4 + j] = acc[ai][bj][m][1][j] * rs; }
#pragma unroll
                    for (int j = 0; j < 8; ++j) v[j] = __builtin_amdgcn_rcpf(1.0f + __builtin_amdgcn_exp2f(-1.4426950408889634f * v[j]));
                    u32x4 w; w.x = cvt_pk_bf16(v[0], v[1]); w.y = cvt_pk_bf16(v[2], v[3]); w.z = cvt_pk_bf16(v[4], v[5]); w.w = cvt_pk_bf16(v[6], v[7]);
                    *(u32x4*)(rowp + bj * HALF) = w; } }
    }
};
template <bool FIRST> struct EpiMerge {
    static constexpr bool PERM = true, AFTER_DRAIN = false;
    const bf16_t* G; bf16_t* Mg;
    __device__ __forceinline__ void operator()(const f32x4 (&acc)[2][2][4][2], const Unit& u, int wr, int wc, int fr, int fq) const {
        const int row0 = u.pm * BM + wr * 64 + fr; const int col0 = u.pn * BM + wc * 32 + 8 * fq;
#pragma unroll
        for (int ai = 0; ai < 2; ++ai)
#pragma unroll
            for (int m = 0; m < 4; ++m) { const size_t off = (size_t)(row0 + ai * HALF + m * 16) * 1024 + col0;
#pragma unroll
                for (int bj = 0; bj < 2; ++bj) { const u32x4 g = *(const u32x4*)(G + off + bj * HALF); const f32x4 a0 = acc[ai][bj][m][0], a1 = acc[ai][bj][m][1];
                    float v[8] = { bf_lo(g.x) * a0[0], bf_hi(g.x) * a0[1], bf_lo(g.y) * a0[2], bf_hi(g.y) * a0[3], bf_lo(g.z) * a1[0], bf_hi(g.z) * a1[1], bf_lo(g.w) * a1[2], bf_hi(g.w) * a1[3] };
                    if (!FIRST) { const u32x4 o = *(const u32x4*)(Mg + off + bj * HALF);
                        v[0] += bf_lo(o.x); v[1] += bf_hi(o.x); v[2] += bf_lo(o.y); v[3] += bf_hi(o.y); v[4] += bf_lo(o.z); v[5] += bf_hi(o.z); v[6] += bf_lo(o.w); v[7] += bf_hi(o.w); }
                    u32x4 w; w.x = cvt_pk_bf16(v[0], v[1]); w.y = cvt_pk_bf16(v[2], v[3]); w.z = cvt_pk_bf16(v[4], v[5]); w.w = cvt_pk_bf16(v[6], v[7]);
                    *(u32x4*)(Mg + off + bj * HALF) = w; }
                asm volatile("" ::: "memory"); }
    }
};
struct EpiResid {
    static constexpr bool PERM = false, AFTER_DRAIN = false;
    const float* src; float* out; bf16_t* xb; float* ssq;
    __device__ __forceinline__ void operator()(const f32x4 (&acc)[2][2][4][2], const Unit& u, int wr, int wc, int fr, int fq) const {
        const int row0 = u.pm * BM + wr * 64 + fr, col0 = u.pn * BM + wc * 32 + 4 * fq;
#pragma unroll
        for (int ai = 0; ai < 2; ++ai)
#pragma unroll
            for (int m = 0; m < 4; ++m) { const int row = row0 + ai * HALF + m * 16; const size_t off = (size_t)row * 1024 + col0; float sq = 0.f;
#pragma unroll
                for (int bj = 0; bj < 2; ++bj)
#pragma unroll
                    for (int n = 0; n < 2; ++n) { const f32x4 s = *(const f32x4*)(src + off + bj * HALF + n * 16); const f32x4 v = s + acc[ai][bj][m][n]; *(f32x4*)(out + off + bj * HALF + n * 16) = v;
                        if (xb) { typedef unsigned u32x2v __attribute__((ext_vector_type(2))); u32x2v w; w.x = cvt_pk_bf16(v[0], v[1]); w.y = cvt_pk_bf16(v[2], v[3]); *(u32x2v*)(xb + off + bj * HALF + n * 16) = w;
                            sq += (v[0] * v[0] + v[1] * v[1]) + (v[2] * v[2] + v[3] * v[3]); } }
                if (xb) { sq += __shfl_xor(sq, 16); sq += __shfl_xor(sq, 32); if (fq == 0) unsafeAtomicAdd(ssq + row, sq); } }
    }
};
struct EpiUp {
    static constexpr bool PERM = true, AFTER_DRAIN = false;
    bf16_t* O; const float* rstd;
    __device__ __forceinline__ void operator()(const f32x4 (&acc)[2][2][4][2], const Unit& u, int wr, int wc, int fr, int fq) const {
        const int row0 = u.pm * BM + wr * 64 + fr; const int col0 = u.pn * BM + wc * 32 + 8 * fq;
#pragma unroll
        for (int ai = 0; ai < 2; ++ai)
#pragma unroll
            for (int m = 0; m < 4; ++m) { const int row = row0 + ai * HALF + m * 16; const float rs = __builtin_amdgcn_rsqf(rstd[row] * (1.0f / 1024.0f) + EPS); bf16_t* rowp = O + (size_t)row * DFF + col0;
#pragma unroll
                for (int bj = 0; bj < 2; ++bj) { float v[8];
#pragma unroll
                    for (int j = 0; j < 4; ++j) { v[j] = fmaxf(acc[ai][bj][m][0][j] * rs, 0.f); v[4 + j] = fmaxf(acc[ai][bj][m][1][j] * rs, 0.f); }
#pragma unroll
                    for (int j = 0; j < 8; ++j) v[j] = v[j] * v[j];
                    u32x4 w; w.x = cvt_pk_bf16(v[0], v[1]); w.y = cvt_pk_bf16(v[2], v[3]); w.z = cvt_pk_bf16(v[4], v[5]); w.w = cvt_pk_bf16(v[6], v[7]);
                    *(u32x4*)(rowp + bj * HALF) = w; } }
    }
};

template <class Epi, class Sched, bool ALIGN_EPI = false, bool SP2 = false>
__device__ __forceinline__ void gemm_phase(PG8_LAS unsigned char* lds, const Gemm g, const Sched& S, const Epi& E, int tid_in) {
    int tid_ = tid_in; asm volatile("" : "+v"(tid_));
    const int tid = tid_, wid = __builtin_amdgcn_readfirstlane(tid >> 6), lane = tid & 63, wr = wid >> 2, wc = wid & 3, fr = lane & 15, fq = lane >> 4;
    const int K = g.K, nt = K / BK;
    unsigned voffA[2], voffB[2];
#pragma unroll
    for (int i = 0; i < 2; ++i) { int R, C; stage_rc(tid * 16 + i * 8192, R, C); const int Rb = Epi::PERM ? ((R & ~31) + perm32(R & 31)) : R;
        voffA[i] = (unsigned)(R * K + C) * 2u; voffB[i] = (unsigned)(Rb * K + C) * 2u; }
    const size_t kstep = (size_t)(BK * 2);
    const size_t hstep = (size_t)HALF * K * 2;
    const size_t tstep = 2 * hstep;
    const unsigned ldsw = (unsigned)wid * 1024u;
    const int aoff = lds_byte(wr * 64 + fr, fq * 8), boff = lds_byte(wc * 32 + fr, fq * 8);
#define PG8_SA(b, h) (((b) * 2 + (h)) * HTB)
#define PG8_SB(b, h) ((4 + (b) * 2 + (h)) * HTB)
#define PG8_STAGE(bufoff, gbase, voff) do { _Pragma("unroll") for (int _i = 0; _i < 2; ++_i) \
        __builtin_amdgcn_global_load_lds((const unsigned*)((const char*)(gbase) + (voff)[_i]), (PG8_LAS unsigned*)(lds + (bufoff) + ldsw + _i * 8192), 16, 0, 0); } while (0)
#define PG8_LDA(dst, b, h) do { _Pragma("unroll") for (int m = 0; m < 4; ++m) _Pragma("unroll") for (int k = 0; k < 2; ++k) dst[m][k] = *(const PG8_LAS bf16x8*)(lds + PG8_SA(b, h) + aoff + m * 2048 + k * 1024); } while (0)
#define PG8_LDB(dst, b, h) do { _Pragma("unroll") for (int n = 0; n < 2; ++n) _Pragma("unroll") for (int k = 0; k < 2; ++k) dst[n][k] = *(const PG8_LAS bf16x8*)(lds + PG8_SB(b, h) + boff + n * 2048 + k * 1024); } while (0)
#define PG8_MMA(ai, bj, At, Bt) do { __builtin_amdgcn_s_setprio(1); _Pragma("unroll") for (int m = 0; m < 4; ++m) _Pragma("unroll") for (int n = 0; n < 2; ++n) _Pragma("unroll") for (int k = 0; k < 2; ++k) \
        acc[ai][bj][m][n] = __builtin_amdgcn_mfma_f32_16x16x32_bf16(Bt[n][k], At[m][k], acc[ai][bj][m][n], 0, 0, 0); __builtin_amdgcn_s_setprio(0); } while (0)
#define PG8_WAIT_V(n) asm volatile("s_waitcnt vmcnt(" #n ")" ::: "memory")
#define PG8_WAIT_L(n) asm volatile("s_waitcnt lgkmcnt(" #n ")" ::: "memory")
#define PG8_BAR __builtin_amdgcn_s_barrier()
#define PG8_SCHED __builtin_amdgcn_sched_barrier(0)
    Unit cur, nxt; int ui = 0;
    if (!S.next(0, cur)) return;
    f32x4 acc[2][2][4][2];
#pragma unroll
    for (int a = 0; a < 2; ++a)
#pragma unroll
        for (int b = 0; b < 2; ++b)
#pragma unroll
            for (int m = 0; m < 4; ++m)
#pragma unroll
                for (int n = 0; n < 2; ++n) acc[a][b][m][n] = (f32x4){0.f, 0.f, 0.f, 0.f};
    bf16x8 At[4][2], B0[2][2], B1[2][2];
    const char* cA = (const char*)g.A + (size_t)cur.pm * tstep; const char* cB = (const char*)g.Bt + (size_t)cur.pn * tstep;
    S.a_ready(cur);
    if constexpr (SP2) {
        PG8_STAGE(PG8_SB(0, 0), cB, voffB); PG8_STAGE(PG8_SB(0, 1), cB + hstep, voffB); PG8_STAGE(PG8_SA(0, 0), cA, voffA); PG8_STAGE(PG8_SA(0, 1), cA + hstep, voffA);
        if (wr == 1) PG8_BAR;
        PG8_WAIT_V(2); PG8_BAR;
        PG8_STAGE(PG8_SB(1, 0), cB + kstep, voffB); PG8_STAGE(PG8_SA(1, 0), cA + kstep, voffA); PG8_STAGE(PG8_SB(1, 1), cB + hstep + kstep, voffB);
        PG8_WAIT_V(6); PG8_BAR;
    } else {
        PG8_STAGE(PG8_SB(0, 0), cB, voffB); PG8_STAGE(PG8_SA(0, 0), cA, voffA); PG8_STAGE(PG8_SB(0, 1), cB + hstep, voffB); PG8_STAGE(PG8_SA(0, 1), cA + hstep, voffA);
        if (wr == 1) PG8_BAR;
        PG8_WAIT_V(4); PG8_BAR;
        PG8_STAGE(PG8_SB(1, 0), cB + kstep, voffB); PG8_STAGE(PG8_SA(1, 0), cA + kstep, voffA); PG8_STAGE(PG8_SB(1, 1), cB + hstep + kstep, voffB);
        PG8_WAIT_V(6); PG8_BAR;
    }
    for (;;) {
        const bool has_next = S.next(ui + 1, nxt);
        const char* nA = has_next ? (const char*)g.A + (size_t)nxt.pm * tstep : cA; const char* nB = has_next ? (const char*)g.Bt + (size_t)nxt.pn * tstep : cB;
        for (int t = 0; t < nt; t += 2) {
            const bool last = (t == nt - 2);
            const char* a1 = cA + (size_t)(t + 1) * kstep;
            const char* a2 = last ? nA : cA + (size_t)(t + 2) * kstep; const char* b2 = last ? nB : cB + (size_t)(t + 2) * kstep;
            const char* a3 = a2 + kstep; const char* b3 = b2 + kstep;
            if (last && has_next) S.a_ready(nxt);
            if constexpr (SP2) {
            PG8_LDB(B0, 0, 0); PG8_LDB(B1, 0, 1); PG8_SCHED; PG8_LDA(At, 0, 0); PG8_STAGE(PG8_SA(1, 1), a1 + hstep, voffA);
            PG8_WAIT_V(8); PG8_WAIT_L(0); PG8_BAR; PG8_MMA(0, 0, At, B0); PG8_MMA(0, 1, At, B1); PG8_BAR; PG8_SCHED;
            PG8_LDA(At, 0, 1); PG8_STAGE(PG8_SB(0, 0), b2, voffB); PG8_STAGE(PG8_SB(0, 1), b2 + hstep, voffB); PG8_STAGE(PG8_SA(0, 0), a2, voffA);
            PG8_WAIT_V(8); PG8_WAIT_L(0); PG8_BAR; PG8_MMA(1, 0, At, B0); PG8_MMA(1, 1, At, B1); PG8_BAR; PG8_SCHED;
            PG8_LDB(B0, 1, 0); PG8_LDB(B1, 1, 1); PG8_SCHED; PG8_LDA(At, 1, 0); PG8_STAGE(PG8_SA(0, 1), a2 + hstep, voffA);
            PG8_WAIT_V(8); PG8_WAIT_L(0); PG8_BAR; PG8_MMA(0, 0, At, B0); PG8_MMA(0, 1, At, B1); PG8_BAR; PG8_SCHED;
            PG8_LDA(At, 1, 1); PG8_STAGE(PG8_SB(1, 0), b3, voffB); PG8_STAGE(PG8_SB(1, 1), b3 + hstep, voffB); PG8_STAGE(PG8_SA(1, 0), a3, voffA);
            PG8_WAIT_V(8); PG8_WAIT_L(0); PG8_BAR; PG8_MMA(1, 0, At, B0); PG8_MMA(1, 1, At, B1); PG8_BAR; PG8_SCHED;
            } else {
            PG8_LDB(B0, 0, 0); PG8_SCHED; PG8_LDA(At, 0, 0); PG8_STAGE(PG8_SA(1, 1), a1 + hstep, voffA);
            PG8_WAIT_L(8); PG8_BAR; PG8_WAIT_L(0); PG8_MMA(0, 0, At, B0); PG8_BAR; PG8_SCHED;
            PG8_LDB(B1, 0, 1); PG8_STAGE(PG8_SB(0, 0), b2, voffB);
            PG8_BAR; PG8_WAIT_L(0); PG8_MMA(0, 1, At, B1); PG8_BAR;
            PG8_LDA(At, 0, 1); PG8_STAGE(PG8_SA(0, 0), a2, voffA);
            PG8_BAR; PG8_WAIT_L(0); PG8_MMA(1, 0, At, B0); PG8_BAR; PG8_SCHED;
            PG8_STAGE(PG8_SB(0, 1), b2 + hstep, voffB);
            PG8_WAIT_V(6); PG8_BAR; PG8_MMA(1, 1, At, B1); PG8_BAR;
            PG8_LDB(B0, 1, 0); PG8_SCHED; PG8_LDA(At, 1, 0); PG8_STAGE(PG8_SA(0, 1), a2 + hstep, voffA);
            PG8_WAIT_L(8); PG8_BAR; PG8_WAIT_L(0); PG8_MMA(0, 0, At, B0); PG8_BAR; PG8_SCHED;
            PG8_LDB(B1, 1, 1); PG8_STAGE(PG8_SB(1, 0), b3, voffB);
            PG8_BAR; PG8_WAIT_L(0); PG8_MMA(0, 1, At, B1); PG8_BAR;
            PG8_LDA(At, 1, 1); PG8_STAGE(PG8_SA(1, 0), a3, voffA);
            PG8_BAR; PG8_WAIT_L(0); PG8_MMA(1, 0, At, B0); PG8_BAR; PG8_SCHED;
            PG8_STAGE(PG8_SB(1, 1), b3 + hstep, voffB);
            PG8_WAIT_V(6); PG8_BAR; PG8_MMA(1, 1, At, B1); PG8_BAR;
            }
        }
        if constexpr (ALIGN_EPI) { if (wr == 0) PG8_BAR; }
        if constexpr (!Epi::AFTER_DRAIN) { E(acc, cur, wr, wc, fr, fq); S.done(cur); }
        if (!has_next) break;
#pragma unroll
        for (int a = 0; a < 2; ++a)
#pragma unroll
            for (int b = 0; b < 2; ++b)
#pragma unroll
                for (int m = 0; m < 4; ++m)
#pragma unroll
                    for (int n = 0; n < 2; ++n) acc[a][b][m][n] = (f32x4){0.f, 0.f, 0.f, 0.f};
        cur = nxt; cA = nA; cB = nB; ++ui;
        if constexpr (ALIGN_EPI) { if (wr == 1) PG8_BAR; }
    }
    PG8_WAIT_V(0);
    if constexpr (!ALIGN_EPI) { if (wr == 0) PG8_BAR; }
    PG8_BAR;
    if constexpr (Epi::AFTER_DRAIN) { E.fused(acc, cur, wr, wc, fr, fq, lds, wid, lane); S.done(cur); }
#undef PG8_SA
#undef PG8_SB
#undef PG8_STAGE
#undef PG8_LDA
#undef PG8_LDB
#undef PG8_MMA
#undef PG8_WAIT_V
#undef PG8_WAIT_L
#undef PG8_BAR
#undef PG8_SCHED
}
}

#ifndef FAST_MOBA
#define FAST_MOBA 2
#endif
#ifndef PG8_SP2
#define PG8_SP2 true
#endif
#ifndef PROBE_SEL
#define PROBE_SEL 0
#endif
constexpr int NWAVES = 8;
constexpr int PH_PER_LAYER = 11;
constexpr int N_PHASES = 2 * PH_PER_LAYER + 1;
constexpr bool ONE_LAUNCH = (MK_ONE_LAUNCH != 0);
static_assert(ONE_LAUNCH, "build with MK_ONE_LAUNCH=1 (build.sh 1): the FIN phase needs its in-phase grid barrier");

constexpr size_t MiB = 1u << 20;
constexpr size_t WS_CTL = 0, CTL_ZERO_BYTES = 1 * MiB;
constexpr size_t WS_W_IN = 1 * MiB;
constexpr size_t WS_W_G = 11 * MiB;
constexpr size_t WS_W_PA = 17 * MiB, WS_W_PB = 18 * MiB, WS_W_PC = 19 * MiB;
constexpr size_t WS_W_O = 20 * MiB;
constexpr size_t WS_W_UP = 22 * MiB;
constexpr size_t WS_W_DN = 30 * MiB;
constexpr size_t WS_XB = 40 * MiB;
constexpr size_t WS_RSTD = 104 * MiB;
constexpr int CW_SSQ = 32768;
static_assert((CW_SSQ + 3 * T) * 4 <= (int)CTL_ZERO_BYTES, "ssq arrays inside the memset region");
constexpr size_t WS_KMEAN = 104 * MiB + 256 * 1024;
constexpr size_t WS_RGA = 104 * MiB + 256 * 1024;
constexpr size_t WS_RGH = 10 * MiB + 512 * 1024;
constexpr int RGC = 128;
constexpr size_t WS_WI = 105 * MiB;
constexpr size_t WS_KI = 106 * MiB;
constexpr size_t WS_ACT = 112 * MiB;
constexpr size_t ACT_STRIDE = (size_t)T * 512 * 2;
constexpr size_t WS_QA = WS_ACT, WS_QB = WS_ACT + ACT_STRIDE, WS_YC = WS_ACT + 2 * ACT_STRIDE, WS_KA = WS_ACT + 3 * ACT_STRIDE, WS_VA = WS_ACT + 4 * ACT_STRIDE,
                 WS_KB = WS_ACT + 5 * ACT_STRIDE, WS_VB = WS_ACT + 6 * ACT_STRIDE, WS_QI = WS_ACT + 7 * ACT_STRIDE, WS_XC = WS_ACT + 8 * ACT_STRIDE;
constexpr size_t WS_G = WS_KA;
constexpr size_t WS_MASK = 400 * MiB;
constexpr size_t WS_MERGED = 400 * MiB;
constexpr size_t WS_H = WS_ACT;
constexpr size_t WS_END = 512 * MiB;
static_assert(WS_XC + ACT_STRIDE == 400 * MiB && WS_G + (size_t)3 * T * 1024 * 2 == 400 * MiB && WS_H + (size_t)T * DFF * 2 <= 400 * MiB, "d_ws map");
constexpr int CW_DYN = 12288;
constexpr int CW_BAR = 4096;

constexpr int RING_OFF = 0, RING_BYTES = 131072;
constexpr int LDSCTL_OFF = RING_BYTES, MISC_OFF = LDSCTL_OFF + 320;
constexpr int LDS_BYTES = 147456;
constexpr int GL_SKEY = 0, GL_QIF = 65536, GL_WQ = GL_QIF + 2048, GL_HIST = GL_WQ + 64, GL_SEL = GL_HIST + 1024, GL_MISC = GL_SEL + 1024, GL_QS = 70656, GL_PS = 73728;
static_assert(GL_MISC + 64 <= GL_QS && GL_QS + 8 * 256 <= GL_PS && GL_PS + 8 * 4096 <= RING_BYTES, "golden LDS map");

#define GAS __attribute__((address_space(1)))
#define LAS __attribute__((address_space(3)))
typedef unsigned short bf16;
typedef unsigned v4u __attribute__((ext_vector_type(4)));
typedef float f32x4 __attribute__((ext_vector_type(4)));
typedef GAS unsigned gu32;
#define RLX_AGENT __ATOMIC_RELAXED, __HIP_MEMORY_SCOPE_AGENT
#define LDS_WAIT() asm volatile("s_waitcnt lgkmcnt(0)" ::: "memory")
#define VM_WAIT() asm volatile("s_waitcnt vmcnt(0)" ::: "memory")
__device__ __forceinline__ float bf2f(bf16 v) { return __uint_as_float(((unsigned)v) << 16); }
__device__ __forceinline__ unsigned pk2(float lo, float hi) { return pg8::cvt_pk_bf16(lo, hi); }
__device__ __forceinline__ unsigned f2bf(float f) { return pg8::cvt_pk_bf16(f, 0.f) & 0xffffu; }
__device__ __forceinline__ float wave_sum(float v) {
#pragma unroll
    for (int o = 1; o < 64; o <<= 1) v += __shfl_xor(v, o);
    return v;
}
__device__ __forceinline__ float wave_max(float v) {
#pragma unroll
    for (int o = 1; o < 64; o <<= 1) v = fmaxf(v, __shfl_xor(v, o));
    return v;
}
__device__ __forceinline__ int t5_bucket(int n) {
    if (n < 16) return n;
    if (n >= 113) return 31;
    return 16 + (n >= 19) + (n >= 21) + (n >= 24) + (n >= 27) + (n >= 31) + (n >= 35) + (n >= 40) + (n >= 46) + (n >= 52) + (n >= 59) + (n >= 67) + (n >= 77) + (n >= 87) + (n >= 99);
}

#define XB_TMO      128
#define XB_XCNT(j)  (256  + 64 * (j))
#define XB_XSUB(j)  (1280 + 64 * (j))
#define XB_XGEN(j)  (2304 + 64 * (j))
#define XB_TOP      3328
#define XB_TOPGEN   3392
#define XCD_BAR_WORDS 3456
#define XB_SPIN_CAP (1u << 22)

__device__ __forceinline__ unsigned xb_ld(unsigned* p)              { return __hip_atomic_load(p, __ATOMIC_RELAXED, __HIP_MEMORY_SCOPE_AGENT); }
__device__ __forceinline__ unsigned xb_add(unsigned* p, unsigned v) { return __hip_atomic_fetch_add(p, v, __ATOMIC_RELAXED, __HIP_MEMORY_SCOPE_AGENT); }
__device__ __forceinline__ unsigned xb_xcc_id() { return (unsigned)__builtin_amdgcn_s_getreg((3 << 11) | 20) & 0xFu; }
#define XB_SPIN(cond, bar) do { unsigned _sp = 0; while (cond) { __builtin_amdgcn_s_sleep(1); \
    if ((++_sp & 255u) == 0u) { if (xb_ld(&(bar)[XB_TMO])) break; if (_sp > XB_SPIN_CAP) { atomicAdd(&(bar)[XB_TMO], 1u); break; } } } } while (0)

struct XcdBarrier { unsigned* bar; unsigned x; volatile LAS unsigned* st; };

__device__ __forceinline__ XcdBarrier xcd_barrier_post(unsigned* bar, volatile LAS unsigned* st) {
    XcdBarrier b; b.bar = bar; b.x = xb_xcc_id(); b.st = st;
    if (threadIdx.x == 0) (void)xb_add(&bar[XB_XCNT(b.x)], 1u);
    return b;
}
__device__ __forceinline__ void xcd_barrier_complete(unsigned* bar, unsigned x, unsigned& nloc, unsigned& nx) {
    const unsigned G = gridDim.x * gridDim.y * gridDim.z;
    unsigned sum, cnt, mine, sp = 0u;
    for (;;) {
        sum = 0u; cnt = 0u; mine = 0u;
#pragma unroll
        for (unsigned j = 0; j < 16; ++j) { const unsigned c = xb_ld(&bar[XB_XCNT(j)]); sum += c; cnt += (c > 0u) ? 1u : 0u; }
        mine = xb_ld(&bar[XB_XCNT(x)]);
        if (sum == G) break;
        __builtin_amdgcn_s_sleep(1);
        if ((++sp & 255u) == 0u) { if (xb_ld(&bar[XB_TMO])) break; if (sp > XB_SPIN_CAP) { atomicAdd(&bar[XB_TMO], 1u); break; } }
    }
    nloc = mine > 0u ? mine : 1u; nx = cnt > 0u ? cnt : 1u;
}
__device__ __forceinline__ void xcd_barrier(const XcdBarrier& b) {
    asm volatile("s_waitcnt vmcnt(0)" ::: "memory");
    __syncthreads();
    if (threadIdx.x == 0) {
        unsigned* bar = b.bar;
        __builtin_amdgcn_s_waitcnt(0);
        unsigned nloc = b.st[0], nx = b.st[1];
        if (nloc == 0u) { xcd_barrier_complete(bar, b.x, nloc, nx); b.st[0] = nloc; b.st[1] = nx; }
        const unsigned old = xb_add(&bar[XB_XSUB(b.x)], 1u);
        const unsigned gen = old / nloc;
        if (old + 1u == (gen + 1u) * nloc) {
            __builtin_amdgcn_fence(__ATOMIC_RELEASE, "agent");
            asm volatile("s_waitcnt vmcnt(0)" ::: "memory");
            const unsigned og = xb_add(&bar[XB_TOP], 1u);
            const unsigned tg = og / nx;
            if (og + 1u == (tg + 1u) * nx) xb_add(&bar[XB_TOPGEN], 1u);
            else XB_SPIN(xb_ld(&bar[XB_TOPGEN]) == tg, bar);
            __builtin_amdgcn_fence(__ATOMIC_ACQUIRE, "agent");
            xb_add(&bar[XB_XGEN(b.x)], 1u);
            asm volatile("s_waitcnt vmcnt(0)" ::: "memory");
        } else {
            XB_SPIN(xb_ld(&bar[XB_XGEN(b.x)]) == gen, bar);
            __builtin_amdgcn_fence(__ATOMIC_ACQUIRE, "agent");
            asm volatile("s_waitcnt vmcnt(0)" ::: "memory");
        }
    }
    __syncthreads();
}

struct Args { const float* in[19]; float* out; unsigned char* ws; int ph_lo, ph_hi; };
struct Frame {
    LAS unsigned char* lds;
    int tid, lane, wave, G, bid;
    int gw;
    const __attribute__((address_space(4))) Args* a;
    unsigned char* ws; float* out;
};
#define WSB(off) ((bf16*)(F.ws + (off)))
#define WSF(off) ((float*)(F.ws + (off)))
#define INP(i) (F.a->in[i])
#define SSQ_MIX(l) ((l) == 0 ? WSF(WS_RSTD) : (float*)(F.ws + WS_CTL) + CW_SSQ + T)
#define SSQ_MLP(l) ((float*)(F.ws + WS_CTL) + CW_SSQ + ((l) == 0 ? 0 : 2 * T))
enum { I_X = 0, I_RELB, I_NMG, I_WIN, I_CONVW, I_CONVB, I_WR, I_BR, I_WI, I_BI, I_LAM, I_WPA, I_WPB, I_WPC, I_WO, I_NLG, I_WUP, I_WDN, I_FNG };

template <class P> __device__ __forceinline__ P* launder_u(P* p) { unsigned lo = (unsigned)(uintptr_t)p, hi = (unsigned)((uintptr_t)p >> 32); asm volatile("" : "+v"(lo), "+v"(hi));
    lo = __builtin_amdgcn_readfirstlane(lo); hi = __builtin_amdgcn_readfirstlane(hi); return (P*)(((uintptr_t)hi << 32) | (uintptr_t)lo); }
__device__ __forceinline__ int launder_i(int v) { asm volatile("" : "+v"(v)); return __builtin_amdgcn_readfirstlane(v); }

__device__ __forceinline__ void transpose_item(const float* W, int ld, int K, int ncol_valid, const float* gain, bf16* WT, LAS float* scr, int item, int nblk, int lane) {
    const int kb = item / nblk, nb = item % nblk, k0 = 64 * kb, n0 = 32 * nb;
    const float gv = gain ? gain[k0 + lane] : 1.0f;
#pragma unroll 8
    for (int i = 0; i < 32; ++i) { const int kk = 2 * i + (lane >> 5); const int n = n0 + (lane & 31);
        float v = (n < ncol_valid) ? W[(size_t)(k0 + kk) * ld + n] : 0.f; v *= __shfl(gv, kk); scr[kk * 33 + (lane & 31)] = v; }
    LDS_WAIT(); asm volatile("" ::: "memory");
    const int c = lane & 7;
#pragma unroll
    for (int j = 0; j < 4; ++j) { const int n = (lane >> 3) + 8 * j; const LAS float* s = scr + (8 * c) * 33 + n;
        v4u o; o.x = pk2(s[0 * 33], s[1 * 33]); o.y = pk2(s[2 * 33], s[3 * 33]); o.z = pk2(s[4 * 33], s[5 * 33]); o.w = pk2(s[6 * 33], s[7 * 33]);
        *(GAS v4u*)(WT + (size_t)(n0 + n) * K + k0 + 8 * c) = o; }
    LDS_WAIT(); asm volatile("" ::: "memory");
}
__device__ __forceinline__ void norm_row(const float* xrow, bf16* orow, float* rstd_out, int lane) {
    const GAS f32x4* xr = (const GAS f32x4*)xrow + lane;
    f32x4 v[4]; float s = 0.f;
#pragma unroll
    for (int j = 0; j < 4; ++j) { v[j] = xr[64 * j]; s += (v[j].x * v[j].x + v[j].y * v[j].y) + (v[j].z * v[j].z + v[j].w * v[j].w); }
    const float ss = wave_sum(s);
    GAS unsigned long long* o8 = (GAS unsigned long long*)orow + lane;
#pragma unroll
    for (int j = 0; j < 4; ++j) o8[64 * j] = (unsigned long long)pk2(v[j].x, v[j].y) | ((unsigned long long)pk2(v[j].z, v[j].w) << 32);
    if (lane == 0) *rstd_out = ss;
}
__device__ __forceinline__ void p_prologue(Frame& F, int l) {
    LAS float* scr = (LAS float*)(F.lds + RING_OFF + F.wave * 16384);
    const int gw = F.bid * NWAVES + F.wave, NGW = F.G * NWAVES;
    const float* w_in = INP(I_WIN) + (size_t)l * DM * DIN; const float* g1 = INP(I_NMG) + l * DM; const float* g2 = INP(I_NLG) + l * DM;
    constexpr int I_BLK = 16 * 16;
    constexpr int I_SP = 16 * 3;
    constexpr int I_G = 16 * 96;
    constexpr int I_P = 8 * 32;
    constexpr int I_O = 16 * 32;
    constexpr int I_UP = 16 * 128;
    constexpr int I_DN = 64 * 32;
    constexpr int NITEMS = 9 * I_BLK + I_SP + I_G + 3 * I_P + I_O + I_UP + I_DN;
    for (int it = gw; it < NITEMS; it += NGW) {
        int r = it;
        if (r < 9 * I_BLK) { const int blk = r / I_BLK; r -= blk * I_BLK;
            const int c0 = blk == 0 ? 0 : blk == 1 ? 1536 : blk == 2 ? 4168 : blk == 3 ? 512 : blk == 4 ? 1024 : blk == 5 ? 2048 : blk == 6 ? 2560 : blk == 7 ? 3072 : 3656;
            transpose_item(w_in + c0, DIN, DM, 512, g1, WSB(WS_W_IN) + (size_t)blk * 512 * DM, scr, r, 16, F.lane); continue; }
        r -= 9 * I_BLK;
        if (r < I_SP) { transpose_item(w_in + 3584, DIN, DM, 72, g1, WSB(WS_W_IN) + (size_t)4608 * DM, scr, r, 3, F.lane); continue; } r -= I_SP;
        if (r < I_G) { transpose_item(w_in + 4680, DIN, DM, 3072, g1, WSB(WS_W_G), scr, r, 96, F.lane); continue; } r -= I_G;
        if (r < I_P) { transpose_item(INP(I_WPA) + (size_t)l * DH * DM, DM, DH, 1024, nullptr, WSB(WS_W_PA), scr, r, 32, F.lane); continue; } r -= I_P;
        if (r < I_P) { transpose_item(INP(I_WPB) + (size_t)l * DH * DM, DM, DH, 1024, nullptr, WSB(WS_W_PB), scr, r, 32, F.lane); continue; } r -= I_P;
        if (r < I_P) { transpose_item(INP(I_WPC) + (size_t)l * DH * DM, DM, DH, 1024, nullptr, WSB(WS_W_PC), scr, r, 32, F.lane); continue; } r -= I_P;
        if (r < I_O) { transpose_item(INP(I_WO) + (size_t)l * DM * DM, DM, DM, 1024, nullptr, WSB(WS_W_O), scr, r, 32, F.lane); continue; } r -= I_O;
        if (r < I_UP) { transpose_item(INP(I_WUP) + (size_t)l * DM * DFF, DFF, DM, DFF, g2, WSB(WS_W_UP), scr, r, 128, F.lane); continue; } r -= I_UP;
        transpose_item(INP(I_WDN) + (size_t)l * DFF * DM, DM, DFF, 1024, nullptr, WSB(WS_W_DN), scr, r, 32, F.lane);
    }
    { GAS v4u* z = (GAS v4u*)(WSB(WS_W_IN) + (size_t)(4608 + 96) * DM); const int gt = F.bid * (NWAVES * 64) + F.tid;
      unsigned zz = 0u; asm volatile("" : "+v"(zz));
      for (int i = gt; i < 160 * DM / 8; i += F.G * NWAVES * 64) z[i] = (v4u){zz, zz, zz, zz}; }
    if (l == 0) for (int m = gw; m < T; m += NGW) norm_row(INP(I_X) + (size_t)m * DM, WSB(WS_XB) + (size_t)m * DM, WSF(WS_RSTD) + m, F.lane);
}
__device__ __forceinline__ void p_norm2(Frame& F) {
    const int gw = F.bid * NWAVES + F.wave, NGW = F.G * NWAVES;
    for (int m = gw; m < T; m += NGW) norm_row(F.out + (size_t)m * DM, WSB(WS_XB) + (size_t)m * DM, WSF(WS_RSTD) + m, F.lane);
}
__device__ __forceinline__ void p_final(Frame& F) {
    const int gw = F.bid * NWAVES + F.wave, NGW = F.G * NWAVES;
    for (int m = gw; m < T; m += NGW) {
        GAS f32x4* xr = (GAS f32x4*)(F.out + (size_t)m * DM) + F.lane; const GAS f32x4* gr = (const GAS f32x4*)INP(I_FNG) + F.lane;
        f32x4 v[4]; float s = 0.f;
#pragma unroll
        for (int j = 0; j < 4; ++j) { v[j] = xr[64 * j]; s += (v[j].x * v[j].x + v[j].y * v[j].y) + (v[j].z * v[j].z + v[j].w * v[j].w); }
        const float rstd = 1.0f / sqrtf(wave_sum(s) * (1.0f / DM) + EPS);
#pragma unroll
        for (int j = 0; j < 4; ++j) xr[64 * j] = v[j] * rstd * gr[64 * j];
    }
}

__device__ __forceinline__ void kmean_unit(Frame& F, int b, int n) {
    const bf16* kp = WSB(WS_KA) + ((size_t)b * SEQ + (size_t)n * 256) * 512 + F.tid; float s = 0.f;
#pragma unroll 8
    for (int j = 0; j < 256; ++j) s += bf2f(kp[(size_t)j * 512]);
    WSF(WS_KMEAN)[((size_t)b * NBLK + n) * 512 + F.tid] = s * (1.0f / 256.0f);
}
__device__ __forceinline__ float sigmoidf_(float v) { return 1.0f / (1.0f + __expf(-v)); }
typedef short bf16x8_t __attribute__((ext_vector_type(8)));
constexpr int RG_XB_STRIDE = 72;
constexpr int RG_XRAW = 0, RG_YRAW = 2048, RG_XB = 4096, RG_PR = RG_XB + 16 * RG_XB_STRIDE * 2, RG_PI = RG_PR + 16 * 64 * 4, RG_WAVE_LDS = RG_PI + 16 * 64 * 4;
static_assert(8 * RG_WAVE_LDS <= RING_BYTES, "rg LDS");
template <bool P2> __device__ __forceinline__ void rg_unit(Frame& F, int l, int b, int c) {
    int d_ = F.lane; asm volatile("" : "+v"(d_));
    const int n = F.wave, d = d_, ch = n * 64 + d;
    LAS unsigned char* wl = F.lds + RING_OFF + n * RG_WAVE_LDS;
    LAS bf16* xraw = (LAS bf16*)(wl + RG_XRAW); LAS bf16* yraw = (LAS bf16*)(wl + RG_YRAW); LAS bf16* xb = (LAS bf16*)(wl + RG_XB); LAS float* prl = (LAS float*)(wl + RG_PR); LAS float* pil = (LAS float*)(wl + RG_PI);
    const int col = d & 15, kq = d >> 4;
    bf16x8_t wfr[2][4], wfi[2][4];
    { const GAS float* prs = (const GAS float*)INP(I_WR) + (((size_t)l * 8 + n) * 64) * 64 + (8 * kq * 64 + col); const GAS float* pis = (const GAS float*)INP(I_WI) + (((size_t)l * 8 + n) * 64) * 64 + (8 * kq * 64 + col);
#pragma unroll
      for (int ks = 0; ks < 2; ++ks)
#pragma unroll
        for (int nb = 0; nb < 4; ++nb) { float tr[8], ti[8];
#pragma unroll
            for (int j = 0; j < 8; ++j) { const int o = (32 * ks + j) * 64 + 16 * nb; tr[j] = prs[o]; ti[j] = pis[o]; }
            union { bf16x8_t v; unsigned u[4]; } ur, ui;
#pragma unroll
            for (int j = 0; j < 4; ++j) { ur.u[j] = pk2(tr[2 * j], tr[2 * j + 1]); ui.u[j] = pk2(ti[2 * j], ti[2 * j + 1]); }
            wfr[ks][nb] = ur.v; wfi[ks][nb] = ui.v; } }
    const float br = ((const GAS float*)INP(I_BR) + l * 512)[ch], bi = ((const GAS float*)INP(I_BI) + l * 512)[ch];
    const float lamv = ((const GAS float*)INP(I_LAM) + l * 512)[ch]; const float sp = log1pf(__expf(-lamv));
    const GAS float* cwp = (const GAS float*)INP(I_CONVW) + (size_t)l * 4 * 512;
    const float cw0 = cwp[ch], cw1 = cwp[512 + ch], cw2 = cwp[1024 + ch], cw3 = cwp[1536 + ch];
    const float cb = ((const GAS float*)INP(I_CONVB) + l * 512)[ch];
    float h = 0.f, A = 1.f;
    if (P2) { const GAS float* ra = (const GAS float*)WSF(WS_RGA) + (size_t)b * RGC * 512; const GAS float* rh = (const GAS float*)WSF(WS_RGH) + (size_t)b * RGC * 512;
        const GAS float* rap = ra + ch; const GAS float* rhp = rh + ch;
        int j = 0;
#pragma unroll 1
        for (; j + 4 <= c; j += 4) { const float a0 = rap[0], a1 = rap[512], a2 = rap[1024], a3 = rap[1536], h0 = rhp[0], h1 = rhp[512], h2 = rhp[1024], h3 = rhp[1536];
            h = a0 * h + h0; h = a1 * h + h1; h = a2 * h + h2; h = a3 * h + h3; rap += 2048; rhp += 2048; }
#pragma unroll 1
        for (; j < c; ++j) { h = rap[0] * h + rhp[0]; rap += 512; rhp += 512; } }
    const int t0 = c * (SEQ / RGC);
    const GAS bf16* xcs = (const GAS bf16*)WSB(WS_XC) + ((size_t)b * SEQ + t0) * 512;
    GAS bf16* ycs = (GAS bf16*)WSB(WS_YC) + ((size_t)b * SEQ + t0) * 512;
    float x1 = 0.f, x2 = 0.f, x3 = 0.f;
    if (t0 > 0) { const GAS bf16* xm = xcs - 3 * 512; x3 = bf2f(xm[ch]); x2 = bf2f(xm[512 + ch]); x1 = bf2f(xm[1024 + ch]); }
    const int tokA = d >> 3, chk = d & 7;
    const size_t goff = (size_t)tokA * 512 + n * 64 + chk * 8;
    const int loff = tokA * 64 + chk * 8;
#pragma unroll 1
    for (int tile = 0; tile < SEQ / RGC / 16; ++tile) {
        const GAS bf16* xt = xcs + (size_t)tile * 16 * 512 + goff; GAS bf16* yt = ycs + (size_t)tile * 16 * 512 + goff;
        { const v4u a0 = *(const GAS v4u*)xt, a1 = *(const GAS v4u*)(xt + 8 * 512); *(LAS v4u*)(xraw + loff) = a0; *(LAS v4u*)(xraw + loff + 8 * 64) = a1; }
        if (P2) { const v4u a0 = *(const GAS v4u*)yt, a1 = *(const GAS v4u*)(yt + 8 * 512); *(LAS v4u*)(yraw + loff) = a0; *(LAS v4u*)(yraw + loff + 8 * 64) = a1; }
        LDS_WAIT(); asm volatile("" ::: "memory");
        float xc[16];
#pragma unroll
        for (int i = 0; i < 16; ++i) { const float xv = bf2f(xraw[i * 64 + d]); xc[i] = cb + cw0 * x3 + cw1 * x2 + cw2 * x1 + cw3 * xv; x3 = x2; x2 = x1; x1 = xv; }
#pragma unroll
        for (int i = 0; i < 16; ++i) xb[i * RG_XB_STRIDE + d] = (bf16)f2bf(xc[i]);
        LDS_WAIT(); asm volatile("" ::: "memory");
        bf16x8_t af[2];
#pragma unroll
        for (int ks = 0; ks < 2; ++ks) af[ks] = *(const LAS bf16x8_t*)(xb + col * RG_XB_STRIDE + 32 * ks + 8 * kq);
        f32x4 ar[4], ai[4];
#pragma unroll
        for (int nb = 0; nb < 4; ++nb) { ar[nb] = (f32x4){0.f, 0.f, 0.f, 0.f}; ai[nb] = (f32x4){0.f, 0.f, 0.f, 0.f};
#pragma unroll
            for (int ks = 0; ks < 2; ++ks) { ar[nb] = __builtin_amdgcn_mfma_f32_16x16x32_bf16(af[ks], wfr[ks][nb], ar[nb], 0, 0, 0); ai[nb] = __builtin_amdgcn_mfma_f32_16x16x32_bf16(af[ks], wfi[ks][nb], ai[nb], 0, 0, 0); } }
        asm volatile("s_nop 15\n\ts_nop 15" : "+v"(ar[0]), "+v"(ar[1]), "+v"(ar[2]), "+v"(ar[3]), "+v"(ai[0]), "+v"(ai[1]), "+v"(ai[2]), "+v"(ai[3]));
#pragma unroll
        for (int nb = 0; nb < 4; ++nb)
#pragma unroll
            for (int r = 0; r < 4; ++r) { prl[(4 * kq + r) * 64 + 16 * nb + col] = ar[nb][r]; pil[(4 * kq + r) * 64 + 16 * nb + col] = ai[nb][r]; }
        LDS_WAIT(); asm volatile("" ::: "memory");
#pragma unroll
        for (int i = 0; i < 16; ++i) {
            const float r = __builtin_amdgcn_rcpf(1.0f + __expf(-(prl[i * 64 + d] + br))), ig = __builtin_amdgcn_rcpf(1.0f + __expf(-(pil[i * 64 + d] + bi)));
            const float la = -8.0f * r * sp; const float a = __expf(la);
            const float x2a = 2.0f * la;
            const float om = (x2a > -0.05f) ? -x2a * (1.0f + x2a * (0.5f + x2a * (0.16666667f + x2a * 0.041666668f))) : 1.0f - a * a;
            const float u = __builtin_amdgcn_sqrtf(om) * (ig * xc[i]);
            h = a * h + u;
            if (!P2) A *= a;
            else { const float y = bf2f(yraw[i * 64 + d]); const float z = 0.7978845608028654f * (y + 0.044715f * y * y * y);
                const float th = 1.0f - 2.0f * __builtin_amdgcn_rcpf(1.0f + __expf(2.0f * z));
                yraw[i * 64 + d] = (bf16)f2bf(h * (0.5f * y * (1.0f + th))); }
        }
        LDS_WAIT(); asm volatile("" ::: "memory");
        if (P2) { const v4u a0 = *(const LAS v4u*)(yraw + loff), a1 = *(const LAS v4u*)(yraw + loff + 8 * 64); *(GAS v4u*)yt = a0; *(GAS v4u*)(yt + 8 * 512) = a1; }
        LDS_WAIT(); asm volatile("" ::: "memory");
    }
    if (!P2) { const size_t o = ((size_t)b * RGC + c) * 512; ((GAS float*)WSF(WS_RGA) + o)[ch] = A; ((GAS float*)WSF(WS_RGH) + o)[ch] = h; }
    __syncthreads();
}

__device__ __forceinline__ float dot64(const LAS float* qs, const bf16* krow) {
    const v4u* kr = (const v4u*)krow; float s = 0.f;
#pragma unroll
    for (int c = 0; c < 8; ++c) { const v4u w = kr[c]; const f32x4 q0 = *(const LAS f32x4*)(qs + c * 8), q1 = *(const LAS f32x4*)(qs + c * 8 + 4);
        s += q0.x * __uint_as_float(w.x << 16) + q0.y * __uint_as_float(w.x & 0xffff0000u) + q0.z * __uint_as_float(w.y << 16) + q0.w * __uint_as_float(w.y & 0xffff0000u)
           + q1.x * __uint_as_float(w.z << 16) + q1.y * __uint_as_float(w.z & 0xffff0000u) + q1.z * __uint_as_float(w.w << 16) + q1.w * __uint_as_float(w.w & 0xffff0000u); }
    return s;
}
__device__ __forceinline__ void moba_unit(Frame& F, int b, int t) {
    const int h = F.wave, lane = F.lane, cur = t >> 8;
    LAS float* qs = (LAS float*)(F.lds + GL_QS) + h * 64; LAS float* ps = (LAS float*)(F.lds + GL_PS) + h * 1024;
    const size_t row = (size_t)b * SEQ + t;
    bf16* qrow = WSB(WS_QA) + row * 512 + h * 64;
    qs[lane] = bf2f(qrow[lane]);
    LDS_WAIT(); asm volatile("" ::: "memory");
    float g = -1e30f;
    if (lane < cur) { const float* km = WSF(WS_KMEAN) + ((size_t)b * NBLK + lane) * 512 + h * 64; float s = 0.f;
#pragma unroll
        for (int d4 = 0; d4 < 16; ++d4) { const f32x4 kv = *(const f32x4*)(km + d4 * 4); const f32x4 qv = *(const LAS f32x4*)(qs + d4 * 4); s += kv.x * qv.x + kv.y * qv.y + kv.z * qv.z + kv.w * qv.w; }
        g = s; }
    int blk[4]; bool ok[4];
#pragma unroll
    for (int i = 0; i < 3; ++i) { const float m = wave_max(g); const unsigned long long bal = __ballot(g == m); const int sel = __ffsll((long long)bal) - 1; blk[i] = sel; ok[i] = sel < cur; if (lane == sel) g = -INFINITY; }
    blk[3] = cur; ok[3] = true;
    const bf16* Kh = WSB(WS_KA) + ((size_t)b * SEQ) * 512 + h * 64; const bf16* Vh = WSB(WS_VA) + ((size_t)b * SEQ) * 512 + h * 64;
    float lg[16];
#pragma unroll
    for (int i = 0; i < 16; ++i) { const int bi = i >> 2; const int pos = blk[bi] * 256 + (i & 3) * 64 + lane; const bool valid = ok[bi] && pos <= t;
        float s = -1e30f;
        if (valid) s = dot64(qs, Kh + (size_t)pos * 512) * 0.125f + INP(I_RELB)[t5_bucket(t - pos) * 16 + h];
        lg[i] = s; if ((i & 3) == 3) asm volatile("" ::: "memory"); }
    float m = lg[0];
#pragma unroll
    for (int i = 1; i < 16; ++i) m = fmaxf(m, lg[i]);
    m = wave_max(m); float sum = 0.f;
#pragma unroll
    for (int i = 0; i < 16; ++i) { const float e = __expf(lg[i] - m); sum += e; ps[i * 64 + lane] = e; }
    sum = wave_sum(sum);
    LDS_WAIT(); asm volatile("" ::: "memory");
    float acc = 0.f;
#pragma unroll
    for (int bi = 0; bi < 4; ++bi) {
        if (!ok[bi]) continue;
        const int base = blk[bi] * 256; const int nk = (bi == 3) ? (t - base + 1) : 256;
        const bf16* vp = Vh + (size_t)base * 512 + lane; const LAS float* pp = ps + bi * 256;
        int kk = 0;
        for (; kk + 8 <= nk; kk += 8) { float pv[8], vv[8];
#pragma unroll
            for (int j = 0; j < 8; ++j) { pv[j] = pp[kk + j]; vv[j] = bf2f(vp[(size_t)(kk + j) * 512]); }
#pragma unroll
            for (int j = 0; j < 8; ++j) acc += pv[j] * vv[j]; }
        for (; kk < nk; ++kk) acc += pp[kk] * bf2f(vp[(size_t)kk * 512]);
    }
    qrow[lane] = (bf16)f2bf(acc / sum);
}
__device__ __forceinline__ void dsa_unit(Frame& F, int b, int t) {
    const int tid = F.tid, lane = F.lane, h = F.wave;
    LAS unsigned* skey = (LAS unsigned*)(F.lds + GL_SKEY); LAS float* qif = (LAS float*)(F.lds + GL_QIF); LAS float* wq = (LAS float*)(F.lds + GL_WQ);
    LAS unsigned* hist = (LAS unsigned*)(F.lds + GL_HIST); LAS int* sel = (LAS int*)(F.lds + GL_SEL); LAS unsigned* misc = (LAS unsigned*)(F.lds + GL_MISC);
    const size_t row = (size_t)b * SEQ + t; const int n = t + 1;
    __syncthreads();
    qif[tid] = bf2f(WSB(WS_QI)[row * 512 + tid]);
    if (tid < 8) wq[tid] = WSF(WS_WI)[row * 8 + tid];
    if (tid < 16) misc[tid] = 0u;
    __syncthreads();
    if (n > 256) {
        const bf16* kib = WSB(WS_KI) + ((size_t)b * SEQ) * 64;
        for (int s = tid; s < n; s += NWAVES * 64) {
            float kf[64];
            { const v4u* kr = (const v4u*)(kib + (size_t)s * 64);
#pragma unroll
              for (int c = 0; c < 8; ++c) { const v4u w = kr[c]; kf[c * 8 + 0] = __uint_as_float(w.x << 16); kf[c * 8 + 1] = __uint_as_float(w.x & 0xffff0000u); kf[c * 8 + 2] = __uint_as_float(w.y << 16); kf[c * 8 + 3] = __uint_as_float(w.y & 0xffff0000u);
                  kf[c * 8 + 4] = __uint_as_float(w.z << 16); kf[c * 8 + 5] = __uint_as_float(w.z & 0xffff0000u); kf[c * 8 + 6] = __uint_as_float(w.w << 16); kf[c * 8 + 7] = __uint_as_float(w.w & 0xffff0000u); } }
            float score = 0.f;
#pragma unroll 1
            for (int hh = 0; hh < 8; ++hh) { float dsum = 0.f;
#pragma unroll
                for (int d4 = 0; d4 < 16; ++d4) { const f32x4 q = *(const LAS f32x4*)(qif + hh * 64 + d4 * 4); dsum += q.x * kf[d4 * 4] + q.y * kf[d4 * 4 + 1] + q.z * kf[d4 * 4 + 2] + q.w * kf[d4 * 4 + 3]; }
                score += wq[hh] * fmaxf(dsum, 0.f); asm volatile("" ::: "memory"); }
            score *= 0.04419417382415922f;
            if (score == 0.f) score = 0.f;
            const unsigned u = __float_as_uint(score);
            skey[s] = (u & 0x80000000u) ? ~u : (u | 0x80000000u);
        }
        __syncthreads();
        unsigned prefix = 0u; unsigned kneed = 256u, neq = 0u;
#pragma unroll
        for (int pass = 0; pass < 4; ++pass) {
            const int shift = 24 - 8 * pass;
            if (tid < 256) hist[tid] = 0u;
            __syncthreads();
            for (int s = tid; s < n; s += NWAVES * 64) { const unsigned key = skey[s]; const bool match = (pass == 0) ? true : ((key >> ((shift + 8) & 31)) == prefix);
                if (match) __hip_atomic_fetch_add(hist + ((key >> shift) & 255u), 1u, __ATOMIC_RELAXED, __HIP_MEMORY_SCOPE_WORKGROUP); }
            __syncthreads();
            if (h == 0) {
                const unsigned c0 = hist[4 * lane], c1 = hist[4 * lane + 1], c2 = hist[4 * lane + 2], c3 = hist[4 * lane + 3]; const unsigned tot = c0 + c1 + c2 + c3;
                unsigned S = tot;
#pragma unroll
                for (int o = 1; o < 64; o <<= 1) { const unsigned v = __shfl_down(S, o); if (lane + o < 64) S += v; }
                const unsigned above = S - tot;
                if (above < kneed && kneed <= S) { unsigned a = above; unsigned bsel, cnt;
                    if (a + c3 >= kneed) { bsel = 3; cnt = c3; } else { a += c3; if (a + c2 >= kneed) { bsel = 2; cnt = c2; } else { a += c2; if (a + c1 >= kneed) { bsel = 1; cnt = c1; } else { a += c1; bsel = 0; cnt = c0; } } }
                    misc[0] = 4u * lane + bsel; misc[1] = kneed - a; misc[2] = cnt; }
            }
            __syncthreads();
            prefix = (prefix << 8) | misc[0]; kneed = misc[1]; neq = misc[2];
            __syncthreads();
        }
        const unsigned Tk = prefix;
        for (int s = tid; s < n; s += NWAVES * 64) { const unsigned key = skey[s];
            if (key > Tk || (key == Tk && neq == kneed)) { const unsigned idx = __hip_atomic_fetch_add(misc + 8, 1u, __ATOMIC_RELAXED, __HIP_MEMORY_SCOPE_WORKGROUP); if (idx < 256u) sel[idx] = s; } }
        __syncthreads();
        if (neq != kneed && tid == 0) { unsigned c = misc[8]; unsigned need = kneed; for (int s = 0; s < n && need > 0u && c < 256u; ++s) if (skey[s] == Tk) { sel[c++] = s; --need; } }
    } else {
        if (tid < 256) sel[tid] = (tid <= t) ? tid : -1;
    }
    __syncthreads();
    LAS float* qs = (LAS float*)(F.lds + GL_QS) + h * 64; LAS float* ps = (LAS float*)(F.lds + GL_PS) + h * 1024;
    bf16* qrow = WSB(WS_QB) + row * 512 + h * 64;
    qs[lane] = bf2f(qrow[lane]);
    LDS_WAIT(); asm volatile("" ::: "memory");
    const bf16* Kh = WSB(WS_KB) + ((size_t)b * SEQ) * 512 + h * 64; const bf16* Vh = WSB(WS_VB) + ((size_t)b * SEQ) * 512 + h * 64;
    float lg[4];
#pragma unroll
    for (int i = 0; i < 4; ++i) { const int pos = sel[i * 64 + lane]; float s = -1e30f;
        if (pos >= 0) s = dot64(qs, Kh + (size_t)pos * 512) * 0.125f + INP(I_RELB)[t5_bucket(t - pos) * 16 + 8 + h];
        lg[i] = s; }
    float m = wave_max(fmaxf(fmaxf(lg[0], lg[1]), fmaxf(lg[2], lg[3]))); float sum = 0.f;
#pragma unroll
    for (int i = 0; i < 4; ++i) { const float e = __expf(lg[i] - m); sum += e; ps[i * 64 + lane] = e; }
    sum = wave_sum(sum);
    LDS_WAIT(); asm volatile("" ::: "memory");
    float acc = 0.f; const int nk = n < 256 ? n : 256;
    int kk = 0;
    for (; kk + 8 <= nk; kk += 8) { float pv[8], vv[8];
#pragma unroll
        for (int j = 0; j < 8; ++j) { const int pos = sel[kk + j]; pv[j] = ps[kk + j]; vv[j] = bf2f(Vh[(size_t)pos * 512 + lane]); }
#pragma unroll
        for (int j = 0; j < 8; ++j) acc += pv[j] * vv[j]; }
    for (; kk < nk; ++kk) { const int pos = sel[kk]; acc += ps[kk] * bf2f(Vh[(size_t)pos * 512 + lane]); }
    qrow[lane] = (bf16)f2bf(acc / sum);
}

typedef float f32x16 __attribute__((ext_vector_type(16)));
constexpr int AT_KROW = 144, AT_VROW = 136;
constexpr int AT_KBUF = 64 * AT_KROW, AT_VBUF = 64 * AT_VROW;
constexpr int AT_K0 = 0, AT_V0 = 2 * AT_KBUF, AT_BT = 36864, AT_OST = 40960;
constexpr float AT_C2 = 0.125f * 1.4426950408889634f;
constexpr float AT_THR = 8.0f;
constexpr float LOG2E = 1.4426950408889634f;
__device__ __forceinline__ int crow_(int r, int hi) { return (r & 3) + 8 * (r >> 2) + 4 * hi; }
#define MFMA_FENCE2(a, b) asm volatile("s_nop 15\n\ts_nop 15" : "+v"(a), "+v"(b))

__device__ __forceinline__ void at_load(const GAS bf16* Kh, const GAS bf16* Vh, int tile, int tid, v4u& kr, v4u& vr) {
    kr = *(const GAS v4u*)(Kh + (size_t)(tile * 64 + (tid >> 3)) * 512 + (tid & 7) * 8);
    vr = *(const GAS v4u*)(Vh + (size_t)(tile * 64 + (tid >> 3)) * 512 + (tid & 7) * 8);
}
__device__ __forceinline__ void at_store(LAS unsigned char* kb, LAS unsigned char* vb, int tid, const v4u kr, const v4u vr) {
    *(LAS v4u*)(kb + (tid >> 3) * AT_KROW + (tid & 7) * 16) = kr;
    LAS bf16* vt = (LAS bf16*)(vb + ((tid & 7) * 8) * AT_VROW) + (tid >> 3);
    constexpr int RS = AT_VROW / 2;
    vt[0 * RS] = (bf16)(vr.x & 0xffffu); vt[1 * RS] = (bf16)(vr.x >> 16); vt[2 * RS] = (bf16)(vr.y & 0xffffu); vt[3 * RS] = (bf16)(vr.y >> 16);
    vt[4 * RS] = (bf16)(vr.z & 0xffffu); vt[5 * RS] = (bf16)(vr.z >> 16); vt[6 * RS] = (bf16)(vr.w & 0xffffu); vt[7 * RS] = (bf16)(vr.w >> 16);
}
__device__ __forceinline__ void at_qk(f32x16& p0, f32x16& p1, const LAS unsigned char* kb, const bf16x8_t (&qf)[4], int r32, int hi) {
    const LAS unsigned char* kp = kb + r32 * AT_KROW + hi * 16;
    bf16x8_t k0[4], k1[4];
#pragma unroll
    for (int s = 0; s < 4; ++s) { k0[s] = *(const LAS bf16x8_t*)(kp + s * 32); k1[s] = *(const LAS bf16x8_t*)(kp + 32 * AT_KROW + s * 32); }
    asm volatile("s_waitcnt lgkmcnt(0)" : "+v"(k0[0]), "+v"(k0[1]), "+v"(k0[2]), "+v"(k0[3]), "+v"(k1[0]), "+v"(k1[1]), "+v"(k1[2]), "+v"(k1[3]) :: "memory");
#pragma unroll
    for (int s = 0; s < 4; ++s) { p0 = __builtin_amdgcn_mfma_f32_32x32x16_bf16(k0[s], qf[s], p0, 0, 0, 0); p1 = __builtin_amdgcn_mfma_f32_32x32x16_bf16(k1[s], qf[s], p1, 0, 0, 0); }
}
__device__ __forceinline__ void at_qk_m(f32x16& p0, f32x16& p1, const LAS unsigned char* kb, const bf16x8_t (&qf)[4], const bf16x8_t oneA, const bf16x8_t mB, int r32, int hi) {
    const LAS unsigned char* kp = kb + r32 * AT_KROW + hi * 16;
    bf16x8_t k0[4], k1[4];
#pragma unroll
    for (int s = 0; s < 4; ++s) { k0[s] = *(const LAS bf16x8_t*)(kp + s * 32); k1[s] = *(const LAS bf16x8_t*)(kp + 32 * AT_KROW + s * 32); }
    p0 = __builtin_amdgcn_mfma_f32_32x32x16_bf16(oneA, mB, p0, 0, 0, 0); p1 = __builtin_amdgcn_mfma_f32_32x32x16_bf16(oneA, mB, p1, 0, 0, 0);
    asm volatile("s_waitcnt lgkmcnt(0)" : "+v"(k0[0]), "+v"(k0[1]), "+v"(k0[2]), "+v"(k0[3]), "+v"(k1[0]), "+v"(k1[1]), "+v"(k1[2]), "+v"(k1[3]) :: "memory");
#pragma unroll
    for (int s = 0; s < 4; ++s) { p0 = __builtin_amdgcn_mfma_f32_32x32x16_bf16(k0[s], qf[s], p0, 0, 0, 0); p1 = __builtin_amdgcn_mfma_f32_32x32x16_bf16(k1[s], qf[s], p1, 0, 0, 0); }
}
__device__ __forceinline__ void at_pv(f32x16& o0, f32x16& o1, const LAS unsigned char* vb, const bf16x8_t (&pb)[4], int r32, int hi) {
    const LAS unsigned char* vp = vb + r32 * AT_VROW + hi * 8;
    union U { bf16x8_t v; unsigned long long u[2]; }; U a0[4], a1[4];
#pragma unroll
    for (int sg = 0; sg < 4; ++sg) { const int kvo = (32 * (sg >> 1) + 16 * (sg & 1)) * 2;
        a0[sg].u[0] = *(const LAS unsigned long long*)(vp + kvo); a0[sg].u[1] = *(const LAS unsigned long long*)(vp + kvo + 16);
        a1[sg].u[0] = *(const LAS unsigned long long*)(vp + 32 * AT_VROW + kvo); a1[sg].u[1] = *(const LAS unsigned long long*)(vp + 32 * AT_VROW + kvo + 16); }
    asm volatile("s_waitcnt lgkmcnt(0)" : "+v"(a0[0].v), "+v"(a0[1].v), "+v"(a0[2].v), "+v"(a0[3].v), "+v"(a1[0].v), "+v"(a1[1].v), "+v"(a1[2].v), "+v"(a1[3].v) :: "memory");
#pragma unroll
    for (int sg = 0; sg < 4; ++sg) { o0 = __builtin_amdgcn_mfma_f32_32x32x16_bf16(a0[sg].v, pb[sg], o0, 0, 0, 0); o1 = __builtin_amdgcn_mfma_f32_32x32x16_bf16(a1[sg].v, pb[sg], o1, 0, 0, 0); }
}
__device__ __forceinline__ float max3_(float a, float b, float c) { float r; asm("v_max3_f32 %0, %1, %2, %3" : "=v"(r) : "v"(a), "v"(b), "v"(c)); return r; }
__device__ __forceinline__ unsigned and_sel(float p, unsigned w, int bit) { int t; asm("v_bfe_i32 %0, %1, %2, 1" : "=v"(t) : "v"(w), "n"(bit)); return __float_as_uint(p) & (unsigned)t; }

template <int MODE  , bool DRY = false  >
__device__ __forceinline__ void attn_unit(Frame& F, int b, int h, int qt) {
    int tid_ = F.tid; asm volatile("" : "+v"(tid_));
    const int tid = tid_, lane = tid & 63, wave = F.wave, r32 = lane & 31, hi = lane >> 5;
    LAS unsigned char* L = F.lds + RING_OFF;
    LAS float* bt = (LAS float*)(L + AT_BT);
    const GAS bf16* Qg = (const GAS bf16*)WSB(MODE == 0 ? WS_QA : WS_QB); const GAS bf16* Kg = (const GAS bf16*)WSB(MODE == 0 ? WS_KA : WS_KB); const GAS bf16* Vg = (const GAS bf16*)WSB(MODE == 0 ? WS_VA : WS_VB);
    const size_t rowb = (size_t)b * SEQ;
    const GAS bf16* Kh = Kg + rowb * 512 + h * 64; const GAS bf16* Vh = Vg + rowb * 512 + h * 64;
    const int q0w = qt * 256 + wave * 32, q = q0w + r32;
    const int NT = 4 * qt + 4;
    __syncthreads();
    if (tid < 128) { const GAS float* rb = (const GAS float*)INP(I_RELB) + (MODE * 8 + h); bt[tid] = (rb[t5_bucket(tid) * 16] - rb[31 * 16]) * LOG2E; }
    bf16x8_t qf[4];
    { const GAS bf16* qp = Qg + (rowb + q) * 512 + h * 64 + hi * 8;
#pragma unroll
      for (int s = 0; s < 4; ++s) qf[s] = *(const GAS bf16x8_t*)(qp + s * 16); }
    unsigned mlo = 0u, mhi = 0u;
    if (MODE == 0) {
        { const int n = tid >> 3, c8 = (tid & 7) * 8; const GAS float* km = (const GAS float*)WSF(WS_KMEAN) + ((size_t)b * NBLK + n) * 512 + h * 64 + c8;
          const f32x4 a = *(const GAS f32x4*)km, c = *(const GAS f32x4*)(km + 4);
          const unsigned h0 = pk2(a.x, a.y), h1 = pk2(a.z, a.w), h2 = pk2(c.x, c.y), h3 = pk2(c.z, c.w);
          const unsigned l0 = pk2(a.x - __uint_as_float(h0 << 16), a.y - __uint_as_float(h0 & 0xffff0000u)), l1 = pk2(a.z - __uint_as_float(h1 << 16), a.w - __uint_as_float(h1 & 0xffff0000u)),
                         l2 = pk2(c.x - __uint_as_float(h2 << 16), c.y - __uint_as_float(h2 & 0xffff0000u)), l3 = pk2(c.z - __uint_as_float(h3 << 16), c.w - __uint_as_float(h3 & 0xffff0000u));
          *(LAS v4u*)(L + AT_K0 + n * AT_KROW + (tid & 7) * 16) = (v4u){h0, h1, h2, h3}; *(LAS v4u*)(L + AT_K0 + AT_KBUF + n * AT_KROW + (tid & 7) * 16) = (v4u){l0, l1, l2, l3}; }
        __syncthreads();
        f32x16 g0 = {0.f, 0.f, 0.f, 0.f, 0.f, 0.f, 0.f, 0.f, 0.f, 0.f, 0.f, 0.f, 0.f, 0.f, 0.f, 0.f}, g1 = g0;
        at_qk(g0, g1, L + AT_K0, qf, r32, hi); at_qk(g0, g1, L + AT_K0 + AT_KBUF, qf, r32, hi);
        MFMA_FENCE2(g0, g1);
#pragma unroll
        for (int r = 0; r < 16; ++r) { if (crow_(r, hi) >= qt) g0[r] = -INFINITY; if (32 + crow_(r, hi) >= qt) g1[r] = -INFINITY; }
#pragma unroll
        for (int it = 0; it < 3; ++it) {
            float bv = -INFINITY; int bn = 64;
#pragma unroll
            for (int r = 0; r < 16; ++r) if (g0[r] > bv) { bv = g0[r]; bn = crow_(r, hi); }
#pragma unroll
            for (int r = 0; r < 16; ++r) if (g1[r] > bv) { bv = g1[r]; bn = 32 + crow_(r, hi); }
            const float pv = __shfl_xor(bv, 32); const int pn = __shfl_xor(bn, 32);
            const bool tp = (pv > bv) || (pv == bv && pn < bn);
            const float wv = tp ? pv : bv; const int wn = tp ? pn : bn;
            if (wv > -INFINITY) { if (wn < 32) mlo |= 1u << wn; else mhi |= 1u << (wn - 32); }
#pragma unroll
            for (int r = 0; r < 16; ++r) { if (crow_(r, hi) == wn) g0[r] = -INFINITY; if (32 + crow_(r, hi) == wn) g1[r] = -INFINITY; }
        }
        __syncthreads();
    }
    v4u krA, vrA, krB, vrB; unsigned wlA = 0u, whA = 0u, wlB = 0u, whB = 0u;
    const GAS unsigned* mrow = (const GAS unsigned*)(F.ws + WS_MASK) + (rowb + q) * 512;
    at_load(Kh, Vh, 0, tid, krA, vrA);
    unsigned wl_c = 0u, wh_c = 0u;
    if (MODE == 1) { wl_c = mrow[0]; wh_c = mrow[1]; }
    at_store(L + AT_K0, L + AT_V0, tid, krA, vrA);
    at_load(Kh, Vh, 1, tid, krA, vrA);
    if (MODE == 1) { wlA = mrow[2]; whA = mrow[3]; }
    __syncthreads();
    float m = -1e30f, lsum = 0.f;
    f32x16 o0 = {0.f, 0.f, 0.f, 0.f, 0.f, 0.f, 0.f, 0.f, 0.f, 0.f, 0.f, 0.f, 0.f, 0.f, 0.f, 0.f}, o1 = o0;
    auto step = [&](int t, v4u& krS, v4u& vrS, unsigned& wlS, unsigned& whS, v4u& krN, v4u& vrN, unsigned& wlN, unsigned& whN) __attribute__((always_inline)) {
        const int cur = t & 1;
        unsigned wlo = wl_c, whi = wh_c;
        if (t + 2 < NT) { at_load(Kh, Vh, t + 2, tid, krN, vrN); if (MODE == 1) { wlN = mrow[2 * (t + 2)]; whN = mrow[2 * (t + 2) + 1]; } }
        if (MODE == 0) {
            if (t < 4 * qt) { const int blk = t >> 2; const unsigned bit = (blk < 32 ? (mlo >> blk) : (mhi >> (blk - 32))) & 1u; wlo = whi = bit ? 0xffffffffu : 0u; }
            else { const int nall = q - t * 64 + 1;
                wlo = nall >= 32 ? 0xffffffffu : (nall <= 0 ? 0u : ((1u << nall) - 1u)); whi = nall >= 64 ? 0xffffffffu : (nall <= 32 ? 0u : ((1u << (nall - 32)) - 1u)); }
        }
        if (__any((wlo | whi) != 0u)) {
            const LAS unsigned char* kb = L + AT_K0 + cur * AT_KBUF; const LAS unsigned char* vb = L + AT_V0 + cur * AT_VBUF;
            const bool and_mask = (MODE == 1) || (t >= 4 * qt);
            const float ci = (!and_mask && wlo == 0u) ? -1e9f : 0.f;
            f32x16 p0 = {ci, ci, ci, ci, ci, ci, ci, ci, ci, ci, ci, ci, ci, ci, ci, ci}, p1 = p0;
            at_qk(p0, p1, kb, qf, r32, hi);
            MFMA_FENCE2(p0, p1);
            const bool near = (t * 64 + 191 > q0w);
            float mx; float sc = AT_C2;
            if (near) {
#pragma unroll
                for (int r = 0; r < 16; ++r) { const int d0 = q - (t * 64 + crow_(r, hi)), d1 = d0 - 32;
                    const float b0 = ((unsigned)d0 < 128u) ? bt[d0] : 0.f, b1 = ((unsigned)d1 < 128u) ? bt[d1] : 0.f;
                    p0[r] = p0[r] * AT_C2 + b0; p1[r] = p1[r] * AT_C2 + b1; }
                sc = 1.0f;
            }
            { float ma = max3_(p0[0], p1[0], p0[1]), mb = max3_(p1[1], p0[2], p1[2]), mc = max3_(p0[3], p1[3], p0[4]), md = max3_(p1[4], p0[5], p1[5]);
              ma = max3_(ma, p0[6], p1[6]); mb = max3_(mb, p0[7], p1[7]); mc = max3_(mc, p0[8], p1[8]); md = max3_(md, p0[9], p1[9]);
              ma = max3_(ma, p0[10], p1[10]); mb = max3_(mb, p0[11], p1[11]); mc = max3_(mc, p0[12], p1[12]); md = max3_(md, p0[13], p1[13]);
              ma = max3_(ma, p0[14], p1[14]); mb = max3_(mb, p0[15], p1[15]); mx = max3_(ma, mb, mc); mx = max3_(mx, md, md); }
            mx = max3_(mx, __shfl_xor(mx, 32), mx) * sc;
            if (__any(mx > m + AT_THR)) {
                const float mn = fmaxf(m, mx); const float al = __builtin_amdgcn_exp2f(m - mn);
                MFMA_FENCE2(o0, o1);
#pragma unroll
                for (int r = 0; r < 16; ++r) { o0[r] *= al; o1[r] *= al; }
                lsum *= al; m = mn;
            }
            float ls = 0.f;
            if (and_mask) {
                const unsigned wl = wlo >> (4 * hi), wh = whi >> (4 * hi);
                float lq[4] = {0.f, 0.f, 0.f, 0.f};
#pragma unroll
                for (int r = 0; r < 16; ++r) { const int cb = (r & 3) + 8 * (r >> 2);
                    const float e0 = __uint_as_float(and_sel(__builtin_amdgcn_exp2f(__builtin_fmaf(p0[r], sc, -m)), wl, cb)), e1 = __uint_as_float(and_sel(__builtin_amdgcn_exp2f(__builtin_fmaf(p1[r], sc, -m)), wh, cb));
                    p0[r] = e0; p1[r] = e1; lq[r & 1] += e0; lq[2 + (r & 1)] += e1; }
                ls = (lq[0] + lq[1]) + (lq[2] + lq[3]);
            } else {
#pragma unroll
                for (int r = 0; r < 16; ++r) { const float e0 = __builtin_amdgcn_exp2f(__builtin_fmaf(p0[r], sc, -m)), e1 = __builtin_amdgcn_exp2f(__builtin_fmaf(p1[r], sc, -m));
                    p0[r] = e0; p1[r] = e1; ls += e0 + e1; }
            }
            lsum += ls;
            bf16x8_t pb[4];
#pragma unroll
            for (int sg = 0; sg < 4; ++sg) { union { bf16x8_t v; unsigned u[4]; } pk;
#pragma unroll
                for (int j = 0; j < 4; ++j) { const int r = 8 * (sg & 1) + 2 * j; pk.u[j] = (sg < 2) ? pg8::cvt_pk_bf16(p0[r], p0[r + 1]) : pg8::cvt_pk_bf16(p1[r], p1[r + 1]); }
                pb[sg] = pk.v; }
            at_pv(o0, o1, vb, pb, r32, hi);
        }
        if (t + 1 < NT) at_store(L + AT_K0 + (cur ^ 1) * AT_KBUF, L + AT_V0 + (cur ^ 1) * AT_VBUF, tid, krS, vrS);
        wl_c = wlS; wh_c = whS;
        __syncthreads();
    };
#pragma unroll 1
    for (int t = 0; t < NT; t += 2) {
        step(t, krA, vrA, wlA, whA, krB, vrB, wlB, whB);
        step(t + 1, krB, vrB, wlB, whB, krA, vrA, wlA, whA);
    }
    MFMA_FENCE2(o0, o1);
    lsum += __shfl_xor(lsum, 32);
    const float inv = 1.0f / lsum;
    LAS bf16* ost = (LAS bf16*)(L + AT_OST + wave * 4096);
#pragma unroll
    for (int r = 0; r < 16; ++r) { ost[r32 * 64 + crow_(r, hi)] = (bf16)f2bf(o0[r] * inv); ost[r32 * 64 + 32 + crow_(r, hi)] = (bf16)f2bf(o1[r] * inv); }
    LDS_WAIT(); asm volatile("" ::: "memory");
    GAS bf16* Og = (GAS bf16*)WSB(MODE == 0 ? WS_QA : WS_QB) + (rowb + q0w) * 512 + h * 64;
#pragma unroll
    for (int i = 0; i < 4; ++i) { const int c = i * 64 + lane, row = c >> 3, ch = c & 7; const v4u ov = *(const LAS v4u*)(ost + row * 64 + ch * 8); if (!DRY) *(GAS v4u*)(Og + (size_t)row * 512 + ch * 8) = ov; else if (ov.x == 0x12345678u && ov.y == 0x9abcdef0u) *(GAS v4u*)(Og + (size_t)row * 512 + ch * 8) = ov; }
}

constexpr int DA_K0 = 0, DA_V0 = 3 * AT_KBUF, DA_BT = DA_V0 + 2 * AT_VBUF, DA_OST = 49152;
static_assert(DA_BT + 512 <= DA_OST && DA_OST + 8 * 4096 <= RING_BYTES, "dsa attention LDS map");
__device__ __forceinline__ v4u at_load_k(const GAS bf16* Kh, int tile, int tid) { return *(const GAS v4u*)(Kh + (size_t)(tile * 64 + (tid >> 3)) * 512 + (tid & 7) * 8); }
__device__ __forceinline__ v4u at_load_v(const GAS bf16* Vh, int tile, int tid) { return *(const GAS v4u*)(Vh + (size_t)(tile * 64 + (tid & 63)) * 512 + (tid >> 6) * 8); }
__device__ __forceinline__ void at_store_k(LAS unsigned char* kb, int tid, const v4u kr) { *(LAS v4u*)(kb + (tid >> 3) * AT_KROW + (tid & 7) * 16) = kr; }
__device__ __forceinline__ void at_store_v(LAS unsigned char* vb, int tid, const v4u vr) {
    LAS bf16* vt = (LAS bf16*)(vb + ((tid >> 6) * 8) * AT_VROW) + (tid & 63); constexpr int RS = AT_VROW / 2;
    vt[0 * RS] = (bf16)(vr.x & 0xffffu); vt[1 * RS] = (bf16)(vr.x >> 16); vt[2 * RS] = (bf16)(vr.y & 0xffffu); vt[3 * RS] = (bf16)(vr.y >> 16);
    vt[4 * RS] = (bf16)(vr.z & 0xffffu); vt[5 * RS] = (bf16)(vr.z >> 16); vt[6 * RS] = (bf16)(vr.w & 0xffffu); vt[7 * RS] = (bf16)(vr.w >> 16);
}
struct DsaState { float m, lsum; f32x16 o0, o1; unsigned wc_lo, wc_hi, wn_lo, wn_hi; };
__device__ __forceinline__ void dsa_step(DsaState& S, f32x16& P0, f32x16& P1, f32x16& Pn0, f32x16& Pn1, int t, int NT, LAS unsigned char* L, const LAS float* bt, const bf16x8_t (&qf)[4],
                                         const GAS bf16* Kh, const GAS bf16* Vh, const GAS unsigned* mrow, int tid, int r32, int hi, int q, int q0w) {
    v4u krn, vrn; unsigned wq_lo = 0u, wq_hi = 0u;
    const bool has1 = (t + 1 < NT), has2 = (t + 2 < NT);
    if (has2) { krn = at_load_k(Kh, t + 2, tid); wq_lo = mrow[2 * (t + 2)]; wq_hi = mrow[2 * (t + 2) + 1]; }
    if (has1) vrn = at_load_v(Vh, t + 1, tid);
    if (has1 && __any((S.wn_lo | S.wn_hi) != 0u)) {
        Pn0 = (f32x16){0.f, 0.f, 0.f, 0.f, 0.f, 0.f, 0.f, 0.f, 0.f, 0.f, 0.f, 0.f, 0.f, 0.f, 0.f, 0.f}; Pn1 = Pn0;
        at_qk(Pn0, Pn1, L + DA_K0 + ((t + 1) % 3) * AT_KBUF, qf, r32, hi);
    }
    if (__any((S.wc_lo | S.wc_hi) != 0u)) {
        const LAS unsigned char* vb = L + DA_V0 + (t & 1) * AT_VBUF;
        MFMA_FENCE2(P0, P1);
        const bool near = (t * 64 + 191 > q0w);
        float sc = AT_C2;
        if (near) {
#pragma unroll
            for (int r = 0; r < 16; ++r) { const int d0 = q - (t * 64 + crow_(r, hi)), d1 = d0 - 32;
                const float b0 = ((unsigned)d0 < 128u) ? bt[d0] : 0.f, b1 = ((unsigned)d1 < 128u) ? bt[d1] : 0.f;
                P0[r] = P0[r] * AT_C2 + b0; P1[r] = P1[r] * AT_C2 + b1; }
            sc = 1.0f;
        }
        float mx = max3_(P0[0], P1[0], P0[1]), mx2 = max3_(P1[1], P0[2], P1[2]);
#pragma unroll
        for (int r = 3; r < 15; r += 2) { mx = max3_(mx, P0[r], P1[r]); mx2 = max3_(mx2, P0[r + 1], P1[r + 1]); }
        mx = max3_(mx, P0[15], P1[15]); mx = max3_(mx, mx2, mx2);
        mx = max3_(mx, __shfl_xor(mx, 32), mx) * sc;
        if (__any(mx > S.m + AT_THR)) {
            const float mn = fmaxf(S.m, mx); const float al = __builtin_amdgcn_exp2f(S.m - mn);
            MFMA_FENCE2(S.o0, S.o1);
#pragma unroll
            for (int r = 0; r < 16; ++r) { S.o0[r] *= al; S.o1[r] *= al; }
            S.lsum *= al; S.m = mn;
        }
        const unsigned wl = S.wc_lo >> (4 * hi), wh = S.wc_hi >> (4 * hi); const float m = S.m;
        float ls = 0.f;
#pragma unroll
        for (int r = 0; r < 16; ++r) { const int cb = (r & 3) + 8 * (r >> 2);
            const float e0 = __uint_as_float(and_sel(__builtin_amdgcn_exp2f(__builtin_fmaf(P0[r], sc, -m)), wl, cb)), e1 = __uint_as_float(and_sel(__builtin_amdgcn_exp2f(__builtin_fmaf(P1[r], sc, -m)), wh, cb));
            P0[r] = e0; P1[r] = e1; ls += e0 + e1; }
        S.lsum += ls;
        bf16x8_t pb[4];
#pragma unroll
        for (int sg = 0; sg < 4; ++sg) { union { bf16x8_t v; unsigned u[4]; } pk;
#pragma unroll
            for (int j = 0; j < 4; ++j) { const int r = 8 * (sg & 1) + 2 * j; pk.u[j] = (sg < 2) ? pg8::cvt_pk_bf16(P0[r], P0[r + 1]) : pg8::cvt_pk_bf16(P1[r], P1[r + 1]); }
            pb[sg] = pk.v; }
        at_pv(S.o0, S.o1, vb, pb, r32, hi);
    }
    if (has2) at_store_k(L + DA_K0 + ((t + 2) % 3) * AT_KBUF, tid, krn);
    if (has1) at_store_v(L + DA_V0 + ((t + 1) & 1) * AT_VBUF, tid, vrn);
    S.wc_lo = S.wn_lo; S.wc_hi = S.wn_hi; S.wn_lo = wq_lo; S.wn_hi = wq_hi;
    __syncthreads();
}
template <bool DRY = false> __device__ __forceinline__ void dsa_attn_unit(Frame& F, int b, int h, int qt) {
    int tid_ = F.tid; asm volatile("" : "+v"(tid_));
    const int tid = tid_, lane = tid & 63, wave = F.wave, r32 = lane & 31, hi = lane >> 5;
    LAS unsigned char* L = F.lds + RING_OFF;
    LAS float* bt = (LAS float*)(L + DA_BT);
    const size_t rowb = (size_t)b * SEQ;
    const GAS bf16* Kh = (const GAS bf16*)WSB(WS_KB) + rowb * 512 + h * 64; const GAS bf16* Vh = (const GAS bf16*)WSB(WS_VB) + rowb * 512 + h * 64;
    const int q0w = qt * 256 + wave * 32, q = q0w + r32;
    const int NT = 4 * qt + 4;
    __syncthreads();
    if (tid < 128) { const GAS float* rb = (const GAS float*)INP(I_RELB) + (8 + h); bt[tid] = (rb[t5_bucket(tid) * 16] - rb[31 * 16]) * LOG2E; }
    bf16x8_t qf[4];
    { const GAS bf16* qp = (const GAS bf16*)WSB(WS_QB) + (rowb + q) * 512 + h * 64 + hi * 8;
#pragma unroll
      for (int s = 0; s < 4; ++s) qf[s] = *(const GAS bf16x8_t*)(qp + s * 16); }
    const GAS unsigned* mrow = (const GAS unsigned*)(F.ws + WS_MASK) + (rowb + q) * 512;
    DsaState S; S.m = -1e30f; S.lsum = 0.f; S.o0 = (f32x16){0.f, 0.f, 0.f, 0.f, 0.f, 0.f, 0.f, 0.f, 0.f, 0.f, 0.f, 0.f, 0.f, 0.f, 0.f, 0.f}; S.o1 = S.o0;
    S.wc_lo = mrow[0]; S.wc_hi = mrow[1]; S.wn_lo = mrow[2]; S.wn_hi = mrow[3];
    { const v4u k0 = at_load_k(Kh, 0, tid), v0 = at_load_v(Vh, 0, tid), k1 = at_load_k(Kh, 1, tid);
      at_store_k(L + DA_K0, tid, k0); at_store_v(L + DA_V0, tid, v0); at_store_k(L + DA_K0 + AT_KBUF, tid, k1); }
    __syncthreads();
    f32x16 pA0 = {0.f, 0.f, 0.f, 0.f, 0.f, 0.f, 0.f, 0.f, 0.f, 0.f, 0.f, 0.f, 0.f, 0.f, 0.f, 0.f}, pA1 = pA0, pB0 = pA0, pB1 = pA0;
    if (__any((S.wc_lo | S.wc_hi) != 0u)) at_qk(pA0, pA1, L + DA_K0, qf, r32, hi);
#pragma unroll 1
    for (int t = 0; t < NT; t += 2) {
        dsa_step(S, pA0, pA1, pB0, pB1, t, NT, L, bt, qf, Kh, Vh, mrow, tid, r32, hi, q, q0w);
        dsa_step(S, pB0, pB1, pA0, pA1, t + 1, NT, L, bt, qf, Kh, Vh, mrow, tid, r32, hi, q, q0w);
    }
    MFMA_FENCE2(S.o0, S.o1);
    float lsum = S.lsum; lsum += __shfl_xor(lsum, 32);
    const float inv = 1.0f / lsum;
    LAS bf16* ost = (LAS bf16*)(L + DA_OST + wave * 4096);
#pragma unroll
    for (int r = 0; r < 16; ++r) { ost[r32 * 64 + crow_(r, hi)] = (bf16)f2bf(S.o0[r] * inv); ost[r32 * 64 + 32 + crow_(r, hi)] = (bf16)f2bf(S.o1[r] * inv); }
    LDS_WAIT(); asm volatile("" ::: "memory");
    GAS bf16* Og = (GAS bf16*)WSB(WS_QB) + (rowb + q0w) * 512 + h * 64;
#pragma unroll
    for (int i = 0; i < 4; ++i) { const int c = i * 64 + lane, row = c >> 3, ch = c & 7; const v4u ov = *(const LAS v4u*)(ost + row * 64 + ch * 8); if (!DRY) *(GAS v4u*)(Og + (size_t)row * 512 + ch * 8) = ov; else if (ov.x == 0x12345678u && ov.y == 0x9abcdef0u) *(GAS v4u*)(Og + (size_t)row * 512 + ch * 8) = ov; }
}

constexpr int A2_TILE = 64 * 128;
__device__ __forceinline__ void at2_dma(const GAS bf16* Kh, const GAS bf16* Vh, int tile, int wave, int lane, LAS unsigned char* kb, LAS unsigned char* vb) {
    const int row = 8 * wave + (lane >> 3), p = lane & 7;
    const GAS bf16* kg = Kh + (size_t)(tile * 64 + row) * 512 + ((p ^ ((row >> 1) & 7)) * 8);
    const GAS bf16* vg = Vh + (size_t)(tile * 64 + row) * 512 + ((p ^ (((row >> 1) & 1) * 4)) * 8);
    __builtin_amdgcn_global_load_lds((const unsigned*)kg, (LAS unsigned*)(kb + wave * 1024), 16, 0, 0);
    __builtin_amdgcn_global_load_lds((const unsigned*)vg, (LAS unsigned*)(vb + wave * 1024), 16, 0, 0);
}
__device__ __forceinline__ void at2_qk_m(f32x16& p0, f32x16& p1, const LAS unsigned char* kb, const LAS unsigned char* ones, const bf16x8_t (&qf)[4], const bf16x8_t mB, int r32, int hi) {
    const int f = (r32 >> 1) & 7;
    const LAS unsigned char* kp = kb + r32 * 128;
    bf16x8_t k0[5], k1[5];
#pragma unroll
    for (int s = 0; s < 4; ++s) { const int po = ((2 * s + hi) ^ f) * 16; k0[s] = *(const LAS bf16x8_t*)(kp + po); k1[s] = *(const LAS bf16x8_t*)(kp + 32 * 128 + po); }
    k0[4] = *(const LAS bf16x8_t*)ones; k1[4] = k0[4];
    asm volatile("s_waitcnt lgkmcnt(0)" : "+v"(k0[0]), "+v"(k0[1]), "+v"(k0[2]), "+v"(k0[3]), "+v"(k0[4]), "+v"(k1[0]), "+v"(k1[1]), "+v"(k1[2]), "+v"(k1[3]), "+v"(k1[4]) :: "memory");
    p0 = __builtin_amdgcn_mfma_f32_32x32x16_bf16(k0[4], mB, p0, 0, 0, 0); p1 = __builtin_amdgcn_mfma_f32_32x32x16_bf16(k1[4], mB, p1, 0, 0, 0);
#pragma unroll
    for (int s = 0; s < 4; ++s) { p0 = __builtin_amdgcn_mfma_f32_32x32x16_bf16(k0[s], qf[s], p0, 0, 0, 0); p1 = __builtin_amdgcn_mfma_f32_32x32x16_bf16(k1[s], qf[s], p1, 0, 0, 0); }
}
typedef short s16x4_t __attribute__((ext_vector_type(4)));
__device__ __forceinline__ void at2_pv(f32x16& o0, f32x16& o1, const LAS unsigned char* vb, const bf16x8_t (&pb)[4], int lane) {
    const int g = lane >> 4, q = (lane & 15) >> 2, p = lane & 3;
    const int sw = ((q >> 1) & 1) * 4, c0 = 2 * (g & 1) + (p >> 1);
    const LAS unsigned char* rowp = vb + (4 * (g >> 1) + q) * 128 + 8 * (p & 1);
    const LAS unsigned char* b0 = rowp + ((c0 ^ sw) * 16); const LAS unsigned char* b1 = rowp + (((c0 + 4) ^ sw) * 16);
    union U { bf16x8_t v; s16x4_t h[2]; }; U a0[4], a1[4];
#pragma unroll
    for (int sg = 0; sg < 4; ++sg) { const int ro = (32 * (sg >> 1) + 16 * (sg & 1)) * 128;
        a0[sg].h[0] = __builtin_amdgcn_ds_read_tr16_b64_v4i16((LAS s16x4_t*)(b0 + ro)); a0[sg].h[1] = __builtin_amdgcn_ds_read_tr16_b64_v4i16((LAS s16x4_t*)(b0 + ro + 8 * 128));
        a1[sg].h[0] = __builtin_amdgcn_ds_read_tr16_b64_v4i16((LAS s16x4_t*)(b1 + ro)); a1[sg].h[1] = __builtin_amdgcn_ds_read_tr16_b64_v4i16((LAS s16x4_t*)(b1 + ro + 8 * 128)); }
    asm volatile("s_waitcnt lgkmcnt(0)" : "+v"(a0[0].v), "+v"(a0[1].v), "+v"(a0[2].v), "+v"(a0[3].v), "+v"(a1[0].v), "+v"(a1[1].v), "+v"(a1[2].v), "+v"(a1[3].v) :: "memory");
#pragma unroll
    for (int sg = 0; sg < 4; ++sg) { o0 = __builtin_amdgcn_mfma_f32_32x32x16_bf16(a0[sg].v, pb[sg], o0, 0, 0, 0); o1 = __builtin_amdgcn_mfma_f32_32x32x16_bf16(a1[sg].v, pb[sg], o1, 0, 0, 0); }
}
constexpr int D2_K = 0, D2_V = 4 * A2_TILE, D2_ONES = 8 * A2_TILE, D2_BT = D2_ONES + 64, D2_OST = 73728;
static_assert(D2_BT + 512 <= D2_OST && D2_OST + 8 * 4096 <= RING_BYTES, "dsa2 LDS map");
template <bool DRY = false> __device__ __forceinline__ void dsa_attn2_unit(Frame& F, int b, int h, int qt) {
    int tid_ = F.tid; asm volatile("" : "+v"(tid_));
    const int tid = tid_, lane = tid & 63, wave = F.wave, r32 = lane & 31, hi = lane >> 5;
    LAS unsigned char* L = F.lds + RING_OFF;
    LAS float* bt = (LAS float*)(L + D2_BT);
    const size_t rowb = (size_t)b * SEQ;
    const GAS bf16* Kh = (const GAS bf16*)WSB(WS_KB) + rowb * 512 + h * 64; const GAS bf16* Vh = (const GAS bf16*)WSB(WS_VB) + rowb * 512 + h * 64;
    const int q0w = qt * 256 + wave * 32, q = q0w + r32;
    const int NS = 2 * qt + 2;
    __syncthreads();
    if (tid < 128) { const GAS float* rb = (const GAS float*)INP(I_RELB) + (8 + h); bt[tid] = (rb[t5_bucket(tid) * 16] - rb[31 * 16]) * LOG2E; }
    bf16x8_t qf[4];
    { const GAS bf16* qp = (const GAS bf16*)WSB(WS_QB) + (rowb + q) * 512 + h * 64 + hi * 8;
#pragma unroll
      for (int s = 0; s < 4; ++s) qf[s] = *(const GAS bf16x8_t*)(qp + s * 16); }
#pragma unroll
    for (int s = 0; s < 4; ++s) { union { bf16x8_t v; unsigned u[4]; } x; x.v = qf[s];
#pragma unroll
        for (int jj = 0; jj < 4; ++jj) x.u[jj] = pg8::cvt_pk_bf16(pg8::bf_lo(x.u[jj]) * AT_C2, pg8::bf_hi(x.u[jj]) * AT_C2);
        qf[s] = x.v; }
    bf16x8_t mB;
    { union { bf16x8_t v; unsigned u[4]; } x; x.u[0] = x.u[1] = x.u[2] = x.u[3] = 0u; mB = x.v; }
    if (tid == 0) { unsigned one = 0x3f80u, zz = 0u; asm volatile("" : "+v"(one), "+v"(zz)); *(LAS v4u*)(L + D2_ONES) = (v4u){one, zz, zz, zz}; }
    bool fresh = true;
    const GAS unsigned* mrow = (const GAS unsigned*)(F.ws + WS_MASK) + (rowb + q) * 512;
    auto dma2 = [&](int s) __attribute__((always_inline)) { const int set = s & 1;
        at2_dma(Kh, Vh, 2 * s, wave, lane, L + D2_K + (2 * set) * A2_TILE, L + D2_V + (2 * set) * A2_TILE);
        at2_dma(Kh, Vh, 2 * s + 1, wave, lane, L + D2_K + (2 * set + 1) * A2_TILE, L + D2_V + (2 * set + 1) * A2_TILE); };
    dma2(0);
    unsigned wc[4] = { mrow[0], mrow[1], mrow[2], mrow[3] };
    VM_WAIT(); __syncthreads();
    float m = 0.f, lsum = 0.f;
    f32x16 o0 = {0.f, 0.f, 0.f, 0.f, 0.f, 0.f, 0.f, 0.f, 0.f, 0.f, 0.f, 0.f, 0.f, 0.f, 0.f, 0.f}, o1 = o0;
    auto step = [&](int s) __attribute__((always_inline)) {
        const int set = s & 1;
        if (s + 1 < NS) dma2(s + 1);
        unsigned wn[4] = {0u, 0u, 0u, 0u};
        if (s + 1 < NS) { const GAS unsigned* mp = mrow + 4 * (s + 1); wn[0] = mp[0]; wn[1] = mp[1]; wn[2] = mp[2]; wn[3] = mp[3]; }
        if (__any((wc[0] | wc[1] | wc[2] | wc[3]) != 0u)) {
            const LAS unsigned char* kb = L + D2_K + (2 * set) * A2_TILE; const LAS unsigned char* vb = L + D2_V + (2 * set) * A2_TILE;
            f32x16 p0 = {0.f, 0.f, 0.f, 0.f, 0.f, 0.f, 0.f, 0.f, 0.f, 0.f, 0.f, 0.f, 0.f, 0.f, 0.f, 0.f}, p1 = p0, p2 = p0, p3 = p0;
            at2_qk_m(p0, p1, kb, L + D2_ONES, qf, mB, r32, hi); at2_qk_m(p2, p3, kb + A2_TILE, L + D2_ONES, qf, mB, r32, hi);
            asm volatile("s_nop 15\n\ts_nop 15" : "+v"(p0), "+v"(p1), "+v"(p2), "+v"(p3));
            const int t0 = 2 * s;
            const bool near = ((t0 + 1) * 64 + 191 > q0w);
            if (near) {
#pragma unroll
                for (int r = 0; r < 16; ++r) { const int d0 = q - (t0 * 64 + crow_(r, hi)), d1 = d0 - 32, d2 = d0 - 64, d3 = d0 - 96;
                    const float b0 = ((unsigned)d0 < 128u) ? bt[d0] : 0.f, b1 = ((unsigned)d1 < 128u) ? bt[d1] : 0.f, b2 = ((unsigned)d2 < 128u) ? bt[d2] : 0.f, b3 = ((unsigned)d3 < 128u) ? bt[d3] : 0.f;
                    p0[r] += b0; p1[r] += b1; p2[r] += b2; p3[r] += b3; }
            }
            float mx;
            { float ma = max3_(p0[0], p1[0], p2[0]), mb = max3_(p3[0], p0[1], p1[1]), mc = max3_(p2[1], p3[1], p0[2]), md = max3_(p1[2], p2[2], p3[2]);
#pragma unroll
              for (int r = 3; r < 15; r += 2) { ma = max3_(ma, p0[r], p1[r]); mb = max3_(mb, p2[r], p3[r]); mc = max3_(mc, p0[r + 1], p1[r + 1]); md = max3_(md, p2[r + 1], p3[r + 1]); }
              ma = max3_(ma, p0[15], p1[15]); mb = max3_(mb, p2[15], p3[15]); mx = max3_(ma, mb, mc); mx = max3_(mx, md, md); }
            mx = max3_(mx, __shfl_xor(mx, 32), mx);
            if (fresh || __any(mx > AT_THR)) {
                const float d = fresh ? mx : fmaxf(mx, 0.f);
                const float mn = __uint_as_float(pg8::cvt_pk_bf16(0.f, m + d) & 0xffff0000u);
                const float dl = mn - m; const float al = __builtin_amdgcn_exp2f(-dl);
                MFMA_FENCE2(o0, o1);
#pragma unroll
                for (int r = 0; r < 16; ++r) { o0[r] *= al; o1[r] *= al; p0[r] -= dl; p1[r] -= dl; p2[r] -= dl; p3[r] -= dl; }
                lsum *= al; m = mn; fresh = false;
                { union { bf16x8_t v; unsigned u[4]; } x; x.u[0] = hi == 0 ? ((__float_as_uint(m) >> 16) ^ 0x8000u) : 0u; x.u[1] = x.u[2] = x.u[3] = 0u; mB = x.v; }
            }
            const unsigned w0 = wc[0] >> (4 * hi), w1 = wc[1] >> (4 * hi), w2 = wc[2] >> (4 * hi), w3 = wc[3] >> (4 * hi);
            float lq[4] = {0.f, 0.f, 0.f, 0.f};
#pragma unroll
            for (int r = 0; r < 16; ++r) { const int cb = (r & 3) + 8 * (r >> 2);
                const float e0 = __uint_as_float(and_sel(__builtin_amdgcn_exp2f(p0[r]), w0, cb)), e1 = __uint_as_float(and_sel(__builtin_amdgcn_exp2f(p1[r]), w1, cb));
                const float e2 = __uint_as_float(and_sel(__builtin_amdgcn_exp2f(p2[r]), w2, cb)), e3 = __uint_as_float(and_sel(__builtin_amdgcn_exp2f(p3[r]), w3, cb));
                p0[r] = e0; p1[r] = e1; p2[r] = e2; p3[r] = e3; lq[0] += e0; lq[1] += e1; lq[2] += e2; lq[3] += e3; }
            lsum += (lq[0] + lq[1]) + (lq[2] + lq[3]);
            bf16x8_t pb[4], pc[4];
#pragma unroll
            for (int sg = 0; sg < 4; ++sg) { union { bf16x8_t v; unsigned u[4]; } pk, pl;
#pragma unroll
                for (int j = 0; j < 4; ++j) { const int r = 8 * (sg & 1) + 2 * j; pk.u[j] = (sg < 2) ? pg8::cvt_pk_bf16(p0[r], p0[r + 1]) : pg8::cvt_pk_bf16(p1[r], p1[r + 1]);
                    pl.u[j] = (sg < 2) ? pg8::cvt_pk_bf16(p2[r], p2[r + 1]) : pg8::cvt_pk_bf16(p3[r], p3[r + 1]); }
                pb[sg] = pk.v; pc[sg] = pl.v; }
            at2_pv(o0, o1, vb, pb, lane); at2_pv(o0, o1, vb + A2_TILE, pc, lane);
        }
        wc[0] = wn[0]; wc[1] = wn[1]; wc[2] = wn[2]; wc[3] = wn[3];
        VM_WAIT(); __syncthreads();
    };
#pragma unroll 1
    for (int s = 0; s < NS; ++s) step(s);
    MFMA_FENCE2(o0, o1);
    lsum += __shfl_xor(lsum, 32);
    const float inv = 1.0f / lsum;
    LAS bf16* ost = (LAS bf16*)(L + D2_OST + wave * 4096);
#pragma unroll
    for (int r = 0; r < 16; ++r) { ost[r32 * 64 + crow_(r, hi)] = (bf16)f2bf(o0[r] * inv); ost[r32 * 64 + 32 + crow_(r, hi)] = (bf16)f2bf(o1[r] * inv); }
    LDS_WAIT(); asm volatile("" ::: "memory");
    GAS bf16* Og = (GAS bf16*)WSB(WS_QB) + (rowb + q0w) * 512 + h * 64;
#pragma unroll
    for (int i = 0; i < 4; ++i) { const int c = i * 64 + lane, row = c >> 3, ch = c & 7; const v4u ov = *(const LAS v4u*)(ost + row * 64 + ch * 8); if (!DRY) *(GAS v4u*)(Og + (size_t)row * 512 + ch * 8) = ov; else if (ov.x == 0x12345678u && ov.y == 0x9abcdef0u) *(GAS v4u*)(Og + (size_t)row * 512 + ch * 8) = ov; }
}
#ifndef IX_SMIN_V
#define IX_SMIN_V 16
#endif
#ifndef IX_ZMAX_V
#define IX_ZMAX_V 255
#endif
constexpr int IX_FSH = 18, IX_FBASE = (0x2000 | (127 << 5)) - 42 * 32, IX_SSTRIDE = 8, IX_SMIN = IX_SMIN_V, IX_SHI = 16, IX_SLO = 56, IX_STOT = 36, IX_ZMAX = IX_ZMAX_V;
constexpr int IX_CAP = 768;
constexpr int IX_HIST = 0, IX_CAND = 0, IX_BM = 98304;
constexpr int IX_W = LDSCTL_OFF + 1024;
constexpr int IX_ST = LDSCTL_OFF + 1536;
constexpr int IX_SUB = LDSCTL_OFF + 2048, IX_L2 = IX_SUB + 8 * 1024, IX_C2 = IX_L2 + 8 * 512;
static_assert(IX_C2 + 64 <= LDS_BYTES, "idx sub-histogram LDS");
static_assert(IX_BM + 16 * 512 * 4 <= RING_BYTES && 16 * IX_CAP * 8 <= IX_BM && IX_ST + 6 * 64 <= LDS_BYTES, "idx LDS map");
#define MFMA_FENCE1(a) asm volatile("s_nop 15\n\ts_nop 15" : "+v"(a))
__device__ __forceinline__ float relu_(float x, float) { float r; asm("v_max_f32 %0, 0, %1" : "=v"(r) : "v"(x)); return r; }
__device__ __forceinline__ unsigned mono_key(float s) { const unsigned u = __float_as_uint(s + 0.0f); return u ^ ((unsigned)((int)u >> 31) | 0x80000000u); }

template <int MODE, bool LEVEL0, bool LAST, int HALF> __device__ __forceinline__ void idx_vec(const f32x16 (&accs)[2], const f32x4 (&wv)[4][4], LAS unsigned* hist, LAS unsigned long long* cand, LAS unsigned* bm, LAS unsigned* st,
                                                                                    const unsigned (&psh)[8], const unsigned (&ppre)[8], const bool (&pact)[8], int key, int t0, int hi, int lane, int w32, int shn, unsigned fmask, bool allsel) {
#pragma unroll
    for (int rb = 2 * HALF; rb < 2 * HALF + 2; ++rb) {
        const f32x16 acc = accs[rb - 2 * HALF];
        const int qla = 4 * rb + 2 * hi;
        const f32x4 w0 = wv[rb][0], w1 = wv[rb][1], w2 = wv[rb][2], w3 = wv[rb][3];
        float sa = w0.x * relu_(acc[0], 0.f), sa2 = w0.y * relu_(acc[1], 0.f); sa += w0.z * relu_(acc[2], 0.f); sa2 += w0.w * relu_(acc[3], 0.f);
        sa += w1.x * relu_(acc[4], 0.f); sa2 += w1.y * relu_(acc[5], 0.f); sa += w1.z * relu_(acc[6], 0.f); sa2 += w1.w * relu_(acc[7], 0.f);
        float sb = w2.x * relu_(acc[8], 0.f), sb2 = w2.y * relu_(acc[9], 0.f); sb += w2.z * relu_(acc[10], 0.f); sb2 += w2.w * relu_(acc[11], 0.f);
        sb += w3.x * relu_(acc[12], 0.f); sb2 += w3.y * relu_(acc[13], 0.f); sb += w3.z * relu_(acc[14], 0.f); sb2 += w3.w * relu_(acc[15], 0.f);
        sa += sa2; sb += sb2;
        const unsigned ua = mono_key(sa), ub = mono_key(sb);
        const bool va = !LAST || key <= t0 + qla, vb = !LAST || key <= t0 + qla + 1;
        if (MODE == 3) {
            const int fa = (int)(ua >> IX_FSH) - IX_FBASE, fb = (int)(ub >> IX_FSH) - IX_FBASE;
            const unsigned ba = (unsigned)(fa > 2047 ? 2047 : fa), bb = (unsigned)(fb > 2047 ? 2047 : fb);
            if (fa > 0) __hip_atomic_fetch_add(hist + qla * 2048 + ba, 1u, __ATOMIC_RELAXED, __HIP_MEMORY_SCOPE_WORKGROUP);
            if (fb > 0) __hip_atomic_fetch_add(hist + (qla + 1) * 2048 + bb, 1u, __ATOMIC_RELAXED, __HIP_MEMORY_SCOPE_WORKGROUP);
        } else if (MODE == 2) {
            const unsigned pa = ua >> IX_FSH, pb = ub >> IX_FSH;
            const bool sela = va && pa > ppre[2 * rb], selb = vb && pb > ppre[2 * rb + 1];
            const bool ca = va && (ppre[2 * rb] - pa) <= psh[2 * rb], cb = vb && (ppre[2 * rb + 1] - pb) <= psh[2 * rb + 1];
            const unsigned long long bala = __ballot(sela), balb = __ballot(selb);
            if (lane == 0) { bm[(4 * rb + 0) * 512 + w32] = (unsigned)bala; bm[(4 * rb + 2) * 512 + w32] = (unsigned)(bala >> 32);
                             bm[(4 * rb + 1) * 512 + w32] = (unsigned)balb; bm[(4 * rb + 3) * 512 + w32] = (unsigned)(balb >> 32); }
            unsigned slota = (unsigned)IX_CAP, slotb = (unsigned)IX_CAP;
            if (ca) slota = __hip_atomic_fetch_add(st + qla, 1u, __ATOMIC_RELAXED, __HIP_MEMORY_SCOPE_WORKGROUP);
            if (cb) slotb = __hip_atomic_fetch_add(st + qla + 1, 1u, __ATOMIC_RELAXED, __HIP_MEMORY_SCOPE_WORKGROUP);
            if (slota < (unsigned)IX_CAP) cand[qla * IX_CAP + slota] = ((unsigned long long)ua << 32) | (unsigned)(0xffff - key);
            if (slotb < (unsigned)IX_CAP) cand[(qla + 1) * IX_CAP + slotb] = ((unsigned long long)ub << 32) | (unsigned)(0xffff - key);
        } else if (MODE == 0) {
            const bool ma = va && (LEVEL0 || (pact[2 * rb] && (ua >> psh[2 * rb]) == ppre[2 * rb]));
            const bool mb = vb && (LEVEL0 || (pact[2 * rb + 1] && (ub >> psh[2 * rb + 1]) == ppre[2 * rb + 1]));
            const unsigned ba = LEVEL0 ? (ua >> 21) : ((ua >> shn) & fmask), bb = LEVEL0 ? (ub >> 21) : ((ub >> shn) & fmask);
            if (ma) __hip_atomic_fetch_add(hist + qla * 2048 + ba, 1u, __ATOMIC_RELAXED, __HIP_MEMORY_SCOPE_WORKGROUP);
            if (mb) __hip_atomic_fetch_add(hist + (qla + 1) * 2048 + bb, 1u, __ATOMIC_RELAXED, __HIP_MEMORY_SCOPE_WORKGROUP);
        } else {
            const unsigned pa = ua >> psh[2 * rb], pb = ub >> psh[2 * rb + 1];
            const bool sela = va && (allsel || pa > ppre[2 * rb]), selb = vb && (allsel || pb > ppre[2 * rb + 1]);
            const bool ca = va && !allsel && pa == ppre[2 * rb], cb = vb && !allsel && pb == ppre[2 * rb + 1];
            const unsigned long long bala = __ballot(sela), balb = __ballot(selb);
            if (lane == 0) { bm[(4 * rb + 0) * 512 + w32] = (unsigned)bala; bm[(4 * rb + 2) * 512 + w32] = (unsigned)(bala >> 32);
                             bm[(4 * rb + 1) * 512 + w32] = (unsigned)balb; bm[(4 * rb + 3) * 512 + w32] = (unsigned)(balb >> 32); }
            unsigned slota = (unsigned)IX_CAP, slotb = (unsigned)IX_CAP;
            if (ca) slota = __hip_atomic_fetch_add(st + qla, 1u, __ATOMIC_RELAXED, __HIP_MEMORY_SCOPE_WORKGROUP);
            if (cb) slotb = __hip_atomic_fetch_add(st + qla + 1, 1u, __ATOMIC_RELAXED, __HIP_MEMORY_SCOPE_WORKGROUP);
            if (slota < (unsigned)IX_CAP) cand[qla * IX_CAP + slota] = ((unsigned long long)ua << 32) | (unsigned)(0xffff - key);
            if (slotb < (unsigned)IX_CAP) cand[(qla + 1) * IX_CAP + slotb] = ((unsigned long long)ub << 32) | (unsigned)(0xffff - key);
        }
    }
}
template <int MODE, bool LEVEL0, int STRIDE = 1> __device__ __forceinline__ void idx_pass(Frame& F, const bf16x8_t (&qa)[4][4], const GAS bf16* kib, int t0, int nst, int wave, int lane,
                                                             int shn, unsigned fmask, bool allsel) {
    const int n = lane & 31, hi = lane >> 5;
    LAS unsigned char* L = F.lds + RING_OFF;
    LAS unsigned* hist = (LAS unsigned*)(L + IX_HIST); LAS unsigned long long* cand = (LAS unsigned long long*)(L + IX_CAND); LAS unsigned* bm = (LAS unsigned*)(L + IX_BM);
    const LAS float* wl = (const LAS float*)(F.lds + IX_W); LAS unsigned* st = (LAS unsigned*)(F.lds + IX_ST);
    unsigned psh[8], ppre[8]; bool pact[8];
#pragma unroll
    for (int i = 0; i < 8; ++i) { const int ql = 4 * (i >> 1) + 2 * hi + (i & 1); psh[i] = st[16 + ql]; ppre[i] = st[32 + ql]; pact[i] = (st[80 + ql] != 0u); }
    f32x4 wv[4][4];
#pragma unroll
    for (int rb = 0; rb < 4; ++rb)
#pragma unroll
        for (int j = 0; j < 4; ++j) wv[rb][j] = *(const LAS f32x4*)(wl + (4 * rb + 2 * hi) * 8 + 4 * j);
    bf16x8_t kf[4];
    const GAS bf16* kp = kib + (size_t)(wave * 32 + n) * 64 + hi * 8;
#pragma unroll
    for (int s = 0; s < 4; ++s) kf[s] = *(const GAS bf16x8_t*)(kp + s * 16);
    const int nlim = STRIDE == 1 ? nst : nst - 1;
#pragma unroll 1
    for (int stile = 0; stile < nlim; stile += STRIDE) {
        const int key = stile * 256 + wave * 32 + n;
        const int w32 = stile * 8 + wave;
        const bool lastt = STRIDE == 1 && (stile + 1 == nst);
        const bool more = (stile + STRIDE < nlim);
        f32x16 accs[2];
#pragma unroll
        for (int rb = 0; rb < 2; ++rb) { accs[rb] = (f32x16){0.f, 0.f, 0.f, 0.f, 0.f, 0.f, 0.f, 0.f, 0.f, 0.f, 0.f, 0.f, 0.f, 0.f, 0.f, 0.f};
#pragma unroll
            for (int s = 0; s < 4; ++s) accs[rb] = __builtin_amdgcn_mfma_f32_32x32x16_bf16(qa[rb][s], kf[s], accs[rb], 0, 0, 0); }
        asm volatile("s_nop 15\n\ts_nop 15" : "+v"(accs[0]), "+v"(accs[1]));
        if (!lastt) idx_vec<MODE, LEVEL0, false, 0>(accs, wv, hist, cand, bm, st, psh, ppre, pact, key, t0, hi, lane, w32, shn, fmask, allsel);
        else idx_vec<MODE, LEVEL0, true, 0>(accs, wv, hist, cand, bm, st, psh, ppre, pact, key, t0, hi, lane, w32, shn, fmask, allsel);
#pragma unroll
        for (int rb = 0; rb < 2; ++rb) { accs[rb] = (f32x16){0.f, 0.f, 0.f, 0.f, 0.f, 0.f, 0.f, 0.f, 0.f, 0.f, 0.f, 0.f, 0.f, 0.f, 0.f, 0.f};
#pragma unroll
            for (int s = 0; s < 4; ++s) accs[rb] = __builtin_amdgcn_mfma_f32_32x32x16_bf16(qa[2 + rb][s], kf[s], accs[rb], 0, 0, 0); }
        asm volatile("s_nop 15\n\ts_nop 15" : "+v"(accs[0]), "+v"(accs[1]), "+v"(kf[0]), "+v"(kf[1]), "+v"(kf[2]), "+v"(kf[3]));
        if (more) { kp += (size_t)STRIDE * 256 * 64;
#pragma unroll
            for (int s = 0; s < 4; ++s) kf[s] = *(const GAS bf16x8_t*)(kp + s * 16); }
        if (!lastt) idx_vec<MODE, LEVEL0, false, 1>(accs, wv, hist, cand, bm, st, psh, ppre, pact, key, t0, hi, lane, w32, shn, fmask, allsel);
        else idx_vec<MODE, LEVEL0, true, 1>(accs, wv, hist, cand, bm, st, psh, ppre, pact, key, t0, hi, lane, w32, shn, fmask, allsel);
    }
}

__device__ __forceinline__ bool idx_find_bin(const LAS unsigned* hrow, int D, unsigned above, unsigned S, unsigned kneed, int lane, int& bsel, unsigned& abovebin, unsigned& cbin) {
    const unsigned long long ownm = __ballot(above < kneed && kneed <= S);
    if (ownm == 0ull) return false;
    const int Lo = __ffsll((long long)ownm) - 1;
    const unsigned aL = (unsigned)__shfl((int)above, Lo);
    const unsigned v = (lane < D) ? hrow[Lo * D + lane] : 0u;
    unsigned s = v;
#pragma unroll
    for (int o = 1; o < 32; o <<= 1) { const unsigned t = __shfl_down(s, o); if (lane + o < 64) s += t; }
    const unsigned excl = s - v;
    const unsigned long long hitm = __ballot(lane < D && aL + excl < kneed && kneed <= aL + s);
    const int H = __ffsll((long long)hitm) - 1;
    bsel = Lo * D + H; abovebin = (unsigned)__shfl((int)(aL + excl), H); cbin = (unsigned)__shfl((int)v, H);
    return hitm != 0ull;
}
__device__ __forceinline__ void idx_unit(Frame& F, int b, int t0) {
    int tid_ = F.tid; asm volatile("" : "+v"(tid_));
    const int tid = tid_, lane = tid & 63, wave = F.wave, r32 = lane & 31, hh = lane >> 5;
    LAS unsigned char* L = F.lds + RING_OFF;
    LAS unsigned* hist = (LAS unsigned*)(L + IX_HIST); LAS unsigned long long* cand = (LAS unsigned long long*)(L + IX_CAND); LAS unsigned* bm = (LAS unsigned*)(L + IX_BM);
    LAS float* wl = (LAS float*)(F.lds + IX_W); LAS unsigned* st = (LAS unsigned*)(F.lds + IX_ST);
    const size_t rowb = (size_t)b * SEQ; const int nst = (t0 >> 8) + 1; const bool allsel = (t0 < 256);
    const GAS bf16* kib = (const GAS bf16*)WSB(WS_KI) + rowb * 64;
    __syncthreads();
    if (tid < 128) wl[tid] = ((const GAS float*)WSF(WS_WI) + (rowb + t0) * 8)[tid];
    if (tid < 16) { st[tid] = 0u; st[16 + tid] = 21u; st[32 + tid] = 0u; st[48 + tid] = 256u; st[64 + tid] = 0u; st[80 + tid] = 1u; }
    if (tid == 0) { unsigned zz = 0u; asm volatile("" : "+v"(zz)); st[96] = zz; st[97] = zz; }
    bf16x8_t qa[4][4];
    { const int qloc = 2 * ((r32 >> 2) & 1) + (r32 >> 4), head = (r32 & 3) + 4 * ((r32 >> 3) & 1);
      const GAS bf16* qp = (const GAS bf16*)WSB(WS_QI) + (rowb + t0 + qloc) * 512 + head * 64 + hh * 8;
#pragma unroll
      for (int rb = 0; rb < 4; ++rb)
#pragma unroll
        for (int s = 0; s < 4; ++s) qa[rb][s] = *(const GAS bf16x8_t*)(qp + (size_t)rb * 4 * 512 + s * 16); }
    __syncthreads();
    bool exact = allsel || nst < IX_SMIN;
    if (!exact) {
        { unsigned zz = 0u; asm volatile("" : "+v"(zz)); const v4u z4 = {zz, zz, zz, zz};
          for (int i = tid; i < 16 * 2048 / 4; i += NWAVES * 64) ((LAS v4u*)hist)[i] = z4; }
        __syncthreads();
        idx_pass<3, true, IX_SSTRIDE>(F, qa, kib, t0, nst, wave, lane, 0, 0u, false);
        __syncthreads();
#pragma unroll 1
        for (int qq = 0; qq < 2; ++qq) { const int ql = 2 * wave + qq; const LAS unsigned* hq = hist + ql * 2048 + lane * 32;
            unsigned tot = 0u;
            for (int dd = 0; dd < 32; ++dd) tot += hq[(dd + lane) & 31];
            unsigned S = tot;
#pragma unroll
            for (int o = 1; o < 64; o <<= 1) { const unsigned v = __shfl_down(S, o); if (lane + o < 64) S += v; }
            const unsigned above = S - tot; const unsigned total = (unsigned)__shfl((int)S, 0);
            if (total < (unsigned)IX_STOT) { if (lane == 0) __hip_atomic_fetch_or(st + 96, 1u, __ATOMIC_RELAXED, __HIP_MEMORY_SCOPE_WORKGROUP); continue; }
            const unsigned slo = total < (unsigned)IX_SLO ? total : (unsigned)IX_SLO;
#pragma unroll
            for (int which = 0; which < 2; ++which) { const unsigned kneed = which == 0 ? (unsigned)IX_SHI : slo;
                int bsel = 0; unsigned ab_, cb_;
                if (idx_find_bin(hist + ql * 2048, 32, above, S, kneed, lane, bsel, ab_, cb_) && lane == 0) {
                    if (which == 0) { st[32 + ql] = (unsigned)(IX_FBASE + bsel); if (bsel >= 2047) __hip_atomic_fetch_or(st + 96, 2u, __ATOMIC_RELAXED, __HIP_MEMORY_SCOPE_WORKGROUP); }
                    else { st[64 + ql] = (unsigned)(IX_FBASE + bsel); if (bsel <= 0) __hip_atomic_fetch_or(st + 96, 4u, __ATOMIC_RELAXED, __HIP_MEMORY_SCOPE_WORKGROUP); } } }
            LDS_WAIT(); asm volatile("" ::: "memory");
            if (lane == 0) { const unsigned w = st[32 + ql] - st[64 + ql]; st[16 + ql] = w; if (w > (unsigned)IX_ZMAX) __hip_atomic_fetch_or(st + 96, 8u, __ATOMIC_RELAXED, __HIP_MEMORY_SCOPE_WORKGROUP); }
        }
        __syncthreads();
        exact = (st[96] != 0u);
        const unsigned why = st[96];
        __syncthreads();
        if (!exact) {
            idx_pass<2, false>(F, qa, kib, t0, nst, wave, lane, 0, 0u, false);
            __syncthreads();
#pragma unroll 1
            for (int qq = 0; qq < 2; ++qq) { const int ql = 2 * wave + qq;
                int members = 0;
                for (int w = lane; w < nst * 8; w += 64) members += __popc(bm[ql * 512 + w]);
#pragma unroll
                for (int o = 32; o > 0; o >>= 1) members += __shfl_xor(members, o);
                const int nct = (int)st[ql], need = 256 - members;
                const bool ok = members <= 256 && need <= nct && nct <= IX_CAP;
                if (lane == 0) { if (!ok) __hip_atomic_fetch_or(st + 96, 16u, __ATOMIC_RELAXED, __HIP_MEMORY_SCOPE_WORKGROUP); st[48 + ql] = (unsigned)(need > 0 ? need : 0); }
            }
            __syncthreads();
            exact = (st[96] != 0u);
            __syncthreads();
        }
        if (exact) {
#ifdef IX_SPIN
            if (why & IX_SPIN) { const long long w1 = wall_clock64(); while (wall_clock64() - w1 < 4000) __builtin_amdgcn_s_sleep(4); }
#endif
            if (tid < 16) { st[tid] = 0u; st[16 + tid] = 21u; st[32 + tid] = 0u; st[48 + tid] = 256u; st[64 + tid] = 0u; st[80 + tid] = 1u; }
            __syncthreads();
        }
    }
    const bool zone = !exact;
    if (exact && !allsel) {
#pragma unroll 1
        for (int level = 0; level < 3; ++level) {
            const int shn = level == 0 ? 21 : (level == 1 ? 10 : 0); const unsigned fmask = level == 2 ? 0x3ffu : 0x7ffu; const int nd = level == 2 ? 1024 : 2048;
            for (int i = tid; i < 16 * 2048 / 4; i += NWAVES * 64) ((LAS v4u*)hist)[i] = (v4u){0u, 0u, 0u, 0u};
            __syncthreads();
            { if (level == 0) idx_pass<0, true>(F, qa, kib, t0, nst, wave, lane, shn, fmask, false); else idx_pass<0, false>(F, qa, kib, t0, nst, wave, lane, shn, fmask, false); }
            __syncthreads();
            if (PROBE_SEL & 8) { for (int i = tid; i < 16 * 2048; i += NWAVES * 64) hist[i] = 0u; __syncthreads(); { if (level == 0) idx_pass<0, true>(F, qa, kib, t0, nst, wave, lane, shn, fmask, false); else idx_pass<0, false>(F, qa, kib, t0, nst, wave, lane, shn, fmask, false); } __syncthreads(); }
#pragma unroll 1
            for (int qq = 0; qq < 2; ++qq) { const int ql = 2 * wave + qq;
                if (st[80 + ql] == 0u) continue;
                const unsigned kneed = st[48 + ql]; const int D = nd >> 6; const LAS unsigned* hq = hist + ql * 2048 + lane * D;
                unsigned tot = 0u;
                for (int dd = 0; dd < D; ++dd) tot += hq[(dd + lane) & (D - 1)];
                unsigned S = tot;
#pragma unroll
                for (int o = 1; o < 64; o <<= 1) { const unsigned v = __shfl_down(S, o); if (lane + o < 64) S += v; }
                const unsigned above = S - tot;
                int bsel = 0; unsigned a = 0u, cb = 0u;
                if (idx_find_bin(hist + ql * 2048, D, above, S, kneed, lane, bsel, a, cb) && lane == 0) {
                    const unsigned opre = st[32 + ql];
                    st[32 + ql] = (level == 0) ? (unsigned)bsel : ((opre << (level == 1 ? 11 : 10)) | (unsigned)bsel);
                    st[16 + ql] = (unsigned)shn; st[48 + ql] = kneed - a; st[64 + ql] = cb;
                    st[80 + ql] = (cb > (unsigned)IX_CAP && level < 2) ? 1u : 0u; }
            }
            __syncthreads();
            unsigned more = 0u;
#pragma unroll
            for (int i = 0; i < 16; ++i) more |= st[80 + i];
            __syncthreads();
            if (more == 0u) break;
        }
    }
    if (exact) idx_pass<1, false>(F, qa, kib, t0, nst, wave, lane, 0, 0u, allsel);
    __syncthreads();
    if (!allsel) {
#pragma unroll 1
        for (int qq = 0; qq < 2; ++qq) { const int ql = 2 * wave + qq;
            const int nc = (int)(st[ql] < (unsigned)IX_CAP ? st[ql] : (unsigned)IX_CAP); int need = (int)st[48 + ql]; const int vbits = zone ? 48 : 16 + (int)st[16 + ql];
            if (need <= 0) continue;
            if (need >= nc) {
                for (int k = lane; k < nc; k += 64) { const int key = 0xffff - (int)(cand[ql * IX_CAP + k] & 0xffffull); __hip_atomic_fetch_or(bm + ql * 512 + (key >> 5), 1u << (key & 31), __ATOMIC_RELAXED, __HIP_MEMORY_SCOPE_WORKGROUP); }
                continue; }
            const int shq = (int)st[16 + ql];
            const int zsh = (zone && st[16 + ql] <= 63u) ? 48 : 50;
            const unsigned zb = zone ? ((st[32 + ql] - st[16 + ql]) << (50 - zsh)) : 0u;
            if (zone || shq >= 8) {
                LAS unsigned* sh2 = (LAS unsigned*)(F.lds + IX_SUB + wave * 1024); LAS unsigned long long* l2 = (LAS unsigned long long*)(F.lds + IX_L2 + wave * 512); LAS unsigned* c2p = (LAS unsigned*)(F.lds + IX_C2 + wave * 4);
#pragma unroll
                for (int i = 0; i < 4; ++i) sh2[4 * lane + i] = 0u;
                if (lane == 0) *c2p = 0u;
                LDS_WAIT(); asm volatile("" ::: "memory");
                const int fsh = 32 + shq - 8;
                for (int k = lane; k < nc; k += 64) { const unsigned long long ckk = cand[ql * IX_CAP + k]; const unsigned f = zone ? (((unsigned)(ckk >> zsh) - zb) & 0xffu) : ((unsigned)(ckk >> fsh) & 0xffu); __hip_atomic_fetch_add(sh2 + f, 1u, __ATOMIC_RELAXED, __HIP_MEMORY_SCOPE_WORKGROUP); }
                LDS_WAIT(); asm volatile("" ::: "memory");
                const unsigned c0 = sh2[4 * lane], c1 = sh2[4 * lane + 1], c2 = sh2[4 * lane + 2], c3 = sh2[4 * lane + 3]; const unsigned tot = c0 + c1 + c2 + c3;
                unsigned S = tot;
#pragma unroll
                for (int o = 1; o < 64; o <<= 1) { const unsigned v = __shfl_down(S, o); if (lane + o < 64) S += v; }
                const unsigned above = S - tot; const unsigned needu = (unsigned)need;
                const bool found = above < needu && needu <= S;
                unsigned a = above; unsigned bsel = 0u, cbin = 0u;
                if (a + c3 >= needu) { bsel = 3u; cbin = c3; } else { a += c3; if (a + c2 >= needu) { bsel = 2u; cbin = c2; } else { a += c2; if (a + c1 >= needu) { bsel = 1u; cbin = c1; } else { a += c1; bsel = 0u; cbin = c0; } } }
                const int src = __ffsll((long long)__ballot(found)) - 1;
                const unsigned b2 = (unsigned)__shfl((int)(4u * lane + bsel), src), need2 = (unsigned)__shfl((int)(needu - a), src), cnt2 = (unsigned)__shfl((int)cbin, src);
                if (cnt2 <= 64u) {
                    for (int k = lane; k < nc; k += 64) { const unsigned long long ckk = cand[ql * IX_CAP + k]; const unsigned f = zone ? (((unsigned)(ckk >> zsh) - zb) & 0xffu) : ((unsigned)(ckk >> fsh) & 0xffu);
                        if (f > b2) { const int key = 0xffff - (int)(ckk & 0xffffull); __hip_atomic_fetch_or(bm + ql * 512 + (key >> 5), 1u << (key & 31), __ATOMIC_RELAXED, __HIP_MEMORY_SCOPE_WORKGROUP); }
                        else if (f == b2) { const unsigned slot = __hip_atomic_fetch_add(c2p, 1u, __ATOMIC_RELAXED, __HIP_MEMORY_SCOPE_WORKGROUP); l2[slot] = ckk; } }
                    LDS_WAIT(); asm volatile("" ::: "memory");
                    if (lane < (int)cnt2) { const unsigned long long mine = l2[lane]; unsigned rank = 0u;
                        for (unsigned j = 0; j < cnt2; ++j) rank += (l2[j] > mine) ? 1u : 0u;
                        if (rank < need2) { const int key = 0xffff - (int)(mine & 0xffffull); __hip_atomic_fetch_or(bm + ql * 512 + (key >> 5), 1u << (key & 31), __ATOMIC_RELAXED, __HIP_MEMORY_SCOPE_WORKGROUP); } }
                    LDS_WAIT(); asm volatile("" ::: "memory");
                    continue;
                }
            }
#ifdef IX_SPIN2
            if (zone) { const long long w1 = wall_clock64(); while (wall_clock64() - w1 < IX_SPIN2 * 100) __builtin_amdgcn_s_sleep(4); }
#endif
            unsigned long long ck[12]; unsigned alive = 0u, selm = 0u;
#pragma unroll
            for (int c = 0; c < 12; ++c) { const int k = c * 64 + lane; ck[c] = (k < nc) ? cand[ql * IX_CAP + k] : 0ull; if (k < nc) alive |= 1u << c; }
#pragma unroll 1
            for (int bit = vbits - 1 + 16; bit >= 0; --bit) {
                if (bit >= 16 && bit < 32) continue;
                unsigned ones = 0u; int cnt1 = 0;
#pragma unroll
                for (int c = 0; c < 12; ++c) { if (c * 64 < nc) { const bool o = ((alive >> c) & 1u) && ((ck[c] >> bit) & 1ull); cnt1 += __popcll(__ballot(o)); if (o) ones |= 1u << c; } }
                if (cnt1 >= need) alive &= ones;
                else { selm |= ones; alive &= ~ones; need -= cnt1; }
            }
            selm |= alive;
#pragma unroll
            for (int c = 0; c < 12; ++c) if ((selm >> c) & 1u) { const int key = 0xffff - (int)(ck[c] & 0xffffull); __hip_atomic_fetch_or(bm + ql * 512 + (key >> 5), 1u << (key & 31), __ATOMIC_RELAXED, __HIP_MEMORY_SCOPE_WORKGROUP); }
        }
    }
    __syncthreads();
    { GAS unsigned* mg = (GAS unsigned*)(F.ws + WS_MASK) + (rowb + t0) * 512; const int nw = nst * 8;
      for (int i = tid; i < 16 * nw; i += NWAVES * 64) { const int ql = i / nw, w = i - ql * nw; mg[(size_t)ql * 512 + w] = bm[ql * 512 + w]; } }
}
typedef __bf16 bf2_t __attribute__((ext_vector_type(2)));
constexpr size_t WS_KM2 = 110 * MiB;
constexpr size_t WS_MREF = 111 * MiB;
constexpr size_t WS_LACC = 38 * MiB;
constexpr size_t WS_PO = 464 * MiB;
constexpr size_t WS_PJ0 = WS_QI, WS_PJ1 = WS_XB, WS_PJ2 = WS_XB + 32 * MiB;
__device__ __forceinline__ unsigned char* pj_base(Frame& F, int l, int j) {
    if (j == 0) return F.ws + WS_PJ0;
    return (l == 0 ? (unsigned char*)F.out : F.ws + WS_PJ1) + (size_t)(j - 1) * (32 * MiB);
}
constexpr size_t WS_LJ = WS_KI;
constexpr size_t WS_LISTS = 496 * MiB;
constexpr int CW_LCNT = 16384;
static_assert((CW_LCNT + 2 * 1024) * 4 <= (int)CTL_ZERO_BYTES, "list counters inside the memset region");
__device__ __forceinline__ int list_off(int n) { return 256 * (63 * n - (n * (n - 1)) / 2); }
constexpr int IT_K = 0, IT_V = 4 * AT_KBUF, IT_BT = IT_V + 4 * AT_VBUF, IT_QP = IT_BT + 512, IT_OST = 73728;
static_assert(IT_QP + 8 * 128 <= IT_OST && IT_OST + 8 * 4096 <= RING_BYTES, "item LDS map");

template <bool DRY = false> __device__ __forceinline__ void moba_own_unit(Frame& F, int l, int b, int h, int qt) {
    int tid_ = F.tid; asm volatile("" : "+v"(tid_));
    const int tid = tid_, lane = tid & 63, wave = F.wave, r32 = lane & 31, hi = lane >> 5;
    LAS unsigned char* L = F.lds + RING_OFF;
    LAS float* bt = (LAS float*)(L + AT_BT);
    const GAS bf16* Qg = (const GAS bf16*)WSB(WS_QA);
    const size_t rowb = (size_t)b * SEQ;
    const GAS bf16* Kh = (const GAS bf16*)WSB(WS_KA) + rowb * 512 + h * 64; const GAS bf16* Vh = (const GAS bf16*)WSB(WS_VA) + rowb * 512 + h * 64;
    const int q0w = qt * 256 + wave * 32, q = q0w + r32;
    __syncthreads();
    if (tid < 128) { const GAS float* rb = (const GAS float*)INP(I_RELB) + h; bt[tid] = (rb[t5_bucket(tid) * 16] - rb[31 * 16]) * LOG2E; }
    bf16x8_t qf[4];
    { const GAS bf16* qp = Qg + (rowb + q) * 512 + h * 64 + hi * 8;
#pragma unroll
      for (int s = 0; s < 4; ++s) qf[s] = *(const GAS bf16x8_t*)(qp + s * 16); }
    { const int n = tid >> 3, c8 = (tid & 7) * 8; const GAS float* km = (const GAS float*)WSF(WS_KM2) + (((size_t)b * NBLK + n) * 2) * 512 + h * 64 + c8;
      f32x4 a = *(const GAS f32x4*)km + *(const GAS f32x4*)(km + 512), c = *(const GAS f32x4*)(km + 4) + *(const GAS f32x4*)(km + 516);
      a = a * (1.0f / 256.0f); c = c * (1.0f / 256.0f);
      const unsigned h0 = pk2(a.x, a.y), h1 = pk2(a.z, a.w), h2 = pk2(c.x, c.y), h3 = pk2(c.z, c.w);
      const unsigned l0 = pk2(a.x - __uint_as_float(h0 << 16), a.y - __uint_as_float(h0 & 0xffff0000u)), l1 = pk2(a.z - __uint_as_float(h1 << 16), a.w - __uint_as_float(h1 & 0xffff0000u)),
                     l2 = pk2(c.x - __uint_as_float(h2 << 16), c.y - __uint_as_float(h2 & 0xffff0000u)), l3 = pk2(c.z - __uint_as_float(h3 << 16), c.w - __uint_as_float(h3 & 0xffff0000u));
      *(LAS v4u*)(L + AT_K0 + n * AT_KROW + (tid & 7) * 16) = (v4u){h0, h1, h2, h3}; *(LAS v4u*)(L + AT_K0 + AT_KBUF + n * AT_KROW + (tid & 7) * 16) = (v4u){l0, l1, l2, l3}; }
    __syncthreads();
    unsigned mlo = 0u, mhi = 0u;
    if (qt > 0) {
        f32x16 g0 = {0.f, 0.f, 0.f, 0.f, 0.f, 0.f, 0.f, 0.f, 0.f, 0.f, 0.f, 0.f, 0.f, 0.f, 0.f, 0.f}, g1 = g0;
        at_qk(g0, g1, L + AT_K0, qf, r32, hi); at_qk(g0, g1, L + AT_K0 + AT_KBUF, qf, r32, hi);
        MFMA_FENCE2(g0, g1);
#pragma unroll
        for (int r = 0; r < 16; ++r) { if (crow_(r, hi) >= qt) g0[r] = -INFINITY; if (32 + crow_(r, hi) >= qt) g1[r] = -INFINITY; }
#pragma unroll
        for (int it = 0; it < 3; ++it) {
            float bv = -INFINITY; int bn = 64;
#pragma unroll
            for (int r = 0; r < 16; ++r) if (g0[r] > bv) { bv = g0[r]; bn = crow_(r, hi); }
#pragma unroll
            for (int r = 0; r < 16; ++r) if (g1[r] > bv) { bv = g1[r]; bn = 32 + crow_(r, hi); }
            const float pv = __shfl_xor(bv, 32); const int pn = __shfl_xor(bn, 32);
            const bool tp = (pv > bv) || (pv == bv && pn < bn);
            const float wv = tp ? pv : bv; const int wn = tp ? pn : bn;
            if (wv > -INFINITY) { if (wn < 32) mlo |= 1u << wn; else mhi |= 1u << (wn - 32);
                if (hi == 0 && !DRY) { GAS unsigned* cnt = (GAS unsigned*)(F.ws + WS_CTL) + CW_LCNT + ((l * 2 + b) * 8 + h) * 64 + wn;
                    const unsigned slot = __hip_atomic_fetch_add(cnt, 1u, __ATOMIC_RELAXED, __HIP_MEMORY_SCOPE_AGENT);
                    ((GAS unsigned short*)(F.ws + WS_LISTS) + ((size_t)(b * 8 + h) << 19))[list_off(wn) + slot] = (unsigned short)(q | (it << 14)); } }
#pragma unroll
            for (int r = 0; r < 16; ++r) { if (crow_(r, hi) == wn) g0[r] = -INFINITY; if (32 + crow_(r, hi) == wn) g1[r] = -INFINITY; }
        }
    }
    __syncthreads();
    v4u kr, vr;
    at_load(Kh, Vh, 4 * qt, tid, kr, vr);
    at_store(L + AT_K0, L + AT_V0, tid, kr, vr);
    __syncthreads();
    float m = -1e30f, lsum = 0.f;
    f32x16 o0 = {0.f, 0.f, 0.f, 0.f, 0.f, 0.f, 0.f, 0.f, 0.f, 0.f, 0.f, 0.f, 0.f, 0.f, 0.f, 0.f}, o1 = o0;
#pragma unroll 1
    for (int tt = 0; tt < 4; ++tt) {
        const int t = 4 * qt + tt, cur = tt & 1;
        if (tt + 1 < 4) at_load(Kh, Vh, t + 1, tid, kr, vr);
        const int nall = q - t * 64 + 1;
        const unsigned wlo = nall >= 32 ? 0xffffffffu : (nall <= 0 ? 0u : ((1u << nall) - 1u)), whi = nall >= 64 ? 0xffffffffu : (nall <= 32 ? 0u : ((1u << (nall - 32)) - 1u));
        if (__any((wlo | whi) != 0u)) {
            const LAS unsigned char* kb = L + AT_K0 + cur * AT_KBUF; const LAS unsigned char* vb = L + AT_V0 + cur * AT_VBUF;
            f32x16 p0 = {0.f, 0.f, 0.f, 0.f, 0.f, 0.f, 0.f, 0.f, 0.f, 0.f, 0.f, 0.f, 0.f, 0.f, 0.f, 0.f}, p1 = p0;
            at_qk(p0, p1, kb, qf, r32, hi);
            MFMA_FENCE2(p0, p1);
#pragma unroll
            for (int r = 0; r < 16; ++r) { const int d0 = q - (t * 64 + crow_(r, hi)), d1 = d0 - 32;
                const float b0 = ((unsigned)d0 < 128u) ? bt[d0] : 0.f, b1 = ((unsigned)d1 < 128u) ? bt[d1] : 0.f;
                p0[r] = p0[r] * AT_C2 + b0; p1[r] = p1[r] * AT_C2 + b1; }
            float mx;
            { float ma = max3_(p0[0], p1[0], p0[1]), mb = max3_(p1[1], p0[2], p1[2]), mc = max3_(p0[3], p1[3], p0[4]), md = max3_(p1[4], p0[5], p1[5]);
              ma = max3_(ma, p0[6], p1[6]); mb = max3_(mb, p0[7], p1[7]); mc = max3_(mc, p0[8], p1[8]); md = max3_(md, p0[9], p1[9]);
              ma = max3_(ma, p0[10], p1[10]); mb = max3_(mb, p0[11], p1[11]); mc = max3_(mc, p0[12], p1[12]); md = max3_(md, p0[13], p1[13]);
              ma = max3_(ma, p0[14], p1[14]); mb = max3_(mb, p0[15], p1[15]); mx = max3_(ma, mb, mc); mx = max3_(mx, md, md); }
            mx = max3_(mx, __shfl_xor(mx, 32), mx);
            if (__any(mx > m + AT_THR)) {
                const float mn = fmaxf(m, mx); const float al = __builtin_amdgcn_exp2f(m - mn);
                MFMA_FENCE2(o0, o1);
#pragma unroll
                for (int r = 0; r < 16; ++r) { o0[r] *= al; o1[r] *= al; }
                lsum *= al; m = mn;
            }
            const unsigned wl = wlo >> (4 * hi), wh = whi >> (4 * hi);
            float lq[4] = {0.f, 0.f, 0.f, 0.f};
#pragma unroll
            for (int r = 0; r < 16; ++r) { const int cb = (r & 3) + 8 * (r >> 2);
                const float e0 = __uint_as_float(and_sel(__builtin_amdgcn_exp2f(p0[r] - m), wl, cb)), e1 = __uint_as_float(and_sel(__builtin_amdgcn_exp2f(p1[r] - m), wh, cb));
                p0[r] = e0; p1[r] = e1; lq[r & 1] += e0; lq[2 + (r & 1)] += e1; }
            lsum += (lq[0] + lq[1]) + (lq[2] + lq[3]);
            bf16x8_t pb[4];
#pragma unroll
            for (int sg = 0; sg < 4; ++sg) { union { bf16x8_t v; unsigned u[4]; } pk;
#pragma unroll
                for (int j = 0; j < 4; ++j) { const int r = 8 * (sg & 1) + 2 * j; pk.u[j] = (sg < 2) ? pg8::cvt_pk_bf16(p0[r], p0[r + 1]) : pg8::cvt_pk_bf16(p1[r], p1[r + 1]); }
                pb[sg] = pk.v; }
            at_pv(o0, o1, vb, pb, r32, hi);
        }
        if (tt + 1 < 4) at_store(L + AT_K0 + (cur ^ 1) * AT_KBUF, L + AT_V0 + (cur ^ 1) * AT_VBUF, tid, kr, vr);
        __syncthreads();
    }
    MFMA_FENCE2(o0, o1);
    lsum += __shfl_xor(lsum, 32);
    if (hi == 0 && !DRY) { ((GAS float*)WSF(WS_MREF))[(rowb + q) * 8 + h] = m; ((GAS float*)WSF(WS_LACC))[(rowb + q) * 8 + h] = lsum; }
    LAS bf16* ost = (LAS bf16*)(L + AT_OST + wave * 4096);
#pragma unroll
    for (int r = 0; r < 16; ++r) { ost[r32 * 64 + crow_(r, hi)] = (bf16)f2bf(o0[r]); ost[r32 * 64 + 32 + crow_(r, hi)] = (bf16)f2bf(o1[r]); }
    LDS_WAIT(); asm volatile("" ::: "memory");
    GAS bf16* Og = (GAS bf16*)WSB(WS_PO) + (rowb + q0w) * 512 + h * 64;
#pragma unroll
    for (int i = 0; i < 4; ++i) { const int c = i * 64 + lane, row = c >> 3, ch = c & 7; const v4u ov = *(const LAS v4u*)(ost + row * 64 + ch * 8); if (!DRY || (ov.x == 0x12345678u && ov.y == 0x9abcdef0u)) *(GAS v4u*)(Og + (size_t)row * 512 + ch * 8) = ov; }
}

template <bool DRY = false> __device__ __forceinline__ void moba_item_unit(Frame& F, int l, int b, int h, int n) {
    int tid_ = F.tid; asm volatile("" : "+v"(tid_));
    const int tid = tid_, lane = tid & 63, wave = F.wave, r32 = lane & 31, hi = lane >> 5;
    LAS unsigned char* L = F.lds + RING_OFF;
    LAS float* bt = (LAS float*)(L + IT_BT);
    const size_t rowb = (size_t)b * SEQ;
    const int cnt = (int)((const GAS unsigned*)(F.ws + WS_CTL))[CW_LCNT + ((l * 2 + b) * 8 + h) * 64 + n];
    if (cnt == 0) return;
    const GAS bf16* Kh = (const GAS bf16*)WSB(WS_KA) + rowb * 512 + h * 64; const GAS bf16* Vh = (const GAS bf16*)WSB(WS_VA) + rowb * 512 + h * 64;
    __syncthreads();
    if (tid < 128) { const GAS float* rb = (const GAS float*)INP(I_RELB) + h; bt[tid] = (rb[t5_bucket(tid) * 16] - rb[31 * 16]) * LOG2E; }
#pragma unroll
    for (int t = 0; t < 4; ++t) { v4u kr, vr; at_load(Kh, Vh, 4 * n + t, tid, kr, vr); at_store(L + IT_K + t * AT_KBUF, L + IT_V + t * AT_VBUF, tid, kr, vr); }
    __syncthreads();
    const GAS unsigned short* lst = (const GAS unsigned short*)(F.ws + WS_LISTS) + ((size_t)(b * 8 + h) << 19) + list_off(n);
    LAS int* qpl = (LAS int*)(L + IT_QP + wave * 128);
    LAS float* ostf = (LAS float*)(L + IT_OST + wave * 4096);
    const int ngrp = (cnt + 31) >> 5;
#pragma unroll 1
    for (int g = wave; g < ngrp; g += NWAVES) {
        const int li = g * 32 + r32; const bool valid = li < cnt;
        const int ent = valid ? (int)lst[li] : (int)lst[g * 32];
        const int q = ent & 0x3fff;
        if (hi == 0) qpl[r32] = valid ? ent : -1;
        bf16x8_t qf[4];
        { const GAS bf16* qp = (const GAS bf16*)WSB(WS_QA) + (rowb + q) * 512 + h * 64 + hi * 8;
#pragma unroll
          for (int s = 0; s < 4; ++s) qf[s] = *(const GAS bf16x8_t*)(qp + s * 16); }
        const float mref = ((const GAS float*)WSF(WS_MREF))[(rowb + q) * 8 + h];
        const bool near = __any(q < 256 * (n + 1) + 128);
        float lsum = 0.f;
        f32x16 o0 = {0.f, 0.f, 0.f, 0.f, 0.f, 0.f, 0.f, 0.f, 0.f, 0.f, 0.f, 0.f, 0.f, 0.f, 0.f, 0.f}, o1 = o0;
#pragma unroll 1
        for (int t = 0; t < 4; ++t) {
            const LAS unsigned char* kb = L + IT_K + t * AT_KBUF; const LAS unsigned char* vb = L + IT_V + t * AT_VBUF;
            f32x16 p0 = {0.f, 0.f, 0.f, 0.f, 0.f, 0.f, 0.f, 0.f, 0.f, 0.f, 0.f, 0.f, 0.f, 0.f, 0.f, 0.f}, p1 = p0;
            at_qk(p0, p1, kb, qf, r32, hi);
            MFMA_FENCE2(p0, p1);
            float lq[4] = {0.f, 0.f, 0.f, 0.f};
            if (near) {
#pragma unroll
                for (int r = 0; r < 16; ++r) { const int d0 = q - ((4 * n + t) * 64 + crow_(r, hi)), d1 = d0 - 32;
                    const float b0 = ((unsigned)d0 < 128u) ? bt[d0] : 0.f, b1 = ((unsigned)d1 < 128u) ? bt[d1] : 0.f;
                    const float e0 = __builtin_amdgcn_exp2f(fminf(p0[r] * AT_C2 + b0 - mref, 60.f)), e1 = __builtin_amdgcn_exp2f(fminf(p1[r] * AT_C2 + b1 - mref, 60.f));
                    p0[r] = e0; p1[r] = e1; lq[r & 1] += e0; lq[2 + (r & 1)] += e1; }
            } else {
#pragma unroll
                for (int r = 0; r < 16; ++r) { const float e0 = __builtin_amdgcn_exp2f(fminf(__builtin_fmaf(p0[r], AT_C2, -mref), 60.f)), e1 = __builtin_amdgcn_exp2f(fminf(__builtin_fmaf(p1[r], AT_C2, -mref), 60.f));
                    p0[r] = e0; p1[r] = e1; lq[r & 1] += e0; lq[2 + (r & 1)] += e1; }
            }
            lsum += (lq[0] + lq[1]) + (lq[2] + lq[3]);
            bf16x8_t pb[4];
#pragma unroll
            for (int sg = 0; sg < 4; ++sg) { union { bf16x8_t v; unsigned u[4]; } pk;
#pragma unroll
                for (int j = 0; j < 4; ++j) { const int r = 8 * (sg & 1) + 2 * j; pk.u[j] = (sg < 2) ? pg8::cvt_pk_bf16(p0[r], p0[r + 1]) : pg8::cvt_pk_bf16(p1[r], p1[r + 1]); }
                pb[sg] = pk.v; }
            at_pv(o0, o1, vb, pb, r32, hi);
        }
        MFMA_FENCE2(o0, o1);
        lsum += __shfl_xor(lsum, 32);
        if (hi == 0 && valid && !DRY) ((GAS float*)WSF(WS_LJ))[((size_t)(ent >> 14) * T + rowb + q) * 8 + h] = lsum;
        LAS bf16* ost = (LAS bf16*)ostf;
#pragma unroll
        for (int r = 0; r < 16; ++r) { ost[r32 * 64 + crow_(r, hi)] = (bf16)f2bf(o0[r]); ost[r32 * 64 + 32 + crow_(r, hi)] = (bf16)f2bf(o1[r]); }
        LDS_WAIT(); asm volatile("" ::: "memory");
#pragma unroll
        for (int i = 0; i < 4; ++i) { const int c = i * 64 + lane, row = c >> 3, ch = c & 7; const int er = qpl[row];
            if (er >= 0 && !DRY) { const int j = er >> 14; GAS bf16* pj = (GAS bf16*)pj_base(F, l, j);
                *(GAS v4u*)(pj + (rowb + (er & 0x3fff)) * 512 + h * 64 + ch * 8) = *(const LAS v4u*)(ost + row * 64 + ch * 8); } }
        LDS_WAIT(); asm volatile("" ::: "memory");
    }
}
__device__ __forceinline__ void moba_fin_row(Frame& F, int layer, int m, int lane) {
    const int nsel = ((m & (SEQ - 1)) >> 8) < 3 ? ((m & (SEQ - 1)) >> 8) : 3;
    const int hd = lane >> 3;
    float l = ((const GAS float*)WSF(WS_LACC))[(size_t)m * 8 + hd];
    v4u v = ((const GAS v4u*)((const GAS bf16*)WSB(WS_PO) + (size_t)m * 512))[lane];
    float acc[8] = { __uint_as_float(v.x << 16), __uint_as_float(v.x & 0xffff0000u), __uint_as_float(v.y << 16), __uint_as_float(v.y & 0xffff0000u),
                     __uint_as_float(v.z << 16), __uint_as_float(v.z & 0xffff0000u), __uint_as_float(v.w << 16), __uint_as_float(v.w & 0xffff0000u) };
#pragma unroll
    for (int j = 0; j < 3; ++j) if (j < nsel) {
        l += ((const GAS float*)WSF(WS_LJ))[((size_t)j * T + m) * 8 + hd];
        const v4u w = ((const GAS v4u*)((const GAS bf16*)pj_base(F, layer, j) + (size_t)m * 512))[lane];
        acc[0] += __uint_as_float(w.x << 16); acc[1] += __uint_as_float(w.x & 0xffff0000u); acc[2] += __uint_as_float(w.y << 16); acc[3] += __uint_as_float(w.y & 0xffff0000u);
        acc[4] += __uint_as_float(w.z << 16); acc[5] += __uint_as_float(w.z & 0xffff0000u); acc[6] += __uint_as_float(w.w << 16); acc[7] += __uint_as_float(w.w & 0xffff0000u); }
    const float inv = 1.0f / l;
    v4u o; o.x = pk2(acc[0] * inv, acc[1] * inv); o.y = pk2(acc[2] * inv, acc[3] * inv); o.z = pk2(acc[4] * inv, acc[5] * inv); o.w = pk2(acc[6] * inv, acc[7] * inv);
    ((GAS v4u*)((GAS bf16*)WSB(WS_QA) + (size_t)m * 512))[lane] = o;
}
__global__ void __launch_bounds__(NWAVES * 64, 2) fwd(Args args) {
    extern __shared__ __attribute__((aligned(16))) unsigned char lds[];
    Frame F;
    F.lds = (LAS unsigned char*)lds;
        F.tid = threadIdx.x; F.lane = F.tid & 63; F.wave = __builtin_amdgcn_readfirstlane(F.tid >> 6);
    F.G = gridDim.x; F.bid = blockIdx.x;
    F.a = (const __attribute__((address_space(4))) Args*)__builtin_amdgcn_kernarg_segment_ptr(); F.ws = args.ws; F.out = args.out;
    unsigned char* ws = args.ws;
    for (int u = F.tid; u < (LDS_BYTES - LDSCTL_OFF) / 4; u += NWAVES * 64) ((LAS unsigned*)(F.lds + LDSCTL_OFF))[u] = 0u;
    __syncthreads();
    {
        volatile LAS unsigned* pw = (volatile LAS unsigned*)(F.lds + MISC_OFF) + 64;
        const unsigned hw = __builtin_amdgcn_s_getreg((4 << 0) | (4 << 6) | (1 << 11));
        if (F.lane == 0) pw[F.wave] = hw & 3u;
        __syncthreads();
        const unsigned my = pw[F.wave]; unsigned cnts = 0, rank = 0;
#pragma unroll
        for (int w = 0; w < NWAVES; ++w) { const unsigned s = pw[w]; cnts += 1u << (8 * s); if (w < F.wave && s == my) ++rank; }
#ifdef BAD_ROLES
        F.gw = __builtin_amdgcn_readfirstlane((cnts == 0x02020202u) ? (int)((my >> 1) * 4 + (my & 1) * 2 + rank) : F.wave);
#else
        F.gw = __builtin_amdgcn_readfirstlane((cnts == 0x02020202u) ? (int)(rank * 4 + my) : F.wave);
#endif
        __syncthreads();
    }
    XcdBarrier bar; bar.bar = (unsigned*)(ws + WS_CTL) + CW_BAR; bar.x = 0; bar.st = nullptr;
    if (ONE_LAUNCH) bar = xcd_barrier_post((unsigned*)(ws + WS_CTL) + CW_BAR, (volatile LAS unsigned*)(F.lds + MISC_OFF) + 8);
#define GRID_BAR() do { if (ONE_LAUNCH) xcd_barrier(bar); } while (0)
    const int lo = args.ph_lo, hi = args.ph_hi;
#ifndef PH_MASK
#define PH_MASK 0xfff
#endif
#define IN(k) (((PH_MASK >> ((k) % PH_PER_LAYER == 0 && (k) == 2 * PH_PER_LAYER ? 11 : (k) % PH_PER_LAYER)) & 1) && lo <= (k) && (k) < hi)
#define BOTH(k) (IN(k) && IN((k) + 1))
#define GEMM_TID ((F.gw << 6) | F.lane)
#define DYN_CTR(k) ((unsigned*)(F.ws + WS_CTL) + CW_DYN + 32 * (k))
#define DYN_FETCH(dst, k) do { __syncthreads(); if (F.tid == 0) *((volatile LAS unsigned*)(F.lds + MISC_OFF) + 32) = atomicAdd(DYN_CTR(k), 1u); __syncthreads(); \
        dst = (int)__builtin_amdgcn_readfirstlane(*((volatile LAS unsigned*)(F.lds + MISC_OFF) + 32)); } while (0)
#define LAUNDER() do { asm volatile("" : "+v"(F.tid)); F.lane = F.tid & 63; F.wave = __builtin_amdgcn_readfirstlane(F.tid >> 6); F.ws = launder_u(F.ws); F.out = launder_u(F.out); F.a = launder_u(F.a); F.bid = launder_i(F.bid); F.G = launder_i(F.G); F.gw = launder_i(F.gw); } while (0)
    LAS unsigned char* ring = F.lds + RING_OFF;
    for (int l = 0; l < 2; ++l) {
        const int P = l * PH_PER_LAYER;
#ifdef DBG_DUMP
        if (lo == DBG_PHASE && l == 0) { for (int u = F.bid; u < T; u += F.G) { F.out[(size_t)u * DM + F.tid] = bf2f(WSB(DBG_DUMP)[(size_t)u * DBG_PITCH + F.tid]); F.out[(size_t)u * DM + 512 + F.tid] = 0.f; } }
        if (lo >= DBG_PHASE && lo < 2 * PH_PER_LAYER) continue;
#endif
        if (IN(P + 0)) { LAUNDER(); p_prologue(F, l); if (PROBE_SEL & 128) { VM_WAIT(); __syncthreads(); p_prologue(F, l); } if (BOTH(P + 0)) GRID_BAR(); }
        if (IN(P + 1)) { LAUNDER();
            pg8::Gemm g{WSB(WS_XB), WSB(WS_W_IN), T, NIN_T, DM}; pg8::StaticOrder S; S.init(T, NIN_T, F.G, F.bid);
            pg8::EpiInproj E{WSB(WS_QA), WSB(WS_KI), WSF(WS_WI), SSQ_MIX(l), WSF(WS_KM2)};
            pg8::gemm_phase<pg8::EpiInproj, pg8::StaticOrder, true, PG8_SP2>(ring, g, S, E, GEMM_TID);
            if (PROBE_SEL & 32) { VM_WAIT(); __syncthreads(); LAUNDER(); pg8::gemm_phase<pg8::EpiInproj, pg8::StaticOrder, true, PG8_SP2>(ring, g, S, E, GEMM_TID); }
            if (BOTH(P + 1)) GRID_BAR();
        }
        if (IN(P + 2)) { LAUNDER();
#ifndef FAST_DSA
#define FAST_DSA 1
#endif
            if ((PROBE_SEL & 1024) && F.bid < 256) { for (int r = 0; r < 4; ++r) { const int i = r * 256 + F.bid; moba_own_unit<true>(F, l, (i & 15) >> 3, i & 7, i >> 4); } __syncthreads(); }
            if (FAST_MOBA == 2 && F.bid < 256) { for (int r = 0; r < 4; ++r) { const int i = r * 256 + F.bid; moba_own_unit<false>(F, l, (i & 15) >> 3, i & 7, i >> 4); } __syncthreads(); }
            for (int rep = 0; rep < ((PROBE_SEL & 64) ? 2 : 1); ++rep)
            for (int u = F.bid; u < 2 * RGC; u += F.G) rg_unit<false>(F, l, u / RGC, u % RGC);
            if (FAST_DSA) {
                for (;;) { int i; DYN_FETCH(i, 2 * l); if (i >= 2048) break; const int stt = 63 - (i >> 5), j = i & 31; idx_unit(F, j >> 4, stt * 256 + (j & 15) * 16); }
                __syncthreads();
            }
            if (BOTH(P + 2)) GRID_BAR();
        }
        if (IN(P + 3)) { LAUNDER();
            #ifndef MIX2_SEL
#define MIX2_SEL 7
#endif
            if (MIX2_SEL & 1) for (int u = F.bid; u < 2 * RGC; u += F.G) rg_unit<true>(F, l, u / RGC, u % RGC);
            if (FAST_MOBA == 2 && F.bid < 256) {
                if (PROBE_SEL & 2048) for (int r = 0; r < 4; ++r) { const int g = F.bid; const int i = r * 256 + ((r & 1) ? 255 - g : g); moba_item_unit<true>(F, l, (i & 15) >> 3, i & 7, i >> 4); }
                for (int r = 0; r < 4; ++r) { const int g = F.bid; const int i = r * 256 + ((r & 1) ? 255 - g : g); moba_item_unit<false>(F, l, (i & 15) >> 3, i & 7, i >> 4); }
                __syncthreads();
            }
            if (FAST_MOBA == 1 && (MIX2_SEL & 2)) {
                if (PROBE_SEL & 1) { for (int r = 0; r < 4; ++r) { const int g = F.bid % 256; const int i = r * 256 + ((r & 1) ? 255 - g : g); if (F.bid >= 256) break;
                    const int qt = 63 - (i >> 4), bh = i & 15; attn_unit<0, true>(F, bh >> 3, bh & 7, qt); } }
                for (int r = 0; r < 4; ++r) { const int g = F.bid % 256; const int i = r * 256 + ((r & 1) ? 255 - g : g); if (F.bid >= 256) break;
                    const int qt = 63 - (i >> 4), bh = i & 15; attn_unit<0>(F, bh >> 3, bh & 7, qt); }
                __syncthreads();
            }
            if (FAST_DSA && (MIX2_SEL & 4)) {
                if (PROBE_SEL & 2) { for (int r = 0; r < 4; ++r) { const int g = F.bid % 256; const int i = r * 256 + ((r & 1) ? 255 - g : g); if (F.bid >= 256) break;
                    const int qt = 63 - (i >> 4), bh = i & 15; dsa_attn2_unit<true>(F, bh >> 3, bh & 7, qt); } }
                for (;;) { int i; DYN_FETCH(i, 2 * l + 1); if (i >= 1024) break;
                    const int qt = 63 - (i >> 4), bh = i & 15; dsa_attn2_unit<false>(F, bh >> 3, bh & 7, qt); }
                __syncthreads();
            }
            if (!(FAST_MOBA && FAST_DSA)) for (int u = F.bid; u < T; u += F.G) { const int b = u & 1, t = u >> 1; if (FAST_MOBA == 0 && (MIX2_SEL & 2)) moba_unit(F, b, t); if (!FAST_DSA && (MIX2_SEL & 4)) dsa_unit(F, b, t); }
            for (int u = F.bid; u < T; u += F.G) { if (!(MIX2_SEL & 2)) WSB(WS_QA)[(size_t)u * 512 + F.tid] = 0; if (!(MIX2_SEL & 4)) WSB(WS_QB)[(size_t)u * 512 + F.tid] = 0; if (!(MIX2_SEL & 1)) WSB(WS_YC)[(size_t)u * 512 + F.tid] = 0; }
            if (BOTH(P + 3)) GRID_BAR();
        }

        if (IN(P + 4)) { LAUNDER();
            if (FAST_MOBA == 2) { const int gw = F.bid * NWAVES + F.wave, NGW = F.G * NWAVES; const float* xin = (l == 0) ? INP(I_X) : (const float*)F.out;
                for (int m = gw; m < T; m += NGW) moba_fin_row(F, l, m, F.lane);
                if (l != 0) {
                    GRID_BAR();
                    for (int m = gw; m < T; m += NGW) norm_row(xin + (size_t)m * DM, WSB(WS_XB) + (size_t)m * DM, SSQ_MIX(l) + m, F.lane); } }
            if (BOTH(P + 4)) GRID_BAR();
        }
        if (IN(P + 5)) { LAUNDER();
            pg8::Gemm g{WSB(WS_XB), WSB(WS_W_G), T, 3072, DM}; pg8::StaticOrder S; S.init(T, 3072, F.G, F.bid);
            pg8::EpiGates E{WSB(WS_G), SSQ_MIX(l)};
            pg8::gemm_phase<pg8::EpiGates, pg8::StaticOrder, true, PG8_SP2>(ring, g, S, E, GEMM_TID);
            if (PROBE_SEL & 32) { VM_WAIT(); __syncthreads(); LAUNDER(); pg8::gemm_phase<pg8::EpiGates, pg8::StaticOrder, true, PG8_SP2>(ring, g, S, E, GEMM_TID); }
            if (BOTH(P + 5)) GRID_BAR();
        }
        if (IN(P + 6)) { LAUNDER();
            pg8::StaticOrder S; S.init(T, DM, F.G, F.bid);
            { pg8::Gemm g{WSB(WS_QA), WSB(WS_W_PA), T, DM, DH}; pg8::EpiMerge<true> E{WSB(WS_G), WSB(WS_MERGED)}; pg8::gemm_phase<pg8::EpiMerge<true>, pg8::StaticOrder, true, PG8_SP2>(ring, g, S, E, GEMM_TID); }
#ifndef MERGE_CALLS
#define MERGE_CALLS 3
#endif
            VM_WAIT(); __syncthreads(); LAUNDER();
            if (MERGE_CALLS >= 2) { pg8::Gemm g{WSB(WS_QB), WSB(WS_W_PB), T, DM, DH}; pg8::EpiMerge<false> E{WSB(WS_G) + (size_t)T * 1024, WSB(WS_MERGED)}; pg8::gemm_phase<pg8::EpiMerge<false>, pg8::StaticOrder, true, PG8_SP2>(ring, g, S, E, GEMM_TID); }
            VM_WAIT(); __syncthreads(); LAUNDER();
            if (MERGE_CALLS >= 3) { pg8::Gemm g{WSB(WS_YC), WSB(WS_W_PC), T, DM, DH}; pg8::EpiMerge<false> E{WSB(WS_G) + (size_t)2 * T * 1024, WSB(WS_MERGED)}; pg8::gemm_phase<pg8::EpiMerge<false>, pg8::StaticOrder, true, PG8_SP2>(ring, g, S, E, GEMM_TID); }
            if (BOTH(P + 6)) GRID_BAR();
        }
        if (IN(P + 7)) { LAUNDER();
            pg8::Gemm g{WSB(WS_MERGED), WSB(WS_W_O), T, DM, DM}; pg8::StaticOrder S; S.init(T, DM, F.G, F.bid);
            pg8::EpiResid E{(l == 0) ? INP(I_X) : (const float*)F.out, F.out, WSB(WS_XB), SSQ_MLP(l)};
            pg8::gemm_phase<pg8::EpiResid, pg8::StaticOrder, true, PG8_SP2>(ring, g, S, E, GEMM_TID);
            if (BOTH(P + 7)) GRID_BAR();
        }
        if (IN(P + 8)) {   }
        if (IN(P + 9)) { LAUNDER();
            pg8::Gemm g{WSB(WS_XB), WSB(WS_W_UP), T, DFF, DM}; pg8::StaticOrder S; S.init(T, DFF, F.G, F.bid);
            pg8::EpiUp E{WSB(WS_H), SSQ_MLP(l)};
            pg8::gemm_phase<pg8::EpiUp, pg8::StaticOrder, true, PG8_SP2>(ring, g, S, E, GEMM_TID);
            if (PROBE_SEL & 32) { VM_WAIT(); __syncthreads(); LAUNDER(); pg8::gemm_phase<pg8::EpiUp, pg8::StaticOrder, true, PG8_SP2>(ring, g, S, E, GEMM_TID); }
            if (BOTH(P + 9)) GRID_BAR();
        }
        if (IN(P + 10)) { LAUNDER();
            pg8::Gemm g{WSB(WS_H), WSB(WS_W_DN), T, DM, DFF}; pg8::StaticOrder S; S.init(T, DM, F.G, F.bid);
            pg8::EpiResid E{(const float*)F.out, F.out, (l == 0) ? WSB(WS_XB) : (bf16*)nullptr, (float*)(F.ws + WS_CTL) + CW_SSQ + T};
            pg8::gemm_phase<pg8::EpiResid, pg8::StaticOrder, true, PG8_SP2>(ring, g, S, E, GEMM_TID);
            if (BOTH(P + 10)) GRID_BAR();
        }
    }
    if (IN(2 * PH_PER_LAYER)) { LAUNDER(); p_final(F); }
#undef IN
#undef BOTH
#undef GRID_BAR
}

extern "C" void kernel_launch(void* const* d_in, const int* in_sizes, int n_in, void* d_out, int out_size, void* d_ws, size_t ws_size, hipStream_t stream) {
    static int grid = 0;
    if (grid == 0) {
        if (n_in != 19 || in_sizes[0] != T * DM || out_size != T * DM || ws_size < WS_END) { fprintf(stderr, "kernel_launch: unexpected shapes (n_in %d, in0 %d, out %d, ws %zu)\n", n_in, n_in > 0 ? in_sizes[0] : -1, out_size, ws_size); grid = -1; return; }
        int dev = 0, cus = 0, per_cu = 0;
        if (hipGetDevice(&dev) != hipSuccess || hipDeviceGetAttribute(&cus, hipDeviceAttributeMultiprocessorCount, dev) != hipSuccess) { grid = -1; return; }
        if (hipFuncSetAttribute((const void*)fwd, hipFuncAttributeMaxDynamicSharedMemorySize, LDS_BYTES) != hipSuccess) { fprintf(stderr, "kernel_launch: hipFuncSetAttribute failed\n"); grid = -1; return; }
        if (hipOccupancyMaxActiveBlocksPerMultiprocessor(&per_cu, (const void*)fwd, NWAVES * 64, LDS_BYTES) != hipSuccess || per_cu < 1) { fprintf(stderr, "kernel_launch: occupancy query says %d\n", per_cu); }
        (void)hipGetLastError();
        grid = cus;
    }
    if (grid < 0) return;
    if (hipMemsetAsync((char*)d_ws + WS_CTL, 0, CTL_ZERO_BYTES, stream) != hipSuccess) return;
    Args a{};
    for (int i = 0; i < 19; ++i) a.in[i] = (const float*)d_in[i];
    a.out = (float*)d_out; a.ws = (unsigned char*)d_ws;
    if (ONE_LAUNCH) { a.ph_lo = 0; a.ph_hi = N_PHASES; hipLaunchKernelGGL(fwd, dim3(grid), dim3(NWAVES * 64), LDS_BYTES, stream, a); }
    else for (int p = 0; p < N_PHASES; ++p) { a.ph_lo = p; a.ph_hi = p + 1; hipLaunchKernelGGL(fwd, dim3(grid), dim3(NWAVES * 64), LDS_BYTES, stream, a); }
}
```

```cpp
#include <hip/hip_runtime.h>
#include <cstdio>
#include <cstdint>

#ifndef MK_ONE_LAUNCH
#define MK_ONE_LAUNCH 1
#endif

constexpr int BATCH = 2, SEQ = 16384, DM = 1024, T = BATCH * SEQ;
constexpr int DIN = 7752, DFF = 4096, DH = 512;
constexpr int NIN_T = 4864;
constexpr int NBLK = SEQ / 256;
constexpr float EPS = 1e-6f;

namespace pg8 {
#define PG8_LAS __attribute__((address_space(3)))
typedef unsigned short bf16_t;
typedef short bf16x8 __attribute__((ext_vector_type(8)));
typedef float f32x4 __attribute__((ext_vector_type(4)));
typedef unsigned u32x4 __attribute__((ext_vector_type(4)));
constexpr int BM = 256, BK = 64, HALF = 128, HTB = HALF * BK * 2  , STAGE_BYTES = 8 * HTB, NXCD = 8, WGM = 8;

__host__ __device__ __forceinline__ int lds_byte(int r, int c) { const int st = (r >> 4) * 2 + (c >> 5), rr = r & 15, cc = c & 31, ob = rr * 64 + cc * 2; return st * 1024 + (ob ^ (((ob >> 9) & 1) << 5)); }
__host__ __device__ __forceinline__ void stage_rc(int b, int& R, int& C) { const int st = b / 1024, sb = b % 1024, swz = sb ^ (((sb >> 9) & 1) << 5); R = (st >> 1) * 16 + swz / 64; C = (st & 1) * 32 + (swz % 64) / 2; }
__host__ __device__ __forceinline__ int perm32(int rho) { const int n = rho >> 4, i = rho & 15; return 8 * (i >> 2) + 4 * n + (i & 3); }

struct Unit { int pm, pn; };
struct Gemm { const bf16_t* A; const bf16_t* Bt; int M, N, K; };

struct StaticOrder {
    int nM, nN, nwg, G, c;
    __host__ __device__ void init(int M, int N, int G_, int c_) { nM = M / BM; nN = N / BM; nwg = nM * nN; G = G_; c = c_; }
    __host__ __device__ bool next(int i, Unit& u) const {
        const long L = (long)i * G + c; if (L >= nwg) return false;
        int wgid = (int)L; { const int q = nwg / NXCD, r = nwg % NXCD, xcd = wgid % NXCD, off = wgid / NXCD; wgid = (xcd < r ? xcd * (q + 1) : r * (q + 1) + (xcd - r) * q) + off; }
        const int nig = WGM * nN, gid = wgid / nig, fm = gid * WGM, gsz = (nM - fm) < WGM ? (nM - fm) : WGM;
        u.pm = fm + ((wgid % nig) % gsz); u.pn = (wgid % nig) / gsz; return true;
    }
    __device__ __forceinline__ void a_ready(const Unit&) const {}
    __device__ __forceinline__ void done(const Unit&) const {}
};

typedef float f32x2_t __attribute__((ext_vector_type(2))); typedef __bf16 bf16x2_t __attribute__((ext_vector_type(2)));
typedef unsigned long long ssq_t;
constexpr float SSQ_ONE = 16777216.0f;
__device__ __forceinline__ float ssq_rs(const ssq_t* a, int row) { return __builtin_amdgcn_rsqf((float)a[row] * (1.0f / (SSQ_ONE * 1024.0f)) + EPS); }
__device__ __forceinline__ unsigned cvt_pk_bf16(float lo, float hi) { f32x2_t v = {lo, hi}; bf16x2_t b = __builtin_convertvector(v, bf16x2_t); return __builtin_bit_cast(unsigned, b); }
__device__ __forceinline__ float bf_lo(unsigned w) { return __uint_as_float(w << 16); }
__device__ __forceinline__ float bf_hi(unsigned w) { return __uint_as_float(w & 0xffff0000u); }

struct EpiInproj {
    static constexpr bool PERM = true, AFTER_DRAIN = false;
    bf16_t* base; bf16_t* ki; float* wi; const ssq_t* rstd  ; float* km2;
    __device__ __forceinline__ void operator()(const f32x4 (&acc)[2][2][4][2], const Unit& u, int wr, int wc, int fr, int fq) const {
        const int row0 = u.pm * BM + wr * 64 + fr;
        if (u.pn < 18) {
            bf16_t* dst = base + (size_t)(u.pn >> 1) * ((size_t)T * 512) + (u.pn & 1) * 256 + wc * 32 + 8 * fq;
            const bool ksum = (u.pn >> 1) == 3;
            f32x4 cs[2][2] = {{{0.f, 0.f, 0.f, 0.f}, {0.f, 0.f, 0.f, 0.f}}, {{0.f, 0.f, 0.f, 0.f}, {0.f, 0.f, 0.f, 0.f}}};
#pragma unroll
            for (int ai = 0; ai < 2; ++ai)
#pragma unroll
                for (int m = 0; m < 4; ++m) { const int row = row0 + ai * HALF + m * 16; const float rs = ssq_rs(rstd, row); bf16_t* rowp = dst + (size_t)row * 512;
#pragma unroll
                    for (int bj = 0; bj < 2; ++bj) { const f32x4 v0 = acc[ai][bj][m][0] * rs, v1 = acc[ai][bj][m][1] * rs;
                        if (ksum) { cs[bj][0] += v0; cs[bj][1] += v1; }
                        u32x4 w; w.x = cvt_pk_bf16(v0[0], v0[1]); w.y = cvt_pk_bf16(v0[2], v0[3]); w.z = cvt_pk_bf16(v1[0], v1[1]); w.w = cvt_pk_bf16(v1[2], v1[3]);
                        *(u32x4*)(rowp + bj * HALF) = w; } }
            if (ksum) {
#pragma unroll
                for (int bj = 0; bj < 2; ++bj)
#pragma unroll
                    for (int n = 0; n < 2; ++n)
#pragma unroll
                        for (int j = 0; j < 4; ++j) { float v = cs[bj][n][j]; v += __shfl_xor(v, 1); v += __shfl_xor(v, 2); v += __shfl_xor(v, 4); v += __shfl_xor(v, 8); cs[bj][n][j] = v; }
                if (fr == 0) { float* kd = km2 + ((size_t)u.pm * 2 + wr) * 512 + (u.pn & 1) * 256 + wc * 32 + 8 * fq;
#pragma unroll
                    for (int bj = 0; bj < 2; ++bj) { *(f32x4*)(kd + bj * HALF) = cs[bj][0]; *(f32x4*)(kd + bj * HALF + 4) = cs[bj][1]; } }
            }
        } else {
#pragma unroll
            for (int ai = 0; ai < 2; ++ai)
#pragma unroll
                for (int m = 0; m < 4; ++m) { const int row = row0 + ai * HALF + m * 16; const float rs = ssq_rs(rstd, row);
                    const f32x4 v0 = acc[ai][0][m][0] * rs, v1 = acc[ai][0][m][1] * rs;
                    if (wc < 2) { u32x4 w; w.x = cvt_pk_bf16(v0[0], v0[1]); w.y = cvt_pk_bf16(v0[2], v0[3]); w.z = cvt_pk_bf16(v1[0], v1[1]); w.w = cvt_pk_bf16(v1[2], v1[3]);
                        *(u32x4*)(ki + (size_t)row * 64 + wc * 32 + 8 * fq) = w; }
                    else if (wc == 2 && fq == 0) { *(f32x4*)(wi + (size_t)row * 8) = v0; *(f32x4*)(wi + (size_t)row * 8 + 4) = v1; } }
        }
    }
};
struct EpiGates {
    static constexpr bool PERM = true, AFTER_DRAIN = false;
    bf16_t* O; const ssq_t* rstd;
    __device__ __forceinline__ void operator()(const f32x4 (&acc)[2][2][4][2], const Unit& u, int wr, int wc, int fr, int fq) const {
        const int row0 = u.pm * BM + wr * 64 + fr; const int tsel = u.pn >> 2;
        bf16_t* dst = O + (size_t)tsel * ((size_t)T * 1024) + (u.pn & 3) * 256 + wc * 32 + 8 * fq;
#pragma unroll
        for (int ai = 0; ai < 2; ++ai)
#pragma unroll
            for (int m = 0; m < 4; ++m) { const int row = row0 + ai * HALF + m * 16; const float rs = ssq_rs(rstd, row); bf16_t* rowp = dst + (size_t)row * 1024;
#pragma unroll
                for (int bj = 0; bj < 2; ++bj) { float v[8];
#pragma unroll
                    for (int j = 0; j < 4; ++j) { v[j] = acc[ai][bj][m][0][j] * rs; v[4 + j] = acc[ai][bj][m][1][j] * rs; }
#pragma unroll
                    for (int j = 0; j < 8; ++j) v[j] = __builtin_amdgcn_rcpf(1.0f + __builtin_amdgcn_exp2f(-1.4426950408889634f * v[j]));
                    u32x4 w; w.x = cvt_pk_bf16(v[0], v[1]); w.y = cvt_pk_bf16(v[2], v[3]); w.z = cvt_pk_bf16(v[4], v[5]); w.w = cvt_pk_bf16(v[6], v[7]);
                    *(u32x4*)(rowp + bj * HALF) = w; } }
    }
};
template <bool FIRST> struct EpiMerge {
    static constexpr bool PERM = true, AFTER_DRAIN = false;
    const bf16_t* G; bf16_t* Mg;
    __device__ __forceinline__ void operator()(const f32x4 (&acc)[2][2][4][2], const Unit& u, int wr, int wc, int fr, int fq) const {
        const int row0 = u.pm * BM + wr * 64 + fr; const int col0 = u.pn * BM + wc * 32 + 8 * fq;
#pragma unroll
        for (int ai = 0; ai < 2; ++ai)
#pragma unroll
            for (int m = 0; m < 4; ++m) { const size_t off = (size_t)(row0 + ai * HALF + m * 16) * 1024 + col0;
#pragma unroll
                for (int bj = 0; bj < 2; ++bj) { const u32x4 g = *(const u32x4*)(G + off + bj * HALF); const f32x4 a0 = acc[ai][bj][m][0], a1 = acc[ai][bj][m][1];
                    float v[8] = { bf_lo(g.x) * a0[0], bf_hi(g.x) * a0[1], bf_lo(g.y) * a0[2], bf_hi(g.y) * a0[3], bf_lo(g.z) * a1[0], bf_hi(g.z) * a1[1], bf_lo(g.w) * a1[2], bf_hi(g.w) * a1[3] };
                    if (!FIRST) { const u32x4 o = *(const u32x4*)(Mg + off + bj * HALF);
                        v[0] += bf_lo(o.x); v[1] += bf_hi(o.x); v[2] += bf_lo(o.y); v[3] += bf_hi(o.y); v[4] += bf_lo(o.z); v[5] += bf_hi(o.z); v[6] += bf_lo(o.w); v[7] += bf_hi(o.w); }
                    u32x4 w; w.x = cvt_pk_bf16(v[0], v[1]); w.y = cvt_pk_bf16(v[2], v[3]); w.z = cvt_pk_bf16(v[4], v[5]); w.w = cvt_pk_bf16(v[6], v[7]);
                    *(u32x4*)(Mg + off + bj * HALF) = w; }
                asm volatile("" ::: "memory"); }
    }
};
struct EpiResid {
    static constexpr bool PERM = false, AFTER_DRAIN = false;
    const float* src; float* out; bf16_t* xb; float* ssq;
    __device__ __forceinline__ void operator()(const f32x4 (&acc)[2][2][4][2], const Unit& u, int wr, int wc, int fr, int fq) const {
        const int row0 = u.pm * BM + wr * 64 + fr, col0 = u.pn * BM + wc * 32 + 4 * fq;
#pragma unroll
        for (int ai = 0; ai < 2; ++ai)
#pragma unroll
            for (int m = 0; m < 4; ++m) { const int row = row0 + ai * HALF + m * 16; const size_t off = (size_t)row * 1024 + col0; float sq = 0.f;
#pragma unroll
                for (int bj = 0; bj < 2; ++bj)
#pragma unroll
                    for (int n = 0; n < 2; ++n) { const f32x4 s = *(const f32x4*)(src + off + bj * HALF + n * 16); const f32x4 v = s + acc[ai][bj][m][n]; *(f32x4*)(out + off + bj * HALF + n * 16) = v;
                        if (xb) { typedef unsigned u32x2v __attribute__((ext_vector_type(2))); u32x2v w; w.x = cvt_pk_bf16(v[0], v[1]); w.y = cvt_pk_bf16(v[2], v[3]); *(u32x2v*)(xb + off + bj * HALF + n * 16) = w;
                            sq += (v[0] * v[0] + v[1] * v[1]) + (v[2] * v[2] + v[3] * v[3]); } }
                if (xb) { sq += __shfl_xor(sq, 16); sq += __shfl_xor(sq, 32); if (fq == 0) unsafeAtomicAdd(ssq + row, sq); } }
    }
};
struct EpiResidB {
    static constexpr bool PERM = true, AFTER_DRAIN = false;
    bf16_t* xb; ssq_t* ssq;
    __device__ __forceinline__ void operator()(const f32x4 (&acc)[2][2][4][2], const Unit& u, int wr, int wc, int fr, int fq) const {
        const int row0 = u.pm * BM + wr * 64 + fr; const int col0 = u.pn * BM + wc * 32 + 8 * fq;
#pragma unroll
        for (int ai = 0; ai < 2; ++ai)
#pragma unroll
            for (int m = 0; m < 4; ++m) { const int row = row0 + ai * HALF + m * 16; const size_t off = (size_t)row * 1024 + col0; float sq = 0.f;
#pragma unroll
                for (int bj = 0; bj < 2; ++bj) { const u32x4 g = *(const u32x4*)(xb + off + bj * HALF); const f32x4 a0 = acc[ai][bj][m][0], a1 = acc[ai][bj][m][1];
                    const float v[8] = { bf_lo(g.x) + a0[0], bf_hi(g.x) + a0[1], bf_lo(g.y) + a0[2], bf_hi(g.y) + a0[3], bf_lo(g.z) + a1[0], bf_hi(g.z) + a1[1], bf_lo(g.w) + a1[2], bf_hi(g.w) + a1[3] };
                    sq += ((v[0] * v[0] + v[1] * v[1]) + (v[2] * v[2] + v[3] * v[3])) + ((v[4] * v[4] + v[5] * v[5]) + (v[6] * v[6] + v[7] * v[7]));
                    u32x4 w; w.x = cvt_pk_bf16(v[0], v[1]); w.y = cvt_pk_bf16(v[2], v[3]); w.z = cvt_pk_bf16(v[4], v[5]); w.w = cvt_pk_bf16(v[6], v[7]);
                    *(u32x4*)(xb + off + bj * HALF) = w; }
                if (ssq) { sq += __shfl_xor(sq, 16); sq += __shfl_xor(sq, 32); if (fq == 0) atomicAdd(ssq + row, (ssq_t)(sq * SSQ_ONE)); } }
    }
};
struct EpiUp {
    static constexpr bool PERM = true, AFTER_DRAIN = false;
    bf16_t* O; const ssq_t* rstd;
    __device__ __forceinline__ void operator()(const f32x4 (&acc)[2][2][4][2], const Unit& u, int wr, int wc, int fr, int fq) const {
        const int row0 = u.pm * BM + wr * 64 + fr; const int col0 = u.pn * BM + wc * 32 + 8 * fq;
#pragma unroll
        for (int ai = 0; ai < 2; ++ai)
#pragma unroll
            for (int m = 0; m < 4; ++m) { const int row = row0 + ai * HALF + m * 16; const float rs = ssq_rs(rstd, row); bf16_t* rowp = O + (size_t)row * DFF + col0;
#pragma unroll
                for (int bj = 0; bj < 2; ++bj) { float v[8];
#pragma unroll
                    for (int j = 0; j < 4; ++j) { v[j] = fmaxf(acc[ai][bj][m][0][j] * rs, 0.f); v[4 + j] = fmaxf(acc[ai][bj][m][1][j] * rs, 0.f); }
#pragma unroll
                    for (int j = 0; j < 8; ++j) v[j] = v[j] * v[j];
                    u32x4 w; w.x = cvt_pk_bf16(v[0], v[1]); w.y = cvt_pk_bf16(v[2], v[3]); w.z = cvt_pk_bf16(v[4], v[5]); w.w = cvt_pk_bf16(v[6], v[7]);
                    *(u32x4*)(rowp + bj * HALF) = w; } }
    }
};

template <class Epi, class Sched, bool ALIGN_EPI = false, bool SP2 = false>
__device__ __forceinline__ void gemm_phase(PG8_LAS unsigned char* lds, const Gemm g, const Sched& S, const Epi& E, int tid_in) {
    int tid_ = tid_in; asm volatile("" : "+v"(tid_));
    const int tid = tid_, wid = __builtin_amdgcn_readfirstlane(tid >> 6), lane = tid & 63, wr = wid >> 2, wc = wid & 3, fr = lane & 15, fq = lane >> 4;
    const int K = g.K, nt = K / BK;
    unsigned voffA[2], voffB[2];
#pragma unroll
    for (int i = 0; i < 2; ++i) { int R, C; stage_rc(tid * 16 + i * 8192, R, C); const int Rb = Epi::PERM ? ((R & ~31) + perm32(R & 31)) : R;
        voffA[i] = (unsigned)(R * K + C) * 2u; voffB[i] = (unsigned)(Rb * K + C) * 2u; }
    const size_t kstep = (size_t)(BK * 2);
    const size_t hstep = (size_t)HALF * K * 2;
    const size_t tstep = 2 * hstep;
    const unsigned ldsw = (unsigned)wid * 1024u;
    const int aoff = lds_byte(wr * 64 + fr, fq * 8), boff = lds_byte(wc * 32 + fr, fq * 8);
#define PG8_SA(b, h) (((b) * 2 + (h)) * HTB)
#define PG8_SB(b, h) ((4 + (b) * 2 + (h)) * HTB)
#define PG8_STAGE(bufoff, gbase, voff) do { _Pragma("unroll") for (int _i = 0; _i < 2; ++_i) \
        __builtin_amdgcn_global_load_lds((const unsigned*)((const char*)(gbase) + (voff)[_i]), (PG8_LAS unsigned*)(lds + (bufoff) + ldsw + _i * 8192), 16, 0, 0); } while (0)
#define PG8_LDA(dst, b, h) do { _Pragma("unroll") for (int m = 0; m < 4; ++m) _Pragma("unroll") for (int k = 0; k < 2; ++k) dst[m][k] = *(const PG8_LAS bf16x8*)(lds + PG8_SA(b, h) + aoff + m * 2048 + k * 1024); } while (0)
#define PG8_LDB(dst, b, h) do { _Pragma("unroll") for (int n = 0; n < 2; ++n) _Pragma("unroll") for (int k = 0; k < 2; ++k) dst[n][k] = *(const PG8_LAS bf16x8*)(lds + PG8_SB(b, h) + boff + n * 2048 + k * 1024); } while (0)
#define PG8_MMA(ai, bj, At, Bt) do { __builtin_amdgcn_s_setprio(1); _Pragma("unroll") for (int m = 0; m < 4; ++m) _Pragma("unroll") for (int n = 0; n < 2; ++n) _Pragma("unroll") for (int k = 0; k < 2; ++k) \
        acc[ai][bj][m][n] = __builtin_amdgcn_mfma_f32_16x16x32_bf16(Bt[n][k], At[m][k], acc[ai][bj][m][n], 0, 0, 0); __builtin_amdgcn_s_setprio(0); } while (0)
#define PG8_WAIT_V(n) asm volatile("s_waitcnt vmcnt(" #n ")" ::: "memory")
#define PG8_WAIT_L(n) asm volatile("s_waitcnt lgkmcnt(" #n ")" ::: "memory")
#define PG8_BAR __builtin_amdgcn_s_barrier()
#define PG8_SCHED __builtin_amdgcn_sched_barrier(0)
    Unit cur, nxt; int ui = 0;
    if (!S.next(0, cur)) return;
    f32x4 acc[2][2][4][2];
#pragma unroll
    for (int a = 0; a < 2; ++a)
#pragma unroll
        for (int b = 0; b < 2; ++b)
#pragma unroll
            for (int m = 0; m < 4; ++m)
#pragma unroll
                for (int n = 0; n < 2; ++n) acc[a][b][m][n] = (f32x4){0.f, 0.f, 0.f, 0.f};
    bf16x8 At[4][2], B0[2][2], B1[2][2];
    const char* cA = (const char*)g.A + (size_t)cur.pm * tstep; const char* cB = (const char*)g.Bt + (size_t)cur.pn * tstep;
    S.a_ready(cur);
    if constexpr (SP2) {
        PG8_STAGE(PG8_SB(0, 0), cB, voffB); PG8_STAGE(PG8_SB(0, 1), cB + hstep, voffB); PG8_STAGE(PG8_SA(0, 0), cA, voffA); PG8_STAGE(PG8_SA(0, 1), cA + hstep, voffA);
        if (wr == 1) PG8_BAR;
        PG8_WAIT_V(2); PG8_BAR;
        PG8_STAGE(PG8_SB(1, 0), cB + kstep, voffB); PG8_STAGE(PG8_SA(1, 0), cA + kstep, voffA); PG8_STAGE(PG8_SB(1, 1), cB + hstep + kstep, voffB);
        PG8_WAIT_V(6); PG8_BAR;
    } else {
        PG8_STAGE(PG8_SB(0, 0), cB, voffB); PG8_STAGE(PG8_SA(0, 0), cA, voffA); PG8_STAGE(PG8_SB(0, 1), cB + hstep, voffB); PG8_STAGE(PG8_SA(0, 1), cA + hstep, voffA);
        if (wr == 1) PG8_BAR;
        PG8_WAIT_V(4); PG8_BAR;
        PG8_STAGE(PG8_SB(1, 0), cB + kstep, voffB); PG8_STAGE(PG8_SA(1, 0), cA + kstep, voffA); PG8_STAGE(PG8_SB(1, 1), cB + hstep + kstep, voffB);
        PG8_WAIT_V(6); PG8_BAR;
    }
    for (;;) {
        const bool has_next = S.next(ui + 1, nxt);
        const char* nA = has_next ? (const char*)g.A + (size_t)nxt.pm * tstep : cA; const char* nB = has_next ? (const char*)g.Bt + (size_t)nxt.pn * tstep : cB;
        for (int t = 0; t < nt; t += 2) {
            const bool last = (t == nt - 2);
            const char* a1 = cA + (size_t)(t + 1) * kstep;
            const char* a2 = last ? nA : cA + (size_t)(t + 2) * kstep; const char* b2 = last ? nB : cB + (size_t)(t + 2) * kstep;
            const char* a3 = a2 + kstep; const char* b3 = b2 + kstep;
            if (last && has_next) S.a_ready(nxt);
            if constexpr (SP2) {
            PG8_LDB(B0, 0, 0); PG8_LDB(B1, 0, 1); PG8_SCHED; PG8_LDA(At, 0, 0); PG8_STAGE(PG8_SA(1, 1), a1 + hstep, voffA);
            PG8_WAIT_V(8); PG8_WAIT_L(0); PG8_BAR; PG8_MMA(0, 0, At, B0); PG8_MMA(0, 1, At, B1); PG8_BAR; PG8_SCHED;
            PG8_LDA(At, 0, 1); PG8_STAGE(PG8_SB(0, 0), b2, voffB); PG8_STAGE(PG8_SB(0, 1), b2 + hstep, voffB); PG8_STAGE(PG8_SA(0, 0), a2, voffA);
            PG8_WAIT_V(8); PG8_WAIT_L(0); PG8_BAR; PG8_MMA(1, 0, At, B0); PG8_MMA(1, 1, At, B1); PG8_BAR; PG8_SCHED;
            PG8_LDB(B0, 1, 0); PG8_LDB(B1, 1, 1); PG8_SCHED; PG8_LDA(At, 1, 0); PG8_STAGE(PG8_SA(0, 1), a2 + hstep, voffA);
            PG8_WAIT_V(8); PG8_WAIT_L(0); PG8_BAR; PG8_MMA(0, 0, At, B0); PG8_MMA(0, 1, At, B1); PG8_BAR; PG8_SCHED;
            PG8_LDA(At, 1, 1); PG8_STAGE(PG8_SB(1, 0), b3, voffB); PG8_STAGE(PG8_SB(1, 1), b3 + hstep, voffB); PG8_STAGE(PG8_SA(1, 0), a3, voffA);
            PG8_WAIT_V(8); PG8_WAIT_L(0); PG8_BAR; PG8_MMA(1, 0, At, B0); PG8_MMA(1, 1, At, B1); PG8_BAR; PG8_SCHED;
            } else {
            PG8_LDB(B0, 0, 0); PG8_SCHED; PG8_LDA(At, 0, 0); PG8_STAGE(PG8_SA(1, 1), a1 + hstep, voffA);
            PG8_WAIT_L(8); PG8_BAR; PG8_WAIT_L(0); PG8_MMA(0, 0, At, B0); PG8_BAR; PG8_SCHED;
            PG8_LDB(B1, 0, 1); PG8_STAGE(PG8_SB(0, 0), b2, voffB);
            PG8_BAR; PG8_WAIT_L(0); PG8_MMA(0, 1, At, B1); PG8_BAR;
            PG8_LDA(At, 0, 1); PG8_STAGE(PG8_SA(0, 0), a2, voffA);
            PG8_BAR; PG8_WAIT_L(0); PG8_MMA(1, 0, At, B0); PG8_BAR; PG8_SCHED;
            PG8_STAGE(PG8_SB(0, 1), b2 + hstep, voffB);
            PG8_WAIT_V(6); PG8_BAR; PG8_MMA(1, 1, At, B1); PG8_BAR;
            PG8_LDB(B0, 1, 0); PG8_SCHED; PG8_LDA(At, 1, 0); PG8_STAGE(PG8_SA(0, 1), a2 + hstep, voffA);
            PG8_WAIT_L(8); PG8_BAR; PG8_WAIT_L(0); PG8_MMA(0, 0, At, B0); PG8_BAR; PG8_SCHED;
            PG8_LDB(B1, 1, 1); PG8_STAGE(PG8_SB(1, 0), b3, voffB);
            PG8_BAR; PG8_WAIT_L(0); PG8_MMA(0, 1, At, B1); PG8_BAR;
            PG8_LDA(At, 1, 1); PG8_STAGE(PG8_SA(1, 0), a3, voffA);
            PG8_BAR; PG8_WAIT_L(0); PG8_MMA(1, 0, At, B0); PG8_BAR; PG8_SCHED;
            PG8_STAGE(PG8_SB(1, 1), b3 + hstep, voffB);
            PG8_WAIT_V(6); PG8_BAR; PG8_MMA(1, 1, At, B1); PG8_BAR;
            }
        }
        if constexpr (ALIGN_EPI) { if (wr == 0) PG8_BAR; }
        if constexpr (!Epi::AFTER_DRAIN) { E(acc, cur, wr, wc, fr, fq); S.done(cur); }
        if (!has_next) break;
#pragma unroll
        for (int a = 0; a < 2; ++a)
#pragma unroll
            for (int b = 0; b < 2; ++b)
#pragma unroll
                for (int m = 0; m < 4; ++m)
#pragma unroll
                    for (int n = 0; n < 2; ++n) acc[a][b][m][n] = (f32x4){0.f, 0.f, 0.f, 0.f};
        cur = nxt; cA = nA; cB = nB; ++ui;
        if constexpr (ALIGN_EPI) { if (wr == 1) PG8_BAR; }
    }
    PG8_WAIT_V(0);
    if constexpr (!ALIGN_EPI) { if (wr == 0) PG8_BAR; }
    PG8_BAR;
    if constexpr (Epi::AFTER_DRAIN) { E.fused(acc, cur, wr, wc, fr, fq, lds, wid, lane); S.done(cur); }
#undef PG8_SA
#undef PG8_SB
#undef PG8_STAGE
#undef PG8_LDA
#undef PG8_LDB
#undef PG8_MMA
#undef PG8_WAIT_V
#undef PG8_WAIT_L
#undef PG8_BAR
#undef PG8_SCHED
}
}

#ifndef FAST_MOBA
#define FAST_MOBA 2
#endif
#ifndef PG8_SP2
#define PG8_SP2 true
#endif
#ifndef PROBE_SEL
#define PROBE_SEL 0
#endif
constexpr int NWAVES = 8;
constexpr int PH_PER_LAYER = 11;
constexpr int N_PHASES = 2 * PH_PER_LAYER + 1;
constexpr bool ONE_LAUNCH = (MK_ONE_LAUNCH != 0);
static_assert(ONE_LAUNCH, "build with MK_ONE_LAUNCH=1 (build.sh 1): the FIN phase needs its in-phase grid barrier");

constexpr size_t MiB = 1u << 20;
constexpr size_t WS_CTL = 0, CTL_ZERO_BYTES = 1 * MiB;
constexpr size_t WS_W_IN = 1 * MiB;
constexpr size_t WS_W_G = 11 * MiB;
constexpr size_t WS_W_PA = 17 * MiB, WS_W_PB = 18 * MiB, WS_W_PC = 19 * MiB;
constexpr size_t WS_W_O = 20 * MiB;
constexpr size_t WS_W_UP = 22 * MiB;
constexpr size_t WS_W_DN = 30 * MiB;
constexpr size_t WS_XB = 40 * MiB;
constexpr size_t WS_RSTD = 104 * MiB;
constexpr int CW_SSQ = 32768;
static_assert(CW_SSQ * 4 + 3 * T * 8 <= (int)CTL_ZERO_BYTES, "ssq arrays inside the memset region");
constexpr size_t WS_KMEAN = 104 * MiB + 256 * 1024;
constexpr size_t WS_RGA = 104 * MiB + 256 * 1024;
constexpr size_t WS_RGH = 10 * MiB + 512 * 1024;
constexpr int RGC = 128;
constexpr size_t WS_WI = 105 * MiB;
constexpr size_t WS_KI = 106 * MiB;
constexpr size_t WS_ACT = 112 * MiB;
constexpr size_t ACT_STRIDE = (size_t)T * 512 * 2;
constexpr size_t WS_QA = WS_ACT, WS_QB = WS_ACT + ACT_STRIDE, WS_YC = WS_ACT + 2 * ACT_STRIDE, WS_KA = WS_ACT + 3 * ACT_STRIDE, WS_VA = WS_ACT + 4 * ACT_STRIDE,
                 WS_KB = WS_ACT + 5 * ACT_STRIDE, WS_VB = WS_ACT + 6 * ACT_STRIDE, WS_QI = WS_ACT + 7 * ACT_STRIDE, WS_XC = WS_ACT + 8 * ACT_STRIDE;
constexpr size_t WS_G = WS_KA;
constexpr size_t WS_MASK = 400 * MiB;
constexpr size_t WS_MERGED = 400 * MiB;
constexpr size_t WS_H = WS_ACT;
constexpr size_t WS_END = 512 * MiB;
static_assert(WS_XC + ACT_STRIDE == 400 * MiB && WS_G + (size_t)3 * T * 1024 * 2 == 400 * MiB && WS_H + (size_t)T * DFF * 2 <= 400 * MiB, "d_ws map");
constexpr int CW_DYN = 12288;
constexpr int CW_BAR = 4096;

constexpr int RING_OFF = 0, RING_BYTES = 131072;
constexpr int LDSCTL_OFF = RING_BYTES, MISC_OFF = LDSCTL_OFF + 320;
constexpr int LDS_BYTES = 147456;
constexpr int GL_SKEY = 0, GL_QIF = 65536, GL_WQ = GL_QIF + 2048, GL_HIST = GL_WQ + 64, GL_SEL = GL_HIST + 1024, GL_MISC = GL_SEL + 1024, GL_QS = 70656, GL_PS = 73728;
static_assert(GL_MISC + 64 <= GL_QS && GL_QS + 8 * 256 <= GL_PS && GL_PS + 8 * 4096 <= RING_BYTES, "golden LDS map");

#define GAS __attribute__((address_space(1)))
#define LAS __attribute__((address_space(3)))
typedef unsigned short bf16;
typedef unsigned v4u __attribute__((ext_vector_type(4)));
typedef float f32x4 __attribute__((ext_vector_type(4)));
typedef GAS unsigned gu32;
#define RLX_AGENT __ATOMIC_RELAXED, __HIP_MEMORY_SCOPE_AGENT
#define LDS_WAIT() asm volatile("s_waitcnt lgkmcnt(0)" ::: "memory")
#define VM_WAIT() asm volatile("s_waitcnt vmcnt(0)" ::: "memory")
__device__ __forceinline__ float bf2f(bf16 v) { return __uint_as_float(((unsigned)v) << 16); }
__device__ __forceinline__ unsigned pk2(float lo, float hi) { return pg8::cvt_pk_bf16(lo, hi); }
__device__ __forceinline__ unsigned f2bf(float f) { return pg8::cvt_pk_bf16(f, 0.f) & 0xffffu; }
__device__ __forceinline__ float wave_sum(float v) {
#pragma unroll
    for (int o = 1; o < 64; o <<= 1) v += __shfl_xor(v, o);
    return v;
}
__device__ __forceinline__ float wave_max(float v) {
#pragma unroll
    for (int o = 1; o < 64; o <<= 1) v = fmaxf(v, __shfl_xor(v, o));
    return v;
}
__device__ __forceinline__ int t5_bucket(int n) {
    if (n < 16) return n;
    if (n >= 113) return 31;
    return 16 + (n >= 19) + (n >= 21) + (n >= 24) + (n >= 27) + (n >= 31) + (n >= 35) + (n >= 40) + (n >= 46) + (n >= 52) + (n >= 59) + (n >= 67) + (n >= 77) + (n >= 87) + (n >= 99);
}

#define XB_TMO      128
#define XB_XCNT(j)  (256  + 64 * (j))
#define XB_XSUB(j)  (1280 + 64 * (j))
#define XB_XGEN(j)  (2304 + 64 * (j))
#define XB_TOP      3328
#define XB_TOPGEN   3392
#define XCD_BAR_WORDS 3456
#define XB_SPIN_CAP (1u << 22)

__device__ __forceinline__ unsigned xb_ld(unsigned* p)              { return __hip_atomic_load(p, __ATOMIC_RELAXED, __HIP_MEMORY_SCOPE_AGENT); }
__device__ __forceinline__ unsigned xb_add(unsigned* p, unsigned v) { return __hip_atomic_fetch_add(p, v, __ATOMIC_RELAXED, __HIP_MEMORY_SCOPE_AGENT); }
__device__ __forceinline__ unsigned xb_xcc_id() { return (unsigned)__builtin_amdgcn_s_getreg((3 << 11) | 20) & 0xFu; }
#define XB_SPIN(cond, bar) do { unsigned _sp = 0; while (cond) { __builtin_amdgcn_s_sleep(1); \
    if ((++_sp & 255u) == 0u) { if (xb_ld(&(bar)[XB_TMO])) break; if (_sp > XB_SPIN_CAP) { atomicAdd(&(bar)[XB_TMO], 1u); break; } } } } while (0)

struct XcdBarrier { unsigned* bar; unsigned x; volatile LAS unsigned* st; };

__device__ __forceinline__ XcdBarrier xcd_barrier_post(unsigned* bar, volatile LAS unsigned* st) {
    XcdBarrier b; b.bar = bar; b.x = xb_xcc_id(); b.st = st;
    if (threadIdx.x == 0) (void)xb_add(&bar[XB_XCNT(b.x)], 1u);
    return b;
}
__device__ __forceinline__ void xcd_barrier_complete(unsigned* bar, unsigned x, unsigned& nloc, unsigned& nx) {
    const unsigned G = gridDim.x * gridDim.y * gridDim.z;
    unsigned sum, cnt, mine, sp = 0u;
    for (;;) {
        sum = 0u; cnt = 0u; mine = 0u;
#pragma unroll
        for (unsigned j = 0; j < 16; ++j) { const unsigned c = xb_ld(&bar[XB_XCNT(j)]); sum += c; cnt += (c > 0u) ? 1u : 0u; }
        mine = xb_ld(&bar[XB_XCNT(x)]);
        if (sum == G) break;
        __builtin_amdgcn_s_sleep(1);
        if ((++sp & 255u) == 0u) { if (xb_ld(&bar[XB_TMO])) break; if (sp > XB_SPIN_CAP) { atomicAdd(&bar[XB_TMO], 1u); break; } }
    }
    nloc = mine > 0u ? mine : 1u; nx = cnt > 0u ? cnt : 1u;
}
__device__ __forceinline__ void xcd_barrier(const XcdBarrier& b) {
    asm volatile("s_waitcnt vmcnt(0)" ::: "memory");
    __syncthreads();
    if (threadIdx.x == 0) {
        unsigned* bar = b.bar;
        __builtin_amdgcn_s_waitcnt(0);
        unsigned nloc = b.st[0], nx = b.st[1];
        if (nloc == 0u) { xcd_barrier_complete(bar, b.x, nloc, nx); b.st[0] = nloc; b.st[1] = nx; }
        const unsigned old = xb_add(&bar[XB_XSUB(b.x)], 1u);
        const unsigned gen = old / nloc;
        if (old + 1u == (gen + 1u) * nloc) {
            __builtin_amdgcn_fence(__ATOMIC_RELEASE, "agent");
            asm volatile("s_waitcnt vmcnt(0)" ::: "memory");
            const unsigned og = xb_add(&bar[XB_TOP], 1u);
            const unsigned tg = og / nx;
            if (og + 1u == (tg + 1u) * nx) xb_add(&bar[XB_TOPGEN], 1u);
            else XB_SPIN(xb_ld(&bar[XB_TOPGEN]) == tg, bar);
            __builtin_amdgcn_fence(__ATOMIC_ACQUIRE, "agent");
            xb_add(&bar[XB_XGEN(b.x)], 1u);
            asm volatile("s_waitcnt vmcnt(0)" ::: "memory");
        } else {
            XB_SPIN(xb_ld(&bar[XB_XGEN(b.x)]) == gen, bar);
            __builtin_amdgcn_fence(__ATOMIC_ACQUIRE, "agent");
            asm volatile("s_waitcnt vmcnt(0)" ::: "memory");
        }
    }
    __syncthreads();
}

struct Args { const float* in[19]; float* out; unsigned char* ws; int ph_lo, ph_hi; };
struct Frame {
    LAS unsigned char* lds;
    int tid, lane, wave, G, bid;
    int gw;
    const __attribute__((address_space(4))) Args* a;
    unsigned char* ws; float* out;
};
#define WSB(off) ((bf16*)(F.ws + (off)))
#define WSF(off) ((float*)(F.ws + (off)))
#define INP(i) (F.a->in[i])
#define SSQ_CTL ((pg8::ssq_t*)(F.ws + WS_CTL + (size_t)CW_SSQ * 4))
#define SSQ_MIX(l) ((l) == 0 ? (pg8::ssq_t*)(F.ws + WS_RSTD) : SSQ_CTL + T)
#define SSQ_MLP(l) (SSQ_CTL + ((l) == 0 ? 0 : 2 * T))
enum { I_X = 0, I_RELB, I_NMG, I_WIN, I_CONVW, I_CONVB, I_WR, I_BR, I_WI, I_BI, I_LAM, I_WPA, I_WPB, I_WPC, I_WO, I_NLG, I_WUP, I_WDN, I_FNG };

template <class P> __device__ __forceinline__ P* launder_u(P* p) { unsigned lo = (unsigned)(uintptr_t)p, hi = (unsigned)((uintptr_t)p >> 32); asm volatile("" : "+v"(lo), "+v"(hi));
    lo = __builtin_amdgcn_readfirstlane(lo); hi = __builtin_amdgcn_readfirstlane(hi); return (P*)(((uintptr_t)hi << 32) | (uintptr_t)lo); }
__device__ __forceinline__ int launder_i(int v) { asm volatile("" : "+v"(v)); return __builtin_amdgcn_readfirstlane(v); }

__device__ __forceinline__ void transpose_item(const float* W, int ld, int K, int ncol_valid, const float* gain, bf16* WT, LAS float* scr, int item, int nblk, int lane) {
    const int kb = item / nblk, nb = item % nblk, k0 = 64 * kb, n0 = 32 * nb;
    const float gv = gain ? gain[k0 + lane] : 1.0f;
#pragma unroll 8
    for (int i = 0; i < 32; ++i) { const int kk = 2 * i + (lane >> 5); const int n = n0 + (lane & 31);
        float v = (n < ncol_valid) ? W[(size_t)(k0 + kk) * ld + n] : 0.f; v *= __shfl(gv, kk); scr[kk * 33 + (lane & 31)] = v; }
    LDS_WAIT(); asm volatile("" ::: "memory");
    const int c = lane & 7;
#pragma unroll
    for (int j = 0; j < 4; ++j) { const int n = (lane >> 3) + 8 * j; const LAS float* s = scr + (8 * c) * 33 + n;
        v4u o; o.x = pk2(s[0 * 33], s[1 * 33]); o.y = pk2(s[2 * 33], s[3 * 33]); o.z = pk2(s[4 * 33], s[5 * 33]); o.w = pk2(s[6 * 33], s[7 * 33]);
        *(GAS v4u*)(WT + (size_t)(n0 + n) * K + k0 + 8 * c) = o; }
    LDS_WAIT(); asm volatile("" ::: "memory");
}
__device__ __forceinline__ void norm_row(const float* xrow, bf16* orow, pg8::ssq_t* rstd_out, int lane) {
    const GAS f32x4* xr = (const GAS f32x4*)xrow + lane;
    f32x4 v[4]; float s = 0.f;
#pragma unroll
    for (int j = 0; j < 4; ++j) { v[j] = xr[64 * j]; s += (v[j].x * v[j].x + v[j].y * v[j].y) + (v[j].z * v[j].z + v[j].w * v[j].w); }
    const float ss = wave_sum(s);
    GAS unsigned long long* o8 = (GAS unsigned long long*)orow + lane;
#pragma unroll
    for (int j = 0; j < 4; ++j) o8[64 * j] = (unsigned long long)pk2(v[j].x, v[j].y) | ((unsigned long long)pk2(v[j].z, v[j].w) << 32);
    if (lane == 0) *rstd_out = (pg8::ssq_t)(ss * pg8::SSQ_ONE);
}
__device__ __forceinline__ void p_prologue(Frame& F, int l) {
    LAS float* scr = (LAS float*)(F.lds + RING_OFF + F.wave * 16384);
    const int gw = F.bid * NWAVES + F.wave, NGW = F.G * NWAVES;
    const float* w_in = INP(I_WIN) + (size_t)l * DM * DIN; const float* g1 = INP(I_NMG) + l * DM; const float* g2 = INP(I_NLG) + l * DM;
    constexpr int I_BLK = 16 * 16;
    constexpr int I_SP = 16 * 3;
    constexpr int I_G = 16 * 96;
    constexpr int I_P = 8 * 32;
    constexpr int I_O = 16 * 32;
    constexpr int I_UP = 16 * 128;
    constexpr int I_DN = 64 * 32;
    constexpr int NITEMS = 9 * I_BLK + I_SP + I_G + 3 * I_P + I_O + I_UP + I_DN;
    for (int it = gw; it < NITEMS; it += NGW) {
        int r = it;
        if (r < 9 * I_BLK) { const int blk = r / I_BLK; r -= blk * I_BLK;
            const int c0 = blk == 0 ? 0 : blk == 1 ? 1536 : blk == 2 ? 4168 : blk == 3 ? 512 : blk == 4 ? 1024 : blk == 5 ? 2048 : blk == 6 ? 2560 : blk == 7 ? 3072 : 3656;
            transpose_item(w_in + c0, DIN, DM, 512, g1, WSB(WS_W_IN) + (size_t)blk * 512 * DM, scr, r, 16, F.lane); continue; }
        r -= 9 * I_BLK;
        if (r < I_SP) { transpose_item(w_in + 3584, DIN, DM, 72, g1, WSB(WS_W_IN) + (size_t)4608 * DM, scr, r, 3, F.lane); continue; } r -= I_SP;
        if (r < I_G) { transpose_item(w_in + 4680, DIN, DM, 3072, g1, WSB(WS_W_G), scr, r, 96, F.lane); continue; } r -= I_G;
        if (r < I_P) { transpose_item(INP(I_WPA) + (size_t)l * DH * DM, DM, DH, 1024, nullptr, WSB(WS_W_PA), scr, r, 32, F.lane); continue; } r -= I_P;
        if (r < I_P) { transpose_item(INP(I_WPB) + (size_t)l * DH * DM, DM, DH, 1024, nullptr, WSB(WS_W_PB), scr, r, 32, F.lane); continue; } r -= I_P;
        if (r < I_P) { transpose_item(INP(I_WPC) + (size_t)l * DH * DM, DM, DH, 1024, nullptr, WSB(WS_W_PC), scr, r, 32, F.lane); continue; } r -= I_P;
        if (r < I_O) { transpose_item(INP(I_WO) + (size_t)l * DM * DM, DM, DM, 1024, nullptr, WSB(WS_W_O), scr, r, 32, F.lane); continue; } r -= I_O;
        if (r < I_UP) { transpose_item(INP(I_WUP) + (size_t)l * DM * DFF, DFF, DM, DFF, g2, WSB(WS_W_UP), scr, r, 128, F.lane); continue; } r -= I_UP;
        transpose_item(INP(I_WDN) + (size_t)l * DFF * DM, DM, DFF, 1024, nullptr, WSB(WS_W_DN), scr, r, 32, F.lane);
    }
    { GAS v4u* z = (GAS v4u*)(WSB(WS_W_IN) + (size_t)(4608 + 96) * DM); const int gt = F.bid * (NWAVES * 64) + F.tid;
      unsigned zz = 0u; asm volatile("" : "+v"(zz));
      for (int i = gt; i < 160 * DM / 8; i += F.G * NWAVES * 64) z[i] = (v4u){zz, zz, zz, zz}; }
    if (l == 0) for (int m = gw; m < T; m += NGW) norm_row(INP(I_X) + (size_t)m * DM, WSB(WS_XB) + (size_t)m * DM, (pg8::ssq_t*)(F.ws + WS_RSTD) + m, F.lane);
}
__device__ __forceinline__ void p_final(Frame& F) {
    const int gw = F.bid * NWAVES + F.wave, NGW = F.G * NWAVES;
    for (int m = gw; m < T; m += NGW) {
        const GAS v4u* xr = (const GAS v4u*)(WSB(WS_XB) + (size_t)m * DM) + F.lane; GAS f32x4* orow = (GAS f32x4*)(F.out + (size_t)m * DM) + 2 * F.lane; const GAS f32x4* gr = (const GAS f32x4*)INP(I_FNG) + 2 * F.lane;
        float v[16]; float s = 0.f;
#pragma unroll
        for (int j = 0; j < 2; ++j) { const v4u w = xr[64 * j];
            v[8 * j + 0] = __uint_as_float(w.x << 16); v[8 * j + 1] = __uint_as_float(w.x & 0xffff0000u); v[8 * j + 2] = __uint_as_float(w.y << 16); v[8 * j + 3] = __uint_as_float(w.y & 0xffff0000u);
            v[8 * j + 4] = __uint_as_float(w.z << 16); v[8 * j + 5] = __uint_as_float(w.z & 0xffff0000u); v[8 * j + 6] = __uint_as_float(w.w << 16); v[8 * j + 7] = __uint_as_float(w.w & 0xffff0000u); }
#pragma unroll
        for (int i = 0; i < 16; ++i) s += v[i] * v[i];
        const float rstd = 1.0f / sqrtf(wave_sum(s) * (1.0f / DM) + EPS);
#pragma unroll
        for (int j = 0; j < 2; ++j)
#pragma unroll
            for (int h = 0; h < 2; ++h) { const f32x4 g4 = gr[128 * j + h]; f32x4 o; o.x = v[8 * j + 4 * h] * rstd * g4.x; o.y = v[8 * j + 4 * h + 1] * rstd * g4.y; o.z = v[8 * j + 4 * h + 2] * rstd * g4.z; o.w = v[8 * j + 4 * h + 3] * rstd * g4.w;
                orow[128 * j + h] = o; }
    }
}

__device__ __forceinline__ void kmean_unit(Frame& F, int b, int n) {
    const bf16* kp = WSB(WS_KA) + ((size_t)b * SEQ + (size_t)n * 256) * 512 + F.tid; float s = 0.f;
#pragma unroll 8
    for (int j = 0; j < 256; ++j) s += bf2f(kp[(size_t)j * 512]);
    WSF(WS_KMEAN)[((size_t)b * NBLK + n) * 512 + F.tid] = s * (1.0f / 256.0f);
}
__device__ __forceinline__ float sigmoidf_(float v) { return 1.0f / (1.0f + __expf(-v)); }
typedef short bf16x8_t __attribute__((ext_vector_type(8)));
constexpr int RG_XB_STRIDE = 72;
constexpr int RG_XRAW = 0, RG_YRAW = 2048, RG_XB = 4096, RG_PR = RG_XB + 16 * RG_XB_STRIDE * 2, RG_PI = RG_PR + 16 * 64 * 4, RG_WAVE_LDS = RG_PI + 16 * 64 * 4;
static_assert(8 * RG_WAVE_LDS <= RING_BYTES, "rg LDS");
template <bool P2> __device__ __forceinline__ void rg_unit(Frame& F, int l, int b, int c) {
    int d_ = F.lane; asm volatile("" : "+v"(d_));
    const int n = F.wave, d = d_, ch = n * 64 + d;
    LAS unsigned char* wl = F.lds + RING_OFF + n * RG_WAVE_LDS;
    LAS bf16* xraw = (LAS bf16*)(wl + RG_XRAW); LAS bf16* yraw = (LAS bf16*)(wl + RG_YRAW); LAS bf16* xb = (LAS bf16*)(wl + RG_XB); LAS float* prl = (LAS float*)(wl + RG_PR); LAS float* pil = (LAS float*)(wl + RG_PI);
    const int col = d & 15, kq = d >> 4;
    bf16x8_t wfr[2][4], wfi[2][4];
    { const GAS float* prs = (const GAS float*)INP(I_WR) + (((size_t)l * 8 + n) * 64) * 64 + (8 * kq * 64 + col); const GAS float* pis = (const GAS float*)INP(I_WI) + (((size_t)l * 8 + n) * 64) * 64 + (8 * kq * 64 + col);
#pragma unroll
      for (int ks = 0; ks < 2; ++ks)
#pragma unroll
        for (int nb = 0; nb < 4; ++nb) { float tr[8], ti[8];
#pragma unroll
            for (int j = 0; j < 8; ++j) { const int o = (32 * ks + j) * 64 + 16 * nb; tr[j] = prs[o]; ti[j] = pis[o]; }
            union { bf16x8_t v; unsigned u[4]; } ur, ui;
#pragma unroll
            for (int j = 0; j < 4; ++j) { ur.u[j] = pk2(tr[2 * j], tr[2 * j + 1]); ui.u[j] = pk2(ti[2 * j], ti[2 * j + 1]); }
            wfr[ks][nb] = ur.v; wfi[ks][nb] = ui.v; } }
    const float br = ((const GAS float*)INP(I_BR) + l * 512)[ch], bi = ((const GAS float*)INP(I_BI) + l * 512)[ch];
    const float lamv = ((const GAS float*)INP(I_LAM) + l * 512)[ch]; const float sp = log1pf(__expf(-lamv));
    const GAS float* cwp = (const GAS float*)INP(I_CONVW) + (size_t)l * 4 * 512;
    const float cw0 = cwp[ch], cw1 = cwp[512 + ch], cw2 = cwp[1024 + ch], cw3 = cwp[1536 + ch];
    const float cb = ((const GAS float*)INP(I_CONVB) + l * 512)[ch];
    float h = 0.f, A = 1.f;
    if (P2) { const GAS float* ra = (const GAS float*)WSF(WS_RGA) + (size_t)b * RGC * 512; const GAS float* rh = (const GAS float*)WSF(WS_RGH) + (size_t)b * RGC * 512;
        const GAS float* rap = ra + ch; const GAS float* rhp = rh + ch;
        int j = 0;
#pragma unroll 1
        for (; j + 4 <= c; j += 4) { const float a0 = rap[0], a1 = rap[512], a2 = rap[1024], a3 = rap[1536], h0 = rhp[0], h1 = rhp[512], h2 = rhp[1024], h3 = rhp[1536];
            h = a0 * h + h0; h = a1 * h + h1; h = a2 * h + h2; h = a3 * h + h3; rap += 2048; rhp += 2048; }
#pragma unroll 1
        for (; j < c; ++j) { h = rap[0] * h + rhp[0]; rap += 512; rhp += 512; } }
    const int t0 = c * (SEQ / RGC);
    const GAS bf16* xcs = (const GAS bf16*)WSB(WS_XC) + ((size_t)b * SEQ + t0) * 512;
    GAS bf16* ycs = (GAS bf16*)WSB(WS_YC) + ((size_t)b * SEQ + t0) * 512;
    float x1 = 0.f, x2 = 0.f, x3 = 0.f;
    if (t0 > 0) { const GAS bf16* xm = xcs - 3 * 512; x3 = bf2f(xm[ch]); x2 = bf2f(xm[512 + ch]); x1 = bf2f(xm[1024 + ch]); }
    const int tokA = d >> 3, chk = d & 7;
    const size_t goff = (size_t)tokA * 512 + n * 64 + chk * 8;
    const int loff = tokA * 64 + chk * 8;
#pragma unroll 1
    for (int tile = 0; tile < SEQ / RGC / 16; ++tile) {
        const GAS bf16* xt = xcs + (size_t)tile * 16 * 512 + goff; GAS bf16* yt = ycs + (size_t)tile * 16 * 512 + goff;
        { const v4u a0 = *(const GAS v4u*)xt, a1 = *(const GAS v4u*)(xt + 8 * 512); *(LAS v4u*)(xraw + loff) = a0; *(LAS v4u*)(xraw + loff + 8 * 64) = a1; }
        if (P2) { const v4u a0 = *(const GAS v4u*)yt, a1 = *(const GAS v4u*)(yt + 8 * 512); *(LAS v4u*)(yraw + loff) = a0; *(LAS v4u*)(yraw + loff + 8 * 64) = a1; }
        LDS_WAIT(); asm volatile("" ::: "memory");
        float xc[16];
#pragma unroll
        for (int i = 0; i < 16; ++i) { const float xv = bf2f(xraw[i * 64 + d]); xc[i] = cb + cw0 * x3 + cw1 * x2 + cw2 * x1 + cw3 * xv; x3 = x2; x2 = x1; x1 = xv; }
#pragma unroll
        for (int i = 0; i < 16; ++i) xb[i * RG_XB_STRIDE + d] = (bf16)f2bf(xc[i]);
        LDS_WAIT(); asm volatile("" ::: "memory");
        bf16x8_t af[2];
#pragma unroll
        for (int ks = 0; ks < 2; ++ks) af[ks] = *(const LAS bf16x8_t*)(xb + col * RG_XB_STRIDE + 32 * ks + 8 * kq);
        f32x4 ar[4], ai[4];
#pragma unroll
        for (int nb = 0; nb < 4; ++nb) { ar[nb] = (f32x4){0.f, 0.f, 0.f, 0.f}; ai[nb] = (f32x4){0.f, 0.f, 0.f, 0.f};
#pragma unroll
            for (int ks = 0; ks < 2; ++ks) { ar[nb] = __builtin_amdgcn_mfma_f32_16x16x32_bf16(af[ks], wfr[ks][nb], ar[nb], 0, 0, 0); ai[nb] = __builtin_amdgcn_mfma_f32_16x16x32_bf16(af[ks], wfi[ks][nb], ai[nb], 0, 0, 0); } }
        asm volatile("s_nop 15\n\ts_nop 15" : "+v"(ar[0]), "+v"(ar[1]), "+v"(ar[2]), "+v"(ar[3]), "+v"(ai[0]), "+v"(ai[1]), "+v"(ai[2]), "+v"(ai[3]));
#pragma unroll
        for (int nb = 0; nb < 4; ++nb)
#pragma unroll
            for (int r = 0; r < 4; ++r) { prl[(4 * kq + r) * 64 + 16 * nb + col] = ar[nb][r]; pil[(4 * kq + r) * 64 + 16 * nb + col] = ai[nb][r]; }
        LDS_WAIT(); asm volatile("" ::: "memory");
#pragma unroll
        for (int i = 0; i < 16; ++i) {
            const float r = __builtin_amdgcn_rcpf(1.0f + __expf(-(prl[i * 64 + d] + br))), ig = __builtin_amdgcn_rcpf(1.0f + __expf(-(pil[i * 64 + d] + bi)));
            const float la = -8.0f * r * sp; const float a = __expf(la);
            const float x2a = 2.0f * la;
            const float om = (x2a > -0.05f) ? -x2a * (1.0f + x2a * (0.5f + x2a * (0.16666667f + x2a * 0.041666668f))) : 1.0f - a * a;
            const float u = __builtin_amdgcn_sqrtf(om) * (ig * xc[i]);
            h = a * h + u;
            if (!P2) A *= a;
            else { const float y = bf2f(yraw[i * 64 + d]); const float z = 0.7978845608028654f * (y + 0.044715f * y * y * y);
                const float th = 1.0f - 2.0f * __builtin_amdgcn_rcpf(1.0f + __expf(2.0f * z));
                yraw[i * 64 + d] = (bf16)f2bf(h * (0.5f * y * (1.0f + th))); }
        }
        LDS_WAIT(); asm volatile("" ::: "memory");
        if (P2) { const v4u a0 = *(const LAS v4u*)(yraw + loff), a1 = *(const LAS v4u*)(yraw + loff + 8 * 64); *(GAS v4u*)yt = a0; *(GAS v4u*)(yt + 8 * 512) = a1; }
        LDS_WAIT(); asm volatile("" ::: "memory");
    }
    if (!P2) { const size_t o = ((size_t)b * RGC + c) * 512; ((GAS float*)WSF(WS_RGA) + o)[ch] = A; ((GAS float*)WSF(WS_RGH) + o)[ch] = h; }
    __syncthreads();
}

__device__ __forceinline__ float dot64(const LAS float* qs, const bf16* krow) {
    const v4u* kr = (const v4u*)krow; float s = 0.f;
#pragma unroll
    for (int c = 0; c < 8; ++c) { const v4u w = kr[c]; const f32x4 q0 = *(const LAS f32x4*)(qs + c * 8), q1 = *(const LAS f32x4*)(qs + c * 8 + 4);
        s += q0.x * __uint_as_float(w.x << 16) + q0.y * __uint_as_float(w.x & 0xffff0000u) + q0.z * __uint_as_float(w.y << 16) + q0.w * __uint_as_float(w.y & 0xffff0000u)
           + q1.x * __uint_as_float(w.z << 16) + q1.y * __uint_as_float(w.z & 0xffff0000u) + q1.z * __uint_as_float(w.w << 16) + q1.w * __uint_as_float(w.w & 0xffff0000u); }
    return s;
}
__device__ __forceinline__ void moba_unit(Frame& F, int b, int t) {
    const int h = F.wave, lane = F.lane, cur = t >> 8;
    LAS float* qs = (LAS float*)(F.lds + GL_QS) + h * 64; LAS float* ps = (LAS float*)(F.lds + GL_PS) + h * 1024;
    const size_t row = (size_t)b * SEQ + t;
    bf16* qrow = WSB(WS_QA) + row * 512 + h * 64;
    qs[lane] = bf2f(qrow[lane]);
    LDS_WAIT(); asm volatile("" ::: "memory");
    float g = -1e30f;
    if (lane < cur) { const float* km = WSF(WS_KMEAN) + ((size_t)b * NBLK + lane) * 512 + h * 64; float s = 0.f;
#pragma unroll
        for (int d4 = 0; d4 < 16; ++d4) { const f32x4 kv = *(const f32x4*)(km + d4 * 4); const f32x4 qv = *(const LAS f32x4*)(qs + d4 * 4); s += kv.x * qv.x + kv.y * qv.y + kv.z * qv.z + kv.w * qv.w; }
        g = s; }
    int blk[4]; bool ok[4];
#pragma unroll
    for (int i = 0; i < 3; ++i) { const float m = wave_max(g); const unsigned long long bal = __ballot(g == m); const int sel = __ffsll((long long)bal) - 1; blk[i] = sel; ok[i] = sel < cur; if (lane == sel) g = -INFINITY; }
    blk[3] = cur; ok[3] = true;
    const bf16* Kh = WSB(WS_KA) + ((size_t)b * SEQ) * 512 + h * 64; const bf16* Vh = WSB(WS_VA) + ((size_t)b * SEQ) * 512 + h * 64;
    float lg[16];
#pragma unroll
    for (int i = 0; i < 16; ++i) { const int bi = i >> 2; const int pos = blk[bi] * 256 + (i & 3) * 64 + lane; const bool valid = ok[bi] && pos <= t;
        float s = -1e30f;
        if (valid) s = dot64(qs, Kh + (size_t)pos * 512) * 0.125f + INP(I_RELB)[t5_bucket(t - pos) * 16 + h];
        lg[i] = s; if ((i & 3) == 3) asm volatile("" ::: "memory"); }
    float m = lg[0];
#pragma unroll
    for (int i = 1; i < 16; ++i) m = fmaxf(m, lg[i]);
    m = wave_max(m); float sum = 0.f;
#pragma unroll
    for (int i = 0; i < 16; ++i) { const float e = __expf(lg[i] - m); sum += e; ps[i * 64 + lane] = e; }
    sum = wave_sum(sum);
    LDS_WAIT(); asm volatile("" ::: "memory");
    float acc = 0.f;
#pragma unroll
    for (int bi = 0; bi < 4; ++bi) {
        if (!ok[bi]) continue;
        const int base = blk[bi] * 256; const int nk = (bi == 3) ? (t - base + 1) : 256;
        const bf16* vp = Vh + (size_t)base * 512 + lane; const LAS float* pp = ps + bi * 256;
        int kk = 0;
        for (; kk + 8 <= nk; kk += 8) { float pv[8], vv[8];
#pragma unroll
            for (int j = 0; j < 8; ++j) { pv[j] = pp[kk + j]; vv[j] = bf2f(vp[(size_t)(kk + j) * 512]); }
#pragma unroll
            for (int j = 0; j < 8; ++j) acc += pv[j] * vv[j]; }
        for (; kk < nk; ++kk) acc += pp[kk] * bf2f(vp[(size_t)kk * 512]);
    }
    qrow[lane] = (bf16)f2bf(acc / sum);
}
__device__ __forceinline__ void dsa_unit(Frame& F, int b, int t) {
    const int tid = F.tid, lane = F.lane, h = F.wave;
    LAS unsigned* skey = (LAS unsigned*)(F.lds + GL_SKEY); LAS float* qif = (LAS float*)(F.lds + GL_QIF); LAS float* wq = (LAS float*)(F.lds + GL_WQ);
    LAS unsigned* hist = (LAS unsigned*)(F.lds + GL_HIST); LAS int* sel = (LAS int*)(F.lds + GL_SEL); LAS unsigned* misc = (LAS unsigned*)(F.lds + GL_MISC);
    const size_t row = (size_t)b * SEQ + t; const int n = t + 1;
    __syncthreads();
    qif[tid] = bf2f(WSB(WS_QI)[row * 512 + tid]);
    if (tid < 8) wq[tid] = WSF(WS_WI)[row * 8 + tid];
    if (tid < 16) misc[tid] = 0u;
    __syncthreads();
    if (n > 256) {
        const bf16* kib = WSB(WS_KI) + ((size_t)b * SEQ) * 64;
        for (int s = tid; s < n; s += NWAVES * 64) {
            float kf[64];
            { const v4u* kr = (const v4u*)(kib + (size_t)s * 64);
#pragma unroll
              for (int c = 0; c < 8; ++c) { const v4u w = kr[c]; kf[c * 8 + 0] = __uint_as_float(w.x << 16); kf[c * 8 + 1] = __uint_as_float(w.x & 0xffff0000u); kf[c * 8 + 2] = __uint_as_float(w.y << 16); kf[c * 8 + 3] = __uint_as_float(w.y & 0xffff0000u);
                  kf[c * 8 + 4] = __uint_as_float(w.z << 16); kf[c * 8 + 5] = __uint_as_float(w.z & 0xffff0000u); kf[c * 8 + 6] = __uint_as_float(w.w << 16); kf[c * 8 + 7] = __uint_as_float(w.w & 0xffff0000u); } }
            float score = 0.f;
#pragma unroll 1
            for (int hh = 0; hh < 8; ++hh) { float dsum = 0.f;
#pragma unroll
                for (int d4 = 0; d4 < 16; ++d4) { const f32x4 q = *(const LAS f32x4*)(qif + hh * 64 + d4 * 4); dsum += q.x * kf[d4 * 4] + q.y * kf[d4 * 4 + 1] + q.z * kf[d4 * 4 + 2] + q.w * kf[d4 * 4 + 3]; }
                score += wq[hh] * fmaxf(dsum, 0.f); asm volatile("" ::: "memory"); }
            score *= 0.04419417382415922f;
            if (score == 0.f) score = 0.f;
            const unsigned u = __float_as_uint(score);
            skey[s] = (u & 0x80000000u) ? ~u : (u | 0x80000000u);
        }
        __syncthreads();
        unsigned prefix = 0u; unsigned kneed = 256u, neq = 0u;
#pragma unroll
        for (int pass = 0; pass < 4; ++pass) {
            const int shift = 24 - 8 * pass;
            if (tid < 256) hist[tid] = 0u;
            __syncthreads();
            for (int s = tid; s < n; s += NWAVES * 64) { const unsigned key = skey[s]; const bool match = (pass == 0) ? true : ((key >> ((shift + 8) & 31)) == prefix);
                if (match) __hip_atomic_fetch_add(hist + ((key >> shift) & 255u), 1u, __ATOMIC_RELAXED, __HIP_MEMORY_SCOPE_WORKGROUP); }
            __syncthreads();
            if (h == 0) {
                const unsigned c0 = hist[4 * lane], c1 = hist[4 * lane + 1], c2 = hist[4 * lane + 2], c3 = hist[4 * lane + 3]; const unsigned tot = c0 + c1 + c2 + c3;
                unsigned S = tot;
#pragma unroll
                for (int o = 1; o < 64; o <<= 1) { const unsigned v = __shfl_down(S, o); if (lane + o < 64) S += v; }
                const unsigned above = S - tot;
                if (above < kneed && kneed <= S) { unsigned a = above; unsigned bsel, cnt;
                    if (a + c3 >= kneed) { bsel = 3; cnt = c3; } else { a += c3; if (a + c2 >= kneed) { bsel = 2; cnt = c2; } else { a += c2; if (a + c1 >= kneed) { bsel = 1; cnt = c1; } else { a += c1; bsel = 0; cnt = c0; } } }
                    misc[0] = 4u * lane + bsel; misc[1] = kneed - a; misc[2] = cnt; }
            }
            __syncthreads();
            prefix = (prefix << 8) | misc[0]; kneed = misc[1]; neq = misc[2];
            __syncthreads();
        }
        const unsigned Tk = prefix;
        for (int s = tid; s < n; s += NWAVES * 64) { const unsigned key = skey[s];
            if (key > Tk || (key == Tk && neq == kneed)) { const unsigned idx = __hip_atomic_fetch_add(misc + 8, 1u, __ATOMIC_RELAXED, __HIP_MEMORY_SCOPE_WORKGROUP); if (idx < 256u) sel[idx] = s; } }
        __syncthreads();
        if (neq != kneed && tid == 0) { unsigned c = misc[8]; unsigned need = kneed; for (int s = 0; s < n && need > 0u && c < 256u; ++s) if (skey[s] == Tk) { sel[c++] = s; --need; } }
    } else {
        if (tid < 256) sel[tid] = (tid <= t) ? tid : -1;
    }
    __syncthreads();
    LAS float* qs = (LAS float*)(F.lds + GL_QS) + h * 64; LAS float* ps = (LAS float*)(F.lds + GL_PS) + h * 1024;
    bf16* qrow = WSB(WS_QB) + row * 512 + h * 64;
    qs[lane] = bf2f(qrow[lane]);
    LDS_WAIT(); asm volatile("" ::: "memory");
    const bf16* Kh = WSB(WS_KB) + ((size_t)b * SEQ) * 512 + h * 64; const bf16* Vh = WSB(WS_VB) + ((size_t)b * SEQ) * 512 + h * 64;
    float lg[4];
#pragma unroll
    for (int i = 0; i < 4; ++i) { const int pos = sel[i * 64 + lane]; float s = -1e30f;
        if (pos >= 0) s = dot64(qs, Kh + (size_t)pos * 512) * 0.125f + INP(I_RELB)[t5_bucket(t - pos) * 16 + 8 + h];
        lg[i] = s; }
    float m = wave_max(fmaxf(fmaxf(lg[0], lg[1]), fmaxf(lg[2], lg[3]))); float sum = 0.f;
#pragma unroll
    for (int i = 0; i < 4; ++i) { const float e = __expf(lg[i] - m); sum += e; ps[i * 64 + lane] = e; }
    sum = wave_sum(sum);
    LDS_WAIT(); asm volatile("" ::: "memory");
    float acc = 0.f; const int nk = n < 256 ? n : 256;
    int kk = 0;
    for (; kk + 8 <= nk; kk += 8) { float pv[8], vv[8];
#pragma unroll
        for (int j = 0; j < 8; ++j) { const int pos = sel[kk + j]; pv[j] = ps[kk + j]; vv[j] = bf2f(Vh[(size_t)pos * 512 + lane]); }
#pragma unroll
        for (int j = 0; j < 8; ++j) acc += pv[j] * vv[j]; }
    for (; kk < nk; ++kk) { const int pos = sel[kk]; acc += ps[kk] * bf2f(Vh[(size_t)pos * 512 + lane]); }
    qrow[lane] = (bf16)f2bf(acc / sum);
}

typedef float f32x16 __attribute__((ext_vector_type(16)));
constexpr int AT_KROW = 144, AT_VROW = 136;
constexpr int AT_KBUF = 64 * AT_KROW, AT_VBUF = 64 * AT_VROW;
constexpr int AT_K0 = 0, AT_V0 = 2 * AT_KBUF, AT_BT = 36864, AT_OST = 40960;
constexpr float AT_C2 = 0.125f * 1.4426950408889634f;
constexpr float AT_THR = 8.0f;
constexpr float LOG2E = 1.4426950408889634f;
__device__ __forceinline__ int crow_(int r, int hi) { return (r & 3) + 8 * (r >> 2) + 4 * hi; }
#define MFMA_FENCE2(a, b) asm volatile("s_nop 15\n\ts_nop 15" : "+v"(a), "+v"(b))

__device__ __forceinline__ void at_load(const GAS bf16* Kh, const GAS bf16* Vh, int tile, int tid, v4u& kr, v4u& vr) {
    kr = *(const GAS v4u*)(Kh + (size_t)(tile * 64 + (tid >> 3)) * 512 + (tid & 7) * 8);
    vr = *(const GAS v4u*)(Vh + (size_t)(tile * 64 + (tid >> 3)) * 512 + (tid & 7) * 8);
}
__device__ __forceinline__ void at_store(LAS unsigned char* kb, LAS unsigned char* vb, int tid, const v4u kr, const v4u vr) {
    *(LAS v4u*)(kb + (tid >> 3) * AT_KROW + (tid & 7) * 16) = kr;
    LAS bf16* vt = (LAS bf16*)(vb + ((tid & 7) * 8) * AT_VROW) + (tid >> 3);
    constexpr int RS = AT_VROW / 2;
    vt[0 * RS] = (bf16)(vr.x & 0xffffu); vt[1 * RS] = (bf16)(vr.x >> 16); vt[2 * RS] = (bf16)(vr.y & 0xffffu); vt[3 * RS] = (bf16)(vr.y >> 16);
    vt[4 * RS] = (bf16)(vr.z & 0xffffu); vt[5 * RS] = (bf16)(vr.z >> 16); vt[6 * RS] = (bf16)(vr.w & 0xffffu); vt[7 * RS] = (bf16)(vr.w >> 16);
}
__device__ __forceinline__ void at_qk(f32x16& p0, f32x16& p1, const LAS unsigned char* kb, const bf16x8_t (&qf)[4], int r32, int hi) {
    const LAS unsigned char* kp = kb + r32 * AT_KROW + hi * 16;
    bf16x8_t k0[4], k1[4];
#pragma unroll
    for (int s = 0; s < 4; ++s) { k0[s] = *(const LAS bf16x8_t*)(kp + s * 32); k1[s] = *(const LAS bf16x8_t*)(kp + 32 * AT_KROW + s * 32); }
    asm volatile("s_waitcnt lgkmcnt(0)" : "+v"(k0[0]), "+v"(k0[1]), "+v"(k0[2]), "+v"(k0[3]), "+v"(k1[0]), "+v"(k1[1]), "+v"(k1[2]), "+v"(k1[3]) :: "memory");
#pragma unroll
    for (int s = 0; s < 4; ++s) { p0 = __builtin_amdgcn_mfma_f32_32x32x16_bf16(k0[s], qf[s], p0, 0, 0, 0); p1 = __builtin_amdgcn_mfma_f32_32x32x16_bf16(k1[s], qf[s], p1, 0, 0, 0); }
}
__device__ __forceinline__ void at_qk_m(f32x16& p0, f32x16& p1, const LAS unsigned char* kb, const bf16x8_t (&qf)[4], const bf16x8_t oneA, const bf16x8_t mB, int r32, int hi) {
    const LAS unsigned char* kp = kb + r32 * AT_KROW + hi * 16;
    bf16x8_t k0[4], k1[4];
#pragma unroll
    for (int s = 0; s < 4; ++s) { k0[s] = *(const LAS bf16x8_t*)(kp + s * 32); k1[s] = *(const LAS bf16x8_t*)(kp + 32 * AT_KROW + s * 32); }
    p0 = __builtin_amdgcn_mfma_f32_32x32x16_bf16(oneA, mB, p0, 0, 0, 0); p1 = __builtin_amdgcn_mfma_f32_32x32x16_bf16(oneA, mB, p1, 0, 0, 0);
    asm volatile("s_waitcnt lgkmcnt(0)" : "+v"(k0[0]), "+v"(k0[1]), "+v"(k0[2]), "+v"(k0[3]), "+v"(k1[0]), "+v"(k1[1]), "+v"(k1[2]), "+v"(k1[3]) :: "memory");
#pragma unroll
    for (int s = 0; s < 4; ++s) { p0 = __builtin_amdgcn_mfma_f32_32x32x16_bf16(k0[s], qf[s], p0, 0, 0, 0); p1 = __builtin_amdgcn_mfma_f32_32x32x16_bf16(k1[s], qf[s], p1, 0, 0, 0); }
}
__device__ __forceinline__ void at_pv(f32x16& o0, f32x16& o1, const LAS unsigned char* vb, const bf16x8_t (&pb)[4], int r32, int hi) {
    const LAS unsigned char* vp = vb + r32 * AT_VROW + hi * 8;
    union U { bf16x8_t v; unsigned long long u[2]; }; U a0[4], a1[4];
#pragma unroll
    for (int sg = 0; sg < 4; ++sg) { const int kvo = (32 * (sg >> 1) + 16 * (sg & 1)) * 2;
        a0[sg].u[0] = *(const LAS unsigned long long*)(vp + kvo); a0[sg].u[1] = *(const LAS unsigned long long*)(vp + kvo + 16);
        a1[sg].u[0] = *(const LAS unsigned long long*)(vp + 32 * AT_VROW + kvo); a1[sg].u[1] = *(const LAS unsigned long long*)(vp + 32 * AT_VROW + kvo + 16); }
    asm volatile("s_waitcnt lgkmcnt(0)" : "+v"(a0[0].v), "+v"(a0[1].v), "+v"(a0[2].v), "+v"(a0[3].v), "+v"(a1[0].v), "+v"(a1[1].v), "+v"(a1[2].v), "+v"(a1[3].v) :: "memory");
#pragma unroll
    for (int sg = 0; sg < 4; ++sg) { o0 = __builtin_amdgcn_mfma_f32_32x32x16_bf16(a0[sg].v, pb[sg], o0, 0, 0, 0); o1 = __builtin_amdgcn_mfma_f32_32x32x16_bf16(a1[sg].v, pb[sg], o1, 0, 0, 0); }
}
__device__ __forceinline__ float max3_(float a, float b, float c) { float r; asm("v_max3_f32 %0, %1, %2, %3" : "=v"(r) : "v"(a), "v"(b), "v"(c)); return r; }
__device__ __forceinline__ unsigned and_sel(float p, unsigned w, int bit) { int t; asm("v_bfe_i32 %0, %1, %2, 1" : "=v"(t) : "v"(w), "n"(bit)); return __float_as_uint(p) & (unsigned)t; }

template <int MODE  , bool DRY = false  >
__device__ __forceinline__ void attn_unit(Frame& F, int b, int h, int qt) {
    int tid_ = F.tid; asm volatile("" : "+v"(tid_));
    const int tid = tid_, lane = tid & 63, wave = F.wave, r32 = lane & 31, hi = lane >> 5;
    LAS unsigned char* L = F.lds + RING_OFF;
    LAS float* bt = (LAS float*)(L + AT_BT);
    const GAS bf16* Qg = (const GAS bf16*)WSB(MODE == 0 ? WS_QA : WS_QB); const GAS bf16* Kg = (const GAS bf16*)WSB(MODE == 0 ? WS_KA : WS_KB); const GAS bf16* Vg = (const GAS bf16*)WSB(MODE == 0 ? WS_VA : WS_VB);
    const size_t rowb = (size_t)b * SEQ;
    const GAS bf16* Kh = Kg + rowb * 512 + h * 64; const GAS bf16* Vh = Vg + rowb * 512 + h * 64;
    const int q0w = qt * 256 + wave * 32, q = q0w + r32;
    const int NT = 4 * qt + 4;
    __syncthreads();
    if (tid < 128) { const GAS float* rb = (const GAS float*)INP(I_RELB) + (MODE * 8 + h); bt[tid] = (rb[t5_bucket(tid) * 16] - rb[31 * 16]) * LOG2E; }
    bf16x8_t qf[4];
    { const GAS bf16* qp = Qg + (rowb + q) * 512 + h * 64 + hi * 8;
#pragma unroll
      for (int s = 0; s < 4; ++s) qf[s] = *(const GAS bf16x8_t*)(qp + s * 16); }
    unsigned mlo = 0u, mhi = 0u;
    if (MODE == 0) {
        { const int n = tid >> 3, c8 = (tid & 7) * 8; const GAS float* km = (const GAS float*)WSF(WS_KMEAN) + ((size_t)b * NBLK + n) * 512 + h * 64 + c8;
          const f32x4 a = *(const GAS f32x4*)km, c = *(const GAS f32x4*)(km + 4);
          const unsigned h0 = pk2(a.x, a.y), h1 = pk2(a.z, a.w), h2 = pk2(c.x, c.y), h3 = pk2(c.z, c.w);
          const unsigned l0 = pk2(a.x - __uint_as_float(h0 << 16), a.y - __uint_as_float(h0 & 0xffff0000u)), l1 = pk2(a.z - __uint_as_float(h1 << 16), a.w - __uint_as_float(h1 & 0xffff0000u)),
                         l2 = pk2(c.x - __uint_as_float(h2 << 16), c.y - __uint_as_float(h2 & 0xffff0000u)), l3 = pk2(c.z - __uint_as_float(h3 << 16), c.w - __uint_as_float(h3 & 0xffff0000u));
          *(LAS v4u*)(L + AT_K0 + n * AT_KROW + (tid & 7) * 16) = (v4u){h0, h1, h2, h3}; *(LAS v4u*)(L + AT_K0 + AT_KBUF + n * AT_KROW + (tid & 7) * 16) = (v4u){l0, l1, l2, l3}; }
        __syncthreads();
        f32x16 g0 = {0.f, 0.f, 0.f, 0.f, 0.f, 0.f, 0.f, 0.f, 0.f, 0.f, 0.f, 0.f, 0.f, 0.f, 0.f, 0.f}, g1 = g0;
        at_qk(g0, g1, L + AT_K0, qf, r32, hi); at_qk(g0, g1, L + AT_K0 + AT_KBUF, qf, r32, hi);
        MFMA_FENCE2(g0, g1);
#pragma unroll
        for (int r = 0; r < 16; ++r) { if (crow_(r, hi) >= qt) g0[r] = -INFINITY; if (32 + crow_(r, hi) >= qt) g1[r] = -INFINITY; }
#pragma unroll
        for (int it = 0; it < 3; ++it) {
            float bv = -INFINITY; int bn = 64;
#pragma unroll
            for (int r = 0; r < 16; ++r) if (g0[r] > bv) { bv = g0[r]; bn = crow_(r, hi); }
#pragma unroll
            for (int r = 0; r < 16; ++r) if (g1[r] > bv) { bv = g1[r]; bn = 32 + crow_(r, hi); }
            const float pv = __shfl_xor(bv, 32); const int pn = __shfl_xor(bn, 32);
            const bool tp = (pv > bv) || (pv == bv && pn < bn);
            const float wv = tp ? pv : bv; const int wn = tp ? pn : bn;
            if (wv > -INFINITY) { if (wn < 32) mlo |= 1u << wn; else mhi |= 1u << (wn - 32); }
#pragma unroll
            for (int r = 0; r < 16; ++r) { if (crow_(r, hi) == wn) g0[r] = -INFINITY; if (32 + crow_(r, hi) == wn) g1[r] = -INFINITY; }
        }
        __syncthreads();
    }
    v4u krA, vrA, krB, vrB; unsigned wlA = 0u, whA = 0u, wlB = 0u, whB = 0u;
    const GAS unsigned* mrow = (const GAS unsigned*)(F.ws + WS_MASK) + (rowb + q) * 512;
    at_load(Kh, Vh, 0, tid, krA, vrA);
    unsigned wl_c = 0u, wh_c = 0u;
    if (MODE == 1) { wl_c = mrow[0]; wh_c = mrow[1]; }
    at_store(L + AT_K0, L + AT_V0, tid, krA, vrA);
    at_load(Kh, Vh, 1, tid, krA, vrA);
    if (MODE == 1) { wlA = mrow[2]; whA = mrow[3]; }
    __syncthreads();
    float m = -1e30f, lsum = 0.f;
    f32x16 o0 = {0.f, 0.f, 0.f, 0.f, 0.f, 0.f, 0.f, 0.f, 0.f, 0.f, 0.f, 0.f, 0.f, 0.f, 0.f, 0.f}, o1 = o0;
    auto step = [&](int t, v4u& krS, v4u& vrS, unsigned& wlS, unsigned& whS, v4u& krN, v4u& vrN, unsigned& wlN, unsigned& whN) __attribute__((always_inline)) {
        const int cur = t & 1;
        unsigned wlo = wl_c, whi = wh_c;
        if (t + 2 < NT) { at_load(Kh, Vh, t + 2, tid, krN, vrN); if (MODE == 1) { wlN = mrow[2 * (t + 2)]; whN = mrow[2 * (t + 2) + 1]; } }
        if (MODE == 0) {
            if (t < 4 * qt) { const int blk = t >> 2; const unsigned bit = (blk < 32 ? (mlo >> blk) : (mhi >> (blk - 32))) & 1u; wlo = whi = bit ? 0xffffffffu : 0u; }
            else { const int nall = q - t * 64 + 1;
                wlo = nall >= 32 ? 0xffffffffu : (nall <= 0 ? 0u : ((1u << nall) - 1u)); whi = nall >= 64 ? 0xffffffffu : (nall <= 32 ? 0u : ((1u << (nall - 32)) - 1u)); }
        }
        if (__any((wlo | whi) != 0u)) {
            const LAS unsigned char* kb = L + AT_K0 + cur * AT_KBUF; const LAS unsigned char* vb = L + AT_V0 + cur * AT_VBUF;
            const bool and_mask = (MODE == 1) || (t >= 4 * qt);
            const float ci = (!and_mask && wlo == 0u) ? -1e9f : 0.f;
            f32x16 p0 = {ci, ci, ci, ci, ci, ci, ci, ci, ci, ci, ci, ci, ci, ci, ci, ci}, p1 = p0;
            at_qk(p0, p1, kb, qf, r32, hi);
            MFMA_FENCE2(p0, p1);
            const bool near = (t * 64 + 191 > q0w);
            float mx; float sc = AT_C2;
            if (near) {
#pragma unroll
                for (int r = 0; r < 16; ++r) { const int d0 = q - (t * 64 + crow_(r, hi)), d1 = d0 - 32;
                    const float b0 = ((unsigned)d0 < 128u) ? bt[d0] : 0.f, b1 = ((unsigned)d1 < 128u) ? bt[d1] : 0.f;
                    p0[r] = p0[r] * AT_C2 + b0; p1[r] = p1[r] * AT_C2 + b1; }
                sc = 1.0f;
            }
            { float ma = max3_(p0[0], p1[0], p0[1]), mb = max3_(p1[1], p0[2], p1[2]), mc = max3_(p0[3], p1[3], p0[4]), md = max3_(p1[4], p0[5], p1[5]);
              ma = max3_(ma, p0[6], p1[6]); mb = max3_(mb, p0[7], p1[7]); mc = max3_(mc, p0[8], p1[8]); md = max3_(md, p0[9], p1[9]);
              ma = max3_(ma, p0[10], p1[10]); mb = max3_(mb, p0[11], p1[11]); mc = max3_(mc, p0[12], p1[12]); md = max3_(md, p0[13], p1[13]);
              ma = max3_(ma, p0[14], p1[14]); mb = max3_(mb, p0[15], p1[15]); mx = max3_(ma, mb, mc); mx = max3_(mx, md, md); }
            mx = max3_(mx, __shfl_xor(mx, 32), mx) * sc;
            if (__any(mx > m + AT_THR)) {
                const float mn = fmaxf(m, mx); const float al = __builtin_amdgcn_exp2f(m - mn);
                MFMA_FENCE2(o0, o1);
#pragma unroll
                for (int r = 0; r < 16; ++r) { o0[r] *= al; o1[r] *= al; }
                lsum *= al; m = mn;
            }
            float ls = 0.f;
            if (and_mask) {
                const unsigned wl = wlo >> (4 * hi), wh = whi >> (4 * hi);
                float lq[4] = {0.f, 0.f, 0.f, 0.f};
#pragma unroll
                for (int r = 0; r < 16; ++r) { const int cb = (r & 3) + 8 * (r >> 2);
                    const float e0 = __uint_as_float(and_sel(__builtin_amdgcn_exp2f(__builtin_fmaf(p0[r], sc, -m)), wl, cb)), e1 = __uint_as_float(and_sel(__builtin_amdgcn_exp2f(__builtin_fmaf(p1[r], sc, -m)), wh, cb));
                    p0[r] = e0; p1[r] = e1; lq[r & 1] += e0; lq[2 + (r & 1)] += e1; }
                ls = (lq[0] + lq[1]) + (lq[2] + lq[3]);
            } else {
#pragma unroll
                for (int r = 0; r < 16; ++r) { const float e0 = __builtin_amdgcn_exp2f(__builtin_fmaf(p0[r], sc, -m)), e1 = __builtin_amdgcn_exp2f(__builtin_fmaf(p1[r], sc, -m));
                    p0[r] = e0; p1[r] = e1; ls += e0 + e1; }
            }
            lsum += ls;
            bf16x8_t pb[4];
#pragma unroll
            for (int sg = 0; sg < 4; ++sg) { union { bf16x8_t v; unsigned u[4]; } pk;
#pragma unroll
                for (int j = 0; j < 4; ++j) { const int r = 8 * (sg & 1) + 2 * j; pk.u[j] = (sg < 2) ? pg8::cvt_pk_bf16(p0[r], p0[r + 1]) : pg8::cvt_pk_bf16(p1[r], p1[r + 1]); }
                pb[sg] = pk.v; }
            at_pv(o0, o1, vb, pb, r32, hi);
        }
        if (t + 1 < NT) at_store(L + AT_K0 + (cur ^ 1) * AT_KBUF, L + AT_V0 + (cur ^ 1) * AT_VBUF, tid, krS, vrS);
        wl_c = wlS; wh_c = whS;
        __syncthreads();
    };
#pragma unroll 1
    for (int t = 0; t < NT; t += 2) {
        step(t, krA, vrA, wlA, whA, krB, vrB, wlB, whB);
        step(t + 1, krB, vrB, wlB, whB, krA, vrA, wlA, whA);
    }
    MFMA_FENCE2(o0, o1);
    lsum += __shfl_xor(lsum, 32);
    const float inv = 1.0f / lsum;
    LAS bf16* ost = (LAS bf16*)(L + AT_OST + wave * 4096);
#pragma unroll
    for (int r = 0; r < 16; ++r) { ost[r32 * 64 + crow_(r, hi)] = (bf16)f2bf(o0[r] * inv); ost[r32 * 64 + 32 + crow_(r, hi)] = (bf16)f2bf(o1[r] * inv); }
    LDS_WAIT(); asm volatile("" ::: "memory");
    GAS bf16* Og = (GAS bf16*)WSB(MODE == 0 ? WS_QA : WS_QB) + (rowb + q0w) * 512 + h * 64;
#pragma unroll
    for (int i = 0; i < 4; ++i) { const int c = i * 64 + lane, row = c >> 3, ch = c & 7; const v4u ov = *(const LAS v4u*)(ost + row * 64 + ch * 8); if (!DRY) *(GAS v4u*)(Og + (size_t)row * 512 + ch * 8) = ov; else if (ov.x == 0x12345678u && ov.y == 0x9abcdef0u) *(GAS v4u*)(Og + (size_t)row * 512 + ch * 8) = ov; }
}

constexpr int DA_K0 = 0, DA_V0 = 3 * AT_KBUF, DA_BT = DA_V0 + 2 * AT_VBUF, DA_OST = 49152;
static_assert(DA_BT + 512 <= DA_OST && DA_OST + 8 * 4096 <= RING_BYTES, "dsa attention LDS map");
__device__ __forceinline__ v4u at_load_k(const GAS bf16* Kh, int tile, int tid) { return *(const GAS v4u*)(Kh + (size_t)(tile * 64 + (tid >> 3)) * 512 + (tid & 7) * 8); }
__device__ __forceinline__ v4u at_load_v(const GAS bf16* Vh, int tile, int tid) { return *(const GAS v4u*)(Vh + (size_t)(tile * 64 + (tid & 63)) * 512 + (tid >> 6) * 8); }
__device__ __forceinline__ void at_store_k(LAS unsigned char* kb, int tid, const v4u kr) { *(LAS v4u*)(kb + (tid >> 3) * AT_KROW + (tid & 7) * 16) = kr; }
__device__ __forceinline__ void at_store_v(LAS unsigned char* vb, int tid, const v4u vr) {
    LAS bf16* vt = (LAS bf16*)(vb + ((tid >> 6) * 8) * AT_VROW) + (tid & 63); constexpr int RS = AT_VROW / 2;
    vt[0 * RS] = (bf16)(vr.x & 0xffffu); vt[1 * RS] = (bf16)(vr.x >> 16); vt[2 * RS] = (bf16)(vr.y & 0xffffu); vt[3 * RS] = (bf16)(vr.y >> 16);
    vt[4 * RS] = (bf16)(vr.z & 0xffffu); vt[5 * RS] = (bf16)(vr.z >> 16); vt[6 * RS] = (bf16)(vr.w & 0xffffu); vt[7 * RS] = (bf16)(vr.w >> 16);
}
struct DsaState { float m, lsum; f32x16 o0, o1; unsigned wc_lo, wc_hi, wn_lo, wn_hi; };
__device__ __forceinline__ void dsa_step(DsaState& S, f32x16& P0, f32x16& P1, f32x16& Pn0, f32x16& Pn1, int t, int NT, LAS unsigned char* L, const LAS float* bt, const bf16x8_t (&qf)[4],
                                         const GAS bf16* Kh, const GAS bf16* Vh, const GAS unsigned* mrow, int tid, int r32, int hi, int q, int q0w) {
    v4u krn, vrn; unsigned wq_lo = 0u, wq_hi = 0u;
    const bool has1 = (t + 1 < NT), has2 = (t + 2 < NT);
    if (has2) { krn = at_load_k(Kh, t + 2, tid); wq_lo = mrow[2 * (t + 2)]; wq_hi = mrow[2 * (t + 2) + 1]; }
    if (has1) vrn = at_load_v(Vh, t + 1, tid);
    if (has1 && __any((S.wn_lo | S.wn_hi) != 0u)) {
        Pn0 = (f32x16){0.f, 0.f, 0.f, 0.f, 0.f, 0.f, 0.f, 0.f, 0.f, 0.f, 0.f, 0.f, 0.f, 0.f, 0.f, 0.f}; Pn1 = Pn0;
        at_qk(Pn0, Pn1, L + DA_K0 + ((t + 1) % 3) * AT_KBUF, qf, r32, hi);
    }
    if (__any((S.wc_lo | S.wc_hi) != 0u)) {
        const LAS unsigned char* vb = L + DA_V0 + (t & 1) * AT_VBUF;
        MFMA_FENCE2(P0, P1);
        const bool near = (t * 64 + 191 > q0w);
        float sc = AT_C2;
        if (near) {
#pragma unroll
            for (int r = 0; r < 16; ++r) { const int d0 = q - (t * 64 + crow_(r, hi)), d1 = d0 - 32;
                const float b0 = ((unsigned)d0 < 128u) ? bt[d0] : 0.f, b1 = ((unsigned)d1 < 128u) ? bt[d1] : 0.f;
                P0[r] = P0[r] * AT_C2 + b0; P1[r] = P1[r] * AT_C2 + b1; }
            sc = 1.0f;
        }
        float mx = max3_(P0[0], P1[0], P0[1]), mx2 = max3_(P1[1], P0[2], P1[2]);
#pragma unroll
        for (int r = 3; r < 15; r += 2) { mx = max3_(mx, P0[r], P1[r]); mx2 = max3_(mx2, P0[r + 1], P1[r + 1]); }
        mx = max3_(mx, P0[15], P1[15]); mx = max3_(mx, mx2, mx2);
        mx = max3_(mx, __shfl_xor(mx, 32), mx) * sc;
        if (__any(mx > S.m + AT_THR)) {
            const float mn = fmaxf(S.m, mx); const float al = __builtin_amdgcn_exp2f(S.m - mn);
            MFMA_FENCE2(S.o0, S.o1);
#pragma unroll
            for (int r = 0; r < 16; ++r) { S.o0[r] *= al; S.o1[r] *= al; }
            S.lsum *= al; S.m = mn;
        }
        const unsigned wl = S.wc_lo >> (4 * hi), wh = S.wc_hi >> (4 * hi); const float m = S.m;
        float ls = 0.f;
#pragma unroll
        for (int r = 0; r < 16; ++r) { const int cb = (r & 3) + 8 * (r >> 2);
            const float e0 = __uint_as_float(and_sel(__builtin_amdgcn_exp2f(__builtin_fmaf(P0[r], sc, -m)), wl, cb)), e1 = __uint_as_float(and_sel(__builtin_amdgcn_exp2f(__builtin_fmaf(P1[r], sc, -m)), wh, cb));
            P0[r] = e0; P1[r] = e1; ls += e0 + e1; }
        S.lsum += ls;
        bf16x8_t pb[4];
#pragma unroll
        for (int sg = 0; sg < 4; ++sg) { union { bf16x8_t v; unsigned u[4]; } pk;
#pragma unroll
            for (int j = 0; j < 4; ++j) { const int r = 8 * (sg & 1) + 2 * j; pk.u[j] = (sg < 2) ? pg8::cvt_pk_bf16(P0[r], P0[r + 1]) : pg8::cvt_pk_bf16(P1[r], P1[r + 1]); }
            pb[sg] = pk.v; }
        at_pv(S.o0, S.o1, vb, pb, r32, hi);
    }
    if (has2) at_store_k(L + DA_K0 + ((t + 2) % 3) * AT_KBUF, tid, krn);
    if (has1) at_store_v(L + DA_V0 + ((t + 1) & 1) * AT_VBUF, tid, vrn);
    S.wc_lo = S.wn_lo; S.wc_hi = S.wn_hi; S.wn_lo = wq_lo; S.wn_hi = wq_hi;
    __syncthreads();
}
template <bool DRY = false> __device__ __forceinline__ void dsa_attn_unit(Frame& F, int b, int h, int qt) {
    int tid_ = F.tid; asm volatile("" : "+v"(tid_));
    const int tid = tid_, lane = tid & 63, wave = F.wave, r32 = lane & 31, hi = lane >> 5;
    LAS unsigned char* L = F.lds + RING_OFF;
    LAS float* bt = (LAS float*)(L + DA_BT);
    const size_t rowb = (size_t)b * SEQ;
    const GAS bf16* Kh = (const GAS bf16*)WSB(WS_KB) + rowb * 512 + h * 64; const GAS bf16* Vh = (const GAS bf16*)WSB(WS_VB) + rowb * 512 + h * 64;
    const int q0w = qt * 256 + wave * 32, q = q0w + r32;
    const int NT = 4 * qt + 4;
    __syncthreads();
    if (tid < 128) { const GAS float* rb = (const GAS float*)INP(I_RELB) + (8 + h); bt[tid] = (rb[t5_bucket(tid) * 16] - rb[31 * 16]) * LOG2E; }
    bf16x8_t qf[4];
    { const GAS bf16* qp = (const GAS bf16*)WSB(WS_QB) + (rowb + q) * 512 + h * 64 + hi * 8;
#pragma unroll
      for (int s = 0; s < 4; ++s) qf[s] = *(const GAS bf16x8_t*)(qp + s * 16); }
    const GAS unsigned* mrow = (const GAS unsigned*)(F.ws + WS_MASK) + (rowb + q) * 512;
    DsaState S; S.m = -1e30f; S.lsum = 0.f; S.o0 = (f32x16){0.f, 0.f, 0.f, 0.f, 0.f, 0.f, 0.f, 0.f, 0.f, 0.f, 0.f, 0.f, 0.f, 0.f, 0.f, 0.f}; S.o1 = S.o0;
    S.wc_lo = mrow[0]; S.wc_hi = mrow[1]; S.wn_lo = mrow[2]; S.wn_hi = mrow[3];
    { const v4u k0 = at_load_k(Kh, 0, tid), v0 = at_load_v(Vh, 0, tid), k1 = at_load_k(Kh, 1, tid);
      at_store_k(L + DA_K0, tid, k0); at_store_v(L + DA_V0, tid, v0); at_store_k(L + DA_K0 + AT_KBUF, tid, k1); }
    __syncthreads();
    f32x16 pA0 = {0.f, 0.f, 0.f, 0.f, 0.f, 0.f, 0.f, 0.f, 0.f, 0.f, 0.f, 0.f, 0.f, 0.f, 0.f, 0.f}, pA1 = pA0, pB0 = pA0, pB1 = pA0;
    if (__any((S.wc_lo | S.wc_hi) != 0u)) at_qk(pA0, pA1, L + DA_K0, qf, r32, hi);
#pragma unroll 1
    for (int t = 0; t < NT; t += 2) {
        dsa_step(S, pA0, pA1, pB0, pB1, t, NT, L, bt, qf, Kh, Vh, mrow, tid, r32, hi, q, q0w);
        dsa_step(S, pB0, pB1, pA0, pA1, t + 1, NT, L, bt, qf, Kh, Vh, mrow, tid, r32, hi, q, q0w);
    }
    MFMA_FENCE2(S.o0, S.o1);
    float lsum = S.lsum; lsum += __shfl_xor(lsum, 32);
    const float inv = 1.0f / lsum;
    LAS bf16* ost = (LAS bf16*)(L + DA_OST + wave * 4096);
#pragma unroll
    for (int r = 0; r < 16; ++r) { ost[r32 * 64 + crow_(r, hi)] = (bf16)f2bf(S.o0[r] * inv); ost[r32 * 64 + 32 + crow_(r, hi)] = (bf16)f2bf(S.o1[r] * inv); }
    LDS_WAIT(); asm volatile("" ::: "memory");
    GAS bf16* Og = (GAS bf16*)WSB(WS_QB) + (rowb + q0w) * 512 + h * 64;
#pragma unroll
    for (int i = 0; i < 4; ++i) { const int c = i * 64 + lane, row = c >> 3, ch = c & 7; const v4u ov = *(const LAS v4u*)(ost + row * 64 + ch * 8); if (!DRY) *(GAS v4u*)(Og + (size_t)row * 512 + ch * 8) = ov; else if (ov.x == 0x12345678u && ov.y == 0x9abcdef0u) *(GAS v4u*)(Og + (size_t)row * 512 + ch * 8) = ov; }
}

constexpr int A2_TILE = 64 * 128;
__device__ __forceinline__ void at2_dma(const GAS bf16* Kh, const GAS bf16* Vh, int tile, int wave, int lane, LAS unsigned char* kb, LAS unsigned char* vb) {
    const int row = 8 * wave + (lane >> 3), p = lane & 7;
    const GAS bf16* kg = Kh + (size_t)(tile * 64 + row) * 512 + ((p ^ ((row >> 1) & 7)) * 8);
    const GAS bf16* vg = Vh + (size_t)(tile * 64 + row) * 512 + ((p ^ (((row >> 1) & 1) * 4)) * 8);
    __builtin_amdgcn_global_load_lds((const unsigned*)kg, (LAS unsigned*)(kb + wave * 1024), 16, 0, 0);
    __builtin_amdgcn_global_load_lds((const unsigned*)vg, (LAS unsigned*)(vb + wave * 1024), 16, 0, 0);
}
__device__ __forceinline__ void at2_qk_m(f32x16& p0, f32x16& p1, const LAS unsigned char* kb, const LAS unsigned char* ones, const bf16x8_t (&qf)[4], const bf16x8_t mB, int r32, int hi) {
    const int f = (r32 >> 1) & 7;
    const LAS unsigned char* kp = kb + r32 * 128;
    bf16x8_t k0[5], k1[5];
#pragma unroll
    for (int s = 0; s < 4; ++s) { const int po = ((2 * s + hi) ^ f) * 16; k0[s] = *(const LAS bf16x8_t*)(kp + po); k1[s] = *(const LAS bf16x8_t*)(kp + 32 * 128 + po); }
    k0[4] = *(const LAS bf16x8_t*)ones; k1[4] = k0[4];
    asm volatile("s_waitcnt lgkmcnt(0)" : "+v"(k0[0]), "+v"(k0[1]), "+v"(k0[2]), "+v"(k0[3]), "+v"(k0[4]), "+v"(k1[0]), "+v"(k1[1]), "+v"(k1[2]), "+v"(k1[3]), "+v"(k1[4]) :: "memory");
    p0 = __builtin_amdgcn_mfma_f32_32x32x16_bf16(k0[4], mB, p0, 0, 0, 0); p1 = __builtin_amdgcn_mfma_f32_32x32x16_bf16(k1[4], mB, p1, 0, 0, 0);
#pragma unroll
    for (int s = 0; s < 4; ++s) { p0 = __builtin_amdgcn_mfma_f32_32x32x16_bf16(k0[s], qf[s], p0, 0, 0, 0); p1 = __builtin_amdgcn_mfma_f32_32x32x16_bf16(k1[s], qf[s], p1, 0, 0, 0); }
}
typedef short s16x4_t __attribute__((ext_vector_type(4)));
__device__ __forceinline__ void at2_pv(f32x16& o0, f32x16& o1, const LAS unsigned char* vb, const bf16x8_t (&pb)[4], int lane) {
    const int g = lane >> 4, q = (lane & 15) >> 2, p = lane & 3;
    const int sw = ((q >> 1) & 1) * 4, c0 = 2 * (g & 1) + (p >> 1);
    const LAS unsigned char* rowp = vb + (4 * (g >> 1) + q) * 128 + 8 * (p & 1);
    const LAS unsigned char* b0 = rowp + ((c0 ^ sw) * 16); const LAS unsigned char* b1 = rowp + (((c0 + 4) ^ sw) * 16);
    union U { bf16x8_t v; s16x4_t h[2]; }; U a0[4], a1[4];
#pragma unroll
    for (int sg = 0; sg < 4; ++sg) { const int ro = (32 * (sg >> 1) + 16 * (sg & 1)) * 128;
        a0[sg].h[0] = __builtin_amdgcn_ds_read_tr16_b64_v4i16((LAS s16x4_t*)(b0 + ro)); a0[sg].h[1] = __builtin_amdgcn_ds_read_tr16_b64_v4i16((LAS s16x4_t*)(b0 + ro + 8 * 128));
        a1[sg].h[0] = __builtin_amdgcn_ds_read_tr16_b64_v4i16((LAS s16x4_t*)(b1 + ro)); a1[sg].h[1] = __builtin_amdgcn_ds_read_tr16_b64_v4i16((LAS s16x4_t*)(b1 + ro + 8 * 128)); }
    asm volatile("s_waitcnt lgkmcnt(0)" : "+v"(a0[0].v), "+v"(a0[1].v), "+v"(a0[2].v), "+v"(a0[3].v), "+v"(a1[0].v), "+v"(a1[1].v), "+v"(a1[2].v), "+v"(a1[3].v) :: "memory");
#pragma unroll
    for (int sg = 0; sg < 4; ++sg) { o0 = __builtin_amdgcn_mfma_f32_32x32x16_bf16(a0[sg].v, pb[sg], o0, 0, 0, 0); o1 = __builtin_amdgcn_mfma_f32_32x32x16_bf16(a1[sg].v, pb[sg], o1, 0, 0, 0); }
}
constexpr int D2_K = 0, D2_V = 4 * A2_TILE, D2_ONES = 8 * A2_TILE, D2_BT = D2_ONES + 64, D2_OST = 73728;
static_assert(D2_BT + 512 <= D2_OST && D2_OST + 8 * 4096 <= RING_BYTES, "dsa2 LDS map");
template <bool DRY = false> __device__ __forceinline__ void dsa_attn2_unit(Frame& F, int b, int h, int qt) {
    int tid_ = F.tid; asm volatile("" : "+v"(tid_));
    const int tid = tid_, lane = tid & 63, wave = F.wave, r32 = lane & 31, hi = lane >> 5;
    LAS unsigned char* L = F.lds + RING_OFF;
    LAS float* bt = (LAS float*)(L + D2_BT);
    const size_t rowb = (size_t)b * SEQ;
    const GAS bf16* Kh = (const GAS bf16*)WSB(WS_KB) + rowb * 512 + h * 64; const GAS bf16* Vh = (const GAS bf16*)WSB(WS_VB) + rowb * 512 + h * 64;
    const int q0w = qt * 256 + wave * 32, q = q0w + r32;
    const int NS = 2 * qt + 2;
    __syncthreads();
    if (tid < 128) { const GAS float* rb = (const GAS float*)INP(I_RELB) + (8 + h); bt[tid] = (rb[t5_bucket(tid) * 16] - rb[31 * 16]) * LOG2E; }
    bf16x8_t qf[4];
    { const GAS bf16* qp = (const GAS bf16*)WSB(WS_QB) + (rowb + q) * 512 + h * 64 + hi * 8;
#pragma unroll
      for (int s = 0; s < 4; ++s) qf[s] = *(const GAS bf16x8_t*)(qp + s * 16); }
#pragma unroll
    for (int s = 0; s < 4; ++s) { union { bf16x8_t v; unsigned u[4]; } x; x.v = qf[s];
#pragma unroll
        for (int jj = 0; jj < 4; ++jj) x.u[jj] = pg8::cvt_pk_bf16(pg8::bf_lo(x.u[jj]) * AT_C2, pg8::bf_hi(x.u[jj]) * AT_C2);
        qf[s] = x.v; }
    bf16x8_t mB;
    { union { bf16x8_t v; unsigned u[4]; } x; x.u[0] = x.u[1] = x.u[2] = x.u[3] = 0u; mB = x.v; }
    if (tid == 0) { unsigned one = 0x3f80u, zz = 0u; asm volatile("" : "+v"(one), "+v"(zz)); *(LAS v4u*)(L + D2_ONES) = (v4u){one, zz, zz, zz}; }
    bool fresh = true;
    const GAS unsigned* mrow = (const GAS unsigned*)(F.ws + WS_MASK) + (rowb + q) * 512;
    auto dma2 = [&](int s) __attribute__((always_inline)) { const int set = s & 1;
        at2_dma(Kh, Vh, 2 * s, wave, lane, L + D2_K + (2 * set) * A2_TILE, L + D2_V + (2 * set) * A2_TILE);
        at2_dma(Kh, Vh, 2 * s + 1, wave, lane, L + D2_K + (2 * set + 1) * A2_TILE, L + D2_V + (2 * set + 1) * A2_TILE); };
    dma2(0);
    unsigned wc[4] = { mrow[0], mrow[1], mrow[2], mrow[3] };
    VM_WAIT(); __syncthreads();
    float m = 0.f, lsum = 0.f;
    f32x16 o0 = {0.f, 0.f, 0.f, 0.f, 0.f, 0.f, 0.f, 0.f, 0.f, 0.f, 0.f, 0.f, 0.f, 0.f, 0.f, 0.f}, o1 = o0;
    auto step = [&](int s) __attribute__((always_inline)) {
        const int set = s & 1;
        if (s + 1 < NS) dma2(s + 1);
        unsigned wn[4] = {0u, 0u, 0u, 0u};
        if (s + 1 < NS) { const GAS unsigned* mp = mrow + 4 * (s + 1); wn[0] = mp[0]; wn[1] = mp[1]; wn[2] = mp[2]; wn[3] = mp[3]; }
        if (__any((wc[0] | wc[1] | wc[2] | wc[3]) != 0u)) {
            const LAS unsigned char* kb = L + D2_K + (2 * set) * A2_TILE; const LAS unsigned char* vb = L + D2_V + (2 * set) * A2_TILE;
            f32x16 p0 = {0.f, 0.f, 0.f, 0.f, 0.f, 0.f, 0.f, 0.f, 0.f, 0.f, 0.f, 0.f, 0.f, 0.f, 0.f, 0.f}, p1 = p0, p2 = p0, p3 = p0;
            at2_qk_m(p0, p1, kb, L + D2_ONES, qf, mB, r32, hi); at2_qk_m(p2, p3, kb + A2_TILE, L + D2_ONES, qf, mB, r32, hi);
            asm volatile("s_nop 15\n\ts_nop 15" : "+v"(p0), "+v"(p1), "+v"(p2), "+v"(p3));
            const int t0 = 2 * s;
            const bool near = ((t0 + 1) * 64 + 191 > q0w);
            if (near) {
#pragma unroll
                for (int r = 0; r < 16; ++r) { const int d0 = q - (t0 * 64 + crow_(r, hi)), d1 = d0 - 32, d2 = d0 - 64, d3 = d0 - 96;
                    const float b0 = ((unsigned)d0 < 128u) ? bt[d0] : 0.f, b1 = ((unsigned)d1 < 128u) ? bt[d1] : 0.f, b2 = ((unsigned)d2 < 128u) ? bt[d2] : 0.f, b3 = ((unsigned)d3 < 128u) ? bt[d3] : 0.f;
                    p0[r] += b0; p1[r] += b1; p2[r] += b2; p3[r] += b3; }
            }
            float mx;
            { float ma = max3_(p0[0], p1[0], p2[0]), mb = max3_(p3[0], p0[1], p1[1]), mc = max3_(p2[1], p3[1], p0[2]), md = max3_(p1[2], p2[2], p3[2]);
#pragma unroll
              for (int r = 3; r < 15; r += 2) { ma = max3_(ma, p0[r], p1[r]); mb = max3_(mb, p2[r], p3[r]); mc = max3_(mc, p0[r + 1], p1[r + 1]); md = max3_(md, p2[r + 1], p3[r + 1]); }
              ma = max3_(ma, p0[15], p1[15]); mb = max3_(mb, p2[15], p3[15]); mx = max3_(ma, mb, mc); mx = max3_(mx, md, md); }
            mx = max3_(mx, __shfl_xor(mx, 32), mx);
            if (fresh || __any(mx > AT_THR)) {
                const float d = fresh ? mx : fmaxf(mx, 0.f);
                const float mn = __uint_as_float(pg8::cvt_pk_bf16(0.f, m + d) & 0xffff0000u);
                const float dl = mn - m; const float al = __builtin_amdgcn_exp2f(-dl);
                MFMA_FENCE2(o0, o1);
#pragma unroll
                for (int r = 0; r < 16; ++r) { o0[r] *= al; o1[r] *= al; p0[r] -= dl; p1[r] -= dl; p2[r] -= dl; p3[r] -= dl; }
                lsum *= al; m = mn; fresh = false;
                { union { bf16x8_t v; unsigned u[4]; } x; x.u[0] = hi == 0 ? ((__float_as_uint(m) >> 16) ^ 0x8000u) : 0u; x.u[1] = x.u[2] = x.u[3] = 0u; mB = x.v; }
            }
            const unsigned w0 = wc[0] >> (4 * hi), w1 = wc[1] >> (4 * hi), w2 = wc[2] >> (4 * hi), w3 = wc[3] >> (4 * hi);
            float lq[4] = {0.f, 0.f, 0.f, 0.f};
#pragma unroll
            for (int r = 0; r < 16; ++r) { const int cb = (r & 3) + 8 * (r >> 2);
                const float e0 = __uint_as_float(and_sel(__builtin_amdgcn_exp2f(p0[r]), w0, cb)), e1 = __uint_as_float(and_sel(__builtin_amdgcn_exp2f(p1[r]), w1, cb));
                const float e2 = __uint_as_float(and_sel(__builtin_amdgcn_exp2f(p2[r]), w2, cb)), e3 = __uint_as_float(and_sel(__builtin_amdgcn_exp2f(p3[r]), w3, cb));
                p0[r] = e0; p1[r] = e1; p2[r] = e2; p3[r] = e3; lq[0] += e0; lq[1] += e1; lq[2] += e2; lq[3] += e3; }
            lsum += (lq[0] + lq[1]) + (lq[2] + lq[3]);
            bf16x8_t pb[4], pc[4];
#pragma unroll
            for (int sg = 0; sg < 4; ++sg) { union { bf16x8_t v; unsigned u[4]; } pk, pl;
#pragma unroll
                for (int j = 0; j < 4; ++j) { const int r = 8 * (sg & 1) + 2 * j; pk.u[j] = (sg < 2) ? pg8::cvt_pk_bf16(p0[r], p0[r + 1]) : pg8::cvt_pk_bf16(p1[r], p1[r + 1]);
                    pl.u[j] = (sg < 2) ? pg8::cvt_pk_bf16(p2[r], p2[r + 1]) : pg8::cvt_pk_bf16(p3[r], p3[r + 1]); }
                pb[sg] = pk.v; pc[sg] = pl.v; }
            at2_pv(o0, o1, vb, pb, lane); at2_pv(o0, o1, vb + A2_TILE, pc, lane);
        }
        wc[0] = wn[0]; wc[1] = wn[1]; wc[2] = wn[2]; wc[3] = wn[3];
        VM_WAIT(); __syncthreads();
    };
#pragma unroll 1
    for (int s = 0; s < NS; ++s) step(s);
    MFMA_FENCE2(o0, o1);
    lsum += __shfl_xor(lsum, 32);
    const float inv = 1.0f / lsum;
    LAS bf16* ost = (LAS bf16*)(L + D2_OST + wave * 4096);
#pragma unroll
    for (int r = 0; r < 16; ++r) { ost[r32 * 64 + crow_(r, hi)] = (bf16)f2bf(o0[r] * inv); ost[r32 * 64 + 32 + crow_(r, hi)] = (bf16)f2bf(o1[r] * inv); }
    LDS_WAIT(); asm volatile("" ::: "memory");
    GAS bf16* Og = (GAS bf16*)WSB(WS_QB) + (rowb + q0w) * 512 + h * 64;
#pragma unroll
    for (int i = 0; i < 4; ++i) { const int c = i * 64 + lane, row = c >> 3, ch = c & 7; const v4u ov = *(const LAS v4u*)(ost + row * 64 + ch * 8); if (!DRY) *(GAS v4u*)(Og + (size_t)row * 512 + ch * 8) = ov; else if (ov.x == 0x12345678u && ov.y == 0x9abcdef0u) *(GAS v4u*)(Og + (size_t)row * 512 + ch * 8) = ov; }
}
#ifndef IX_SMIN_V
#define IX_SMIN_V 16
#endif
#ifndef IX_ZMAX_V
#define IX_ZMAX_V 255
#endif
constexpr int IX_FSH = 18, IX_FBASE = (0x2000 | (127 << 5)) - 42 * 32, IX_SSTRIDE = 8, IX_SMIN = IX_SMIN_V, IX_SHI = 16, IX_SLO = 56, IX_STOT = 36, IX_ZMAX = IX_ZMAX_V;
constexpr int IX_CAP = 768;
constexpr int IX_HIST = 0, IX_CAND = 0, IX_BM = 98304;
constexpr int IX_W = LDSCTL_OFF + 1024;
constexpr int IX_ST = LDSCTL_OFF + 1536;
constexpr int IX_SUB = LDSCTL_OFF + 2048, IX_L2 = IX_SUB + 8 * 1024, IX_C2 = IX_L2 + 8 * 512;
static_assert(IX_C2 + 64 <= LDS_BYTES, "idx sub-histogram LDS");
static_assert(IX_BM + 16 * 512 * 4 <= RING_BYTES && 16 * IX_CAP * 8 <= IX_BM && IX_ST + 6 * 64 <= LDS_BYTES, "idx LDS map");
#define MFMA_FENCE1(a) asm volatile("s_nop 15\n\ts_nop 15" : "+v"(a))
__device__ __forceinline__ float relu_(float x, float) { float r; asm("v_max_f32 %0, 0, %1" : "=v"(r) : "v"(x)); return r; }
__device__ __forceinline__ unsigned mono_key(float s) { const unsigned u = __float_as_uint(s + 0.0f); return u ^ ((unsigned)((int)u >> 31) | 0x80000000u); }

template <int MODE, bool LEVEL0, bool LAST, int HALF> __device__ __forceinline__ void idx_vec(const f32x16 (&accs)[2], const f32x4 (&wv)[4][4], LAS unsigned* hist, LAS unsigned long long* cand, LAS unsigned* bm, LAS unsigned* st,
                                                                                    const unsigned (&psh)[8], const unsigned (&ppre)[8], const bool (&pact)[8], int key, int t0, int hi, int lane, int w32, int shn, unsigned fmask, bool allsel) {
#pragma unroll
    for (int rb = 2 * HALF; rb < 2 * HALF + 2; ++rb) {
        const f32x16 acc = accs[rb - 2 * HALF];
        const int qla = 4 * rb + 2 * hi;
        const f32x4 w0 = wv[rb][0], w1 = wv[rb][1], w2 = wv[rb][2], w3 = wv[rb][3];
        float sa = w0.x * relu_(acc[0], 0.f), sa2 = w0.y * relu_(acc[1], 0.f); sa += w0.z * relu_(acc[2], 0.f); sa2 += w0.w * relu_(acc[3], 0.f);
        sa += w1.x * relu_(acc[4], 0.f); sa2 += w1.y * relu_(acc[5], 0.f); sa += w1.z * relu_(acc[6], 0.f); sa2 += w1.w * relu_(acc[7], 0.f);
        float sb = w2.x * relu_(acc[8], 0.f), sb2 = w2.y * relu_(acc[9], 0.f); sb += w2.z * relu_(acc[10], 0.f); sb2 += w2.w * relu_(acc[11], 0.f);
        sb += w3.x * relu_(acc[12], 0.f); sb2 += w3.y * relu_(acc[13], 0.f); sb += w3.z * relu_(acc[14], 0.f); sb2 += w3.w * relu_(acc[15], 0.f);
        sa += sa2; sb += sb2;
        const unsigned ua = mono_key(sa), ub = mono_key(sb);
        const bool va = !LAST || key <= t0 + qla, vb = !LAST || key <= t0 + qla + 1;
        if (MODE == 3) {
            const int fa = (int)(ua >> IX_FSH) - IX_FBASE, fb = (int)(ub >> IX_FSH) - IX_FBASE;
            const unsigned ba = (unsigned)(fa > 2047 ? 2047 : fa), bb = (unsigned)(fb > 2047 ? 2047 : fb);
            if (fa > 0) __hip_atomic_fetch_add(hist + qla * 2048 + ba, 1u, __ATOMIC_RELAXED, __HIP_MEMORY_SCOPE_WORKGROUP);
            if (fb > 0) __hip_atomic_fetch_add(hist + (qla + 1) * 2048 + bb, 1u, __ATOMIC_RELAXED, __HIP_MEMORY_SCOPE_WORKGROUP);
        } else if (MODE == 2) {
            const unsigned pa = ua >> IX_FSH, pb = ub >> IX_FSH;
            const bool sela = va && pa > ppre[2 * rb], selb = vb && pb > ppre[2 * rb + 1];
            const bool ca = va && (ppre[2 * rb] - pa) <= psh[2 * rb], cb = vb && (ppre[2 * rb + 1] - pb) <= psh[2 * rb + 1];
            const unsigned long long bala = __ballot(sela), balb = __ballot(selb);
            if (lane == 0) { bm[(4 * rb + 0) * 512 + w32] = (unsigned)bala; bm[(4 * rb + 2) * 512 + w32] = (unsigned)(bala >> 32);
                             bm[(4 * rb + 1) * 512 + w32] = (unsigned)balb; bm[(4 * rb + 3) * 512 + w32] = (unsigned)(balb >> 32); }
            if (ca) { const unsigned slot = __hip_atomic_fetch_add(st + qla, 1u, __ATOMIC_RELAXED, __HIP_MEMORY_SCOPE_WORKGROUP);
                if (slot < (unsigned)IX_CAP) cand[qla * IX_CAP + slot] = ((unsigned long long)ua << 32) | (unsigned)(0xffff - key); }
            if (cb) { const unsigned slot = __hip_atomic_fetch_add(st + qla + 1, 1u, __ATOMIC_RELAXED, __HIP_MEMORY_SCOPE_WORKGROUP);
                if (slot < (unsigned)IX_CAP) cand[(qla + 1) * IX_CAP + slot] = ((unsigned long long)ub << 32) | (unsigned)(0xffff - key); }
        } else if (MODE == 0) {
            const bool ma = va && (LEVEL0 || (pact[2 * rb] && (ua >> psh[2 * rb]) == ppre[2 * rb]));
            const bool mb = vb && (LEVEL0 || (pact[2 * rb + 1] && (ub >> psh[2 * rb + 1]) == ppre[2 * rb + 1]));
            const unsigned ba = LEVEL0 ? (ua >> 21) : ((ua >> shn) & fmask), bb = LEVEL0 ? (ub >> 21) : ((ub >> shn) & fmask);
            if (ma) __hip_atomic_fetch_add(hist + qla * 2048 + ba, 1u, __ATOMIC_RELAXED, __HIP_MEMORY_SCOPE_WORKGROUP);
            if (mb) __hip_atomic_fetch_add(hist + (qla + 1) * 2048 + bb, 1u, __ATOMIC_RELAXED, __HIP_MEMORY_SCOPE_WORKGROUP);
        } else {
            const unsigned pa = ua >> psh[2 * rb], pb = ub >> psh[2 * rb + 1];
            const bool sela = va && (allsel || pa > ppre[2 * rb]), selb = vb && (allsel || pb > ppre[2 * rb + 1]);
            const bool ca = va && !allsel && pa == ppre[2 * rb], cb = vb && !allsel && pb == ppre[2 * rb + 1];
            const unsigned long long bala = __ballot(sela), balb = __ballot(selb);
            if (lane == 0) { bm[(4 * rb + 0) * 512 + w32] = (unsigned)bala; bm[(4 * rb + 2) * 512 + w32] = (unsigned)(bala >> 32);
                             bm[(4 * rb + 1) * 512 + w32] = (unsigned)balb; bm[(4 * rb + 3) * 512 + w32] = (unsigned)(balb >> 32); }
            if (ca) { const unsigned slot = __hip_atomic_fetch_add(st + qla, 1u, __ATOMIC_RELAXED, __HIP_MEMORY_SCOPE_WORKGROUP);
                if (slot < (unsigned)IX_CAP) cand[qla * IX_CAP + slot] = ((unsigned long long)ua << 32) | (unsigned)(0xffff - key); }
            if (cb) { const unsigned slot = __hip_atomic_fetch_add(st + qla + 1, 1u, __ATOMIC_RELAXED, __HIP_MEMORY_SCOPE_WORKGROUP);
                if (slot < (unsigned)IX_CAP) cand[(qla + 1) * IX_CAP + slot] = ((unsigned long long)ub << 32) | (unsigned)(0xffff - key); }
        }
    }
}
template <int MODE, bool LEVEL0, int STRIDE = 1> __device__ __forceinline__ void idx_pass(Frame& F, const bf16x8_t (&qa)[4][4], const GAS bf16* kib, int t0, int nst, int wave, int lane,
                                                             int shn, unsigned fmask, bool allsel) {
    const int n = lane & 31, hi = lane >> 5;
    LAS unsigned char* L = F.lds + RING_OFF;
    LAS unsigned* hist = (LAS unsigned*)(L + IX_HIST); LAS unsigned long long* cand = (LAS unsigned long long*)(L + IX_CAND); LAS unsigned* bm = (LAS unsigned*)(L + IX_BM);
    const LAS float* wl = (const LAS float*)(F.lds + IX_W); LAS unsigned* st = (LAS unsigned*)(F.lds + IX_ST);
    unsigned psh[8], ppre[8]; bool pact[8];
#pragma unroll
    for (int i = 0; i < 8; ++i) { const int ql = 4 * (i >> 1) + 2 * hi + (i & 1); psh[i] = st[16 + ql]; ppre[i] = st[32 + ql]; pact[i] = (st[80 + ql] != 0u); }
    f32x4 wv[4][4];
#pragma unroll
    for (int rb = 0; rb < 4; ++rb)
#pragma unroll
        for (int j = 0; j < 4; ++j) wv[rb][j] = *(const LAS f32x4*)(wl + (4 * rb + 2 * hi) * 8 + 4 * j);
    bf16x8_t kf[4];
    const GAS bf16* kp = kib + (size_t)(wave * 32 + n) * 64 + hi * 8;
#pragma unroll
    for (int s = 0; s < 4; ++s) kf[s] = *(const GAS bf16x8_t*)(kp + s * 16);
    const int nlim = STRIDE == 1 ? nst : nst - 1;
#pragma unroll 1
    for (int stile = 0; stile < nlim; stile += STRIDE) {
        const int key = stile * 256 + wave * 32 + n;
        const int w32 = stile * 8 + wave;
        const bool lastt = STRIDE == 1 && (stile + 1 == nst);
        const bool more = (stile + STRIDE < nlim);
        f32x16 accs[2];
#pragma unroll
        for (int rb = 0; rb < 2; ++rb) { accs[rb] = (f32x16){0.f, 0.f, 0.f, 0.f, 0.f, 0.f, 0.f, 0.f, 0.f, 0.f, 0.f, 0.f, 0.f, 0.f, 0.f, 0.f};
#pragma unroll
            for (int s = 0; s < 4; ++s) accs[rb] = __builtin_amdgcn_mfma_f32_32x32x16_bf16(qa[rb][s], kf[s], accs[rb], 0, 0, 0); }
        asm volatile("s_nop 15\n\ts_nop 15" : "+v"(accs[0]), "+v"(accs[1]));
        if (!lastt) idx_vec<MODE, LEVEL0, false, 0>(accs, wv, hist, cand, bm, st, psh, ppre, pact, key, t0, hi, lane, w32, shn, fmask, allsel);
        else idx_vec<MODE, LEVEL0, true, 0>(accs, wv, hist, cand, bm, st, psh, ppre, pact, key, t0, hi, lane, w32, shn, fmask, allsel);
#pragma unroll
        for (int rb = 0; rb < 2; ++rb) { accs[rb] = (f32x16){0.f, 0.f, 0.f, 0.f, 0.f, 0.f, 0.f, 0.f, 0.f, 0.f, 0.f, 0.f, 0.f, 0.f, 0.f, 0.f};
#pragma unroll
            for (int s = 0; s < 4; ++s) accs[rb] = __builtin_amdgcn_mfma_f32_32x32x16_bf16(qa[2 + rb][s], kf[s], accs[rb], 0, 0, 0); }
        asm volatile("s_nop 15\n\ts_nop 15" : "+v"(accs[0]), "+v"(accs[1]), "+v"(kf[0]), "+v"(kf[1]), "+v"(kf[2]), "+v"(kf[3]));
        if (more) { kp += (size_t)STRIDE * 256 * 64;
#pragma unroll
            for (int s = 0; s < 4; ++s) kf[s] = *(const GAS bf16x8_t*)(kp + s * 16); }
        if (!lastt) idx_vec<MODE, LEVEL0, false, 1>(accs, wv, hist, cand, bm, st, psh, ppre, pact, key, t0, hi, lane, w32, shn, fmask, allsel);
        else idx_vec<MODE, LEVEL0, true, 1>(accs, wv, hist, cand, bm, st, psh, ppre, pact, key, t0, hi, lane, w32, shn, fmask, allsel);
    }
}

__device__ __forceinline__ bool idx_find_bin(const LAS unsigned* hrow, int D, unsigned above, unsigned S, unsigned kneed, int lane, int& bsel, unsigned& abovebin, unsigned& cbin) {
    const unsigned long long ownm = __ballot(above < kneed && kneed <= S);
    if (ownm == 0ull) return false;
    const int Lo = __ffsll((long long)ownm) - 1;
    const unsigned aL = (unsigned)__shfl((int)above, Lo);
    const unsigned v = (lane < D) ? hrow[Lo * D + lane] : 0u;
    unsigned s = v;
#pragma unroll
    for (int o = 1; o < 32; o <<= 1) { const unsigned t = __shfl_down(s, o); if (lane + o < 64) s += t; }
    const unsigned excl = s - v;
    const unsigned long long hitm = __ballot(lane < D && aL + excl < kneed && kneed <= aL + s);
    const int H = __ffsll((long long)hitm) - 1;
    bsel = Lo * D + H; abovebin = (unsigned)__shfl((int)(aL + excl), H); cbin = (unsigned)__shfl((int)v, H);
    return hitm != 0ull;
}
__device__ __forceinline__ void idx_unit(Frame& F, int b, int t0) {
    int tid_ = F.tid; asm volatile("" : "+v"(tid_));
    const int tid = tid_, lane = tid & 63, wave = F.wave, r32 = lane & 31, hh = lane >> 5;
    LAS unsigned char* L = F.lds + RING_OFF;
    LAS unsigned* hist = (LAS unsigned*)(L + IX_HIST); LAS unsigned long long* cand = (LAS unsigned long long*)(L + IX_CAND); LAS unsigned* bm = (LAS unsigned*)(L + IX_BM);
    LAS float* wl = (LAS float*)(F.lds + IX_W); LAS unsigned* st = (LAS unsigned*)(F.lds + IX_ST);
    const size_t rowb = (size_t)b * SEQ; const int nst = (t0 >> 8) + 1; const bool allsel = (t0 < 256);
    const GAS bf16* kib = (const GAS bf16*)WSB(WS_KI) + rowb * 64;
    __syncthreads();
    if (tid < 128) wl[tid] = ((const GAS float*)WSF(WS_WI) + (rowb + t0) * 8)[tid];
    if (tid < 16) { st[tid] = 0u; st[16 + tid] = 21u; st[32 + tid] = 0u; st[48 + tid] = 256u; st[64 + tid] = 0u; st[80 + tid] = 1u; }
    if (tid == 0) { unsigned zz = 0u; asm volatile("" : "+v"(zz)); st[96] = zz; st[97] = zz; }
    bf16x8_t qa[4][4];
    { const int qloc = 2 * ((r32 >> 2) & 1) + (r32 >> 4), head = (r32 & 3) + 4 * ((r32 >> 3) & 1);
      const GAS bf16* qp = (const GAS bf16*)WSB(WS_QI) + (rowb + t0 + qloc) * 512 + head * 64 + hh * 8;
#pragma unroll
      for (int rb = 0; rb < 4; ++rb)
#pragma unroll
        for (int s = 0; s < 4; ++s) qa[rb][s] = *(const GAS bf16x8_t*)(qp + (size_t)rb * 4 * 512 + s * 16); }
    __syncthreads();
    bool exact = allsel || nst < IX_SMIN;
    if (!exact) {
        { unsigned zz = 0u; asm volatile("" : "+v"(zz)); const v4u z4 = {zz, zz, zz, zz};
          for (int i = tid; i < 16 * 2048 / 4; i += NWAVES * 64) ((LAS v4u*)hist)[i] = z4; }
        __syncthreads();
        idx_pass<3, true, IX_SSTRIDE>(F, qa, kib, t0, nst, wave, lane, 0, 0u, false);
        __syncthreads();
#pragma unroll 1
        for (int qq = 0; qq < 2; ++qq) { const int ql = 2 * wave + qq; const LAS unsigned* hq = hist + ql * 2048 + lane * 32;
            unsigned tot = 0u;
            for (int dd = 0; dd < 32; ++dd) tot += hq[(dd + lane) & 31];
            unsigned S = tot;
#pragma unroll
            for (int o = 1; o < 64; o <<= 1) { const unsigned v = __shfl_down(S, o); if (lane + o < 64) S += v; }
            const unsigned above = S - tot; const unsigned total = (unsigned)__shfl((int)S, 0);
            if (total < (unsigned)IX_STOT) { if (lane == 0) __hip_atomic_fetch_or(st + 96, 1u, __ATOMIC_RELAXED, __HIP_MEMORY_SCOPE_WORKGROUP); continue; }
            const unsigned slo = total < (unsigned)IX_SLO ? total : (unsigned)IX_SLO;
#pragma unroll
            for (int which = 0; which < 2; ++which) { const unsigned kneed = which == 0 ? (unsigned)IX_SHI : slo;
                int bsel = 0; unsigned ab_, cb_;
                if (idx_find_bin(hist + ql * 2048, 32, above, S, kneed, lane, bsel, ab_, cb_) && lane == 0) {
                    if (which == 0) { st[32 + ql] = (unsigned)(IX_FBASE + bsel); if (bsel >= 2047) __hip_atomic_fetch_or(st + 96, 2u, __ATOMIC_RELAXED, __HIP_MEMORY_SCOPE_WORKGROUP); }
                    else { st[64 + ql] = (unsigned)(IX_FBASE + bsel); if (bsel <= 0) __hip_atomic_fetch_or(st + 96, 4u, __ATOMIC_RELAXED, __HIP_MEMORY_SCOPE_WORKGROUP); } } }
            LDS_WAIT(); asm volatile("" ::: "memory");
            if (lane == 0) { const unsigned w = st[32 + ql] - st[64 + ql]; st[16 + ql] = w; if (w > (unsigned)IX_ZMAX) __hip_atomic_fetch_or(st + 96, 8u, __ATOMIC_RELAXED, __HIP_MEMORY_SCOPE_WORKGROUP); }
        }
        __syncthreads();
        exact = (st[96] != 0u);
        const unsigned why = st[96];
        __syncthreads();
        if (!exact) {
            idx_pass<2, false>(F, qa, kib, t0, nst, wave, lane, 0, 0u, false);
            __syncthreads();
#pragma unroll 1
            for (int qq = 0; qq < 2; ++qq) { const int ql = 2 * wave + qq;
                int members = 0;
                for (int w = lane; w < nst * 8; w += 64) members += __popc(bm[ql * 512 + w]);
#pragma unroll
                for (int o = 32; o > 0; o >>= 1) members += __shfl_xor(members, o);
                const int nct = (int)st[ql], need = 256 - members;
                const bool ok = members <= 256 && need <= nct && nct <= IX_CAP;
                if (lane == 0) { if (!ok) __hip_atomic_fetch_or(st + 96, 16u, __ATOMIC_RELAXED, __HIP_MEMORY_SCOPE_WORKGROUP); st[48 + ql] = (unsigned)(need > 0 ? need : 0); }
            }
            __syncthreads();
            exact = (st[96] != 0u);
            __syncthreads();
        }
        if (exact) {
#ifdef IX_SPIN
            if (why & IX_SPIN) { const long long w1 = wall_clock64(); while (wall_clock64() - w1 < 4000) __builtin_amdgcn_s_sleep(4); }
#endif
            if (tid < 16) { st[tid] = 0u; st[16 + tid] = 21u; st[32 + tid] = 0u; st[48 + tid] = 256u; st[64 + tid] = 0u; st[80 + tid] = 1u; }
            __syncthreads();
        }
    }
    const bool zone = !exact;
    if (exact && !allsel) {
#pragma unroll 1
        for (int level = 0; level < 3; ++level) {
            const int shn = level == 0 ? 21 : (level == 1 ? 10 : 0); const unsigned fmask = level == 2 ? 0x3ffu : 0x7ffu; const int nd = level == 2 ? 1024 : 2048;
            for (int i = tid; i < 16 * 2048 / 4; i += NWAVES * 64) ((LAS v4u*)hist)[i] = (v4u){0u, 0u, 0u, 0u};
            __syncthreads();
            { if (level == 0) idx_pass<0, true>(F, qa, kib, t0, nst, wave, lane, shn, fmask, false); else idx_pass<0, false>(F, qa, kib, t0, nst, wave, lane, shn, fmask, false); }
            __syncthreads();
            if (PROBE_SEL & 8) { for (int i = tid; i < 16 * 2048; i += NWAVES * 64) hist[i] = 0u; __syncthreads(); { if (level == 0) idx_pass<0, true>(F, qa, kib, t0, nst, wave, lane, shn, fmask, false); else idx_pass<0, false>(F, qa, kib, t0, nst, wave, lane, shn, fmask, false); } __syncthreads(); }
#pragma unroll 1
            for (int qq = 0; qq < 2; ++qq) { const int ql = 2 * wave + qq;
                if (st[80 + ql] == 0u) continue;
                const unsigned kneed = st[48 + ql]; const int D = nd >> 6; const LAS unsigned* hq = hist + ql * 2048 + lane * D;
                unsigned tot = 0u;
                for (int dd = 0; dd < D; ++dd) tot += hq[(dd + lane) & (D - 1)];
                unsigned S = tot;
#pragma unroll
                for (int o = 1; o < 64; o <<= 1) { const unsigned v = __shfl_down(S, o); if (lane + o < 64) S += v; }
                const unsigned above = S - tot;
                int bsel = 0; unsigned a = 0u, cb = 0u;
                if (idx_find_bin(hist + ql * 2048, D, above, S, kneed, lane, bsel, a, cb) && lane == 0) {
                    const unsigned opre = st[32 + ql];
                    st[32 + ql] = (level == 0) ? (unsigned)bsel : ((opre << (level == 1 ? 11 : 10)) | (unsigned)bsel);
                    st[16 + ql] = (unsigned)shn; st[48 + ql] = kneed - a; st[64 + ql] = cb;
                    st[80 + ql] = (cb > (unsigned)IX_CAP && level < 2) ? 1u : 0u; }
            }
            __syncthreads();
            unsigned more = 0u;
#pragma unroll
            for (int i = 0; i < 16; ++i) more |= st[80 + i];
            __syncthreads();
            if (more == 0u) break;
        }
    }
    if (exact) idx_pass<1, false>(F, qa, kib, t0, nst, wave, lane, 0, 0u, allsel);
    __syncthreads();
    if (!allsel) {
#pragma unroll 1
        for (int qq = 0; qq < 2; ++qq) { const int ql = 2 * wave + qq;
            const int nc = (int)(st[ql] < (unsigned)IX_CAP ? st[ql] : (unsigned)IX_CAP); int need = (int)st[48 + ql]; const int vbits = zone ? 48 : 16 + (int)st[16 + ql];
            if (need <= 0) continue;
            if (need >= nc) {
                for (int k = lane; k < nc; k += 64) { const int key = 0xffff - (int)(cand[ql * IX_CAP + k] & 0xffffull); __hip_atomic_fetch_or(bm + ql * 512 + (key >> 5), 1u << (key & 31), __ATOMIC_RELAXED, __HIP_MEMORY_SCOPE_WORKGROUP); }
                continue; }
            const int shq = (int)st[16 + ql];
            const int zsh = (zone && st[16 + ql] <= 63u) ? 48 : 50;
            const unsigned zb = zone ? ((st[32 + ql] - st[16 + ql]) << (50 - zsh)) : 0u;
            if (zone || shq >= 8) {
                LAS unsigned* sh2 = (LAS unsigned*)(F.lds + IX_SUB + wave * 1024); LAS unsigned long long* l2 = (LAS unsigned long long*)(F.lds + IX_L2 + wave * 512); LAS unsigned* c2p = (LAS unsigned*)(F.lds + IX_C2 + wave * 4);
#pragma unroll
                for (int i = 0; i < 4; ++i) sh2[4 * lane + i] = 0u;
                if (lane == 0) *c2p = 0u;
                LDS_WAIT(); asm volatile("" ::: "memory");
                const int fsh = 32 + shq - 8;
                for (int k = lane; k < nc; k += 64) { const unsigned long long ckk = cand[ql * IX_CAP + k]; const unsigned f = zone ? (((unsigned)(ckk >> zsh) - zb) & 0xffu) : ((unsigned)(ckk >> fsh) & 0xffu); __hip_atomic_fetch_add(sh2 + f, 1u, __ATOMIC_RELAXED, __HIP_MEMORY_SCOPE_WORKGROUP); }
                LDS_WAIT(); asm volatile("" ::: "memory");
                const unsigned c0 = sh2[4 * lane], c1 = sh2[4 * lane + 1], c2 = sh2[4 * lane + 2], c3 = sh2[4 * lane + 3]; const unsigned tot = c0 + c1 + c2 + c3;
                unsigned S = tot;
#pragma unroll
                for (int o = 1; o < 64; o <<= 1) { const unsigned v = __shfl_down(S, o); if (lane + o < 64) S += v; }
                const unsigned above = S - tot; const unsigned needu = (unsigned)need;
                const bool found = above < needu && needu <= S;
                unsigned a = above; unsigned bsel = 0u, cbin = 0u;
                if (a + c3 >= needu) { bsel = 3u; cbin = c3; } else { a += c3; if (a + c2 >= needu) { bsel = 2u; cbin = c2; } else { a += c2; if (a + c1 >= needu) { bsel = 1u; cbin = c1; } else { a += c1; bsel = 0u; cbin = c0; } } }
                const int src = __ffsll((long long)__ballot(found)) - 1;
                const unsigned b2 = (unsigned)__shfl((int)(4u * lane + bsel), src), need2 = (unsigned)__shfl((int)(needu - a), src), cnt2 = (unsigned)__shfl((int)cbin, src);
                if (cnt2 <= 64u) {
                    for (int k = lane; k < nc; k += 64) { const unsigned long long ckk = cand[ql * IX_CAP + k]; const unsigned f = zone ? (((unsigned)(ckk >> zsh) - zb) & 0xffu) : ((unsigned)(ckk >> fsh) & 0xffu);
                        if (f > b2) { const int key = 0xffff - (int)(ckk & 0xffffull); __hip_atomic_fetch_or(bm + ql * 512 + (key >> 5), 1u << (key & 31), __ATOMIC_RELAXED, __HIP_MEMORY_SCOPE_WORKGROUP); }
                        else if (f == b2) { const unsigned slot = __hip_atomic_fetch_add(c2p, 1u, __ATOMIC_RELAXED, __HIP_MEMORY_SCOPE_WORKGROUP); l2[slot] = ckk; } }
                    LDS_WAIT(); asm volatile("" ::: "memory");
                    if (lane < (int)cnt2) { const unsigned long long mine = l2[lane]; unsigned rank = 0u;
                        for (unsigned j = 0; j < cnt2; ++j) rank += (l2[j] > mine) ? 1u : 0u;
                        if (rank < need2) { const int key = 0xffff - (int)(mine & 0xffffull); __hip_atomic_fetch_or(bm + ql * 512 + (key >> 5), 1u << (key & 31), __ATOMIC_RELAXED, __HIP_MEMORY_SCOPE_WORKGROUP); } }
                    LDS_WAIT(); asm volatile("" ::: "memory");
                    continue;
                }
            }
#ifdef IX_SPIN2
            if (zone) { const long long w1 = wall_clock64(); while (wall_clock64() - w1 < IX_SPIN2 * 100) __builtin_amdgcn_s_sleep(4); }
#endif
            unsigned long long ck[12]; unsigned alive = 0u, selm = 0u;
#pragma unroll
            for (int c = 0; c < 12; ++c) { const int k = c * 64 + lane; ck[c] = (k < nc) ? cand[ql * IX_CAP + k] : 0ull; if (k < nc) alive |= 1u << c; }
#pragma unroll 1
            for (int bit = vbits - 1 + 16; bit >= 0; --bit) {
                if (bit >= 16 && bit < 32) continue;
                unsigned ones = 0u; int cnt1 = 0;
#pragma unroll
                for (int c = 0; c < 12; ++c) { if (c * 64 < nc) { const bool o = ((alive >> c) & 1u) && ((ck[c] >> bit) & 1ull); cnt1 += __popcll(__ballot(o)); if (o) ones |= 1u << c; } }
                if (cnt1 >= need) alive &= ones;
                else { selm |= ones; alive &= ~ones; need -= cnt1; }
            }
            selm |= alive;
#pragma unroll
            for (int c = 0; c < 12; ++c) if ((selm >> c) & 1u) { const int key = 0xffff - (int)(ck[c] & 0xffffull); __hip_atomic_fetch_or(bm + ql * 512 + (key >> 5), 1u << (key & 31), __ATOMIC_RELAXED, __HIP_MEMORY_SCOPE_WORKGROUP); }
        }
    }
    __syncthreads();
    { GAS unsigned* mg = (GAS unsigned*)(F.ws + WS_MASK) + (rowb + t0) * 512; const int nw = nst * 8;
      for (int i = tid; i < 16 * nw; i += NWAVES * 64) { const int ql = i / nw, w = i - ql * nw; mg[(size_t)ql * 512 + w] = bm[ql * 512 + w]; } }
}
typedef __bf16 bf2_t __attribute__((ext_vector_type(2)));
constexpr size_t WS_KM2 = 110 * MiB;
constexpr size_t WS_MREF = 111 * MiB;
constexpr size_t WS_LACC = 38 * MiB;
constexpr size_t WS_PO = 464 * MiB;
constexpr size_t WS_PJ0 = WS_QI, WS_PJ1 = WS_XB, WS_PJ2 = WS_XB + 32 * MiB;
__device__ __forceinline__ unsigned char* pj_base(Frame& F, int l, int j) {
    if (j == 0) return F.ws + WS_PJ0;
    return (unsigned char*)F.out + (size_t)(j - 1) * (32 * MiB);
}
constexpr size_t WS_LJ = WS_KI;
constexpr size_t WS_LISTS = 496 * MiB;
constexpr int CW_LCNT = 16384;
static_assert((CW_LCNT + 2 * 1024) * 4 <= (int)CTL_ZERO_BYTES, "list counters inside the memset region");
__device__ __forceinline__ int list_off(int n) { return 256 * (63 * n - (n * (n - 1)) / 2); }
constexpr int IT_K = 0, IT_V = 4 * AT_KBUF, IT_BT = IT_V + 4 * AT_VBUF, IT_QP = IT_BT + 512, IT_OST = 73728;
static_assert(IT_QP + 8 * 128 <= IT_OST && IT_OST + 8 * 4096 <= RING_BYTES, "item LDS map");

template <bool DRY = false> __device__ __forceinline__ void moba_own_unit(Frame& F, int l, int b, int h, int qt) {
    int tid_ = F.tid; asm volatile("" : "+v"(tid_));
    const int tid = tid_, lane = tid & 63, wave = F.wave, r32 = lane & 31, hi = lane >> 5;
    LAS unsigned char* L = F.lds + RING_OFF;
    LAS float* bt = (LAS float*)(L + AT_BT);
    const GAS bf16* Qg = (const GAS bf16*)WSB(WS_QA);
    const size_t rowb = (size_t)b * SEQ;
    const GAS bf16* Kh = (const GAS bf16*)WSB(WS_KA) + rowb * 512 + h * 64; const GAS bf16* Vh = (const GAS bf16*)WSB(WS_VA) + rowb * 512 + h * 64;
    const int q0w = qt * 256 + wave * 32, q = q0w + r32;
    __syncthreads();
    if (tid < 128) { const GAS float* rb = (const GAS float*)INP(I_RELB) + h; bt[tid] = (rb[t5_bucket(tid) * 16] - rb[31 * 16]) * LOG2E; }
    bf16x8_t qf[4];
    { const GAS bf16* qp = Qg + (rowb + q) * 512 + h * 64 + hi * 8;
#pragma unroll
      for (int s = 0; s < 4; ++s) qf[s] = *(const GAS bf16x8_t*)(qp + s * 16); }
    { const int n = tid >> 3, c8 = (tid & 7) * 8; const GAS float* km = (const GAS float*)WSF(WS_KM2) + (((size_t)b * NBLK + n) * 2) * 512 + h * 64 + c8;
      f32x4 a = *(const GAS f32x4*)km + *(const GAS f32x4*)(km + 512), c = *(const GAS f32x4*)(km + 4) + *(const GAS f32x4*)(km + 516);
      a = a * (1.0f / 256.0f); c = c * (1.0f / 256.0f);
      const unsigned h0 = pk2(a.x, a.y), h1 = pk2(a.z, a.w), h2 = pk2(c.x, c.y), h3 = pk2(c.z, c.w);
      const unsigned l0 = pk2(a.x - __uint_as_float(h0 << 16), a.y - __uint_as_float(h0 & 0xffff0000u)), l1 = pk2(a.z - __uint_as_float(h1 << 16), a.w - __uint_as_float(h1 & 0xffff0000u)),
                     l2 = pk2(c.x - __uint_as_float(h2 << 16), c.y - __uint_as_float(h2 & 0xffff0000u)), l3 = pk2(c.z - __uint_as_float(h3 << 16), c.w - __uint_as_float(h3 & 0xffff0000u));
      *(LAS v4u*)(L + AT_K0 + n * AT_KROW + (tid & 7) * 16) = (v4u){h0, h1, h2, h3}; *(LAS v4u*)(L + AT_K0 + AT_KBUF + n * AT_KROW + (tid & 7) * 16) = (v4u){l0, l1, l2, l3}; }
    __syncthreads();
    unsigned mlo = 0u, mhi = 0u;
    if (qt > 0) {
        f32x16 g0 = {0.f, 0.f, 0.f, 0.f, 0.f, 0.f, 0.f, 0.f, 0.f, 0.f, 0.f, 0.f, 0.f, 0.f, 0.f, 0.f}, g1 = g0;
        at_qk(g0, g1, L + AT_K0, qf, r32, hi); at_qk(g0, g1, L + AT_K0 + AT_KBUF, qf, r32, hi);
        MFMA_FENCE2(g0, g1);
#pragma unroll
        for (int r = 0; r < 16; ++r) { if (crow_(r, hi) >= qt) g0[r] = -INFINITY; if (32 + crow_(r, hi) >= qt) g1[r] = -INFINITY; }
#pragma unroll
        for (int it = 0; it < 3; ++it) {
            float bv = -INFINITY; int bn = 64;
#pragma unroll
            for (int r = 0; r < 16; ++r) if (g0[r] > bv) { bv = g0[r]; bn = crow_(r, hi); }
#pragma unroll
            for (int r = 0; r < 16; ++r) if (g1[r] > bv) { bv = g1[r]; bn = 32 + crow_(r, hi); }
            const float pv = __shfl_xor(bv, 32); const int pn = __shfl_xor(bn, 32);
            const bool tp = (pv > bv) || (pv == bv && pn < bn);
            const float wv = tp ? pv : bv; const int wn = tp ? pn : bn;
            if (wv > -INFINITY) { if (wn < 32) mlo |= 1u << wn; else mhi |= 1u << (wn - 32);
                if (hi == 0 && !DRY) { GAS unsigned* cnt = (GAS unsigned*)(F.ws + WS_CTL) + CW_LCNT + ((l * 2 + b) * 8 + h) * 64 + wn;
                    const unsigned slot = __hip_atomic_fetch_add(cnt, 1u, __ATOMIC_RELAXED, __HIP_MEMORY_SCOPE_AGENT);
                    ((GAS unsigned short*)(F.ws + WS_LISTS) + ((size_t)(b * 8 + h) << 19))[list_off(wn) + slot] = (unsigned short)(q | (it << 14)); } }
#pragma unroll
            for (int r = 0; r < 16; ++r) { if (crow_(r, hi) == wn) g0[r] = -INFINITY; if (32 + crow_(r, hi) == wn) g1[r] = -INFINITY; }
        }
    }
    __syncthreads();
    v4u kr, vr;
    at_load(Kh, Vh, 4 * qt, tid, kr, vr);
    at_store(L + AT_K0, L + AT_V0, tid, kr, vr);
    __syncthreads();
    float m = -1e30f, lsum = 0.f;
    f32x16 o0 = {0.f, 0.f, 0.f, 0.f, 0.f, 0.f, 0.f, 0.f, 0.f, 0.f, 0.f, 0.f, 0.f, 0.f, 0.f, 0.f}, o1 = o0;
#pragma unroll 1
    for (int tt = 0; tt < 4; ++tt) {
        const int t = 4 * qt + tt, cur = tt & 1;
        if (tt + 1 < 4) at_load(Kh, Vh, t + 1, tid, kr, vr);
        const int nall = q - t * 64 + 1;
        const unsigned wlo = nall >= 32 ? 0xffffffffu : (nall <= 0 ? 0u : ((1u << nall) - 1u)), whi = nall >= 64 ? 0xffffffffu : (nall <= 32 ? 0u : ((1u << (nall - 32)) - 1u));
        if (__any((wlo | whi) != 0u)) {
            const LAS unsigned char* kb = L + AT_K0 + cur * AT_KBUF; const LAS unsigned char* vb = L + AT_V0 + cur * AT_VBUF;
            f32x16 p0 = {0.f, 0.f, 0.f, 0.f, 0.f, 0.f, 0.f, 0.f, 0.f, 0.f, 0.f, 0.f, 0.f, 0.f, 0.f, 0.f}, p1 = p0;
            at_qk(p0, p1, kb, qf, r32, hi);
            MFMA_FENCE2(p0, p1);
#pragma unroll
            for (int r = 0; r < 16; ++r) { const int d0 = q - (t * 64 + crow_(r, hi)), d1 = d0 - 32;
                const float b0 = ((unsigned)d0 < 128u) ? bt[d0] : 0.f, b1 = ((unsigned)d1 < 128u) ? bt[d1] : 0.f;
                p0[r] = p0[r] * AT_C2 + b0; p1[r] = p1[r] * AT_C2 + b1; }
            float mx;
            { float ma = max3_(p0[0], p1[0], p0[1]), mb = max3_(p1[1], p0[2], p1[2]), mc = max3_(p0[3], p1[3], p0[4]), md = max3_(p1[4], p0[5], p1[5]);
              ma = max3_(ma, p0[6], p1[6]); mb = max3_(mb, p0[7], p1[7]); mc = max3_(mc, p0[8], p1[8]); md = max3_(md, p0[9], p1[9]);
              ma = max3_(ma, p0[10], p1[10]); mb = max3_(mb, p0[11], p1[11]); mc = max3_(mc, p0[12], p1[12]); md = max3_(md, p0[13], p1[13]);
              ma = max3_(ma, p0[14], p1[14]); mb = max3_(mb, p0[15], p1[15]); mx = max3_(ma, mb, mc); mx = max3_(mx, md, md); }
            mx = max3_(mx, __shfl_xor(mx, 32), mx);
            if (__any(mx > m + AT_THR)) {
                const float mn = fmaxf(m, mx); const float al = __builtin_amdgcn_exp2f(m - mn);
                MFMA_FENCE2(o0, o1);
#pragma unroll
                for (int r = 0; r < 16; ++r) { o0[r] *= al; o1[r] *= al; }
                lsum *= al; m = mn;
            }
            const unsigned wl = wlo >> (4 * hi), wh = whi >> (4 * hi);
            float lq[4] = {0.f, 0.f, 0.f, 0.f};
#pragma unroll
            for (int r = 0; r < 16; ++r) { const int cb = (r & 3) + 8 * (r >> 2);
                const float e0 = __uint_as_float(and_sel(__builtin_amdgcn_exp2f(p0[r] - m), wl, cb)), e1 = __uint_as_float(and_sel(__builtin_amdgcn_exp2f(p1[r] - m), wh, cb));
                p0[r] = e0; p1[r] = e1; lq[r & 1] += e0; lq[2 + (r & 1)] += e1; }
            lsum += (lq[0] + lq[1]) + (lq[2] + lq[3]);
            bf16x8_t pb[4];
#pragma unroll
            for (int sg = 0; sg < 4; ++sg) { union { bf16x8_t v; unsigned u[4]; } pk;
#pragma unroll
                for (int j = 0; j < 4; ++j) { const int r = 8 * (sg & 1) + 2 * j; pk.u[j] = (sg < 2) ? pg8::cvt_pk_bf16(p0[r], p0[r + 1]) : pg8::cvt_pk_bf16(p1[r], p1[r + 1]); }
                pb[sg] = pk.v; }
            at_pv(o0, o1, vb, pb, r32, hi);
        }
        if (tt + 1 < 4) at_store(L + AT_K0 + (cur ^ 1) * AT_KBUF, L + AT_V0 + (cur ^ 1) * AT_VBUF, tid, kr, vr);
        __syncthreads();
    }
    MFMA_FENCE2(o0, o1);
    lsum += __shfl_xor(lsum, 32);
    if (hi == 0 && !DRY) { ((GAS float*)WSF(WS_MREF))[(rowb + q) * 8 + h] = m; ((GAS float*)WSF(WS_LACC))[(rowb + q) * 8 + h] = lsum; }
    LAS bf16* ost = (LAS bf16*)(L + AT_OST + wave * 4096);
#pragma unroll
    for (int r = 0; r < 16; ++r) { ost[r32 * 64 + crow_(r, hi)] = (bf16)f2bf(o0[r]); ost[r32 * 64 + 32 + crow_(r, hi)] = (bf16)f2bf(o1[r]); }
    LDS_WAIT(); asm volatile("" ::: "memory");
    GAS bf16* Og = (GAS bf16*)WSB(WS_PO) + (rowb + q0w) * 512 + h * 64;
#pragma unroll
    for (int i = 0; i < 4; ++i) { const int c = i * 64 + lane, row = c >> 3, ch = c & 7; const v4u ov = *(const LAS v4u*)(ost + row * 64 + ch * 8); if (!DRY || (ov.x == 0x12345678u && ov.y == 0x9abcdef0u)) *(GAS v4u*)(Og + (size_t)row * 512 + ch * 8) = ov; }
}

template <bool DRY = false> __device__ __forceinline__ void moba_item_unit(Frame& F, int l, int b, int h, int n) {
    int tid_ = F.tid; asm volatile("" : "+v"(tid_));
    const int tid = tid_, lane = tid & 63, wave = F.wave, r32 = lane & 31, hi = lane >> 5;
    LAS unsigned char* L = F.lds + RING_OFF;
    LAS float* bt = (LAS float*)(L + IT_BT);
    const size_t rowb = (size_t)b * SEQ;
    const int cnt = (int)((const GAS unsigned*)(F.ws + WS_CTL))[CW_LCNT + ((l * 2 + b) * 8 + h) * 64 + n];
    if (cnt == 0) return;
    const GAS bf16* Kh = (const GAS bf16*)WSB(WS_KA) + rowb * 512 + h * 64; const GAS bf16* Vh = (const GAS bf16*)WSB(WS_VA) + rowb * 512 + h * 64;
    __syncthreads();
    if (tid < 128) { const GAS float* rb = (const GAS float*)INP(I_RELB) + h; bt[tid] = (rb[t5_bucket(tid) * 16] - rb[31 * 16]) * LOG2E; }
#pragma unroll
    for (int t = 0; t < 4; ++t) { v4u kr, vr; at_load(Kh, Vh, 4 * n + t, tid, kr, vr); at_store(L + IT_K + t * AT_KBUF, L + IT_V + t * AT_VBUF, tid, kr, vr); }
    __syncthreads();
    const GAS unsigned short* lst = (const GAS unsigned short*)(F.ws + WS_LISTS) + ((size_t)(b * 8 + h) << 19) + list_off(n);
    LAS int* qpl = (LAS int*)(L + IT_QP + wave * 128);
    LAS float* ostf = (LAS float*)(L + IT_OST + wave * 4096);
    const int ngrp = (cnt + 31) >> 5;
#pragma unroll 1
    for (int g = wave; g < ngrp; g += NWAVES) {
        const int li = g * 32 + r32; const bool valid = li < cnt;
        const int ent = valid ? (int)lst[li] : (int)lst[g * 32];
        const int q = ent & 0x3fff;
        if (hi == 0) qpl[r32] = valid ? ent : -1;
        bf16x8_t qf[4];
        { const GAS bf16* qp = (const GAS bf16*)WSB(WS_QA) + (rowb + q) * 512 + h * 64 + hi * 8;
#pragma unroll
          for (int s = 0; s < 4; ++s) qf[s] = *(const GAS bf16x8_t*)(qp + s * 16); }
        const float mref = ((const GAS float*)WSF(WS_MREF))[(rowb + q) * 8 + h];
        const bool near = __any(q < 256 * (n + 1) + 128);
        float lsum = 0.f;
        f32x16 o0 = {0.f, 0.f, 0.f, 0.f, 0.f, 0.f, 0.f, 0.f, 0.f, 0.f, 0.f, 0.f, 0.f, 0.f, 0.f, 0.f}, o1 = o0;
#pragma unroll 1
        for (int t = 0; t < 4; ++t) {
            const LAS unsigned char* kb = L + IT_K + t * AT_KBUF; const LAS unsigned char* vb = L + IT_V + t * AT_VBUF;
            f32x16 p0 = {0.f, 0.f, 0.f, 0.f, 0.f, 0.f, 0.f, 0.f, 0.f, 0.f, 0.f, 0.f, 0.f, 0.f, 0.f, 0.f}, p1 = p0;
            at_qk(p0, p1, kb, qf, r32, hi);
            MFMA_FENCE2(p0, p1);
            float lq[4] = {0.f, 0.f, 0.f, 0.f};
            if (near) {
#pragma unroll
                for (int r = 0; r < 16; ++r) { const int d0 = q - ((4 * n + t) * 64 + crow_(r, hi)), d1 = d0 - 32;
                    const float b0 = ((unsigned)d0 < 128u) ? bt[d0] : 0.f, b1 = ((unsigned)d1 < 128u) ? bt[d1] : 0.f;
                    const float e0 = __builtin_amdgcn_exp2f(fminf(__builtin_fmaf(p0[r], AT_C2, -mref) + b0, 60.f)), e1 = __builtin_amdgcn_exp2f(fminf(__builtin_fmaf(p1[r], AT_C2, -mref) + b1, 60.f));
                    p0[r] = e0; p1[r] = e1; lq[r & 1] += e0; lq[2 + (r & 1)] += e1; }
            } else {
#pragma unroll
                for (int r = 0; r < 16; ++r) { const float e0 = __builtin_amdgcn_exp2f(fminf(__builtin_fmaf(p0[r], AT_C2, -mref), 60.f)), e1 = __builtin_amdgcn_exp2f(fminf(__builtin_fmaf(p1[r], AT_C2, -mref), 60.f));
                    p0[r] = e0; p1[r] = e1; lq[r & 1] += e0; lq[2 + (r & 1)] += e1; }
            }
            lsum += (lq[0] + lq[1]) + (lq[2] + lq[3]);
            bf16x8_t pb[4];
#pragma unroll
            for (int sg = 0; sg < 4; ++sg) { union { bf16x8_t v; unsigned u[4]; } pk;
#pragma unroll
                for (int j = 0; j < 4; ++j) { const int r = 8 * (sg & 1) + 2 * j; pk.u[j] = (sg < 2) ? pg8::cvt_pk_bf16(p0[r], p0[r + 1]) : pg8::cvt_pk_bf16(p1[r], p1[r + 1]); }
                pb[sg] = pk.v; }
            at_pv(o0, o1, vb, pb, r32, hi);
        }
        MFMA_FENCE2(o0, o1);
        lsum += __shfl_xor(lsum, 32);
        if (hi == 0 && valid && !DRY) ((GAS float*)WSF(WS_LJ))[((size_t)(ent >> 14) * T + rowb + q) * 8 + h] = lsum;
        LAS bf16* ost = (LAS bf16*)ostf;
#pragma unroll
        for (int r = 0; r < 16; ++r) { ost[r32 * 64 + crow_(r, hi)] = (bf16)f2bf(o0[r]); ost[r32 * 64 + 32 + crow_(r, hi)] = (bf16)f2bf(o1[r]); }
        LDS_WAIT(); asm volatile("" ::: "memory");
#pragma unroll
        for (int i = 0; i < 4; ++i) { const int c = i * 64 + lane, row = c >> 3, ch = c & 7; const int er = qpl[row];
            if (er >= 0 && !DRY) { const int j = er >> 14; GAS bf16* pj = (GAS bf16*)pj_base(F, l, j);
                *(GAS v4u*)(pj + (rowb + (er & 0x3fff)) * 512 + h * 64 + ch * 8) = *(const LAS v4u*)(ost + row * 64 + ch * 8); } }
        LDS_WAIT(); asm volatile("" ::: "memory");
    }
}
__device__ __forceinline__ void moba_fin_row(Frame& F, int layer, int m, int lane) {
    const int nsel = ((m & (SEQ - 1)) >> 8) < 3 ? ((m & (SEQ - 1)) >> 8) : 3;
    const int hd = lane >> 3;
    float l = ((const GAS float*)WSF(WS_LACC))[(size_t)m * 8 + hd];
    v4u v = ((const GAS v4u*)((const GAS bf16*)WSB(WS_PO) + (size_t)m * 512))[lane];
    float acc[8] = { __uint_as_float(v.x << 16), __uint_as_float(v.x & 0xffff0000u), __uint_as_float(v.y << 16), __uint_as_float(v.y & 0xffff0000u),
                     __uint_as_float(v.z << 16), __uint_as_float(v.z & 0xffff0000u), __uint_as_float(v.w << 16), __uint_as_float(v.w & 0xffff0000u) };
#pragma unroll
    for (int j = 0; j < 3; ++j) if (j < nsel) {
        l += ((const GAS float*)WSF(WS_LJ))[((size_t)j * T + m) * 8 + hd];
        const v4u w = ((const GAS v4u*)((const GAS bf16*)pj_base(F, layer, j) + (size_t)m * 512))[lane];
        acc[0] += __uint_as_float(w.x << 16); acc[1] += __uint_as_float(w.x & 0xffff0000u); acc[2] += __uint_as_float(w.y << 16); acc[3] += __uint_as_float(w.y & 0xffff0000u);
        acc[4] += __uint_as_float(w.z << 16); acc[5] += __uint_as_float(w.z & 0xffff0000u); acc[6] += __uint_as_float(w.w << 16); acc[7] += __uint_as_float(w.w & 0xffff0000u); }
    const float inv = 1.0f / l;
    v4u o; o.x = pk2(acc[0] * inv, acc[1] * inv); o.y = pk2(acc[2] * inv, acc[3] * inv); o.z = pk2(acc[4] * inv, acc[5] * inv); o.w = pk2(acc[6] * inv, acc[7] * inv);
    ((GAS v4u*)((GAS bf16*)WSB(WS_QA) + (size_t)m * 512))[lane] = o;
}
__global__ void __launch_bounds__(NWAVES * 64, 2) fwd(Args args) {
    extern __shared__ __attribute__((aligned(16))) unsigned char lds[];
    Frame F;
    F.lds = (LAS unsigned char*)lds;
        F.tid = threadIdx.x; F.lane = F.tid & 63; F.wave = __builtin_amdgcn_readfirstlane(F.tid >> 6);
    F.G = gridDim.x; F.bid = blockIdx.x;
    F.a = (const __attribute__((address_space(4))) Args*)__builtin_amdgcn_kernarg_segment_ptr(); F.ws = args.ws; F.out = args.out;
    unsigned char* ws = args.ws;
    for (int u = F.tid; u < (LDS_BYTES - LDSCTL_OFF) / 4; u += NWAVES * 64) ((LAS unsigned*)(F.lds + LDSCTL_OFF))[u] = 0u;
    __syncthreads();
    {
        volatile LAS unsigned* pw = (volatile LAS unsigned*)(F.lds + MISC_OFF) + 64;
        const unsigned hw = __builtin_amdgcn_s_getreg((4 << 0) | (4 << 6) | (1 << 11));
        if (F.lane == 0) pw[F.wave] = hw & 3u;
        __syncthreads();
        const unsigned my = pw[F.wave]; unsigned cnts = 0, rank = 0;
#pragma unroll
        for (int w = 0; w < NWAVES; ++w) { const unsigned s = pw[w]; cnts += 1u << (8 * s); if (w < F.wave && s == my) ++rank; }
#ifdef BAD_ROLES
        F.gw = __builtin_amdgcn_readfirstlane((cnts == 0x02020202u) ? (int)((my >> 1) * 4 + (my & 1) * 2 + rank) : F.wave);
#else
        F.gw = __builtin_amdgcn_readfirstlane((cnts == 0x02020202u) ? (int)(rank * 4 + my) : F.wave);
#endif
        __syncthreads();
    }
    XcdBarrier bar; bar.bar = (unsigned*)(ws + WS_CTL) + CW_BAR; bar.x = 0; bar.st = nullptr;
    if (ONE_LAUNCH) bar = xcd_barrier_post((unsigned*)(ws + WS_CTL) + CW_BAR, (volatile LAS unsigned*)(F.lds + MISC_OFF) + 8);
#define GRID_BAR() do { if (ONE_LAUNCH) xcd_barrier(bar); } while (0)
    const int lo = args.ph_lo, hi = args.ph_hi;
#ifndef PH_MASK
#define PH_MASK 0xfff
#endif
#define IN(k) (((PH_MASK >> ((k) % PH_PER_LAYER == 0 && (k) == 2 * PH_PER_LAYER ? 11 : (k) % PH_PER_LAYER)) & 1) && lo <= (k) && (k) < hi)
#define BOTH(k) (IN(k) && IN((k) + 1))
#define GEMM_TID ((F.gw << 6) | F.lane)
#define DYN_CTR(k) ((unsigned*)(F.ws + WS_CTL) + CW_DYN + 32 * (k))
#define DYN_FETCH(dst, k) do { __syncthreads(); if (F.tid == 0) *((volatile LAS unsigned*)(F.lds + MISC_OFF) + 32) = atomicAdd(DYN_CTR(k), 1u); __syncthreads(); \
        dst = (int)__builtin_amdgcn_readfirstlane(*((volatile LAS unsigned*)(F.lds + MISC_OFF) + 32)); } while (0)
#define LAUNDER() do { asm volatile("" : "+v"(F.tid)); F.lane = F.tid & 63; F.wave = __builtin_amdgcn_readfirstlane(F.tid >> 6); F.ws = launder_u(F.ws); F.out = launder_u(F.out); F.a = launder_u(F.a); F.bid = launder_i(F.bid); F.G = launder_i(F.G); F.gw = launder_i(F.gw); } while (0)
    LAS unsigned char* ring = F.lds + RING_OFF;
    for (int l = 0; l < 2; ++l) {
        const int P = l * PH_PER_LAYER;
#ifdef DBG_DUMP
        if (lo == DBG_PHASE && l == 0) { for (int u = F.bid; u < T; u += F.G) { F.out[(size_t)u * DM + F.tid] = bf2f(WSB(DBG_DUMP)[(size_t)u * DBG_PITCH + F.tid]); F.out[(size_t)u * DM + 512 + F.tid] = 0.f; } }
        if (lo >= DBG_PHASE && lo < 2 * PH_PER_LAYER) continue;
#endif
        if (IN(P + 0)) { LAUNDER(); p_prologue(F, l); if (PROBE_SEL & 128) { VM_WAIT(); __syncthreads(); p_prologue(F, l); } if (BOTH(P + 0)) GRID_BAR(); }
        if (IN(P + 1)) { LAUNDER();
            pg8::Gemm g{WSB(WS_XB), WSB(WS_W_IN), T, NIN_T, DM}; pg8::StaticOrder S; S.init(T, NIN_T, F.G, F.bid);
            pg8::EpiInproj E{WSB(WS_QA), WSB(WS_KI), WSF(WS_WI), SSQ_MIX(l), WSF(WS_KM2)};
            pg8::gemm_phase<pg8::EpiInproj, pg8::StaticOrder, true, PG8_SP2>(ring, g, S, E, GEMM_TID);
            if (PROBE_SEL & 32) { VM_WAIT(); __syncthreads(); LAUNDER(); pg8::gemm_phase<pg8::EpiInproj, pg8::StaticOrder, true, PG8_SP2>(ring, g, S, E, GEMM_TID); }
            if (BOTH(P + 1)) GRID_BAR();
        }
        if (IN(P + 2)) { LAUNDER();
#ifndef FAST_DSA
#define FAST_DSA 1
#endif
            if ((PROBE_SEL & 1024) && F.bid < 256) { for (int r = 0; r < 4; ++r) { const int i = r * 256 + F.bid; moba_own_unit<true>(F, l, (i & 15) >> 3, i & 7, i >> 4); } __syncthreads(); }
            if (FAST_MOBA == 2 && F.bid < 256) { for (int r = 0; r < 4; ++r) { const int i = r * 256 + F.bid; moba_own_unit<false>(F, l, (i & 15) >> 3, i & 7, i >> 4); } __syncthreads(); }
            for (int rep = 0; rep < ((PROBE_SEL & 64) ? 2 : 1); ++rep)
            for (int u = F.bid; u < 2 * RGC; u += F.G) rg_unit<false>(F, l, u / RGC, u % RGC);
            if (FAST_DSA) {
                for (;;) { int i; DYN_FETCH(i, 2 * l); if (i >= 2048) break; const int stt = 63 - (i >> 5), j = i & 31; idx_unit(F, j >> 4, stt * 256 + (j & 15) * 16); }
                __syncthreads();
            }
            if (BOTH(P + 2)) GRID_BAR();
        }
        if (IN(P + 3)) { LAUNDER();
            #ifndef MIX2_SEL
#define MIX2_SEL 7
#endif
            if (MIX2_SEL & 1) for (int u = F.bid; u < 2 * RGC; u += F.G) rg_unit<true>(F, l, u / RGC, u % RGC);
            if (FAST_MOBA == 2 && F.bid < 256) {
                if (PROBE_SEL & 2048) for (int r = 0; r < 4; ++r) { const int g = F.bid; const int i = r * 256 + ((r & 1) ? 255 - g : g); moba_item_unit<true>(F, l, (i & 15) >> 3, i & 7, i >> 4); }
                for (int r = 0; r < 4; ++r) { const int g = F.bid; const int i = r * 256 + ((r & 1) ? 255 - g : g); moba_item_unit<false>(F, l, (i & 15) >> 3, i & 7, i >> 4); }
                __syncthreads();
            }
            if (FAST_MOBA == 1 && (MIX2_SEL & 2)) {
                if (PROBE_SEL & 1) { for (int r = 0; r < 4; ++r) { const int g = F.bid % 256; const int i = r * 256 + ((r & 1) ? 255 - g : g); if (F.bid >= 256) break;
                    const int qt = 63 - (i >> 4), bh = i & 15; attn_unit<0, true>(F, bh >> 3, bh & 7, qt); } }
                for (int r = 0; r < 4; ++r) { const int g = F.bid % 256; const int i = r * 256 + ((r & 1) ? 255 - g : g); if (F.bid >= 256) break;
                    const int qt = 63 - (i >> 4), bh = i & 15; attn_unit<0>(F, bh >> 3, bh & 7, qt); }
                __syncthreads();
            }
            if (FAST_DSA && (MIX2_SEL & 4)) {
                if (PROBE_SEL & 2) { for (int r = 0; r < 4; ++r) { const int g = F.bid % 256; const int i = r * 256 + ((r & 1) ? 255 - g : g); if (F.bid >= 256) break;
                    const int qt = 63 - (i >> 4), bh = i & 15; dsa_attn2_unit<true>(F, bh >> 3, bh & 7, qt); } }
                for (;;) { int i; DYN_FETCH(i, 2 * l + 1); if (i >= 1024) break;
                    const int qt = 63 - (i >> 4), bh = i & 15; dsa_attn2_unit<false>(F, bh >> 3, bh & 7, qt); }
                __syncthreads();
            }
            if (!(FAST_MOBA && FAST_DSA)) for (int u = F.bid; u < T; u += F.G) { const int b = u & 1, t = u >> 1; if (FAST_MOBA == 0 && (MIX2_SEL & 2)) moba_unit(F, b, t); if (!FAST_DSA && (MIX2_SEL & 4)) dsa_unit(F, b, t); }
            for (int u = F.bid; u < T; u += F.G) { if (!(MIX2_SEL & 2)) WSB(WS_QA)[(size_t)u * 512 + F.tid] = 0; if (!(MIX2_SEL & 4)) WSB(WS_QB)[(size_t)u * 512 + F.tid] = 0; if (!(MIX2_SEL & 1)) WSB(WS_YC)[(size_t)u * 512 + F.tid] = 0; }
            if (BOTH(P + 3)) GRID_BAR();
        }

        if (IN(P + 4)) { LAUNDER();
            if (FAST_MOBA == 2) { const int gw = F.bid * NWAVES + F.wave, NGW = F.G * NWAVES;
                for (int m = gw; m < T; m += NGW) moba_fin_row(F, l, m, F.lane); }
            if (BOTH(P + 4)) GRID_BAR();
        }
        if (IN(P + 5)) { LAUNDER();
            pg8::Gemm g{WSB(WS_XB), WSB(WS_W_G), T, 3072, DM}; pg8::StaticOrder S; S.init(T, 3072, F.G, F.bid);
            pg8::EpiGates E{WSB(WS_G), SSQ_MIX(l)};
            pg8::gemm_phase<pg8::EpiGates, pg8::StaticOrder, true, PG8_SP2>(ring, g, S, E, GEMM_TID);
            if (PROBE_SEL & 32) { VM_WAIT(); __syncthreads(); LAUNDER(); pg8::gemm_phase<pg8::EpiGates, pg8::StaticOrder, true, PG8_SP2>(ring, g, S, E, GEMM_TID); }
            if (BOTH(P + 5)) GRID_BAR();
        }
        if (IN(P + 6)) { LAUNDER();
            pg8::StaticOrder S; S.init(T, DM, F.G, F.bid);
            { pg8::Gemm g{WSB(WS_QA), WSB(WS_W_PA), T, DM, DH}; pg8::EpiMerge<true> E{WSB(WS_G), WSB(WS_MERGED)}; pg8::gemm_phase<pg8::EpiMerge<true>, pg8::StaticOrder, true, PG8_SP2>(ring, g, S, E, GEMM_TID); }
#ifndef MERGE_CALLS
#define MERGE_CALLS 3
#endif
            VM_WAIT(); __syncthreads(); LAUNDER();
            if (MERGE_CALLS >= 2) { pg8::Gemm g{WSB(WS_QB), WSB(WS_W_PB), T, DM, DH}; pg8::EpiMerge<false> E{WSB(WS_G) + (size_t)T * 1024, WSB(WS_MERGED)}; pg8::gemm_phase<pg8::EpiMerge<false>, pg8::StaticOrder, true, PG8_SP2>(ring, g, S, E, GEMM_TID); }
            VM_WAIT(); __syncthreads(); LAUNDER();
            if (MERGE_CALLS >= 3) { pg8::Gemm g{WSB(WS_YC), WSB(WS_W_PC), T, DM, DH}; pg8::EpiMerge<false> E{WSB(WS_G) + (size_t)2 * T * 1024, WSB(WS_MERGED)}; pg8::gemm_phase<pg8::EpiMerge<false>, pg8::StaticOrder, true, PG8_SP2>(ring, g, S, E, GEMM_TID); }
            if (BOTH(P + 6)) GRID_BAR();
        }
        if (IN(P + 7)) { LAUNDER();
            pg8::Gemm g{WSB(WS_MERGED), WSB(WS_W_O), T, DM, DM}; pg8::StaticOrder S; S.init(T, DM, F.G, F.bid);
            pg8::EpiResidB E{WSB(WS_XB), SSQ_MLP(l)};
            pg8::gemm_phase<pg8::EpiResidB, pg8::StaticOrder, true, PG8_SP2>(ring, g, S, E, GEMM_TID);
            if (BOTH(P + 7)) GRID_BAR();
        }
        if (IN(P + 8)) {   }
        if (IN(P + 9)) { LAUNDER();
            pg8::Gemm g{WSB(WS_XB), WSB(WS_W_UP), T, DFF, DM}; pg8::StaticOrder S; S.init(T, DFF, F.G, F.bid);
            pg8::EpiUp E{WSB(WS_H), SSQ_MLP(l)};
            pg8::gemm_phase<pg8::EpiUp, pg8::StaticOrder, true, PG8_SP2>(ring, g, S, E, GEMM_TID);
            if (PROBE_SEL & 32) { VM_WAIT(); __syncthreads(); LAUNDER(); pg8::gemm_phase<pg8::EpiUp, pg8::StaticOrder, true, PG8_SP2>(ring, g, S, E, GEMM_TID); }
            if (BOTH(P + 9)) GRID_BAR();
        }
        if (IN(P + 10)) { LAUNDER();
            pg8::Gemm g{WSB(WS_H), WSB(WS_W_DN), T, DM, DFF}; pg8::StaticOrder S; S.init(T, DM, F.G, F.bid);
            pg8::EpiResidB E{WSB(WS_XB), (l == 0) ? SSQ_CTL + T : (pg8::ssq_t*)nullptr};
            pg8::gemm_phase<pg8::EpiResidB, pg8::StaticOrder, true, PG8_SP2>(ring, g, S, E, GEMM_TID);
            if (BOTH(P + 10)) GRID_BAR();
        }
    }
    if (IN(2 * PH_PER_LAYER)) { LAUNDER(); p_final(F); }
#undef IN
#undef BOTH
#undef GRID_BAR
}

extern "C" void kernel_launch(void* const* d_in, const int* in_sizes, int n_in, void* d_out, int out_size, void* d_ws, size_t ws_size, hipStream_t stream) {
    static int grid = 0;
    if (grid == 0) {
        if (n_in != 19 || in_sizes[0] != T * DM || out_size != T * DM || ws_size < WS_END) { fprintf(stderr, "kernel_launch: unexpected shapes (n_in %d, in0 %d, out %d, ws %zu)\n", n_in, n_in > 0 ? in_sizes[0] : -1, out_size, ws_size); grid = -1; return; }
        int dev = 0, cus = 0, per_cu = 0;
        if (hipGetDevice(&dev) != hipSuccess || hipDeviceGetAttribute(&cus, hipDeviceAttributeMultiprocessorCount, dev) != hipSuccess) { grid = -1; return; }
        if (hipFuncSetAttribute((const void*)fwd, hipFuncAttributeMaxDynamicSharedMemorySize, LDS_BYTES) != hipSuccess) { fprintf(stderr, "kernel_launch: hipFuncSetAttribute failed\n"); grid = -1; return; }
        if (hipOccupancyMaxActiveBlocksPerMultiprocessor(&per_cu, (const void*)fwd, NWAVES * 64, LDS_BYTES) != hipSuccess || per_cu < 1) { fprintf(stderr, "kernel_launch: occupancy query says %d\n", per_cu); }
        (void)hipGetLastError();
        grid = cus;
    }
    if (grid < 0) return;
    if (hipMemsetAsync((char*)d_ws + WS_CTL, 0, CTL_ZERO_BYTES, stream) != hipSuccess) return;
    Args a{};
    for (int i = 0; i < 19; ++i) a.in[i] = (const float*)d_in[i];
    a.out = (float*)d_out; a.ws = (unsigned char*)d_ws;
    if (ONE_LAUNCH) { a.ph_lo = 0; a.ph_hi = N_PHASES; hipLaunchKernelGGL(fwd, dim3(grid), dim3(NWAVES * 64), LDS_BYTES, stream, a); }
    else for (int p = 0; p < N_PHASES; ++p) { a.ph_lo = p; a.ph_hi = p + 1; hipLaunchKernelGGL(fwd, dim3(grid), dim3(NWAVES * 64), LDS_BYTES, stream, a); }
}
```

```cpp
#include <hip/hip_runtime.h>
#include <cstdio>
#include <cstdint>

#ifndef MK_ONE_LAUNCH
#define MK_ONE_LAUNCH 1
#endif

constexpr int BATCH = 2, SEQ = 16384, DM = 1024, T = BATCH * SEQ;
constexpr int DIN = 7752, DFF = 4096, DH = 512;
constexpr int NIN_T = 4864;
constexpr int NBLK = SEQ / 256;
constexpr float EPS = 1e-6f;

namespace pg8 {
#define PG8_LAS __attribute__((address_space(3)))
typedef unsigned short bf16_t;
typedef short bf16x8 __attribute__((ext_vector_type(8)));
typedef float f32x4 __attribute__((ext_vector_type(4)));
typedef unsigned u32x4 __attribute__((ext_vector_type(4)));
constexpr int BM = 256, BK = 64, HALF = 128, HTB = HALF * BK * 2  , STAGE_BYTES = 8 * HTB, NXCD = 8, WGM = 8;

__host__ __device__ __forceinline__ int lds_byte(int r, int c) { const int st = (r >> 4) * 2 + (c >> 5), rr = r & 15, cc = c & 31, ob = rr * 64 + cc * 2; return st * 1024 + (ob ^ (((ob >> 9) & 1) << 5)); }
__host__ __device__ __forceinline__ void stage_rc(int b, int& R, int& C) { const int st = b / 1024, sb = b % 1024, swz = sb ^ (((sb >> 9) & 1) << 5); R = (st >> 1) * 16 + swz / 64; C = (st & 1) * 32 + (swz % 64) / 2; }
__host__ __device__ __forceinline__ int perm32(int rho) { const int n = rho >> 4, i = rho & 15; return 8 * (i >> 2) + 4 * n + (i & 3); }

struct Unit { int pm, pn; };
struct Gemm { const bf16_t* A; const bf16_t* Bt; int M, N, K; };

struct StaticOrder {
    int nM, nN, nwg, G, c;
    __host__ __device__ void init(int M, int N, int G_, int c_) { nM = M / BM; nN = N / BM; nwg = nM * nN; G = G_; c = c_; }
    __host__ __device__ bool next(int i, Unit& u) const {
        const long L = (long)i * G + c; if (L >= nwg) return false;
        int wgid = (int)L; { const int q = nwg / NXCD, r = nwg % NXCD, xcd = wgid % NXCD, off = wgid / NXCD; wgid = (xcd < r ? xcd * (q + 1) : r * (q + 1) + (xcd - r) * q) + off; }
        const int nig = WGM * nN, gid = wgid / nig, fm = gid * WGM, gsz = (nM - fm) < WGM ? (nM - fm) : WGM;
        u.pm = fm + ((wgid % nig) % gsz); u.pn = (wgid % nig) / gsz; return true;
    }
    __device__ __forceinline__ void a_ready(const Unit&) const {}
    __device__ __forceinline__ void done(const Unit&) const {}
};

typedef float f32x2_t __attribute__((ext_vector_type(2))); typedef __bf16 bf16x2_t __attribute__((ext_vector_type(2)));
typedef unsigned long long ssq_t;
constexpr float SSQ_ONE = 16777216.0f;
__device__ __forceinline__ float ssq_rs(const ssq_t* a, int row) { return __builtin_amdgcn_rsqf((float)a[row] * (1.0f / (SSQ_ONE * 1024.0f)) + EPS); }
__device__ __forceinline__ unsigned cvt_pk_bf16(float lo, float hi) { f32x2_t v = {lo, hi}; bf16x2_t b = __builtin_convertvector(v, bf16x2_t); return __builtin_bit_cast(unsigned, b); }
__device__ __forceinline__ float bf_lo(unsigned w) { return __uint_as_float(w << 16); }
__device__ __forceinline__ float bf_hi(unsigned w) { return __uint_as_float(w & 0xffff0000u); }

struct EpiInproj {
    static constexpr bool PERM = true, AFTER_DRAIN = false;
    bf16_t* base; bf16_t* ki; float* wi; const ssq_t* rstd  ; float* km2;
    __device__ __forceinline__ void operator()(const f32x4 (&acc)[2][2][4][2], const Unit& u, int wr, int wc, int fr, int fq) const {
        const int row0 = u.pm * BM + wr * 64 + fr;
        if (u.pn < 18) {
            bf16_t* dst = base + (size_t)(u.pn >> 1) * ((size_t)T * 512) + (u.pn & 1) * 256 + wc * 32 + 8 * fq;
            const bool ksum = (u.pn >> 1) == 3;
            f32x4 cs[2][2] = {{{0.f, 0.f, 0.f, 0.f}, {0.f, 0.f, 0.f, 0.f}}, {{0.f, 0.f, 0.f, 0.f}, {0.f, 0.f, 0.f, 0.f}}};
#pragma unroll
            for (int ai = 0; ai < 2; ++ai)
#pragma unroll
                for (int m = 0; m < 4; ++m) { const int row = row0 + ai * HALF + m * 16; const float rs = ssq_rs(rstd, row); bf16_t* rowp = dst + (size_t)row * 512;
#pragma unroll
                    for (int bj = 0; bj < 2; ++bj) { const f32x4 v0 = acc[ai][bj][m][0] * rs, v1 = acc[ai][bj][m][1] * rs;
                        if (ksum) { cs[bj][0] += v0; cs[bj][1] += v1; }
                        u32x4 w; w.x = cvt_pk_bf16(v0[0], v0[1]); w.y = cvt_pk_bf16(v0[2], v0[3]); w.z = cvt_pk_bf16(v1[0], v1[1]); w.w = cvt_pk_bf16(v1[2], v1[3]);
                        *(u32x4*)(rowp + bj * HALF) = w; } }
            if (ksum) {
#pragma unroll
                for (int bj = 0; bj < 2; ++bj)
#pragma unroll
                    for (int n = 0; n < 2; ++n)
#pragma unroll
                        for (int j = 0; j < 4; ++j) { float v = cs[bj][n][j]; v += __shfl_xor(v, 1); v += __shfl_xor(v, 2); v += __shfl_xor(v, 4); v += __shfl_xor(v, 8); cs[bj][n][j] = v; }
                if (fr == 0) { float* kd = km2 + ((size_t)u.pm * 2 + wr) * 512 + (u.pn & 1) * 256 + wc * 32 + 8 * fq;
#pragma unroll
                    for (int bj = 0; bj < 2; ++bj) { *(f32x4*)(kd + bj * HALF) = cs[bj][0]; *(f32x4*)(kd + bj * HALF + 4) = cs[bj][1]; } }
            }
        } else {
#pragma unroll
            for (int ai = 0; ai < 2; ++ai)
#pragma unroll
                for (int m = 0; m < 4; ++m) { const int row = row0 + ai * HALF + m * 16; const float rs = ssq_rs(rstd, row);
                    const f32x4 v0 = acc[ai][0][m][0] * rs, v1 = acc[ai][0][m][1] * rs;
                    if (wc < 2) { u32x4 w; w.x = cvt_pk_bf16(v0[0], v0[1]); w.y = cvt_pk_bf16(v0[2], v0[3]); w.z = cvt_pk_bf16(v1[0], v1[1]); w.w = cvt_pk_bf16(v1[2], v1[3]);
                        *(u32x4*)(ki + (size_t)row * 64 + wc * 32 + 8 * fq) = w; }
                    else if (wc == 2 && fq == 0) { *(f32x4*)(wi + (size_t)row * 8) = v0; *(f32x4*)(wi + (size_t)row * 8 + 4) = v1; } }
        }
    }
};
struct EpiGates {
    static constexpr bool PERM = true, AFTER_DRAIN = false;
    bf16_t* O; const ssq_t* rstd;
    __device__ __forceinline__ void operator()(const f32x4 (&acc)[2][2][4][2], const Unit& u, int wr, int wc, int fr, int fq) const {
        const int row0 = u.pm * BM + wr * 64 + fr; const int tsel = u.pn >> 2;
        bf16_t* dst = O + (size_t)tsel * ((size_t)T * 1024) + (u.pn & 3) * 256 + wc * 32 + 8 * fq;
#pragma unroll
        for (int ai = 0; ai < 2; ++ai)
#pragma unroll
            for (int m = 0; m < 4; ++m) { const int row = row0 + ai * HALF + m * 16; const float rs = ssq_rs(rstd, row); bf16_t* rowp = dst + (size_t)row * 1024;
#pragma unroll
                for (int bj = 0; bj < 2; ++bj) { float v[8];
#pragma unroll
                    for (int j = 0; j < 4; ++j) { v[j] = acc[ai][bj][m][0][j] * rs; v[4 + j] = acc[ai][bj][m][1][j] * rs; }
#pragma unroll
                    for (int j = 0; j < 8; ++j) v[j] = __builtin_amdgcn_rcpf(1.0f + __builtin_amdgcn_exp2f(-1.4426950408889634f * v[j]));
                    u32x4 w; w.x = cvt_pk_bf16(v[0], v[1]); w.y = cvt_pk_bf16(v[2], v[3]); w.z = cvt_pk_bf16(v[4], v[5]); w.w = cvt_pk_bf16(v[6], v[7]);
                    *(u32x4*)(rowp + bj * HALF) = w; } }
    }
};
template <bool FIRST> struct EpiMerge {
    static constexpr bool PERM = true, AFTER_DRAIN = false;
    const bf16_t* G; bf16_t* Mg;
    __device__ __forceinline__ void operator()(const f32x4 (&acc)[2][2][4][2], const Unit& u, int wr, int wc, int fr, int fq) const {
        const int row0 = u.pm * BM + wr * 64 + fr; const int col0 = u.pn * BM + wc * 32 + 8 * fq;
#pragma unroll
        for (int ai = 0; ai < 2; ++ai)
#pragma unroll
            for (int m = 0; m < 4; ++m) { const size_t off = (size_t)(row0 + ai * HALF + m * 16) * 1024 + col0;
#pragma unroll
                for (int bj = 0; bj < 2; ++bj) { const u32x4 g = *(const u32x4*)(G + off + bj * HALF); const f32x4 a0 = acc[ai][bj][m][0], a1 = acc[ai][bj][m][1];
                    float v[8] = { bf_lo(g.x) * a0[0], bf_hi(g.x) * a0[1], bf_lo(g.y) * a0[2], bf_hi(g.y) * a0[3], bf_lo(g.z) * a1[0], bf_hi(g.z) * a1[1], bf_lo(g.w) * a1[2], bf_hi(g.w) * a1[3] };
                    if (!FIRST) { const u32x4 o = *(const u32x4*)(Mg + off + bj * HALF);
                        v[0] += bf_lo(o.x); v[1] += bf_hi(o.x); v[2] += bf_lo(o.y); v[3] += bf_hi(o.y); v[4] += bf_lo(o.z); v[5] += bf_hi(o.z); v[6] += bf_lo(o.w); v[7] += bf_hi(o.w); }
                    u32x4 w; w.x = cvt_pk_bf16(v[0], v[1]); w.y = cvt_pk_bf16(v[2], v[3]); w.z = cvt_pk_bf16(v[4], v[5]); w.w = cvt_pk_bf16(v[6], v[7]);
                    *(u32x4*)(Mg + off + bj * HALF) = w; }
                asm volatile("" ::: "memory"); }
    }
};
struct EpiResid {
    static constexpr bool PERM = false, AFTER_DRAIN = false;
    const float* src; float* out; bf16_t* xb; float* ssq;
    __device__ __forceinline__ void operator()(const f32x4 (&acc)[2][2][4][2], const Unit& u, int wr, int wc, int fr, int fq) const {
        const int row0 = u.pm * BM + wr * 64 + fr, col0 = u.pn * BM + wc * 32 + 4 * fq;
#pragma unroll
        for (int ai = 0; ai < 2; ++ai)
#pragma unroll
            for (int m = 0; m < 4; ++m) { const int row = row0 + ai * HALF + m * 16; const size_t off = (size_t)row * 1024 + col0; float sq = 0.f;
#pragma unroll
                for (int bj = 0; bj < 2; ++bj)
#pragma unroll
                    for (int n = 0; n < 2; ++n) { const f32x4 s = *(const f32x4*)(src + off + bj * HALF + n * 16); const f32x4 v = s + acc[ai][bj][m][n]; *(f32x4*)(out + off + bj * HALF + n * 16) = v;
                        if (xb) { typedef unsigned u32x2v __attribute__((ext_vector_type(2))); u32x2v w; w.x = cvt_pk_bf16(v[0], v[1]); w.y = cvt_pk_bf16(v[2], v[3]); *(u32x2v*)(xb + off + bj * HALF + n * 16) = w;
                            sq += (v[0] * v[0] + v[1] * v[1]) + (v[2] * v[2] + v[3] * v[3]); } }
                if (xb) { sq += __shfl_xor(sq, 16); sq += __shfl_xor(sq, 32); if (fq == 0) unsafeAtomicAdd(ssq + row, sq); } }
    }
};
struct EpiResidB {
    static constexpr bool PERM = true, AFTER_DRAIN = false;
    bf16_t* xb; ssq_t* ssq;
    __device__ __forceinline__ void operator()(const f32x4 (&acc)[2][2][4][2], const Unit& u, int wr, int wc, int fr, int fq) const {
        const int row0 = u.pm * BM + wr * 64 + fr; const int col0 = u.pn * BM + wc * 32 + 8 * fq;
#pragma unroll
        for (int ai = 0; ai < 2; ++ai)
#pragma unroll
            for (int m = 0; m < 4; ++m) { const int row = row0 + ai * HALF + m * 16; const size_t off = (size_t)row * 1024 + col0; float sq = 0.f;
#pragma unroll
                for (int bj = 0; bj < 2; ++bj) { const u32x4 g = *(const u32x4*)(xb + off + bj * HALF); const f32x4 a0 = acc[ai][bj][m][0], a1 = acc[ai][bj][m][1];
                    const float v[8] = { bf_lo(g.x) + a0[0], bf_hi(g.x) + a0[1], bf_lo(g.y) + a0[2], bf_hi(g.y) + a0[3], bf_lo(g.z) + a1[0], bf_hi(g.z) + a1[1], bf_lo(g.w) + a1[2], bf_hi(g.w) + a1[3] };
                    sq += ((v[0] * v[0] + v[1] * v[1]) + (v[2] * v[2] + v[3] * v[3])) + ((v[4] * v[4] + v[5] * v[5]) + (v[6] * v[6] + v[7] * v[7]));
                    u32x4 w; w.x = cvt_pk_bf16(v[0], v[1]); w.y = cvt_pk_bf16(v[2], v[3]); w.z = cvt_pk_bf16(v[4], v[5]); w.w = cvt_pk_bf16(v[6], v[7]);
                    *(u32x4*)(xb + off + bj * HALF) = w; }
                if (ssq) { sq += __shfl_xor(sq, 16); sq += __shfl_xor(sq, 32); if (fq == 0) atomicAdd(ssq + row, (ssq_t)(sq * SSQ_ONE)); } }
    }
};
struct EpiUp {
    static constexpr bool PERM = true, AFTER_DRAIN = false;
    bf16_t* O; const ssq_t* rstd;
    __device__ __forceinline__ void operator()(const f32x4 (&acc)[2][2][4][2], const Unit& u, int wr, int wc, int fr, int fq) const {
        const int row0 = u.pm * BM + wr * 64 + fr; const int col0 = u.pn * BM + wc * 32 + 8 * fq;
#pragma unroll
        for (int ai = 0; ai < 2; ++ai)
#pragma unroll
            for (int m = 0; m < 4; ++m) { const int row = row0 + ai * HALF + m * 16; const float rs = ssq_rs(rstd, row); bf16_t* rowp = O + (size_t)row * DFF + col0;
#pragma unroll
                for (int bj = 0; bj < 2; ++bj) { float v[8];
#pragma unroll
                    for (int j = 0; j < 4; ++j) { v[j] = fmaxf(acc[ai][bj][m][0][j] * rs, 0.f); v[4 + j] = fmaxf(acc[ai][bj][m][1][j] * rs, 0.f); }
#pragma unroll
                    for (int j = 0; j < 8; ++j) v[j] = v[j] * v[j];
                    u32x4 w; w.x = cvt_pk_bf16(v[0], v[1]); w.y = cvt_pk_bf16(v[2], v[3]); w.z = cvt_pk_bf16(v[4], v[5]); w.w = cvt_pk_bf16(v[6], v[7]);
                    *(u32x4*)(rowp + bj * HALF) = w; } }
    }
};

template <class Epi, class Sched, bool ALIGN_EPI = false, bool SP2 = false>
__device__ __forceinline__ void gemm_phase(PG8_LAS unsigned char* lds, const Gemm g, const Sched& S, const Epi& E, int tid_in) {
    int tid_ = tid_in; asm volatile("" : "+v"(tid_));
    const int tid = tid_, wid = __builtin_amdgcn_readfirstlane(tid >> 6), lane = tid & 63, wr = wid >> 2, wc = wid & 3, fr = lane & 15, fq = lane >> 4;
    const int K = g.K, nt = K / BK;
    unsigned voffA[2], voffB[2];
#pragma unroll
    for (int i = 0; i < 2; ++i) { int R, C; stage_rc(tid * 16 + i * 8192, R, C); const int Rb = Epi::PERM ? ((R & ~31) + perm32(R & 31)) : R;
        voffA[i] = (unsigned)(R * K + C) * 2u; voffB[i] = (unsigned)(Rb * K + C) * 2u; }
    const size_t kstep = (size_t)(BK * 2);
    const size_t hstep = (size_t)HALF * K * 2;
    const size_t tstep = 2 * hstep;
    const unsigned ldsw = (unsigned)wid * 1024u;
    const int aoff = lds_byte(wr * 64 + fr, fq * 8), boff = lds_byte(wc * 32 + fr, fq * 8);
#define PG8_SA(b, h) (((b) * 2 + (h)) * HTB)
#define PG8_SB(b, h) ((4 + (b) * 2 + (h)) * HTB)
#define PG8_STAGE(bufoff, gbase, voff) do { _Pragma("unroll") for (int _i = 0; _i < 2; ++_i) \
        __builtin_amdgcn_global_load_lds((const unsigned*)((const char*)(gbase) + (voff)[_i]), (PG8_LAS unsigned*)(lds + (bufoff) + ldsw + _i * 8192), 16, 0, 0); } while (0)
#define PG8_LDA(dst, b, h) do { _Pragma("unroll") for (int m = 0; m < 4; ++m) _Pragma("unroll") for (int k = 0; k < 2; ++k) dst[m][k] = *(const PG8_LAS bf16x8*)(lds + PG8_SA(b, h) + aoff + m * 2048 + k * 1024); } while (0)
#define PG8_LDB(dst, b, h) do { _Pragma("unroll") for (int n = 0; n < 2; ++n) _Pragma("unroll") for (int k = 0; k < 2; ++k) dst[n][k] = *(const PG8_LAS bf16x8*)(lds + PG8_SB(b, h) + boff + n * 2048 + k * 1024); } while (0)
#define PG8_MMA(ai, bj, At, Bt) do { __builtin_amdgcn_s_setprio(1); _Pragma("unroll") for (int m = 0; m < 4; ++m) _Pragma("unroll") for (int n = 0; n < 2; ++n) _Pragma("unroll") for (int k = 0; k < 2; ++k) \
        acc[ai][bj][m][n] = __builtin_amdgcn_mfma_f32_16x16x32_bf16(Bt[n][k], At[m][k], acc[ai][bj][m][n], 0, 0, 0); __builtin_amdgcn_s_setprio(0); } while (0)
#define PG8_WAIT_V(n) asm volatile("s_waitcnt vmcnt(" #n ")" ::: "memory")
#define PG8_WAIT_L(n) asm volatile("s_waitcnt lgkmcnt(" #n ")" ::: "memory")
#define PG8_BAR __builtin_amdgcn_s_barrier()
#define PG8_SCHED __builtin_amdgcn_sched_barrier(0)
    Unit cur, nxt; int ui = 0;
    if (!S.next(0, cur)) return;
    f32x4 acc[2][2][4][2];
#pragma unroll
    for (int a = 0; a < 2; ++a)
#pragma unroll
        for (int b = 0; b < 2; ++b)
#pragma unroll
            for (int m = 0; m < 4; ++m)
#pragma unroll
                for (int n = 0; n < 2; ++n) acc[a][b][m][n] = (f32x4){0.f, 0.f, 0.f, 0.f};
    bf16x8 At[4][2], B0[2][2], B1[2][2];
    const char* cA = (const char*)g.A + (size_t)cur.pm * tstep; const char* cB = (const char*)g.Bt + (size_t)cur.pn * tstep;
    S.a_ready(cur);
    if constexpr (SP2) {
        PG8_STAGE(PG8_SB(0, 0), cB, voffB); PG8_STAGE(PG8_SB(0, 1), cB + hstep, voffB); PG8_STAGE(PG8_SA(0, 0), cA, voffA); PG8_STAGE(PG8_SA(0, 1), cA + hstep, voffA);
        if (wr == 1) PG8_BAR;
        PG8_WAIT_V(2); PG8_BAR;
        PG8_STAGE(PG8_SB(1, 0), cB + kstep, voffB); PG8_STAGE(PG8_SA(1, 0), cA + kstep, voffA); PG8_STAGE(PG8_SB(1, 1), cB + hstep + kstep, voffB);
        PG8_WAIT_V(6); PG8_BAR;
    } else {
        PG8_STAGE(PG8_SB(0, 0), cB, voffB); PG8_STAGE(PG8_SA(0, 0), cA, voffA); PG8_STAGE(PG8_SB(0, 1), cB + hstep, voffB); PG8_STAGE(PG8_SA(0, 1), cA + hstep, voffA);
        if (wr == 1) PG8_BAR;
        PG8_WAIT_V(4); PG8_BAR;
        PG8_STAGE(PG8_SB(1, 0), cB + kstep, voffB); PG8_STAGE(PG8_SA(1, 0), cA + kstep, voffA); PG8_STAGE(PG8_SB(1, 1), cB + hstep + kstep, voffB);
        PG8_WAIT_V(6); PG8_BAR;
    }
    for (;;) {
        const bool has_next = S.next(ui + 1, nxt);
        const char* nA = has_next ? (const char*)g.A + (size_t)nxt.pm * tstep : cA; const char* nB = has_next ? (const char*)g.Bt + (size_t)nxt.pn * tstep : cB;
        for (int t = 0; t < nt; t += 2) {
            const bool last = (t == nt - 2);
            const char* a1 = cA + (size_t)(t + 1) * kstep;
            const char* a2 = last ? nA : cA + (size_t)(t + 2) * kstep; const char* b2 = last ? nB : cB + (size_t)(t + 2) * kstep;
            const char* a3 = a2 + kstep; const char* b3 = b2 + kstep;
            if (last && has_next) S.a_ready(nxt);
            if constexpr (SP2) {
            PG8_LDB(B0, 0, 0); PG8_LDB(B1, 0, 1); PG8_SCHED; PG8_LDA(At, 0, 0); PG8_STAGE(PG8_SA(1, 1), a1 + hstep, voffA);
            PG8_WAIT_V(8); PG8_WAIT_L(0); PG8_BAR; PG8_MMA(0, 0, At, B0); PG8_MMA(0, 1, At, B1); PG8_BAR; PG8_SCHED;
            PG8_LDA(At, 0, 1); PG8_STAGE(PG8_SB(0, 0), b2, voffB); PG8_STAGE(PG8_SB(0, 1), b2 + hstep, voffB); PG8_STAGE(PG8_SA(0, 0), a2, voffA);
            PG8_WAIT_V(8); PG8_WAIT_L(0); PG8_BAR; PG8_MMA(1, 0, At, B0); PG8_MMA(1, 1, At, B1); PG8_BAR; PG8_SCHED;
            PG8_LDB(B0, 1, 0); PG8_LDB(B1, 1, 1); PG8_SCHED; PG8_LDA(At, 1, 0); PG8_STAGE(PG8_SA(0, 1), a2 + hstep, voffA);
            PG8_WAIT_V(8); PG8_WAIT_L(0); PG8_BAR; PG8_MMA(0, 0, At, B0); PG8_MMA(0, 1, At, B1); PG8_BAR; PG8_SCHED;
            PG8_LDA(At, 1, 1); PG8_STAGE(PG8_SB(1, 0), b3, voffB); PG8_STAGE(PG8_SB(1, 1), b3 + hstep, voffB); PG8_STAGE(PG8_SA(1, 0), a3, voffA);
            PG8_WAIT_V(8); PG8_WAIT_L(0); PG8_BAR; PG8_MMA(1, 0, At, B0); PG8_MMA(1, 1, At, B1); PG8_BAR; PG8_SCHED;
            } else {
            PG8_LDB(B0, 0, 0); PG8_SCHED; PG8_LDA(At, 0, 0); PG8_STAGE(PG8_SA(1, 1), a1 + hstep, voffA);
            PG8_WAIT_L(8); PG8_BAR; PG8_WAIT_L(0); PG8_MMA(0, 0, At, B0); PG8_BAR; PG8_SCHED;
            PG8_LDB(B1, 0, 1); PG8_STAGE(PG8_SB(0, 0), b2, voffB);
            PG8_BAR; PG8_WAIT_L(0); PG8_MMA(0, 1, At, B1); PG8_BAR;
            PG8_LDA(At, 0, 1); PG8_STAGE(PG8_SA(0, 0), a2, voffA);
            PG8_BAR; PG8_WAIT_L(0); PG8_MMA(1, 0, At, B0); PG8_BAR; PG8_SCHED;
            PG8_STAGE(PG8_SB(0, 1), b2 + hstep, voffB);
            PG8_WAIT_V(6); PG8_BAR; PG8_MMA(1, 1, At, B1); PG8_BAR;
            PG8_LDB(B0, 1, 0); PG8_SCHED; PG8_LDA(At, 1, 0); PG8_STAGE(PG8_SA(0, 1), a2 + hstep, voffA);
            PG8_WAIT_L(8); PG8_BAR; PG8_WAIT_L(0); PG8_MMA(0, 0, At, B0); PG8_BAR; PG8_SCHED;
            PG8_LDB(B1, 1, 1); PG8_STAGE(PG8_SB(1, 0), b3, voffB);
            PG8_BAR; PG8_WAIT_L(0); PG8_MMA(0, 1, At, B1); PG8_BAR;
            PG8_LDA(At, 1, 1); PG8_STAGE(PG8_SA(1, 0), a3, voffA);
            PG8_BAR; PG8_WAIT_L(0); PG8_MMA(1, 0, At, B0); PG8_BAR; PG8_SCHED;
            PG8_STAGE(PG8_SB(1, 1), b3 + hstep, voffB);
            PG8_WAIT_V(6); PG8_BAR; PG8_MMA(1, 1, At, B1); PG8_BAR;
            }
        }
        if constexpr (ALIGN_EPI) { if (wr == 0) PG8_BAR; }
        if constexpr (!Epi::AFTER_DRAIN) { E(acc, cur, wr, wc, fr, fq); S.done(cur); }
        if (!has_next) break;
#pragma unroll
        for (int a = 0; a < 2; ++a)
#pragma unroll
            for (int b = 0; b < 2; ++b)
#pragma unroll
                for (int m = 0; m < 4; ++m)
#pragma unroll
                    for (int n = 0; n < 2; ++n) acc[a][b][m][n] = (f32x4){0.f, 0.f, 0.f, 0.f};
        cur = nxt; cA = nA; cB = nB; ++ui;
        if constexpr (ALIGN_EPI) { if (wr == 1) PG8_BAR; }
    }
    PG8_WAIT_V(0);
    if constexpr (!ALIGN_EPI) { if (wr == 0) PG8_BAR; }
    PG8_BAR;
    if constexpr (Epi::AFTER_DRAIN) { E.fused(acc, cur, wr, wc, fr, fq, lds, wid, lane); S.done(cur); }
#undef PG8_SA
#undef PG8_SB
#undef PG8_STAGE
#undef PG8_LDA
#undef PG8_LDB
#undef PG8_MMA
#undef PG8_WAIT_V
#undef PG8_WAIT_L
#undef PG8_BAR
#undef PG8_SCHED
}
}

#ifndef FAST_MOBA
#define FAST_MOBA 2
#endif
#ifndef PG8_SP2
#define PG8_SP2 true
#endif
#ifndef PROBE_SEL
#define PROBE_SEL 0
#endif
constexpr int NWAVES = 8;
constexpr int PH_PER_LAYER = 11;
constexpr int N_PHASES = 2 * PH_PER_LAYER + 1;
constexpr bool ONE_LAUNCH = (MK_ONE_LAUNCH != 0);
static_assert(ONE_LAUNCH, "build with MK_ONE_LAUNCH=1 (build.sh 1): the unit queues and the phase program assume one launch");

constexpr size_t MiB = 1u << 20;
constexpr size_t WS_CTL = 0, CTL_ZERO_BYTES = 1 * MiB;
constexpr size_t WS_W_IN = 1 * MiB;
constexpr size_t WS_W_G = 11 * MiB;
constexpr size_t WS_W_PA = 17 * MiB, WS_W_PB = 18 * MiB, WS_W_PC = 19 * MiB;
constexpr size_t WS_W_O = 20 * MiB;
constexpr size_t WS_W_UP = 22 * MiB;
constexpr size_t WS_W_DN = 30 * MiB;
constexpr size_t WS_XB = 40 * MiB;
constexpr size_t WS_RSTD = 104 * MiB;
constexpr int CW_SSQ = 32768;
static_assert(CW_SSQ * 4 + 3 * T * 8 <= (int)CTL_ZERO_BYTES, "ssq arrays inside the memset region");
constexpr size_t WS_KMEAN = 104 * MiB + 256 * 1024;
constexpr size_t WS_RGA = 104 * MiB + 256 * 1024;
constexpr size_t WS_RGH = 10 * MiB + 512 * 1024;
constexpr int RGC = 128;
constexpr size_t WS_WI = 105 * MiB;
constexpr size_t WS_KI = 106 * MiB;
constexpr size_t WS_ACT = 112 * MiB;
constexpr size_t ACT_STRIDE = (size_t)T * 512 * 2;
constexpr size_t WS_QA = WS_ACT, WS_QB = WS_ACT + ACT_STRIDE, WS_YC = WS_ACT + 2 * ACT_STRIDE, WS_KA = WS_ACT + 3 * ACT_STRIDE, WS_VA = WS_ACT + 4 * ACT_STRIDE,
                 WS_KB = WS_ACT + 5 * ACT_STRIDE, WS_VB = WS_ACT + 6 * ACT_STRIDE, WS_QI = WS_ACT + 7 * ACT_STRIDE, WS_XC = WS_ACT + 8 * ACT_STRIDE;
constexpr size_t WS_G = WS_KA;
constexpr size_t WS_MASK = 400 * MiB;
constexpr size_t WS_MERGED = 400 * MiB;
constexpr size_t WS_H = WS_ACT;
constexpr size_t WS_END = 512 * MiB;
static_assert(WS_XC + ACT_STRIDE == 400 * MiB && WS_G + (size_t)3 * T * 1024 * 2 == 400 * MiB && WS_H + (size_t)T * DFF * 2 <= 400 * MiB, "d_ws map");
constexpr int CW_DYN = 12288;
constexpr int CW_BAR = 4096;

constexpr int RING_OFF = 0, RING_BYTES = 131072;
constexpr int LDSCTL_OFF = RING_BYTES, MISC_OFF = LDSCTL_OFF + 320;
constexpr int LDS_BYTES = 147456;
constexpr int GL_SKEY = 0, GL_QIF = 65536, GL_WQ = GL_QIF + 2048, GL_HIST = GL_WQ + 64, GL_SEL = GL_HIST + 1024, GL_MISC = GL_SEL + 1024, GL_QS = 70656, GL_PS = 73728;
static_assert(GL_MISC + 64 <= GL_QS && GL_QS + 8 * 256 <= GL_PS && GL_PS + 8 * 4096 <= RING_BYTES, "golden LDS map");

#define GAS __attribute__((address_space(1)))
#define LAS __attribute__((address_space(3)))
typedef unsigned short bf16;
typedef unsigned v4u __attribute__((ext_vector_type(4)));
typedef float f32x4 __attribute__((ext_vector_type(4)));
typedef GAS unsigned gu32;
#define RLX_AGENT __ATOMIC_RELAXED, __HIP_MEMORY_SCOPE_AGENT
#define LDS_WAIT() asm volatile("s_waitcnt lgkmcnt(0)" ::: "memory")
#define VM_WAIT() asm volatile("s_waitcnt vmcnt(0)" ::: "memory")
__device__ __forceinline__ float bf2f(bf16 v) { return __uint_as_float(((unsigned)v) << 16); }
__device__ __forceinline__ unsigned pk2(float lo, float hi) { return pg8::cvt_pk_bf16(lo, hi); }
__device__ __forceinline__ unsigned f2bf(float f) { return pg8::cvt_pk_bf16(f, 0.f) & 0xffffu; }
__device__ __forceinline__ float wave_sum(float v) {
#pragma unroll
    for (int o = 1; o < 64; o <<= 1) v += __shfl_xor(v, o);
    return v;
}
__device__ __forceinline__ float wave_max(float v) {
#pragma unroll
    for (int o = 1; o < 64; o <<= 1) v = fmaxf(v, __shfl_xor(v, o));
    return v;
}
__device__ __forceinline__ int t5_bucket(int n) {
    if (n < 16) return n;
    if (n >= 113) return 31;
    return 16 + (n >= 19) + (n >= 21) + (n >= 24) + (n >= 27) + (n >= 31) + (n >= 35) + (n >= 40) + (n >= 46) + (n >= 52) + (n >= 59) + (n >= 67) + (n >= 77) + (n >= 87) + (n >= 99);
}

#define XB_TMO      128
#define XB_XCNT(j)  (256  + 64 * (j))
#define XB_XSUB(j)  (1280 + 64 * (j))
#define XB_XGEN(j)  (2304 + 64 * (j))
#define XB_TOP      3328
#define XB_TOPGEN   3392
#define XCD_BAR_WORDS 3456
#define XB_SPIN_CAP (1u << 22)

__device__ __forceinline__ unsigned xb_ld(unsigned* p)              { return __hip_atomic_load(p, __ATOMIC_RELAXED, __HIP_MEMORY_SCOPE_AGENT); }
__device__ __forceinline__ unsigned xb_add(unsigned* p, unsigned v) { return __hip_atomic_fetch_add(p, v, __ATOMIC_RELAXED, __HIP_MEMORY_SCOPE_AGENT); }
__device__ __forceinline__ unsigned xb_xcc_id() { return (unsigned)__builtin_amdgcn_s_getreg((3 << 11) | 20) & 0xFu; }
#define XB_SPIN(cond, bar) do { unsigned _sp = 0; while (cond) { __builtin_amdgcn_s_sleep(1); \
    if ((++_sp & 255u) == 0u) { if (xb_ld(&(bar)[XB_TMO])) break; if (_sp > XB_SPIN_CAP) { atomicAdd(&(bar)[XB_TMO], 1u); break; } } } } while (0)

struct XcdBarrier { unsigned* bar; unsigned x; volatile LAS unsigned* st; };

__device__ __forceinline__ XcdBarrier xcd_barrier_post(unsigned* bar, volatile LAS unsigned* st) {
    XcdBarrier b; b.bar = bar; b.x = xb_xcc_id(); b.st = st;
    if (threadIdx.x == 0) (void)xb_add(&bar[XB_XCNT(b.x)], 1u);
    return b;
}
__device__ __forceinline__ void xcd_barrier_complete(unsigned* bar, unsigned x, unsigned& nloc, unsigned& nx) {
    const unsigned G = gridDim.x * gridDim.y * gridDim.z;
    unsigned sum, cnt, mine, sp = 0u;
    for (;;) {
        sum = 0u; cnt = 0u; mine = 0u;
#pragma unroll
        for (unsigned j = 0; j < 16; ++j) { const unsigned c = xb_ld(&bar[XB_XCNT(j)]); sum += c; cnt += (c > 0u) ? 1u : 0u; }
        mine = xb_ld(&bar[XB_XCNT(x)]);
        if (sum == G) break;
        __builtin_amdgcn_s_sleep(1);
        if ((++sp & 255u) == 0u) { if (xb_ld(&bar[XB_TMO])) break; if (sp > XB_SPIN_CAP) { atomicAdd(&bar[XB_TMO], 1u); break; } }
    }
    nloc = mine > 0u ? mine : 1u; nx = cnt > 0u ? cnt : 1u;
}
__device__ __forceinline__ void xcd_barrier(const XcdBarrier& b) {
    asm volatile("s_waitcnt vmcnt(0)" ::: "memory");
    __syncthreads();
    if (threadIdx.x == 0) {
        unsigned* bar = b.bar;
        __builtin_amdgcn_s_waitcnt(0);
        unsigned nloc = b.st[0], nx = b.st[1];
        if (nloc == 0u) { xcd_barrier_complete(bar, b.x, nloc, nx); b.st[0] = nloc; b.st[1] = nx; }
        const unsigned old = xb_add(&bar[XB_XSUB(b.x)], 1u);
        const unsigned gen = old / nloc;
        if (old + 1u == (gen + 1u) * nloc) {
            __builtin_amdgcn_fence(__ATOMIC_RELEASE, "agent");
            asm volatile("s_waitcnt vmcnt(0)" ::: "memory");
            const unsigned og = xb_add(&bar[XB_TOP], 1u);
            const unsigned tg = og / nx;
            if (og + 1u == (tg + 1u) * nx) xb_add(&bar[XB_TOPGEN], 1u);
            else XB_SPIN(xb_ld(&bar[XB_TOPGEN]) == tg, bar);
            __builtin_amdgcn_fence(__ATOMIC_ACQUIRE, "agent");
            xb_add(&bar[XB_XGEN(b.x)], 1u);
            asm volatile("s_waitcnt vmcnt(0)" ::: "memory");
        } else {
            XB_SPIN(xb_ld(&bar[XB_XGEN(b.x)]) == gen, bar);
            __builtin_amdgcn_fence(__ATOMIC_ACQUIRE, "agent");
            asm volatile("s_waitcnt vmcnt(0)" ::: "memory");
        }
    }
    __syncthreads();
}

struct Args { const float* in[19]; float* out; unsigned char* ws; int ph_lo, ph_hi; };
struct Frame {
    LAS unsigned char* lds;
    int tid, lane, wave, G, bid;
    int gw;
    const __attribute__((address_space(4))) Args* a;
    unsigned char* ws; float* out;
};
#define WSB(off) ((bf16*)(F.ws + (off)))
#define WSF(off) ((float*)(F.ws + (off)))
#define INP(i) (F.a->in[i])
#define SSQ_CTL ((pg8::ssq_t*)(F.ws + WS_CTL + (size_t)CW_SSQ * 4))
#define SSQ_MIX(l) ((l) == 0 ? (pg8::ssq_t*)(F.ws + WS_RSTD) : SSQ_CTL + T)
#define SSQ_MLP(l) (SSQ_CTL + ((l) == 0 ? 0 : 2 * T))
enum { I_X = 0, I_RELB, I_NMG, I_WIN, I_CONVW, I_CONVB, I_WR, I_BR, I_WI, I_BI, I_LAM, I_WPA, I_WPB, I_WPC, I_WO, I_NLG, I_WUP, I_WDN, I_FNG };

template <class P> __device__ __forceinline__ P* launder_u(P* p) { unsigned lo = (unsigned)(uintptr_t)p, hi = (unsigned)((uintptr_t)p >> 32); asm volatile("" : "+v"(lo), "+v"(hi));
    lo = __builtin_amdgcn_readfirstlane(lo); hi = __builtin_amdgcn_readfirstlane(hi); return (P*)(((uintptr_t)hi << 32) | (uintptr_t)lo); }
__device__ __forceinline__ int launder_i(int v) { asm volatile("" : "+v"(v)); return __builtin_amdgcn_readfirstlane(v); }

__device__ __forceinline__ void transpose_item(const float* W, int ld, int K, int ncol_valid, const float* gain, bf16* WT, LAS float* scr, int item, int nblk, int lane) {
    const int kb = item / nblk, nb = item % nblk, k0 = 64 * kb, n0 = 32 * nb;
    const float gv = gain ? gain[k0 + lane] : 1.0f;
#pragma unroll 8
    for (int i = 0; i < 32; ++i) { const int kk = 2 * i + (lane >> 5); const int n = n0 + (lane & 31);
        float v = (n < ncol_valid) ? W[(size_t)(k0 + kk) * ld + n] : 0.f; v *= __shfl(gv, kk); scr[kk * 33 + (lane & 31)] = v; }
    LDS_WAIT(); asm volatile("" ::: "memory");
    const int c = lane & 7;
#pragma unroll
    for (int j = 0; j < 4; ++j) { const int n = (lane >> 3) + 8 * j; const LAS float* s = scr + (8 * c) * 33 + n;
        v4u o; o.x = pk2(s[0 * 33], s[1 * 33]); o.y = pk2(s[2 * 33], s[3 * 33]); o.z = pk2(s[4 * 33], s[5 * 33]); o.w = pk2(s[6 * 33], s[7 * 33]);
        *(GAS v4u*)(WT + (size_t)(n0 + n) * K + k0 + 8 * c) = o; }
    LDS_WAIT(); asm volatile("" ::: "memory");
}
__device__ __forceinline__ void norm_row(const float* xrow, bf16* orow, pg8::ssq_t* rstd_out, int lane) {
    const GAS f32x4* xr = (const GAS f32x4*)xrow + lane;
    f32x4 v[4]; float s = 0.f;
#pragma unroll
    for (int j = 0; j < 4; ++j) { v[j] = xr[64 * j]; s += (v[j].x * v[j].x + v[j].y * v[j].y) + (v[j].z * v[j].z + v[j].w * v[j].w); }
    const float ss = wave_sum(s);
    GAS unsigned long long* o8 = (GAS unsigned long long*)orow + lane;
#pragma unroll
    for (int j = 0; j < 4; ++j) o8[64 * j] = (unsigned long long)pk2(v[j].x, v[j].y) | ((unsigned long long)pk2(v[j].z, v[j].w) << 32);
    if (lane == 0) *rstd_out = (pg8::ssq_t)(ss * pg8::SSQ_ONE);
}
__device__ __forceinline__ void p_prologue(Frame& F, int l) {
    LAS float* scr = (LAS float*)(F.lds + RING_OFF + F.wave * 16384);
    const int gw = F.bid * NWAVES + F.wave, NGW = F.G * NWAVES;
    const float* w_in = INP(I_WIN) + (size_t)l * DM * DIN; const float* g1 = INP(I_NMG) + l * DM; const float* g2 = INP(I_NLG) + l * DM;
    constexpr int I_BLK = 16 * 16;
    constexpr int I_SP = 16 * 3;
    constexpr int I_G = 16 * 96;
    constexpr int I_P = 8 * 32;
    constexpr int I_O = 16 * 32;
    constexpr int I_UP = 16 * 128;
    constexpr int I_DN = 64 * 32;
    constexpr int NITEMS = 9 * I_BLK + I_SP + I_G + 3 * I_P + I_O + I_UP + I_DN;
    for (int it = gw; it < NITEMS; it += NGW) {
        int r = it;
        if (r < 9 * I_BLK) { const int blk = r / I_BLK; r -= blk * I_BLK;
            const int c0 = blk == 0 ? 0 : blk == 1 ? 1536 : blk == 2 ? 4168 : blk == 3 ? 512 : blk == 4 ? 1024 : blk == 5 ? 2048 : blk == 6 ? 2560 : blk == 7 ? 3072 : 3656;
            transpose_item(w_in + c0, DIN, DM, 512, g1, WSB(WS_W_IN) + (size_t)blk * 512 * DM, scr, r, 16, F.lane); continue; }
        r -= 9 * I_BLK;
        if (r < I_SP) { transpose_item(w_in + 3584, DIN, DM, 72, g1, WSB(WS_W_IN) + (size_t)4608 * DM, scr, r, 3, F.lane); continue; } r -= I_SP;
        if (r < I_G) { transpose_item(w_in + 4680, DIN, DM, 3072, g1, WSB(WS_W_G), scr, r, 96, F.lane); continue; } r -= I_G;
        if (r < I_P) { transpose_item(INP(I_WPA) + (size_t)l * DH * DM, DM, DH, 1024, nullptr, WSB(WS_W_PA), scr, r, 32, F.lane); continue; } r -= I_P;
        if (r < I_P) { transpose_item(INP(I_WPB) + (size_t)l * DH * DM, DM, DH, 1024, nullptr, WSB(WS_W_PB), scr, r, 32, F.lane); continue; } r -= I_P;
        if (r < I_P) { transpose_item(INP(I_WPC) + (size_t)l * DH * DM, DM, DH, 1024, nullptr, WSB(WS_W_PC), scr, r, 32, F.lane); continue; } r -= I_P;
        if (r < I_O) { transpose_item(INP(I_WO) + (size_t)l * DM * DM, DM, DM, 1024, nullptr, WSB(WS_W_O), scr, r, 32, F.lane); continue; } r -= I_O;
        if (r < I_UP) { transpose_item(INP(I_WUP) + (size_t)l * DM * DFF, DFF, DM, DFF, g2, WSB(WS_W_UP), scr, r, 128, F.lane); continue; } r -= I_UP;
        transpose_item(INP(I_WDN) + (size_t)l * DFF * DM, DM, DFF, 1024, nullptr, WSB(WS_W_DN), scr, r, 32, F.lane);
    }
    { GAS v4u* z = (GAS v4u*)(WSB(WS_W_IN) + (size_t)(4608 + 96) * DM); const int gt = F.bid * (NWAVES * 64) + F.tid;
      unsigned zz = 0u; asm volatile("" : "+v"(zz));
      for (int i = gt; i < 160 * DM / 8; i += F.G * NWAVES * 64) z[i] = (v4u){zz, zz, zz, zz}; }
    if (l == 0) for (int m = gw; m < T; m += NGW) norm_row(INP(I_X) + (size_t)m * DM, WSB(WS_XB) + (size_t)m * DM, (pg8::ssq_t*)(F.ws + WS_RSTD) + m, F.lane);
}
__device__ __forceinline__ void p_final(Frame& F) {
    const int gw = F.bid * NWAVES + F.wave, NGW = F.G * NWAVES;
    for (int m = gw; m < T; m += NGW) {
        const GAS v4u* xr = (const GAS v4u*)(WSB(WS_XB) + (size_t)m * DM) + F.lane; GAS f32x4* orow = (GAS f32x4*)(F.out + (size_t)m * DM) + 2 * F.lane; const GAS f32x4* gr = (const GAS f32x4*)INP(I_FNG) + 2 * F.lane;
        float v[16]; float s = 0.f;
#pragma unroll
        for (int j = 0; j < 2; ++j) { const v4u w = xr[64 * j];
            v[8 * j + 0] = __uint_as_float(w.x << 16); v[8 * j + 1] = __uint_as_float(w.x & 0xffff0000u); v[8 * j + 2] = __uint_as_float(w.y << 16); v[8 * j + 3] = __uint_as_float(w.y & 0xffff0000u);
            v[8 * j + 4] = __uint_as_float(w.z << 16); v[8 * j + 5] = __uint_as_float(w.z & 0xffff0000u); v[8 * j + 6] = __uint_as_float(w.w << 16); v[8 * j + 7] = __uint_as_float(w.w & 0xffff0000u); }
#pragma unroll
        for (int i = 0; i < 16; ++i) s += v[i] * v[i];
        const float rstd = 1.0f / sqrtf(wave_sum(s) * (1.0f / DM) + EPS);
#pragma unroll
        for (int j = 0; j < 2; ++j)
#pragma unroll
            for (int h = 0; h < 2; ++h) { const f32x4 g4 = gr[128 * j + h]; f32x4 o; o.x = v[8 * j + 4 * h] * rstd * g4.x; o.y = v[8 * j + 4 * h + 1] * rstd * g4.y; o.z = v[8 * j + 4 * h + 2] * rstd * g4.z; o.w = v[8 * j + 4 * h + 3] * rstd * g4.w;
                orow[128 * j + h] = o; }
    }
}

__device__ __forceinline__ void kmean_unit(Frame& F, int b, int n) {
    const bf16* kp = WSB(WS_KA) + ((size_t)b * SEQ + (size_t)n * 256) * 512 + F.tid; float s = 0.f;
#pragma unroll 8
    for (int j = 0; j < 256; ++j) s += bf2f(kp[(size_t)j * 512]);
    WSF(WS_KMEAN)[((size_t)b * NBLK + n) * 512 + F.tid] = s * (1.0f / 256.0f);
}
__device__ __forceinline__ float sigmoidf_(float v) { return 1.0f / (1.0f + __expf(-v)); }
typedef short bf16x8_t __attribute__((ext_vector_type(8)));
constexpr int RG_XB_STRIDE = 72;
constexpr int RG_XRAW = 0, RG_YRAW = 2048, RG_XB = 4096, RG_PR = RG_XB + 16 * RG_XB_STRIDE * 2, RG_PI = RG_PR + 16 * 64 * 4, RG_WAVE_LDS = RG_PI + 16 * 64 * 4;
static_assert(8 * RG_WAVE_LDS <= RING_BYTES, "rg LDS");
template <bool P2> __device__ __forceinline__ void rg_unit(Frame& F, int l, int b, int c) {
    int d_ = F.lane; asm volatile("" : "+v"(d_));
    const int n = F.wave, d = d_, ch = n * 64 + d;
    LAS unsigned char* wl = F.lds + RING_OFF + n * RG_WAVE_LDS;
    LAS bf16* xraw = (LAS bf16*)(wl + RG_XRAW); LAS bf16* yraw = (LAS bf16*)(wl + RG_YRAW); LAS bf16* xb = (LAS bf16*)(wl + RG_XB); LAS float* prl = (LAS float*)(wl + RG_PR); LAS float* pil = (LAS float*)(wl + RG_PI);
    const int col = d & 15, kq = d >> 4;
    bf16x8_t wfr[2][4], wfi[2][4];
    { const GAS float* prs = (const GAS float*)INP(I_WR) + (((size_t)l * 8 + n) * 64) * 64 + (8 * kq * 64 + col); const GAS float* pis = (const GAS float*)INP(I_WI) + (((size_t)l * 8 + n) * 64) * 64 + (8 * kq * 64 + col);
#pragma unroll
      for (int ks = 0; ks < 2; ++ks)
#pragma unroll
        for (int nb = 0; nb < 4; ++nb) { float tr[8], ti[8];
#pragma unroll
            for (int j = 0; j < 8; ++j) { const int o = (32 * ks + j) * 64 + 16 * nb; tr[j] = prs[o]; ti[j] = pis[o]; }
            union { bf16x8_t v; unsigned u[4]; } ur, ui;
#pragma unroll
            for (int j = 0; j < 4; ++j) { ur.u[j] = pk2(tr[2 * j], tr[2 * j + 1]); ui.u[j] = pk2(ti[2 * j], ti[2 * j + 1]); }
            wfr[ks][nb] = ur.v; wfi[ks][nb] = ui.v; } }
    const float br = ((const GAS float*)INP(I_BR) + l * 512)[ch], bi = ((const GAS float*)INP(I_BI) + l * 512)[ch];
    const float lamv = ((const GAS float*)INP(I_LAM) + l * 512)[ch]; const float sp = log1pf(__expf(-lamv));
    const GAS float* cwp = (const GAS float*)INP(I_CONVW) + (size_t)l * 4 * 512;
    const float cw0 = cwp[ch], cw1 = cwp[512 + ch], cw2 = cwp[1024 + ch], cw3 = cwp[1536 + ch];
    const float cb = ((const GAS float*)INP(I_CONVB) + l * 512)[ch];
    float h = 0.f, A = 1.f;
    if (P2) { const GAS float* ra = (const GAS float*)WSF(WS_RGA) + (size_t)b * RGC * 512; const GAS float* rh = (const GAS float*)WSF(WS_RGH) + (size_t)b * RGC * 512;
        const GAS float* rap = ra + ch; const GAS float* rhp = rh + ch;
        int j = 0;
#pragma unroll 1
        for (; j + 4 <= c; j += 4) { const float a0 = rap[0], a1 = rap[512], a2 = rap[1024], a3 = rap[1536], h0 = rhp[0], h1 = rhp[512], h2 = rhp[1024], h3 = rhp[1536];
            h = a0 * h + h0; h = a1 * h + h1; h = a2 * h + h2; h = a3 * h + h3; rap += 2048; rhp += 2048; }
#pragma unroll 1
        for (; j < c; ++j) { h = rap[0] * h + rhp[0]; rap += 512; rhp += 512; } }
    const int t0 = c * (SEQ / RGC);
    const GAS bf16* xcs = (const GAS bf16*)WSB(WS_XC) + ((size_t)b * SEQ + t0) * 512;
    GAS bf16* ycs = (GAS bf16*)WSB(WS_YC) + ((size_t)b * SEQ + t0) * 512;
    float x1 = 0.f, x2 = 0.f, x3 = 0.f;
    if (t0 > 0) { const GAS bf16* xm = xcs - 3 * 512; x3 = bf2f(xm[ch]); x2 = bf2f(xm[512 + ch]); x1 = bf2f(xm[1024 + ch]); }
    const int tokA = d >> 3, chk = d & 7;
    const size_t goff = (size_t)tokA * 512 + n * 64 + chk * 8;
    const int loff = tokA * 64 + chk * 8;
#pragma unroll 1
    for (int tile = 0; tile < SEQ / RGC / 16; ++tile) {
        const GAS bf16* xt = xcs + (size_t)tile * 16 * 512 + goff; GAS bf16* yt = ycs + (size_t)tile * 16 * 512 + goff;
        { const v4u a0 = *(const GAS v4u*)xt, a1 = *(const GAS v4u*)(xt + 8 * 512); *(LAS v4u*)(xraw + loff) = a0; *(LAS v4u*)(xraw + loff + 8 * 64) = a1; }
        if (P2) { const v4u a0 = *(const GAS v4u*)yt, a1 = *(const GAS v4u*)(yt + 8 * 512); *(LAS v4u*)(yraw + loff) = a0; *(LAS v4u*)(yraw + loff + 8 * 64) = a1; }
        LDS_WAIT(); asm volatile("" ::: "memory");
        float xc[16];
#pragma unroll
        for (int i = 0; i < 16; ++i) { const float xv = bf2f(xraw[i * 64 + d]); xc[i] = cb + cw0 * x3 + cw1 * x2 + cw2 * x1 + cw3 * xv; x3 = x2; x2 = x1; x1 = xv; }
#pragma unroll
        for (int i = 0; i < 16; ++i) xb[i * RG_XB_STRIDE + d] = (bf16)f2bf(xc[i]);
        LDS_WAIT(); asm volatile("" ::: "memory");
        bf16x8_t af[2];
#pragma unroll
        for (int ks = 0; ks < 2; ++ks) af[ks] = *(const LAS bf16x8_t*)(xb + col * RG_XB_STRIDE + 32 * ks + 8 * kq);
        f32x4 ar[4], ai[4];
#pragma unroll
        for (int nb = 0; nb < 4; ++nb) { ar[nb] = (f32x4){0.f, 0.f, 0.f, 0.f}; ai[nb] = (f32x4){0.f, 0.f, 0.f, 0.f};
#pragma unroll
            for (int ks = 0; ks < 2; ++ks) { ar[nb] = __builtin_amdgcn_mfma_f32_16x16x32_bf16(af[ks], wfr[ks][nb], ar[nb], 0, 0, 0); ai[nb] = __builtin_amdgcn_mfma_f32_16x16x32_bf16(af[ks], wfi[ks][nb], ai[nb], 0, 0, 0); } }
        asm volatile("s_nop 15\n\ts_nop 15" : "+v"(ar[0]), "+v"(ar[1]), "+v"(ar[2]), "+v"(ar[3]), "+v"(ai[0]), "+v"(ai[1]), "+v"(ai[2]), "+v"(ai[3]));
#pragma unroll
        for (int nb = 0; nb < 4; ++nb)
#pragma unroll
            for (int r = 0; r < 4; ++r) { prl[(4 * kq + r) * 64 + 16 * nb + col] = ar[nb][r]; pil[(4 * kq + r) * 64 + 16 * nb + col] = ai[nb][r]; }
        LDS_WAIT(); asm volatile("" ::: "memory");
#pragma unroll
        for (int i = 0; i < 16; ++i) {
            const float r = __builtin_amdgcn_rcpf(1.0f + __expf(-(prl[i * 64 + d] + br))), ig = __builtin_amdgcn_rcpf(1.0f + __expf(-(pil[i * 64 + d] + bi)));
            const float la = -8.0f * r * sp; const float a = __expf(la);
            const float x2a = 2.0f * la;
            const float om = (x2a > -0.05f) ? -x2a * (1.0f + x2a * (0.5f + x2a * (0.16666667f + x2a * 0.041666668f))) : 1.0f - a * a;
            const float u = __builtin_amdgcn_sqrtf(om) * (ig * xc[i]);
            h = a * h + u;
            if (!P2) A *= a;
            else { const float y = bf2f(yraw[i * 64 + d]); const float z = 0.7978845608028654f * (y + 0.044715f * y * y * y);
                const float th = 1.0f - 2.0f * __builtin_amdgcn_rcpf(1.0f + __expf(2.0f * z));
                yraw[i * 64 + d] = (bf16)f2bf(h * (0.5f * y * (1.0f + th))); }
        }
        LDS_WAIT(); asm volatile("" ::: "memory");
        if (P2) { const v4u a0 = *(const LAS v4u*)(yraw + loff), a1 = *(const LAS v4u*)(yraw + loff + 8 * 64); *(GAS v4u*)yt = a0; *(GAS v4u*)(yt + 8 * 512) = a1; }
        LDS_WAIT(); asm volatile("" ::: "memory");
    }
    if (!P2) { const size_t o = ((size_t)b * RGC + c) * 512; ((GAS float*)WSF(WS_RGA) + o)[ch] = A; ((GAS float*)WSF(WS_RGH) + o)[ch] = h; }
    __syncthreads();
}

__device__ __forceinline__ float dot64(const LAS float* qs, const bf16* krow) {
    const v4u* kr = (const v4u*)krow; float s = 0.f;
#pragma unroll
    for (int c = 0; c < 8; ++c) { const v4u w = kr[c]; const f32x4 q0 = *(const LAS f32x4*)(qs + c * 8), q1 = *(const LAS f32x4*)(qs + c * 8 + 4);
        s += q0.x * __uint_as_float(w.x << 16) + q0.y * __uint_as_float(w.x & 0xffff0000u) + q0.z * __uint_as_float(w.y << 16) + q0.w * __uint_as_float(w.y & 0xffff0000u)
           + q1.x * __uint_as_float(w.z << 16) + q1.y * __uint_as_float(w.z & 0xffff0000u) + q1.z * __uint_as_float(w.w << 16) + q1.w * __uint_as_float(w.w & 0xffff0000u); }
    return s;
}
__device__ __forceinline__ void moba_unit(Frame& F, int b, int t) {
    const int h = F.wave, lane = F.lane, cur = t >> 8;
    LAS float* qs = (LAS float*)(F.lds + GL_QS) + h * 64; LAS float* ps = (LAS float*)(F.lds + GL_PS) + h * 1024;
    const size_t row = (size_t)b * SEQ + t;
    bf16* qrow = WSB(WS_QA) + row * 512 + h * 64;
    qs[lane] = bf2f(qrow[lane]);
    LDS_WAIT(); asm volatile("" ::: "memory");
    float g = -1e30f;
    if (lane < cur) { const float* km = WSF(WS_KMEAN) + ((size_t)b * NBLK + lane) * 512 + h * 64; float s = 0.f;
#pragma unroll
        for (int d4 = 0; d4 < 16; ++d4) { const f32x4 kv = *(const f32x4*)(km + d4 * 4); const f32x4 qv = *(const LAS f32x4*)(qs + d4 * 4); s += kv.x * qv.x + kv.y * qv.y + kv.z * qv.z + kv.w * qv.w; }
        g = s; }
    int blk[4]; bool ok[4];
#pragma unroll
    for (int i = 0; i < 3; ++i) { const float m = wave_max(g); const unsigned long long bal = __ballot(g == m); const int sel = __ffsll((long long)bal) - 1; blk[i] = sel; ok[i] = sel < cur; if (lane == sel) g = -INFINITY; }
    blk[3] = cur; ok[3] = true;
    const bf16* Kh = WSB(WS_KA) + ((size_t)b * SEQ) * 512 + h * 64; const bf16* Vh = WSB(WS_VA) + ((size_t)b * SEQ) * 512 + h * 64;
    float lg[16];
#pragma unroll
    for (int i = 0; i < 16; ++i) { const int bi = i >> 2; const int pos = blk[bi] * 256 + (i & 3) * 64 + lane; const bool valid = ok[bi] && pos <= t;
        float s = -1e30f;
        if (valid) s = dot64(qs, Kh + (size_t)pos * 512) * 0.125f + INP(I_RELB)[t5_bucket(t - pos) * 16 + h];
        lg[i] = s; if ((i & 3) == 3) asm volatile("" ::: "memory"); }
    float m = lg[0];
#pragma unroll
    for (int i = 1; i < 16; ++i) m = fmaxf(m, lg[i]);
    m = wave_max(m); float sum = 0.f;
#pragma unroll
    for (int i = 0; i < 16; ++i) { const float e = __expf(lg[i] - m); sum += e; ps[i * 64 + lane] = e; }
    sum = wave_sum(sum);
    LDS_WAIT(); asm volatile("" ::: "memory");
    float acc = 0.f;
#pragma unroll
    for (int bi = 0; bi < 4; ++bi) {
        if (!ok[bi]) continue;
        const int base = blk[bi] * 256; const int nk = (bi == 3) ? (t - base + 1) : 256;
        const bf16* vp = Vh + (size_t)base * 512 + lane; const LAS float* pp = ps + bi * 256;
        int kk = 0;
        for (; kk + 8 <= nk; kk += 8) { float pv[8], vv[8];
#pragma unroll
            for (int j = 0; j < 8; ++j) { pv[j] = pp[kk + j]; vv[j] = bf2f(vp[(size_t)(kk + j) * 512]); }
#pragma unroll
            for (int j = 0; j < 8; ++j) acc += pv[j] * vv[j]; }
        for (; kk < nk; ++kk) acc += pp[kk] * bf2f(vp[(size_t)kk * 512]);
    }
    qrow[lane] = (bf16)f2bf(acc / sum);
}
__device__ __forceinline__ void dsa_unit(Frame& F, int b, int t) {
    const int tid = F.tid, lane = F.lane, h = F.wave;
    LAS unsigned* skey = (LAS unsigned*)(F.lds + GL_SKEY); LAS float* qif = (LAS float*)(F.lds + GL_QIF); LAS float* wq = (LAS float*)(F.lds + GL_WQ);
    LAS unsigned* hist = (LAS unsigned*)(F.lds + GL_HIST); LAS int* sel = (LAS int*)(F.lds + GL_SEL); LAS unsigned* misc = (LAS unsigned*)(F.lds + GL_MISC);
    const size_t row = (size_t)b * SEQ + t; const int n = t + 1;
    __syncthreads();
    qif[tid] = bf2f(WSB(WS_QI)[row * 512 + tid]);
    if (tid < 8) wq[tid] = WSF(WS_WI)[row * 8 + tid];
    if (tid < 16) misc[tid] = 0u;
    __syncthreads();
    if (n > 256) {
        const bf16* kib = WSB(WS_KI) + ((size_t)b * SEQ) * 64;
        for (int s = tid; s < n; s += NWAVES * 64) {
            float kf[64];
            { const v4u* kr = (const v4u*)(kib + (size_t)s * 64);
#pragma unroll
              for (int c = 0; c < 8; ++c) { const v4u w = kr[c]; kf[c * 8 + 0] = __uint_as_float(w.x << 16); kf[c * 8 + 1] = __uint_as_float(w.x & 0xffff0000u); kf[c * 8 + 2] = __uint_as_float(w.y << 16); kf[c * 8 + 3] = __uint_as_float(w.y & 0xffff0000u);
                  kf[c * 8 + 4] = __uint_as_float(w.z << 16); kf[c * 8 + 5] = __uint_as_float(w.z & 0xffff0000u); kf[c * 8 + 6] = __uint_as_float(w.w << 16); kf[c * 8 + 7] = __uint_as_float(w.w & 0xffff0000u); } }
            float score = 0.f;
#pragma unroll 1
            for (int hh = 0; hh < 8; ++hh) { float dsum = 0.f;
#pragma unroll
                for (int d4 = 0; d4 < 16; ++d4) { const f32x4 q = *(const LAS f32x4*)(qif + hh * 64 + d4 * 4); dsum += q.x * kf[d4 * 4] + q.y * kf[d4 * 4 + 1] + q.z * kf[d4 * 4 + 2] + q.w * kf[d4 * 4 + 3]; }
                score += wq[hh] * fmaxf(dsum, 0.f); asm volatile("" ::: "memory"); }
            score *= 0.04419417382415922f;
            if (score == 0.f) score = 0.f;
            const unsigned u = __float_as_uint(score);
            skey[s] = (u & 0x80000000u) ? ~u : (u | 0x80000000u);
        }
        __syncthreads();
        unsigned prefix = 0u; unsigned kneed = 256u, neq = 0u;
#pragma unroll
        for (int pass = 0; pass < 4; ++pass) {
            const int shift = 24 - 8 * pass;
            if (tid < 256) hist[tid] = 0u;
            __syncthreads();
            for (int s = tid; s < n; s += NWAVES * 64) { const unsigned key = skey[s]; const bool match = (pass == 0) ? true : ((key >> ((shift + 8) & 31)) == prefix);
                if (match) __hip_atomic_fetch_add(hist + ((key >> shift) & 255u), 1u, __ATOMIC_RELAXED, __HIP_MEMORY_SCOPE_WORKGROUP); }
            __syncthreads();
            if (h == 0) {
                const unsigned c0 = hist[4 * lane], c1 = hist[4 * lane + 1], c2 = hist[4 * lane + 2], c3 = hist[4 * lane + 3]; const unsigned tot = c0 + c1 + c2 + c3;
                unsigned S = tot;
#pragma unroll
                for (int o = 1; o < 64; o <<= 1) { const unsigned v = __shfl_down(S, o); if (lane + o < 64) S += v; }
                const unsigned above = S - tot;
                if (above < kneed && kneed <= S) { unsigned a = above; unsigned bsel, cnt;
                    if (a + c3 >= kneed) { bsel = 3; cnt = c3; } else { a += c3; if (a + c2 >= kneed) { bsel = 2; cnt = c2; } else { a += c2; if (a + c1 >= kneed) { bsel = 1; cnt = c1; } else { a += c1; bsel = 0; cnt = c0; } } }
                    misc[0] = 4u * lane + bsel; misc[1] = kneed - a; misc[2] = cnt; }
            }
            __syncthreads();
            prefix = (prefix << 8) | misc[0]; kneed = misc[1]; neq = misc[2];
            __syncthreads();
        }
        const unsigned Tk = prefix;
        for (int s = tid; s < n; s += NWAVES * 64) { const unsigned key = skey[s];
            if (key > Tk || (key == Tk && neq == kneed)) { const unsigned idx = __hip_atomic_fetch_add(misc + 8, 1u, __ATOMIC_RELAXED, __HIP_MEMORY_SCOPE_WORKGROUP); if (idx < 256u) sel[idx] = s; } }
        __syncthreads();
        if (neq != kneed && tid == 0) { unsigned c = misc[8]; unsigned need = kneed; for (int s = 0; s < n && need > 0u && c < 256u; ++s) if (skey[s] == Tk) { sel[c++] = s; --need; } }
    } else {
        if (tid < 256) sel[tid] = (tid <= t) ? tid : -1;
    }
    __syncthreads();
    LAS float* qs = (LAS float*)(F.lds + GL_QS) + h * 64; LAS float* ps = (LAS float*)(F.lds + GL_PS) + h * 1024;
    bf16* qrow = WSB(WS_QB) + row * 512 + h * 64;
    qs[lane] = bf2f(qrow[lane]);
    LDS_WAIT(); asm volatile("" ::: "memory");
    const bf16* Kh = WSB(WS_KB) + ((size_t)b * SEQ) * 512 + h * 64; const bf16* Vh = WSB(WS_VB) + ((size_t)b * SEQ) * 512 + h * 64;
    float lg[4];
#pragma unroll
    for (int i = 0; i < 4; ++i) { const int pos = sel[i * 64 + lane]; float s = -1e30f;
        if (pos >= 0) s = dot64(qs, Kh + (size_t)pos * 512) * 0.125f + INP(I_RELB)[t5_bucket(t - pos) * 16 + 8 + h];
        lg[i] = s; }
    float m = wave_max(fmaxf(fmaxf(lg[0], lg[1]), fmaxf(lg[2], lg[3]))); float sum = 0.f;
#pragma unroll
    for (int i = 0; i < 4; ++i) { const float e = __expf(lg[i] - m); sum += e; ps[i * 64 + lane] = e; }
    sum = wave_sum(sum);
    LDS_WAIT(); asm volatile("" ::: "memory");
    float acc = 0.f; const int nk = n < 256 ? n : 256;
    int kk = 0;
    for (; kk + 8 <= nk; kk += 8) { float pv[8], vv[8];
#pragma unroll
        for (int j = 0; j < 8; ++j) { const int pos = sel[kk + j]; pv[j] = ps[kk + j]; vv[j] = bf2f(Vh[(size_t)pos * 512 + lane]); }
#pragma unroll
        for (int j = 0; j < 8; ++j) acc += pv[j] * vv[j]; }
    for (; kk < nk; ++kk) { const int pos = sel[kk]; acc += ps[kk] * bf2f(Vh[(size_t)pos * 512 + lane]); }
    qrow[lane] = (bf16)f2bf(acc / sum);
}

typedef float f32x16 __attribute__((ext_vector_type(16)));
constexpr int AT_KROW = 144, AT_VROW = 136;
constexpr int AT_KBUF = 64 * AT_KROW, AT_VBUF = 64 * AT_VROW;
constexpr int AT_K0 = 0, AT_V0 = 2 * AT_KBUF, AT_BT = 36864, AT_OST = 40960;
constexpr float AT_C2 = 0.125f * 1.4426950408889634f;
constexpr float AT_THR = 8.0f;
constexpr float LOG2E = 1.4426950408889634f;
__device__ __forceinline__ int crow_(int r, int hi) { return (r & 3) + 8 * (r >> 2) + 4 * hi; }
#define MFMA_FENCE2(a, b) asm volatile("s_nop 15\n\ts_nop 15" : "+v"(a), "+v"(b))

__device__ __forceinline__ void at_load(const GAS bf16* Kh, const GAS bf16* Vh, int tile, int tid, v4u& kr, v4u& vr) {
    kr = *(const GAS v4u*)(Kh + (size_t)(tile * 64 + (tid >> 3)) * 512 + (tid & 7) * 8);
    vr = *(const GAS v4u*)(Vh + (size_t)(tile * 64 + (tid >> 3)) * 512 + (tid & 7) * 8);
}
__device__ __forceinline__ void at_store(LAS unsigned char* kb, LAS unsigned char* vb, int tid, const v4u kr, const v4u vr) {
    *(LAS v4u*)(kb + (tid >> 3) * AT_KROW + (tid & 7) * 16) = kr;
    LAS bf16* vt = (LAS bf16*)(vb + ((tid & 7) * 8) * AT_VROW) + (tid >> 3);
    constexpr int RS = AT_VROW / 2;
    vt[0 * RS] = (bf16)(vr.x & 0xffffu); vt[1 * RS] = (bf16)(vr.x >> 16); vt[2 * RS] = (bf16)(vr.y & 0xffffu); vt[3 * RS] = (bf16)(vr.y >> 16);
    vt[4 * RS] = (bf16)(vr.z & 0xffffu); vt[5 * RS] = (bf16)(vr.z >> 16); vt[6 * RS] = (bf16)(vr.w & 0xffffu); vt[7 * RS] = (bf16)(vr.w >> 16);
}
__device__ __forceinline__ void at_qk(f32x16& p0, f32x16& p1, const LAS unsigned char* kb, const bf16x8_t (&qf)[4], int r32, int hi) {
    const LAS unsigned char* kp = kb + r32 * AT_KROW + hi * 16;
    bf16x8_t k0[4], k1[4];
#pragma unroll
    for (int s = 0; s < 4; ++s) { k0[s] = *(const LAS bf16x8_t*)(kp + s * 32); k1[s] = *(const LAS bf16x8_t*)(kp + 32 * AT_KROW + s * 32); }
    asm volatile("s_waitcnt lgkmcnt(0)" : "+v"(k0[0]), "+v"(k0[1]), "+v"(k0[2]), "+v"(k0[3]), "+v"(k1[0]), "+v"(k1[1]), "+v"(k1[2]), "+v"(k1[3]) :: "memory");
#pragma unroll
    for (int s = 0; s < 4; ++s) { p0 = __builtin_amdgcn_mfma_f32_32x32x16_bf16(k0[s], qf[s], p0, 0, 0, 0); p1 = __builtin_amdgcn_mfma_f32_32x32x16_bf16(k1[s], qf[s], p1, 0, 0, 0); }
}
__device__ __forceinline__ void at_qk_m(f32x16& p0, f32x16& p1, const LAS unsigned char* kb, const bf16x8_t (&qf)[4], const bf16x8_t oneA, const bf16x8_t mB, int r32, int hi) {
    const LAS unsigned char* kp = kb + r32 * AT_KROW + hi * 16;
    bf16x8_t k0[4], k1[4];
#pragma unroll
    for (int s = 0; s < 4; ++s) { k0[s] = *(const LAS bf16x8_t*)(kp + s * 32); k1[s] = *(const LAS bf16x8_t*)(kp + 32 * AT_KROW + s * 32); }
    p0 = __builtin_amdgcn_mfma_f32_32x32x16_bf16(oneA, mB, p0, 0, 0, 0); p1 = __builtin_amdgcn_mfma_f32_32x32x16_bf16(oneA, mB, p1, 0, 0, 0);
    asm volatile("s_waitcnt lgkmcnt(0)" : "+v"(k0[0]), "+v"(k0[1]), "+v"(k0[2]), "+v"(k0[3]), "+v"(k1[0]), "+v"(k1[1]), "+v"(k1[2]), "+v"(k1[3]) :: "memory");
#pragma unroll
    for (int s = 0; s < 4; ++s) { p0 = __builtin_amdgcn_mfma_f32_32x32x16_bf16(k0[s], qf[s], p0, 0, 0, 0); p1 = __builtin_amdgcn_mfma_f32_32x32x16_bf16(k1[s], qf[s], p1, 0, 0, 0); }
}
__device__ __forceinline__ void at_pv(f32x16& o0, f32x16& o1, const LAS unsigned char* vb, const bf16x8_t (&pb)[4], int r32, int hi) {
    const LAS unsigned char* vp = vb + r32 * AT_VROW + hi * 8;
    union U { bf16x8_t v; unsigned long long u[2]; }; U a0[4], a1[4];
#pragma unroll
    for (int sg = 0; sg < 4; ++sg) { const int kvo = (32 * (sg >> 1) + 16 * (sg & 1)) * 2;
        a0[sg].u[0] = *(const LAS unsigned long long*)(vp + kvo); a0[sg].u[1] = *(const LAS unsigned long long*)(vp + kvo + 16);
        a1[sg].u[0] = *(const LAS unsigned long long*)(vp + 32 * AT_VROW + kvo); a1[sg].u[1] = *(const LAS unsigned long long*)(vp + 32 * AT_VROW + kvo + 16); }
    asm volatile("s_waitcnt lgkmcnt(0)" : "+v"(a0[0].v), "+v"(a0[1].v), "+v"(a0[2].v), "+v"(a0[3].v), "+v"(a1[0].v), "+v"(a1[1].v), "+v"(a1[2].v), "+v"(a1[3].v) :: "memory");
#pragma unroll
    for (int sg = 0; sg < 4; ++sg) { o0 = __builtin_amdgcn_mfma_f32_32x32x16_bf16(a0[sg].v, pb[sg], o0, 0, 0, 0); o1 = __builtin_amdgcn_mfma_f32_32x32x16_bf16(a1[sg].v, pb[sg], o1, 0, 0, 0); }
}
__device__ __forceinline__ float max3_(float a, float b, float c) { float r; asm("v_max3_f32 %0, %1, %2, %3" : "=v"(r) : "v"(a), "v"(b), "v"(c)); return r; }
__device__ __forceinline__ unsigned and_sel(float p, unsigned w, int bit) { int t; asm("v_bfe_i32 %0, %1, %2, 1" : "=v"(t) : "v"(w), "n"(bit)); return __float_as_uint(p) & (unsigned)t; }

template <int MODE  , bool DRY = false  >
__device__ __forceinline__ void attn_unit(Frame& F, int b, int h, int qt) {
    int tid_ = F.tid; asm volatile("" : "+v"(tid_));
    const int tid = tid_, lane = tid & 63, wave = F.wave, r32 = lane & 31, hi = lane >> 5;
    LAS unsigned char* L = F.lds + RING_OFF;
    LAS float* bt = (LAS float*)(L + AT_BT);
    const GAS bf16* Qg = (const GAS bf16*)WSB(MODE == 0 ? WS_QA : WS_QB); const GAS bf16* Kg = (const GAS bf16*)WSB(MODE == 0 ? WS_KA : WS_KB); const GAS bf16* Vg = (const GAS bf16*)WSB(MODE == 0 ? WS_VA : WS_VB);
    const size_t rowb = (size_t)b * SEQ;
    const GAS bf16* Kh = Kg + rowb * 512 + h * 64; const GAS bf16* Vh = Vg + rowb * 512 + h * 64;
    const int q0w = qt * 256 + wave * 32, q = q0w + r32;
    const int NT = 4 * qt + 4;
    __syncthreads();
    if (tid < 128) { const GAS float* rb = (const GAS float*)INP(I_RELB) + (MODE * 8 + h); bt[tid] = (rb[t5_bucket(tid) * 16] - rb[31 * 16]) * LOG2E; }
    bf16x8_t qf[4];
    { const GAS bf16* qp = Qg + (rowb + q) * 512 + h * 64 + hi * 8;
#pragma unroll
      for (int s = 0; s < 4; ++s) qf[s] = *(const GAS bf16x8_t*)(qp + s * 16); }
    unsigned mlo = 0u, mhi = 0u;
    if (MODE == 0) {
        { const int n = tid >> 3, c8 = (tid & 7) * 8; const GAS float* km = (const GAS float*)WSF(WS_KMEAN) + ((size_t)b * NBLK + n) * 512 + h * 64 + c8;
          const f32x4 a = *(const GAS f32x4*)km, c = *(const GAS f32x4*)(km + 4);
          const unsigned h0 = pk2(a.x, a.y), h1 = pk2(a.z, a.w), h2 = pk2(c.x, c.y), h3 = pk2(c.z, c.w);
          const unsigned l0 = pk2(a.x - __uint_as_float(h0 << 16), a.y - __uint_as_float(h0 & 0xffff0000u)), l1 = pk2(a.z - __uint_as_float(h1 << 16), a.w - __uint_as_float(h1 & 0xffff0000u)),
                         l2 = pk2(c.x - __uint_as_float(h2 << 16), c.y - __uint_as_float(h2 & 0xffff0000u)), l3 = pk2(c.z - __uint_as_float(h3 << 16), c.w - __uint_as_float(h3 & 0xffff0000u));
          *(LAS v4u*)(L + AT_K0 + n * AT_KROW + (tid & 7) * 16) = (v4u){h0, h1, h2, h3}; *(LAS v4u*)(L + AT_K0 + AT_KBUF + n * AT_KROW + (tid & 7) * 16) = (v4u){l0, l1, l2, l3}; }
        __syncthreads();
        f32x16 g0 = {0.f, 0.f, 0.f, 0.f, 0.f, 0.f, 0.f, 0.f, 0.f, 0.f, 0.f, 0.f, 0.f, 0.f, 0.f, 0.f}, g1 = g0;
        at_qk(g0, g1, L + AT_K0, qf, r32, hi); at_qk(g0, g1, L + AT_K0 + AT_KBUF, qf, r32, hi);
        MFMA_FENCE2(g0, g1);
#pragma unroll
        for (int r = 0; r < 16; ++r) { if (crow_(r, hi) >= qt) g0[r] = -INFINITY; if (32 + crow_(r, hi) >= qt) g1[r] = -INFINITY; }
#pragma unroll
        for (int it = 0; it < 3; ++it) {
            float bv = -INFINITY; int bn = 64;
#pragma unroll
            for (int r = 0; r < 16; ++r) if (g0[r] > bv) { bv = g0[r]; bn = crow_(r, hi); }
#pragma unroll
            for (int r = 0; r < 16; ++r) if (g1[r] > bv) { bv = g1[r]; bn = 32 + crow_(r, hi); }
            const float pv = __shfl_xor(bv, 32); const int pn = __shfl_xor(bn, 32);
            const bool tp = (pv > bv) || (pv == bv && pn < bn);
            const float wv = tp ? pv : bv; const int wn = tp ? pn : bn;
            if (wv > -INFINITY) { if (wn < 32) mlo |= 1u << wn; else mhi |= 1u << (wn - 32); }
#pragma unroll
            for (int r = 0; r < 16; ++r) { if (crow_(r, hi) == wn) g0[r] = -INFINITY; if (32 + crow_(r, hi) == wn) g1[r] = -INFINITY; }
        }
        __syncthreads();
    }
    v4u krA, vrA, krB, vrB; unsigned wlA = 0u, whA = 0u, wlB = 0u, whB = 0u;
    const GAS unsigned* mrow = (const GAS unsigned*)(F.ws + WS_MASK) + (rowb + q) * 512;
    at_load(Kh, Vh, 0, tid, krA, vrA);
    unsigned wl_c = 0u, wh_c = 0u;
    if (MODE == 1) { wl_c = mrow[0]; wh_c = mrow[1]; }
    at_store(L + AT_K0, L + AT_V0, tid, krA, vrA);
    at_load(Kh, Vh, 1, tid, krA, vrA);
    if (MODE == 1) { wlA = mrow[2]; whA = mrow[3]; }
    __syncthreads();
    float m = -1e30f, lsum = 0.f;
    f32x16 o0 = {0.f, 0.f, 0.f, 0.f, 0.f, 0.f, 0.f, 0.f, 0.f, 0.f, 0.f, 0.f, 0.f, 0.f, 0.f, 0.f}, o1 = o0;
    auto step = [&](int t, v4u& krS, v4u& vrS, unsigned& wlS, unsigned& whS, v4u& krN, v4u& vrN, unsigned& wlN, unsigned& whN) __attribute__((always_inline)) {
        const int cur = t & 1;
        unsigned wlo = wl_c, whi = wh_c;
        if (t + 2 < NT) { at_load(Kh, Vh, t + 2, tid, krN, vrN); if (MODE == 1) { wlN = mrow[2 * (t + 2)]; whN = mrow[2 * (t + 2) + 1]; } }
        if (MODE == 0) {
            if (t < 4 * qt) { const int blk = t >> 2; const unsigned bit = (blk < 32 ? (mlo >> blk) : (mhi >> (blk - 32))) & 1u; wlo = whi = bit ? 0xffffffffu : 0u; }
            else { const int nall = q - t * 64 + 1;
                wlo = nall >= 32 ? 0xffffffffu : (nall <= 0 ? 0u : ((1u << nall) - 1u)); whi = nall >= 64 ? 0xffffffffu : (nall <= 32 ? 0u : ((1u << (nall - 32)) - 1u)); }
        }
        if (__any((wlo | whi) != 0u)) {
            const LAS unsigned char* kb = L + AT_K0 + cur * AT_KBUF; const LAS unsigned char* vb = L + AT_V0 + cur * AT_VBUF;
            const bool and_mask = (MODE == 1) || (t >= 4 * qt);
            const float ci = (!and_mask && wlo == 0u) ? -1e9f : 0.f;
            f32x16 p0 = {ci, ci, ci, ci, ci, ci, ci, ci, ci, ci, ci, ci, ci, ci, ci, ci}, p1 = p0;
            at_qk(p0, p1, kb, qf, r32, hi);
            MFMA_FENCE2(p0, p1);
            const bool near = (t * 64 + 191 > q0w);
            float mx; float sc = AT_C2;
            if (near) {
#pragma unroll
                for (int r = 0; r < 16; ++r) { const int d0 = q - (t * 64 + crow_(r, hi)), d1 = d0 - 32;
                    const float b0 = ((unsigned)d0 < 128u) ? bt[d0] : 0.f, b1 = ((unsigned)d1 < 128u) ? bt[d1] : 0.f;
                    p0[r] = p0[r] * AT_C2 + b0; p1[r] = p1[r] * AT_C2 + b1; }
                sc = 1.0f;
            }
            { float ma = max3_(p0[0], p1[0], p0[1]), mb = max3_(p1[1], p0[2], p1[2]), mc = max3_(p0[3], p1[3], p0[4]), md = max3_(p1[4], p0[5], p1[5]);
              ma = max3_(ma, p0[6], p1[6]); mb = max3_(mb, p0[7], p1[7]); mc = max3_(mc, p0[8], p1[8]); md = max3_(md, p0[9], p1[9]);
              ma = max3_(ma, p0[10], p1[10]); mb = max3_(mb, p0[11], p1[11]); mc = max3_(mc, p0[12], p1[12]); md = max3_(md, p0[13], p1[13]);
              ma = max3_(ma, p0[14], p1[14]); mb = max3_(mb, p0[15], p1[15]); mx = max3_(ma, mb, mc); mx = max3_(mx, md, md); }
            mx = max3_(mx, __shfl_xor(mx, 32), mx) * sc;
            if (__any(mx > m + AT_THR)) {
                const float mn = fmaxf(m, mx); const float al = __builtin_amdgcn_exp2f(m - mn);
                MFMA_FENCE2(o0, o1);
#pragma unroll
                for (int r = 0; r < 16; ++r) { o0[r] *= al; o1[r] *= al; }
                lsum *= al; m = mn;
            }
            float ls = 0.f;
            if (and_mask) {
                const unsigned wl = wlo >> (4 * hi), wh = whi >> (4 * hi);
                float lq[4] = {0.f, 0.f, 0.f, 0.f};
#pragma unroll
                for (int r = 0; r < 16; ++r) { const int cb = (r & 3) + 8 * (r >> 2);
                    const float e0 = __uint_as_float(and_sel(__builtin_amdgcn_exp2f(__builtin_fmaf(p0[r], sc, -m)), wl, cb)), e1 = __uint_as_float(and_sel(__builtin_amdgcn_exp2f(__builtin_fmaf(p1[r], sc, -m)), wh, cb));
                    p0[r] = e0; p1[r] = e1; lq[r & 1] += e0; lq[2 + (r & 1)] += e1; }
                ls = (lq[0] + lq[1]) + (lq[2] + lq[3]);
            } else {
#pragma unroll
                for (int r = 0; r < 16; ++r) { const float e0 = __builtin_amdgcn_exp2f(__builtin_fmaf(p0[r], sc, -m)), e1 = __builtin_amdgcn_exp2f(__builtin_fmaf(p1[r], sc, -m));
                    p0[r] = e0; p1[r] = e1; ls += e0 + e1; }
            }
            lsum += ls;
            bf16x8_t pb[4];
#pragma unroll
            for (int sg = 0; sg < 4; ++sg) { union { bf16x8_t v; unsigned u[4]; } pk;
#pragma unroll
                for (int j = 0; j < 4; ++j) { const int r = 8 * (sg & 1) + 2 * j; pk.u[j] = (sg < 2) ? pg8::cvt_pk_bf16(p0[r], p0[r + 1]) : pg8::cvt_pk_bf16(p1[r], p1[r + 1]); }
                pb[sg] = pk.v; }
            at_pv(o0, o1, vb, pb, r32, hi);
        }
        if (t + 1 < NT) at_store(L + AT_K0 + (cur ^ 1) * AT_KBUF, L + AT_V0 + (cur ^ 1) * AT_VBUF, tid, krS, vrS);
        wl_c = wlS; wh_c = whS;
        __syncthreads();
    };
#pragma unroll 1
    for (int t = 0; t < NT; t += 2) {
        step(t, krA, vrA, wlA, whA, krB, vrB, wlB, whB);
        step(t + 1, krB, vrB, wlB, whB, krA, vrA, wlA, whA);
    }
    MFMA_FENCE2(o0, o1);
    lsum += __shfl_xor(lsum, 32);
    const float inv = 1.0f / lsum;
    LAS bf16* ost = (LAS bf16*)(L + AT_OST + wave * 4096);
#pragma unroll
    for (int r = 0; r < 16; ++r) { ost[r32 * 64 + crow_(r, hi)] = (bf16)f2bf(o0[r] * inv); ost[r32 * 64 + 32 + crow_(r, hi)] = (bf16)f2bf(o1[r] * inv); }
    LDS_WAIT(); asm volatile("" ::: "memory");
    GAS bf16* Og = (GAS bf16*)WSB(MODE == 0 ? WS_QA : WS_QB) + (rowb + q0w) * 512 + h * 64;
#pragma unroll
    for (int i = 0; i < 4; ++i) { const int c = i * 64 + lane, row = c >> 3, ch = c & 7; const v4u ov = *(const LAS v4u*)(ost + row * 64 + ch * 8); if (!DRY) *(GAS v4u*)(Og + (size_t)row * 512 + ch * 8) = ov; else if (ov.x == 0x12345678u && ov.y == 0x9abcdef0u) *(GAS v4u*)(Og + (size_t)row * 512 + ch * 8) = ov; }
}

constexpr int DA_K0 = 0, DA_V0 = 3 * AT_KBUF, DA_BT = DA_V0 + 2 * AT_VBUF, DA_OST = 49152;
static_assert(DA_BT + 512 <= DA_OST && DA_OST + 8 * 4096 <= RING_BYTES, "dsa attention LDS map");
__device__ __forceinline__ v4u at_load_k(const GAS bf16* Kh, int tile, int tid) { return *(const GAS v4u*)(Kh + (size_t)(tile * 64 + (tid >> 3)) * 512 + (tid & 7) * 8); }
__device__ __forceinline__ v4u at_load_v(const GAS bf16* Vh, int tile, int tid) { return *(const GAS v4u*)(Vh + (size_t)(tile * 64 + (tid & 63)) * 512 + (tid >> 6) * 8); }
__device__ __forceinline__ void at_store_k(LAS unsigned char* kb, int tid, const v4u kr) { *(LAS v4u*)(kb + (tid >> 3) * AT_KROW + (tid & 7) * 16) = kr; }
__device__ __forceinline__ void at_store_v(LAS unsigned char* vb, int tid, const v4u vr) {
    LAS bf16* vt = (LAS bf16*)(vb + ((tid >> 6) * 8) * AT_VROW) + (tid & 63); constexpr int RS = AT_VROW / 2;
    vt[0 * RS] = (bf16)(vr.x & 0xffffu); vt[1 * RS] = (bf16)(vr.x >> 16); vt[2 * RS] = (bf16)(vr.y & 0xffffu); vt[3 * RS] = (bf16)(vr.y >> 16);
    vt[4 * RS] = (bf16)(vr.z & 0xffffu); vt[5 * RS] = (bf16)(vr.z >> 16); vt[6 * RS] = (bf16)(vr.w & 0xffffu); vt[7 * RS] = (bf16)(vr.w >> 16);
}
struct DsaState { float m, lsum; f32x16 o0, o1; unsigned wc_lo, wc_hi, wn_lo, wn_hi; };
__device__ __forceinline__ void dsa_step(DsaState& S, f32x16& P0, f32x16& P1, f32x16& Pn0, f32x16& Pn1, int t, int NT, LAS unsigned char* L, const LAS float* bt, const bf16x8_t (&qf)[4],
                                         const GAS bf16* Kh, const GAS bf16* Vh, const GAS unsigned* mrow, int tid, int r32, int hi, int q, int q0w) {
    v4u krn, vrn; unsigned wq_lo = 0u, wq_hi = 0u;
    const bool has1 = (t + 1 < NT), has2 = (t + 2 < NT);
    if (has2) { krn = at_load_k(Kh, t + 2, tid); wq_lo = mrow[2 * (t + 2)]; wq_hi = mrow[2 * (t + 2) + 1]; }
    if (has1) vrn = at_load_v(Vh, t + 1, tid);
    if (has1 && __any((S.wn_lo | S.wn_hi) != 0u)) {
        Pn0 = (f32x16){0.f, 0.f, 0.f, 0.f, 0.f, 0.f, 0.f, 0.f, 0.f, 0.f, 0.f, 0.f, 0.f, 0.f, 0.f, 0.f}; Pn1 = Pn0;
        at_qk(Pn0, Pn1, L + DA_K0 + ((t + 1) % 3) * AT_KBUF, qf, r32, hi);
    }
    if (__any((S.wc_lo | S.wc_hi) != 0u)) {
        const LAS unsigned char* vb = L + DA_V0 + (t & 1) * AT_VBUF;
        MFMA_FENCE2(P0, P1);
        const bool near = (t * 64 + 191 > q0w);
        float sc = AT_C2;
        if (near) {
#pragma unroll
            for (int r = 0; r < 16; ++r) { const int d0 = q - (t * 64 + crow_(r, hi)), d1 = d0 - 32;
                const float b0 = ((unsigned)d0 < 128u) ? bt[d0] : 0.f, b1 = ((unsigned)d1 < 128u) ? bt[d1] : 0.f;
                P0[r] = P0[r] * AT_C2 + b0; P1[r] = P1[r] * AT_C2 + b1; }
            sc = 1.0f;
        }
        float mx = max3_(P0[0], P1[0], P0[1]), mx2 = max3_(P1[1], P0[2], P1[2]);
#pragma unroll
        for (int r = 3; r < 15; r += 2) { mx = max3_(mx, P0[r], P1[r]); mx2 = max3_(mx2, P0[r + 1], P1[r + 1]); }
        mx = max3_(mx, P0[15], P1[15]); mx = max3_(mx, mx2, mx2);
        mx = max3_(mx, __shfl_xor(mx, 32), mx) * sc;
        if (__any(mx > S.m + AT_THR)) {
            const float mn = fmaxf(S.m, mx); const float al = __builtin_amdgcn_exp2f(S.m - mn);
            MFMA_FENCE2(S.o0, S.o1);
#pragma unroll
            for (int r = 0; r < 16; ++r) { S.o0[r] *= al; S.o1[r] *= al; }
            S.lsum *= al; S.m = mn;
        }
        const unsigned wl = S.wc_lo >> (4 * hi), wh = S.wc_hi >> (4 * hi); const float m = S.m;
        float ls = 0.f;
#pragma unroll
        for (int r = 0; r < 16; ++r) { const int cb = (r & 3) + 8 * (r >> 2);
            const float e0 = __uint_as_float(and_sel(__builtin_amdgcn_exp2f(__builtin_fmaf(P0[r], sc, -m)), wl, cb)), e1 = __uint_as_float(and_sel(__builtin_amdgcn_exp2f(__builtin_fmaf(P1[r], sc, -m)), wh, cb));
            P0[r] = e0; P1[r] = e1; ls += e0 + e1; }
        S.lsum += ls;
        bf16x8_t pb[4];
#pragma unroll
        for (int sg = 0; sg < 4; ++sg) { union { bf16x8_t v; unsigned u[4]; } pk;
#pragma unroll
            for (int j = 0; j < 4; ++j) { const int r = 8 * (sg & 1) + 2 * j; pk.u[j] = (sg < 2) ? pg8::cvt_pk_bf16(P0[r], P0[r + 1]) : pg8::cvt_pk_bf16(P1[r], P1[r + 1]); }
            pb[sg] = pk.v; }
        at_pv(S.o0, S.o1, vb, pb, r32, hi);
    }
    if (has2) at_store_k(L + DA_K0 + ((t + 2) % 3) * AT_KBUF, tid, krn);
    if (has1) at_store_v(L + DA_V0 + ((t + 1) & 1) * AT_VBUF, tid, vrn);
    S.wc_lo = S.wn_lo; S.wc_hi = S.wn_hi; S.wn_lo = wq_lo; S.wn_hi = wq_hi;
    __syncthreads();
}
template <bool DRY = false> __device__ __forceinline__ void dsa_attn_unit(Frame& F, int b, int h, int qt) {
    int tid_ = F.tid; asm volatile("" : "+v"(tid_));
    const int tid = tid_, lane = tid & 63, wave = F.wave, r32 = lane & 31, hi = lane >> 5;
    LAS unsigned char* L = F.lds + RING_OFF;
    LAS float* bt = (LAS float*)(L + DA_BT);
    const size_t rowb = (size_t)b * SEQ;
    const GAS bf16* Kh = (const GAS bf16*)WSB(WS_KB) + rowb * 512 + h * 64; const GAS bf16* Vh = (const GAS bf16*)WSB(WS_VB) + rowb * 512 + h * 64;
    const int q0w = qt * 256 + wave * 32, q = q0w + r32;
    const int NT = 4 * qt + 4;
    __syncthreads();
    if (tid < 128) { const GAS float* rb = (const GAS float*)INP(I_RELB) + (8 + h); bt[tid] = (rb[t5_bucket(tid) * 16] - rb[31 * 16]) * LOG2E; }
    bf16x8_t qf[4];
    { const GAS bf16* qp = (const GAS bf16*)WSB(WS_QB) + (rowb + q) * 512 + h * 64 + hi * 8;
#pragma unroll
      for (int s = 0; s < 4; ++s) qf[s] = *(const GAS bf16x8_t*)(qp + s * 16); }
    const GAS unsigned* mrow = (const GAS unsigned*)(F.ws + WS_MASK) + (rowb + q) * 512;
    DsaState S; S.m = -1e30f; S.lsum = 0.f; S.o0 = (f32x16){0.f, 0.f, 0.f, 0.f, 0.f, 0.f, 0.f, 0.f, 0.f, 0.f, 0.f, 0.f, 0.f, 0.f, 0.f, 0.f}; S.o1 = S.o0;
    S.wc_lo = mrow[0]; S.wc_hi = mrow[1]; S.wn_lo = mrow[2]; S.wn_hi = mrow[3];
    { const v4u k0 = at_load_k(Kh, 0, tid), v0 = at_load_v(Vh, 0, tid), k1 = at_load_k(Kh, 1, tid);
      at_store_k(L + DA_K0, tid, k0); at_store_v(L + DA_V0, tid, v0); at_store_k(L + DA_K0 + AT_KBUF, tid, k1); }
    __syncthreads();
    f32x16 pA0 = {0.f, 0.f, 0.f, 0.f, 0.f, 0.f, 0.f, 0.f, 0.f, 0.f, 0.f, 0.f, 0.f, 0.f, 0.f, 0.f}, pA1 = pA0, pB0 = pA0, pB1 = pA0;
    if (__any((S.wc_lo | S.wc_hi) != 0u)) at_qk(pA0, pA1, L + DA_K0, qf, r32, hi);
#pragma unroll 1
    for (int t = 0; t < NT; t += 2) {
        dsa_step(S, pA0, pA1, pB0, pB1, t, NT, L, bt, qf, Kh, Vh, mrow, tid, r32, hi, q, q0w);
        dsa_step(S, pB0, pB1, pA0, pA1, t + 1, NT, L, bt, qf, Kh, Vh, mrow, tid, r32, hi, q, q0w);
    }
    MFMA_FENCE2(S.o0, S.o1);
    float lsum = S.lsum; lsum += __shfl_xor(lsum, 32);
    const float inv = 1.0f / lsum;
    LAS bf16* ost = (LAS bf16*)(L + DA_OST + wave * 4096);
#pragma unroll
    for (int r = 0; r < 16; ++r) { ost[r32 * 64 + crow_(r, hi)] = (bf16)f2bf(S.o0[r] * inv); ost[r32 * 64 + 32 + crow_(r, hi)] = (bf16)f2bf(S.o1[r] * inv); }
    LDS_WAIT(); asm volatile("" ::: "memory");
    GAS bf16* Og = (GAS bf16*)WSB(WS_QB) + (rowb + q0w) * 512 + h * 64;
#pragma unroll
    for (int i = 0; i < 4; ++i) { const int c = i * 64 + lane, row = c >> 3, ch = c & 7; const v4u ov = *(const LAS v4u*)(ost + row * 64 + ch * 8); if (!DRY) *(GAS v4u*)(Og + (size_t)row * 512 + ch * 8) = ov; else if (ov.x == 0x12345678u && ov.y == 0x9abcdef0u) *(GAS v4u*)(Og + (size_t)row * 512 + ch * 8) = ov; }
}

constexpr int A2_TILE = 64 * 128;
__device__ __forceinline__ void at2_dma(const GAS bf16* Kh, const GAS bf16* Vh, int tile, int wave, int lane, LAS unsigned char* kb, LAS unsigned char* vb) {
    const int row = 8 * wave + (lane >> 3), p = lane & 7;
    const GAS bf16* kg = Kh + (size_t)(tile * 64 + row) * 512 + ((p ^ ((row >> 1) & 7)) * 8);
    const GAS bf16* vg = Vh + (size_t)(tile * 64 + row) * 512 + ((p ^ (((row >> 1) & 1) * 4)) * 8);
    __builtin_amdgcn_global_load_lds((const unsigned*)kg, (LAS unsigned*)(kb + wave * 1024), 16, 0, 0);
    __builtin_amdgcn_global_load_lds((const unsigned*)vg, (LAS unsigned*)(vb + wave * 1024), 16, 0, 0);
}
__device__ __forceinline__ void at2_qk_m(f32x16& p0, f32x16& p1, const LAS unsigned char* kb, const LAS unsigned char* ones, const bf16x8_t (&qf)[4], const bf16x8_t mB, int r32, int hi) {
    const int f = (r32 >> 1) & 7;
    const LAS unsigned char* kp = kb + r32 * 128;
    bf16x8_t k0[5], k1[5];
#pragma unroll
    for (int s = 0; s < 4; ++s) { const int po = ((2 * s + hi) ^ f) * 16; k0[s] = *(const LAS bf16x8_t*)(kp + po); k1[s] = *(const LAS bf16x8_t*)(kp + 32 * 128 + po); }
    k0[4] = *(const LAS bf16x8_t*)ones; k1[4] = k0[4];
    asm volatile("s_waitcnt lgkmcnt(0)" : "+v"(k0[0]), "+v"(k0[1]), "+v"(k0[2]), "+v"(k0[3]), "+v"(k0[4]), "+v"(k1[0]), "+v"(k1[1]), "+v"(k1[2]), "+v"(k1[3]), "+v"(k1[4]) :: "memory");
    p0 = __builtin_amdgcn_mfma_f32_32x32x16_bf16(k0[4], mB, p0, 0, 0, 0); p1 = __builtin_amdgcn_mfma_f32_32x32x16_bf16(k1[4], mB, p1, 0, 0, 0);
#pragma unroll
    for (int s = 0; s < 4; ++s) { p0 = __builtin_amdgcn_mfma_f32_32x32x16_bf16(k0[s], qf[s], p0, 0, 0, 0); p1 = __builtin_amdgcn_mfma_f32_32x32x16_bf16(k1[s], qf[s], p1, 0, 0, 0); }
}
typedef short s16x4_t __attribute__((ext_vector_type(4)));
__device__ __forceinline__ void at2_pv(f32x16& o0, f32x16& o1, const LAS unsigned char* vb, const bf16x8_t (&pb)[4], int lane) {
    const int g = lane >> 4, q = (lane & 15) >> 2, p = lane & 3;
    const int sw = ((q >> 1) & 1) * 4, c0 = 2 * (g & 1) + (p >> 1);
    const LAS unsigned char* rowp = vb + (4 * (g >> 1) + q) * 128 + 8 * (p & 1);
    const LAS unsigned char* b0 = rowp + ((c0 ^ sw) * 16); const LAS unsigned char* b1 = rowp + (((c0 + 4) ^ sw) * 16);
    union U { bf16x8_t v; s16x4_t h[2]; }; U a0[4], a1[4];
#pragma unroll
    for (int sg = 0; sg < 4; ++sg) { const int ro = (32 * (sg >> 1) + 16 * (sg & 1)) * 128;
        a0[sg].h[0] = __builtin_amdgcn_ds_read_tr16_b64_v4i16((LAS s16x4_t*)(b0 + ro)); a0[sg].h[1] = __builtin_amdgcn_ds_read_tr16_b64_v4i16((LAS s16x4_t*)(b0 + ro + 8 * 128));
        a1[sg].h[0] = __builtin_amdgcn_ds_read_tr16_b64_v4i16((LAS s16x4_t*)(b1 + ro)); a1[sg].h[1] = __builtin_amdgcn_ds_read_tr16_b64_v4i16((LAS s16x4_t*)(b1 + ro + 8 * 128)); }
    asm volatile("s_waitcnt lgkmcnt(0)" : "+v"(a0[0].v), "+v"(a0[1].v), "+v"(a0[2].v), "+v"(a0[3].v), "+v"(a1[0].v), "+v"(a1[1].v), "+v"(a1[2].v), "+v"(a1[3].v) :: "memory");
#pragma unroll
    for (int sg = 0; sg < 4; ++sg) { o0 = __builtin_amdgcn_mfma_f32_32x32x16_bf16(a0[sg].v, pb[sg], o0, 0, 0, 0); o1 = __builtin_amdgcn_mfma_f32_32x32x16_bf16(a1[sg].v, pb[sg], o1, 0, 0, 0); }
}
constexpr int D2_K = 0, D2_V = 4 * A2_TILE, D2_ONES = 8 * A2_TILE, D2_BT = D2_ONES + 64, D2_OST = 73728;
static_assert(D2_BT + 512 <= D2_OST && D2_OST + 8 * 4096 <= RING_BYTES, "dsa2 LDS map");
template <bool DRY = false> __device__ __forceinline__ void dsa_attn2_unit(Frame& F, int b, int h, int qt) {
    int tid_ = F.tid; asm volatile("" : "+v"(tid_));
    const int tid = tid_, lane = tid & 63, wave = F.wave, r32 = lane & 31, hi = lane >> 5;
    LAS unsigned char* L = F.lds + RING_OFF;
    LAS float* bt = (LAS float*)(L + D2_BT);
    const size_t rowb = (size_t)b * SEQ;
    const GAS bf16* Kh = (const GAS bf16*)WSB(WS_KB) + rowb * 512 + h * 64; const GAS bf16* Vh = (const GAS bf16*)WSB(WS_VB) + rowb * 512 + h * 64;
    const int q0w = qt * 256 + wave * 32, q = q0w + r32;
    const int NS = 2 * qt + 2;
    __syncthreads();
    if (tid < 128) { const GAS float* rb = (const GAS float*)INP(I_RELB) + (8 + h); bt[tid] = (rb[t5_bucket(tid) * 16] - rb[31 * 16]) * LOG2E; }
    bf16x8_t qf[4];
    { const GAS bf16* qp = (const GAS bf16*)WSB(WS_QB) + (rowb + q) * 512 + h * 64 + hi * 8;
#pragma unroll
      for (int s = 0; s < 4; ++s) qf[s] = *(const GAS bf16x8_t*)(qp + s * 16); }
#pragma unroll
    for (int s = 0; s < 4; ++s) { union { bf16x8_t v; unsigned u[4]; } x; x.v = qf[s];
#pragma unroll
        for (int jj = 0; jj < 4; ++jj) x.u[jj] = pg8::cvt_pk_bf16(pg8::bf_lo(x.u[jj]) * AT_C2, pg8::bf_hi(x.u[jj]) * AT_C2);
        qf[s] = x.v; }
    bf16x8_t mB;
    { union { bf16x8_t v; unsigned u[4]; } x; x.u[0] = x.u[1] = x.u[2] = x.u[3] = 0u; mB = x.v; }
    if (tid == 0) { unsigned one = 0x3f80u, zz = 0u; asm volatile("" : "+v"(one), "+v"(zz)); *(LAS v4u*)(L + D2_ONES) = (v4u){one, zz, zz, zz}; }
    bool fresh = true;
    const GAS unsigned* mrow = (const GAS unsigned*)(F.ws + WS_MASK) + (rowb + q) * 512;
    auto dma2 = [&](int s) __attribute__((always_inline)) { const int set = s & 1;
        at2_dma(Kh, Vh, 2 * s, wave, lane, L + D2_K + (2 * set) * A2_TILE, L + D2_V + (2 * set) * A2_TILE);
        at2_dma(Kh, Vh, 2 * s + 1, wave, lane, L + D2_K + (2 * set + 1) * A2_TILE, L + D2_V + (2 * set + 1) * A2_TILE); };
    dma2(0);
    unsigned wc[4] = { mrow[0], mrow[1], mrow[2], mrow[3] };
    VM_WAIT(); __syncthreads();
    float m = 0.f, lsum = 0.f;
    f32x16 o0 = {0.f, 0.f, 0.f, 0.f, 0.f, 0.f, 0.f, 0.f, 0.f, 0.f, 0.f, 0.f, 0.f, 0.f, 0.f, 0.f}, o1 = o0;
    auto step = [&](int s) __attribute__((always_inline)) {
        const int set = s & 1;
        if (s + 1 < NS) dma2(s + 1);
        unsigned wn[4] = {0u, 0u, 0u, 0u};
        if (s + 1 < NS) { const GAS unsigned* mp = mrow + 4 * (s + 1); wn[0] = mp[0]; wn[1] = mp[1]; wn[2] = mp[2]; wn[3] = mp[3]; }
        if (__any((wc[0] | wc[1] | wc[2] | wc[3]) != 0u)) {
            const LAS unsigned char* kb = L + D2_K + (2 * set) * A2_TILE; const LAS unsigned char* vb = L + D2_V + (2 * set) * A2_TILE;
            f32x16 p0 = {0.f, 0.f, 0.f, 0.f, 0.f, 0.f, 0.f, 0.f, 0.f, 0.f, 0.f, 0.f, 0.f, 0.f, 0.f, 0.f}, p1 = p0, p2 = p0, p3 = p0;
            at2_qk_m(p0, p1, kb, L + D2_ONES, qf, mB, r32, hi); at2_qk_m(p2, p3, kb + A2_TILE, L + D2_ONES, qf, mB, r32, hi);
            asm volatile("s_nop 15\n\ts_nop 15" : "+v"(p0), "+v"(p1), "+v"(p2), "+v"(p3));
            const int t0 = 2 * s;
            const bool near = ((t0 + 1) * 64 + 191 > q0w);
            if (near) {
#pragma unroll
                for (int r = 0; r < 16; ++r) { const int d0 = q - (t0 * 64 + crow_(r, hi)), d1 = d0 - 32, d2 = d0 - 64, d3 = d0 - 96;
                    const float b0 = ((unsigned)d0 < 128u) ? bt[d0] : 0.f, b1 = ((unsigned)d1 < 128u) ? bt[d1] : 0.f, b2 = ((unsigned)d2 < 128u) ? bt[d2] : 0.f, b3 = ((unsigned)d3 < 128u) ? bt[d3] : 0.f;
                    p0[r] += b0; p1[r] += b1; p2[r] += b2; p3[r] += b3; }
            }
            float mx;
            { float ma = max3_(p0[0], p1[0], p2[0]), mb = max3_(p3[0], p0[1], p1[1]), mc = max3_(p2[1], p3[1], p0[2]), md = max3_(p1[2], p2[2], p3[2]);
#pragma unroll
              for (int r = 3; r < 15; r += 2) { ma = max3_(ma, p0[r], p1[r]); mb = max3_(mb, p2[r], p3[r]); mc = max3_(mc, p0[r + 1], p1[r + 1]); md = max3_(md, p2[r + 1], p3[r + 1]); }
              ma = max3_(ma, p0[15], p1[15]); mb = max3_(mb, p2[15], p3[15]); mx = max3_(ma, mb, mc); mx = max3_(mx, md, md); }
            mx = max3_(mx, __shfl_xor(mx, 32), mx);
            if (fresh || __any(mx > AT_THR)) {
                const float d = fresh ? mx : fmaxf(mx, 0.f);
                const float mn = __uint_as_float(pg8::cvt_pk_bf16(0.f, m + d) & 0xffff0000u);
                const float dl = mn - m; const float al = __builtin_amdgcn_exp2f(-dl);
                MFMA_FENCE2(o0, o1);
#pragma unroll
                for (int r = 0; r < 16; ++r) { o0[r] *= al; o1[r] *= al; p0[r] -= dl; p1[r] -= dl; p2[r] -= dl; p3[r] -= dl; }
                lsum *= al; m = mn; fresh = false;
                { union { bf16x8_t v; unsigned u[4]; } x; x.u[0] = hi == 0 ? ((__float_as_uint(m) >> 16) ^ 0x8000u) : 0u; x.u[1] = x.u[2] = x.u[3] = 0u; mB = x.v; }
            }
            const unsigned w0 = wc[0] >> (4 * hi), w1 = wc[1] >> (4 * hi), w2 = wc[2] >> (4 * hi), w3 = wc[3] >> (4 * hi);
            float lq[4] = {0.f, 0.f, 0.f, 0.f};
#pragma unroll
            for (int r = 0; r < 16; ++r) { const int cb = (r & 3) + 8 * (r >> 2);
                const float e0 = __uint_as_float(and_sel(__builtin_amdgcn_exp2f(p0[r]), w0, cb)), e1 = __uint_as_float(and_sel(__builtin_amdgcn_exp2f(p1[r]), w1, cb));
                const float e2 = __uint_as_float(and_sel(__builtin_amdgcn_exp2f(p2[r]), w2, cb)), e3 = __uint_as_float(and_sel(__builtin_amdgcn_exp2f(p3[r]), w3, cb));
                p0[r] = e0; p1[r] = e1; p2[r] = e2; p3[r] = e3; lq[0] += e0; lq[1] += e1; lq[2] += e2; lq[3] += e3; }
            lsum += (lq[0] + lq[1]) + (lq[2] + lq[3]);
            bf16x8_t pb[4], pc[4];
#pragma unroll
            for (int sg = 0; sg < 4; ++sg) { union { bf16x8_t v; unsigned u[4]; } pk, pl;
#pragma unroll
                for (int j = 0; j < 4; ++j) { const int r = 8 * (sg & 1) + 2 * j; pk.u[j] = (sg < 2) ? pg8::cvt_pk_bf16(p0[r], p0[r + 1]) : pg8::cvt_pk_bf16(p1[r], p1[r + 1]);
                    pl.u[j] = (sg < 2) ? pg8::cvt_pk_bf16(p2[r], p2[r + 1]) : pg8::cvt_pk_bf16(p3[r], p3[r + 1]); }
                pb[sg] = pk.v; pc[sg] = pl.v; }
            at2_pv(o0, o1, vb, pb, lane); at2_pv(o0, o1, vb + A2_TILE, pc, lane);
        }
        wc[0] = wn[0]; wc[1] = wn[1]; wc[2] = wn[2]; wc[3] = wn[3];
        VM_WAIT(); __syncthreads();
    };
#pragma unroll 1
    for (int s = 0; s < NS; ++s) step(s);
    MFMA_FENCE2(o0, o1);
    lsum += __shfl_xor(lsum, 32);
    const float inv = 1.0f / lsum;
    LAS bf16* ost = (LAS bf16*)(L + D2_OST + wave * 4096);
#pragma unroll
    for (int r = 0; r < 16; ++r) { ost[r32 * 64 + crow_(r, hi)] = (bf16)f2bf(o0[r] * inv); ost[r32 * 64 + 32 + crow_(r, hi)] = (bf16)f2bf(o1[r] * inv); }
    LDS_WAIT(); asm volatile("" ::: "memory");
    GAS bf16* Og = (GAS bf16*)WSB(WS_QB) + (rowb + q0w) * 512 + h * 64;
#pragma unroll
    for (int i = 0; i < 4; ++i) { const int c = i * 64 + lane, row = c >> 3, ch = c & 7; const v4u ov = *(const LAS v4u*)(ost + row * 64 + ch * 8); if (!DRY) *(GAS v4u*)(Og + (size_t)row * 512 + ch * 8) = ov; else if (ov.x == 0x12345678u && ov.y == 0x9abcdef0u) *(GAS v4u*)(Og + (size_t)row * 512 + ch * 8) = ov; }
}
#ifndef IX_SMIN_V
#define IX_SMIN_V 16
#endif
#ifndef IX_ZMAX_V
#define IX_ZMAX_V 255
#endif
constexpr int IX_FSH = 18, IX_FBASE = (0x2000 | (127 << 5)) - 42 * 32, IX_SSTRIDE = 8, IX_SMIN = IX_SMIN_V, IX_SHI = 16, IX_SLO = 56, IX_STOT = 36, IX_ZMAX = IX_ZMAX_V;
constexpr int IX_CAP = 768;
constexpr int IX_HIST = 0, IX_CAND = 0, IX_BM = 98304;
constexpr int IX_W = LDSCTL_OFF + 1024;
constexpr int IX_ST = LDSCTL_OFF + 1536;
constexpr int IX_SUB = LDSCTL_OFF + 2048, IX_L2 = IX_SUB + 8 * 1024, IX_C2 = IX_L2 + 8 * 512;
static_assert(IX_C2 + 64 <= LDS_BYTES, "idx sub-histogram LDS");
static_assert(IX_BM + 16 * 512 * 4 <= RING_BYTES && 16 * IX_CAP * 8 <= IX_BM && IX_ST + 6 * 64 <= LDS_BYTES, "idx LDS map");
#define MFMA_FENCE1(a) asm volatile("s_nop 15\n\ts_nop 15" : "+v"(a))
__device__ __forceinline__ float relu_(float x, float) { float r; asm("v_max_f32 %0, 0, %1" : "=v"(r) : "v"(x)); return r; }
__device__ __forceinline__ unsigned mono_key(float s) { const unsigned u = __float_as_uint(s + 0.0f); return u ^ ((unsigned)((int)u >> 31) | 0x80000000u); }

template <int MODE, bool LEVEL0, bool LAST, int HALF> __device__ __forceinline__ void idx_vec(const f32x16 (&accs)[2], const f32x4 (&wv)[4][4], LAS unsigned* hist, LAS unsigned long long* cand, LAS unsigned* bm, LAS unsigned* st,
                                                                                    const unsigned (&psh)[8], const unsigned (&ppre)[8], const bool (&pact)[8], int key, int t0, int hi, int lane, int w32, int shn, unsigned fmask, bool allsel) {
#pragma unroll
    for (int rb = 2 * HALF; rb < 2 * HALF + 2; ++rb) {
        const f32x16 acc = accs[rb - 2 * HALF];
        const int qla = 4 * rb + 2 * hi;
        const f32x4 w0 = wv[rb][0], w1 = wv[rb][1], w2 = wv[rb][2], w3 = wv[rb][3];
        float sa = w0.x * relu_(acc[0], 0.f), sa2 = w0.y * relu_(acc[1], 0.f); sa += w0.z * relu_(acc[2], 0.f); sa2 += w0.w * relu_(acc[3], 0.f);
        sa += w1.x * relu_(acc[4], 0.f); sa2 += w1.y * relu_(acc[5], 0.f); sa += w1.z * relu_(acc[6], 0.f); sa2 += w1.w * relu_(acc[7], 0.f);
        float sb = w2.x * relu_(acc[8], 0.f), sb2 = w2.y * relu_(acc[9], 0.f); sb += w2.z * relu_(acc[10], 0.f); sb2 += w2.w * relu_(acc[11], 0.f);
        sb += w3.x * relu_(acc[12], 0.f); sb2 += w3.y * relu_(acc[13], 0.f); sb += w3.z * relu_(acc[14], 0.f); sb2 += w3.w * relu_(acc[15], 0.f);
        sa += sa2; sb += sb2;
        const unsigned ua = mono_key(sa), ub = mono_key(sb);
        const bool va = !LAST || key <= t0 + qla, vb = !LAST || key <= t0 + qla + 1;
        if (MODE == 3) {
            const int fa = (int)(ua >> IX_FSH) - IX_FBASE, fb = (int)(ub >> IX_FSH) - IX_FBASE;
            const unsigned ba = (unsigned)(fa > 2047 ? 2047 : fa), bb = (unsigned)(fb > 2047 ? 2047 : fb);
            if (fa > 0) __hip_atomic_fetch_add(hist + qla * 2048 + ba, 1u, __ATOMIC_RELAXED, __HIP_MEMORY_SCOPE_WORKGROUP);
            if (fb > 0) __hip_atomic_fetch_add(hist + (qla + 1) * 2048 + bb, 1u, __ATOMIC_RELAXED, __HIP_MEMORY_SCOPE_WORKGROUP);
        } else if (MODE == 2) {
            const unsigned pa = ua >> IX_FSH, pb = ub >> IX_FSH;
            const bool sela = va && pa > ppre[2 * rb], selb = vb && pb > ppre[2 * rb + 1];
            const bool ca = va && (ppre[2 * rb] - pa) <= psh[2 * rb], cb = vb && (ppre[2 * rb + 1] - pb) <= psh[2 * rb + 1];
            const unsigned long long bala = __ballot(sela), balb = __ballot(selb);
            if (lane == 0) { bm[(4 * rb + 0) * 512 + w32] = (unsigned)bala; bm[(4 * rb + 2) * 512 + w32] = (unsigned)(bala >> 32);
                             bm[(4 * rb + 1) * 512 + w32] = (unsigned)balb; bm[(4 * rb + 3) * 512 + w32] = (unsigned)(balb >> 32); }
            if (ca) { const unsigned slot = __hip_atomic_fetch_add(st + qla, 1u, __ATOMIC_RELAXED, __HIP_MEMORY_SCOPE_WORKGROUP);
                if (slot < (unsigned)IX_CAP) cand[qla * IX_CAP + slot] = ((unsigned long long)ua << 32) | (unsigned)(0xffff - key); }
            if (cb) { const unsigned slot = __hip_atomic_fetch_add(st + qla + 1, 1u, __ATOMIC_RELAXED, __HIP_MEMORY_SCOPE_WORKGROUP);
                if (slot < (unsigned)IX_CAP) cand[(qla + 1) * IX_CAP + slot] = ((unsigned long long)ub << 32) | (unsigned)(0xffff - key); }
        } else if (MODE == 0) {
            const bool ma = va && (LEVEL0 || (pact[2 * rb] && (ua >> psh[2 * rb]) == ppre[2 * rb]));
            const bool mb = vb && (LEVEL0 || (pact[2 * rb + 1] && (ub >> psh[2 * rb + 1]) == ppre[2 * rb + 1]));
            const unsigned ba = LEVEL0 ? (ua >> 21) : ((ua >> shn) & fmask), bb = LEVEL0 ? (ub >> 21) : ((ub >> shn) & fmask);
            if (ma) __hip_atomic_fetch_add(hist + qla * 2048 + ba, 1u, __ATOMIC_RELAXED, __HIP_MEMORY_SCOPE_WORKGROUP);
            if (mb) __hip_atomic_fetch_add(hist + (qla + 1) * 2048 + bb, 1u, __ATOMIC_RELAXED, __HIP_MEMORY_SCOPE_WORKGROUP);
        } else {
            const unsigned pa = ua >> psh[2 * rb], pb = ub >> psh[2 * rb + 1];
            const bool sela = va && (allsel || pa > ppre[2 * rb]), selb = vb && (allsel || pb > ppre[2 * rb + 1]);
            const bool ca = va && !allsel && pa == ppre[2 * rb], cb = vb && !allsel && pb == ppre[2 * rb + 1];
            const unsigned long long bala = __ballot(sela), balb = __ballot(selb);
            if (lane == 0) { bm[(4 * rb + 0) * 512 + w32] = (unsigned)bala; bm[(4 * rb + 2) * 512 + w32] = (unsigned)(bala >> 32);
                             bm[(4 * rb + 1) * 512 + w32] = (unsigned)balb; bm[(4 * rb + 3) * 512 + w32] = (unsigned)(balb >> 32); }
            if (ca) { const unsigned slot = __hip_atomic_fetch_add(st + qla, 1u, __ATOMIC_RELAXED, __HIP_MEMORY_SCOPE_WORKGROUP);
                if (slot < (unsigned)IX_CAP) cand[qla * IX_CAP + slot] = ((unsigned long long)ua << 32) | (unsigned)(0xffff - key); }
            if (cb) { const unsigned slot = __hip_atomic_fetch_add(st + qla + 1, 1u, __ATOMIC_RELAXED, __HIP_MEMORY_SCOPE_WORKGROUP);
                if (slot < (unsigned)IX_CAP) cand[(qla + 1) * IX_CAP + slot] = ((unsigned long long)ub << 32) | (unsigned)(0xffff - key); }
        }
    }
}
template <int MODE, bool LEVEL0, int STRIDE = 1> __device__ __forceinline__ void idx_pass(Frame& F, const bf16x8_t (&qa)[4][4], const GAS bf16* kib, int t0, int nst, int wave, int lane,
                                                             int shn, unsigned fmask, bool allsel) {
    const int n = lane & 31, hi = lane >> 5;
    LAS unsigned char* L = F.lds + RING_OFF;
    LAS unsigned* hist = (LAS unsigned*)(L + IX_HIST); LAS unsigned long long* cand = (LAS unsigned long long*)(L + IX_CAND); LAS unsigned* bm = (LAS unsigned*)(L + IX_BM);
    const LAS float* wl = (const LAS float*)(F.lds + IX_W); LAS unsigned* st = (LAS unsigned*)(F.lds + IX_ST);
    unsigned psh[8], ppre[8]; bool pact[8];
#pragma unroll
    for (int i = 0; i < 8; ++i) { const int ql = 4 * (i >> 1) + 2 * hi + (i & 1); psh[i] = st[16 + ql]; ppre[i] = st[32 + ql]; pact[i] = (st[80 + ql] != 0u); }
    f32x4 wv[4][4];
#pragma unroll
    for (int rb = 0; rb < 4; ++rb)
#pragma unroll
        for (int j = 0; j < 4; ++j) wv[rb][j] = *(const LAS f32x4*)(wl + (4 * rb + 2 * hi) * 8 + 4 * j);
    bf16x8_t kf[4];
    const GAS bf16* kp = kib + (size_t)(wave * 32 + n) * 64 + hi * 8;
#pragma unroll
    for (int s = 0; s < 4; ++s) kf[s] = *(const GAS bf16x8_t*)(kp + s * 16);
    const int nlim = STRIDE == 1 ? nst : nst - 1;
#pragma unroll 1
    for (int stile = 0; stile < nlim; stile += STRIDE) {
        const int key = stile * 256 + wave * 32 + n;
        const int w32 = stile * 8 + wave;
        const bool lastt = STRIDE == 1 && (stile + 1 == nst);
        const bool more = (stile + STRIDE < nlim);
        f32x16 accs[2];
#pragma unroll
        for (int rb = 0; rb < 2; ++rb) { accs[rb] = (f32x16){0.f, 0.f, 0.f, 0.f, 0.f, 0.f, 0.f, 0.f, 0.f, 0.f, 0.f, 0.f, 0.f, 0.f, 0.f, 0.f};
#pragma unroll
            for (int s = 0; s < 4; ++s) accs[rb] = __builtin_amdgcn_mfma_f32_32x32x16_bf16(qa[rb][s], kf[s], accs[rb], 0, 0, 0); }
        asm volatile("s_nop 15\n\ts_nop 15" : "+v"(accs[0]), "+v"(accs[1]));
        if (!lastt) idx_vec<MODE, LEVEL0, false, 0>(accs, wv, hist, cand, bm, st, psh, ppre, pact, key, t0, hi, lane, w32, shn, fmask, allsel);
        else idx_vec<MODE, LEVEL0, true, 0>(accs, wv, hist, cand, bm, st, psh, ppre, pact, key, t0, hi, lane, w32, shn, fmask, allsel);
#pragma unroll
        for (int rb = 0; rb < 2; ++rb) { accs[rb] = (f32x16){0.f, 0.f, 0.f, 0.f, 0.f, 0.f, 0.f, 0.f, 0.f, 0.f, 0.f, 0.f, 0.f, 0.f, 0.f, 0.f};
#pragma unroll
            for (int s = 0; s < 4; ++s) accs[rb] = __builtin_amdgcn_mfma_f32_32x32x16_bf16(qa[2 + rb][s], kf[s], accs[rb], 0, 0, 0); }
        asm volatile("s_nop 15\n\ts_nop 15" : "+v"(accs[0]), "+v"(accs[1]), "+v"(kf[0]), "+v"(kf[1]), "+v"(kf[2]), "+v"(kf[3]));
        if (more) { kp += (size_t)STRIDE * 256 * 64;
#pragma unroll
            for (int s = 0; s < 4; ++s) kf[s] = *(const GAS bf16x8_t*)(kp + s * 16); }
        if (!lastt) idx_vec<MODE, LEVEL0, false, 1>(accs, wv, hist, cand, bm, st, psh, ppre, pact, key, t0, hi, lane, w32, shn, fmask, allsel);
        else idx_vec<MODE, LEVEL0, true, 1>(accs, wv, hist, cand, bm, st, psh, ppre, pact, key, t0, hi, lane, w32, shn, fmask, allsel);
    }
}

__device__ __forceinline__ bool idx_find_bin(const LAS unsigned* hrow, int D, unsigned above, unsigned S, unsigned kneed, int lane, int& bsel, unsigned& abovebin, unsigned& cbin) {
    const unsigned long long ownm = __ballot(above < kneed && kneed <= S);
    if (ownm == 0ull) return false;
    const int Lo = __ffsll((long long)ownm) - 1;
    const unsigned aL = (unsigned)__shfl((int)above, Lo);
    const unsigned v = (lane < D) ? hrow[Lo * D + lane] : 0u;
    unsigned s = v;
#pragma unroll
    for (int o = 1; o < 32; o <<= 1) { const unsigned t = __shfl_down(s, o); if (lane + o < 64) s += t; }
    const unsigned excl = s - v;
    const unsigned long long hitm = __ballot(lane < D && aL + excl < kneed && kneed <= aL + s);
    const int H = __ffsll((long long)hitm) - 1;
    bsel = Lo * D + H; abovebin = (unsigned)__shfl((int)(aL + excl), H); cbin = (unsigned)__shfl((int)v, H);
    return hitm != 0ull;
}
__device__ __forceinline__ void idx_unit(Frame& F, int b, int t0) {
    int tid_ = F.tid; asm volatile("" : "+v"(tid_));
    const int tid = tid_, lane = tid & 63, wave = F.wave, r32 = lane & 31, hh = lane >> 5;
    LAS unsigned char* L = F.lds + RING_OFF;
    LAS unsigned* hist = (LAS unsigned*)(L + IX_HIST); LAS unsigned long long* cand = (LAS unsigned long long*)(L + IX_CAND); LAS unsigned* bm = (LAS unsigned*)(L + IX_BM);
    LAS float* wl = (LAS float*)(F.lds + IX_W); LAS unsigned* st = (LAS unsigned*)(F.lds + IX_ST);
    const size_t rowb = (size_t)b * SEQ; const int nst = (t0 >> 8) + 1; const bool allsel = (t0 < 256);
    const GAS bf16* kib = (const GAS bf16*)WSB(WS_KI) + rowb * 64;
    __syncthreads();
    if (tid < 128) wl[tid] = ((const GAS float*)WSF(WS_WI) + (rowb + t0) * 8)[tid];
    if (tid < 16) { st[tid] = 0u; st[16 + tid] = 21u; st[32 + tid] = 0u; st[48 + tid] = 256u; st[64 + tid] = 0u; st[80 + tid] = 1u; }
    if (tid == 0) { unsigned zz = 0u; asm volatile("" : "+v"(zz)); st[96] = zz; st[97] = zz; }
    bf16x8_t qa[4][4];
    { const int qloc = 2 * ((r32 >> 2) & 1) + (r32 >> 4), head = (r32 & 3) + 4 * ((r32 >> 3) & 1);
      const GAS bf16* qp = (const GAS bf16*)WSB(WS_QI) + (rowb + t0 + qloc) * 512 + head * 64 + hh * 8;
#pragma unroll
      for (int rb = 0; rb < 4; ++rb)
#pragma unroll
        for (int s = 0; s < 4; ++s) qa[rb][s] = *(const GAS bf16x8_t*)(qp + (size_t)rb * 4 * 512 + s * 16); }
    __syncthreads();
    bool exact = allsel || nst < IX_SMIN;
    if (!exact) {
        { unsigned zz = 0u; asm volatile("" : "+v"(zz)); const v4u z4 = {zz, zz, zz, zz};
          for (int i = tid; i < 16 * 2048 / 4; i += NWAVES * 64) ((LAS v4u*)hist)[i] = z4; }
        __syncthreads();
        idx_pass<3, true, IX_SSTRIDE>(F, qa, kib, t0, nst, wave, lane, 0, 0u, false);
        __syncthreads();
#pragma unroll 1
        for (int qq = 0; qq < 2; ++qq) { const int ql = 2 * wave + qq; const LAS unsigned* hq = hist + ql * 2048 + lane * 32;
            unsigned tot = 0u;
            for (int dd = 0; dd < 32; ++dd) tot += hq[(dd + lane) & 31];
            unsigned S = tot;
#pragma unroll
            for (int o = 1; o < 64; o <<= 1) { const unsigned v = __shfl_down(S, o); if (lane + o < 64) S += v; }
            const unsigned above = S - tot; const unsigned total = (unsigned)__shfl((int)S, 0);
            if (total < (unsigned)IX_STOT) { if (lane == 0) __hip_atomic_fetch_or(st + 96, 1u, __ATOMIC_RELAXED, __HIP_MEMORY_SCOPE_WORKGROUP); continue; }
            const unsigned slo = total < (unsigned)IX_SLO ? total : (unsigned)IX_SLO;
#pragma unroll
            for (int which = 0; which < 2; ++which) { const unsigned kneed = which == 0 ? (unsigned)IX_SHI : slo;
                int bsel = 0; unsigned ab_, cb_;
                if (idx_find_bin(hist + ql * 2048, 32, above, S, kneed, lane, bsel, ab_, cb_) && lane == 0) {
                    if (which == 0) { st[32 + ql] = (unsigned)(IX_FBASE + bsel); if (bsel >= 2047) __hip_atomic_fetch_or(st + 96, 2u, __ATOMIC_RELAXED, __HIP_MEMORY_SCOPE_WORKGROUP); }
                    else { st[64 + ql] = (unsigned)(IX_FBASE + bsel); if (bsel <= 0) __hip_atomic_fetch_or(st + 96, 4u, __ATOMIC_RELAXED, __HIP_MEMORY_SCOPE_WORKGROUP); } } }
            LDS_WAIT(); asm volatile("" ::: "memory");
            if (lane == 0) { const unsigned w = st[32 + ql] - st[64 + ql]; st[16 + ql] = w; if (w > (unsigned)IX_ZMAX) __hip_atomic_fetch_or(st + 96, 8u, __ATOMIC_RELAXED, __HIP_MEMORY_SCOPE_WORKGROUP); }
        }
        __syncthreads();
        exact = (st[96] != 0u);
        const unsigned why = st[96];
        __syncthreads();
        if (!exact) {
            idx_pass<2, false>(F, qa, kib, t0, nst, wave, lane, 0, 0u, false);
            __syncthreads();
#pragma unroll 1
            for (int qq = 0; qq < 2; ++qq) { const int ql = 2 * wave + qq;
                int members = 0;
                for (int w = lane; w < nst * 8; w += 64) members += __popc(bm[ql * 512 + w]);
#pragma unroll
                for (int o = 32; o > 0; o >>= 1) members += __shfl_xor(members, o);
                const int nct = (int)st[ql], need = 256 - members;
                const bool ok = members <= 256 && need <= nct && nct <= IX_CAP;
                if (lane == 0) { if (!ok) __hip_atomic_fetch_or(st + 96, 16u, __ATOMIC_RELAXED, __HIP_MEMORY_SCOPE_WORKGROUP); st[48 + ql] = (unsigned)(need > 0 ? need : 0); }
            }
            __syncthreads();
            exact = (st[96] != 0u);
            __syncthreads();
        }
        if (exact) {
#ifdef IX_SPIN
            if (why & IX_SPIN) { const long long w1 = wall_clock64(); while (wall_clock64() - w1 < 4000) __builtin_amdgcn_s_sleep(4); }
#endif
            if (tid < 16) { st[tid] = 0u; st[16 + tid] = 21u; st[32 + tid] = 0u; st[48 + tid] = 256u; st[64 + tid] = 0u; st[80 + tid] = 1u; }
            __syncthreads();
        }
    }
    const bool zone = !exact;
    if (exact && !allsel) {
#pragma unroll 1
        for (int level = 0; level < 3; ++level) {
            const int shn = level == 0 ? 21 : (level == 1 ? 10 : 0); const unsigned fmask = level == 2 ? 0x3ffu : 0x7ffu; const int nd = level == 2 ? 1024 : 2048;
            for (int i = tid; i < 16 * 2048 / 4; i += NWAVES * 64) ((LAS v4u*)hist)[i] = (v4u){0u, 0u, 0u, 0u};
            __syncthreads();
            { if (level == 0) idx_pass<0, true>(F, qa, kib, t0, nst, wave, lane, shn, fmask, false); else idx_pass<0, false>(F, qa, kib, t0, nst, wave, lane, shn, fmask, false); }
            __syncthreads();
            if (PROBE_SEL & 8) { for (int i = tid; i < 16 * 2048; i += NWAVES * 64) hist[i] = 0u; __syncthreads(); { if (level == 0) idx_pass<0, true>(F, qa, kib, t0, nst, wave, lane, shn, fmask, false); else idx_pass<0, false>(F, qa, kib, t0, nst, wave, lane, shn, fmask, false); } __syncthreads(); }
#pragma unroll 1
            for (int qq = 0; qq < 2; ++qq) { const int ql = 2 * wave + qq;
                if (st[80 + ql] == 0u) continue;
                const unsigned kneed = st[48 + ql]; const int D = nd >> 6; const LAS unsigned* hq = hist + ql * 2048 + lane * D;
                unsigned tot = 0u;
                for (int dd = 0; dd < D; ++dd) tot += hq[(dd + lane) & (D - 1)];
                unsigned S = tot;
#pragma unroll
                for (int o = 1; o < 64; o <<= 1) { const unsigned v = __shfl_down(S, o); if (lane + o < 64) S += v; }
                const unsigned above = S - tot;
                int bsel = 0; unsigned a = 0u, cb = 0u;
                if (idx_find_bin(hist + ql * 2048, D, above, S, kneed, lane, bsel, a, cb) && lane == 0) {
                    const unsigned opre = st[32 + ql];
                    st[32 + ql] = (level == 0) ? (unsigned)bsel : ((opre << (level == 1 ? 11 : 10)) | (unsigned)bsel);
                    st[16 + ql] = (unsigned)shn; st[48 + ql] = kneed - a; st[64 + ql] = cb;
                    st[80 + ql] = (cb > (unsigned)IX_CAP && level < 2) ? 1u : 0u; }
            }
            __syncthreads();
            unsigned more = 0u;
#pragma unroll
            for (int i = 0; i < 16; ++i) more |= st[80 + i];
            __syncthreads();
            if (more == 0u) break;
        }
    }
    if (exact) idx_pass<1, false>(F, qa, kib, t0, nst, wave, lane, 0, 0u, allsel);
    __syncthreads();
    if (!allsel) {
#pragma unroll 1
        for (int qq = 0; qq < 2; ++qq) { const int ql = 2 * wave + qq;
            const int nc = (int)(st[ql] < (unsigned)IX_CAP ? st[ql] : (unsigned)IX_CAP); int need = (int)st[48 + ql]; const int vbits = zone ? 48 : 16 + (int)st[16 + ql];
            if (need <= 0) continue;
            if (need >= nc) {
                for (int k = lane; k < nc; k += 64) { const int key = 0xffff - (int)(cand[ql * IX_CAP + k] & 0xffffull); __hip_atomic_fetch_or(bm + ql * 512 + (key >> 5), 1u << (key & 31), __ATOMIC_RELAXED, __HIP_MEMORY_SCOPE_WORKGROUP); }
                continue; }
            const int shq = (int)st[16 + ql];
            const int zsh = (zone && st[16 + ql] <= 63u) ? 48 : 50;
            const unsigned zb = zone ? ((st[32 + ql] - st[16 + ql]) << (50 - zsh)) : 0u;
            if (zone || shq >= 8) {
                LAS unsigned* sh2 = (LAS unsigned*)(F.lds + IX_SUB + wave * 1024); LAS unsigned long long* l2 = (LAS unsigned long long*)(F.lds + IX_L2 + wave * 512); LAS unsigned* c2p = (LAS unsigned*)(F.lds + IX_C2 + wave * 4);
#pragma unroll
                for (int i = 0; i < 4; ++i) sh2[4 * lane + i] = 0u;
                if (lane == 0) *c2p = 0u;
                LDS_WAIT(); asm volatile("" ::: "memory");
                const int fsh = 32 + shq - 8;
                for (int k = lane; k < nc; k += 64) { const unsigned long long ckk = cand[ql * IX_CAP + k]; const unsigned f = zone ? (((unsigned)(ckk >> zsh) - zb) & 0xffu) : ((unsigned)(ckk >> fsh) & 0xffu); __hip_atomic_fetch_add(sh2 + f, 1u, __ATOMIC_RELAXED, __HIP_MEMORY_SCOPE_WORKGROUP); }
                LDS_WAIT(); asm volatile("" ::: "memory");
                const unsigned c0 = sh2[4 * lane], c1 = sh2[4 * lane + 1], c2 = sh2[4 * lane + 2], c3 = sh2[4 * lane + 3]; const unsigned tot = c0 + c1 + c2 + c3;
                unsigned S = tot;
#pragma unroll
                for (int o = 1; o < 64; o <<= 1) { const unsigned v = __shfl_down(S, o); if (lane + o < 64) S += v; }
                const unsigned above = S - tot; const unsigned needu = (unsigned)need;
                const bool found = above < needu && needu <= S;
                unsigned a = above; unsigned bsel = 0u, cbin = 0u;
                if (a + c3 >= needu) { bsel = 3u; cbin = c3; } else { a += c3; if (a + c2 >= needu) { bsel = 2u; cbin = c2; } else { a += c2; if (a + c1 >= needu) { bsel = 1u; cbin = c1; } else { a += c1; bsel = 0u; cbin = c0; } } }
                const int src = __ffsll((long long)__ballot(found)) - 1;
                const unsigned b2 = (unsigned)__shfl((int)(4u * lane + bsel), src), need2 = (unsigned)__shfl((int)(needu - a), src), cnt2 = (unsigned)__shfl((int)cbin, src);
                if (cnt2 <= 64u) {
                    for (int k = lane; k < nc; k += 64) { const unsigned long long ckk = cand[ql * IX_CAP + k]; const unsigned f = zone ? (((unsigned)(ckk >> zsh) - zb) & 0xffu) : ((unsigned)(ckk >> fsh) & 0xffu);
                        if (f > b2) { const int key = 0xffff - (int)(ckk & 0xffffull); __hip_atomic_fetch_or(bm + ql * 512 + (key >> 5), 1u << (key & 31), __ATOMIC_RELAXED, __HIP_MEMORY_SCOPE_WORKGROUP); }
                        else if (f == b2) { const unsigned slot = __hip_atomic_fetch_add(c2p, 1u, __ATOMIC_RELAXED, __HIP_MEMORY_SCOPE_WORKGROUP); l2[slot] = ckk; } }
                    LDS_WAIT(); asm volatile("" ::: "memory");
                    if (lane < (int)cnt2) { const unsigned long long mine = l2[lane]; unsigned rank = 0u;
                        for (unsigned j = 0; j < cnt2; ++j) rank += (l2[j] > mine) ? 1u : 0u;
                        if (rank < need2) { const int key = 0xffff - (int)(mine & 0xffffull); __hip_atomic_fetch_or(bm + ql * 512 + (key >> 5), 1u << (key & 31), __ATOMIC_RELAXED, __HIP_MEMORY_SCOPE_WORKGROUP); } }
                    LDS_WAIT(); asm volatile("" ::: "memory");
                    continue;
                }
            }
#ifdef IX_SPIN2
            if (zone) { const long long w1 = wall_clock64(); while (wall_clock64() - w1 < IX_SPIN2 * 100) __builtin_amdgcn_s_sleep(4); }
#endif
            unsigned long long ck[12]; unsigned alive = 0u, selm = 0u;
#pragma unroll
            for (int c = 0; c < 12; ++c) { const int k = c * 64 + lane; ck[c] = (k < nc) ? cand[ql * IX_CAP + k] : 0ull; if (k < nc) alive |= 1u << c; }
#pragma unroll 1
            for (int bit = vbits - 1 + 16; bit >= 0; --bit) {
                if (bit >= 16 && bit < 32) continue;
                unsigned ones = 0u; int cnt1 = 0;
#pragma unroll
                for (int c = 0; c < 12; ++c) { if (c * 64 < nc) { const bool o = ((alive >> c) & 1u) && ((ck[c] >> bit) & 1ull); cnt1 += __popcll(__ballot(o)); if (o) ones |= 1u << c; } }
                if (cnt1 >= need) alive &= ones;
                else { selm |= ones; alive &= ~ones; need -= cnt1; }
            }
            selm |= alive;
#pragma unroll
            for (int c = 0; c < 12; ++c) if ((selm >> c) & 1u) { const int key = 0xffff - (int)(ck[c] & 0xffffull); __hip_atomic_fetch_or(bm + ql * 512 + (key >> 5), 1u << (key & 31), __ATOMIC_RELAXED, __HIP_MEMORY_SCOPE_WORKGROUP); }
        }
    }
    __syncthreads();
    { GAS unsigned* mg = (GAS unsigned*)(F.ws + WS_MASK) + (rowb + t0) * 512; const int nw = nst * 8;
      for (int i = tid; i < 16 * nw; i += NWAVES * 64) { const int ql = i / nw, w = i - ql * nw; mg[(size_t)ql * 512 + w] = bm[ql * 512 + w]; } }
}
typedef __bf16 bf2_t __attribute__((ext_vector_type(2)));
constexpr size_t WS_KM2 = 110 * MiB;
constexpr size_t WS_MREF = 111 * MiB;
constexpr size_t WS_LACC = 38 * MiB;
constexpr size_t WS_PO = 464 * MiB;
constexpr size_t WS_PJ0 = WS_QI, WS_PJ1 = WS_XB, WS_PJ2 = WS_XB + 32 * MiB;
__device__ __forceinline__ unsigned char* pj_base(Frame& F, int l, int j) {
    if (j == 0) return F.ws + WS_PJ0;
    return (unsigned char*)F.out + (size_t)(j - 1) * (32 * MiB);
}
constexpr size_t WS_LJ = WS_KI;
constexpr size_t WS_LISTS = 496 * MiB;
constexpr int CW_LCNT = 16384;
static_assert((CW_LCNT + 2 * 1024) * 4 <= (int)CTL_ZERO_BYTES, "list counters inside the memset region");
__device__ __forceinline__ int list_off(int n) { return 256 * (63 * n - (n * (n - 1)) / 2); }
constexpr int IT_K = 0, IT_V = 4 * AT_KBUF, IT_BT = IT_V + 4 * AT_VBUF, IT_QP = IT_BT + 512, IT_OST = 73728;
static_assert(IT_QP + 8 * 128 <= IT_OST && IT_OST + 8 * 4096 <= RING_BYTES, "item LDS map");

template <bool DRY = false> __device__ __forceinline__ void moba_own_unit(Frame& F, int l, int b, int h, int qt) {
    int tid_ = F.tid; asm volatile("" : "+v"(tid_));
    const int tid = tid_, lane = tid & 63, wave = F.wave, r32 = lane & 31, hi = lane >> 5;
    LAS unsigned char* L = F.lds + RING_OFF;
    LAS float* bt = (LAS float*)(L + AT_BT);
    const GAS bf16* Qg = (const GAS bf16*)WSB(WS_QA);
    const size_t rowb = (size_t)b * SEQ;
    const GAS bf16* Kh = (const GAS bf16*)WSB(WS_KA) + rowb * 512 + h * 64; const GAS bf16* Vh = (const GAS bf16*)WSB(WS_VA) + rowb * 512 + h * 64;
    const int q0w = qt * 256 + wave * 32, q = q0w + r32;
    __syncthreads();
    if (tid < 128) { const GAS float* rb = (const GAS float*)INP(I_RELB) + h; bt[tid] = (rb[t5_bucket(tid) * 16] - rb[31 * 16]) * LOG2E; }
    bf16x8_t qf[4];
    { const GAS bf16* qp = Qg + (rowb + q) * 512 + h * 64 + hi * 8;
#pragma unroll
      for (int s = 0; s < 4; ++s) qf[s] = *(const GAS bf16x8_t*)(qp + s * 16); }
    { const int n = tid >> 3, c8 = (tid & 7) * 8; const GAS float* km = (const GAS float*)WSF(WS_KM2) + (((size_t)b * NBLK + n) * 2) * 512 + h * 64 + c8;
      f32x4 a = *(const GAS f32x4*)km + *(const GAS f32x4*)(km + 512), c = *(const GAS f32x4*)(km + 4) + *(const GAS f32x4*)(km + 516);
      a = a * (1.0f / 256.0f); c = c * (1.0f / 256.0f);
      const unsigned h0 = pk2(a.x, a.y), h1 = pk2(a.z, a.w), h2 = pk2(c.x, c.y), h3 = pk2(c.z, c.w);
      const unsigned l0 = pk2(a.x - __uint_as_float(h0 << 16), a.y - __uint_as_float(h0 & 0xffff0000u)), l1 = pk2(a.z - __uint_as_float(h1 << 16), a.w - __uint_as_float(h1 & 0xffff0000u)),
                     l2 = pk2(c.x - __uint_as_float(h2 << 16), c.y - __uint_as_float(h2 & 0xffff0000u)), l3 = pk2(c.z - __uint_as_float(h3 << 16), c.w - __uint_as_float(h3 & 0xffff0000u));
      *(LAS v4u*)(L + AT_K0 + n * AT_KROW + (tid & 7) * 16) = (v4u){h0, h1, h2, h3}; *(LAS v4u*)(L + AT_K0 + AT_KBUF + n * AT_KROW + (tid & 7) * 16) = (v4u){l0, l1, l2, l3}; }
    __syncthreads();
    unsigned mlo = 0u, mhi = 0u;
    if (qt > 0) {
        f32x16 g0 = {0.f, 0.f, 0.f, 0.f, 0.f, 0.f, 0.f, 0.f, 0.f, 0.f, 0.f, 0.f, 0.f, 0.f, 0.f, 0.f}, g1 = g0;
        at_qk(g0, g1, L + AT_K0, qf, r32, hi); at_qk(g0, g1, L + AT_K0 + AT_KBUF, qf, r32, hi);
        MFMA_FENCE2(g0, g1);
#pragma unroll
        for (int r = 0; r < 16; ++r) { if (crow_(r, hi) >= qt) g0[r] = -INFINITY; if (32 + crow_(r, hi) >= qt) g1[r] = -INFINITY; }
#pragma unroll
        for (int it = 0; it < 3; ++it) {
            float bv = -INFINITY; int bn = 64;
#pragma unroll
            for (int r = 0; r < 16; ++r) if (g0[r] > bv) { bv = g0[r]; bn = crow_(r, hi); }
#pragma unroll
            for (int r = 0; r < 16; ++r) if (g1[r] > bv) { bv = g1[r]; bn = 32 + crow_(r, hi); }
            const float pv = __shfl_xor(bv, 32); const int pn = __shfl_xor(bn, 32);
            const bool tp = (pv > bv) || (pv == bv && pn < bn);
            const float wv = tp ? pv : bv; const int wn = tp ? pn : bn;
            if (wv > -INFINITY) { if (wn < 32) mlo |= 1u << wn; else mhi |= 1u << (wn - 32);
                if (hi == 0 && !DRY) { GAS unsigned* cnt = (GAS unsigned*)(F.ws + WS_CTL) + CW_LCNT + ((l * 2 + b) * 8 + h) * 64 + wn;
                    const unsigned slot = __hip_atomic_fetch_add(cnt, 1u, __ATOMIC_RELAXED, __HIP_MEMORY_SCOPE_AGENT);
                    ((GAS unsigned short*)(F.ws + WS_LISTS) + ((size_t)(b * 8 + h) << 19))[list_off(wn) + slot] = (unsigned short)(q | (it << 14)); } }
#pragma unroll
            for (int r = 0; r < 16; ++r) { if (crow_(r, hi) == wn) g0[r] = -INFINITY; if (32 + crow_(r, hi) == wn) g1[r] = -INFINITY; }
        }
    }
    __syncthreads();
    v4u kr, vr;
    at_load(Kh, Vh, 4 * qt, tid, kr, vr);
    at_store(L + AT_K0, L + AT_V0, tid, kr, vr);
    __syncthreads();
    float m = -1e30f, lsum = 0.f;
    f32x16 o0 = {0.f, 0.f, 0.f, 0.f, 0.f, 0.f, 0.f, 0.f, 0.f, 0.f, 0.f, 0.f, 0.f, 0.f, 0.f, 0.f}, o1 = o0;
#pragma unroll 1
    for (int tt = 0; tt < 4; ++tt) {
        const int t = 4 * qt + tt, cur = tt & 1;
        if (tt + 1 < 4) at_load(Kh, Vh, t + 1, tid, kr, vr);
        const int nall = q - t * 64 + 1;
        const unsigned wlo = nall >= 32 ? 0xffffffffu : (nall <= 0 ? 0u : ((1u << nall) - 1u)), whi = nall >= 64 ? 0xffffffffu : (nall <= 32 ? 0u : ((1u << (nall - 32)) - 1u));
        if (__any((wlo | whi) != 0u)) {
            const LAS unsigned char* kb = L + AT_K0 + cur * AT_KBUF; const LAS unsigned char* vb = L + AT_V0 + cur * AT_VBUF;
            f32x16 p0 = {0.f, 0.f, 0.f, 0.f, 0.f, 0.f, 0.f, 0.f, 0.f, 0.f, 0.f, 0.f, 0.f, 0.f, 0.f, 0.f}, p1 = p0;
            at_qk(p0, p1, kb, qf, r32, hi);
            MFMA_FENCE2(p0, p1);
#pragma unroll
            for (int r = 0; r < 16; ++r) { const int d0 = q - (t * 64 + crow_(r, hi)), d1 = d0 - 32;
                const float b0 = ((unsigned)d0 < 128u) ? bt[d0] : 0.f, b1 = ((unsigned)d1 < 128u) ? bt[d1] : 0.f;
                p0[r] = p0[r] * AT_C2 + b0; p1[r] = p1[r] * AT_C2 + b1; }
            float mx;
            { float ma = max3_(p0[0], p1[0], p0[1]), mb = max3_(p1[1], p0[2], p1[2]), mc = max3_(p0[3], p1[3], p0[4]), md = max3_(p1[4], p0[5], p1[5]);
              ma = max3_(ma, p0[6], p1[6]); mb = max3_(mb, p0[7], p1[7]); mc = max3_(mc, p0[8], p1[8]); md = max3_(md, p0[9], p1[9]);
              ma = max3_(ma, p0[10], p1[10]); mb = max3_(mb, p0[11], p1[11]); mc = max3_(mc, p0[12], p1[12]); md = max3_(md, p0[13], p1[13]);
              ma = max3_(ma, p0[14], p1[14]); mb = max3_(mb, p0[15], p1[15]); mx = max3_(ma, mb, mc); mx = max3_(mx, md, md); }
            mx = max3_(mx, __shfl_xor(mx, 32), mx);
            if (__any(mx > m + AT_THR)) {
                const float mn = fmaxf(m, mx); const float al = __builtin_amdgcn_exp2f(m - mn);
                MFMA_FENCE2(o0, o1);
#pragma unroll
                for (int r = 0; r < 16; ++r) { o0[r] *= al; o1[r] *= al; }
                lsum *= al; m = mn;
            }
            const unsigned wl = wlo >> (4 * hi), wh = whi >> (4 * hi);
            float lq[4] = {0.f, 0.f, 0.f, 0.f};
#pragma unroll
            for (int r = 0; r < 16; ++r) { const int cb = (r & 3) + 8 * (r >> 2);
                const float e0 = __uint_as_float(and_sel(__builtin_amdgcn_exp2f(p0[r] - m), wl, cb)), e1 = __uint_as_float(and_sel(__builtin_amdgcn_exp2f(p1[r] - m), wh, cb));
                p0[r] = e0; p1[r] = e1; lq[r & 1] += e0; lq[2 + (r & 1)] += e1; }
            lsum += (lq[0] + lq[1]) + (lq[2] + lq[3]);
            bf16x8_t pb[4];
#pragma unroll
            for (int sg = 0; sg < 4; ++sg) { union { bf16x8_t v; unsigned u[4]; } pk;
#pragma unroll
                for (int j = 0; j < 4; ++j) { const int r = 8 * (sg & 1) + 2 * j; pk.u[j] = (sg < 2) ? pg8::cvt_pk_bf16(p0[r], p0[r + 1]) : pg8::cvt_pk_bf16(p1[r], p1[r + 1]); }
                pb[sg] = pk.v; }
            at_pv(o0, o1, vb, pb, r32, hi);
        }
        if (tt + 1 < 4) at_store(L + AT_K0 + (cur ^ 1) * AT_KBUF, L + AT_V0 + (cur ^ 1) * AT_VBUF, tid, kr, vr);
        __syncthreads();
    }
    MFMA_FENCE2(o0, o1);
    lsum += __shfl_xor(lsum, 32);
    if (hi == 0 && !DRY) { ((GAS float*)WSF(WS_MREF))[(rowb + q) * 8 + h] = m; ((GAS float*)WSF(WS_LACC))[(rowb + q) * 8 + h] = lsum; }
    LAS bf16* ost = (LAS bf16*)(L + AT_OST + wave * 4096);
#pragma unroll
    for (int r = 0; r < 16; ++r) { ost[r32 * 64 + crow_(r, hi)] = (bf16)f2bf(o0[r]); ost[r32 * 64 + 32 + crow_(r, hi)] = (bf16)f2bf(o1[r]); }
    LDS_WAIT(); asm volatile("" ::: "memory");
    GAS bf16* Og = (GAS bf16*)WSB(WS_PO) + (rowb + q0w) * 512 + h * 64;
#pragma unroll
    for (int i = 0; i < 4; ++i) { const int c = i * 64 + lane, row = c >> 3, ch = c & 7; const v4u ov = *(const LAS v4u*)(ost + row * 64 + ch * 8); if (!DRY || (ov.x == 0x12345678u && ov.y == 0x9abcdef0u)) *(GAS v4u*)(Og + (size_t)row * 512 + ch * 8) = ov; }
}

template <bool DRY = false> __device__ __forceinline__ void moba_item_unit(Frame& F, int l, int b, int h, int n) {
    int tid_ = F.tid; asm volatile("" : "+v"(tid_));
    const int tid = tid_, lane = tid & 63, wave = F.wave, r32 = lane & 31, hi = lane >> 5;
    LAS unsigned char* L = F.lds + RING_OFF;
    LAS float* bt = (LAS float*)(L + IT_BT);
    const size_t rowb = (size_t)b * SEQ;
    const int cnt = (int)((const GAS unsigned*)(F.ws + WS_CTL))[CW_LCNT + ((l * 2 + b) * 8 + h) * 64 + n];
    if (cnt == 0) return;
    const GAS bf16* Kh = (const GAS bf16*)WSB(WS_KA) + rowb * 512 + h * 64; const GAS bf16* Vh = (const GAS bf16*)WSB(WS_VA) + rowb * 512 + h * 64;
    __syncthreads();
    if (tid < 128) { const GAS float* rb = (const GAS float*)INP(I_RELB) + h; bt[tid] = (rb[t5_bucket(tid) * 16] - rb[31 * 16]) * LOG2E; }
#pragma unroll
    for (int t = 0; t < 4; ++t) { v4u kr, vr; at_load(Kh, Vh, 4 * n + t, tid, kr, vr); at_store(L + IT_K + t * AT_KBUF, L + IT_V + t * AT_VBUF, tid, kr, vr); }
    __syncthreads();
    const GAS unsigned short* lst = (const GAS unsigned short*)(F.ws + WS_LISTS) + ((size_t)(b * 8 + h) << 19) + list_off(n);
    LAS int* qpl = (LAS int*)(L + IT_QP + wave * 128);
    LAS float* ostf = (LAS float*)(L + IT_OST + wave * 4096);
    const int ngrp = (cnt + 31) >> 5;
#pragma unroll 1
    for (int g = wave; g < ngrp; g += NWAVES) {
        const int li = g * 32 + r32; const bool valid = li < cnt;
        const int ent = valid ? (int)lst[li] : (int)lst[g * 32];
        const int q = ent & 0x3fff;
        if (hi == 0) qpl[r32] = valid ? ent : -1;
        bf16x8_t qf[4];
        { const GAS bf16* qp = (const GAS bf16*)WSB(WS_QA) + (rowb + q) * 512 + h * 64 + hi * 8;
#pragma unroll
          for (int s = 0; s < 4; ++s) qf[s] = *(const GAS bf16x8_t*)(qp + s * 16); }
        const float mref = ((const GAS float*)WSF(WS_MREF))[(rowb + q) * 8 + h];
        const bool near = __any(q < 256 * (n + 1) + 128);
        float lsum = 0.f;
        f32x16 o0 = {0.f, 0.f, 0.f, 0.f, 0.f, 0.f, 0.f, 0.f, 0.f, 0.f, 0.f, 0.f, 0.f, 0.f, 0.f, 0.f}, o1 = o0;
#pragma unroll 1
        for (int t = 0; t < 4; ++t) {
            const LAS unsigned char* kb = L + IT_K + t * AT_KBUF; const LAS unsigned char* vb = L + IT_V + t * AT_VBUF;
            f32x16 p0 = {0.f, 0.f, 0.f, 0.f, 0.f, 0.f, 0.f, 0.f, 0.f, 0.f, 0.f, 0.f, 0.f, 0.f, 0.f, 0.f}, p1 = p0;
            at_qk(p0, p1, kb, qf, r32, hi);
            MFMA_FENCE2(p0, p1);
            float lq[4] = {0.f, 0.f, 0.f, 0.f};
            if (near) {
#pragma unroll
                for (int r = 0; r < 16; ++r) { const int d0 = q - ((4 * n + t) * 64 + crow_(r, hi)), d1 = d0 - 32;
                    const float b0 = ((unsigned)d0 < 128u) ? bt[d0] : 0.f, b1 = ((unsigned)d1 < 128u) ? bt[d1] : 0.f;
                    const float e0 = __builtin_amdgcn_exp2f(fminf(__builtin_fmaf(p0[r], AT_C2, -mref) + b0, 60.f)), e1 = __builtin_amdgcn_exp2f(fminf(__builtin_fmaf(p1[r], AT_C2, -mref) + b1, 60.f));
                    p0[r] = e0; p1[r] = e1; lq[r & 1] += e0; lq[2 + (r & 1)] += e1; }
            } else {
#pragma unroll
                for (int r = 0; r < 16; ++r) { const float e0 = __builtin_amdgcn_exp2f(fminf(__builtin_fmaf(p0[r], AT_C2, -mref), 60.f)), e1 = __builtin_amdgcn_exp2f(fminf(__builtin_fmaf(p1[r], AT_C2, -mref), 60.f));
                    p0[r] = e0; p1[r] = e1; lq[r & 1] += e0; lq[2 + (r & 1)] += e1; }
            }
            lsum += (lq[0] + lq[1]) + (lq[2] + lq[3]);
            bf16x8_t pb[4];
#pragma unroll
            for (int sg = 0; sg < 4; ++sg) { union { bf16x8_t v; unsigned u[4]; } pk;
#pragma unroll
                for (int j = 0; j < 4; ++j) { const int r = 8 * (sg & 1) + 2 * j; pk.u[j] = (sg < 2) ? pg8::cvt_pk_bf16(p0[r], p0[r + 1]) : pg8::cvt_pk_bf16(p1[r], p1[r + 1]); }
                pb[sg] = pk.v; }
            at_pv(o0, o1, vb, pb, r32, hi);
        }
        MFMA_FENCE2(o0, o1);
        lsum += __shfl_xor(lsum, 32);
        if (hi == 0 && valid && !DRY) ((GAS float*)WSF(WS_LJ))[((size_t)(ent >> 14) * T + rowb + q) * 8 + h] = lsum;
        LAS bf16* ost = (LAS bf16*)ostf;
#pragma unroll
        for (int r = 0; r < 16; ++r) { ost[r32 * 64 + crow_(r, hi)] = (bf16)f2bf(o0[r]); ost[r32 * 64 + 32 + crow_(r, hi)] = (bf16)f2bf(o1[r]); }
        LDS_WAIT(); asm volatile("" ::: "memory");
#pragma unroll
        for (int i = 0; i < 4; ++i) { const int c = i * 64 + lane, row = c >> 3, ch = c & 7; const int er = qpl[row];
            if (er >= 0 && !DRY) { const int j = er >> 14; GAS bf16* pj = (GAS bf16*)pj_base(F, l, j);
                *(GAS v4u*)(pj + (rowb + (er & 0x3fff)) * 512 + h * 64 + ch * 8) = *(const LAS v4u*)(ost + row * 64 + ch * 8); } }
        LDS_WAIT(); asm volatile("" ::: "memory");
    }
}
__device__ __forceinline__ void moba_fin_row(Frame& F, int layer, int m, int lane) {
    const int nsel = ((m & (SEQ - 1)) >> 8) < 3 ? ((m & (SEQ - 1)) >> 8) : 3;
    const int hd = lane >> 3;
    float l = ((const GAS float*)WSF(WS_LACC))[(size_t)m * 8 + hd];
    v4u v = ((const GAS v4u*)((const GAS bf16*)WSB(WS_PO) + (size_t)m * 512))[lane];
    float acc[8] = { __uint_as_float(v.x << 16), __uint_as_float(v.x & 0xffff0000u), __uint_as_float(v.y << 16), __uint_as_float(v.y & 0xffff0000u),
                     __uint_as_float(v.z << 16), __uint_as_float(v.z & 0xffff0000u), __uint_as_float(v.w << 16), __uint_as_float(v.w & 0xffff0000u) };
#pragma unroll
    for (int j = 0; j < 3; ++j) if (j < nsel) {
        l += ((const GAS float*)WSF(WS_LJ))[((size_t)j * T + m) * 8 + hd];
        const v4u w = ((const GAS v4u*)((const GAS bf16*)pj_base(F, layer, j) + (size_t)m * 512))[lane];
        acc[0] += __uint_as_float(w.x << 16); acc[1] += __uint_as_float(w.x & 0xffff0000u); acc[2] += __uint_as_float(w.y << 16); acc[3] += __uint_as_float(w.y & 0xffff0000u);
        acc[4] += __uint_as_float(w.z << 16); acc[5] += __uint_as_float(w.z & 0xffff0000u); acc[6] += __uint_as_float(w.w << 16); acc[7] += __uint_as_float(w.w & 0xffff0000u); }
    const float inv = 1.0f / l;
    v4u o; o.x = pk2(acc[0] * inv, acc[1] * inv); o.y = pk2(acc[2] * inv, acc[3] * inv); o.z = pk2(acc[4] * inv, acc[5] * inv); o.w = pk2(acc[6] * inv, acc[7] * inv);
    ((GAS v4u*)((GAS bf16*)WSB(WS_QA) + (size_t)m * 512))[lane] = o;
}
__global__ void __launch_bounds__(NWAVES * 64, 2) fwd(Args args) {
    extern __shared__ __attribute__((aligned(16))) unsigned char lds[];
    Frame F;
    F.lds = (LAS unsigned char*)lds;
        F.tid = threadIdx.x; F.lane = F.tid & 63; F.wave = __builtin_amdgcn_readfirstlane(F.tid >> 6);
    F.G = gridDim.x; F.bid = blockIdx.x;
    F.a = (const __attribute__((address_space(4))) Args*)__builtin_amdgcn_kernarg_segment_ptr(); F.ws = args.ws; F.out = args.out;
    unsigned char* ws = args.ws;
    for (int u = F.tid; u < (LDS_BYTES - LDSCTL_OFF) / 4; u += NWAVES * 64) ((LAS unsigned*)(F.lds + LDSCTL_OFF))[u] = 0u;
    __syncthreads();
    {
        volatile LAS unsigned* pw = (volatile LAS unsigned*)(F.lds + MISC_OFF) + 64;
        const unsigned hw = __builtin_amdgcn_s_getreg((4 << 0) | (4 << 6) | (1 << 11));
        if (F.lane == 0) pw[F.wave] = hw & 3u;
        __syncthreads();
        const unsigned my = pw[F.wave]; unsigned cnts = 0, rank = 0;
#pragma unroll
        for (int w = 0; w < NWAVES; ++w) { const unsigned s = pw[w]; cnts += 1u << (8 * s); if (w < F.wave && s == my) ++rank; }
#ifdef BAD_ROLES
        F.gw = __builtin_amdgcn_readfirstlane((cnts == 0x02020202u) ? (int)((my >> 1) * 4 + (my & 1) * 2 + rank) : F.wave);
#else
        F.gw = __builtin_amdgcn_readfirstlane((cnts == 0x02020202u) ? (int)(rank * 4 + my) : F.wave);
#endif
        __syncthreads();
    }
    XcdBarrier bar; bar.bar = (unsigned*)(ws + WS_CTL) + CW_BAR; bar.x = 0; bar.st = nullptr;
    if (ONE_LAUNCH) bar = xcd_barrier_post((unsigned*)(ws + WS_CTL) + CW_BAR, (volatile LAS unsigned*)(F.lds + MISC_OFF) + 8);
#define GRID_BAR() do { if (ONE_LAUNCH) xcd_barrier(bar); } while (0)
    const int lo = args.ph_lo, hi = args.ph_hi;
#ifndef PH_MASK
#define PH_MASK 0xfff
#endif
#define IN(k) (((PH_MASK >> ((k) % PH_PER_LAYER == 0 && (k) == 2 * PH_PER_LAYER ? 11 : (k) % PH_PER_LAYER)) & 1) && lo <= (k) && (k) < hi)
#define BOTH(k) (IN(k) && IN((k) + 1))
#define GEMM_TID ((F.gw << 6) | F.lane)
#define DYN_CTR(k) ((unsigned*)(F.ws + WS_CTL) + CW_DYN + 32 * (k))
#define DYN_FETCH(dst, k) do { __syncthreads(); if (F.tid == 0) *((volatile LAS unsigned*)(F.lds + MISC_OFF) + 32) = atomicAdd(DYN_CTR(k), 1u); __syncthreads(); \
        dst = (int)__builtin_amdgcn_readfirstlane(*((volatile LAS unsigned*)(F.lds + MISC_OFF) + 32)); } while (0)
#define LAUNDER() do { asm volatile("" : "+v"(F.tid)); F.lane = F.tid & 63; F.wave = __builtin_amdgcn_readfirstlane(F.tid >> 6); F.ws = launder_u(F.ws); F.out = launder_u(F.out); F.a = launder_u(F.a); F.bid = launder_i(F.bid); F.G = launder_i(F.G); F.gw = launder_i(F.gw); } while (0)
    LAS unsigned char* ring = F.lds + RING_OFF;
    for (int l = 0; l < 2; ++l) {
        const int P = l * PH_PER_LAYER;
#ifdef DBG_DUMP
        if (lo == DBG_PHASE && l == 0) { for (int u = F.bid; u < T; u += F.G) { F.out[(size_t)u * DM + F.tid] = bf2f(WSB(DBG_DUMP)[(size_t)u * DBG_PITCH + F.tid]); F.out[(size_t)u * DM + 512 + F.tid] = 0.f; } }
        if (lo >= DBG_PHASE && lo < 2 * PH_PER_LAYER) continue;
#endif
        if (IN(P + 0)) { LAUNDER(); p_prologue(F, l); if (PROBE_SEL & 128) { VM_WAIT(); __syncthreads(); p_prologue(F, l); } if (BOTH(P + 0)) GRID_BAR(); }
        if (IN(P + 1)) { LAUNDER();
            pg8::Gemm g{WSB(WS_XB), WSB(WS_W_IN), T, NIN_T, DM}; pg8::StaticOrder S; S.init(T, NIN_T, F.G, F.bid);
            pg8::EpiInproj E{WSB(WS_QA), WSB(WS_KI), WSF(WS_WI), SSQ_MIX(l), WSF(WS_KM2)};
            pg8::gemm_phase<pg8::EpiInproj, pg8::StaticOrder, true, PG8_SP2>(ring, g, S, E, GEMM_TID);
            if (PROBE_SEL & 32) { VM_WAIT(); __syncthreads(); LAUNDER(); pg8::gemm_phase<pg8::EpiInproj, pg8::StaticOrder, true, PG8_SP2>(ring, g, S, E, GEMM_TID); }
            if (BOTH(P + 1)) GRID_BAR();
        }
        if (IN(P + 2)) { LAUNDER();
#ifndef FAST_DSA
#define FAST_DSA 1
#endif
            if ((PROBE_SEL & 1024) && F.bid < 256) { for (int r = 0; r < 4; ++r) { const int i = r * 256 + F.bid; moba_own_unit<true>(F, l, (i & 15) >> 3, i & 7, i >> 4); } __syncthreads(); }
            if (FAST_MOBA == 2 && F.bid < 256) { for (int r = 0; r < 4; ++r) { const int i = r * 256 + F.bid; moba_own_unit<false>(F, l, (i & 15) >> 3, i & 7, i >> 4); } __syncthreads(); }
            for (int rep = 0; rep < ((PROBE_SEL & 64) ? 2 : 1); ++rep)
            for (int u = F.bid; u < 2 * RGC; u += F.G) rg_unit<false>(F, l, u / RGC, u % RGC);
            if (FAST_DSA) {
                for (;;) { int i; DYN_FETCH(i, 2 * l); if (i >= 2048) break; const int stt = 63 - (i >> 5), j = i & 31; idx_unit(F, j >> 4, stt * 256 + (j & 15) * 16); }
                __syncthreads();
            }
            if (BOTH(P + 2)) GRID_BAR();
        }
        if (IN(P + 3)) { LAUNDER();
            #ifndef MIX2_SEL
#define MIX2_SEL 7
#endif
            if (MIX2_SEL & 1) for (int u = F.bid; u < 2 * RGC; u += F.G) rg_unit<true>(F, l, u / RGC, u % RGC);
            if (FAST_MOBA == 2 && F.bid < 256) {
                if (PROBE_SEL & 2048) for (int r = 0; r < 4; ++r) { const int g = F.bid; const int i = r * 256 + ((r & 1) ? 255 - g : g); moba_item_unit<true>(F, l, (i & 15) >> 3, i & 7, i >> 4); }
                for (int r = 0; r < 4; ++r) { const int g = F.bid; const int i = r * 256 + ((r & 1) ? 255 - g : g); moba_item_unit<false>(F, l, (i & 15) >> 3, i & 7, i >> 4); }
                __syncthreads();
            }
            if (FAST_MOBA == 1 && (MIX2_SEL & 2)) {
                if (PROBE_SEL & 1) { for (int r = 0; r < 4; ++r) { const int g = F.bid % 256; const int i = r * 256 + ((r & 1) ? 255 - g : g); if (F.bid >= 256) break;
                    const int qt = 63 - (i >> 4), bh = i & 15; attn_unit<0, true>(F, bh >> 3, bh & 7, qt); } }
                for (int r = 0; r < 4; ++r) { const int g = F.bid % 256; const int i = r * 256 + ((r & 1) ? 255 - g : g); if (F.bid >= 256) break;
                    const int qt = 63 - (i >> 4), bh = i & 15; attn_unit<0>(F, bh >> 3, bh & 7, qt); }
                __syncthreads();
            }
            if (FAST_DSA && (MIX2_SEL & 4)) {
                if (PROBE_SEL & 2) { for (int r = 0; r < 4; ++r) { const int g = F.bid % 256; const int i = r * 256 + ((r & 1) ? 255 - g : g); if (F.bid >= 256) break;
                    const int qt = 63 - (i >> 4), bh = i & 15; dsa_attn2_unit<true>(F, bh >> 3, bh & 7, qt); } }
                for (;;) { int i; DYN_FETCH(i, 2 * l + 1); if (i >= 1024) break;
                    const int qt = 63 - (i >> 4), bh = i & 15; dsa_attn2_unit<false>(F, bh >> 3, bh & 7, qt); }
                __syncthreads();
            }
            if (!(FAST_MOBA && FAST_DSA)) for (int u = F.bid; u < T; u += F.G) { const int b = u & 1, t = u >> 1; if (FAST_MOBA == 0 && (MIX2_SEL & 2)) moba_unit(F, b, t); if (!FAST_DSA && (MIX2_SEL & 4)) dsa_unit(F, b, t); }
            for (int u = F.bid; u < T; u += F.G) { if (!(MIX2_SEL & 2)) WSB(WS_QA)[(size_t)u * 512 + F.tid] = 0; if (!(MIX2_SEL & 4)) WSB(WS_QB)[(size_t)u * 512 + F.tid] = 0; if (!(MIX2_SEL & 1)) WSB(WS_YC)[(size_t)u * 512 + F.tid] = 0; }
            if (BOTH(P + 3)) GRID_BAR();
        }

        if (IN(P + 4)) { LAUNDER();
            if (FAST_MOBA == 2) { const int gw = F.bid * NWAVES + F.wave, NGW = F.G * NWAVES;
                for (int m = gw; m < T; m += NGW) moba_fin_row(F, l, m, F.lane); }
            if (BOTH(P + 4)) GRID_BAR();
        }
        if (IN(P + 5)) { LAUNDER();
            pg8::Gemm g{WSB(WS_XB), WSB(WS_W_G), T, 3072, DM}; pg8::StaticOrder S; S.init(T, 3072, F.G, F.bid);
            pg8::EpiGates E{WSB(WS_G), SSQ_MIX(l)};
            pg8::gemm_phase<pg8::EpiGates, pg8::StaticOrder, true, PG8_SP2>(ring, g, S, E, GEMM_TID);
            if (PROBE_SEL & 32) { VM_WAIT(); __syncthreads(); LAUNDER(); pg8::gemm_phase<pg8::EpiGates, pg8::StaticOrder, true, PG8_SP2>(ring, g, S, E, GEMM_TID); }
            if (BOTH(P + 5)) GRID_BAR();
        }
        if (IN(P + 6)) { LAUNDER();
            pg8::StaticOrder S; S.init(T, DM, F.G, F.bid);
            { pg8::Gemm g{WSB(WS_QA), WSB(WS_W_PA), T, DM, DH}; pg8::EpiMerge<true> E{WSB(WS_G), WSB(WS_MERGED)}; pg8::gemm_phase<pg8::EpiMerge<true>, pg8::StaticOrder, true, PG8_SP2>(ring, g, S, E, GEMM_TID); }
#ifndef MERGE_CALLS
#define MERGE_CALLS 3
#endif
            VM_WAIT(); __syncthreads(); LAUNDER();
            if (MERGE_CALLS >= 2) { pg8::Gemm g{WSB(WS_QB), WSB(WS_W_PB), T, DM, DH}; pg8::EpiMerge<false> E{WSB(WS_G) + (size_t)T * 1024, WSB(WS_MERGED)}; pg8::gemm_phase<pg8::EpiMerge<false>, pg8::StaticOrder, true, PG8_SP2>(ring, g, S, E, GEMM_TID); }
            VM_WAIT(); __syncthreads(); LAUNDER();
            if (MERGE_CALLS >= 3) { pg8::Gemm g{WSB(WS_YC), WSB(WS_W_PC), T, DM, DH}; pg8::EpiMerge<false> E{WSB(WS_G) + (size_t)2 * T * 1024, WSB(WS_MERGED)}; pg8::gemm_phase<pg8::EpiMerge<false>, pg8::StaticOrder, true, PG8_SP2>(ring, g, S, E, GEMM_TID); }
            if (BOTH(P + 6)) GRID_BAR();
        }
        if (IN(P + 7)) { LAUNDER();
            pg8::Gemm g{WSB(WS_MERGED), WSB(WS_W_O), T, DM, DM}; pg8::StaticOrder S; S.init(T, DM, F.G, F.bid);
            pg8::EpiResidB E{WSB(WS_XB), SSQ_MLP(l)};
            pg8::gemm_phase<pg8::EpiResidB, pg8::StaticOrder, true, PG8_SP2>(ring, g, S, E, GEMM_TID);
            if (BOTH(P + 7)) GRID_BAR();
        }
        if (IN(P + 8)) {   }
        if (IN(P + 9)) { LAUNDER();
            pg8::Gemm g{WSB(WS_XB), WSB(WS_W_UP), T, DFF, DM}; pg8::StaticOrder S; S.init(T, DFF, F.G, F.bid);
            pg8::EpiUp E{WSB(WS_H), SSQ_MLP(l)};
            pg8::gemm_phase<pg8::EpiUp, pg8::StaticOrder, true, PG8_SP2>(ring, g, S, E, GEMM_TID);
            if (PROBE_SEL & 32) { VM_WAIT(); __syncthreads(); LAUNDER(); pg8::gemm_phase<pg8::EpiUp, pg8::StaticOrder, true, PG8_SP2>(ring, g, S, E, GEMM_TID); }
            if (BOTH(P + 9)) GRID_BAR();
        }
        if (IN(P + 10)) { LAUNDER();
            pg8::Gemm g{WSB(WS_H), WSB(WS_W_DN), T, DM, DFF}; pg8::StaticOrder S; S.init(T, DM, F.G, F.bid);
            pg8::EpiResidB E{WSB(WS_XB), (l == 0) ? SSQ_CTL + T : (pg8::ssq_t*)nullptr};
            pg8::gemm_phase<pg8::EpiResidB, pg8::StaticOrder, true, PG8_SP2>(ring, g, S, E, GEMM_TID);
            if (BOTH(P + 10)) GRID_BAR();
        }
    }
    if (IN(2 * PH_PER_LAYER)) { LAUNDER(); p_final(F); }
#undef IN
#undef BOTH
#undef GRID_BAR
}

extern "C" void kernel_launch(void* const* d_in, const int* in_sizes, int n_in, void* d_out, int out_size, void* d_ws, size_t ws_size, hipStream_t stream) {
    static int grid = 0;
    if (grid == 0) {
        if (n_in != 19 || in_sizes[0] != T * DM || out_size != T * DM || ws_size < WS_END) { fprintf(stderr, "kernel_launch: unexpected shapes (n_in %d, in0 %d, out %d, ws %zu)\n", n_in, n_in > 0 ? in_sizes[0] : -1, out_size, ws_size); grid = -1; return; }
        int dev = 0, cus = 0, per_cu = 0;
        if (hipGetDevice(&dev) != hipSuccess || hipDeviceGetAttribute(&cus, hipDeviceAttributeMultiprocessorCount, dev) != hipSuccess) { grid = -1; return; }
        if (hipFuncSetAttribute((const void*)fwd, hipFuncAttributeMaxDynamicSharedMemorySize, LDS_BYTES) != hipSuccess) { fprintf(stderr, "kernel_launch: hipFuncSetAttribute failed\n"); grid = -1; return; }
        if (hipOccupancyMaxActiveBlocksPerMultiprocessor(&per_cu, (const void*)fwd, NWAVES * 64, LDS_BYTES) != hipSuccess || per_cu < 1) { fprintf(stderr, "kernel_launch: occupancy query says %d\n", per_cu); }
        (void)hipGetLastError();
        grid = cus;
    }
    if (grid < 0) return;
    if (hipMemsetAsync((char*)d_ws + WS_CTL, 0, CTL_ZERO_BYTES, stream) != hipSuccess) return;
    Args a{};
    for (int i = 0; i < 19; ++i) a.in[i] = (const float*)d_in[i];
    a.out = (float*)d_out; a.ws = (unsigned char*)d_ws;
    if (ONE_LAUNCH) { a.ph_lo = 0; a.ph_hi = N_PHASES; hipLaunchKernelGGL(fwd, dim3(grid), dim3(NWAVES * 64), LDS_BYTES, stream, a); }
    else for (int p = 0; p < N_PHASES; ++p) { a.ph_lo = p; a.ph_hi = p + 1; hipLaunchKernelGGL(fwd, dim3(grid), dim3(NWAVES * 64), LDS_BYTES, stream, a); }
}
```

```cpp
#include <hip/hip_runtime.h>
#include <cstdio>
#include <cstdint>

#ifndef MK_ONE_LAUNCH
#define MK_ONE_LAUNCH 1
#endif

constexpr int BATCH = 2, SEQ = 16384, DM = 1024, T = BATCH * SEQ;
constexpr int DIN = 7752, DFF = 4096, DH = 512;
constexpr int NIN_T = 4864;
constexpr int NBLK = SEQ / 256;
constexpr float EPS = 1e-6f;

namespace pg8 {
#define PG8_LAS __attribute__((address_space(3)))
typedef unsigned short bf16_t;
typedef short bf16x8 __attribute__((ext_vector_type(8)));
typedef float f32x4 __attribute__((ext_vector_type(4)));
typedef unsigned u32x4 __attribute__((ext_vector_type(4)));
constexpr int BM = 256, BK = 64, HALF = 128, HTB = HALF * BK * 2  , STAGE_BYTES = 8 * HTB, NXCD = 8, WGM = 8;

__host__ __device__ __forceinline__ int lds_byte(int r, int c) { const int st = (r >> 4) * 2 + (c >> 5), rr = r & 15, cc = c & 31, ob = rr * 64 + cc * 2; return st * 1024 + (ob ^ (((ob >> 9) & 1) << 5)); }
__host__ __device__ __forceinline__ void stage_rc(int b, int& R, int& C) { const int st = b / 1024, sb = b % 1024, swz = sb ^ (((sb >> 9) & 1) << 5); R = (st >> 1) * 16 + swz / 64; C = (st & 1) * 32 + (swz % 64) / 2; }
__host__ __device__ __forceinline__ int perm32(int rho) { const int n = rho >> 4, i = rho & 15; return 8 * (i >> 2) + 4 * n + (i & 3); }

struct Unit { int pm, pn; };
struct Gemm { const bf16_t* A; const bf16_t* Bt; int M, N, K; };

struct StaticOrder {
    int nM, nN, nwg, G, c;
    __host__ __device__ void init(int M, int N, int G_, int c_) { nM = M / BM; nN = N / BM; nwg = nM * nN; G = G_; c = c_; }
    __host__ __device__ bool next(int i, Unit& u) const {
        const long L = (long)i * G + c; if (L >= nwg) return false;
        int wgid = (int)L; { const int q = nwg / NXCD, r = nwg % NXCD, xcd = wgid % NXCD, off = wgid / NXCD; wgid = (xcd < r ? xcd * (q + 1) : r * (q + 1) + (xcd - r) * q) + off; }
        const int nig = WGM * nN, gid = wgid / nig, fm = gid * WGM, gsz = (nM - fm) < WGM ? (nM - fm) : WGM;
        u.pm = fm + ((wgid % nig) % gsz); u.pn = (wgid % nig) / gsz; return true;
    }
    __device__ __forceinline__ void a_ready(const Unit&) const {}
    __device__ __forceinline__ void done(const Unit&) const {}
};

typedef float f32x2_t __attribute__((ext_vector_type(2))); typedef __bf16 bf16x2_t __attribute__((ext_vector_type(2)));
typedef unsigned long long ssq_t;
constexpr float SSQ_ONE = 16777216.0f;
__device__ __forceinline__ float ssq_rs(const ssq_t* a, int row) { return __builtin_amdgcn_rsqf((float)a[row] * (1.0f / (SSQ_ONE * 1024.0f)) + EPS); }
__device__ __forceinline__ unsigned cvt_pk_bf16(float lo, float hi) { f32x2_t v = {lo, hi}; bf16x2_t b = __builtin_convertvector(v, bf16x2_t); return __builtin_bit_cast(unsigned, b); }
__device__ __forceinline__ float bf_lo(unsigned w) { return __uint_as_float(w << 16); }
__device__ __forceinline__ float bf_hi(unsigned w) { return __uint_as_float(w & 0xffff0000u); }

struct EpiInproj {
    static constexpr bool PERM = true, AFTER_DRAIN = false;
    bf16_t* base; bf16_t* ki; float* wi; const ssq_t* rstd  ; float* km2;
    __device__ __forceinline__ void operator()(const f32x4 (&acc)[2][2][4][2], const Unit& u, int wr, int wc, int fr, int fq) const {
        const int row0 = u.pm * BM + wr * 64 + fr;
        if (u.pn < 18) {
            bf16_t* dst = base + (size_t)(u.pn >> 1) * ((size_t)T * 512) + (u.pn & 1) * 256 + wc * 32 + 8 * fq;
            const bool ksum = (u.pn >> 1) == 3;
            f32x4 cs[2][2] = {{{0.f, 0.f, 0.f, 0.f}, {0.f, 0.f, 0.f, 0.f}}, {{0.f, 0.f, 0.f, 0.f}, {0.f, 0.f, 0.f, 0.f}}};
#pragma unroll
            for (int ai = 0; ai < 2; ++ai)
#pragma unroll
                for (int m = 0; m < 4; ++m) { const int row = row0 + ai * HALF + m * 16; const float rs = ssq_rs(rstd, row); bf16_t* rowp = dst + (size_t)row * 512;
#pragma unroll
                    for (int bj = 0; bj < 2; ++bj) { const f32x4 v0 = acc[ai][bj][m][0] * rs, v1 = acc[ai][bj][m][1] * rs;
                        if (ksum) { cs[bj][0] += v0; cs[bj][1] += v1; }
                        u32x4 w; w.x = cvt_pk_bf16(v0[0], v0[1]); w.y = cvt_pk_bf16(v0[2], v0[3]); w.z = cvt_pk_bf16(v1[0], v1[1]); w.w = cvt_pk_bf16(v1[2], v1[3]);
                        *(u32x4*)(rowp + bj * HALF) = w; } }
            if (ksum) {
#pragma unroll
                for (int bj = 0; bj < 2; ++bj)
#pragma unroll
                    for (int n = 0; n < 2; ++n)
#pragma unroll
                        for (int j = 0; j < 4; ++j) { float v = cs[bj][n][j]; v += __shfl_xor(v, 1); v += __shfl_xor(v, 2); v += __shfl_xor(v, 4); v += __shfl_xor(v, 8); cs[bj][n][j] = v; }
                if (fr == 0) { float* kd = km2 + ((size_t)u.pm * 2 + wr) * 512 + (u.pn & 1) * 256 + wc * 32 + 8 * fq;
#pragma unroll
                    for (int bj = 0; bj < 2; ++bj) { *(f32x4*)(kd + bj * HALF) = cs[bj][0]; *(f32x4*)(kd + bj * HALF + 4) = cs[bj][1]; } }
            }
        } else {
#pragma unroll
            for (int ai = 0; ai < 2; ++ai)
#pragma unroll
                for (int m = 0; m < 4; ++m) { const int row = row0 + ai * HALF + m * 16; const float rs = ssq_rs(rstd, row);
                    const f32x4 v0 = acc[ai][0][m][0] * rs, v1 = acc[ai][0][m][1] * rs;
                    if (wc < 2) { u32x4 w; w.x = cvt_pk_bf16(v0[0], v0[1]); w.y = cvt_pk_bf16(v0[2], v0[3]); w.z = cvt_pk_bf16(v1[0], v1[1]); w.w = cvt_pk_bf16(v1[2], v1[3]);
                        *(u32x4*)(ki + (size_t)row * 64 + wc * 32 + 8 * fq) = w; }
                    else if (wc == 2 && fq == 0) { *(f32x4*)(wi + (size_t)row * 8) = v0; *(f32x4*)(wi + (size_t)row * 8 + 4) = v1; } }
        }
    }
};
struct EpiGates {
    static constexpr bool PERM = true, AFTER_DRAIN = false;
    bf16_t* O; const ssq_t* rstd;
    __device__ __forceinline__ void operator()(const f32x4 (&acc)[2][2][4][2], const Unit& u, int wr, int wc, int fr, int fq) const {
        const int row0 = u.pm * BM + wr * 64 + fr; const int tsel = u.pn >> 2;
        bf16_t* dst = O + (size_t)tsel * ((size_t)T * 1024) + (u.pn & 3) * 256 + wc * 32 + 8 * fq;
#pragma unroll
        for (int ai = 0; ai < 2; ++ai)
#pragma unroll
            for (int m = 0; m < 4; ++m) { const int row = row0 + ai * HALF + m * 16; const float rs = ssq_rs(rstd, row); bf16_t* rowp = dst + (size_t)row * 1024;
#pragma unroll
                for (int bj = 0; bj < 2; ++bj) { float v[8];
#pragma unroll
                    for (int j = 0; j < 4; ++j) { v[j] = acc[ai][bj][m][0][j] * rs; v[4 + j] = acc[ai][bj][m][1][j] * rs; }
#pragma unroll
                    for (int j = 0; j < 8; ++j) v[j] = __builtin_amdgcn_rcpf(1.0f + __builtin_amdgcn_exp2f(-1.4426950408889634f * v[j]));
                    u32x4 w; w.x = cvt_pk_bf16(v[0], v[1]); w.y = cvt_pk_bf16(v[2], v[3]); w.z = cvt_pk_bf16(v[4], v[5]); w.w = cvt_pk_bf16(v[6], v[7]);
                    *(u32x4*)(rowp + bj * HALF) = w; } }
    }
};
template <bool FIRST> struct EpiMerge {
    static constexpr bool PERM = true, AFTER_DRAIN = false;
    const bf16_t* G; bf16_t* Mg;
    __device__ __forceinline__ void operator()(const f32x4 (&acc)[2][2][4][2], const Unit& u, int wr, int wc, int fr, int fq) const {
        const int row0 = u.pm * BM + wr * 64 + fr; const int col0 = u.pn * BM + wc * 32 + 8 * fq;
#pragma unroll
        for (int ai = 0; ai < 2; ++ai)
#pragma unroll
            for (int m = 0; m < 4; ++m) { const size_t off = (size_t)(row0 + ai * HALF + m * 16) * 1024 + col0;
#pragma unroll
                for (int bj = 0; bj < 2; ++bj) { const u32x4 g = *(const u32x4*)(G + off + bj * HALF); const f32x4 a0 = acc[ai][bj][m][0], a1 = acc[ai][bj][m][1];
                    float v[8] = { bf_lo(g.x) * a0[0], bf_hi(g.x) * a0[1], bf_lo(g.y) * a0[2], bf_hi(g.y) * a0[3], bf_lo(g.z) * a1[0], bf_hi(g.z) * a1[1], bf_lo(g.w) * a1[2], bf_hi(g.w) * a1[3] };
                    if (!FIRST) { const u32x4 o = *(const u32x4*)(Mg + off + bj * HALF);
                        v[0] += bf_lo(o.x); v[1] += bf_hi(o.x); v[2] += bf_lo(o.y); v[3] += bf_hi(o.y); v[4] += bf_lo(o.z); v[5] += bf_hi(o.z); v[6] += bf_lo(o.w); v[7] += bf_hi(o.w); }
                    u32x4 w; w.x = cvt_pk_bf16(v[0], v[1]); w.y = cvt_pk_bf16(v[2], v[3]); w.z = cvt_pk_bf16(v[4], v[5]); w.w = cvt_pk_bf16(v[6], v[7]);
                    *(u32x4*)(Mg + off + bj * HALF) = w; }
                asm volatile("" ::: "memory"); }
    }
};
struct EpiResid {
    static constexpr bool PERM = false, AFTER_DRAIN = false;
    const float* src; float* out; bf16_t* xb; float* ssq;
    __device__ __forceinline__ void operator()(const f32x4 (&acc)[2][2][4][2], const Unit& u, int wr, int wc, int fr, int fq) const {
        const int row0 = u.pm * BM + wr * 64 + fr, col0 = u.pn * BM + wc * 32 + 4 * fq;
#pragma unroll
        for (int ai = 0; ai < 2; ++ai)
#pragma unroll
            for (int m = 0; m < 4; ++m) { const int row = row0 + ai * HALF + m * 16; const size_t off = (size_t)row * 1024 + col0; float sq = 0.f;
#pragma unroll
                for (int bj = 0; bj < 2; ++bj)
#pragma unroll
                    for (int n = 0; n < 2; ++n) { const f32x4 s = *(const f32x4*)(src + off + bj * HALF + n * 16); const f32x4 v = s + acc[ai][bj][m][n]; *(f32x4*)(out + off + bj * HALF + n * 16) = v;
                        if (xb) { typedef unsigned u32x2v __attribute__((ext_vector_type(2))); u32x2v w; w.x = cvt_pk_bf16(v[0], v[1]); w.y = cvt_pk_bf16(v[2], v[3]); *(u32x2v*)(xb + off + bj * HALF + n * 16) = w;
                            sq += (v[0] * v[0] + v[1] * v[1]) + (v[2] * v[2] + v[3] * v[3]); } }
                if (xb) { sq += __shfl_xor(sq, 16); sq += __shfl_xor(sq, 32); if (fq == 0) unsafeAtomicAdd(ssq + row, sq); } }
    }
};
struct EpiResidB {
    static constexpr bool PERM = true, AFTER_DRAIN = false;
    bf16_t* xb; ssq_t* ssq;
    __device__ __forceinline__ void operator()(const f32x4 (&acc)[2][2][4][2], const Unit& u, int wr, int wc, int fr, int fq) const {
        const int row0 = u.pm * BM + wr * 64 + fr; const int col0 = u.pn * BM + wc * 32 + 8 * fq;
#pragma unroll
        for (int ai = 0; ai < 2; ++ai)
#pragma unroll
            for (int m = 0; m < 4; ++m) { const int row = row0 + ai * HALF + m * 16; const size_t off = (size_t)row * 1024 + col0; float sq = 0.f;
#pragma unroll
                for (int bj = 0; bj < 2; ++bj) { const u32x4 g = *(const u32x4*)(xb + off + bj * HALF); const f32x4 a0 = acc[ai][bj][m][0], a1 = acc[ai][bj][m][1];
                    const float v[8] = { bf_lo(g.x) + a0[0], bf_hi(g.x) + a0[1], bf_lo(g.y) + a0[2], bf_hi(g.y) + a0[3], bf_lo(g.z) + a1[0], bf_hi(g.z) + a1[1], bf_lo(g.w) + a1[2], bf_hi(g.w) + a1[3] };
                    sq += ((v[0] * v[0] + v[1] * v[1]) + (v[2] * v[2] + v[3] * v[3])) + ((v[4] * v[4] + v[5] * v[5]) + (v[6] * v[6] + v[7] * v[7]));
                    u32x4 w; w.x = cvt_pk_bf16(v[0], v[1]); w.y = cvt_pk_bf16(v[2], v[3]); w.z = cvt_pk_bf16(v[4], v[5]); w.w = cvt_pk_bf16(v[6], v[7]);
                    *(u32x4*)(xb + off + bj * HALF) = w; }
                if (ssq) { sq += __shfl_xor(sq, 16); sq += __shfl_xor(sq, 32); if (fq == 0) atomicAdd(ssq + row, (ssq_t)(sq * SSQ_ONE)); } }
    }
};
struct EpiUp {
    static constexpr bool PERM = true, AFTER_DRAIN = false;
    bf16_t* O; const ssq_t* rstd;
    __device__ __forceinline__ void operator()(const f32x4 (&acc)[2][2][4][2], const Unit& u, int wr, int wc, int fr, int fq) const {
        const int row0 = u.pm * BM + wr * 64 + fr; const int col0 = u.pn * BM + wc * 32 + 8 * fq;
#pragma unroll
        for (int ai = 0; ai < 2; ++ai)
#pragma unroll
            for (int m = 0; m < 4; ++m) { const int row = row0 + ai * HALF + m * 16; const float rs = ssq_rs(rstd, row); bf16_t* rowp = O + (size_t)row * DFF + col0;
#pragma unroll
                for (int bj = 0; bj < 2; ++bj) { float v[8];
#pragma unroll
                    for (int j = 0; j < 4; ++j) { v[j] = fmaxf(acc[ai][bj][m][0][j] * rs, 0.f); v[4 + j] = fmaxf(acc[ai][bj][m][1][j] * rs, 0.f); }
#pragma unroll
                    for (int j = 0; j < 8; ++j) v[j] = v[j] * v[j];
                    u32x4 w; w.x = cvt_pk_bf16(v[0], v[1]); w.y = cvt_pk_bf16(v[2], v[3]); w.z = cvt_pk_bf16(v[4], v[5]); w.w = cvt_pk_bf16(v[6], v[7]);
                    *(u32x4*)(rowp + bj * HALF) = w; } }
    }
};

template <class Epi, class Sched, bool ALIGN_EPI = false, bool SP2 = false>
__device__ __forceinline__ void gemm_phase(PG8_LAS unsigned char* lds, const Gemm g, const Sched& S, const Epi& E, int tid_in) {
    int tid_ = tid_in; asm volatile("" : "+v"(tid_));
    const int tid = tid_, wid = __builtin_amdgcn_readfirstlane(tid >> 6), lane = tid & 63, wr = wid >> 2, wc = wid & 3, fr = lane & 15, fq = lane >> 4;
    const int K = g.K, nt = K / BK;
    unsigned voffA[2], voffB[2];
#pragma unroll
    for (int i = 0; i < 2; ++i) { int R, C; stage_rc(tid * 16 + i * 8192, R, C); const int Rb = Epi::PERM ? ((R & ~31) + perm32(R & 31)) : R;
        voffA[i] = (unsigned)(R * K + C) * 2u; voffB[i] = (unsigned)(Rb * K + C) * 2u; }
    const size_t kstep = (size_t)(BK * 2);
    const size_t hstep = (size_t)HALF * K * 2;
    const size_t tstep = 2 * hstep;
    const unsigned ldsw = (unsigned)wid * 1024u;
    const int aoff = lds_byte(wr * 64 + fr, fq * 8), boff = lds_byte(wc * 32 + fr, fq * 8);
#define PG8_SA(b, h) (((b) * 2 + (h)) * HTB)
#define PG8_SB(b, h) ((4 + (b) * 2 + (h)) * HTB)
#define PG8_STAGE(bufoff, gbase, voff) do { _Pragma("unroll") for (int _i = 0; _i < 2; ++_i) \
        __builtin_amdgcn_global_load_lds((const unsigned*)((const char*)(gbase) + (voff)[_i]), (PG8_LAS unsigned*)(lds + (bufoff) + ldsw + _i * 8192), 16, 0, 0); } while (0)
#define PG8_LDA(dst, b, h) do { _Pragma("unroll") for (int m = 0; m < 4; ++m) _Pragma("unroll") for (int k = 0; k < 2; ++k) dst[m][k] = *(const PG8_LAS bf16x8*)(lds + PG8_SA(b, h) + aoff + m * 2048 + k * 1024); } while (0)
#define PG8_LDB(dst, b, h) do { _Pragma("unroll") for (int n = 0; n < 2; ++n) _Pragma("unroll") for (int k = 0; k < 2; ++k) dst[n][k] = *(const PG8_LAS bf16x8*)(lds + PG8_SB(b, h) + boff + n * 2048 + k * 1024); } while (0)
#define PG8_MMA(ai, bj, At, Bt) do { __builtin_amdgcn_s_setprio(1); _Pragma("unroll") for (int m = 0; m < 4; ++m) _Pragma("unroll") for (int n = 0; n < 2; ++n) _Pragma("unroll") for (int k = 0; k < 2; ++k) \
        acc[ai][bj][m][n] = __builtin_amdgcn_mfma_f32_16x16x32_bf16(Bt[n][k], At[m][k], acc[ai][bj][m][n], 0, 0, 0); __builtin_amdgcn_s_setprio(0); } while (0)
#define PG8_WAIT_V(n) asm volatile("s_waitcnt vmcnt(" #n ")" ::: "memory")
#define PG8_WAIT_L(n) asm volatile("s_waitcnt lgkmcnt(" #n ")" ::: "memory")
#define PG8_BAR __builtin_amdgcn_s_barrier()
#define PG8_SCHED __builtin_amdgcn_sched_barrier(0)
    Unit cur, nxt; int ui = 0;
    if (!S.next(0, cur)) return;
    f32x4 acc[2][2][4][2];
#pragma unroll
    for (int a = 0; a < 2; ++a)
#pragma unroll
        for (int b = 0; b < 2; ++b)
#pragma unroll
            for (int m = 0; m < 4; ++m)
#pragma unroll
                for (int n = 0; n < 2; ++n) acc[a][b][m][n] = (f32x4){0.f, 0.f, 0.f, 0.f};
    bf16x8 At[4][2], B0[2][2], B1[2][2];
    const char* cA = (const char*)g.A + (size_t)cur.pm * tstep; const char* cB = (const char*)g.Bt + (size_t)cur.pn * tstep;
    S.a_ready(cur);
    if constexpr (SP2) {
        PG8_STAGE(PG8_SB(0, 0), cB, voffB); PG8_STAGE(PG8_SB(0, 1), cB + hstep, voffB); PG8_STAGE(PG8_SA(0, 0), cA, voffA); PG8_STAGE(PG8_SA(0, 1), cA + hstep, voffA);
        if (wr == 1) PG8_BAR;
        PG8_WAIT_V(2); PG8_BAR;
        PG8_STAGE(PG8_SB(1, 0), cB + kstep, voffB); PG8_STAGE(PG8_SA(1, 0), cA + kstep, voffA); PG8_STAGE(PG8_SB(1, 1), cB + hstep + kstep, voffB);
        PG8_WAIT_V(6); PG8_BAR;
    } else {
        PG8_STAGE(PG8_SB(0, 0), cB, voffB); PG8_STAGE(PG8_SA(0, 0), cA, voffA); PG8_STAGE(PG8_SB(0, 1), cB + hstep, voffB); PG8_STAGE(PG8_SA(0, 1), cA + hstep, voffA);
        if (wr == 1) PG8_BAR;
        PG8_WAIT_V(4); PG8_BAR;
        PG8_STAGE(PG8_SB(1, 0), cB + kstep, voffB); PG8_STAGE(PG8_SA(1, 0), cA + kstep, voffA); PG8_STAGE(PG8_SB(1, 1), cB + hstep + kstep, voffB);
        PG8_WAIT_V(6); PG8_BAR;
    }
    for (;;) {
        const bool has_next = S.next(ui + 1, nxt);
        const char* nA = has_next ? (const char*)g.A + (size_t)nxt.pm * tstep : cA; const char* nB = has_next ? (const char*)g.Bt + (size_t)nxt.pn * tstep : cB;
        for (int t = 0; t < nt; t += 2) {
            const bool last = (t == nt - 2);
            const char* a1 = cA + (size_t)(t + 1) * kstep;
            const char* a2 = last ? nA : cA + (size_t)(t + 2) * kstep; const char* b2 = last ? nB : cB + (size_t)(t + 2) * kstep;
            const char* a3 = a2 + kstep; const char* b3 = b2 + kstep;
            if (last && has_next) S.a_ready(nxt);
            if constexpr (SP2) {
            PG8_LDB(B0, 0, 0); PG8_LDB(B1, 0, 1); PG8_SCHED; PG8_LDA(At, 0, 0); PG8_STAGE(PG8_SA(1, 1), a1 + hstep, voffA);
            PG8_WAIT_V(8); PG8_WAIT_L(0); PG8_BAR; PG8_MMA(0, 0, At, B0); PG8_MMA(0, 1, At, B1); PG8_BAR; PG8_SCHED;
            PG8_LDA(At, 0, 1); PG8_STAGE(PG8_SB(0, 0), b2, voffB); PG8_STAGE(PG8_SB(0, 1), b2 + hstep, voffB); PG8_STAGE(PG8_SA(0, 0), a2, voffA);
            PG8_WAIT_V(8); PG8_WAIT_L(0); PG8_BAR; PG8_MMA(1, 0, At, B0); PG8_MMA(1, 1, At, B1); PG8_BAR; PG8_SCHED;
            PG8_LDB(B0, 1, 0); PG8_LDB(B1, 1, 1); PG8_SCHED; PG8_LDA(At, 1, 0); PG8_STAGE(PG8_SA(0, 1), a2 + hstep, voffA);
            PG8_WAIT_V(8); PG8_WAIT_L(0); PG8_BAR; PG8_MMA(0, 0, At, B0); PG8_MMA(0, 1, At, B1); PG8_BAR; PG8_SCHED;
            PG8_LDA(At, 1, 1); PG8_STAGE(PG8_SB(1, 0), b3, voffB); PG8_STAGE(PG8_SB(1, 1), b3 + hstep, voffB); PG8_STAGE(PG8_SA(1, 0), a3, voffA);
            PG8_WAIT_V(8); PG8_WAIT_L(0); PG8_BAR; PG8_MMA(1, 0, At, B0); PG8_MMA(1, 1, At, B1); PG8_BAR; PG8_SCHED;
            } else {
            PG8_LDB(B0, 0, 0); PG8_SCHED; PG8_LDA(At, 0, 0); PG8_STAGE(PG8_SA(1, 1), a1 + hstep, voffA);
            PG8_WAIT_L(8); PG8_BAR; PG8_WAIT_L(0); PG8_MMA(0, 0, At, B0); PG8_BAR; PG8_SCHED;
            PG8_LDB(B1, 0, 1); PG8_STAGE(PG8_SB(0, 0), b2, voffB);
            PG8_BAR; PG8_WAIT_L(0); PG8_MMA(0, 1, At, B1); PG8_BAR;
            PG8_LDA(At, 0, 1); PG8_STAGE(PG8_SA(0, 0), a2, voffA);
            PG8_BAR; PG8_WAIT_L(0); PG8_MMA(1, 0, At, B0); PG8_BAR; PG8_SCHED;
            PG8_STAGE(PG8_SB(0, 1), b2 + hstep, voffB);
            PG8_WAIT_V(6); PG8_BAR; PG8_MMA(1, 1, At, B1); PG8_BAR;
            PG8_LDB(B0, 1, 0); PG8_SCHED; PG8_LDA(At, 1, 0); PG8_STAGE(PG8_SA(0, 1), a2 + hstep, voffA);
            PG8_WAIT_L(8); PG8_BAR; PG8_WAIT_L(0); PG8_MMA(0, 0, At, B0); PG8_BAR; PG8_SCHED;
            PG8_LDB(B1, 1, 1); PG8_STAGE(PG8_SB(1, 0), b3, voffB);
            PG8_BAR; PG8_WAIT_L(0); PG8_MMA(0, 1, At, B1); PG8_BAR;
            PG8_LDA(At, 1, 1); PG8_STAGE(PG8_SA(1, 0), a3, voffA);
            PG8_BAR; PG8_WAIT_L(0); PG8_MMA(1, 0, At, B0); PG8_BAR; PG8_SCHED;
            PG8_STAGE(PG8_SB(1, 1), b3 + hstep, voffB);
            PG8_WAIT_V(6); PG8_BAR; PG8_MMA(1, 1, At, B1); PG8_BAR;
            }
        }
        if constexpr (ALIGN_EPI) { if (wr == 0) PG8_BAR; }
        if constexpr (!Epi::AFTER_DRAIN) { E(acc, cur, wr, wc, fr, fq); S.done(cur); }
        if (!has_next) break;
#pragma unroll
        for (int a = 0; a < 2; ++a)
#pragma unroll
            for (int b = 0; b < 2; ++b)
#pragma unroll
                for (int m = 0; m < 4; ++m)
#pragma unroll
                    for (int n = 0; n < 2; ++n) acc[a][b][m][n] = (f32x4){0.f, 0.f, 0.f, 0.f};
        cur = nxt; cA = nA; cB = nB; ++ui;
        if constexpr (ALIGN_EPI) { if (wr == 1) PG8_BAR; }
    }
    PG8_WAIT_V(0);
    if constexpr (!ALIGN_EPI) { if (wr == 0) PG8_BAR; }
    PG8_BAR;
    if constexpr (Epi::AFTER_DRAIN) { E.fused(acc, cur, wr, wc, fr, fq, lds, wid, lane); S.done(cur); }
#undef PG8_SA
#undef PG8_SB
#undef PG8_STAGE
#undef PG8_LDA
#undef PG8_LDB
#undef PG8_MMA
#undef PG8_WAIT_V
#undef PG8_WAIT_L
#undef PG8_BAR
#undef PG8_SCHED
}
}

#ifndef FAST_MOBA
#define FAST_MOBA 2
#endif
#ifndef PG8_SP2
#define PG8_SP2 true
#endif
#ifndef PROBE_SEL
#define PROBE_SEL 0
#endif
constexpr int NWAVES = 8;
constexpr int PH_PER_LAYER = 11;
constexpr int N_PHASES = 2 * PH_PER_LAYER + 1;
constexpr bool ONE_LAUNCH = (MK_ONE_LAUNCH != 0);
static_assert(ONE_LAUNCH, "build with MK_ONE_LAUNCH=1 (build.sh 1): the unit queues and the phase program assume one launch");

constexpr size_t MiB = 1u << 20;
constexpr size_t WS_CTL = 0, CTL_ZERO_BYTES = 1 * MiB;
constexpr size_t WS_W_IN = 1 * MiB;
constexpr size_t WS_W_G = 11 * MiB;
constexpr size_t WS_W_PA = 17 * MiB, WS_W_PB = 18 * MiB, WS_W_PC = 19 * MiB;
constexpr size_t WS_W_O = 20 * MiB;
constexpr size_t WS_W_UP = 22 * MiB;
constexpr size_t WS_W_DN = 30 * MiB;
constexpr size_t WS_XB = 40 * MiB;
constexpr size_t WS_RSTD = 104 * MiB;
constexpr int CW_SSQ = 32768;
static_assert(CW_SSQ * 4 + 3 * T * 8 <= (int)CTL_ZERO_BYTES, "ssq arrays inside the memset region");
constexpr size_t WS_KMEAN = 104 * MiB + 256 * 1024;
constexpr size_t WS_RGA = 104 * MiB + 256 * 1024;
constexpr size_t WS_RGH = 10 * MiB + 512 * 1024;
constexpr int RGC = 128;
constexpr size_t WS_WI = 105 * MiB;
constexpr size_t WS_KI = 106 * MiB;
constexpr size_t WS_ACT = 112 * MiB;
constexpr size_t ACT_STRIDE = (size_t)T * 512 * 2;
constexpr size_t WS_QA = WS_ACT, WS_QB = WS_ACT + ACT_STRIDE, WS_YC = WS_ACT + 2 * ACT_STRIDE, WS_KA = WS_ACT + 3 * ACT_STRIDE, WS_VA = WS_ACT + 4 * ACT_STRIDE,
                 WS_KB = WS_ACT + 5 * ACT_STRIDE, WS_VB = WS_ACT + 6 * ACT_STRIDE, WS_QI = WS_ACT + 7 * ACT_STRIDE, WS_XC = WS_ACT + 8 * ACT_STRIDE;
constexpr size_t WS_G = WS_KA;
constexpr size_t WS_MASK = 400 * MiB;
constexpr size_t WS_MERGED = 400 * MiB;
constexpr size_t WS_H = WS_ACT;
constexpr size_t WS_END = 512 * MiB;
static_assert(WS_XC + ACT_STRIDE == 400 * MiB && WS_G + (size_t)3 * T * 1024 * 2 == 400 * MiB && WS_H + (size_t)T * DFF * 2 <= 400 * MiB, "d_ws map");
constexpr int CW_DYN = 12288;
constexpr int CW_BAR = 4096;

constexpr int RING_OFF = 0, RING_BYTES = 131072;
constexpr int LDSCTL_OFF = RING_BYTES, MISC_OFF = LDSCTL_OFF + 320;
constexpr int LDS_BYTES = 147456;
constexpr int GL_SKEY = 0, GL_QIF = 65536, GL_WQ = GL_QIF + 2048, GL_HIST = GL_WQ + 64, GL_SEL = GL_HIST + 1024, GL_MISC = GL_SEL + 1024, GL_QS = 70656, GL_PS = 73728;
static_assert(GL_MISC + 64 <= GL_QS && GL_QS + 8 * 256 <= GL_PS && GL_PS + 8 * 4096 <= RING_BYTES, "golden LDS map");

#define GAS __attribute__((address_space(1)))
#define LAS __attribute__((address_space(3)))
typedef unsigned short bf16;
typedef unsigned v4u __attribute__((ext_vector_type(4)));
typedef float f32x4 __attribute__((ext_vector_type(4)));
typedef GAS unsigned gu32;
#define RLX_AGENT __ATOMIC_RELAXED, __HIP_MEMORY_SCOPE_AGENT
#define LDS_WAIT() asm volatile("s_waitcnt lgkmcnt(0)" ::: "memory")
#define VM_WAIT() asm volatile("s_waitcnt vmcnt(0)" ::: "memory")
__device__ __forceinline__ float bf2f(bf16 v) { return __uint_as_float(((unsigned)v) << 16); }
__device__ __forceinline__ unsigned pk2(float lo, float hi) { return pg8::cvt_pk_bf16(lo, hi); }
__device__ __forceinline__ unsigned f2bf(float f) { return pg8::cvt_pk_bf16(f, 0.f) & 0xffffu; }
__device__ __forceinline__ float wave_sum(float v) {
#pragma unroll
    for (int o = 1; o < 64; o <<= 1) v += __shfl_xor(v, o);
    return v;
}
__device__ __forceinline__ float wave_max(float v) {
#pragma unroll
    for (int o = 1; o < 64; o <<= 1) v = fmaxf(v, __shfl_xor(v, o));
    return v;
}
__device__ __forceinline__ int t5_bucket(int n) {
    if (n < 16) return n;
    if (n >= 113) return 31;
    return 16 + (n >= 19) + (n >= 21) + (n >= 24) + (n >= 27) + (n >= 31) + (n >= 35) + (n >= 40) + (n >= 46) + (n >= 52) + (n >= 59) + (n >= 67) + (n >= 77) + (n >= 87) + (n >= 99);
}

#define XB_TMO      128
#define XB_XCNT(j)  (256  + 64 * (j))
#define XB_XSUB(j)  (1280 + 64 * (j))
#define XB_XGEN(j)  (2304 + 64 * (j))
#define XB_TOP      3328
#define XB_TOPGEN   3392
#define XCD_BAR_WORDS 3456
#define XB_SPIN_CAP (1u << 22)

__device__ __forceinline__ unsigned xb_ld(unsigned* p)              { return __hip_atomic_load(p, __ATOMIC_RELAXED, __HIP_MEMORY_SCOPE_AGENT); }
__device__ __forceinline__ unsigned xb_add(unsigned* p, unsigned v) { return __hip_atomic_fetch_add(p, v, __ATOMIC_RELAXED, __HIP_MEMORY_SCOPE_AGENT); }
__device__ __forceinline__ unsigned xb_xcc_id() { return (unsigned)__builtin_amdgcn_s_getreg((3 << 11) | 20) & 0xFu; }
#define XB_SPIN(cond, bar) do { unsigned _sp = 0; while (cond) { __builtin_amdgcn_s_sleep(1); \
    if ((++_sp & 255u) == 0u) { if (xb_ld(&(bar)[XB_TMO])) break; if (_sp > XB_SPIN_CAP) { atomicAdd(&(bar)[XB_TMO], 1u); break; } } } } while (0)

struct XcdBarrier { unsigned* bar; unsigned x; volatile LAS unsigned* st; };

__device__ __forceinline__ XcdBarrier xcd_barrier_post(unsigned* bar, volatile LAS unsigned* st) {
    XcdBarrier b; b.bar = bar; b.x = xb_xcc_id(); b.st = st;
    if (threadIdx.x == 0) (void)xb_add(&bar[XB_XCNT(b.x)], 1u);
    return b;
}
__device__ __forceinline__ void xcd_barrier_complete(unsigned* bar, unsigned x, unsigned& nloc, unsigned& nx) {
    const unsigned G = gridDim.x * gridDim.y * gridDim.z;
    unsigned sum, cnt, mine, sp = 0u;
    for (;;) {
        sum = 0u; cnt = 0u; mine = 0u;
#pragma unroll
        for (unsigned j = 0; j < 16; ++j) { const unsigned c = xb_ld(&bar[XB_XCNT(j)]); sum += c; cnt += (c > 0u) ? 1u : 0u; }
        mine = xb_ld(&bar[XB_XCNT(x)]);
        if (sum == G) break;
        __builtin_amdgcn_s_sleep(1);
        if ((++sp & 255u) == 0u) { if (xb_ld(&bar[XB_TMO])) break; if (sp > XB_SPIN_CAP) { atomicAdd(&bar[XB_TMO], 1u); break; } }
    }
    nloc = mine > 0u ? mine : 1u; nx = cnt > 0u ? cnt : 1u;
}
__device__ __forceinline__ void xcd_barrier(const XcdBarrier& b) {
    asm volatile("s_waitcnt vmcnt(0)" ::: "memory");
    __syncthreads();
    if (threadIdx.x == 0) {
        unsigned* bar = b.bar;
        __builtin_amdgcn_s_waitcnt(0);
        unsigned nloc = b.st[0], nx = b.st[1];
        if (nloc == 0u) { xcd_barrier_complete(bar, b.x, nloc, nx); b.st[0] = nloc; b.st[1] = nx; }
        const unsigned old = xb_add(&bar[XB_XSUB(b.x)], 1u);
        const unsigned gen = old / nloc;
        if (old + 1u == (gen + 1u) * nloc) {
            __builtin_amdgcn_fence(__ATOMIC_RELEASE, "agent");
            asm volatile("s_waitcnt vmcnt(0)" ::: "memory");
            const unsigned og = xb_add(&bar[XB_TOP], 1u);
            const unsigned tg = og / nx;
            if (og + 1u == (tg + 1u) * nx) xb_add(&bar[XB_TOPGEN], 1u);
            else XB_SPIN(xb_ld(&bar[XB_TOPGEN]) == tg, bar);
            __builtin_amdgcn_fence(__ATOMIC_ACQUIRE, "agent");
            xb_add(&bar[XB_XGEN(b.x)], 1u);
            asm volatile("s_waitcnt vmcnt(0)" ::: "memory");
        } else {
            XB_SPIN(xb_ld(&bar[XB_XGEN(b.x)]) == gen, bar);
            __builtin_amdgcn_fence(__ATOMIC_ACQUIRE, "agent");
            asm volatile("s_waitcnt vmcnt(0)" ::: "memory");
        }
    }
    __syncthreads();
}

struct Args { const float* in[19]; float* out; unsigned char* ws; int ph_lo, ph_hi; };
struct Frame {
    LAS unsigned char* lds;
    int tid, lane, wave, G, bid;
    int gw;
    const __attribute__((address_space(4))) Args* a;
    unsigned char* ws; float* out;
};
#define WSB(off) ((bf16*)(F.ws + (off)))
#define WSF(off) ((float*)(F.ws + (off)))
#define INP(i) (F.a->in[i])
#define SSQ_CTL ((pg8::ssq_t*)(F.ws + WS_CTL + (size_t)CW_SSQ * 4))
#define SSQ_MIX(l) ((l) == 0 ? (pg8::ssq_t*)(F.ws + WS_RSTD) : SSQ_CTL + T)
#define SSQ_MLP(l) (SSQ_CTL + ((l) == 0 ? 0 : 2 * T))
enum { I_X = 0, I_RELB, I_NMG, I_WIN, I_CONVW, I_CONVB, I_WR, I_BR, I_WI, I_BI, I_LAM, I_WPA, I_WPB, I_WPC, I_WO, I_NLG, I_WUP, I_WDN, I_FNG };

template <class P> __device__ __forceinline__ P* launder_u(P* p) { unsigned lo = (unsigned)(uintptr_t)p, hi = (unsigned)((uintptr_t)p >> 32); asm volatile("" : "+v"(lo), "+v"(hi));
    lo = __builtin_amdgcn_readfirstlane(lo); hi = __builtin_amdgcn_readfirstlane(hi); return (P*)(((uintptr_t)hi << 32) | (uintptr_t)lo); }
__device__ __forceinline__ int launder_i(int v) { asm volatile("" : "+v"(v)); return __builtin_amdgcn_readfirstlane(v); }

__device__ __forceinline__ void transpose_item(const float* W, int ld, int K, int ncol_valid, const float* gain, bf16* WT, LAS float* scr, int item, int nblk, int lane) {
    const int kb = item / nblk, nb = item % nblk, k0 = 64 * kb, n0 = 32 * nb;
    const float gv = gain ? gain[k0 + lane] : 1.0f;
#pragma unroll 8
    for (int i = 0; i < 32; ++i) { const int kk = 2 * i + (lane >> 5); const int n = n0 + (lane & 31);
        float v = (n < ncol_valid) ? W[(size_t)(k0 + kk) * ld + n] : 0.f; v *= __shfl(gv, kk); scr[kk * 33 + (lane & 31)] = v; }
    LDS_WAIT(); asm volatile("" ::: "memory");
    const int c = lane & 7;
#pragma unroll
    for (int j = 0; j < 4; ++j) { const int n = (lane >> 3) + 8 * j; const LAS float* s = scr + (8 * c) * 33 + n;
        v4u o; o.x = pk2(s[0 * 33], s[1 * 33]); o.y = pk2(s[2 * 33], s[3 * 33]); o.z = pk2(s[4 * 33], s[5 * 33]); o.w = pk2(s[6 * 33], s[7 * 33]);
        *(GAS v4u*)(WT + (size_t)(n0 + n) * K + k0 + 8 * c) = o; }
    LDS_WAIT(); asm volatile("" ::: "memory");
}
__device__ __forceinline__ void norm_row(const float* xrow, bf16* orow, pg8::ssq_t* rstd_out, int lane) {
    const GAS f32x4* xr = (const GAS f32x4*)xrow + lane;
    f32x4 v[4]; float s = 0.f;
#pragma unroll
    for (int j = 0; j < 4; ++j) { v[j] = xr[64 * j]; s += (v[j].x * v[j].x + v[j].y * v[j].y) + (v[j].z * v[j].z + v[j].w * v[j].w); }
    const float ss = wave_sum(s);
    GAS unsigned long long* o8 = (GAS unsigned long long*)orow + lane;
#pragma unroll
    for (int j = 0; j < 4; ++j) o8[64 * j] = (unsigned long long)pk2(v[j].x, v[j].y) | ((unsigned long long)pk2(v[j].z, v[j].w) << 32);
    if (lane == 0) *rstd_out = (pg8::ssq_t)(ss * pg8::SSQ_ONE);
}
__device__ __forceinline__ void p_prologue(Frame& F, int l) {
    LAS float* scr = (LAS float*)(F.lds + RING_OFF + F.wave * 16384);
    const int gw = F.bid * NWAVES + F.wave, NGW = F.G * NWAVES;
    const float* w_in = INP(I_WIN) + (size_t)l * DM * DIN; const float* g1 = INP(I_NMG) + l * DM; const float* g2 = INP(I_NLG) + l * DM;
    constexpr int I_BLK = 16 * 16;
    constexpr int I_SP = 16 * 3;
    constexpr int I_G = 16 * 96;
    constexpr int I_P = 8 * 32;
    constexpr int I_O = 16 * 32;
    constexpr int I_UP = 16 * 128;
    constexpr int I_DN = 64 * 32;
    constexpr int NITEMS = 9 * I_BLK + I_SP + I_G + 3 * I_P + I_O + I_UP + I_DN;
    for (int it = gw; it < NITEMS; it += NGW) {
        int r = it;
        if (r < 9 * I_BLK) { const int blk = r / I_BLK; r -= blk * I_BLK;
            const int c0 = blk == 0 ? 0 : blk == 1 ? 1536 : blk == 2 ? 4168 : blk == 3 ? 512 : blk == 4 ? 1024 : blk == 5 ? 2048 : blk == 6 ? 2560 : blk == 7 ? 3072 : 3656;
            transpose_item(w_in + c0, DIN, DM, 512, g1, WSB(WS_W_IN) + (size_t)blk * 512 * DM, scr, r, 16, F.lane); continue; }
        r -= 9 * I_BLK;
        if (r < I_SP) { transpose_item(w_in + 3584, DIN, DM, 72, g1, WSB(WS_W_IN) + (size_t)4608 * DM, scr, r, 3, F.lane); continue; } r -= I_SP;
        if (r < I_G) { transpose_item(w_in + 4680, DIN, DM, 3072, g1, WSB(WS_W_G), scr, r, 96, F.lane); continue; } r -= I_G;
        if (r < I_P) { transpose_item(INP(I_WPA) + (size_t)l * DH * DM, DM, DH, 1024, nullptr, WSB(WS_W_PA), scr, r, 32, F.lane); continue; } r -= I_P;
        if (r < I_P) { transpose_item(INP(I_WPB) + (size_t)l * DH * DM, DM, DH, 1024, nullptr, WSB(WS_W_PB), scr, r, 32, F.lane); continue; } r -= I_P;
        if (r < I_P) { transpose_item(INP(I_WPC) + (size_t)l * DH * DM, DM, DH, 1024, nullptr, WSB(WS_W_PC), scr, r, 32, F.lane); continue; } r -= I_P;
        if (r < I_O) { transpose_item(INP(I_WO) + (size_t)l * DM * DM, DM, DM, 1024, nullptr, WSB(WS_W_O), scr, r, 32, F.lane); continue; } r -= I_O;
        if (r < I_UP) { transpose_item(INP(I_WUP) + (size_t)l * DM * DFF, DFF, DM, DFF, g2, WSB(WS_W_UP), scr, r, 128, F.lane); continue; } r -= I_UP;
        transpose_item(INP(I_WDN) + (size_t)l * DFF * DM, DM, DFF, 1024, nullptr, WSB(WS_W_DN), scr, r, 32, F.lane);
    }
    { GAS v4u* z = (GAS v4u*)(WSB(WS_W_IN) + (size_t)(4608 + 96) * DM); const int gt = F.bid * (NWAVES * 64) + F.tid;
      unsigned zz = 0u; asm volatile("" : "+v"(zz));
      for (int i = gt; i < 160 * DM / 8; i += F.G * NWAVES * 64) z[i] = (v4u){zz, zz, zz, zz}; }
    if (l == 0) for (int m = gw; m < T; m += NGW) norm_row(INP(I_X) + (size_t)m * DM, WSB(WS_XB) + (size_t)m * DM, (pg8::ssq_t*)(F.ws + WS_RSTD) + m, F.lane);
}
__device__ __forceinline__ void p_final(Frame& F) {
    const int gw = F.bid * NWAVES + F.wave, NGW = F.G * NWAVES;
    for (int m = gw; m < T; m += NGW) {
        const GAS v4u* xr = (const GAS v4u*)(WSB(WS_XB) + (size_t)m * DM) + F.lane; GAS f32x4* orow = (GAS f32x4*)(F.out + (size_t)m * DM) + 2 * F.lane; const GAS f32x4* gr = (const GAS f32x4*)INP(I_FNG) + 2 * F.lane;
        float v[16]; float s = 0.f;
#pragma unroll
        for (int j = 0; j < 2; ++j) { const v4u w = xr[64 * j];
            v[8 * j + 0] = __uint_as_float(w.x << 16); v[8 * j + 1] = __uint_as_float(w.x & 0xffff0000u); v[8 * j + 2] = __uint_as_float(w.y << 16); v[8 * j + 3] = __uint_as_float(w.y & 0xffff0000u);
            v[8 * j + 4] = __uint_as_float(w.z << 16); v[8 * j + 5] = __uint_as_float(w.z & 0xffff0000u); v[8 * j + 6] = __uint_as_float(w.w << 16); v[8 * j + 7] = __uint_as_float(w.w & 0xffff0000u); }
#pragma unroll
        for (int i = 0; i < 16; ++i) s += v[i] * v[i];
        const float rstd = 1.0f / sqrtf(wave_sum(s) * (1.0f / DM) + EPS);
#pragma unroll
        for (int j = 0; j < 2; ++j)
#pragma unroll
            for (int h = 0; h < 2; ++h) { const f32x4 g4 = gr[128 * j + h]; f32x4 o; o.x = v[8 * j + 4 * h] * rstd * g4.x; o.y = v[8 * j + 4 * h + 1] * rstd * g4.y; o.z = v[8 * j + 4 * h + 2] * rstd * g4.z; o.w = v[8 * j + 4 * h + 3] * rstd * g4.w;
                orow[128 * j + h] = o; }
    }
}

__device__ __forceinline__ void kmean_unit(Frame& F, int b, int n) {
    const bf16* kp = WSB(WS_KA) + ((size_t)b * SEQ + (size_t)n * 256) * 512 + F.tid; float s = 0.f;
#pragma unroll 8
    for (int j = 0; j < 256; ++j) s += bf2f(kp[(size_t)j * 512]);
    WSF(WS_KMEAN)[((size_t)b * NBLK + n) * 512 + F.tid] = s * (1.0f / 256.0f);
}
__device__ __forceinline__ float sigmoidf_(float v) { return 1.0f / (1.0f + __expf(-v)); }
typedef short bf16x8_t __attribute__((ext_vector_type(8)));
constexpr int RG_XB_STRIDE = 72;
constexpr int RG_XRAW = 0, RG_YRAW = 2048, RG_XB = 4096, RG_PR = RG_XB + 16 * RG_XB_STRIDE * 2, RG_PI = RG_PR + 16 * 64 * 4, RG_WAVE_LDS = RG_PI + 16 * 64 * 4;
static_assert(8 * RG_WAVE_LDS <= RING_BYTES, "rg LDS");
template <bool P2> __device__ __forceinline__ void rg_unit(Frame& F, int l, int b, int c) {
    int d_ = F.lane; asm volatile("" : "+v"(d_));
    const int n = F.wave, d = d_, ch = n * 64 + d;
    LAS unsigned char* wl = F.lds + RING_OFF + n * RG_WAVE_LDS;
    LAS bf16* xraw = (LAS bf16*)(wl + RG_XRAW); LAS bf16* yraw = (LAS bf16*)(wl + RG_YRAW); LAS bf16* xb = (LAS bf16*)(wl + RG_XB); LAS float* prl = (LAS float*)(wl + RG_PR); LAS float* pil = (LAS float*)(wl + RG_PI);
    const int col = d & 15, kq = d >> 4;
    bf16x8_t wfr[2][4], wfi[2][4];
    { const GAS float* prs = (const GAS float*)INP(I_WR) + (((size_t)l * 8 + n) * 64) * 64 + (8 * kq * 64 + col); const GAS float* pis = (const GAS float*)INP(I_WI) + (((size_t)l * 8 + n) * 64) * 64 + (8 * kq * 64 + col);
#pragma unroll
      for (int ks = 0; ks < 2; ++ks)
#pragma unroll
        for (int nb = 0; nb < 4; ++nb) { float tr[8], ti[8];
#pragma unroll
            for (int j = 0; j < 8; ++j) { const int o = (32 * ks + j) * 64 + 16 * nb; tr[j] = prs[o]; ti[j] = pis[o]; }
            union { bf16x8_t v; unsigned u[4]; } ur, ui;
#pragma unroll
            for (int j = 0; j < 4; ++j) { ur.u[j] = pk2(tr[2 * j], tr[2 * j + 1]); ui.u[j] = pk2(ti[2 * j], ti[2 * j + 1]); }
            wfr[ks][nb] = ur.v; wfi[ks][nb] = ui.v; } }
    const float br = ((const GAS float*)INP(I_BR) + l * 512)[ch], bi = ((const GAS float*)INP(I_BI) + l * 512)[ch];
    const float lamv = ((const GAS float*)INP(I_LAM) + l * 512)[ch]; const float sp = log1pf(__expf(-lamv));
    const GAS float* cwp = (const GAS float*)INP(I_CONVW) + (size_t)l * 4 * 512;
    const float cw0 = cwp[ch], cw1 = cwp[512 + ch], cw2 = cwp[1024 + ch], cw3 = cwp[1536 + ch];
    const float cb = ((const GAS float*)INP(I_CONVB) + l * 512)[ch];
    float h = 0.f, A = 1.f;
    if (P2) { const GAS float* ra = (const GAS float*)WSF(WS_RGA) + (size_t)b * RGC * 512; const GAS float* rh = (const GAS float*)WSF(WS_RGH) + (size_t)b * RGC * 512;
        const GAS float* rap = ra + ch; const GAS float* rhp = rh + ch;
        int j = 0;
#pragma unroll 1
        for (; j + 4 <= c; j += 4) { const float a0 = rap[0], a1 = rap[512], a2 = rap[1024], a3 = rap[1536], h0 = rhp[0], h1 = rhp[512], h2 = rhp[1024], h3 = rhp[1536];
            h = a0 * h + h0; h = a1 * h + h1; h = a2 * h + h2; h = a3 * h + h3; rap += 2048; rhp += 2048; }
#pragma unroll 1
        for (; j < c; ++j) { h = rap[0] * h + rhp[0]; rap += 512; rhp += 512; } }
    const int t0 = c * (SEQ / RGC);
    const GAS bf16* xcs = (const GAS bf16*)WSB(WS_XC) + ((size_t)b * SEQ + t0) * 512;
    GAS bf16* ycs = (GAS bf16*)WSB(WS_YC) + ((size_t)b * SEQ + t0) * 512;
    float x1 = 0.f, x2 = 0.f, x3 = 0.f;
    if (t0 > 0) { const GAS bf16* xm = xcs - 3 * 512; x3 = bf2f(xm[ch]); x2 = bf2f(xm[512 + ch]); x1 = bf2f(xm[1024 + ch]); }
    const int tokA = d >> 3, chk = d & 7;
    const size_t goff = (size_t)tokA * 512 + n * 64 + chk * 8;
    const int loff = tokA * 64 + chk * 8;
#pragma unroll 1
    for (int tile = 0; tile < SEQ / RGC / 16; ++tile) {
        const GAS bf16* xt = xcs + (size_t)tile * 16 * 512 + goff; GAS bf16* yt = ycs + (size_t)tile * 16 * 512 + goff;
        { const v4u a0 = *(const GAS v4u*)xt, a1 = *(const GAS v4u*)(xt + 8 * 512); *(LAS v4u*)(xraw + loff) = a0; *(LAS v4u*)(xraw + loff + 8 * 64) = a1; }
        if (P2) { const v4u a0 = *(const GAS v4u*)yt, a1 = *(const GAS v4u*)(yt + 8 * 512); *(LAS v4u*)(yraw + loff) = a0; *(LAS v4u*)(yraw + loff + 8 * 64) = a1; }
        LDS_WAIT(); asm volatile("" ::: "memory");
        float xc[16];
#pragma unroll
        for (int i = 0; i < 16; ++i) { const float xv = bf2f(xraw[i * 64 + d]); xc[i] = cb + cw0 * x3 + cw1 * x2 + cw2 * x1 + cw3 * xv; x3 = x2; x2 = x1; x1 = xv; }
#pragma unroll
        for (int i = 0; i < 16; ++i) xb[i * RG_XB_STRIDE + d] = (bf16)f2bf(xc[i]);
        LDS_WAIT(); asm volatile("" ::: "memory");
        bf16x8_t af[2];
#pragma unroll
        for (int ks = 0; ks < 2; ++ks) af[ks] = *(const LAS bf16x8_t*)(xb + col * RG_XB_STRIDE + 32 * ks + 8 * kq);
        f32x4 ar[4], ai[4];
#pragma unroll
        for (int nb = 0; nb < 4; ++nb) { ar[nb] = (f32x4){0.f, 0.f, 0.f, 0.f}; ai[nb] = (f32x4){0.f, 0.f, 0.f, 0.f};
#pragma unroll
            for (int ks = 0; ks < 2; ++ks) { ar[nb] = __builtin_amdgcn_mfma_f32_16x16x32_bf16(af[ks], wfr[ks][nb], ar[nb], 0, 0, 0); ai[nb] = __builtin_amdgcn_mfma_f32_16x16x32_bf16(af[ks], wfi[ks][nb], ai[nb], 0, 0, 0); } }
        asm volatile("s_nop 15\n\ts_nop 15" : "+v"(ar[0]), "+v"(ar[1]), "+v"(ar[2]), "+v"(ar[3]), "+v"(ai[0]), "+v"(ai[1]), "+v"(ai[2]), "+v"(ai[3]));
#pragma unroll
        for (int nb = 0; nb < 4; ++nb)
#pragma unroll
            for (int r = 0; r < 4; ++r) { prl[(4 * kq + r) * 64 + 16 * nb + col] = ar[nb][r]; pil[(4 * kq + r) * 64 + 16 * nb + col] = ai[nb][r]; }
        LDS_WAIT(); asm volatile("" ::: "memory");
#pragma unroll
        for (int i = 0; i < 16; ++i) {
            const float r = __builtin_amdgcn_rcpf(1.0f + __expf(-(prl[i * 64 + d] + br))), ig = __builtin_amdgcn_rcpf(1.0f + __expf(-(pil[i * 64 + d] + bi)));
            const float la = -8.0f * r * sp; const float a = __expf(la);
            const float x2a = 2.0f * la;
            const float om = (x2a > -0.05f) ? -x2a * (1.0f + x2a * (0.5f + x2a * (0.16666667f + x2a * 0.041666668f))) : 1.0f - a * a;
            const float u = __builtin_amdgcn_sqrtf(om) * (ig * xc[i]);
            h = a * h + u;
            if (!P2) A *= a;
            else { const float y = bf2f(yraw[i * 64 + d]); const float z = 0.7978845608028654f * (y + 0.044715f * y * y * y);
                const float th = 1.0f - 2.0f * __builtin_amdgcn_rcpf(1.0f + __expf(2.0f * z));
                yraw[i * 64 + d] = (bf16)f2bf(h * (0.5f * y * (1.0f + th))); }
        }
        LDS_WAIT(); asm volatile("" ::: "memory");
        if (P2) { const v4u a0 = *(const LAS v4u*)(yraw + loff), a1 = *(const LAS v4u*)(yraw + loff + 8 * 64); *(GAS v4u*)yt = a0; *(GAS v4u*)(yt + 8 * 512) = a1; }
        LDS_WAIT(); asm volatile("" ::: "memory");
    }
    if (!P2) { const size_t o = ((size_t)b * RGC + c) * 512; ((GAS float*)WSF(WS_RGA) + o)[ch] = A; ((GAS float*)WSF(WS_RGH) + o)[ch] = h; }
    __syncthreads();
}

__device__ __forceinline__ float dot64(const LAS float* qs, const bf16* krow) {
    const v4u* kr = (const v4u*)krow; float s = 0.f;
#pragma unroll
    for (int c = 0; c < 8; ++c) { const v4u w = kr[c]; const f32x4 q0 = *(const LAS f32x4*)(qs + c * 8), q1 = *(const LAS f32x4*)(qs + c * 8 + 4);
        s += q0.x * __uint_as_float(w.x << 16) + q0.y * __uint_as_float(w.x & 0xffff0000u) + q0.z * __uint_as_float(w.y << 16) + q0.w * __uint_as_float(w.y & 0xffff0000u)
           + q1.x * __uint_as_float(w.z << 16) + q1.y * __uint_as_float(w.z & 0xffff0000u) + q1.z * __uint_as_float(w.w << 16) + q1.w * __uint_as_float(w.w & 0xffff0000u); }
    return s;
}
__device__ __forceinline__ void moba_unit(Frame& F, int b, int t) {
    const int h = F.wave, lane = F.lane, cur = t >> 8;
    LAS float* qs = (LAS float*)(F.lds + GL_QS) + h * 64; LAS float* ps = (LAS float*)(F.lds + GL_PS) + h * 1024;
    const size_t row = (size_t)b * SEQ + t;
    bf16* qrow = WSB(WS_QA) + row * 512 + h * 64;
    qs[lane] = bf2f(qrow[lane]);
    LDS_WAIT(); asm volatile("" ::: "memory");
    float g = -1e30f;
    if (lane < cur) { const float* km = WSF(WS_KMEAN) + ((size_t)b * NBLK + lane) * 512 + h * 64; float s = 0.f;
#pragma unroll
        for (int d4 = 0; d4 < 16; ++d4) { const f32x4 kv = *(const f32x4*)(km + d4 * 4); const f32x4 qv = *(const LAS f32x4*)(qs + d4 * 4); s += kv.x * qv.x + kv.y * qv.y + kv.z * qv.z + kv.w * qv.w; }
        g = s; }
    int blk[4]; bool ok[4];
#pragma unroll
    for (int i = 0; i < 3; ++i) { const float m = wave_max(g); const unsigned long long bal = __ballot(g == m); const int sel = __ffsll((long long)bal) - 1; blk[i] = sel; ok[i] = sel < cur; if (lane == sel) g = -INFINITY; }
    blk[3] = cur; ok[3] = true;
    const bf16* Kh = WSB(WS_KA) + ((size_t)b * SEQ) * 512 + h * 64; const bf16* Vh = WSB(WS_VA) + ((size_t)b * SEQ) * 512 + h * 64;
    float lg[16];
#pragma unroll
    for (int i = 0; i < 16; ++i) { const int bi = i >> 2; const int pos = blk[bi] * 256 + (i & 3) * 64 + lane; const bool valid = ok[bi] && pos <= t;
        float s = -1e30f;
        if (valid) s = dot64(qs, Kh + (size_t)pos * 512) * 0.125f + INP(I_RELB)[t5_bucket(t - pos) * 16 + h];
        lg[i] = s; if ((i & 3) == 3) asm volatile("" ::: "memory"); }
    float m = lg[0];
#pragma unroll
    for (int i = 1; i < 16; ++i) m = fmaxf(m, lg[i]);
    m = wave_max(m); float sum = 0.f;
#pragma unroll
    for (int i = 0; i < 16; ++i) { const float e = __expf(lg[i] - m); sum += e; ps[i * 64 + lane] = e; }
    sum = wave_sum(sum);
    LDS_WAIT(); asm volatile("" ::: "memory");
    float acc = 0.f;
#pragma unroll
    for (int bi = 0; bi < 4; ++bi) {
        if (!ok[bi]) continue;
        const int base = blk[bi] * 256; const int nk = (bi == 3) ? (t - base + 1) : 256;
        const bf16* vp = Vh + (size_t)base * 512 + lane; const LAS float* pp = ps + bi * 256;
        int kk = 0;
        for (; kk + 8 <= nk; kk += 8) { float pv[8], vv[8];
#pragma unroll
            for (int j = 0; j < 8; ++j) { pv[j] = pp[kk + j]; vv[j] = bf2f(vp[(size_t)(kk + j) * 512]); }
#pragma unroll
            for (int j = 0; j < 8; ++j) acc += pv[j] * vv[j]; }
        for (; kk < nk; ++kk) acc += pp[kk] * bf2f(vp[(size_t)kk * 512]);
    }
    qrow[lane] = (bf16)f2bf(acc / sum);
}
__device__ __forceinline__ void dsa_unit(Frame& F, int b, int t) {
    const int tid = F.tid, lane = F.lane, h = F.wave;
    LAS unsigned* skey = (LAS unsigned*)(F.lds + GL_SKEY); LAS float* qif = (LAS float*)(F.lds + GL_QIF); LAS float* wq = (LAS float*)(F.lds + GL_WQ);
    LAS unsigned* hist = (LAS unsigned*)(F.lds + GL_HIST); LAS int* sel = (LAS int*)(F.lds + GL_SEL); LAS unsigned* misc = (LAS unsigned*)(F.lds + GL_MISC);
    const size_t row = (size_t)b * SEQ + t; const int n = t + 1;
    __syncthreads();
    qif[tid] = bf2f(WSB(WS_QI)[row * 512 + tid]);
    if (tid < 8) wq[tid] = WSF(WS_WI)[row * 8 + tid];
    if (tid < 16) misc[tid] = 0u;
    __syncthreads();
    if (n > 256) {
        const bf16* kib = WSB(WS_KI) + ((size_t)b * SEQ) * 64;
        for (int s = tid; s < n; s += NWAVES * 64) {
            float kf[64];
            { const v4u* kr = (const v4u*)(kib + (size_t)s * 64);
#pragma unroll
              for (int c = 0; c < 8; ++c) { const v4u w = kr[c]; kf[c * 8 + 0] = __uint_as_float(w.x << 16); kf[c * 8 + 1] = __uint_as_float(w.x & 0xffff0000u); kf[c * 8 + 2] = __uint_as_float(w.y << 16); kf[c * 8 + 3] = __uint_as_float(w.y & 0xffff0000u);
                  kf[c * 8 + 4] = __uint_as_float(w.z << 16); kf[c * 8 + 5] = __uint_as_float(w.z & 0xffff0000u); kf[c * 8 + 6] = __uint_as_float(w.w << 16); kf[c * 8 + 7] = __uint_as_float(w.w & 0xffff0000u); } }
            float score = 0.f;
#pragma unroll 1
            for (int hh = 0; hh < 8; ++hh) { float dsum = 0.f;
#pragma unroll
                for (int d4 = 0; d4 < 16; ++d4) { const f32x4 q = *(const LAS f32x4*)(qif + hh * 64 + d4 * 4); dsum += q.x * kf[d4 * 4] + q.y * kf[d4 * 4 + 1] + q.z * kf[d4 * 4 + 2] + q.w * kf[d4 * 4 + 3]; }
                score += wq[hh] * fmaxf(dsum, 0.f); asm volatile("" ::: "memory"); }
            score *= 0.04419417382415922f;
            if (score == 0.f) score = 0.f;
            const unsigned u = __float_as_uint(score);
            skey[s] = (u & 0x80000000u) ? ~u : (u | 0x80000000u);
        }
        __syncthreads();
        unsigned prefix = 0u; unsigned kneed = 256u, neq = 0u;
#pragma unroll
        for (int pass = 0; pass < 4; ++pass) {
            const int shift = 24 - 8 * pass;
            if (tid < 256) hist[tid] = 0u;
            __syncthreads();
            for (int s = tid; s < n; s += NWAVES * 64) { const unsigned key = skey[s]; const bool match = (pass == 0) ? true : ((key >> ((shift + 8) & 31)) == prefix);
                if (match) __hip_atomic_fetch_add(hist + ((key >> shift) & 255u), 1u, __ATOMIC_RELAXED, __HIP_MEMORY_SCOPE_WORKGROUP); }
            __syncthreads();
            if (h == 0) {
                const unsigned c0 = hist[4 * lane], c1 = hist[4 * lane + 1], c2 = hist[4 * lane + 2], c3 = hist[4 * lane + 3]; const unsigned tot = c0 + c1 + c2 + c3;
                unsigned S = tot;
#pragma unroll
                for (int o = 1; o < 64; o <<= 1) { const unsigned v = __shfl_down(S, o); if (lane + o < 64) S += v; }
                const unsigned above = S - tot;
                if (above < kneed && kneed <= S) { unsigned a = above; unsigned bsel, cnt;
                    if (a + c3 >= kneed) { bsel = 3; cnt = c3; } else { a += c3; if (a + c2 >= kneed) { bsel = 2; cnt = c2; } else { a += c2; if (a + c1 >= kneed) { bsel = 1; cnt = c1; } else { a += c1; bsel = 0; cnt = c0; } } }
                    misc[0] = 4u * lane + bsel; misc[1] = kneed - a; misc[2] = cnt; }
            }
            __syncthreads();
            prefix = (prefix << 8) | misc[0]; kneed = misc[1]; neq = misc[2];
            __syncthreads();
        }
        const unsigned Tk = prefix;
        for (int s = tid; s < n; s += NWAVES * 64) { const unsigned key = skey[s];
            if (key > Tk || (key == Tk && neq == kneed)) { const unsigned idx = __hip_atomic_fetch_add(misc + 8, 1u, __ATOMIC_RELAXED, __HIP_MEMORY_SCOPE_WORKGROUP); if (idx < 256u) sel[idx] = s; } }
        __syncthreads();
        if (neq != kneed && tid == 0) { unsigned c = misc[8]; unsigned need = kneed; for (int s = 0; s < n && need > 0u && c < 256u; ++s) if (skey[s] == Tk) { sel[c++] = s; --need; } }
    } else {
        if (tid < 256) sel[tid] = (tid <= t) ? tid : -1;
    }
    __syncthreads();
    LAS float* qs = (LAS float*)(F.lds + GL_QS) + h * 64; LAS float* ps = (LAS float*)(F.lds + GL_PS) + h * 1024;
    bf16* qrow = WSB(WS_QB) + row * 512 + h * 64;
    qs[lane] = bf2f(qrow[lane]);
    LDS_WAIT(); asm volatile("" ::: "memory");
    const bf16* Kh = WSB(WS_KB) + ((size_t)b * SEQ) * 512 + h * 64; const bf16* Vh = WSB(WS_VB) + ((size_t)b * SEQ) * 512 + h * 64;
    float lg[4];
#pragma unroll
    for (int i = 0; i < 4; ++i) { const int pos = sel[i * 64 + lane]; float s = -1e30f;
        if (pos >= 0) s = dot64(qs, Kh + (size_t)pos * 512) * 0.125f + INP(I_RELB)[t5_bucket(t - pos) * 16 + 8 + h];
        lg[i] = s; }
    float m = wave_max(fmaxf(fmaxf(lg[0], lg[1]), fmaxf(lg[2], lg[3]))); float sum = 0.f;
#pragma unroll
    for (int i = 0; i < 4; ++i) { const float e = __expf(lg[i] - m); sum += e; ps[i * 64 + lane] = e; }
    sum = wave_sum(sum);
    LDS_WAIT(); asm volatile("" ::: "memory");
    float acc = 0.f; const int nk = n < 256 ? n : 256;
    int kk = 0;
    for (; kk + 8 <= nk; kk += 8) { float pv[8], vv[8];
#pragma unroll
        for (int j = 0; j < 8; ++j) { const int pos = sel[kk + j]; pv[j] = ps[kk + j]; vv[j] = bf2f(Vh[(size_t)pos * 512 + lane]); }
#pragma unroll
        for (int j = 0; j < 8; ++j) acc += pv[j] * vv[j]; }
    for (; kk < nk; ++kk) { const int pos = sel[kk]; acc += ps[kk] * bf2f(Vh[(size_t)pos * 512 + lane]); }
    qrow[lane] = (bf16)f2bf(acc / sum);
}

typedef float f32x16 __attribute__((ext_vector_type(16)));
constexpr int AT_KROW = 144, AT_VROW = 136;
constexpr int AT_KBUF = 64 * AT_KROW, AT_VBUF = 64 * AT_VROW;
constexpr int AT_K0 = 0, AT_V0 = 2 * AT_KBUF, AT_BT = 36864, AT_OST = 40960;
constexpr float AT_C2 = 0.125f * 1.4426950408889634f;
constexpr float AT_THR = 8.0f;
constexpr float LOG2E = 1.4426950408889634f;
__device__ __forceinline__ int crow_(int r, int hi) { return (r & 3) + 8 * (r >> 2) + 4 * hi; }
#define MFMA_FENCE2(a, b) asm volatile("s_nop 15\n\ts_nop 15" : "+v"(a), "+v"(b))

__device__ __forceinline__ void at_load(const GAS bf16* Kh, const GAS bf16* Vh, int tile, int tid, v4u& kr, v4u& vr) {
    kr = *(const GAS v4u*)(Kh + (size_t)(tile * 64 + (tid >> 3)) * 512 + (tid & 7) * 8);
    vr = *(const GAS v4u*)(Vh + (size_t)(tile * 64 + (tid >> 3)) * 512 + (tid & 7) * 8);
}
__device__ __forceinline__ void at_store(LAS unsigned char* kb, LAS unsigned char* vb, int tid, const v4u kr, const v4u vr) {
    *(LAS v4u*)(kb + (tid >> 3) * AT_KROW + (tid & 7) * 16) = kr;
    LAS bf16* vt = (LAS bf16*)(vb + ((tid & 7) * 8) * AT_VROW) + (tid >> 3);
    constexpr int RS = AT_VROW / 2;
    vt[0 * RS] = (bf16)(vr.x & 0xffffu); vt[1 * RS] = (bf16)(vr.x >> 16); vt[2 * RS] = (bf16)(vr.y & 0xffffu); vt[3 * RS] = (bf16)(vr.y >> 16);
    vt[4 * RS] = (bf16)(vr.z & 0xffffu); vt[5 * RS] = (bf16)(vr.z >> 16); vt[6 * RS] = (bf16)(vr.w & 0xffffu); vt[7 * RS] = (bf16)(vr.w >> 16);
}
__device__ __forceinline__ void at_qk(f32x16& p0, f32x16& p1, const LAS unsigned char* kb, const bf16x8_t (&qf)[4], int r32, int hi) {
    const LAS unsigned char* kp = kb + r32 * AT_KROW + hi * 16;
    bf16x8_t k0[4], k1[4];
#pragma unroll
    for (int s = 0; s < 4; ++s) { k0[s] = *(const LAS bf16x8_t*)(kp + s * 32); k1[s] = *(const LAS bf16x8_t*)(kp + 32 * AT_KROW + s * 32); }
    asm volatile("s_waitcnt lgkmcnt(0)" : "+v"(k0[0]), "+v"(k0[1]), "+v"(k0[2]), "+v"(k0[3]), "+v"(k1[0]), "+v"(k1[1]), "+v"(k1[2]), "+v"(k1[3]) :: "memory");
#pragma unroll
    for (int s = 0; s < 4; ++s) { p0 = __builtin_amdgcn_mfma_f32_32x32x16_bf16(k0[s], qf[s], p0, 0, 0, 0); p1 = __builtin_amdgcn_mfma_f32_32x32x16_bf16(k1[s], qf[s], p1, 0, 0, 0); }
}
__device__ __forceinline__ void at_qk_m(f32x16& p0, f32x16& p1, const LAS unsigned char* kb, const bf16x8_t (&qf)[4], const bf16x8_t oneA, const bf16x8_t mB, int r32, int hi) {
    const LAS unsigned char* kp = kb + r32 * AT_KROW + hi * 16;
    bf16x8_t k0[4], k1[4];
#pragma unroll
    for (int s = 0; s < 4; ++s) { k0[s] = *(const LAS bf16x8_t*)(kp + s * 32); k1[s] = *(const LAS bf16x8_t*)(kp + 32 * AT_KROW + s * 32); }
    p0 = __builtin_amdgcn_mfma_f32_32x32x16_bf16(oneA, mB, p0, 0, 0, 0); p1 = __builtin_amdgcn_mfma_f32_32x32x16_bf16(oneA, mB, p1, 0, 0, 0);
    asm volatile("s_waitcnt lgkmcnt(0)" : "+v"(k0[0]), "+v"(k0[1]), "+v"(k0[2]), "+v"(k0[3]), "+v"(k1[0]), "+v"(k1[1]), "+v"(k1[2]), "+v"(k1[3]) :: "memory");
#pragma unroll
    for (int s = 0; s < 4; ++s) { p0 = __builtin_amdgcn_mfma_f32_32x32x16_bf16(k0[s], qf[s], p0, 0, 0, 0); p1 = __builtin_amdgcn_mfma_f32_32x32x16_bf16(k1[s], qf[s], p1, 0, 0, 0); }
}
__device__ __forceinline__ void at_pv(f32x16& o0, f32x16& o1, const LAS unsigned char* vb, const bf16x8_t (&pb)[4], int r32, int hi) {
    const LAS unsigned char* vp = vb + r32 * AT_VROW + hi * 8;
    union U { bf16x8_t v; unsigned long long u[2]; }; U a0[4], a1[4];
#pragma unroll
    for (int sg = 0; sg < 4; ++sg) { const int kvo = (32 * (sg >> 1) + 16 * (sg & 1)) * 2;
        a0[sg].u[0] = *(const LAS unsigned long long*)(vp + kvo); a0[sg].u[1] = *(const LAS unsigned long long*)(vp + kvo + 16);
        a1[sg].u[0] = *(const LAS unsigned long long*)(vp + 32 * AT_VROW + kvo); a1[sg].u[1] = *(const LAS unsigned long long*)(vp + 32 * AT_VROW + kvo + 16); }
    asm volatile("s_waitcnt lgkmcnt(0)" : "+v"(a0[0].v), "+v"(a0[1].v), "+v"(a0[2].v), "+v"(a0[3].v), "+v"(a1[0].v), "+v"(a1[1].v), "+v"(a1[2].v), "+v"(a1[3].v) :: "memory");
#pragma unroll
    for (int sg = 0; sg < 4; ++sg) { o0 = __builtin_amdgcn_mfma_f32_32x32x16_bf16(a0[sg].v, pb[sg], o0, 0, 0, 0); o1 = __builtin_amdgcn_mfma_f32_32x32x16_bf16(a1[sg].v, pb[sg], o1, 0, 0, 0); }
}
__device__ __forceinline__ float max3_(float a, float b, float c) { float r; asm("v_max3_f32 %0, %1, %2, %3" : "=v"(r) : "v"(a), "v"(b), "v"(c)); return r; }
__device__ __forceinline__ unsigned and_sel(float p, unsigned w, int bit) { int t; asm("v_bfe_i32 %0, %1, %2, 1" : "=v"(t) : "v"(w), "n"(bit)); return __float_as_uint(p) & (unsigned)t; }

template <int MODE  , bool DRY = false  >
__device__ __forceinline__ void attn_unit(Frame& F, int b, int h, int qt) {
    int tid_ = F.tid; asm volatile("" : "+v"(tid_));
    const int tid = tid_, lane = tid & 63, wave = F.wave, r32 = lane & 31, hi = lane >> 5;
    LAS unsigned char* L = F.lds + RING_OFF;
    LAS float* bt = (LAS float*)(L + AT_BT);
    const GAS bf16* Qg = (const GAS bf16*)WSB(MODE == 0 ? WS_QA : WS_QB); const GAS bf16* Kg = (const GAS bf16*)WSB(MODE == 0 ? WS_KA : WS_KB); const GAS bf16* Vg = (const GAS bf16*)WSB(MODE == 0 ? WS_VA : WS_VB);
    const size_t rowb = (size_t)b * SEQ;
    const GAS bf16* Kh = Kg + rowb * 512 + h * 64; const GAS bf16* Vh = Vg + rowb * 512 + h * 64;
    const int q0w = qt * 256 + wave * 32, q = q0w + r32;
    const int NT = 4 * qt + 4;
    __syncthreads();
    if (tid < 128) { const GAS float* rb = (const GAS float*)INP(I_RELB) + (MODE * 8 + h); bt[tid] = (rb[t5_bucket(tid) * 16] - rb[31 * 16]) * LOG2E; }
    bf16x8_t qf[4];
    { const GAS bf16* qp = Qg + (rowb + q) * 512 + h * 64 + hi * 8;
#pragma unroll
      for (int s = 0; s < 4; ++s) qf[s] = *(const GAS bf16x8_t*)(qp + s * 16); }
    unsigned mlo = 0u, mhi = 0u;
    if (MODE == 0) {
        { const int n = tid >> 3, c8 = (tid & 7) * 8; const GAS float* km = (const GAS float*)WSF(WS_KMEAN) + ((size_t)b * NBLK + n) * 512 + h * 64 + c8;
          const f32x4 a = *(const GAS f32x4*)km, c = *(const GAS f32x4*)(km + 4);
          const unsigned h0 = pk2(a.x, a.y), h1 = pk2(a.z, a.w), h2 = pk2(c.x, c.y), h3 = pk2(c.z, c.w);
          const unsigned l0 = pk2(a.x - __uint_as_float(h0 << 16), a.y - __uint_as_float(h0 & 0xffff0000u)), l1 = pk2(a.z - __uint_as_float(h1 << 16), a.w - __uint_as_float(h1 & 0xffff0000u)),
                         l2 = pk2(c.x - __uint_as_float(h2 << 16), c.y - __uint_as_float(h2 & 0xffff0000u)), l3 = pk2(c.z - __uint_as_float(h3 << 16), c.w - __uint_as_float(h3 & 0xffff0000u));
          *(LAS v4u*)(L + AT_K0 + n * AT_KROW + (tid & 7) * 16) = (v4u){h0, h1, h2, h3}; *(LAS v4u*)(L + AT_K0 + AT_KBUF + n * AT_KROW + (tid & 7) * 16) = (v4u){l0, l1, l2, l3}; }
        __syncthreads();
        f32x16 g0 = {0.f, 0.f, 0.f, 0.f, 0.f, 0.f, 0.f, 0.f, 0.f, 0.f, 0.f, 0.f, 0.f, 0.f, 0.f, 0.f}, g1 = g0;
        at_qk(g0, g1, L + AT_K0, qf, r32, hi); at_qk(g0, g1, L + AT_K0 + AT_KBUF, qf, r32, hi);
        MFMA_FENCE2(g0, g1);
#pragma unroll
        for (int r = 0; r < 16; ++r) { if (crow_(r, hi) >= qt) g0[r] = -INFINITY; if (32 + crow_(r, hi) >= qt) g1[r] = -INFINITY; }
#pragma unroll
        for (int it = 0; it < 3; ++it) {
            float bv = -INFINITY; int bn = 64;
#pragma unroll
            for (int r = 0; r < 16; ++r) if (g0[r] > bv) { bv = g0[r]; bn = crow_(r, hi); }
#pragma unroll
            for (int r = 0; r < 16; ++r) if (g1[r] > bv) { bv = g1[r]; bn = 32 + crow_(r, hi); }
            const float pv = __shfl_xor(bv, 32); const int pn = __shfl_xor(bn, 32);
            const bool tp = (pv > bv) || (pv == bv && pn < bn);
            const float wv = tp ? pv : bv; const int wn = tp ? pn : bn;
            if (wv > -INFINITY) { if (wn < 32) mlo |= 1u << wn; else mhi |= 1u << (wn - 32); }
#pragma unroll
            for (int r = 0; r < 16; ++r) { if (crow_(r, hi) == wn) g0[r] = -INFINITY; if (32 + crow_(r, hi) == wn) g1[r] = -INFINITY; }
        }
        __syncthreads();
    }
    v4u krA, vrA, krB, vrB; unsigned wlA = 0u, whA = 0u, wlB = 0u, whB = 0u;
    const GAS unsigned* mrow = (const GAS unsigned*)(F.ws + WS_MASK) + (rowb + q) * 512;
    at_load(Kh, Vh, 0, tid, krA, vrA);
    unsigned wl_c = 0u, wh_c = 0u;
    if (MODE == 1) { wl_c = mrow[0]; wh_c = mrow[1]; }
    at_store(L + AT_K0, L + AT_V0, tid, krA, vrA);
    at_load(Kh, Vh, 1, tid, krA, vrA);
    if (MODE == 1) { wlA = mrow[2]; whA = mrow[3]; }
    __syncthreads();
    float m = -1e30f, lsum = 0.f;
    f32x16 o0 = {0.f, 0.f, 0.f, 0.f, 0.f, 0.f, 0.f, 0.f, 0.f, 0.f, 0.f, 0.f, 0.f, 0.f, 0.f, 0.f}, o1 = o0;
    auto step = [&](int t, v4u& krS, v4u& vrS, unsigned& wlS, unsigned& whS, v4u& krN, v4u& vrN, unsigned& wlN, unsigned& whN) __attribute__((always_inline)) {
        const int cur = t & 1;
        unsigned wlo = wl_c, whi = wh_c;
        if (t + 2 < NT) { at_load(Kh, Vh, t + 2, tid, krN, vrN); if (MODE == 1) { wlN = mrow[2 * (t + 2)]; whN = mrow[2 * (t + 2) + 1]; } }
        if (MODE == 0) {
            if (t < 4 * qt) { const int blk = t >> 2; const unsigned bit = (blk < 32 ? (mlo >> blk) : (mhi >> (blk - 32))) & 1u; wlo = whi = bit ? 0xffffffffu : 0u; }
            else { const int nall = q - t * 64 + 1;
                wlo = nall >= 32 ? 0xffffffffu : (nall <= 0 ? 0u : ((1u << nall) - 1u)); whi = nall >= 64 ? 0xffffffffu : (nall <= 32 ? 0u : ((1u << (nall - 32)) - 1u)); }
        }
        if (__any((wlo | whi) != 0u)) {
            const LAS unsigned char* kb = L + AT_K0 + cur * AT_KBUF; const LAS unsigned char* vb = L + AT_V0 + cur * AT_VBUF;
            const bool and_mask = (MODE == 1) || (t >= 4 * qt);
            const float ci = (!and_mask && wlo == 0u) ? -1e9f : 0.f;
            f32x16 p0 = {ci, ci, ci, ci, ci, ci, ci, ci, ci, ci, ci, ci, ci, ci, ci, ci}, p1 = p0;
            at_qk(p0, p1, kb, qf, r32, hi);
            MFMA_FENCE2(p0, p1);
            const bool near = (t * 64 + 191 > q0w);
            float mx; float sc = AT_C2;
            if (near) {
#pragma unroll
                for (int r = 0; r < 16; ++r) { const int d0 = q - (t * 64 + crow_(r, hi)), d1 = d0 - 32;
                    const float b0 = ((unsigned)d0 < 128u) ? bt[d0] : 0.f, b1 = ((unsigned)d1 < 128u) ? bt[d1] : 0.f;
                    p0[r] = p0[r] * AT_C2 + b0; p1[r] = p1[r] * AT_C2 + b1; }
                sc = 1.0f;
            }
            { float ma = max3_(p0[0], p1[0], p0[1]), mb = max3_(p1[1], p0[2], p1[2]), mc = max3_(p0[3], p1[3], p0[4]), md = max3_(p1[4], p0[5], p1[5]);
              ma = max3_(ma, p0[6], p1[6]); mb = max3_(mb, p0[7], p1[7]); mc = max3_(mc, p0[8], p1[8]); md = max3_(md, p0[9], p1[9]);
              ma = max3_(ma, p0[10], p1[10]); mb = max3_(mb, p0[11], p1[11]); mc = max3_(mc, p0[12], p1[12]); md = max3_(md, p0[13], p1[13]);
              ma = max3_(ma, p0[14], p1[14]); mb = max3_(mb, p0[15], p1[15]); mx = max3_(ma, mb, mc); mx = max3_(mx, md, md); }
            mx = max3_(mx, __shfl_xor(mx, 32), mx) * sc;
            if (__any(mx > m + AT_THR)) {
                const float mn = fmaxf(m, mx); const float al = __builtin_amdgcn_exp2f(m - mn);
                MFMA_FENCE2(o0, o1);
#pragma unroll
                for (int r = 0; r < 16; ++r) { o0[r] *= al; o1[r] *= al; }
                lsum *= al; m = mn;
            }
            float ls = 0.f;
            if (and_mask) {
                const unsigned wl = wlo >> (4 * hi), wh = whi >> (4 * hi);
                float lq[4] = {0.f, 0.f, 0.f, 0.f};
#pragma unroll
                for (int r = 0; r < 16; ++r) { const int cb = (r & 3) + 8 * (r >> 2);
                    const float e0 = __uint_as_float(and_sel(__builtin_amdgcn_exp2f(__builtin_fmaf(p0[r], sc, -m)), wl, cb)), e1 = __uint_as_float(and_sel(__builtin_amdgcn_exp2f(__builtin_fmaf(p1[r], sc, -m)), wh, cb));
                    p0[r] = e0; p1[r] = e1; lq[r & 1] += e0; lq[2 + (r & 1)] += e1; }
                ls = (lq[0] + lq[1]) + (lq[2] + lq[3]);
            } else {
#pragma unroll
                for (int r = 0; r < 16; ++r) { const float e0 = __builtin_amdgcn_exp2f(__builtin_fmaf(p0[r], sc, -m)), e1 = __builtin_amdgcn_exp2f(__builtin_fmaf(p1[r], sc, -m));
                    p0[r] = e0; p1[r] = e1; ls += e0 + e1; }
            }
            lsum += ls;
            bf16x8_t pb[4];
#pragma unroll
            for (int sg = 0; sg < 4; ++sg) { union { bf16x8_t v; unsigned u[4]; } pk;
#pragma unroll
                for (int j = 0; j < 4; ++j) { const int r = 8 * (sg & 1) + 2 * j; pk.u[j] = (sg < 2) ? pg8::cvt_pk_bf16(p0[r], p0[r + 1]) : pg8::cvt_pk_bf16(p1[r], p1[r + 1]); }
                pb[sg] = pk.v; }
            at_pv(o0, o1, vb, pb, r32, hi);
        }
        if (t + 1 < NT) at_store(L + AT_K0 + (cur ^ 1) * AT_KBUF, L + AT_V0 + (cur ^ 1) * AT_VBUF, tid, krS, vrS);
        wl_c = wlS; wh_c = whS;
        __syncthreads();
    };
#pragma unroll 1
    for (int t = 0; t < NT; t += 2) {
        step(t, krA, vrA, wlA, whA, krB, vrB, wlB, whB);
        step(t + 1, krB, vrB, wlB, whB, krA, vrA, wlA, whA);
    }
    MFMA_FENCE2(o0, o1);
    lsum += __shfl_xor(lsum, 32);
    const float inv = 1.0f / lsum;
    LAS bf16* ost = (LAS bf16*)(L + AT_OST + wave * 4096);
#pragma unroll
    for (int r = 0; r < 16; ++r) { ost[r32 * 64 + crow_(r, hi)] = (bf16)f2bf(o0[r] * inv); ost[r32 * 64 + 32 + crow_(r, hi)] = (bf16)f2bf(o1[r] * inv); }
    LDS_WAIT(); asm volatile("" ::: "memory");
    GAS bf16* Og = (GAS bf16*)WSB(MODE == 0 ? WS_QA : WS_QB) + (rowb + q0w) * 512 + h * 64;
#pragma unroll
    for (int i = 0; i < 4; ++i) { const int c = i * 64 + lane, row = c >> 3, ch = c & 7; const v4u ov = *(const LAS v4u*)(ost + row * 64 + ch * 8); if (!DRY) *(GAS v4u*)(Og + (size_t)row * 512 + ch * 8) = ov; else if (ov.x == 0x12345678u && ov.y == 0x9abcdef0u) *(GAS v4u*)(Og + (size_t)row * 512 + ch * 8) = ov; }
}

constexpr int DA_K0 = 0, DA_V0 = 3 * AT_KBUF, DA_BT = DA_V0 + 2 * AT_VBUF, DA_OST = 49152;
static_assert(DA_BT + 512 <= DA_OST && DA_OST + 8 * 4096 <= RING_BYTES, "dsa attention LDS map");
__device__ __forceinline__ v4u at_load_k(const GAS bf16* Kh, int tile, int tid) { return *(const GAS v4u*)(Kh + (size_t)(tile * 64 + (tid >> 3)) * 512 + (tid & 7) * 8); }
__device__ __forceinline__ v4u at_load_v(const GAS bf16* Vh, int tile, int tid) { return *(const GAS v4u*)(Vh + (size_t)(tile * 64 + (tid & 63)) * 512 + (tid >> 6) * 8); }
__device__ __forceinline__ void at_store_k(LAS unsigned char* kb, int tid, const v4u kr) { *(LAS v4u*)(kb + (tid >> 3) * AT_KROW + (tid & 7) * 16) = kr; }
__device__ __forceinline__ void at_store_v(LAS unsigned char* vb, int tid, const v4u vr) {
    LAS bf16* vt = (LAS bf16*)(vb + ((tid >> 6) * 8) * AT_VROW) + (tid & 63); constexpr int RS = AT_VROW / 2;
    vt[0 * RS] = (bf16)(vr.x & 0xffffu); vt[1 * RS] = (bf16)(vr.x >> 16); vt[2 * RS] = (bf16)(vr.y & 0xffffu); vt[3 * RS] = (bf16)(vr.y >> 16);
    vt[4 * RS] = (bf16)(vr.z & 0xffffu); vt[5 * RS] = (bf16)(vr.z >> 16); vt[6 * RS] = (bf16)(vr.w & 0xffffu); vt[7 * RS] = (bf16)(vr.w >> 16);
}
struct DsaState { float m, lsum; f32x16 o0, o1; unsigned wc_lo, wc_hi, wn_lo, wn_hi; };
__device__ __forceinline__ void dsa_step(DsaState& S, f32x16& P0, f32x16& P1, f32x16& Pn0, f32x16& Pn1, int t, int NT, LAS unsigned char* L, const LAS float* bt, const bf16x8_t (&qf)[4],
                                         const GAS bf16* Kh, const GAS bf16* Vh, const GAS unsigned* mrow, int tid, int r32, int hi, int q, int q0w) {
    v4u krn, vrn; unsigned wq_lo = 0u, wq_hi = 0u;
    const bool has1 = (t + 1 < NT), has2 = (t + 2 < NT);
    if (has2) { krn = at_load_k(Kh, t + 2, tid); wq_lo = mrow[2 * (t + 2)]; wq_hi = mrow[2 * (t + 2) + 1]; }
    if (has1) vrn = at_load_v(Vh, t + 1, tid);
    if (has1 && __any((S.wn_lo | S.wn_hi) != 0u)) {
        Pn0 = (f32x16){0.f, 0.f, 0.f, 0.f, 0.f, 0.f, 0.f, 0.f, 0.f, 0.f, 0.f, 0.f, 0.f, 0.f, 0.f, 0.f}; Pn1 = Pn0;
        at_qk(Pn0, Pn1, L + DA_K0 + ((t + 1) % 3) * AT_KBUF, qf, r32, hi);
    }
    if (__any((S.wc_lo | S.wc_hi) != 0u)) {
        const LAS unsigned char* vb = L + DA_V0 + (t & 1) * AT_VBUF;
        MFMA_FENCE2(P0, P1);
        const bool near = (t * 64 + 191 > q0w);
        float sc = AT_C2;
        if (near) {
#pragma unroll
            for (int r = 0; r < 16; ++r) { const int d0 = q - (t * 64 + crow_(r, hi)), d1 = d0 - 32;
                const float b0 = ((unsigned)d0 < 128u) ? bt[d0] : 0.f, b1 = ((unsigned)d1 < 128u) ? bt[d1] : 0.f;
                P0[r] = P0[r] * AT_C2 + b0; P1[r] = P1[r] * AT_C2 + b1; }
            sc = 1.0f;
        }
        float mx = max3_(P0[0], P1[0], P0[1]), mx2 = max3_(P1[1], P0[2], P1[2]);
#pragma unroll
        for (int r = 3; r < 15; r += 2) { mx = max3_(mx, P0[r], P1[r]); mx2 = max3_(mx2, P0[r + 1], P1[r + 1]); }
        mx = max3_(mx, P0[15], P1[15]); mx = max3_(mx, mx2, mx2);
        mx = max3_(mx, __shfl_xor(mx, 32), mx) * sc;
        if (__any(mx > S.m + AT_THR)) {
            const float mn = fmaxf(S.m, mx); const float al = __builtin_amdgcn_exp2f(S.m - mn);
            MFMA_FENCE2(S.o0, S.o1);
#pragma unroll
            for (int r = 0; r < 16; ++r) { S.o0[r] *= al; S.o1[r] *= al; }
            S.lsum *= al; S.m = mn;
        }
        const unsigned wl = S.wc_lo >> (4 * hi), wh = S.wc_hi >> (4 * hi); const float m = S.m;
        float ls = 0.f;
#pragma unroll
        for (int r = 0; r < 16; ++r) { const int cb = (r & 3) + 8 * (r >> 2);
            const float e0 = __uint_as_float(and_sel(__builtin_amdgcn_exp2f(__builtin_fmaf(P0[r], sc, -m)), wl, cb)), e1 = __uint_as_float(and_sel(__builtin_amdgcn_exp2f(__builtin_fmaf(P1[r], sc, -m)), wh, cb));
            P0[r] = e0; P1[r] = e1; ls += e0 + e1; }
        S.lsum += ls;
        bf16x8_t pb[4];
#pragma unroll
        for (int sg = 0; sg < 4; ++sg) { union { bf16x8_t v; unsigned u[4]; } pk;
#pragma unroll
            for (int j = 0; j < 4; ++j) { const int r = 8 * (sg & 1) + 2 * j; pk.u[j] = (sg < 2) ? pg8::cvt_pk_bf16(P0[r], P0[r + 1]) : pg8::cvt_pk_bf16(P1[r], P1[r + 1]); }
            pb[sg] = pk.v; }
        at_pv(S.o0, S.o1, vb, pb, r32, hi);
    }
    if (has2) at_store_k(L + DA_K0 + ((t + 2) % 3) * AT_KBUF, tid, krn);
    if (has1) at_store_v(L + DA_V0 + ((t + 1) & 1) * AT_VBUF, tid, vrn);
    S.wc_lo = S.wn_lo; S.wc_hi = S.wn_hi; S.wn_lo = wq_lo; S.wn_hi = wq_hi;
    __syncthreads();
}
template <bool DRY = false> __device__ __forceinline__ void dsa_attn_unit(Frame& F, int b, int h, int qt) {
    int tid_ = F.tid; asm volatile("" : "+v"(tid_));
    const int tid = tid_, lane = tid & 63, wave = F.wave, r32 = lane & 31, hi = lane >> 5;
    LAS unsigned char* L = F.lds + RING_OFF;
    LAS float* bt = (LAS float*)(L + DA_BT);
    const size_t rowb = (size_t)b * SEQ;
    const GAS bf16* Kh = (const GAS bf16*)WSB(WS_KB) + rowb * 512 + h * 64; const GAS bf16* Vh = (const GAS bf16*)WSB(WS_VB) + rowb * 512 + h * 64;
    const int q0w = qt * 256 + wave * 32, q = q0w + r32;
    const int NT = 4 * qt + 4;
    __syncthreads();
    if (tid < 128) { const GAS float* rb = (const GAS float*)INP(I_RELB) + (8 + h); bt[tid] = (rb[t5_bucket(tid) * 16] - rb[31 * 16]) * LOG2E; }
    bf16x8_t qf[4];
    { const GAS bf16* qp = (const GAS bf16*)WSB(WS_QB) + (rowb + q) * 512 + h * 64 + hi * 8;
#pragma unroll
      for (int s = 0; s < 4; ++s) qf[s] = *(const GAS bf16x8_t*)(qp + s * 16); }
    const GAS unsigned* mrow = (const GAS unsigned*)(F.ws + WS_MASK) + (rowb + q) * 512;
    DsaState S; S.m = -1e30f; S.lsum = 0.f; S.o0 = (f32x16){0.f, 0.f, 0.f, 0.f, 0.f, 0.f, 0.f, 0.f, 0.f, 0.f, 0.f, 0.f, 0.f, 0.f, 0.f, 0.f}; S.o1 = S.o0;
    S.wc_lo = mrow[0]; S.wc_hi = mrow[1]; S.wn_lo = mrow[2]; S.wn_hi = mrow[3];
    { const v4u k0 = at_load_k(Kh, 0, tid), v0 = at_load_v(Vh, 0, tid), k1 = at_load_k(Kh, 1, tid);
      at_store_k(L + DA_K0, tid, k0); at_store_v(L + DA_V0, tid, v0); at_store_k(L + DA_K0 + AT_KBUF, tid, k1); }
    __syncthreads();
    f32x16 pA0 = {0.f, 0.f, 0.f, 0.f, 0.f, 0.f, 0.f, 0.f, 0.f, 0.f, 0.f, 0.f, 0.f, 0.f, 0.f, 0.f}, pA1 = pA0, pB0 = pA0, pB1 = pA0;
    if (__any((S.wc_lo | S.wc_hi) != 0u)) at_qk(pA0, pA1, L + DA_K0, qf, r32, hi);
#pragma unroll 1
    for (int t = 0; t < NT; t += 2) {
        dsa_step(S, pA0, pA1, pB0, pB1, t, NT, L, bt, qf, Kh, Vh, mrow, tid, r32, hi, q, q0w);
        dsa_step(S, pB0, pB1, pA0, pA1, t + 1, NT, L, bt, qf, Kh, Vh, mrow, tid, r32, hi, q, q0w);
    }
    MFMA_FENCE2(S.o0, S.o1);
    float lsum = S.lsum; lsum += __shfl_xor(lsum, 32);
    const float inv = 1.0f / lsum;
    LAS bf16* ost = (LAS bf16*)(L + DA_OST + wave * 4096);
#pragma unroll
    for (int r = 0; r < 16; ++r) { ost[r32 * 64 + crow_(r, hi)] = (bf16)f2bf(S.o0[r] * inv); ost[r32 * 64 + 32 + crow_(r, hi)] = (bf16)f2bf(S.o1[r] * inv); }
    LDS_WAIT(); asm volatile("" ::: "memory");
    GAS bf16* Og = (GAS bf16*)WSB(WS_QB) + (rowb + q0w) * 512 + h * 64;
#pragma unroll
    for (int i = 0; i < 4; ++i) { const int c = i * 64 + lane, row = c >> 3, ch = c & 7; const v4u ov = *(const LAS v4u*)(ost + row * 64 + ch * 8); if (!DRY) *(GAS v4u*)(Og + (size_t)row * 512 + ch * 8) = ov; else if (ov.x == 0x12345678u && ov.y == 0x9abcdef0u) *(GAS v4u*)(Og + (size_t)row * 512 + ch * 8) = ov; }
}

constexpr int A2_TILE = 64 * 128;
__device__ __forceinline__ void at2_dma(const GAS bf16* Kh, const GAS bf16* Vh, int tile, int wave, int lane, LAS unsigned char* kb, LAS unsigned char* vb) {
    const int row = 8 * wave + (lane >> 3), p = lane & 7;
    const GAS bf16* kg = Kh + (size_t)(tile * 64 + row) * 512 + ((p ^ ((row >> 1) & 7)) * 8);
    const GAS bf16* vg = Vh + (size_t)(tile * 64 + row) * 512 + ((p ^ (((row >> 1) & 1) * 4)) * 8);
    __builtin_amdgcn_global_load_lds((const unsigned*)kg, (LAS unsigned*)(kb + wave * 1024), 16, 0, 0);
    __builtin_amdgcn_global_load_lds((const unsigned*)vg, (LAS unsigned*)(vb + wave * 1024), 16, 0, 0);
}
__device__ __forceinline__ void at2_qk_m(f32x16& p0, f32x16& p1, const LAS unsigned char* kb, const LAS unsigned char* ones, const bf16x8_t (&qf)[4], const bf16x8_t mB, int r32, int hi) {
    const int f = (r32 >> 1) & 7;
    const LAS unsigned char* kp = kb + r32 * 128;
    bf16x8_t k0[5], k1[5];
#pragma unroll
    for (int s = 0; s < 4; ++s) { const int po = ((2 * s + hi) ^ f) * 16; k0[s] = *(const LAS bf16x8_t*)(kp + po); k1[s] = *(const LAS bf16x8_t*)(kp + 32 * 128 + po); }
    k0[4] = *(const LAS bf16x8_t*)ones; k1[4] = k0[4];
    asm volatile("s_waitcnt lgkmcnt(0)" : "+v"(k0[0]), "+v"(k0[1]), "+v"(k0[2]), "+v"(k0[3]), "+v"(k0[4]), "+v"(k1[0]), "+v"(k1[1]), "+v"(k1[2]), "+v"(k1[3]), "+v"(k1[4]) :: "memory");
    p0 = __builtin_amdgcn_mfma_f32_32x32x16_bf16(k0[4], mB, p0, 0, 0, 0); p1 = __builtin_amdgcn_mfma_f32_32x32x16_bf16(k1[4], mB, p1, 0, 0, 0);
#pragma unroll
    for (int s = 0; s < 4; ++s) { p0 = __builtin_amdgcn_mfma_f32_32x32x16_bf16(k0[s], qf[s], p0, 0, 0, 0); p1 = __builtin_amdgcn_mfma_f32_32x32x16_bf16(k1[s], qf[s], p1, 0, 0, 0); }
}
typedef short s16x4_t __attribute__((ext_vector_type(4)));
__device__ __forceinline__ void at2_pv(f32x16& o0, f32x16& o1, const LAS unsigned char* vb, const bf16x8_t (&pb)[4], int lane) {
    const int g = lane >> 4, q = (lane & 15) >> 2, p = lane & 3;
    const int sw = ((q >> 1) & 1) * 4, c0 = 2 * (g & 1) + (p >> 1);
    const LAS unsigned char* rowp = vb + (4 * (g >> 1) + q) * 128 + 8 * (p & 1);
    const LAS unsigned char* b0 = rowp + ((c0 ^ sw) * 16); const LAS unsigned char* b1 = rowp + (((c0 + 4) ^ sw) * 16);
    union U { bf16x8_t v; s16x4_t h[2]; }; U a0[4], a1[4];
#pragma unroll
    for (int sg = 0; sg < 4; ++sg) { const int ro = (32 * (sg >> 1) + 16 * (sg & 1)) * 128;
        a0[sg].h[0] = __builtin_amdgcn_ds_read_tr16_b64_v4i16((LAS s16x4_t*)(b0 + ro)); a0[sg].h[1] = __builtin_amdgcn_ds_read_tr16_b64_v4i16((LAS s16x4_t*)(b0 + ro + 8 * 128));
        a1[sg].h[0] = __builtin_amdgcn_ds_read_tr16_b64_v4i16((LAS s16x4_t*)(b1 + ro)); a1[sg].h[1] = __builtin_amdgcn_ds_read_tr16_b64_v4i16((LAS s16x4_t*)(b1 + ro + 8 * 128)); }
    asm volatile("s_waitcnt lgkmcnt(0)" : "+v"(a0[0].v), "+v"(a0[1].v), "+v"(a0[2].v), "+v"(a0[3].v), "+v"(a1[0].v), "+v"(a1[1].v), "+v"(a1[2].v), "+v"(a1[3].v) :: "memory");
#pragma unroll
    for (int sg = 0; sg < 4; ++sg) { o0 = __builtin_amdgcn_mfma_f32_32x32x16_bf16(a0[sg].v, pb[sg], o0, 0, 0, 0); o1 = __builtin_amdgcn_mfma_f32_32x32x16_bf16(a1[sg].v, pb[sg], o1, 0, 0, 0); }
}
constexpr int D2_K = 0, D2_V = 4 * A2_TILE, D2_ONES = 8 * A2_TILE, D2_BT = D2_ONES + 64, D2_OST = 73728;
static_assert(D2_BT + 512 <= D2_OST && D2_OST + 8 * 4096 <= RING_BYTES, "dsa2 LDS map");
template <bool DRY = false> __device__ __forceinline__ void dsa_attn2_unit(Frame& F, int b, int h, int qt) {
    int tid_ = F.tid; asm volatile("" : "+v"(tid_));
    const int tid = tid_, lane = tid & 63, wave = F.wave, r32 = lane & 31, hi = lane >> 5;
    LAS unsigned char* L = F.lds + RING_OFF;
    LAS float* bt = (LAS float*)(L + D2_BT);
    const size_t rowb = (size_t)b * SEQ;
    const GAS bf16* Kh = (const GAS bf16*)WSB(WS_KB) + rowb * 512 + h * 64; const GAS bf16* Vh = (const GAS bf16*)WSB(WS_VB) + rowb * 512 + h * 64;
    const int q0w = qt * 256 + wave * 32, q = q0w + r32;
    const int NS = 2 * qt + 2;
    __syncthreads();
    if (tid < 128) { const GAS float* rb = (const GAS float*)INP(I_RELB) + (8 + h); bt[tid] = (rb[t5_bucket(tid) * 16] - rb[31 * 16]) * LOG2E; }
    bf16x8_t qf[4];
    { const GAS bf16* qp = (const GAS bf16*)WSB(WS_QB) + (rowb + q) * 512 + h * 64 + hi * 8;
#pragma unroll
      for (int s = 0; s < 4; ++s) qf[s] = *(const GAS bf16x8_t*)(qp + s * 16); }
#pragma unroll
    for (int s = 0; s < 4; ++s) { union { bf16x8_t v; unsigned u[4]; } x; x.v = qf[s];
#pragma unroll
        for (int jj = 0; jj < 4; ++jj) x.u[jj] = pg8::cvt_pk_bf16(pg8::bf_lo(x.u[jj]) * AT_C2, pg8::bf_hi(x.u[jj]) * AT_C2);
        qf[s] = x.v; }
    bf16x8_t mB;
    { union { bf16x8_t v; unsigned u[4]; } x; x.u[0] = x.u[1] = x.u[2] = x.u[3] = 0u; mB = x.v; }
    if (tid == 0) { unsigned one = 0x3f80u, zz = 0u; asm volatile("" : "+v"(one), "+v"(zz)); *(LAS v4u*)(L + D2_ONES) = (v4u){one, zz, zz, zz}; }
    bool fresh = true;
    const GAS unsigned* mrow = (const GAS unsigned*)(F.ws + WS_MASK) + (rowb + q) * 512;
    auto dma2 = [&](int s) __attribute__((always_inline)) { const int set = s & 1;
        at2_dma(Kh, Vh, 2 * s, wave, lane, L + D2_K + (2 * set) * A2_TILE, L + D2_V + (2 * set) * A2_TILE);
        at2_dma(Kh, Vh, 2 * s + 1, wave, lane, L + D2_K + (2 * set + 1) * A2_TILE, L + D2_V + (2 * set + 1) * A2_TILE); };
    dma2(0);
    unsigned wc[4] = { mrow[0], mrow[1], mrow[2], mrow[3] };
    VM_WAIT(); __syncthreads();
    float m = 0.f, lsum = 0.f;
    f32x16 o0 = {0.f, 0.f, 0.f, 0.f, 0.f, 0.f, 0.f, 0.f, 0.f, 0.f, 0.f, 0.f, 0.f, 0.f, 0.f, 0.f}, o1 = o0;
    auto step = [&](int s) __attribute__((always_inline)) {
        const int set = s & 1;
        if (s + 1 < NS) dma2(s + 1);
        unsigned wn[4] = {0u, 0u, 0u, 0u};
        if (s + 1 < NS) { const GAS unsigned* mp = mrow + 4 * (s + 1); wn[0] = mp[0]; wn[1] = mp[1]; wn[2] = mp[2]; wn[3] = mp[3]; }
        if (__any((wc[0] | wc[1] | wc[2] | wc[3]) != 0u)) {
            const LAS unsigned char* kb = L + D2_K + (2 * set) * A2_TILE; const LAS unsigned char* vb = L + D2_V + (2 * set) * A2_TILE;
            f32x16 p0 = {0.f, 0.f, 0.f, 0.f, 0.f, 0.f, 0.f, 0.f, 0.f, 0.f, 0.f, 0.f, 0.f, 0.f, 0.f, 0.f}, p1 = p0, p2 = p0, p3 = p0;
            at2_qk_m(p0, p1, kb, L + D2_ONES, qf, mB, r32, hi); at2_qk_m(p2, p3, kb + A2_TILE, L + D2_ONES, qf, mB, r32, hi);
            asm volatile("s_nop 15\n\ts_nop 15" : "+v"(p0), "+v"(p1), "+v"(p2), "+v"(p3));
            const int t0 = 2 * s;
            const bool near = ((t0 + 1) * 64 + 191 > q0w);
            if (near) {
#pragma unroll
                for (int r = 0; r < 16; ++r) { const int d0 = q - (t0 * 64 + crow_(r, hi)), d1 = d0 - 32, d2 = d0 - 64, d3 = d0 - 96;
                    const float b0 = ((unsigned)d0 < 128u) ? bt[d0] : 0.f, b1 = ((unsigned)d1 < 128u) ? bt[d1] : 0.f, b2 = ((unsigned)d2 < 128u) ? bt[d2] : 0.f, b3 = ((unsigned)d3 < 128u) ? bt[d3] : 0.f;
                    p0[r] += b0; p1[r] += b1; p2[r] += b2; p3[r] += b3; }
            }
            float mx;
            { float ma = max3_(p0[0], p1[0], p2[0]), mb = max3_(p3[0], p0[1], p1[1]), mc = max3_(p2[1], p3[1], p0[2]), md = max3_(p1[2], p2[2], p3[2]);
#pragma unroll
              for (int r = 3; r < 15; r += 2) { ma = max3_(ma, p0[r], p1[r]); mb = max3_(mb, p2[r], p3[r]); mc = max3_(mc, p0[r + 1], p1[r + 1]); md = max3_(md, p2[r + 1], p3[r + 1]); }
              ma = max3_(ma, p0[15], p1[15]); mb = max3_(mb, p2[15], p3[15]); mx = max3_(ma, mb, mc); mx = max3_(mx, md, md); }
            mx = max3_(mx, __shfl_xor(mx, 32), mx);
            if (fresh || __any(mx > AT_THR)) {
                const float d = fresh ? mx : fmaxf(mx, 0.f);
                const float mn = __uint_as_float(pg8::cvt_pk_bf16(0.f, m + d) & 0xffff0000u);
                const float dl = mn - m; const float al = __builtin_amdgcn_exp2f(-dl);
                MFMA_FENCE2(o0, o1);
#pragma unroll
                for (int r = 0; r < 16; ++r) { o0[r] *= al; o1[r] *= al; p0[r] -= dl; p1[r] -= dl; p2[r] -= dl; p3[r] -= dl; }
                lsum *= al; m = mn; fresh = false;
                { union { bf16x8_t v; unsigned u[4]; } x; x.u[0] = hi == 0 ? ((__float_as_uint(m) >> 16) ^ 0x8000u) : 0u; x.u[1] = x.u[2] = x.u[3] = 0u; mB = x.v; }
            }
            const unsigned w0 = wc[0] >> (4 * hi), w1 = wc[1] >> (4 * hi), w2 = wc[2] >> (4 * hi), w3 = wc[3] >> (4 * hi);
            float lq[4] = {0.f, 0.f, 0.f, 0.f};
#pragma unroll
            for (int r = 0; r < 16; ++r) { const int cb = (r & 3) + 8 * (r >> 2);
                const float e0 = __uint_as_float(and_sel(__builtin_amdgcn_exp2f(p0[r]), w0, cb)), e1 = __uint_as_float(and_sel(__builtin_amdgcn_exp2f(p1[r]), w1, cb));
                const float e2 = __uint_as_float(and_sel(__builtin_amdgcn_exp2f(p2[r]), w2, cb)), e3 = __uint_as_float(and_sel(__builtin_amdgcn_exp2f(p3[r]), w3, cb));
                p0[r] = e0; p1[r] = e1; p2[r] = e2; p3[r] = e3; lq[0] += e0; lq[1] += e1; lq[2] += e2; lq[3] += e3; }
            lsum += (lq[0] + lq[1]) + (lq[2] + lq[3]);
            bf16x8_t pb[4], pc[4];
#pragma unroll
            for (int sg = 0; sg < 4; ++sg) { union { bf16x8_t v; unsigned u[4]; } pk, pl;
#pragma unroll
                for (int j = 0; j < 4; ++j) { const int r = 8 * (sg & 1) + 2 * j; pk.u[j] = (sg < 2) ? pg8::cvt_pk_bf16(p0[r], p0[r + 1]) : pg8::cvt_pk_bf16(p1[r], p1[r + 1]);
                    pl.u[j] = (sg < 2) ? pg8::cvt_pk_bf16(p2[r], p2[r + 1]) : pg8::cvt_pk_bf16(p3[r], p3[r + 1]); }
                pb[sg] = pk.v; pc[sg] = pl.v; }
            at2_pv(o0, o1, vb, pb, lane); at2_pv(o0, o1, vb + A2_TILE, pc, lane);
        }
        wc[0] = wn[0]; wc[1] = wn[1]; wc[2] = wn[2]; wc[3] = wn[3];
        VM_WAIT(); __syncthreads();
    };
#pragma unroll 1
    for (int s = 0; s < NS; ++s) step(s);
    MFMA_FENCE2(o0, o1);
    lsum += __shfl_xor(lsum, 32);
    const float inv = 1.0f / lsum;
    LAS bf16* ost = (LAS bf16*)(L + D2_OST + wave * 4096);
#pragma unroll
    for (int r = 0; r < 16; ++r) { ost[r32 * 64 + crow_(r, hi)] = (bf16)f2bf(o0[r] * inv); ost[r32 * 64 + 32 + crow_(r, hi)] = (bf16)f2bf(o1[r] * inv); }
    LDS_WAIT(); asm volatile("" ::: "memory");
    GAS bf16* Og = (GAS bf16*)WSB(WS_QB) + (rowb + q0w) * 512 + h * 64;
#pragma unroll
    for (int i = 0; i < 4; ++i) { const int c = i * 64 + lane, row = c >> 3, ch = c & 7; const v4u ov = *(const LAS v4u*)(ost + row * 64 + ch * 8); if (!DRY) *(GAS v4u*)(Og + (size_t)row * 512 + ch * 8) = ov; else if (ov.x == 0x12345678u && ov.y == 0x9abcdef0u) *(GAS v4u*)(Og + (size_t)row * 512 + ch * 8) = ov; }
}
#ifndef IX_SMIN_V
#define IX_SMIN_V 16
#endif
#ifndef IX_ZMAX_V
#define IX_ZMAX_V 255
#endif
constexpr int IX_FSH = 18, IX_FBASE = (0x2000 | (127 << 5)) - 42 * 32, IX_SSTRIDE = 8, IX_SMIN = IX_SMIN_V, IX_SHI = 16, IX_SLO = 56, IX_STOT = 36, IX_ZMAX = IX_ZMAX_V;
constexpr int IX_CAP = 768;
constexpr int IX_HIST = 0, IX_CAND = 0, IX_BM = 98304;
constexpr int IX_W = LDSCTL_OFF + 1024;
constexpr int IX_ST = LDSCTL_OFF + 1536;
constexpr int IX_SUB = LDSCTL_OFF + 2048, IX_L2 = IX_SUB + 8 * 1024, IX_C2 = IX_L2 + 8 * 512;
static_assert(IX_C2 + 64 <= LDS_BYTES, "idx sub-histogram LDS");
static_assert(IX_BM + 16 * 512 * 4 <= RING_BYTES && 16 * IX_CAP * 8 <= IX_BM && IX_ST + 6 * 64 <= LDS_BYTES, "idx LDS map");
#define MFMA_FENCE1(a) asm volatile("s_nop 15\n\ts_nop 15" : "+v"(a))
__device__ __forceinline__ float relu_(float x, float) { float r; asm("v_max_f32 %0, 0, %1" : "=v"(r) : "v"(x)); return r; }
__device__ __forceinline__ unsigned mono_key(float s) { const unsigned u = __float_as_uint(s + 0.0f); return u ^ ((unsigned)((int)u >> 31) | 0x80000000u); }

template <int MODE, bool LEVEL0, bool LAST, int HALF> __device__ __forceinline__ void idx_vec(const f32x16 (&accs)[2], const f32x4 (&wv)[4][4], LAS unsigned* hist, LAS unsigned long long* cand, LAS unsigned* bm, LAS unsigned* st,
                                                                                    const unsigned (&psh)[8], const unsigned (&ppre)[8], const bool (&pact)[8], int key, int t0, int hi, int lane, int w32, int shn, unsigned fmask, bool allsel) {
#pragma unroll
    for (int rb = 2 * HALF; rb < 2 * HALF + 2; ++rb) {
        const f32x16 acc = accs[rb - 2 * HALF];
        const int qla = 4 * rb + 2 * hi;
        const f32x4 w0 = wv[rb][0], w1 = wv[rb][1], w2 = wv[rb][2], w3 = wv[rb][3];
        float sa = w0.x * relu_(acc[0], 0.f), sa2 = w0.y * relu_(acc[1], 0.f); sa += w0.z * relu_(acc[2], 0.f); sa2 += w0.w * relu_(acc[3], 0.f);
        sa += w1.x * relu_(acc[4], 0.f); sa2 += w1.y * relu_(acc[5], 0.f); sa += w1.z * relu_(acc[6], 0.f); sa2 += w1.w * relu_(acc[7], 0.f);
        float sb = w2.x * relu_(acc[8], 0.f), sb2 = w2.y * relu_(acc[9], 0.f); sb += w2.z * relu_(acc[10], 0.f); sb2 += w2.w * relu_(acc[11], 0.f);
        sb += w3.x * relu_(acc[12], 0.f); sb2 += w3.y * relu_(acc[13], 0.f); sb += w3.z * relu_(acc[14], 0.f); sb2 += w3.w * relu_(acc[15], 0.f);
        sa += sa2; sb += sb2;
        const unsigned ua = mono_key(sa), ub = mono_key(sb);
        const bool va = !LAST || key <= t0 + qla, vb = !LAST || key <= t0 + qla + 1;
        if (MODE == 3) {
            const int fa = (int)(ua >> IX_FSH) - IX_FBASE, fb = (int)(ub >> IX_FSH) - IX_FBASE;
            const unsigned ba = (unsigned)(fa > 2047 ? 2047 : fa), bb = (unsigned)(fb > 2047 ? 2047 : fb);
            if (fa > 0) __hip_atomic_fetch_add(hist + qla * 2048 + ba, 1u, __ATOMIC_RELAXED, __HIP_MEMORY_SCOPE_WORKGROUP);
            if (fb > 0) __hip_atomic_fetch_add(hist + (qla + 1) * 2048 + bb, 1u, __ATOMIC_RELAXED, __HIP_MEMORY_SCOPE_WORKGROUP);
        } else if (MODE == 2) {
            const unsigned pa = ua >> IX_FSH, pb = ub >> IX_FSH;
            const bool sela = va && pa > ppre[2 * rb], selb = vb && pb > ppre[2 * rb + 1];
            const bool ca = va && (ppre[2 * rb] - pa) <= psh[2 * rb], cb = vb && (ppre[2 * rb + 1] - pb) <= psh[2 * rb + 1];
            const unsigned long long bala = __ballot(sela), balb = __ballot(selb);
            if (lane == 0) { bm[(4 * rb + 0) * 512 + w32] = (unsigned)bala; bm[(4 * rb + 2) * 512 + w32] = (unsigned)(bala >> 32);
                             bm[(4 * rb + 1) * 512 + w32] = (unsigned)balb; bm[(4 * rb + 3) * 512 + w32] = (unsigned)(balb >> 32); }
            if (ca) { const unsigned slot = __hip_atomic_fetch_add(st + qla, 1u, __ATOMIC_RELAXED, __HIP_MEMORY_SCOPE_WORKGROUP);
                if (slot < (unsigned)IX_CAP) cand[qla * IX_CAP + slot] = ((unsigned long long)ua << 32) | (unsigned)(0xffff - key); }
            if (cb) { const unsigned slot = __hip_atomic_fetch_add(st + qla + 1, 1u, __ATOMIC_RELAXED, __HIP_MEMORY_SCOPE_WORKGROUP);
                if (slot < (unsigned)IX_CAP) cand[(qla + 1) * IX_CAP + slot] = ((unsigned long long)ub << 32) | (unsigned)(0xffff - key); }
        } else if (MODE == 0) {
            const bool ma = va && (LEVEL0 || (pact[2 * rb] && (ua >> psh[2 * rb]) == ppre[2 * rb]));
            const bool mb = vb && (LEVEL0 || (pact[2 * rb + 1] && (ub >> psh[2 * rb + 1]) == ppre[2 * rb + 1]));
            const unsigned ba = LEVEL0 ? (ua >> 21) : ((ua >> shn) & fmask), bb = LEVEL0 ? (ub >> 21) : ((ub >> shn) & fmask);
            if (ma) __hip_atomic_fetch_add(hist + qla * 2048 + ba, 1u, __ATOMIC_RELAXED, __HIP_MEMORY_SCOPE_WORKGROUP);
            if (mb) __hip_atomic_fetch_add(hist + (qla + 1) * 2048 + bb, 1u, __ATOMIC_RELAXED, __HIP_MEMORY_SCOPE_WORKGROUP);
        } else {
            const unsigned pa = ua >> psh[2 * rb], pb = ub >> psh[2 * rb + 1];
            const bool sela = va && (allsel || pa > ppre[2 * rb]), selb = vb && (allsel || pb > ppre[2 * rb + 1]);
            const bool ca = va && !allsel && pa == ppre[2 * rb], cb = vb && !allsel && pb == ppre[2 * rb + 1];
            const unsigned long long bala = __ballot(sela), balb = __ballot(selb);
            if (lane == 0) { bm[(4 * rb + 0) * 512 + w32] = (unsigned)bala; bm[(4 * rb + 2) * 512 + w32] = (unsigned)(bala >> 32);
                             bm[(4 * rb + 1) * 512 + w32] = (unsigned)balb; bm[(4 * rb + 3) * 512 + w32] = (unsigned)(balb >> 32); }
            if (ca) { const unsigned slot = __hip_atomic_fetch_add(st + qla, 1u, __ATOMIC_RELAXED, __HIP_MEMORY_SCOPE_WORKGROUP);
                if (slot < (unsigned)IX_CAP) cand[qla * IX_CAP + slot] = ((unsigned long long)ua << 32) | (unsigned)(0xffff - key); }
            if (cb) { const unsigned slot = __hip_atomic_fetch_add(st + qla + 1, 1u, __ATOMIC_RELAXED, __HIP_MEMORY_SCOPE_WORKGROUP);
                if (slot < (unsigned)IX_CAP) cand[(qla + 1) * IX_CAP + slot] = ((unsigned long long)ub << 32) | (unsigned)(0xffff - key); }
        }
    }
}
template <int MODE, bool LEVEL0, int STRIDE = 1> __device__ __forceinline__ void idx_pass(Frame& F, const bf16x8_t (&qa)[4][4], const GAS bf16* kib, int t0, int nst, int wave, int lane,
                                                             int shn, unsigned fmask, bool allsel) {
    const int n = lane & 31, hi = lane >> 5;
    LAS unsigned char* L = F.lds + RING_OFF;
    LAS unsigned* hist = (LAS unsigned*)(L + IX_HIST); LAS unsigned long long* cand = (LAS unsigned long long*)(L + IX_CAND); LAS unsigned* bm = (LAS unsigned*)(L + IX_BM);
    const LAS float* wl = (const LAS float*)(F.lds + IX_W); LAS unsigned* st = (LAS unsigned*)(F.lds + IX_ST);
    unsigned psh[8], ppre[8]; bool pact[8];
#pragma unroll
    for (int i = 0; i < 8; ++i) { const int ql = 4 * (i >> 1) + 2 * hi + (i & 1); psh[i] = st[16 + ql]; ppre[i] = st[32 + ql]; pact[i] = (st[80 + ql] != 0u); }
    f32x4 wv[4][4];
#pragma unroll
    for (int rb = 0; rb < 4; ++rb)
#pragma unroll
        for (int j = 0; j < 4; ++j) wv[rb][j] = *(const LAS f32x4*)(wl + (4 * rb + 2 * hi) * 8 + 4 * j);
    bf16x8_t kf[4];
    const GAS bf16* kp = kib + (size_t)(wave * 32 + n) * 64 + hi * 8;
#pragma unroll
    for (int s = 0; s < 4; ++s) kf[s] = *(const GAS bf16x8_t*)(kp + s * 16);
    const int nlim = STRIDE == 1 ? nst : nst - 1;
#pragma unroll 1
    for (int stile = 0; stile < nlim; stile += STRIDE) {
        const int key = stile * 256 + wave * 32 + n;
        const int w32 = stile * 8 + wave;
        const bool lastt = STRIDE == 1 && (stile + 1 == nst);
        const bool more = (stile + STRIDE < nlim);
        f32x16 accs[2];
#pragma unroll
        for (int rb = 0; rb < 2; ++rb) { accs[rb] = (f32x16){0.f, 0.f, 0.f, 0.f, 0.f, 0.f, 0.f, 0.f, 0.f, 0.f, 0.f, 0.f, 0.f, 0.f, 0.f, 0.f};
#pragma unroll
            for (int s = 0; s < 4; ++s) accs[rb] = __builtin_amdgcn_mfma_f32_32x32x16_bf16(qa[rb][s], kf[s], accs[rb], 0, 0, 0); }
        asm volatile("s_nop 15\n\ts_nop 15" : "+v"(accs[0]), "+v"(accs[1]));
        if (!lastt) idx_vec<MODE, LEVEL0, false, 0>(accs, wv, hist, cand, bm, st, psh, ppre, pact, key, t0, hi, lane, w32, shn, fmask, allsel);
        else idx_vec<MODE, LEVEL0, true, 0>(accs, wv, hist, cand, bm, st, psh, ppre, pact, key, t0, hi, lane, w32, shn, fmask, allsel);
#pragma unroll
        for (int rb = 0; rb < 2; ++rb) { accs[rb] = (f32x16){0.f, 0.f, 0.f, 0.f, 0.f, 0.f, 0.f, 0.f, 0.f, 0.f, 0.f, 0.f, 0.f, 0.f, 0.f, 0.f};
#pragma unroll
            for (int s = 0; s < 4; ++s) accs[rb] = __builtin_amdgcn_mfma_f32_32x32x16_bf16(qa[2 + rb][s], kf[s], accs[rb], 0, 0, 0); }
        asm volatile("s_nop 15\n\ts_nop 15" : "+v"(accs[0]), "+v"(accs[1]), "+v"(kf[0]), "+v"(kf[1]), "+v"(kf[2]), "+v"(kf[3]));
        if (more) { kp += (size_t)STRIDE * 256 * 64;
#pragma unroll
            for (int s = 0; s < 4; ++s) kf[s] = *(const GAS bf16x8_t*)(kp + s * 16); }
        if (!lastt) idx_vec<MODE, LEVEL0, false, 1>(accs, wv, hist, cand, bm, st, psh, ppre, pact, key, t0, hi, lane, w32, shn, fmask, allsel);
        else idx_vec<MODE, LEVEL0, true, 1>(accs, wv, hist, cand, bm, st, psh, ppre, pact, key, t0, hi, lane, w32, shn, fmask, allsel);
    }
}

__device__ __forceinline__ bool idx_find_bin(const LAS unsigned* hrow, int D, unsigned above, unsigned S, unsigned kneed, int lane, int& bsel, unsigned& abovebin, unsigned& cbin) {
    const unsigned long long ownm = __ballot(above < kneed && kneed <= S);
    if (ownm == 0ull) return false;
    const int Lo = __ffsll((long long)ownm) - 1;
    const unsigned aL = (unsigned)__shfl((int)above, Lo);
    const unsigned v = (lane < D) ? hrow[Lo * D + lane] : 0u;
    unsigned s = v;
#pragma unroll
    for (int o = 1; o < 32; o <<= 1) { const unsigned t = __shfl_down(s, o); if (lane + o < 64) s += t; }
    const unsigned excl = s - v;
    const unsigned long long hitm = __ballot(lane < D && aL + excl < kneed && kneed <= aL + s);
    const int H = __ffsll((long long)hitm) - 1;
    bsel = Lo * D + H; abovebin = (unsigned)__shfl((int)(aL + excl), H); cbin = (unsigned)__shfl((int)v, H);
    return hitm != 0ull;
}
__device__ __forceinline__ void idx_unit(Frame& F, int b, int t0) {
    int tid_ = F.tid; asm volatile("" : "+v"(tid_));
    const int tid = tid_, lane = tid & 63, wave = F.wave, r32 = lane & 31, hh = lane >> 5;
    LAS unsigned char* L = F.lds + RING_OFF;
    LAS unsigned* hist = (LAS unsigned*)(L + IX_HIST); LAS unsigned long long* cand = (LAS unsigned long long*)(L + IX_CAND); LAS unsigned* bm = (LAS unsigned*)(L + IX_BM);
    LAS float* wl = (LAS float*)(F.lds + IX_W); LAS unsigned* st = (LAS unsigned*)(F.lds + IX_ST);
    const size_t rowb = (size_t)b * SEQ; const int nst = (t0 >> 8) + 1; const bool allsel = (t0 < 256);
    const GAS bf16* kib = (const GAS bf16*)WSB(WS_KI) + rowb * 64;
    __syncthreads();
    if (tid < 128) wl[tid] = ((const GAS float*)WSF(WS_WI) + (rowb + t0) * 8)[tid];
    if (tid < 16) { st[tid] = 0u; st[16 + tid] = 21u; st[32 + tid] = 0u; st[48 + tid] = 256u; st[64 + tid] = 0u; st[80 + tid] = 1u; }
    if (tid == 0) { unsigned zz = 0u; asm volatile("" : "+v"(zz)); st[96] = zz; st[97] = zz; }
    bf16x8_t qa[4][4];
    { const int qloc = 2 * ((r32 >> 2) & 1) + (r32 >> 4), head = (r32 & 3) + 4 * ((r32 >> 3) & 1);
      const GAS bf16* qp = (const GAS bf16*)WSB(WS_QI) + (rowb + t0 + qloc) * 512 + head * 64 + hh * 8;
#pragma unroll
      for (int rb = 0; rb < 4; ++rb)
#pragma unroll
        for (int s = 0; s < 4; ++s) qa[rb][s] = *(const GAS bf16x8_t*)(qp + (size_t)rb * 4 * 512 + s * 16); }
    __syncthreads();
    bool exact = allsel || nst < IX_SMIN;
    if (!exact) {
        { unsigned zz = 0u; asm volatile("" : "+v"(zz)); const v4u z4 = {zz, zz, zz, zz};
          for (int i = tid; i < 16 * 2048 / 4; i += NWAVES * 64) ((LAS v4u*)hist)[i] = z4; }
        __syncthreads();
        idx_pass<3, true, IX_SSTRIDE>(F, qa, kib, t0, nst, wave, lane, 0, 0u, false);
        __syncthreads();
#pragma unroll 1
        for (int qq = 0; qq < 2; ++qq) { const int ql = 2 * wave + qq; const LAS unsigned* hq = hist + ql * 2048 + lane * 32;
            unsigned tot = 0u;
            for (int dd = 0; dd < 32; ++dd) tot += hq[(dd + lane) & 31];
            unsigned S = tot;
#pragma unroll
            for (int o = 1; o < 64; o <<= 1) { const unsigned v = __shfl_down(S, o); if (lane + o < 64) S += v; }
            const unsigned above = S - tot; const unsigned total = (unsigned)__shfl((int)S, 0);
            if (total < (unsigned)IX_STOT) { if (lane == 0) __hip_atomic_fetch_or(st + 96, 1u, __ATOMIC_RELAXED, __HIP_MEMORY_SCOPE_WORKGROUP); continue; }
            const unsigned slo = total < (unsigned)IX_SLO ? total : (unsigned)IX_SLO;
#pragma unroll
            for (int which = 0; which < 2; ++which) { const unsigned kneed = which == 0 ? (unsigned)IX_SHI : slo;
                int bsel = 0; unsigned ab_, cb_;
                if (idx_find_bin(hist + ql * 2048, 32, above, S, kneed, lane, bsel, ab_, cb_) && lane == 0) {
                    if (which == 0) { st[32 + ql] = (unsigned)(IX_FBASE + bsel); if (bsel >= 2047) __hip_atomic_fetch_or(st + 96, 2u, __ATOMIC_RELAXED, __HIP_MEMORY_SCOPE_WORKGROUP); }
                    else { st[64 + ql] = (unsigned)(IX_FBASE + bsel); if (bsel <= 0) __hip_atomic_fetch_or(st + 96, 4u, __ATOMIC_RELAXED, __HIP_MEMORY_SCOPE_WORKGROUP); } } }
            LDS_WAIT(); asm volatile("" ::: "memory");
            if (lane == 0) { const unsigned w = st[32 + ql] - st[64 + ql]; st[16 + ql] = w; if (w > (unsigned)IX_ZMAX) __hip_atomic_fetch_or(st + 96, 8u, __ATOMIC_RELAXED, __HIP_MEMORY_SCOPE_WORKGROUP); }
        }
        __syncthreads();
        exact = (st[96] != 0u);
        const unsigned why = st[96];
        __syncthreads();
        if (!exact) {
            idx_pass<2, false>(F, qa, kib, t0, nst, wave, lane, 0, 0u, false);
            __syncthreads();
#pragma unroll 1
            for (int qq = 0; qq < 2; ++qq) { const int ql = 2 * wave + qq;
                int members = 0;
                for (int w = lane; w < nst * 8; w += 64) members += __popc(bm[ql * 512 + w]);
#pragma unroll
                for (int o = 32; o > 0; o >>= 1) members += __shfl_xor(members, o);
                const int nct = (int)st[ql], need = 256 - members;
                const bool ok = members <= 256 && need <= nct && nct <= IX_CAP;
                if (lane == 0) { if (!ok) __hip_atomic_fetch_or(st + 96, 16u, __ATOMIC_RELAXED, __HIP_MEMORY_SCOPE_WORKGROUP); st[48 + ql] = (unsigned)(need > 0 ? need : 0); }
            }
            __syncthreads();
            exact = (st[96] != 0u);
            __syncthreads();
        }
        if (exact) {
#ifdef IX_SPIN
            if (why & IX_SPIN) { const long long w1 = wall_clock64(); while (wall_clock64() - w1 < 4000) __builtin_amdgcn_s_sleep(4); }
#endif
            if (tid < 16) { st[tid] = 0u; st[16 + tid] = 21u; st[32 + tid] = 0u; st[48 + tid] = 256u; st[64 + tid] = 0u; st[80 + tid] = 1u; }
            __syncthreads();
        }
    }
    const bool zone = !exact;
    if (exact && !allsel) {
#pragma unroll 1
        for (int level = 0; level < 3; ++level) {
            const int shn = level == 0 ? 21 : (level == 1 ? 10 : 0); const unsigned fmask = level == 2 ? 0x3ffu : 0x7ffu; const int nd = level == 2 ? 1024 : 2048;
            for (int i = tid; i < 16 * 2048 / 4; i += NWAVES * 64) ((LAS v4u*)hist)[i] = (v4u){0u, 0u, 0u, 0u};
            __syncthreads();
            { if (level == 0) idx_pass<0, true>(F, qa, kib, t0, nst, wave, lane, shn, fmask, false); else idx_pass<0, false>(F, qa, kib, t0, nst, wave, lane, shn, fmask, false); }
            __syncthreads();
            if (PROBE_SEL & 8) { for (int i = tid; i < 16 * 2048; i += NWAVES * 64) hist[i] = 0u; __syncthreads(); { if (level == 0) idx_pass<0, true>(F, qa, kib, t0, nst, wave, lane, shn, fmask, false); else idx_pass<0, false>(F, qa, kib, t0, nst, wave, lane, shn, fmask, false); } __syncthreads(); }
#pragma unroll 1
            for (int qq = 0; qq < 2; ++qq) { const int ql = 2 * wave + qq;
                if (st[80 + ql] == 0u) continue;
                const unsigned kneed = st[48 + ql]; const int D = nd >> 6; const LAS unsigned* hq = hist + ql * 2048 + lane * D;
                unsigned tot = 0u;
                for (int dd = 0; dd < D; ++dd) tot += hq[(dd + lane) & (D - 1)];
                unsigned S = tot;
#pragma unroll
                for (int o = 1; o < 64; o <<= 1) { const unsigned v = __shfl_down(S, o); if (lane + o < 64) S += v; }
                const unsigned above = S - tot;
                int bsel = 0; unsigned a = 0u, cb = 0u;
                if (idx_find_bin(hist + ql * 2048, D, above, S, kneed, lane, bsel, a, cb) && lane == 0) {
                    const unsigned opre = st[32 + ql];
                    st[32 + ql] = (level == 0) ? (unsigned)bsel : ((opre << (level == 1 ? 11 : 10)) | (unsigned)bsel);
                    st[16 + ql] = (unsigned)shn; st[48 + ql] = kneed - a; st[64 + ql] = cb;
                    st[80 + ql] = (cb > (unsigned)IX_CAP && level < 2) ? 1u : 0u; }
            }
            __syncthreads();
            unsigned more = 0u;
#pragma unroll
            for (int i = 0; i < 16; ++i) more |= st[80 + i];
            __syncthreads();
            if (more == 0u) break;
        }
    }
    if (exact) idx_pass<1, false>(F, qa, kib, t0, nst, wave, lane, 0, 0u, allsel);
    __syncthreads();
    if (!allsel) {
#pragma unroll 1
        for (int qq = 0; qq < 2; ++qq) { const int ql = 2 * wave + qq;
            const int nc = (int)(st[ql] < (unsigned)IX_CAP ? st[ql] : (unsigned)IX_CAP); int need = (int)st[48 + ql]; const int vbits = zone ? 48 : 16 + (int)st[16 + ql];
            if (need <= 0) continue;
            if (need >= nc) {
                for (int k = lane; k < nc; k += 64) { const int key = 0xffff - (int)(cand[ql * IX_CAP + k] & 0xffffull); __hip_atomic_fetch_or(bm + ql * 512 + (key >> 5), 1u << (key & 31), __ATOMIC_RELAXED, __HIP_MEMORY_SCOPE_WORKGROUP); }
                continue; }
            const int shq = (int)st[16 + ql];
            const int zsh = (zone && st[16 + ql] <= 63u) ? 48 : 50;
            const unsigned zb = zone ? ((st[32 + ql] - st[16 + ql]) << (50 - zsh)) : 0u;
            if (zone || shq >= 8) {
                LAS unsigned* sh2 = (LAS unsigned*)(F.lds + IX_SUB + wave * 1024); LAS unsigned long long* l2 = (LAS unsigned long long*)(F.lds + IX_L2 + wave * 512); LAS unsigned* c2p = (LAS unsigned*)(F.lds + IX_C2 + wave * 4);
#pragma unroll
                for (int i = 0; i < 4; ++i) sh2[4 * lane + i] = 0u;
                if (lane == 0) *c2p = 0u;
                LDS_WAIT(); asm volatile("" ::: "memory");
                const int fsh = 32 + shq - 8;
                for (int k = lane; k < nc; k += 64) { const unsigned long long ckk = cand[ql * IX_CAP + k]; const unsigned f = zone ? (((unsigned)(ckk >> zsh) - zb) & 0xffu) : ((unsigned)(ckk >> fsh) & 0xffu); __hip_atomic_fetch_add(sh2 + f, 1u, __ATOMIC_RELAXED, __HIP_MEMORY_SCOPE_WORKGROUP); }
                LDS_WAIT(); asm volatile("" ::: "memory");
                const unsigned c0 = sh2[4 * lane], c1 = sh2[4 * lane + 1], c2 = sh2[4 * lane + 2], c3 = sh2[4 * lane + 3]; const unsigned tot = c0 + c1 + c2 + c3;
                unsigned S = tot;
#pragma unroll
                for (int o = 1; o < 64; o <<= 1) { const unsigned v = __shfl_down(S, o); if (lane + o < 64) S += v; }
                const unsigned above = S - tot; const unsigned needu = (unsigned)need;
                const bool found = above < needu && needu <= S;
                unsigned a = above; unsigned bsel = 0u, cbin = 0u;
                if (a + c3 >= needu) { bsel = 3u; cbin = c3; } else { a += c3; if (a + c2 >= needu) { bsel = 2u; cbin = c2; } else { a += c2; if (a + c1 >= needu) { bsel = 1u; cbin = c1; } else { a += c1; bsel = 0u; cbin = c0; } } }
                const int src = __ffsll((long long)__ballot(found)) - 1;
                const unsigned b2 = (unsigned)__shfl((int)(4u * lane + bsel), src), need2 = (unsigned)__shfl((int)(needu - a), src), cnt2 = (unsigned)__shfl((int)cbin, src);
                if (cnt2 <= 64u) {
                    for (int k = lane; k < nc; k += 64) { const unsigned long long ckk = cand[ql * IX_CAP + k]; const unsigned f = zone ? (((unsigned)(ckk >> zsh) - zb) & 0xffu) : ((unsigned)(ckk >> fsh) & 0xffu);
                        if (f > b2) { const int key = 0xffff - (int)(ckk & 0xffffull); __hip_atomic_fetch_or(bm + ql * 512 + (key >> 5), 1u << (key & 31), __ATOMIC_RELAXED, __HIP_MEMORY_SCOPE_WORKGROUP); }
                        else if (f == b2) { const unsigned slot = __hip_atomic_fetch_add(c2p, 1u, __ATOMIC_RELAXED, __HIP_MEMORY_SCOPE_WORKGROUP); l2[slot] = ckk; } }
                    LDS_WAIT(); asm volatile("" ::: "memory");
                    if (lane < (int)cnt2) { const unsigned long long mine = l2[lane]; unsigned rank = 0u;
                        for (unsigned j = 0; j < cnt2; ++j) rank += (l2[j] > mine) ? 1u : 0u;
                        if (rank < need2) { const int key = 0xffff - (int)(mine & 0xffffull); __hip_atomic_fetch_or(bm + ql * 512 + (key >> 5), 1u << (key & 31), __ATOMIC_RELAXED, __HIP_MEMORY_SCOPE_WORKGROUP); } }
                    LDS_WAIT(); asm volatile("" ::: "memory");
                    continue;
                }
            }
#ifdef IX_SPIN2
            if (zone) { const long long w1 = wall_clock64(); while (wall_clock64() - w1 < IX_SPIN2 * 100) __builtin_amdgcn_s_sleep(4); }
#endif
            unsigned long long ck[12]; unsigned alive = 0u, selm = 0u;
#pragma unroll
            for (int c = 0; c < 12; ++c) { const int k = c * 64 + lane; ck[c] = (k < nc) ? cand[ql * IX_CAP + k] : 0ull; if (k < nc) alive |= 1u << c; }
#pragma unroll 1
            for (int bit = vbits - 1 + 16; bit >= 0; --bit) {
                if (bit >= 16 && bit < 32) continue;
                unsigned ones = 0u; int cnt1 = 0;
#pragma unroll
                for (int c = 0; c < 12; ++c) { if (c * 64 < nc) { const bool o = ((alive >> c) & 1u) && ((ck[c] >> bit) & 1ull); cnt1 += __popcll(__ballot(o)); if (o) ones |= 1u << c; } }
                if (cnt1 >= need) alive &= ones;
                else { selm |= ones; alive &= ~ones; need -= cnt1; }
            }
            selm |= alive;
#pragma unroll
            for (int c = 0; c < 12; ++c) if ((selm >> c) & 1u) { const int key = 0xffff - (int)(ck[c] & 0xffffull); __hip_atomic_fetch_or(bm + ql * 512 + (key >> 5), 1u << (key & 31), __ATOMIC_RELAXED, __HIP_MEMORY_SCOPE_WORKGROUP); }
        }
    }
    __syncthreads();
    { GAS unsigned* mg = (GAS unsigned*)(F.ws + WS_MASK) + (rowb + t0) * 512; const int nw = nst * 8;
      for (int i = tid; i < 16 * nw; i += NWAVES * 64) { const int ql = i / nw, w = i - ql * nw; mg[(size_t)ql * 512 + w] = bm[ql * 512 + w]; } }
}
typedef __bf16 bf2_t __attribute__((ext_vector_type(2)));
constexpr size_t WS_KM2 = 110 * MiB;
constexpr size_t WS_MREF = 111 * MiB;
constexpr size_t WS_LACC = 38 * MiB;
constexpr size_t WS_PO = 464 * MiB;
constexpr size_t WS_PJ0 = WS_QI, WS_PJ1 = WS_XB, WS_PJ2 = WS_XB + 32 * MiB;
__device__ __forceinline__ unsigned char* pj_base(Frame& F, int l, int j) {
    if (j == 0) return F.ws + WS_PJ0;
    return (unsigned char*)F.out + (size_t)(j - 1) * (32 * MiB);
}
constexpr size_t WS_LJ = WS_KI;
constexpr size_t WS_LISTS = 496 * MiB;
constexpr int CW_LCNT = 16384;
static_assert((CW_LCNT + 2 * 1024) * 4 <= (int)CTL_ZERO_BYTES, "list counters inside the memset region");
__device__ __forceinline__ int list_off(int n) { return 256 * (63 * n - (n * (n - 1)) / 2); }
constexpr int IT_K = 0, IT_V = 4 * AT_KBUF, IT_BT = IT_V + 4 * AT_VBUF, IT_QP = IT_BT + 512, IT_OST = 73728;
static_assert(IT_QP + 8 * 128 <= IT_OST && IT_OST + 8 * 4096 <= RING_BYTES, "item LDS map");

template <bool DRY = false> __device__ __forceinline__ void moba_own_unit(Frame& F, int l, int b, int h, int qt) {
    int tid_ = F.tid; asm volatile("" : "+v"(tid_));
    const int tid = tid_, lane = tid & 63, wave = F.wave, r32 = lane & 31, hi = lane >> 5;
    LAS unsigned char* L = F.lds + RING_OFF;
    LAS float* bt = (LAS float*)(L + AT_BT);
    const GAS bf16* Qg = (const GAS bf16*)WSB(WS_QA);
    const size_t rowb = (size_t)b * SEQ;
    const GAS bf16* Kh = (const GAS bf16*)WSB(WS_KA) + rowb * 512 + h * 64; const GAS bf16* Vh = (const GAS bf16*)WSB(WS_VA) + rowb * 512 + h * 64;
    const int q0w = qt * 256 + wave * 32, q = q0w + r32;
    __syncthreads();
    if (tid < 128) { const GAS float* rb = (const GAS float*)INP(I_RELB) + h; bt[tid] = (rb[t5_bucket(tid) * 16] - rb[31 * 16]) * LOG2E; }
    bf16x8_t qf[4];
    { const GAS bf16* qp = Qg + (rowb + q) * 512 + h * 64 + hi * 8;
#pragma unroll
      for (int s = 0; s < 4; ++s) qf[s] = *(const GAS bf16x8_t*)(qp + s * 16); }
    { const int n = tid >> 3, c8 = (tid & 7) * 8; const GAS float* km = (const GAS float*)WSF(WS_KM2) + (((size_t)b * NBLK + n) * 2) * 512 + h * 64 + c8;
      f32x4 a = *(const GAS f32x4*)km + *(const GAS f32x4*)(km + 512), c = *(const GAS f32x4*)(km + 4) + *(const GAS f32x4*)(km + 516);
      a = a * (1.0f / 256.0f); c = c * (1.0f / 256.0f);
      const unsigned h0 = pk2(a.x, a.y), h1 = pk2(a.z, a.w), h2 = pk2(c.x, c.y), h3 = pk2(c.z, c.w);
      const unsigned l0 = pk2(a.x - __uint_as_float(h0 << 16), a.y - __uint_as_float(h0 & 0xffff0000u)), l1 = pk2(a.z - __uint_as_float(h1 << 16), a.w - __uint_as_float(h1 & 0xffff0000u)),
                     l2 = pk2(c.x - __uint_as_float(h2 << 16), c.y - __uint_as_float(h2 & 0xffff0000u)), l3 = pk2(c.z - __uint_as_float(h3 << 16), c.w - __uint_as_float(h3 & 0xffff0000u));
      *(LAS v4u*)(L + AT_K0 + n * AT_KROW + (tid & 7) * 16) = (v4u){h0, h1, h2, h3}; *(LAS v4u*)(L + AT_K0 + AT_KBUF + n * AT_KROW + (tid & 7) * 16) = (v4u){l0, l1, l2, l3}; }
    __syncthreads();
    unsigned mlo = 0u, mhi = 0u;
    if (qt > 0) {
        f32x16 g0 = {0.f, 0.f, 0.f, 0.f, 0.f, 0.f, 0.f, 0.f, 0.f, 0.f, 0.f, 0.f, 0.f, 0.f, 0.f, 0.f}, g1 = g0;
        at_qk(g0, g1, L + AT_K0, qf, r32, hi); at_qk(g0, g1, L + AT_K0 + AT_KBUF, qf, r32, hi);
        MFMA_FENCE2(g0, g1);
#pragma unroll
        for (int r = 0; r < 16; ++r) { if (crow_(r, hi) >= qt) g0[r] = -INFINITY; if (32 + crow_(r, hi) >= qt) g1[r] = -INFINITY; }
#pragma unroll
        for (int it = 0; it < 3; ++it) {
            float bv = -INFINITY; int bn = 64;
#pragma unroll
            for (int r = 0; r < 16; ++r) if (g0[r] > bv) { bv = g0[r]; bn = crow_(r, hi); }
#pragma unroll
            for (int r = 0; r < 16; ++r) if (g1[r] > bv) { bv = g1[r]; bn = 32 + crow_(r, hi); }
            const float pv = __shfl_xor(bv, 32); const int pn = __shfl_xor(bn, 32);
            const bool tp = (pv > bv) || (pv == bv && pn < bn);
            const float wv = tp ? pv : bv; const int wn = tp ? pn : bn;
            if (wv > -INFINITY) { if (wn < 32) mlo |= 1u << wn; else mhi |= 1u << (wn - 32);
                if (hi == 0 && !DRY) { GAS unsigned* cnt = (GAS unsigned*)(F.ws + WS_CTL) + CW_LCNT + ((l * 2 + b) * 8 + h) * 64 + wn;
                    const unsigned slot = __hip_atomic_fetch_add(cnt, 1u, __ATOMIC_RELAXED, __HIP_MEMORY_SCOPE_AGENT);
                    ((GAS unsigned short*)(F.ws + WS_LISTS) + ((size_t)(b * 8 + h) << 19))[list_off(wn) + slot] = (unsigned short)(q | (it << 14)); } }
#pragma unroll
            for (int r = 0; r < 16; ++r) { if (crow_(r, hi) == wn) g0[r] = -INFINITY; if (32 + crow_(r, hi) == wn) g1[r] = -INFINITY; }
        }
    }
    __syncthreads();
    v4u kr, vr;
    at_load(Kh, Vh, 4 * qt, tid, kr, vr);
    at_store(L + AT_K0, L + AT_V0, tid, kr, vr);
    __syncthreads();
    float m = -1e30f, lsum = 0.f;
    f32x16 o0 = {0.f, 0.f, 0.f, 0.f, 0.f, 0.f, 0.f, 0.f, 0.f, 0.f, 0.f, 0.f, 0.f, 0.f, 0.f, 0.f}, o1 = o0;
#pragma unroll 1
    for (int tt = 0; tt < 4; ++tt) {
        const int t = 4 * qt + tt, cur = tt & 1;
        if (tt + 1 < 4) at_load(Kh, Vh, t + 1, tid, kr, vr);
        const int nall = q - t * 64 + 1;
        const unsigned wlo = nall >= 32 ? 0xffffffffu : (nall <= 0 ? 0u : ((1u << nall) - 1u)), whi = nall >= 64 ? 0xffffffffu : (nall <= 32 ? 0u : ((1u << (nall - 32)) - 1u));
        if (__any((wlo | whi) != 0u)) {
            const LAS unsigned char* kb = L + AT_K0 + cur * AT_KBUF; const LAS unsigned char* vb = L + AT_V0 + cur * AT_VBUF;
            f32x16 p0 = {0.f, 0.f, 0.f, 0.f, 0.f, 0.f, 0.f, 0.f, 0.f, 0.f, 0.f, 0.f, 0.f, 0.f, 0.f, 0.f}, p1 = p0;
            at_qk(p0, p1, kb, qf, r32, hi);
            MFMA_FENCE2(p0, p1);
#pragma unroll
            for (int r = 0; r < 16; ++r) { const int d0 = q - (t * 64 + crow_(r, hi)), d1 = d0 - 32;
                const float b0 = ((unsigned)d0 < 128u) ? bt[d0] : 0.f, b1 = ((unsigned)d1 < 128u) ? bt[d1] : 0.f;
                p0[r] = p0[r] * AT_C2 + b0; p1[r] = p1[r] * AT_C2 + b1; }
            float mx;
            { float ma = max3_(p0[0], p1[0], p0[1]), mb = max3_(p1[1], p0[2], p1[2]), mc = max3_(p0[3], p1[3], p0[4]), md = max3_(p1[4], p0[5], p1[5]);
              ma = max3_(ma, p0[6], p1[6]); mb = max3_(mb, p0[7], p1[7]); mc = max3_(mc, p0[8], p1[8]); md = max3_(md, p0[9], p1[9]);
              ma = max3_(ma, p0[10], p1[10]); mb = max3_(mb, p0[11], p1[11]); mc = max3_(mc, p0[12], p1[12]); md = max3_(md, p0[13], p1[13]);
              ma = max3_(ma, p0[14], p1[14]); mb = max3_(mb, p0[15], p1[15]); mx = max3_(ma, mb, mc); mx = max3_(mx, md, md); }
            mx = max3_(mx, __shfl_xor(mx, 32), mx);
            if (__any(mx > m + AT_THR)) {
                const float mn = fmaxf(m, mx); const float al = __builtin_amdgcn_exp2f(m - mn);
                MFMA_FENCE2(o0, o1);
#pragma unroll
                for (int r = 0; r < 16; ++r) { o0[r] *= al; o1[r] *= al; }
                lsum *= al; m = mn;
            }
            const unsigned wl = wlo >> (4 * hi), wh = whi >> (4 * hi);
            float lq[4] = {0.f, 0.f, 0.f, 0.f};
#pragma unroll
            for (int r = 0; r < 16; ++r) { const int cb = (r & 3) + 8 * (r >> 2);
                const float e0 = __uint_as_float(and_sel(__builtin_amdgcn_exp2f(p0[r] - m), wl, cb)), e1 = __uint_as_float(and_sel(__builtin_amdgcn_exp2f(p1[r] - m), wh, cb));
                p0[r] = e0; p1[r] = e1; lq[r & 1] += e0; lq[2 + (r & 1)] += e1; }
            lsum += (lq[0] + lq[1]) + (lq[2] + lq[3]);
            bf16x8_t pb[4];
#pragma unroll
            for (int sg = 0; sg < 4; ++sg) { union { bf16x8_t v; unsigned u[4]; } pk;
#pragma unroll
                for (int j = 0; j < 4; ++j) { const int r = 8 * (sg & 1) + 2 * j; pk.u[j] = (sg < 2) ? pg8::cvt_pk_bf16(p0[r], p0[r + 1]) : pg8::cvt_pk_bf16(p1[r], p1[r + 1]); }
                pb[sg] = pk.v; }
            at_pv(o0, o1, vb, pb, r32, hi);
        }
        if (tt + 1 < 4) at_store(L + AT_K0 + (cur ^ 1) * AT_KBUF, L + AT_V0 + (cur ^ 1) * AT_VBUF, tid, kr, vr);
        __syncthreads();
    }
    MFMA_FENCE2(o0, o1);
    lsum += __shfl_xor(lsum, 32);
    if (hi == 0 && !DRY) { ((GAS float*)WSF(WS_MREF))[(rowb + q) * 8 + h] = m; ((GAS float*)WSF(WS_LACC))[(rowb + q) * 8 + h] = lsum; }
    LAS bf16* ost = (LAS bf16*)(L + AT_OST + wave * 4096);
#pragma unroll
    for (int r = 0; r < 16; ++r) { ost[r32 * 64 + crow_(r, hi)] = (bf16)f2bf(o0[r]); ost[r32 * 64 + 32 + crow_(r, hi)] = (bf16)f2bf(o1[r]); }
    LDS_WAIT(); asm volatile("" ::: "memory");
    GAS bf16* Og = (GAS bf16*)WSB(WS_PO) + (rowb + q0w) * 512 + h * 64;
#pragma unroll
    for (int i = 0; i < 4; ++i) { const int c = i * 64 + lane, row = c >> 3, ch = c & 7; const v4u ov = *(const LAS v4u*)(ost + row * 64 + ch * 8); if (!DRY || (ov.x == 0x12345678u && ov.y == 0x9abcdef0u)) *(GAS v4u*)(Og + (size_t)row * 512 + ch * 8) = ov; }
}

template <bool DRY = false> __device__ __forceinline__ void moba_item_unit(Frame& F, int l, int b, int h, int n) {
    int tid_ = F.tid; asm volatile("" : "+v"(tid_));
    const int tid = tid_, lane = tid & 63, wave = F.wave, r32 = lane & 31, hi = lane >> 5;
    LAS unsigned char* L = F.lds + RING_OFF;
    LAS float* bt = (LAS float*)(L + IT_BT);
    const size_t rowb = (size_t)b * SEQ;
    const int cnt = (int)((const GAS unsigned*)(F.ws + WS_CTL))[CW_LCNT + ((l * 2 + b) * 8 + h) * 64 + n];
    if (cnt == 0) return;
    const GAS bf16* Kh = (const GAS bf16*)WSB(WS_KA) + rowb * 512 + h * 64; const GAS bf16* Vh = (const GAS bf16*)WSB(WS_VA) + rowb * 512 + h * 64;
    __syncthreads();
    if (tid < 128) { const GAS float* rb = (const GAS float*)INP(I_RELB) + h; bt[tid] = (rb[t5_bucket(tid) * 16] - rb[31 * 16]) * LOG2E; }
#pragma unroll
    for (int t = 0; t < 4; ++t) { v4u kr, vr; at_load(Kh, Vh, 4 * n + t, tid, kr, vr); at_store(L + IT_K + t * AT_KBUF, L + IT_V + t * AT_VBUF, tid, kr, vr); }
    __syncthreads();
    const GAS unsigned short* lst = (const GAS unsigned short*)(F.ws + WS_LISTS) + ((size_t)(b * 8 + h) << 19) + list_off(n);
    LAS int* qpl = (LAS int*)(L + IT_QP + wave * 128);
    LAS float* ostf = (LAS float*)(L + IT_OST + wave * 4096);
    const int ngrp = (cnt + 31) >> 5;
#pragma unroll 1
    for (int g = wave; g < ngrp; g += NWAVES) {
        const int li = g * 32 + r32; const bool valid = li < cnt;
        const int ent = valid ? (int)lst[li] : (int)lst[g * 32];
        const int q = ent & 0x3fff;
        if (hi == 0) qpl[r32] = valid ? ent : -1;
        bf16x8_t qf[4];
        { const GAS bf16* qp = (const GAS bf16*)WSB(WS_QA) + (rowb + q) * 512 + h * 64 + hi * 8;
#pragma unroll
          for (int s = 0; s < 4; ++s) qf[s] = *(const GAS bf16x8_t*)(qp + s * 16); }
        const float mref = ((const GAS float*)WSF(WS_MREF))[(rowb + q) * 8 + h];
        const bool near = __any(q < 256 * (n + 1) + 128);
        float lsum = 0.f;
        f32x16 o0 = {0.f, 0.f, 0.f, 0.f, 0.f, 0.f, 0.f, 0.f, 0.f, 0.f, 0.f, 0.f, 0.f, 0.f, 0.f, 0.f}, o1 = o0;
#pragma unroll 1
        for (int t = 0; t < 4; ++t) {
            const LAS unsigned char* kb = L + IT_K + t * AT_KBUF; const LAS unsigned char* vb = L + IT_V + t * AT_VBUF;
            f32x16 p0 = {0.f, 0.f, 0.f, 0.f, 0.f, 0.f, 0.f, 0.f, 0.f, 0.f, 0.f, 0.f, 0.f, 0.f, 0.f, 0.f}, p1 = p0;
            at_qk(p0, p1, kb, qf, r32, hi);
            MFMA_FENCE2(p0, p1);
            float lq[4] = {0.f, 0.f, 0.f, 0.f};
            if (near) {
#pragma unroll
                for (int r = 0; r < 16; ++r) { const int d0 = q - ((4 * n + t) * 64 + crow_(r, hi)), d1 = d0 - 32;
                    const float b0 = ((unsigned)d0 < 128u) ? bt[d0] : 0.f, b1 = ((unsigned)d1 < 128u) ? bt[d1] : 0.f;
                    const float e0 = __builtin_amdgcn_exp2f(fminf(__builtin_fmaf(p0[r], AT_C2, -mref) + b0, 60.f)), e1 = __builtin_amdgcn_exp2f(fminf(__builtin_fmaf(p1[r], AT_C2, -mref) + b1, 60.f));
                    p0[r] = e0; p1[r] = e1; lq[r & 1] += e0; lq[2 + (r & 1)] += e1; }
            } else {
#pragma unroll
                for (int r = 0; r < 16; ++r) { const float e0 = __builtin_amdgcn_exp2f(fminf(__builtin_fmaf(p0[r], AT_C2, -mref), 60.f)), e1 = __builtin_amdgcn_exp2f(fminf(__builtin_fmaf(p1[r], AT_C2, -mref), 60.f));
                    p0[r] = e0; p1[r] = e1; lq[r & 1] += e0; lq[2 + (r & 1)] += e1; }
            }
            lsum += (lq[0] + lq[1]) + (lq[2] + lq[3]);
            bf16x8_t pb[4];
#pragma unroll
            for (int sg = 0; sg < 4; ++sg) { union { bf16x8_t v; unsigned u[4]; } pk;
#pragma unroll
                for (int j = 0; j < 4; ++j) { const int r = 8 * (sg & 1) + 2 * j; pk.u[j] = (sg < 2) ? pg8::cvt_pk_bf16(p0[r], p0[r + 1]) : pg8::cvt_pk_bf16(p1[r], p1[r + 1]); }
                pb[sg] = pk.v; }
            at_pv(o0, o1, vb, pb, r32, hi);
        }
        MFMA_FENCE2(o0, o1);
        lsum += __shfl_xor(lsum, 32);
        if (hi == 0 && valid && !DRY) ((GAS float*)WSF(WS_LJ))[((size_t)(ent >> 14) * T + rowb + q) * 8 + h] = lsum;
        LAS bf16* ost = (LAS bf16*)ostf;
#pragma unroll
        for (int r = 0; r < 16; ++r) { ost[r32 * 64 + crow_(r, hi)] = (bf16)f2bf(o0[r]); ost[r32 * 64 + 32 + crow_(r, hi)] = (bf16)f2bf(o1[r]); }
        LDS_WAIT(); asm volatile("" ::: "memory");
#pragma unroll
        for (int i = 0; i < 4; ++i) { const int c = i * 64 + lane, row = c >> 3, ch = c & 7; const int er = qpl[row];
            if (er >= 0 && !DRY) { const int j = er >> 14; GAS bf16* pj = (GAS bf16*)pj_base(F, l, j);
                *(GAS v4u*)(pj + (rowb + (er & 0x3fff)) * 512 + h * 64 + ch * 8) = *(const LAS v4u*)(ost + row * 64 + ch * 8); } }
        LDS_WAIT(); asm volatile("" ::: "memory");
    }
}
__device__ __forceinline__ void moba_fin_row(Frame& F, int layer, int m, int lane) {
    const int nsel = ((m & (SEQ - 1)) >> 8) < 3 ? ((m & (SEQ - 1)) >> 8) : 3;
    const int hd = lane >> 3;
    float l = ((const GAS float*)WSF(WS_LACC))[(size_t)m * 8 + hd];
    v4u v = ((const GAS v4u*)((const GAS bf16*)WSB(WS_PO) + (size_t)m * 512))[lane];
    float acc[8] = { __uint_as_float(v.x << 16), __uint_as_float(v.x & 0xffff0000u), __uint_as_float(v.y << 16), __uint_as_float(v.y & 0xffff0000u),
                     __uint_as_float(v.z << 16), __uint_as_float(v.z & 0xffff0000u), __uint_as_float(v.w << 16), __uint_as_float(v.w & 0xffff0000u) };
#pragma unroll
    for (int j = 0; j < 3; ++j) if (j < nsel) {
        l += ((const GAS float*)WSF(WS_LJ))[((size_t)j * T + m) * 8 + hd];
        const v4u w = ((const GAS v4u*)((const GAS bf16*)pj_base(F, layer, j) + (size_t)m * 512))[lane];
        acc[0] += __uint_as_float(w.x << 16); acc[1] += __uint_as_float(w.x & 0xffff0000u); acc[2] += __uint_as_float(w.y << 16); acc[3] += __uint_as_float(w.y & 0xffff0000u);
        acc[4] += __uint_as_float(w.z << 16); acc[5] += __uint_as_float(w.z & 0xffff0000u); acc[6] += __uint_as_float(w.w << 16); acc[7] += __uint_as_float(w.w & 0xffff0000u); }
    const float inv = 1.0f / l;
    v4u o; o.x = pk2(acc[0] * inv, acc[1] * inv); o.y = pk2(acc[2] * inv, acc[3] * inv); o.z = pk2(acc[4] * inv, acc[5] * inv); o.w = pk2(acc[6] * inv, acc[7] * inv);
    ((GAS v4u*)((GAS bf16*)WSB(WS_QA) + (size_t)m * 512))[lane] = o;
}
__global__ void __launch_bounds__(NWAVES * 64, 2) fwd(Args args) {
    extern __shared__ __attribute__((aligned(16))) unsigned char lds[];
    Frame F;
    F.lds = (LAS unsigned char*)lds;
        F.tid = threadIdx.x; F.lane = F.tid & 63; F.wave = __builtin_amdgcn_readfirstlane(F.tid >> 6);
    F.G = gridDim.x; F.bid = blockIdx.x;
    F.a = (const __attribute__((address_space(4))) Args*)__builtin_amdgcn_kernarg_segment_ptr(); F.ws = args.ws; F.out = args.out;
    unsigned char* ws = args.ws;
    for (int u = F.tid; u < (LDS_BYTES - LDSCTL_OFF) / 4; u += NWAVES * 64) ((LAS unsigned*)(F.lds + LDSCTL_OFF))[u] = 0u;
    __syncthreads();
    {
        volatile LAS unsigned* pw = (volatile LAS unsigned*)(F.lds + MISC_OFF) + 64;
        const unsigned hw = __builtin_amdgcn_s_getreg((4 << 0) | (4 << 6) | (1 << 11));
        if (F.lane == 0) pw[F.wave] = hw & 3u;
        __syncthreads();
        const unsigned my = pw[F.wave]; unsigned cnts = 0, rank = 0;
#pragma unroll
        for (int w = 0; w < NWAVES; ++w) { const unsigned s = pw[w]; cnts += 1u << (8 * s); if (w < F.wave && s == my) ++rank; }
#ifdef BAD_ROLES
        F.gw = __builtin_amdgcn_readfirstlane((cnts == 0x02020202u) ? (int)((my >> 1) * 4 + (my & 1) * 2 + rank) : F.wave);
#else
        F.gw = __builtin_amdgcn_readfirstlane((cnts == 0x02020202u) ? (int)(rank * 4 + my) : F.wave);
#endif
        __syncthreads();
    }
    XcdBarrier bar; bar.bar = (unsigned*)(ws + WS_CTL) + CW_BAR; bar.x = 0; bar.st = nullptr;
    if (ONE_LAUNCH) bar = xcd_barrier_post((unsigned*)(ws + WS_CTL) + CW_BAR, (volatile LAS unsigned*)(F.lds + MISC_OFF) + 8);
#define GRID_BAR() do { if (ONE_LAUNCH) xcd_barrier(bar); } while (0)
    const int lo = args.ph_lo, hi = args.ph_hi;
#ifndef PH_MASK
#define PH_MASK 0xfff
#endif
#define IN(k) (((PH_MASK >> ((k) % PH_PER_LAYER == 0 && (k) == 2 * PH_PER_LAYER ? 11 : (k) % PH_PER_LAYER)) & 1) && lo <= (k) && (k) < hi)
#define BOTH(k) (IN(k) && IN((k) + 1))
#define GEMM_TID ((F.gw << 6) | F.lane)
#define DYN_CTR(k) ((unsigned*)(F.ws + WS_CTL) + CW_DYN + 32 * (k))
#define DYN_FETCH(dst, k) do { __syncthreads(); if (F.tid == 0) *((volatile LAS unsigned*)(F.lds + MISC_OFF) + 32) = atomicAdd(DYN_CTR(k), 1u); __syncthreads(); \
        dst = (int)__builtin_amdgcn_readfirstlane(*((volatile LAS unsigned*)(F.lds + MISC_OFF) + 32)); } while (0)
#define LAUNDER() do { asm volatile("" : "+v"(F.tid)); F.lane = F.tid & 63; F.wave = __builtin_amdgcn_readfirstlane(F.tid >> 6); F.ws = launder_u(F.ws); F.out = launder_u(F.out); F.a = launder_u(F.a); F.bid = launder_i(F.bid); F.G = launder_i(F.G); F.gw = launder_i(F.gw); } while (0)
    LAS unsigned char* ring = F.lds + RING_OFF;
    for (int l = 0; l < 2; ++l) {
        const int P = l * PH_PER_LAYER;
#ifdef DBG_DUMP
        if (lo == DBG_PHASE && l == 0) { for (int u = F.bid; u < T; u += F.G) { F.out[(size_t)u * DM + F.tid] = bf2f(WSB(DBG_DUMP)[(size_t)u * DBG_PITCH + F.tid]); F.out[(size_t)u * DM + 512 + F.tid] = 0.f; } }
        if (lo >= DBG_PHASE && lo < 2 * PH_PER_LAYER) continue;
#endif
        if (IN(P + 0)) { LAUNDER(); p_prologue(F, l); if (PROBE_SEL & 128) { VM_WAIT(); __syncthreads(); p_prologue(F, l); } if (BOTH(P + 0)) GRID_BAR(); }
        if (IN(P + 1)) { LAUNDER();
            pg8::Gemm g{WSB(WS_XB), WSB(WS_W_IN), T, NIN_T, DM}; pg8::StaticOrder S; S.init(T, NIN_T, F.G, F.bid);
            pg8::EpiInproj E{WSB(WS_QA), WSB(WS_KI), WSF(WS_WI), SSQ_MIX(l), WSF(WS_KM2)};
            pg8::gemm_phase<pg8::EpiInproj, pg8::StaticOrder, true, PG8_SP2>(ring, g, S, E, GEMM_TID);
            if (PROBE_SEL & 32) { VM_WAIT(); __syncthreads(); LAUNDER(); pg8::gemm_phase<pg8::EpiInproj, pg8::StaticOrder, true, PG8_SP2>(ring, g, S, E, GEMM_TID); }
            if (BOTH(P + 1)) GRID_BAR();
        }
        if (IN(P + 2)) { LAUNDER();
#ifndef FAST_DSA
#define FAST_DSA 1
#endif
            if ((PROBE_SEL & 1024) && F.bid < 256) { for (int r = 0; r < 4; ++r) { const int i = r * 256 + F.bid; moba_own_unit<true>(F, l, (i & 15) >> 3, i & 7, i >> 4); } __syncthreads(); }
            if (FAST_MOBA == 2 && F.bid < 256) { for (int r = 0; r < 4; ++r) { const int i = r * 256 + F.bid; moba_own_unit<false>(F, l, (i & 15) >> 3, i & 7, i >> 4); } __syncthreads(); }
            for (int rep = 0; rep < ((PROBE_SEL & 64) ? 2 : 1); ++rep)
            for (int u = F.bid; u < 2 * RGC; u += F.G) rg_unit<false>(F, l, u / RGC, u % RGC);
            if (FAST_DSA) {
                for (;;) { int i; DYN_FETCH(i, 2 * l); if (i >= 2048) break; const int stt = 63 - (i >> 5), j = i & 31; idx_unit(F, j >> 4, stt * 256 + (j & 15) * 16); }
                __syncthreads();
            }
            if (BOTH(P + 2)) GRID_BAR();
        }
        if (IN(P + 3)) { LAUNDER();
            #ifndef MIX2_SEL
#define MIX2_SEL 7
#endif
            if (MIX2_SEL & 1) for (int u = F.bid; u < 2 * RGC; u += F.G) rg_unit<true>(F, l, u / RGC, u % RGC);
            if (FAST_MOBA == 2 && F.bid < 256) {
                if (PROBE_SEL & 2048) for (int r = 0; r < 4; ++r) { const int g = F.bid; const int i = r * 256 + ((r & 1) ? 255 - g : g); moba_item_unit<true>(F, l, (i & 15) >> 3, i & 7, i >> 4); }
                for (int r = 0; r < 4; ++r) { const int g = F.bid; const int i = r * 256 + ((r & 1) ? 255 - g : g); moba_item_unit<false>(F, l, (i & 15) >> 3, i & 7, i >> 4); }
                __syncthreads();
            }
            if (FAST_MOBA == 1 && (MIX2_SEL & 2)) {
                if (PROBE_SEL & 1) { for (int r = 0; r < 4; ++r) { const int g = F.bid % 256; const int i = r * 256 + ((r & 1) ? 255 - g : g); if (F.bid >= 256) break;
                    const int qt = 63 - (i >> 4), bh = i & 15; attn_unit<0, true>(F, bh >> 3, bh & 7, qt); } }
                for (int r = 0; r < 4; ++r) { const int g = F.bid % 256; const int i = r * 256 + ((r & 1) ? 255 - g : g); if (F.bid >= 256) break;
                    const int qt = 63 - (i >> 4), bh = i & 15; attn_unit<0>(F, bh >> 3, bh & 7, qt); }
                __syncthreads();
            }
            if (FAST_DSA && (MIX2_SEL & 4)) {
                if (PROBE_SEL & 2) { for (int r = 0; r < 4; ++r) { const int g = F.bid % 256; const int i = r * 256 + ((r & 1) ? 255 - g : g); if (F.bid >= 256) break;
                    const int qt = 63 - (i >> 4), bh = i & 15; dsa_attn2_unit<true>(F, bh >> 3, bh & 7, qt); } }
                { const int xq = F.bid & 7;
                  for (;;) { int i; DYN_FETCH(i, 4 + 8 * l + xq); if (i >= 128) break;
                    const int qt = 63 - (i >> 1), bh = 2 * xq + (i & 1); dsa_attn2_unit<false>(F, bh >> 3, bh & 7, qt); } }
                __syncthreads();
            }
            if (!(FAST_MOBA && FAST_DSA)) for (int u = F.bid; u < T; u += F.G) { const int b = u & 1, t = u >> 1; if (FAST_MOBA == 0 && (MIX2_SEL & 2)) moba_unit(F, b, t); if (!FAST_DSA && (MIX2_SEL & 4)) dsa_unit(F, b, t); }
            for (int u = F.bid; u < T; u += F.G) { if (!(MIX2_SEL & 2)) WSB(WS_QA)[(size_t)u * 512 + F.tid] = 0; if (!(MIX2_SEL & 4)) WSB(WS_QB)[(size_t)u * 512 + F.tid] = 0; if (!(MIX2_SEL & 1)) WSB(WS_YC)[(size_t)u * 512 + F.tid] = 0; }
            if (BOTH(P + 3)) GRID_BAR();
        }

        if (IN(P + 4)) { LAUNDER();
            if (FAST_MOBA == 2) { const int gw = F.bid * NWAVES + F.wave, NGW = F.G * NWAVES;
                for (int m = gw; m < T; m += NGW) moba_fin_row(F, l, m, F.lane); }
            if (BOTH(P + 4)) GRID_BAR();
        }
        if (IN(P + 5)) { LAUNDER();
            pg8::Gemm g{WSB(WS_XB), WSB(WS_W_G), T, 3072, DM}; pg8::StaticOrder S; S.init(T, 3072, F.G, F.bid);
            pg8::EpiGates E{WSB(WS_G), SSQ_MIX(l)};
            pg8::gemm_phase<pg8::EpiGates, pg8::StaticOrder, true, PG8_SP2>(ring, g, S, E, GEMM_TID);
            if (PROBE_SEL & 32) { VM_WAIT(); __syncthreads(); LAUNDER(); pg8::gemm_phase<pg8::EpiGates, pg8::StaticOrder, true, PG8_SP2>(ring, g, S, E, GEMM_TID); }
            if (BOTH(P + 5)) GRID_BAR();
        }
        if (IN(P + 6)) { LAUNDER();
            pg8::StaticOrder S; S.init(T, DM, F.G, F.bid);
            { pg8::Gemm g{WSB(WS_QA), WSB(WS_W_PA), T, DM, DH}; pg8::EpiMerge<true> E{WSB(WS_G), WSB(WS_MERGED)}; pg8::gemm_phase<pg8::EpiMerge<true>, pg8::StaticOrder, true, PG8_SP2>(ring, g, S, E, GEMM_TID); }
#ifndef MERGE_CALLS
#define MERGE_CALLS 3
#endif
            VM_WAIT(); __syncthreads(); LAUNDER();
            if (MERGE_CALLS >= 2) { pg8::Gemm g{WSB(WS_QB), WSB(WS_W_PB), T, DM, DH}; pg8::EpiMerge<false> E{WSB(WS_G) + (size_t)T * 1024, WSB(WS_MERGED)}; pg8::gemm_phase<pg8::EpiMerge<false>, pg8::StaticOrder, true, PG8_SP2>(ring, g, S, E, GEMM_TID); }
            VM_WAIT(); __syncthreads(); LAUNDER();
            if (MERGE_CALLS >= 3) { pg8::Gemm g{WSB(WS_YC), WSB(WS_W_PC), T, DM, DH}; pg8::EpiMerge<false> E{WSB(WS_G) + (size_t)2 * T * 1024, WSB(WS_MERGED)}; pg8::gemm_phase<pg8::EpiMerge<false>, pg8::StaticOrder, true, PG8_SP2>(ring, g, S, E, GEMM_TID); }
            if (BOTH(P + 6)) GRID_BAR();
        }
        if (IN(P + 7)) { LAUNDER();
            pg8::Gemm g{WSB(WS_MERGED), WSB(WS_W_O), T, DM, DM}; pg8::StaticOrder S; S.init(T, DM, F.G, F.bid);
            pg8::EpiResidB E{WSB(WS_XB), SSQ_MLP(l)};
            pg8::gemm_phase<pg8::EpiResidB, pg8::StaticOrder, true, PG8_SP2>(ring, g, S, E, GEMM_TID);
            if (BOTH(P + 7)) GRID_BAR();
        }
        if (IN(P + 8)) {   }
        if (IN(P + 9)) { LAUNDER();
            pg8::Gemm g{WSB(WS_XB), WSB(WS_W_UP), T, DFF, DM}; pg8::StaticOrder S; S.init(T, DFF, F.G, F.bid);
            pg8::EpiUp E{WSB(WS_H), SSQ_MLP(l)};
            pg8::gemm_phase<pg8::EpiUp, pg8::StaticOrder, true, PG8_SP2>(ring, g, S, E, GEMM_TID);
            if (PROBE_SEL & 32) { VM_WAIT(); __syncthreads(); LAUNDER(); pg8::gemm_phase<pg8::EpiUp, pg8::StaticOrder, true, PG8_SP2>(ring, g, S, E, GEMM_TID); }
            if (BOTH(P + 9)) GRID_BAR();
        }
        if (IN(P + 10)) { LAUNDER();
            pg8::Gemm g{WSB(WS_H), WSB(WS_W_DN), T, DM, DFF}; pg8::StaticOrder S; S.init(T, DM, F.G, F.bid);
            pg8::EpiResidB E{WSB(WS_XB), (l == 0) ? SSQ_CTL + T : (pg8::ssq_t*)nullptr};
            pg8::gemm_phase<pg8::EpiResidB, pg8::StaticOrder, true, PG8_SP2>(ring, g, S, E, GEMM_TID);
            if (BOTH(P + 10)) GRID_BAR();
        }
    }
    if (IN(2 * PH_PER_LAYER)) { LAUNDER(); p_final(F); }
#undef IN
#undef BOTH
#undef GRID_BAR
}

extern "C" void kernel_launch(void* const* d_in, const int* in_sizes, int n_in, void* d_out, int out_size, void* d_ws, size_t ws_size, hipStream_t stream) {
    static int grid = 0;
    if (grid == 0) {
        if (n_in != 19 || in_sizes[0] != T * DM || out_size != T * DM || ws_size < WS_END) { fprintf(stderr, "kernel_launch: unexpected shapes (n_in %d, in0 %d, out %d, ws %zu)\n", n_in, n_in > 0 ? in_sizes[0] : -1, out_size, ws_size); grid = -1; return; }
        int dev = 0, cus = 0, per_cu = 0;
        if (hipGetDevice(&dev) != hipSuccess || hipDeviceGetAttribute(&cus, hipDeviceAttributeMultiprocessorCount, dev) != hipSuccess) { grid = -1; return; }
        if (hipFuncSetAttribute((const void*)fwd, hipFuncAttributeMaxDynamicSharedMemorySize, LDS_BYTES) != hipSuccess) { fprintf(stderr, "kernel_launch: hipFuncSetAttribute failed\n"); grid = -1; return; }
        if (hipOccupancyMaxActiveBlocksPerMultiprocessor(&per_cu, (const void*)fwd, NWAVES * 64, LDS_BYTES) != hipSuccess || per_cu < 1) { fprintf(stderr, "kernel_launch: occupancy query says %d\n", per_cu); }
        (void)hipGetLastError();
        grid = cus;
    }
    if (grid < 0) return;
    if (hipMemsetAsync((char*)d_ws + WS_CTL, 0, CTL_ZERO_BYTES, stream) != hipSuccess) return;
    Args a{};
    for (int i = 0; i < 19; ++i) a.in[i] = (const float*)d_in[i];
    a.out = (float*)d_out; a.ws = (unsigned char*)d_ws;
    if (ONE_LAUNCH) { a.ph_lo = 0; a.ph_hi = N_PHASES; hipLaunchKernelGGL(fwd, dim3(grid), dim3(NWAVES * 64), LDS_BYTES, stream, a); }
    else for (int p = 0; p < N_PHASES; ++p) { a.ph_lo = p; a.ph_hi = p + 1; hipLaunchKernelGGL(fwd, dim3(grid), dim3(NWAVES * 64), LDS_BYTES, stream, a); }
}
```

```cpp
#include <hip/hip_runtime.h>
#include <cstdio>
#include <cstdint>

#ifndef MK_ONE_LAUNCH
#define MK_ONE_LAUNCH 1
#endif

constexpr int BATCH = 2, SEQ = 16384, DM = 1024, T = BATCH * SEQ;
constexpr int DIN = 7752, DFF = 4096, DH = 512;
constexpr int NIN_T = 4864;
constexpr int NBLK = SEQ / 256;
constexpr float EPS = 1e-6f;

namespace pg8 {
#define PG8_LAS __attribute__((address_space(3)))
typedef unsigned short bf16_t;
typedef short bf16x8 __attribute__((ext_vector_type(8)));
typedef float f32x4 __attribute__((ext_vector_type(4)));
typedef unsigned u32x4 __attribute__((ext_vector_type(4)));
constexpr int BM = 256, BK = 64, HALF = 128, HTB = HALF * BK * 2  , STAGE_BYTES = 8 * HTB, NXCD = 8, WGM = 8;

__host__ __device__ __forceinline__ int lds_byte(int r, int c) { const int st = (r >> 4) * 2 + (c >> 5), rr = r & 15, cc = c & 31, ob = rr * 64 + cc * 2; return st * 1024 + (ob ^ (((ob >> 9) & 1) << 5)); }
__host__ __device__ __forceinline__ void stage_rc(int b, int& R, int& C) { const int st = b / 1024, sb = b % 1024, swz = sb ^ (((sb >> 9) & 1) << 5); R = (st >> 1) * 16 + swz / 64; C = (st & 1) * 32 + (swz % 64) / 2; }
__host__ __device__ __forceinline__ int perm32(int rho) { const int n = rho >> 4, i = rho & 15; return 8 * (i >> 2) + 4 * n + (i & 3); }

struct Unit { int pm, pn; };
struct Gemm { const bf16_t* A; const bf16_t* Bt; int M, N, K; };

struct StaticOrder {
    int nM, nN, nwg, G, c;
    __host__ __device__ void init(int M, int N, int G_, int c_) { nM = M / BM; nN = N / BM; nwg = nM * nN; G = G_; c = c_; }
    __host__ __device__ bool next(int i, Unit& u) const {
        const long L = (long)i * G + c; if (L >= nwg) return false;
        int wgid = (int)L; { const int q = nwg / NXCD, r = nwg % NXCD, xcd = wgid % NXCD, off = wgid / NXCD; wgid = (xcd < r ? xcd * (q + 1) : r * (q + 1) + (xcd - r) * q) + off; }
        const int nig = WGM * nN, gid = wgid / nig, fm = gid * WGM, gsz = (nM - fm) < WGM ? (nM - fm) : WGM;
        u.pm = fm + ((wgid % nig) % gsz); u.pn = (wgid % nig) / gsz; return true;
    }
    __device__ __forceinline__ void a_ready(const Unit&) const {}
    __device__ __forceinline__ void done(const Unit&) const {}
};

typedef float f32x2_t __attribute__((ext_vector_type(2))); typedef __bf16 bf16x2_t __attribute__((ext_vector_type(2)));
typedef unsigned long long ssq_t;
constexpr float SSQ_ONE = 16777216.0f;
__device__ __forceinline__ float ssq_rs(const ssq_t* a, int row) { return __builtin_amdgcn_rsqf((float)a[row] * (1.0f / (SSQ_ONE * 1024.0f)) + EPS); }
__device__ __forceinline__ unsigned cvt_pk_bf16(float lo, float hi) { f32x2_t v = {lo, hi}; bf16x2_t b = __builtin_convertvector(v, bf16x2_t); return __builtin_bit_cast(unsigned, b); }
__device__ __forceinline__ float bf_lo(unsigned w) { return __uint_as_float(w << 16); }
__device__ __forceinline__ float bf_hi(unsigned w) { return __uint_as_float(w & 0xffff0000u); }

struct EpiInproj {
    static constexpr bool PERM = true, AFTER_DRAIN = false;
    bf16_t* base; bf16_t* ki; float* wi; const ssq_t* rstd  ; float* km2;
    __device__ __forceinline__ void operator()(const f32x4 (&acc)[2][2][4][2], const Unit& u, int wr, int wc, int fr, int fq) const {
        const int row0 = u.pm * BM + wr * 64 + fr;
        if (u.pn < 18) {
            bf16_t* dst = base + (size_t)(u.pn >> 1) * ((size_t)T * 512) + (u.pn & 1) * 256 + wc * 32 + 8 * fq;
            const bool ksum = (u.pn >> 1) == 3;
            f32x4 cs[2][2] = {{{0.f, 0.f, 0.f, 0.f}, {0.f, 0.f, 0.f, 0.f}}, {{0.f, 0.f, 0.f, 0.f}, {0.f, 0.f, 0.f, 0.f}}};
#pragma unroll
            for (int ai = 0; ai < 2; ++ai)
#pragma unroll
                for (int m = 0; m < 4; ++m) { const int row = row0 + ai * HALF + m * 16; const float rs = ssq_rs(rstd, row); bf16_t* rowp = dst + (size_t)row * 512;
#pragma unroll
                    for (int bj = 0; bj < 2; ++bj) { const f32x4 v0 = acc[ai][bj][m][0] * rs, v1 = acc[ai][bj][m][1] * rs;
                        if (ksum) { cs[bj][0] += v0; cs[bj][1] += v1; }
                        u32x4 w; w.x = cvt_pk_bf16(v0[0], v0[1]); w.y = cvt_pk_bf16(v0[2], v0[3]); w.z = cvt_pk_bf16(v1[0], v1[1]); w.w = cvt_pk_bf16(v1[2], v1[3]);
                        *(u32x4*)(rowp + bj * HALF) = w; } }
            if (ksum) {
#pragma unroll
                for (int bj = 0; bj < 2; ++bj)
#pragma unroll
                    for (int n = 0; n < 2; ++n)
#pragma unroll
                        for (int j = 0; j < 4; ++j) { float v = cs[bj][n][j]; v += __shfl_xor(v, 1); v += __shfl_xor(v, 2); v += __shfl_xor(v, 4); v += __shfl_xor(v, 8); cs[bj][n][j] = v; }
                if (fr == 0) { float* kd = km2 + ((size_t)u.pm * 2 + wr) * 512 + (u.pn & 1) * 256 + wc * 32 + 8 * fq;
#pragma unroll
                    for (int bj = 0; bj < 2; ++bj) { *(f32x4*)(kd + bj * HALF) = cs[bj][0]; *(f32x4*)(kd + bj * HALF + 4) = cs[bj][1]; } }
            }
        } else {
#pragma unroll
            for (int ai = 0; ai < 2; ++ai)
#pragma unroll
                for (int m = 0; m < 4; ++m) { const int row = row0 + ai * HALF + m * 16; const float rs = ssq_rs(rstd, row);
                    const f32x4 v0 = acc[ai][0][m][0] * rs, v1 = acc[ai][0][m][1] * rs;
                    if (wc < 2) { u32x4 w; w.x = cvt_pk_bf16(v0[0], v0[1]); w.y = cvt_pk_bf16(v0[2], v0[3]); w.z = cvt_pk_bf16(v1[0], v1[1]); w.w = cvt_pk_bf16(v1[2], v1[3]);
                        *(u32x4*)(ki + (size_t)row * 64 + wc * 32 + 8 * fq) = w; }
                    else if (wc == 2 && fq == 0) { *(f32x4*)(wi + (size_t)row * 8) = v0; *(f32x4*)(wi + (size_t)row * 8 + 4) = v1; } }
        }
    }
};
struct EpiGates {
    static constexpr bool PERM = true, AFTER_DRAIN = false;
    bf16_t* O; const ssq_t* rstd;
    __device__ __forceinline__ void operator()(const f32x4 (&acc)[2][2][4][2], const Unit& u, int wr, int wc, int fr, int fq) const {
        const int row0 = u.pm * BM + wr * 64 + fr; const int tsel = u.pn >> 2;
        bf16_t* dst = O + (size_t)tsel * ((size_t)T * 1024) + (u.pn & 3) * 256 + wc * 32 + 8 * fq;
#pragma unroll
        for (int ai = 0; ai < 2; ++ai)
#pragma unroll
            for (int m = 0; m < 4; ++m) { const int row = row0 + ai * HALF + m * 16; const float rs = ssq_rs(rstd, row); bf16_t* rowp = dst + (size_t)row * 1024;
#pragma unroll
                for (int bj = 0; bj < 2; ++bj) { float v[8];
#pragma unroll
                    for (int j = 0; j < 4; ++j) { v[j] = acc[ai][bj][m][0][j] * rs; v[4 + j] = acc[ai][bj][m][1][j] * rs; }
#pragma unroll
                    for (int j = 0; j < 8; ++j) v[j] = __builtin_amdgcn_rcpf(1.0f + __builtin_amdgcn_exp2f(-1.4426950408889634f * v[j]));
                    u32x4 w; w.x = cvt_pk_bf16(v[0], v[1]); w.y = cvt_pk_bf16(v[2], v[3]); w.z = cvt_pk_bf16(v[4], v[5]); w.w = cvt_pk_bf16(v[6], v[7]);
                    *(u32x4*)(rowp + bj * HALF) = w; } }
    }
};
template <bool FIRST> struct EpiMerge {
    static constexpr bool PERM = true, AFTER_DRAIN = false;
    const bf16_t* G; bf16_t* Mg;
    __device__ __forceinline__ void operator()(const f32x4 (&acc)[2][2][4][2], const Unit& u, int wr, int wc, int fr, int fq) const {
        const int row0 = u.pm * BM + wr * 64 + fr; const int col0 = u.pn * BM + wc * 32 + 8 * fq;
#pragma unroll
        for (int ai = 0; ai < 2; ++ai)
#pragma unroll
            for (int m = 0; m < 4; ++m) { const size_t off = (size_t)(row0 + ai * HALF + m * 16) * 1024 + col0;
#pragma unroll
                for (int bj = 0; bj < 2; ++bj) { const u32x4 g = *(const u32x4*)(G + off + bj * HALF); const f32x4 a0 = acc[ai][bj][m][0], a1 = acc[ai][bj][m][1];
                    float v[8] = { bf_lo(g.x) * a0[0], bf_hi(g.x) * a0[1], bf_lo(g.y) * a0[2], bf_hi(g.y) * a0[3], bf_lo(g.z) * a1[0], bf_hi(g.z) * a1[1], bf_lo(g.w) * a1[2], bf_hi(g.w) * a1[3] };
                    if (!FIRST) { const u32x4 o = *(const u32x4*)(Mg + off + bj * HALF);
                        v[0] += bf_lo(o.x); v[1] += bf_hi(o.x); v[2] += bf_lo(o.y); v[3] += bf_hi(o.y); v[4] += bf_lo(o.z); v[5] += bf_hi(o.z); v[6] += bf_lo(o.w); v[7] += bf_hi(o.w); }
                    u32x4 w; w.x = cvt_pk_bf16(v[0], v[1]); w.y = cvt_pk_bf16(v[2], v[3]); w.z = cvt_pk_bf16(v[4], v[5]); w.w = cvt_pk_bf16(v[6], v[7]);
                    *(u32x4*)(Mg + off + bj * HALF) = w; }
                asm volatile("" ::: "memory"); }
    }
};
struct EpiResid {
    static constexpr bool PERM = false, AFTER_DRAIN = false;
    const float* src; float* out; bf16_t* xb; float* ssq;
    __device__ __forceinline__ void operator()(const f32x4 (&acc)[2][2][4][2], const Unit& u, int wr, int wc, int fr, int fq) const {
        const int row0 = u.pm * BM + wr * 64 + fr, col0 = u.pn * BM + wc * 32 + 4 * fq;
#pragma unroll
        for (int ai = 0; ai < 2; ++ai)
#pragma unroll
            for (int m = 0; m < 4; ++m) { const int row = row0 + ai * HALF + m * 16; const size_t off = (size_t)row * 1024 + col0; float sq = 0.f;
#pragma unroll
                for (int bj = 0; bj < 2; ++bj)
#pragma unroll
                    for (int n = 0; n < 2; ++n) { const f32x4 s = *(const f32x4*)(src + off + bj * HALF + n * 16); const f32x4 v = s + acc[ai][bj][m][n]; *(f32x4*)(out + off + bj * HALF + n * 16) = v;
                        if (xb) { typedef unsigned u32x2v __attribute__((ext_vector_type(2))); u32x2v w; w.x = cvt_pk_bf16(v[0], v[1]); w.y = cvt_pk_bf16(v[2], v[3]); *(u32x2v*)(xb + off + bj * HALF + n * 16) = w;
                            sq += (v[0] * v[0] + v[1] * v[1]) + (v[2] * v[2] + v[3] * v[3]); } }
                if (xb) { sq += __shfl_xor(sq, 16); sq += __shfl_xor(sq, 32); if (fq == 0) unsafeAtomicAdd(ssq + row, sq); } }
    }
};
struct EpiResidB {
    static constexpr bool PERM = true, AFTER_DRAIN = false;
    bf16_t* xb; ssq_t* ssq;
    __device__ __forceinline__ void operator()(const f32x4 (&acc)[2][2][4][2], const Unit& u, int wr, int wc, int fr, int fq) const {
        const int row0 = u.pm * BM + wr * 64 + fr; const int col0 = u.pn * BM + wc * 32 + 8 * fq;
#pragma unroll
        for (int ai = 0; ai < 2; ++ai)
#pragma unroll
            for (int m = 0; m < 4; ++m) { const int row = row0 + ai * HALF + m * 16; const size_t off = (size_t)row * 1024 + col0; float sq = 0.f;
#pragma unroll
                for (int bj = 0; bj < 2; ++bj) { const u32x4 g = *(const u32x4*)(xb + off + bj * HALF); const f32x4 a0 = acc[ai][bj][m][0], a1 = acc[ai][bj][m][1];
                    const float v[8] = { bf_lo(g.x) + a0[0], bf_hi(g.x) + a0[1], bf_lo(g.y) + a0[2], bf_hi(g.y) + a0[3], bf_lo(g.z) + a1[0], bf_hi(g.z) + a1[1], bf_lo(g.w) + a1[2], bf_hi(g.w) + a1[3] };
                    sq += ((v[0] * v[0] + v[1] * v[1]) + (v[2] * v[2] + v[3] * v[3])) + ((v[4] * v[4] + v[5] * v[5]) + (v[6] * v[6] + v[7] * v[7]));
                    u32x4 w; w.x = cvt_pk_bf16(v[0], v[1]); w.y = cvt_pk_bf16(v[2], v[3]); w.z = cvt_pk_bf16(v[4], v[5]); w.w = cvt_pk_bf16(v[6], v[7]);
                    *(u32x4*)(xb + off + bj * HALF) = w; }
                if (ssq) { sq += __shfl_xor(sq, 16); sq += __shfl_xor(sq, 32); if (fq == 0) atomicAdd(ssq + row, (ssq_t)(sq * SSQ_ONE)); } }
    }
};
struct EpiUp {
    static constexpr bool PERM = true, AFTER_DRAIN = false;
    bf16_t* O; const ssq_t* rstd;
    __device__ __forceinline__ void operator()(const f32x4 (&acc)[2][2][4][2], const Unit& u, int wr, int wc, int fr, int fq) const {
        const int row0 = u.pm * BM + wr * 64 + fr; const int col0 = u.pn * BM + wc * 32 + 8 * fq;
#pragma unroll
        for (int ai = 0; ai < 2; ++ai)
#pragma unroll
            for (int m = 0; m < 4; ++m) { const int row = row0 + ai * HALF + m * 16; const float rs = ssq_rs(rstd, row); bf16_t* rowp = O + (size_t)row * DFF + col0;
#pragma unroll
                for (int bj = 0; bj < 2; ++bj) { float v[8];
#pragma unroll
                    for (int j = 0; j < 4; ++j) { v[j] = fmaxf(acc[ai][bj][m][0][j] * rs, 0.f); v[4 + j] = fmaxf(acc[ai][bj][m][1][j] * rs, 0.f); }
#pragma unroll
                    for (int j = 0; j < 8; ++j) v[j] = v[j] * v[j];
                    u32x4 w; w.x = cvt_pk_bf16(v[0], v[1]); w.y = cvt_pk_bf16(v[2], v[3]); w.z = cvt_pk_bf16(v[4], v[5]); w.w = cvt_pk_bf16(v[6], v[7]);
                    *(u32x4*)(rowp + bj * HALF) = w; } }
    }
};

template <class Epi, class Sched, bool ALIGN_EPI = false, bool SP2 = false>
__device__ __forceinline__ void gemm_phase(PG8_LAS unsigned char* lds, const Gemm g, const Sched& S, const Epi& E, int tid_in) {
    int tid_ = tid_in; asm volatile("" : "+v"(tid_));
    const int tid = tid_, wid = __builtin_amdgcn_readfirstlane(tid >> 6), lane = tid & 63, wr = wid >> 2, wc = wid & 3, fr = lane & 15, fq = lane >> 4;
    const int K = g.K, nt = K / BK;
    unsigned voffA[2], voffB[2];
#pragma unroll
    for (int i = 0; i < 2; ++i) { int R, C; stage_rc(tid * 16 + i * 8192, R, C); const int Rb = Epi::PERM ? ((R & ~31) + perm32(R & 31)) : R;
        voffA[i] = (unsigned)(R * K + C) * 2u; voffB[i] = (unsigned)(Rb * K + C) * 2u; }
    const size_t kstep = (size_t)(BK * 2);
    const size_t hstep = (size_t)HALF * K * 2;
    const size_t tstep = 2 * hstep;
    const unsigned ldsw = (unsigned)wid * 1024u;
    const int aoff = lds_byte(wr * 64 + fr, fq * 8), boff = lds_byte(wc * 32 + fr, fq * 8);
#define PG8_SA(b, h) (((b) * 2 + (h)) * HTB)
#define PG8_SB(b, h) ((4 + (b) * 2 + (h)) * HTB)
#define PG8_STAGE(bufoff, gbase, voff) do { _Pragma("unroll") for (int _i = 0; _i < 2; ++_i) \
        __builtin_amdgcn_global_load_lds((const unsigned*)((const char*)(gbase) + (voff)[_i]), (PG8_LAS unsigned*)(lds + (bufoff) + ldsw + _i * 8192), 16, 0, 0); } while (0)
#define PG8_LDA(dst, b, h) do { _Pragma("unroll") for (int m = 0; m < 4; ++m) _Pragma("unroll") for (int k = 0; k < 2; ++k) dst[m][k] = *(const PG8_LAS bf16x8*)(lds + PG8_SA(b, h) + aoff + m * 2048 + k * 1024); } while (0)
#define PG8_LDB(dst, b, h) do { _Pragma("unroll") for (int n = 0; n < 2; ++n) _Pragma("unroll") for (int k = 0; k < 2; ++k) dst[n][k] = *(const PG8_LAS bf16x8*)(lds + PG8_SB(b, h) + boff + n * 2048 + k * 1024); } while (0)
#define PG8_MMA(ai, bj, At, Bt) do { __builtin_amdgcn_s_setprio(1); _Pragma("unroll") for (int m = 0; m < 4; ++m) _Pragma("unroll") for (int n = 0; n < 2; ++n) _Pragma("unroll") for (int k = 0; k < 2; ++k) \
        acc[ai][bj][m][n] = __builtin_amdgcn_mfma_f32_16x16x32_bf16(Bt[n][k], At[m][k], acc[ai][bj][m][n], 0, 0, 0); __builtin_amdgcn_s_setprio(0); } while (0)
#define PG8_WAIT_V(n) asm volatile("s_waitcnt vmcnt(" #n ")" ::: "memory")
#define PG8_WAIT_L(n) asm volatile("s_waitcnt lgkmcnt(" #n ")" ::: "memory")
#define PG8_BAR __builtin_amdgcn_s_barrier()
#define PG8_SCHED __builtin_amdgcn_sched_barrier(0)
    Unit cur, nxt; int ui = 0;
    if (!S.next(0, cur)) return;
    f32x4 acc[2][2][4][2];
#pragma unroll
    for (int a = 0; a < 2; ++a)
#pragma unroll
        for (int b = 0; b < 2; ++b)
#pragma unroll
            for (int m = 0; m < 4; ++m)
#pragma unroll
                for (int n = 0; n < 2; ++n) acc[a][b][m][n] = (f32x4){0.f, 0.f, 0.f, 0.f};
    bf16x8 At[4][2], B0[2][2], B1[2][2];
    const char* cA = (const char*)g.A + (size_t)cur.pm * tstep; const char* cB = (const char*)g.Bt + (size_t)cur.pn * tstep;
    S.a_ready(cur);
    if constexpr (SP2) {
        PG8_STAGE(PG8_SB(0, 0), cB, voffB); PG8_STAGE(PG8_SB(0, 1), cB + hstep, voffB); PG8_STAGE(PG8_SA(0, 0), cA, voffA); PG8_STAGE(PG8_SA(0, 1), cA + hstep, voffA);
        if (wr == 1) PG8_BAR;
        PG8_WAIT_V(2); PG8_BAR;
        PG8_STAGE(PG8_SB(1, 0), cB + kstep, voffB); PG8_STAGE(PG8_SA(1, 0), cA + kstep, voffA); PG8_STAGE(PG8_SB(1, 1), cB + hstep + kstep, voffB);
        PG8_WAIT_V(6); PG8_BAR;
    } else {
        PG8_STAGE(PG8_SB(0, 0), cB, voffB); PG8_STAGE(PG8_SA(0, 0), cA, voffA); PG8_STAGE(PG8_SB(0, 1), cB + hstep, voffB); PG8_STAGE(PG8_SA(0, 1), cA + hstep, voffA);
        if (wr == 1) PG8_BAR;
        PG8_WAIT_V(4); PG8_BAR;
        PG8_STAGE(PG8_SB(1, 0), cB + kstep, voffB); PG8_STAGE(PG8_SA(1, 0), cA + kstep, voffA); PG8_STAGE(PG8_SB(1, 1), cB + hstep + kstep, voffB);
        PG8_WAIT_V(6); PG8_BAR;
    }
    for (;;) {
        const bool has_next = S.next(ui + 1, nxt);
        const char* nA = has_next ? (const char*)g.A + (size_t)nxt.pm * tstep : cA; const char* nB = has_next ? (const char*)g.Bt + (size_t)nxt.pn * tstep : cB;
        for (int t = 0; t < nt; t += 2) {
            const bool last = (t == nt - 2);
            const char* a1 = cA + (size_t)(t + 1) * kstep;
            const char* a2 = last ? nA : cA + (size_t)(t + 2) * kstep; const char* b2 = last ? nB : cB + (size_t)(t + 2) * kstep;
            const char* a3 = a2 + kstep; const char* b3 = b2 + kstep;
            if (last && has_next) S.a_ready(nxt);
            if constexpr (SP2) {
            PG8_LDB(B0, 0, 0); PG8_LDB(B1, 0, 1); PG8_SCHED; PG8_LDA(At, 0, 0); PG8_STAGE(PG8_SA(1, 1), a1 + hstep, voffA);
            PG8_WAIT_V(8); PG8_WAIT_L(0); PG8_BAR; PG8_MMA(0, 0, At, B0); PG8_MMA(0, 1, At, B1); PG8_BAR; PG8_SCHED;
            PG8_LDA(At, 0, 1); PG8_STAGE(PG8_SB(0, 0), b2, voffB); PG8_STAGE(PG8_SB(0, 1), b2 + hstep, voffB); PG8_STAGE(PG8_SA(0, 0), a2, voffA);
            PG8_WAIT_V(8); PG8_WAIT_L(0); PG8_BAR; PG8_MMA(1, 0, At, B0); PG8_MMA(1, 1, At, B1); PG8_BAR; PG8_SCHED;
            PG8_LDB(B0, 1, 0); PG8_LDB(B1, 1, 1); PG8_SCHED; PG8_LDA(At, 1, 0); PG8_STAGE(PG8_SA(0, 1), a2 + hstep, voffA);
            PG8_WAIT_V(8); PG8_WAIT_L(0); PG8_BAR; PG8_MMA(0, 0, At, B0); PG8_MMA(0, 1, At, B1); PG8_BAR; PG8_SCHED;
            PG8_LDA(At, 1, 1); PG8_STAGE(PG8_SB(1, 0), b3, voffB); PG8_STAGE(PG8_SB(1, 1), b3 + hstep, voffB); PG8_STAGE(PG8_SA(1, 0), a3, voffA);
            PG8_WAIT_V(8); PG8_WAIT_L(0); PG8_BAR; PG8_MMA(1, 0, At, B0); PG8_MMA(1, 1, At, B1); PG8_BAR; PG8_SCHED;
            } else {
            PG8_LDB(B0, 0, 0); PG8_SCHED; PG8_LDA(At, 0, 0); PG8_STAGE(PG8_SA(1, 1), a1 + hstep, voffA);
            PG8_WAIT_L(8); PG8_BAR; PG8_WAIT_L(0); PG8_MMA(0, 0, At, B0); PG8_BAR; PG8_SCHED;
            PG8_LDB(B1, 0, 1); PG8_STAGE(PG8_SB(0, 0), b2, voffB);
            PG8_BAR; PG8_WAIT_L(0); PG8_MMA(0, 1, At, B1); PG8_BAR;
            PG8_LDA(At, 0, 1); PG8_STAGE(PG8_SA(0, 0), a2, voffA);
            PG8_BAR; PG8_WAIT_L(0); PG8_MMA(1, 0, At, B0); PG8_BAR; PG8_SCHED;
            PG8_STAGE(PG8_SB(0, 1), b2 + hstep, voffB);
            PG8_WAIT_V(6); PG8_BAR; PG8_MMA(1, 1, At, B1); PG8_BAR;
            PG8_LDB(B0, 1, 0); PG8_SCHED; PG8_LDA(At, 1, 0); PG8_STAGE(PG8_SA(0, 1), a2 + hstep, voffA);
            PG8_WAIT_L(8); PG8_BAR; PG8_WAIT_L(0); PG8_MMA(0, 0, At, B0); PG8_BAR; PG8_SCHED;
            PG8_LDB(B1, 1, 1); PG8_STAGE(PG8_SB(1, 0), b3, voffB);
            PG8_BAR; PG8_WAIT_L(0); PG8_MMA(0, 1, At, B1); PG8_BAR;
            PG8_LDA(At, 1, 1); PG8_STAGE(PG8_SA(1, 0), a3, voffA);
            PG8_BAR; PG8_WAIT_L(0); PG8_MMA(1, 0, At, B0); PG8_BAR; PG8_SCHED;
            PG8_STAGE(PG8_SB(1, 1), b3 + hstep, voffB);
            PG8_WAIT_V(6); PG8_BAR; PG8_MMA(1, 1, At, B1); PG8_BAR;
            }
        }
        if constexpr (ALIGN_EPI) { if (wr == 0) PG8_BAR; }
        if constexpr (!Epi::AFTER_DRAIN) { E(acc, cur, wr, wc, fr, fq); S.done(cur); }
        if (!has_next) break;
#pragma unroll
        for (int a = 0; a < 2; ++a)
#pragma unroll
            for (int b = 0; b < 2; ++b)
#pragma unroll
                for (int m = 0; m < 4; ++m)
#pragma unroll
                    for (int n = 0; n < 2; ++n) acc[a][b][m][n] = (f32x4){0.f, 0.f, 0.f, 0.f};
        cur = nxt; cA = nA; cB = nB; ++ui;
        if constexpr (ALIGN_EPI) { if (wr == 1) PG8_BAR; }
    }
    PG8_WAIT_V(0);
    if constexpr (!ALIGN_EPI) { if (wr == 0) PG8_BAR; }
    PG8_BAR;
    if constexpr (Epi::AFTER_DRAIN) { E.fused(acc, cur, wr, wc, fr, fq, lds, wid, lane); S.done(cur); }
#undef PG8_SA
#undef PG8_SB
#undef PG8_STAGE
#undef PG8_LDA
#undef PG8_LDB
#undef PG8_MMA
#undef PG8_WAIT_V
#undef PG8_WAIT_L
#undef PG8_BAR
#undef PG8_SCHED
}
}

#ifndef FAST_MOBA
#define FAST_MOBA 2
#endif
#ifndef PG8_SP2
#define PG8_SP2 true
#endif
#ifndef PROBE_SEL
#define PROBE_SEL 0
#endif
constexpr int NWAVES = 8;
constexpr int PH_PER_LAYER = 11;
constexpr int N_PHASES = 2 * PH_PER_LAYER + 1;
constexpr bool ONE_LAUNCH = (MK_ONE_LAUNCH != 0);
static_assert(ONE_LAUNCH, "build with MK_ONE_LAUNCH=1 (build.sh 1): the unit queues and the phase program assume one launch");

constexpr size_t MiB = 1u << 20;
constexpr size_t WS_CTL = 0, CTL_ZERO_BYTES = 1 * MiB;
constexpr size_t WS_W_IN = 1 * MiB;
constexpr size_t WS_W_G = 11 * MiB;
constexpr size_t WS_W_PA = 17 * MiB, WS_W_PB = 18 * MiB, WS_W_PC = 19 * MiB;
constexpr size_t WS_W_O = 20 * MiB;
constexpr size_t WS_W_UP = 22 * MiB;
constexpr size_t WS_W_DN = 30 * MiB;
constexpr size_t WS_XB = 40 * MiB;
constexpr size_t WS_RSTD = 104 * MiB;
constexpr int CW_SSQ = 32768;
static_assert(CW_SSQ * 4 + 3 * T * 8 <= (int)CTL_ZERO_BYTES, "ssq arrays inside the memset region");
constexpr size_t WS_KMEAN = 104 * MiB + 256 * 1024;
constexpr size_t WS_RGA = 104 * MiB + 256 * 1024;
constexpr size_t WS_RGH = 10 * MiB + 512 * 1024;
constexpr int RGC = 128;
constexpr size_t WS_WI = 105 * MiB;
constexpr size_t WS_KI = 106 * MiB;
constexpr size_t WS_ACT = 112 * MiB;
constexpr size_t ACT_STRIDE = (size_t)T * 512 * 2;
constexpr size_t WS_QA = WS_ACT, WS_QB = WS_ACT + ACT_STRIDE, WS_YC = WS_ACT + 2 * ACT_STRIDE, WS_KA = WS_ACT + 3 * ACT_STRIDE, WS_VA = WS_ACT + 4 * ACT_STRIDE,
                 WS_KB = WS_ACT + 5 * ACT_STRIDE, WS_VB = WS_ACT + 6 * ACT_STRIDE, WS_QI = WS_ACT + 7 * ACT_STRIDE, WS_XC = WS_ACT + 8 * ACT_STRIDE;
constexpr size_t WS_G = WS_KA;
constexpr size_t WS_MASK = 400 * MiB;
constexpr size_t WS_MERGED = 400 * MiB;
constexpr size_t WS_H = WS_ACT;
constexpr size_t WS_END = 512 * MiB;
static_assert(WS_XC + ACT_STRIDE == 400 * MiB && WS_G + (size_t)3 * T * 1024 * 2 == 400 * MiB && WS_H + (size_t)T * DFF * 2 <= 400 * MiB, "d_ws map");
constexpr int CW_DYN = 12288;
constexpr int CW_BAR = 4096;

constexpr int RING_OFF = 0, RING_BYTES = 131072;
constexpr int LDSCTL_OFF = RING_BYTES, MISC_OFF = LDSCTL_OFF + 320;
constexpr int LDS_BYTES = 147456;
constexpr int GL_SKEY = 0, GL_QIF = 65536, GL_WQ = GL_QIF + 2048, GL_HIST = GL_WQ + 64, GL_SEL = GL_HIST + 1024, GL_MISC = GL_SEL + 1024, GL_QS = 70656, GL_PS = 73728;
static_assert(GL_MISC + 64 <= GL_QS && GL_QS + 8 * 256 <= GL_PS && GL_PS + 8 * 4096 <= RING_BYTES, "golden LDS map");

#define GAS __attribute__((address_space(1)))
#define LAS __attribute__((address_space(3)))
typedef unsigned short bf16;
typedef unsigned v4u __attribute__((ext_vector_type(4)));
typedef float f32x4 __attribute__((ext_vector_type(4)));
typedef GAS unsigned gu32;
#define RLX_AGENT __ATOMIC_RELAXED, __HIP_MEMORY_SCOPE_AGENT
#define LDS_WAIT() asm volatile("s_waitcnt lgkmcnt(0)" ::: "memory")
#define VM_WAIT() asm volatile("s_waitcnt vmcnt(0)" ::: "memory")
__device__ __forceinline__ float bf2f(bf16 v) { return __uint_as_float(((unsigned)v) << 16); }
__device__ __forceinline__ unsigned pk2(float lo, float hi) { return pg8::cvt_pk_bf16(lo, hi); }
__device__ __forceinline__ unsigned f2bf(float f) { return pg8::cvt_pk_bf16(f, 0.f) & 0xffffu; }
__device__ __forceinline__ float wave_sum(float v) {
#pragma unroll
    for (int o = 1; o < 64; o <<= 1) v += __shfl_xor(v, o);
    return v;
}
__device__ __forceinline__ float wave_max(float v) {
#pragma unroll
    for (int o = 1; o < 64; o <<= 1) v = fmaxf(v, __shfl_xor(v, o));
    return v;
}
__device__ __forceinline__ int t5_bucket(int n) {
    if (n < 16) return n;
    if (n >= 113) return 31;
    return 16 + (n >= 19) + (n >= 21) + (n >= 24) + (n >= 27) + (n >= 31) + (n >= 35) + (n >= 40) + (n >= 46) + (n >= 52) + (n >= 59) + (n >= 67) + (n >= 77) + (n >= 87) + (n >= 99);
}

#define XB_TMO      128
#define XB_XCNT(j)  (256  + 64 * (j))
#define XB_XSUB(j)  (1280 + 64 * (j))
#define XB_XGEN(j)  (2304 + 64 * (j))
#define XB_TOP      3328
#define XB_TOPGEN   3392
#define XCD_BAR_WORDS 3456
#define XB_SPIN_CAP (1u << 22)

__device__ __forceinline__ unsigned xb_ld(unsigned* p)              { return __hip_atomic_load(p, __ATOMIC_RELAXED, __HIP_MEMORY_SCOPE_AGENT); }
__device__ __forceinline__ unsigned xb_add(unsigned* p, unsigned v) { return __hip_atomic_fetch_add(p, v, __ATOMIC_RELAXED, __HIP_MEMORY_SCOPE_AGENT); }
__device__ __forceinline__ unsigned xb_xcc_id() { return (unsigned)__builtin_amdgcn_s_getreg((3 << 11) | 20) & 0xFu; }
#define XB_SPIN(cond, bar) do { unsigned _sp = 0; while (cond) { __builtin_amdgcn_s_sleep(1); \
    if ((++_sp & 255u) == 0u) { if (xb_ld(&(bar)[XB_TMO])) break; if (_sp > XB_SPIN_CAP) { atomicAdd(&(bar)[XB_TMO], 1u); break; } } } } while (0)

struct XcdBarrier { unsigned* bar; unsigned x; volatile LAS unsigned* st; };

__device__ __forceinline__ XcdBarrier xcd_barrier_post(unsigned* bar, volatile LAS unsigned* st) {
    XcdBarrier b; b.bar = bar; b.x = xb_xcc_id(); b.st = st;
    if (threadIdx.x == 0) (void)xb_add(&bar[XB_XCNT(b.x)], 1u);
    return b;
}
__device__ __forceinline__ void xcd_barrier_complete(unsigned* bar, unsigned x, unsigned& nloc, unsigned& nx) {
    const unsigned G = gridDim.x * gridDim.y * gridDim.z;
    unsigned sum, cnt, mine, sp = 0u;
    for (;;) {
        sum = 0u; cnt = 0u; mine = 0u;
#pragma unroll
        for (unsigned j = 0; j < 16; ++j) { const unsigned c = xb_ld(&bar[XB_XCNT(j)]); sum += c; cnt += (c > 0u) ? 1u : 0u; }
        mine = xb_ld(&bar[XB_XCNT(x)]);
        if (sum == G) break;
        __builtin_amdgcn_s_sleep(1);
        if ((++sp & 255u) == 0u) { if (xb_ld(&bar[XB_TMO])) break; if (sp > XB_SPIN_CAP) { atomicAdd(&bar[XB_TMO], 1u); break; } }
    }
    nloc = mine > 0u ? mine : 1u; nx = cnt > 0u ? cnt : 1u;
}
__device__ __forceinline__ void xcd_barrier(const XcdBarrier& b) {
    asm volatile("s_waitcnt vmcnt(0)" ::: "memory");
    __syncthreads();
    if (threadIdx.x == 0) {
        unsigned* bar = b.bar;
        __builtin_amdgcn_s_waitcnt(0);
        unsigned nloc = b.st[0], nx = b.st[1];
        if (nloc == 0u) { xcd_barrier_complete(bar, b.x, nloc, nx); b.st[0] = nloc; b.st[1] = nx; }
        const unsigned old = xb_add(&bar[XB_XSUB(b.x)], 1u);
        const unsigned gen = old / nloc;
        if (old + 1u == (gen + 1u) * nloc) {
            __builtin_amdgcn_fence(__ATOMIC_RELEASE, "agent");
            asm volatile("s_waitcnt vmcnt(0)" ::: "memory");
            const unsigned og = xb_add(&bar[XB_TOP], 1u);
            const unsigned tg = og / nx;
            if (og + 1u == (tg + 1u) * nx) xb_add(&bar[XB_TOPGEN], 1u);
            else XB_SPIN(xb_ld(&bar[XB_TOPGEN]) == tg, bar);
            __builtin_amdgcn_fence(__ATOMIC_ACQUIRE, "agent");
            xb_add(&bar[XB_XGEN(b.x)], 1u);
            asm volatile("s_waitcnt vmcnt(0)" ::: "memory");
        } else {
            XB_SPIN(xb_ld(&bar[XB_XGEN(b.x)]) == gen, bar);
            __builtin_amdgcn_fence(__ATOMIC_ACQUIRE, "agent");
            asm volatile("s_waitcnt vmcnt(0)" ::: "memory");
        }
    }
    __syncthreads();
}

struct Args { const float* in[19]; float* out; unsigned char* ws; int ph_lo, ph_hi; };
struct Frame {
    LAS unsigned char* lds;
    int tid, lane, wave, G, bid;
    int gw;
    const __attribute__((address_space(4))) Args* a;
    unsigned char* ws; float* out;
};
#define WSB(off) ((bf16*)(F.ws + (off)))
#define WSF(off) ((float*)(F.ws + (off)))
#define INP(i) (F.a->in[i])
#define SSQ_CTL ((pg8::ssq_t*)(F.ws + WS_CTL + (size_t)CW_SSQ * 4))
#define SSQ_MIX(l) ((l) == 0 ? (pg8::ssq_t*)(F.ws + WS_RSTD) : SSQ_CTL + T)
#define SSQ_MLP(l) (SSQ_CTL + ((l) == 0 ? 0 : 2 * T))
enum { I_X = 0, I_RELB, I_NMG, I_WIN, I_CONVW, I_CONVB, I_WR, I_BR, I_WI, I_BI, I_LAM, I_WPA, I_WPB, I_WPC, I_WO, I_NLG, I_WUP, I_WDN, I_FNG };

template <class P> __device__ __forceinline__ P* launder_u(P* p) { unsigned lo = (unsigned)(uintptr_t)p, hi = (unsigned)((uintptr_t)p >> 32); asm volatile("" : "+v"(lo), "+v"(hi));
    lo = __builtin_amdgcn_readfirstlane(lo); hi = __builtin_amdgcn_readfirstlane(hi); return (P*)(((uintptr_t)hi << 32) | (uintptr_t)lo); }
__device__ __forceinline__ int launder_i(int v) { asm volatile("" : "+v"(v)); return __builtin_amdgcn_readfirstlane(v); }

__device__ __forceinline__ void transpose_item(const float* W, int ld, int K, int ncol_valid, const float* gain, bf16* WT, LAS float* scr, int item, int nblk, int lane) {
    const int kb = item / nblk, nb = item % nblk, k0 = 64 * kb, n0 = 32 * nb;
    const float gv = gain ? gain[k0 + lane] : 1.0f;
#pragma unroll 8
    for (int i = 0; i < 32; ++i) { const int kk = 2 * i + (lane >> 5); const int n = n0 + (lane & 31);
        float v = (n < ncol_valid) ? W[(size_t)(k0 + kk) * ld + n] : 0.f; v *= __shfl(gv, kk); scr[kk * 33 + (lane & 31)] = v; }
    LDS_WAIT(); asm volatile("" ::: "memory");
    const int c = lane & 7;
#pragma unroll
    for (int j = 0; j < 4; ++j) { const int n = (lane >> 3) + 8 * j; const LAS float* s = scr + (8 * c) * 33 + n;
        v4u o; o.x = pk2(s[0 * 33], s[1 * 33]); o.y = pk2(s[2 * 33], s[3 * 33]); o.z = pk2(s[4 * 33], s[5 * 33]); o.w = pk2(s[6 * 33], s[7 * 33]);
        *(GAS v4u*)(WT + (size_t)(n0 + n) * K + k0 + 8 * c) = o; }
    LDS_WAIT(); asm volatile("" ::: "memory");
}
__device__ __forceinline__ void norm_row(const float* xrow, bf16* orow, pg8::ssq_t* rstd_out, int lane) {
    const GAS f32x4* xr = (const GAS f32x4*)xrow + lane;
    f32x4 v[4]; float s = 0.f;
#pragma unroll
    for (int j = 0; j < 4; ++j) { v[j] = xr[64 * j]; s += (v[j].x * v[j].x + v[j].y * v[j].y) + (v[j].z * v[j].z + v[j].w * v[j].w); }
    const float ss = wave_sum(s);
    GAS unsigned long long* o8 = (GAS unsigned long long*)orow + lane;
#pragma unroll
    for (int j = 0; j < 4; ++j) o8[64 * j] = (unsigned long long)pk2(v[j].x, v[j].y) | ((unsigned long long)pk2(v[j].z, v[j].w) << 32);
    if (lane == 0) *rstd_out = (pg8::ssq_t)(ss * pg8::SSQ_ONE);
}
__device__ __forceinline__ void p_prologue(Frame& F, int l) {
    LAS float* scr = (LAS float*)(F.lds + RING_OFF + F.wave * 16384);
    const int gw = F.bid * NWAVES + F.wave, NGW = F.G * NWAVES;
    const float* w_in = INP(I_WIN) + (size_t)l * DM * DIN; const float* g1 = INP(I_NMG) + l * DM; const float* g2 = INP(I_NLG) + l * DM;
    constexpr int I_BLK = 16 * 16;
    constexpr int I_SP = 16 * 3;
    constexpr int I_G = 16 * 96;
    constexpr int I_P = 8 * 32;
    constexpr int I_O = 16 * 32;
    constexpr int I_UP = 16 * 128;
    constexpr int I_DN = 64 * 32;
    constexpr int NITEMS = 9 * I_BLK + I_SP + I_G + 3 * I_P + I_O + I_UP + I_DN;
    for (int it = gw; it < NITEMS; it += NGW) {
        int r = it;
        if (r < 9 * I_BLK) { const int blk = r / I_BLK; r -= blk * I_BLK;
            const int c0 = blk == 0 ? 0 : blk == 1 ? 1536 : blk == 2 ? 4168 : blk == 3 ? 512 : blk == 4 ? 1024 : blk == 5 ? 2048 : blk == 6 ? 2560 : blk == 7 ? 3072 : 3656;
            transpose_item(w_in + c0, DIN, DM, 512, g1, WSB(WS_W_IN) + (size_t)blk * 512 * DM, scr, r, 16, F.lane); continue; }
        r -= 9 * I_BLK;
        if (r < I_SP) { transpose_item(w_in + 3584, DIN, DM, 72, g1, WSB(WS_W_IN) + (size_t)4608 * DM, scr, r, 3, F.lane); continue; } r -= I_SP;
        if (r < I_G) { transpose_item(w_in + 4680, DIN, DM, 3072, g1, WSB(WS_W_G), scr, r, 96, F.lane); continue; } r -= I_G;
        if (r < I_P) { transpose_item(INP(I_WPA) + (size_t)l * DH * DM, DM, DH, 1024, nullptr, WSB(WS_W_PA), scr, r, 32, F.lane); continue; } r -= I_P;
        if (r < I_P) { transpose_item(INP(I_WPB) + (size_t)l * DH * DM, DM, DH, 1024, nullptr, WSB(WS_W_PB), scr, r, 32, F.lane); continue; } r -= I_P;
        if (r < I_P) { transpose_item(INP(I_WPC) + (size_t)l * DH * DM, DM, DH, 1024, nullptr, WSB(WS_W_PC), scr, r, 32, F.lane); continue; } r -= I_P;
        if (r < I_O) { transpose_item(INP(I_WO) + (size_t)l * DM * DM, DM, DM, 1024, nullptr, WSB(WS_W_O), scr, r, 32, F.lane); continue; } r -= I_O;
        if (r < I_UP) { transpose_item(INP(I_WUP) + (size_t)l * DM * DFF, DFF, DM, DFF, g2, WSB(WS_W_UP), scr, r, 128, F.lane); continue; } r -= I_UP;
        transpose_item(INP(I_WDN) + (size_t)l * DFF * DM, DM, DFF, 1024, nullptr, WSB(WS_W_DN), scr, r, 32, F.lane);
    }
    { GAS v4u* z = (GAS v4u*)(WSB(WS_W_IN) + (size_t)(4608 + 96) * DM); const int gt = F.bid * (NWAVES * 64) + F.tid;
      unsigned zz = 0u; asm volatile("" : "+v"(zz));
      for (int i = gt; i < 160 * DM / 8; i += F.G * NWAVES * 64) z[i] = (v4u){zz, zz, zz, zz}; }
    if (l == 0) for (int m = gw; m < T; m += NGW) norm_row(INP(I_X) + (size_t)m * DM, WSB(WS_XB) + (size_t)m * DM, (pg8::ssq_t*)(F.ws + WS_RSTD) + m, F.lane);
}
__device__ __forceinline__ void p_final(Frame& F) {
    const int gw = F.bid * NWAVES + F.wave, NGW = F.G * NWAVES;
    for (int m = gw; m < T; m += NGW) {
        const GAS v4u* xr = (const GAS v4u*)(WSB(WS_XB) + (size_t)m * DM) + F.lane; GAS f32x4* orow = (GAS f32x4*)(F.out + (size_t)m * DM) + 2 * F.lane; const GAS f32x4* gr = (const GAS f32x4*)INP(I_FNG) + 2 * F.lane;
        float v[16]; float s = 0.f;
#pragma unroll
        for (int j = 0; j < 2; ++j) { const v4u w = xr[64 * j];
            v[8 * j + 0] = __uint_as_float(w.x << 16); v[8 * j + 1] = __uint_as_float(w.x & 0xffff0000u); v[8 * j + 2] = __uint_as_float(w.y << 16); v[8 * j + 3] = __uint_as_float(w.y & 0xffff0000u);
            v[8 * j + 4] = __uint_as_float(w.z << 16); v[8 * j + 5] = __uint_as_float(w.z & 0xffff0000u); v[8 * j + 6] = __uint_as_float(w.w << 16); v[8 * j + 7] = __uint_as_float(w.w & 0xffff0000u); }
#pragma unroll
        for (int i = 0; i < 16; ++i) s += v[i] * v[i];
        const float rstd = 1.0f / sqrtf(wave_sum(s) * (1.0f / DM) + EPS);
#pragma unroll
        for (int j = 0; j < 2; ++j)
#pragma unroll
            for (int h = 0; h < 2; ++h) { const f32x4 g4 = gr[128 * j + h]; f32x4 o; o.x = v[8 * j + 4 * h] * rstd * g4.x; o.y = v[8 * j + 4 * h + 1] * rstd * g4.y; o.z = v[8 * j + 4 * h + 2] * rstd * g4.z; o.w = v[8 * j + 4 * h + 3] * rstd * g4.w;
                orow[128 * j + h] = o; }
    }
}

__device__ __forceinline__ void kmean_unit(Frame& F, int b, int n) {
    const bf16* kp = WSB(WS_KA) + ((size_t)b * SEQ + (size_t)n * 256) * 512 + F.tid; float s = 0.f;
#pragma unroll 8
    for (int j = 0; j < 256; ++j) s += bf2f(kp[(size_t)j * 512]);
    WSF(WS_KMEAN)[((size_t)b * NBLK + n) * 512 + F.tid] = s * (1.0f / 256.0f);
}
__device__ __forceinline__ float sigmoidf_(float v) { return 1.0f / (1.0f + __expf(-v)); }
typedef short bf16x8_t __attribute__((ext_vector_type(8)));
constexpr int RG_XB_STRIDE = 72;
constexpr int RG_XRAW = 0, RG_YRAW = 2048, RG_XB = 4096, RG_PR = RG_XB + 16 * RG_XB_STRIDE * 2, RG_PI = RG_PR + 16 * 64 * 4, RG_WAVE_LDS = RG_PI + 16 * 64 * 4;
static_assert(8 * RG_WAVE_LDS <= RING_BYTES, "rg LDS");
template <bool P2> __device__ __forceinline__ void rg_unit(Frame& F, int l, int b, int c) {
    int d_ = F.lane; asm volatile("" : "+v"(d_));
    const int n = F.wave, d = d_, ch = n * 64 + d;
    LAS unsigned char* wl = F.lds + RING_OFF + n * RG_WAVE_LDS;
    LAS bf16* xraw = (LAS bf16*)(wl + RG_XRAW); LAS bf16* yraw = (LAS bf16*)(wl + RG_YRAW); LAS bf16* xb = (LAS bf16*)(wl + RG_XB); LAS float* prl = (LAS float*)(wl + RG_PR); LAS float* pil = (LAS float*)(wl + RG_PI);
    const int col = d & 15, kq = d >> 4;
    bf16x8_t wfr[2][4], wfi[2][4];
    { const GAS float* prs = (const GAS float*)INP(I_WR) + (((size_t)l * 8 + n) * 64) * 64 + (8 * kq * 64 + col); const GAS float* pis = (const GAS float*)INP(I_WI) + (((size_t)l * 8 + n) * 64) * 64 + (8 * kq * 64 + col);
#pragma unroll
      for (int ks = 0; ks < 2; ++ks)
#pragma unroll
        for (int nb = 0; nb < 4; ++nb) { float tr[8], ti[8];
#pragma unroll
            for (int j = 0; j < 8; ++j) { const int o = (32 * ks + j) * 64 + 16 * nb; tr[j] = prs[o]; ti[j] = pis[o]; }
            union { bf16x8_t v; unsigned u[4]; } ur, ui;
#pragma unroll
            for (int j = 0; j < 4; ++j) { ur.u[j] = pk2(tr[2 * j], tr[2 * j + 1]); ui.u[j] = pk2(ti[2 * j], ti[2 * j + 1]); }
            wfr[ks][nb] = ur.v; wfi[ks][nb] = ui.v; } }
    const float br = ((const GAS float*)INP(I_BR) + l * 512)[ch], bi = ((const GAS float*)INP(I_BI) + l * 512)[ch];
    const float lamv = ((const GAS float*)INP(I_LAM) + l * 512)[ch]; const float sp = log1pf(__expf(-lamv));
    const GAS float* cwp = (const GAS float*)INP(I_CONVW) + (size_t)l * 4 * 512;
    const float cw0 = cwp[ch], cw1 = cwp[512 + ch], cw2 = cwp[1024 + ch], cw3 = cwp[1536 + ch];
    const float cb = ((const GAS float*)INP(I_CONVB) + l * 512)[ch];
    float h = 0.f, A = 1.f;
    if (P2) { const GAS float* ra = (const GAS float*)WSF(WS_RGA) + (size_t)b * RGC * 512; const GAS float* rh = (const GAS float*)WSF(WS_RGH) + (size_t)b * RGC * 512;
        const GAS float* rap = ra + ch; const GAS float* rhp = rh + ch;
        int j = 0;
#pragma unroll 1
        for (; j + 4 <= c; j += 4) { const float a0 = rap[0], a1 = rap[512], a2 = rap[1024], a3 = rap[1536], h0 = rhp[0], h1 = rhp[512], h2 = rhp[1024], h3 = rhp[1536];
            h = a0 * h + h0; h = a1 * h + h1; h = a2 * h + h2; h = a3 * h + h3; rap += 2048; rhp += 2048; }
#pragma unroll 1
        for (; j < c; ++j) { h = rap[0] * h + rhp[0]; rap += 512; rhp += 512; } }
    const int t0 = c * (SEQ / RGC);
    const GAS bf16* xcs = (const GAS bf16*)WSB(WS_XC) + ((size_t)b * SEQ + t0) * 512;
    GAS bf16* ycs = (GAS bf16*)WSB(WS_YC) + ((size_t)b * SEQ + t0) * 512;
    float x1 = 0.f, x2 = 0.f, x3 = 0.f;
    if (t0 > 0) { const GAS bf16* xm = xcs - 3 * 512; x3 = bf2f(xm[ch]); x2 = bf2f(xm[512 + ch]); x1 = bf2f(xm[1024 + ch]); }
    const int tokA = d >> 3, chk = d & 7;
    const size_t goff = (size_t)tokA * 512 + n * 64 + chk * 8;
    const int loff = tokA * 64 + chk * 8;
#pragma unroll 1
    for (int tile = 0; tile < SEQ / RGC / 16; ++tile) {
        const GAS bf16* xt = xcs + (size_t)tile * 16 * 512 + goff; GAS bf16* yt = ycs + (size_t)tile * 16 * 512 + goff;
        { const v4u a0 = *(const GAS v4u*)xt, a1 = *(const GAS v4u*)(xt + 8 * 512); *(LAS v4u*)(xraw + loff) = a0; *(LAS v4u*)(xraw + loff + 8 * 64) = a1; }
        if (P2) { const v4u a0 = *(const GAS v4u*)yt, a1 = *(const GAS v4u*)(yt + 8 * 512); *(LAS v4u*)(yraw + loff) = a0; *(LAS v4u*)(yraw + loff + 8 * 64) = a1; }
        LDS_WAIT(); asm volatile("" ::: "memory");
        float xc[16];
#pragma unroll
        for (int i = 0; i < 16; ++i) { const float xv = bf2f(xraw[i * 64 + d]); xc[i] = cb + cw0 * x3 + cw1 * x2 + cw2 * x1 + cw3 * xv; x3 = x2; x2 = x1; x1 = xv; }
#pragma unroll
        for (int i = 0; i < 16; ++i) xb[i * RG_XB_STRIDE + d] = (bf16)f2bf(xc[i]);
        LDS_WAIT(); asm volatile("" ::: "memory");
        bf16x8_t af[2];
#pragma unroll
        for (int ks = 0; ks < 2; ++ks) af[ks] = *(const LAS bf16x8_t*)(xb + col * RG_XB_STRIDE + 32 * ks + 8 * kq);
        f32x4 ar[4], ai[4];
#pragma unroll
        for (int nb = 0; nb < 4; ++nb) { ar[nb] = (f32x4){0.f, 0.f, 0.f, 0.f}; ai[nb] = (f32x4){0.f, 0.f, 0.f, 0.f};
#pragma unroll
            for (int ks = 0; ks < 2; ++ks) { ar[nb] = __builtin_amdgcn_mfma_f32_16x16x32_bf16(af[ks], wfr[ks][nb], ar[nb], 0, 0, 0); ai[nb] = __builtin_amdgcn_mfma_f32_16x16x32_bf16(af[ks], wfi[ks][nb], ai[nb], 0, 0, 0); } }
        asm volatile("s_nop 15\n\ts_nop 15" : "+v"(ar[0]), "+v"(ar[1]), "+v"(ar[2]), "+v"(ar[3]), "+v"(ai[0]), "+v"(ai[1]), "+v"(ai[2]), "+v"(ai[3]));
#pragma unroll
        for (int nb = 0; nb < 4; ++nb)
#pragma unroll
            for (int r = 0; r < 4; ++r) { prl[(4 * kq + r) * 64 + 16 * nb + col] = ar[nb][r]; pil[(4 * kq + r) * 64 + 16 * nb + col] = ai[nb][r]; }
        LDS_WAIT(); asm volatile("" ::: "memory");
#pragma unroll
        for (int i = 0; i < 16; ++i) {
            const float r = __builtin_amdgcn_rcpf(1.0f + __expf(-(prl[i * 64 + d] + br))), ig = __builtin_amdgcn_rcpf(1.0f + __expf(-(pil[i * 64 + d] + bi)));
            const float la = -8.0f * r * sp; const float a = __expf(la);
            const float x2a = 2.0f * la;
            const float om = (x2a > -0.05f) ? -x2a * (1.0f + x2a * (0.5f + x2a * (0.16666667f + x2a * 0.041666668f))) : 1.0f - a * a;
            const float u = __builtin_amdgcn_sqrtf(om) * (ig * xc[i]);
            h = a * h + u;
            if (!P2) A *= a;
            else { const float y = bf2f(yraw[i * 64 + d]); const float z = 0.7978845608028654f * (y + 0.044715f * y * y * y);
                const float th = 1.0f - 2.0f * __builtin_amdgcn_rcpf(1.0f + __expf(2.0f * z));
                yraw[i * 64 + d] = (bf16)f2bf(h * (0.5f * y * (1.0f + th))); }
        }
        LDS_WAIT(); asm volatile("" ::: "memory");
        if (P2) { const v4u a0 = *(const LAS v4u*)(yraw + loff), a1 = *(const LAS v4u*)(yraw + loff + 8 * 64); *(GAS v4u*)yt = a0; *(GAS v4u*)(yt + 8 * 512) = a1; }
        LDS_WAIT(); asm volatile("" ::: "memory");
    }
    if (!P2) { const size_t o = ((size_t)b * RGC + c) * 512; ((GAS float*)WSF(WS_RGA) + o)[ch] = A; ((GAS float*)WSF(WS_RGH) + o)[ch] = h; }
    __syncthreads();
}

__device__ __forceinline__ float dot64(const LAS float* qs, const bf16* krow) {
    const v4u* kr = (const v4u*)krow; float s = 0.f;
#pragma unroll
    for (int c = 0; c < 8; ++c) { const v4u w = kr[c]; const f32x4 q0 = *(const LAS f32x4*)(qs + c * 8), q1 = *(const LAS f32x4*)(qs + c * 8 + 4);
        s += q0.x * __uint_as_float(w.x << 16) + q0.y * __uint_as_float(w.x & 0xffff0000u) + q0.z * __uint_as_float(w.y << 16) + q0.w * __uint_as_float(w.y & 0xffff0000u)
           + q1.x * __uint_as_float(w.z << 16) + q1.y * __uint_as_float(w.z & 0xffff0000u) + q1.z * __uint_as_float(w.w << 16) + q1.w * __uint_as_float(w.w & 0xffff0000u); }
    return s;
}
__device__ __forceinline__ void moba_unit(Frame& F, int b, int t) {
    const int h = F.wave, lane = F.lane, cur = t >> 8;
    LAS float* qs = (LAS float*)(F.lds + GL_QS) + h * 64; LAS float* ps = (LAS float*)(F.lds + GL_PS) + h * 1024;
    const size_t row = (size_t)b * SEQ + t;
    bf16* qrow = WSB(WS_QA) + row * 512 + h * 64;
    qs[lane] = bf2f(qrow[lane]);
    LDS_WAIT(); asm volatile("" ::: "memory");
    float g = -1e30f;
    if (lane < cur) { const float* km = WSF(WS_KMEAN) + ((size_t)b * NBLK + lane) * 512 + h * 64; float s = 0.f;
#pragma unroll
        for (int d4 = 0; d4 < 16; ++d4) { const f32x4 kv = *(const f32x4*)(km + d4 * 4); const f32x4 qv = *(const LAS f32x4*)(qs + d4 * 4); s += kv.x * qv.x + kv.y * qv.y + kv.z * qv.z + kv.w * qv.w; }
        g = s; }
    int blk[4]; bool ok[4];
#pragma unroll
    for (int i = 0; i < 3; ++i) { const float m = wave_max(g); const unsigned long long bal = __ballot(g == m); const int sel = __ffsll((long long)bal) - 1; blk[i] = sel; ok[i] = sel < cur; if (lane == sel) g = -INFINITY; }
    blk[3] = cur; ok[3] = true;
    const bf16* Kh = WSB(WS_KA) + ((size_t)b * SEQ) * 512 + h * 64; const bf16* Vh = WSB(WS_VA) + ((size_t)b * SEQ) * 512 + h * 64;
    float lg[16];
#pragma unroll
    for (int i = 0; i < 16; ++i) { const int bi = i >> 2; const int pos = blk[bi] * 256 + (i & 3) * 64 + lane; const bool valid = ok[bi] && pos <= t;
        float s = -1e30f;
        if (valid) s = dot64(qs, Kh + (size_t)pos * 512) * 0.125f + INP(I_RELB)[t5_bucket(t - pos) * 16 + h];
        lg[i] = s; if ((i & 3) == 3) asm volatile("" ::: "memory"); }
    float m = lg[0];
#pragma unroll
    for (int i = 1; i < 16; ++i) m = fmaxf(m, lg[i]);
    m = wave_max(m); float sum = 0.f;
#pragma unroll
    for (int i = 0; i < 16; ++i) { const float e = __expf(lg[i] - m); sum += e; ps[i * 64 + lane] = e; }
    sum = wave_sum(sum);
    LDS_WAIT(); asm volatile("" ::: "memory");
    float acc = 0.f;
#pragma unroll
    for (int bi = 0; bi < 4; ++bi) {
        if (!ok[bi]) continue;
        const int base = blk[bi] * 256; const int nk = (bi == 3) ? (t - base + 1) : 256;
        const bf16* vp = Vh + (size_t)base * 512 + lane; const LAS float* pp = ps + bi * 256;
        int kk = 0;
        for (; kk + 8 <= nk; kk += 8) { float pv[8], vv[8];
#pragma unroll
            for (int j = 0; j < 8; ++j) { pv[j] = pp[kk + j]; vv[j] = bf2f(vp[(size_t)(kk + j) * 512]); }
#pragma unroll
            for (int j = 0; j < 8; ++j) acc += pv[j] * vv[j]; }
        for (; kk < nk; ++kk) acc += pp[kk] * bf2f(vp[(size_t)kk * 512]);
    }
    qrow[lane] = (bf16)f2bf(acc / sum);
}
__device__ __forceinline__ void dsa_unit(Frame& F, int b, int t) {
    const int tid = F.tid, lane = F.lane, h = F.wave;
    LAS unsigned* skey = (LAS unsigned*)(F.lds + GL_SKEY); LAS float* qif = (LAS float*)(F.lds + GL_QIF); LAS float* wq = (LAS float*)(F.lds + GL_WQ);
    LAS unsigned* hist = (LAS unsigned*)(F.lds + GL_HIST); LAS int* sel = (LAS int*)(F.lds + GL_SEL); LAS unsigned* misc = (LAS unsigned*)(F.lds + GL_MISC);
    const size_t row = (size_t)b * SEQ + t; const int n = t + 1;
    __syncthreads();
    qif[tid] = bf2f(WSB(WS_QI)[row * 512 + tid]);
    if (tid < 8) wq[tid] = WSF(WS_WI)[row * 8 + tid];
    if (tid < 16) misc[tid] = 0u;
    __syncthreads();
    if (n > 256) {
        const bf16* kib = WSB(WS_KI) + ((size_t)b * SEQ) * 64;
        for (int s = tid; s < n; s += NWAVES * 64) {
            float kf[64];
            { const v4u* kr = (const v4u*)(kib + (size_t)s * 64);
#pragma unroll
              for (int c = 0; c < 8; ++c) { const v4u w = kr[c]; kf[c * 8 + 0] = __uint_as_float(w.x << 16); kf[c * 8 + 1] = __uint_as_float(w.x & 0xffff0000u); kf[c * 8 + 2] = __uint_as_float(w.y << 16); kf[c * 8 + 3] = __uint_as_float(w.y & 0xffff0000u);
                  kf[c * 8 + 4] = __uint_as_float(w.z << 16); kf[c * 8 + 5] = __uint_as_float(w.z & 0xffff0000u); kf[c * 8 + 6] = __uint_as_float(w.w << 16); kf[c * 8 + 7] = __uint_as_float(w.w & 0xffff0000u); } }
            float score = 0.f;
#pragma unroll 1
            for (int hh = 0; hh < 8; ++hh) { float dsum = 0.f;
#pragma unroll
                for (int d4 = 0; d4 < 16; ++d4) { const f32x4 q = *(const LAS f32x4*)(qif + hh * 64 + d4 * 4); dsum += q.x * kf[d4 * 4] + q.y * kf[d4 * 4 + 1] + q.z * kf[d4 * 4 + 2] + q.w * kf[d4 * 4 + 3]; }
                score += wq[hh] * fmaxf(dsum, 0.f); asm volatile("" ::: "memory"); }
            score *= 0.04419417382415922f;
            if (score == 0.f) score = 0.f;
            const unsigned u = __float_as_uint(score);
            skey[s] = (u & 0x80000000u) ? ~u : (u | 0x80000000u);
        }
        __syncthreads();
        unsigned prefix = 0u; unsigned kneed = 256u, neq = 0u;
#pragma unroll
        for (int pass = 0; pass < 4; ++pass) {
            const int shift = 24 - 8 * pass;
            if (tid < 256) hist[tid] = 0u;
            __syncthreads();
            for (int s = tid; s < n; s += NWAVES * 64) { const unsigned key = skey[s]; const bool match = (pass == 0) ? true : ((key >> ((shift + 8) & 31)) == prefix);
                if (match) __hip_atomic_fetch_add(hist + ((key >> shift) & 255u), 1u, __ATOMIC_RELAXED, __HIP_MEMORY_SCOPE_WORKGROUP); }
            __syncthreads();
            if (h == 0) {
                const unsigned c0 = hist[4 * lane], c1 = hist[4 * lane + 1], c2 = hist[4 * lane + 2], c3 = hist[4 * lane + 3]; const unsigned tot = c0 + c1 + c2 + c3;
                unsigned S = tot;
#pragma unroll
                for (int o = 1; o < 64; o <<= 1) { const unsigned v = __shfl_down(S, o); if (lane + o < 64) S += v; }
                const unsigned above = S - tot;
                if (above < kneed && kneed <= S) { unsigned a = above; unsigned bsel, cnt;
                    if (a + c3 >= kneed) { bsel = 3; cnt = c3; } else { a += c3; if (a + c2 >= kneed) { bsel = 2; cnt = c2; } else { a += c2; if (a + c1 >= kneed) { bsel = 1; cnt = c1; } else { a += c1; bsel = 0; cnt = c0; } } }
                    misc[0] = 4u * lane + bsel; misc[1] = kneed - a; misc[2] = cnt; }
            }
            __syncthreads();
            prefix = (prefix << 8) | misc[0]; kneed = misc[1]; neq = misc[2];
            __syncthreads();
        }
        const unsigned Tk = prefix;
        for (int s = tid; s < n; s += NWAVES * 64) { const unsigned key = skey[s];
            if (key > Tk || (key == Tk && neq == kneed)) { const unsigned idx = __hip_atomic_fetch_add(misc + 8, 1u, __ATOMIC_RELAXED, __HIP_MEMORY_SCOPE_WORKGROUP); if (idx < 256u) sel[idx] = s; } }
        __syncthreads();
        if (neq != kneed && tid == 0) { unsigned c = misc[8]; unsigned need = kneed; for (int s = 0; s < n && need > 0u && c < 256u; ++s) if (skey[s] == Tk) { sel[c++] = s; --need; } }
    } else {
        if (tid < 256) sel[tid] = (tid <= t) ? tid : -1;
    }
    __syncthreads();
    LAS float* qs = (LAS float*)(F.lds + GL_QS) + h * 64; LAS float* ps = (LAS float*)(F.lds + GL_PS) + h * 1024;
    bf16* qrow = WSB(WS_QB) + row * 512 + h * 64;
    qs[lane] = bf2f(qrow[lane]);
    LDS_WAIT(); asm volatile("" ::: "memory");
    const bf16* Kh = WSB(WS_KB) + ((size_t)b * SEQ) * 512 + h * 64; const bf16* Vh = WSB(WS_VB) + ((size_t)b * SEQ) * 512 + h * 64;
    float lg[4];
#pragma unroll
    for (int i = 0; i < 4; ++i) { const int pos = sel[i * 64 + lane]; float s = -1e30f;
        if (pos >= 0) s = dot64(qs, Kh + (size_t)pos * 512) * 0.125f + INP(I_RELB)[t5_bucket(t - pos) * 16 + 8 + h];
        lg[i] = s; }
    float m = wave_max(fmaxf(fmaxf(lg[0], lg[1]), fmaxf(lg[2], lg[3]))); float sum = 0.f;
#pragma unroll
    for (int i = 0; i < 4; ++i) { const float e = __expf(lg[i] - m); sum += e; ps[i * 64 + lane] = e; }
    sum = wave_sum(sum);
    LDS_WAIT(); asm volatile("" ::: "memory");
    float acc = 0.f; const int nk = n < 256 ? n : 256;
    int kk = 0;
    for (; kk + 8 <= nk; kk += 8) { float pv[8], vv[8];
#pragma unroll
        for (int j = 0; j < 8; ++j) { const int pos = sel[kk + j]; pv[j] = ps[kk + j]; vv[j] = bf2f(Vh[(size_t)pos * 512 + lane]); }
#pragma unroll
        for (int j = 0; j < 8; ++j) acc += pv[j] * vv[j]; }
    for (; kk < nk; ++kk) { const int pos = sel[kk]; acc += ps[kk] * bf2f(Vh[(size_t)pos * 512 + lane]); }
    qrow[lane] = (bf16)f2bf(acc / sum);
}

typedef float f32x16 __attribute__((ext_vector_type(16)));
constexpr int AT_KROW = 144, AT_VROW = 136;
constexpr int AT_KBUF = 64 * AT_KROW, AT_VBUF = 64 * AT_VROW;
constexpr int AT_K0 = 0, AT_V0 = 2 * AT_KBUF, AT_BT = 36864, AT_OST = 40960;
constexpr float AT_C2 = 0.125f * 1.4426950408889634f;
constexpr float AT_THR = 8.0f;
constexpr float LOG2E = 1.4426950408889634f;
__device__ __forceinline__ int crow_(int r, int hi) { return (r & 3) + 8 * (r >> 2) + 4 * hi; }
#define MFMA_FENCE2(a, b) asm volatile("s_nop 15\n\ts_nop 15" : "+v"(a), "+v"(b))

__device__ __forceinline__ void at_load(const GAS bf16* Kh, const GAS bf16* Vh, int tile, int tid, v4u& kr, v4u& vr) {
    kr = *(const GAS v4u*)(Kh + (size_t)(tile * 64 + (tid >> 3)) * 512 + (tid & 7) * 8);
    vr = *(const GAS v4u*)(Vh + (size_t)(tile * 64 + (tid >> 3)) * 512 + (tid & 7) * 8);
}
__device__ __forceinline__ void at_store(LAS unsigned char* kb, LAS unsigned char* vb, int tid, const v4u kr, const v4u vr) {
    *(LAS v4u*)(kb + (tid >> 3) * AT_KROW + (tid & 7) * 16) = kr;
    LAS bf16* vt = (LAS bf16*)(vb + ((tid & 7) * 8) * AT_VROW) + (tid >> 3);
    constexpr int RS = AT_VROW / 2;
    vt[0 * RS] = (bf16)(vr.x & 0xffffu); vt[1 * RS] = (bf16)(vr.x >> 16); vt[2 * RS] = (bf16)(vr.y & 0xffffu); vt[3 * RS] = (bf16)(vr.y >> 16);
    vt[4 * RS] = (bf16)(vr.z & 0xffffu); vt[5 * RS] = (bf16)(vr.z >> 16); vt[6 * RS] = (bf16)(vr.w & 0xffffu); vt[7 * RS] = (bf16)(vr.w >> 16);
}
__device__ __forceinline__ void at_qk(f32x16& p0, f32x16& p1, const LAS unsigned char* kb, const bf16x8_t (&qf)[4], int r32, int hi) {
    const LAS unsigned char* kp = kb + r32 * AT_KROW + hi * 16;
    bf16x8_t k0[4], k1[4];
#pragma unroll
    for (int s = 0; s < 4; ++s) { k0[s] = *(const LAS bf16x8_t*)(kp + s * 32); k1[s] = *(const LAS bf16x8_t*)(kp + 32 * AT_KROW + s * 32); }
    asm volatile("s_waitcnt lgkmcnt(0)" : "+v"(k0[0]), "+v"(k0[1]), "+v"(k0[2]), "+v"(k0[3]), "+v"(k1[0]), "+v"(k1[1]), "+v"(k1[2]), "+v"(k1[3]) :: "memory");
#pragma unroll
    for (int s = 0; s < 4; ++s) { p0 = __builtin_amdgcn_mfma_f32_32x32x16_bf16(k0[s], qf[s], p0, 0, 0, 0); p1 = __builtin_amdgcn_mfma_f32_32x32x16_bf16(k1[s], qf[s], p1, 0, 0, 0); }
}
__device__ __forceinline__ void at_qk_m(f32x16& p0, f32x16& p1, const LAS unsigned char* kb, const bf16x8_t (&qf)[4], const bf16x8_t oneA, const bf16x8_t mB, int r32, int hi) {
    const LAS unsigned char* kp = kb + r32 * AT_KROW + hi * 16;
    bf16x8_t k0[4], k1[4];
#pragma unroll
    for (int s = 0; s < 4; ++s) { k0[s] = *(const LAS bf16x8_t*)(kp + s * 32); k1[s] = *(const LAS bf16x8_t*)(kp + 32 * AT_KROW + s * 32); }
    p0 = __builtin_amdgcn_mfma_f32_32x32x16_bf16(oneA, mB, p0, 0, 0, 0); p1 = __builtin_amdgcn_mfma_f32_32x32x16_bf16(oneA, mB, p1, 0, 0, 0);
    asm volatile("s_waitcnt lgkmcnt(0)" : "+v"(k0[0]), "+v"(k0[1]), "+v"(k0[2]), "+v"(k0[3]), "+v"(k1[0]), "+v"(k1[1]), "+v"(k1[2]), "+v"(k1[3]) :: "memory");
#pragma unroll
    for (int s = 0; s < 4; ++s) { p0 = __builtin_amdgcn_mfma_f32_32x32x16_bf16(k0[s], qf[s], p0, 0, 0, 0); p1 = __builtin_amdgcn_mfma_f32_32x32x16_bf16(k1[s], qf[s], p1, 0, 0, 0); }
}
__device__ __forceinline__ void at_pv(f32x16& o0, f32x16& o1, const LAS unsigned char* vb, const bf16x8_t (&pb)[4], int r32, int hi) {
    const LAS unsigned char* vp = vb + r32 * AT_VROW + hi * 8;
    union U { bf16x8_t v; unsigned long long u[2]; }; U a0[4], a1[4];
#pragma unroll
    for (int sg = 0; sg < 4; ++sg) { const int kvo = (32 * (sg >> 1) + 16 * (sg & 1)) * 2;
        a0[sg].u[0] = *(const LAS unsigned long long*)(vp + kvo); a0[sg].u[1] = *(const LAS unsigned long long*)(vp + kvo + 16);
        a1[sg].u[0] = *(const LAS unsigned long long*)(vp + 32 * AT_VROW + kvo); a1[sg].u[1] = *(const LAS unsigned long long*)(vp + 32 * AT_VROW + kvo + 16); }
    asm volatile("s_waitcnt lgkmcnt(0)" : "+v"(a0[0].v), "+v"(a0[1].v), "+v"(a0[2].v), "+v"(a0[3].v), "+v"(a1[0].v), "+v"(a1[1].v), "+v"(a1[2].v), "+v"(a1[3].v) :: "memory");
#pragma unroll
    for (int sg = 0; sg < 4; ++sg) { o0 = __builtin_amdgcn_mfma_f32_32x32x16_bf16(a0[sg].v, pb[sg], o0, 0, 0, 0); o1 = __builtin_amdgcn_mfma_f32_32x32x16_bf16(a1[sg].v, pb[sg], o1, 0, 0, 0); }
}
__device__ __forceinline__ float max3_(float a, float b, float c) { float r; asm("v_max3_f32 %0, %1, %2, %3" : "=v"(r) : "v"(a), "v"(b), "v"(c)); return r; }
__device__ __forceinline__ unsigned and_sel(float p, unsigned w, int bit) { int t; asm("v_bfe_i32 %0, %1, %2, 1" : "=v"(t) : "v"(w), "n"(bit)); return __float_as_uint(p) & (unsigned)t; }

template <int MODE  , bool DRY = false  >
__device__ __forceinline__ void attn_unit(Frame& F, int b, int h, int qt) {
    int tid_ = F.tid; asm volatile("" : "+v"(tid_));
    const int tid = tid_, lane = tid & 63, wave = F.wave, r32 = lane & 31, hi = lane >> 5;
    LAS unsigned char* L = F.lds + RING_OFF;
    LAS float* bt = (LAS float*)(L + AT_BT);
    const GAS bf16* Qg = (const GAS bf16*)WSB(MODE == 0 ? WS_QA : WS_QB); const GAS bf16* Kg = (const GAS bf16*)WSB(MODE == 0 ? WS_KA : WS_KB); const GAS bf16* Vg = (const GAS bf16*)WSB(MODE == 0 ? WS_VA : WS_VB);
    const size_t rowb = (size_t)b * SEQ;
    const GAS bf16* Kh = Kg + rowb * 512 + h * 64; const GAS bf16* Vh = Vg + rowb * 512 + h * 64;
    const int q0w = qt * 256 + wave * 32, q = q0w + r32;
    const int NT = 4 * qt + 4;
    __syncthreads();
    if (tid < 128) { const GAS float* rb = (const GAS float*)INP(I_RELB) + (MODE * 8 + h); bt[tid] = (rb[t5_bucket(tid) * 16] - rb[31 * 16]) * LOG2E; }
    bf16x8_t qf[4];
    { const GAS bf16* qp = Qg + (rowb + q) * 512 + h * 64 + hi * 8;
#pragma unroll
      for (int s = 0; s < 4; ++s) qf[s] = *(const GAS bf16x8_t*)(qp + s * 16); }
    unsigned mlo = 0u, mhi = 0u;
    if (MODE == 0) {
        { const int n = tid >> 3, c8 = (tid & 7) * 8; const GAS float* km = (const GAS float*)WSF(WS_KMEAN) + ((size_t)b * NBLK + n) * 512 + h * 64 + c8;
          const f32x4 a = *(const GAS f32x4*)km, c = *(const GAS f32x4*)(km + 4);
          const unsigned h0 = pk2(a.x, a.y), h1 = pk2(a.z, a.w), h2 = pk2(c.x, c.y), h3 = pk2(c.z, c.w);
          const unsigned l0 = pk2(a.x - __uint_as_float(h0 << 16), a.y - __uint_as_float(h0 & 0xffff0000u)), l1 = pk2(a.z - __uint_as_float(h1 << 16), a.w - __uint_as_float(h1 & 0xffff0000u)),
                         l2 = pk2(c.x - __uint_as_float(h2 << 16), c.y - __uint_as_float(h2 & 0xffff0000u)), l3 = pk2(c.z - __uint_as_float(h3 << 16), c.w - __uint_as_float(h3 & 0xffff0000u));
          *(LAS v4u*)(L + AT_K0 + n * AT_KROW + (tid & 7) * 16) = (v4u){h0, h1, h2, h3}; *(LAS v4u*)(L + AT_K0 + AT_KBUF + n * AT_KROW + (tid & 7) * 16) = (v4u){l0, l1, l2, l3}; }
        __syncthreads();
        f32x16 g0 = {0.f, 0.f, 0.f, 0.f, 0.f, 0.f, 0.f, 0.f, 0.f, 0.f, 0.f, 0.f, 0.f, 0.f, 0.f, 0.f}, g1 = g0;
        at_qk(g0, g1, L + AT_K0, qf, r32, hi); at_qk(g0, g1, L + AT_K0 + AT_KBUF, qf, r32, hi);
        MFMA_FENCE2(g0, g1);
#pragma unroll
        for (int r = 0; r < 16; ++r) { if (crow_(r, hi) >= qt) g0[r] = -INFINITY; if (32 + crow_(r, hi) >= qt) g1[r] = -INFINITY; }
#pragma unroll
        for (int it = 0; it < 3; ++it) {
            float bv = -INFINITY; int bn = 64;
#pragma unroll
            for (int r = 0; r < 16; ++r) if (g0[r] > bv) { bv = g0[r]; bn = crow_(r, hi); }
#pragma unroll
            for (int r = 0; r < 16; ++r) if (g1[r] > bv) { bv = g1[r]; bn = 32 + crow_(r, hi); }
            const float pv = __shfl_xor(bv, 32); const int pn = __shfl_xor(bn, 32);
            const bool tp = (pv > bv) || (pv == bv && pn < bn);
            const float wv = tp ? pv : bv; const int wn = tp ? pn : bn;
            if (wv > -INFINITY) { if (wn < 32) mlo |= 1u << wn; else mhi |= 1u << (wn - 32); }
#pragma unroll
            for (int r = 0; r < 16; ++r) { if (crow_(r, hi) == wn) g0[r] = -INFINITY; if (32 + crow_(r, hi) == wn) g1[r] = -INFINITY; }
        }
        __syncthreads();
    }
    v4u krA, vrA, krB, vrB; unsigned wlA = 0u, whA = 0u, wlB = 0u, whB = 0u;
    const GAS unsigned* mrow = (const GAS unsigned*)(F.ws + WS_MASK) + (rowb + q) * 512;
    at_load(Kh, Vh, 0, tid, krA, vrA);
    unsigned wl_c = 0u, wh_c = 0u;
    if (MODE == 1) { wl_c = mrow[0]; wh_c = mrow[1]; }
    at_store(L + AT_K0, L + AT_V0, tid, krA, vrA);
    at_load(Kh, Vh, 1, tid, krA, vrA);
    if (MODE == 1) { wlA = mrow[2]; whA = mrow[3]; }
    __syncthreads();
    float m = -1e30f, lsum = 0.f;
    f32x16 o0 = {0.f, 0.f, 0.f, 0.f, 0.f, 0.f, 0.f, 0.f, 0.f, 0.f, 0.f, 0.f, 0.f, 0.f, 0.f, 0.f}, o1 = o0;
    auto step = [&](int t, v4u& krS, v4u& vrS, unsigned& wlS, unsigned& whS, v4u& krN, v4u& vrN, unsigned& wlN, unsigned& whN) __attribute__((always_inline)) {
        const int cur = t & 1;
        unsigned wlo = wl_c, whi = wh_c;
        if (t + 2 < NT) { at_load(Kh, Vh, t + 2, tid, krN, vrN); if (MODE == 1) { wlN = mrow[2 * (t + 2)]; whN = mrow[2 * (t + 2) + 1]; } }
        if (MODE == 0) {
            if (t < 4 * qt) { const int blk = t >> 2; const unsigned bit = (blk < 32 ? (mlo >> blk) : (mhi >> (blk - 32))) & 1u; wlo = whi = bit ? 0xffffffffu : 0u; }
            else { const int nall = q - t * 64 + 1;
                wlo = nall >= 32 ? 0xffffffffu : (nall <= 0 ? 0u : ((1u << nall) - 1u)); whi = nall >= 64 ? 0xffffffffu : (nall <= 32 ? 0u : ((1u << (nall - 32)) - 1u)); }
        }
        if (__any((wlo | whi) != 0u)) {
            const LAS unsigned char* kb = L + AT_K0 + cur * AT_KBUF; const LAS unsigned char* vb = L + AT_V0 + cur * AT_VBUF;
            const bool and_mask = (MODE == 1) || (t >= 4 * qt);
            const float ci = (!and_mask && wlo == 0u) ? -1e9f : 0.f;
            f32x16 p0 = {ci, ci, ci, ci, ci, ci, ci, ci, ci, ci, ci, ci, ci, ci, ci, ci}, p1 = p0;
            at_qk(p0, p1, kb, qf, r32, hi);
            MFMA_FENCE2(p0, p1);
            const bool near = (t * 64 + 191 > q0w);
            float mx; float sc = AT_C2;
            if (near) {
#pragma unroll
                for (int r = 0; r < 16; ++r) { const int d0 = q - (t * 64 + crow_(r, hi)), d1 = d0 - 32;
                    const float b0 = ((unsigned)d0 < 128u) ? bt[d0] : 0.f, b1 = ((unsigned)d1 < 128u) ? bt[d1] : 0.f;
                    p0[r] = p0[r] * AT_C2 + b0; p1[r] = p1[r] * AT_C2 + b1; }
                sc = 1.0f;
            }
            { float ma = max3_(p0[0], p1[0], p0[1]), mb = max3_(p1[1], p0[2], p1[2]), mc = max3_(p0[3], p1[3], p0[4]), md = max3_(p1[4], p0[5], p1[5]);
              ma = max3_(ma, p0[6], p1[6]); mb = max3_(mb, p0[7], p1[7]); mc = max3_(mc, p0[8], p1[8]); md = max3_(md, p0[9], p1[9]);
              ma = max3_(ma, p0[10], p1[10]); mb = max3_(mb, p0[11], p1[11]); mc = max3_(mc, p0[12], p1[12]); md = max3_(md, p0[13], p1[13]);
              ma = max3_(ma, p0[14], p1[14]); mb = max3_(mb, p0[15], p1[15]); mx = max3_(ma, mb, mc); mx = max3_(mx, md, md); }
            mx = max3_(mx, __shfl_xor(mx, 32), mx) * sc;
            if (__any(mx > m + AT_THR)) {
                const float mn = fmaxf(m, mx); const float al = __builtin_amdgcn_exp2f(m - mn);
                MFMA_FENCE2(o0, o1);
#pragma unroll
                for (int r = 0; r < 16; ++r) { o0[r] *= al; o1[r] *= al; }
                lsum *= al; m = mn;
            }
            float ls = 0.f;
            if (and_mask) {
                const unsigned wl = wlo >> (4 * hi), wh = whi >> (4 * hi);
                float lq[4] = {0.f, 0.f, 0.f, 0.f};
#pragma unroll
                for (int r = 0; r < 16; ++r) { const int cb = (r & 3) + 8 * (r >> 2);
                    const float e0 = __uint_as_float(and_sel(__builtin_amdgcn_exp2f(__builtin_fmaf(p0[r], sc, -m)), wl, cb)), e1 = __uint_as_float(and_sel(__builtin_amdgcn_exp2f(__builtin_fmaf(p1[r], sc, -m)), wh, cb));
                    p0[r] = e0; p1[r] = e1; lq[r & 1] += e0; lq[2 + (r & 1)] += e1; }
                ls = (lq[0] + lq[1]) + (lq[2] + lq[3]);
            } else {
#pragma unroll
                for (int r = 0; r < 16; ++r) { const float e0 = __builtin_amdgcn_exp2f(__builtin_fmaf(p0[r], sc, -m)), e1 = __builtin_amdgcn_exp2f(__builtin_fmaf(p1[r], sc, -m));
                    p0[r] = e0; p1[r] = e1; ls += e0 + e1; }
            }
            lsum += ls;
            bf16x8_t pb[4];
#pragma unroll
            for (int sg = 0; sg < 4; ++sg) { union { bf16x8_t v; unsigned u[4]; } pk;
#pragma unroll
                for (int j = 0; j < 4; ++j) { const int r = 8 * (sg & 1) + 2 * j; pk.u[j] = (sg < 2) ? pg8::cvt_pk_bf16(p0[r], p0[r + 1]) : pg8::cvt_pk_bf16(p1[r], p1[r + 1]); }
                pb[sg] = pk.v; }
            at_pv(o0, o1, vb, pb, r32, hi);
        }
        if (t + 1 < NT) at_store(L + AT_K0 + (cur ^ 1) * AT_KBUF, L + AT_V0 + (cur ^ 1) * AT_VBUF, tid, krS, vrS);
        wl_c = wlS; wh_c = whS;
        __syncthreads();
    };
#pragma unroll 1
    for (int t = 0; t < NT; t += 2) {
        step(t, krA, vrA, wlA, whA, krB, vrB, wlB, whB);
        step(t + 1, krB, vrB, wlB, whB, krA, vrA, wlA, whA);
    }
    MFMA_FENCE2(o0, o1);
    lsum += __shfl_xor(lsum, 32);
    const float inv = 1.0f / lsum;
    LAS bf16* ost = (LAS bf16*)(L + AT_OST + wave * 4096);
#pragma unroll
    for (int r = 0; r < 16; ++r) { ost[r32 * 64 + crow_(r, hi)] = (bf16)f2bf(o0[r] * inv); ost[r32 * 64 + 32 + crow_(r, hi)] = (bf16)f2bf(o1[r] * inv); }
    LDS_WAIT(); asm volatile("" ::: "memory");
    GAS bf16* Og = (GAS bf16*)WSB(MODE == 0 ? WS_QA : WS_QB) + (rowb + q0w) * 512 + h * 64;
#pragma unroll
    for (int i = 0; i < 4; ++i) { const int c = i * 64 + lane, row = c >> 3, ch = c & 7; const v4u ov = *(const LAS v4u*)(ost + row * 64 + ch * 8); if (!DRY) *(GAS v4u*)(Og + (size_t)row * 512 + ch * 8) = ov; else if (ov.x == 0x12345678u && ov.y == 0x9abcdef0u) *(GAS v4u*)(Og + (size_t)row * 512 + ch * 8) = ov; }
}

constexpr int DA_K0 = 0, DA_V0 = 3 * AT_KBUF, DA_BT = DA_V0 + 2 * AT_VBUF, DA_OST = 49152;
static_assert(DA_BT + 512 <= DA_OST && DA_OST + 8 * 4096 <= RING_BYTES, "dsa attention LDS map");
__device__ __forceinline__ v4u at_load_k(const GAS bf16* Kh, int tile, int tid) { return *(const GAS v4u*)(Kh + (size_t)(tile * 64 + (tid >> 3)) * 512 + (tid & 7) * 8); }
__device__ __forceinline__ v4u at_load_v(const GAS bf16* Vh, int tile, int tid) { return *(const GAS v4u*)(Vh + (size_t)(tile * 64 + (tid & 63)) * 512 + (tid >> 6) * 8); }
__device__ __forceinline__ void at_store_k(LAS unsigned char* kb, int tid, const v4u kr) { *(LAS v4u*)(kb + (tid >> 3) * AT_KROW + (tid & 7) * 16) = kr; }
__device__ __forceinline__ void at_store_v(LAS unsigned char* vb, int tid, const v4u vr) {
    LAS bf16* vt = (LAS bf16*)(vb + ((tid >> 6) * 8) * AT_VROW) + (tid & 63); constexpr int RS = AT_VROW / 2;
    vt[0 * RS] = (bf16)(vr.x & 0xffffu); vt[1 * RS] = (bf16)(vr.x >> 16); vt[2 * RS] = (bf16)(vr.y & 0xffffu); vt[3 * RS] = (bf16)(vr.y >> 16);
    vt[4 * RS] = (bf16)(vr.z & 0xffffu); vt[5 * RS] = (bf16)(vr.z >> 16); vt[6 * RS] = (bf16)(vr.w & 0xffffu); vt[7 * RS] = (bf16)(vr.w >> 16);
}
struct DsaState { float m, lsum; f32x16 o0, o1; unsigned wc_lo, wc_hi, wn_lo, wn_hi; };
__device__ __forceinline__ void dsa_step(DsaState& S, f32x16& P0, f32x16& P1, f32x16& Pn0, f32x16& Pn1, int t, int NT, LAS unsigned char* L, const LAS float* bt, const bf16x8_t (&qf)[4],
                                         const GAS bf16* Kh, const GAS bf16* Vh, const GAS unsigned* mrow, int tid, int r32, int hi, int q, int q0w) {
    v4u krn, vrn; unsigned wq_lo = 0u, wq_hi = 0u;
    const bool has1 = (t + 1 < NT), has2 = (t + 2 < NT);
    if (has2) { krn = at_load_k(Kh, t + 2, tid); wq_lo = mrow[2 * (t + 2)]; wq_hi = mrow[2 * (t + 2) + 1]; }
    if (has1) vrn = at_load_v(Vh, t + 1, tid);
    if (has1 && __any((S.wn_lo | S.wn_hi) != 0u)) {
        Pn0 = (f32x16){0.f, 0.f, 0.f, 0.f, 0.f, 0.f, 0.f, 0.f, 0.f, 0.f, 0.f, 0.f, 0.f, 0.f, 0.f, 0.f}; Pn1 = Pn0;
        at_qk(Pn0, Pn1, L + DA_K0 + ((t + 1) % 3) * AT_KBUF, qf, r32, hi);
    }
    if (__any((S.wc_lo | S.wc_hi) != 0u)) {
        const LAS unsigned char* vb = L + DA_V0 + (t & 1) * AT_VBUF;
        MFMA_FENCE2(P0, P1);
        const bool near = (t * 64 + 191 > q0w);
        float sc = AT_C2;
        if (near) {
#pragma unroll
            for (int r = 0; r < 16; ++r) { const int d0 = q - (t * 64 + crow_(r, hi)), d1 = d0 - 32;
                const float b0 = ((unsigned)d0 < 128u) ? bt[d0] : 0.f, b1 = ((unsigned)d1 < 128u) ? bt[d1] : 0.f;
                P0[r] = P0[r] * AT_C2 + b0; P1[r] = P1[r] * AT_C2 + b1; }
            sc = 1.0f;
        }
        float mx = max3_(P0[0], P1[0], P0[1]), mx2 = max3_(P1[1], P0[2], P1[2]);
#pragma unroll
        for (int r = 3; r < 15; r += 2) { mx = max3_(mx, P0[r], P1[r]); mx2 = max3_(mx2, P0[r + 1], P1[r + 1]); }
        mx = max3_(mx, P0[15], P1[15]); mx = max3_(mx, mx2, mx2);
        mx = max3_(mx, __shfl_xor(mx, 32), mx) * sc;
        if (__any(mx > S.m + AT_THR)) {
            const float mn = fmaxf(S.m, mx); const float al = __builtin_amdgcn_exp2f(S.m - mn);
            MFMA_FENCE2(S.o0, S.o1);
#pragma unroll
            for (int r = 0; r < 16; ++r) { S.o0[r] *= al; S.o1[r] *= al; }
            S.lsum *= al; S.m = mn;
        }
        const unsigned wl = S.wc_lo >> (4 * hi), wh = S.wc_hi >> (4 * hi); const float m = S.m;
        float ls = 0.f;
#pragma unroll
        for (int r = 0; r < 16; ++r) { const int cb = (r & 3) + 8 * (r >> 2);
            const float e0 = __uint_as_float(and_sel(__builtin_amdgcn_exp2f(__builtin_fmaf(P0[r], sc, -m)), wl, cb)), e1 = __uint_as_float(and_sel(__builtin_amdgcn_exp2f(__builtin_fmaf(P1[r], sc, -m)), wh, cb));
            P0[r] = e0; P1[r] = e1; ls += e0 + e1; }
        S.lsum += ls;
        bf16x8_t pb[4];
#pragma unroll
        for (int sg = 0; sg < 4; ++sg) { union { bf16x8_t v; unsigned u[4]; } pk;
#pragma unroll
            for (int j = 0; j < 4; ++j) { const int r = 8 * (sg & 1) + 2 * j; pk.u[j] = (sg < 2) ? pg8::cvt_pk_bf16(P0[r], P0[r + 1]) : pg8::cvt_pk_bf16(P1[r], P1[r + 1]); }
            pb[sg] = pk.v; }
        at_pv(S.o0, S.o1, vb, pb, r32, hi);
    }
    if (has2) at_store_k(L + DA_K0 + ((t + 2) % 3) * AT_KBUF, tid, krn);
    if (has1) at_store_v(L + DA_V0 + ((t + 1) & 1) * AT_VBUF, tid, vrn);
    S.wc_lo = S.wn_lo; S.wc_hi = S.wn_hi; S.wn_lo = wq_lo; S.wn_hi = wq_hi;
    __syncthreads();
}
template <bool DRY = false> __device__ __forceinline__ void dsa_attn_unit(Frame& F, int b, int h, int qt) {
    int tid_ = F.tid; asm volatile("" : "+v"(tid_));
    const int tid = tid_, lane = tid & 63, wave = F.wave, r32 = lane & 31, hi = lane >> 5;
    LAS unsigned char* L = F.lds + RING_OFF;
    LAS float* bt = (LAS float*)(L + DA_BT);
    const size_t rowb = (size_t)b * SEQ;
    const GAS bf16* Kh = (const GAS bf16*)WSB(WS_KB) + rowb * 512 + h * 64; const GAS bf16* Vh = (const GAS bf16*)WSB(WS_VB) + rowb * 512 + h * 64;
    const int q0w = qt * 256 + wave * 32, q = q0w + r32;
    const int NT = 4 * qt + 4;
    __syncthreads();
    if (tid < 128) { const GAS float* rb = (const GAS float*)INP(I_RELB) + (8 + h); bt[tid] = (rb[t5_bucket(tid) * 16] - rb[31 * 16]) * LOG2E; }
    bf16x8_t qf[4];
    { const GAS bf16* qp = (const GAS bf16*)WSB(WS_QB) + (rowb + q) * 512 + h * 64 + hi * 8;
#pragma unroll
      for (int s = 0; s < 4; ++s) qf[s] = *(const GAS bf16x8_t*)(qp + s * 16); }
    const GAS unsigned* mrow = (const GAS unsigned*)(F.ws + WS_MASK) + (rowb + q) * 512;
    DsaState S; S.m = -1e30f; S.lsum = 0.f; S.o0 = (f32x16){0.f, 0.f, 0.f, 0.f, 0.f, 0.f, 0.f, 0.f, 0.f, 0.f, 0.f, 0.f, 0.f, 0.f, 0.f, 0.f}; S.o1 = S.o0;
    S.wc_lo = mrow[0]; S.wc_hi = mrow[1]; S.wn_lo = mrow[2]; S.wn_hi = mrow[3];
    { const v4u k0 = at_load_k(Kh, 0, tid), v0 = at_load_v(Vh, 0, tid), k1 = at_load_k(Kh, 1, tid);
      at_store_k(L + DA_K0, tid, k0); at_store_v(L + DA_V0, tid, v0); at_store_k(L + DA_K0 + AT_KBUF, tid, k1); }
    __syncthreads();
    f32x16 pA0 = {0.f, 0.f, 0.f, 0.f, 0.f, 0.f, 0.f, 0.f, 0.f, 0.f, 0.f, 0.f, 0.f, 0.f, 0.f, 0.f}, pA1 = pA0, pB0 = pA0, pB1 = pA0;
    if (__any((S.wc_lo | S.wc_hi) != 0u)) at_qk(pA0, pA1, L + DA_K0, qf, r32, hi);
#pragma unroll 1
    for (int t = 0; t < NT; t += 2) {
        dsa_step(S, pA0, pA1, pB0, pB1, t, NT, L, bt, qf, Kh, Vh, mrow, tid, r32, hi, q, q0w);
        dsa_step(S, pB0, pB1, pA0, pA1, t + 1, NT, L, bt, qf, Kh, Vh, mrow, tid, r32, hi, q, q0w);
    }
    MFMA_FENCE2(S.o0, S.o1);
    float lsum = S.lsum; lsum += __shfl_xor(lsum, 32);
    const float inv = 1.0f / lsum;
    LAS bf16* ost = (LAS bf16*)(L + DA_OST + wave * 4096);
#pragma unroll
    for (int r = 0; r < 16; ++r) { ost[r32 * 64 + crow_(r, hi)] = (bf16)f2bf(S.o0[r] * inv); ost[r32 * 64 + 32 + crow_(r, hi)] = (bf16)f2bf(S.o1[r] * inv); }
    LDS_WAIT(); asm volatile("" ::: "memory");
    GAS bf16* Og = (GAS bf16*)WSB(WS_QB) + (rowb + q0w) * 512 + h * 64;
#pragma unroll
    for (int i = 0; i < 4; ++i) { const int c = i * 64 + lane, row = c >> 3, ch = c & 7; const v4u ov = *(const LAS v4u*)(ost + row * 64 + ch * 8); if (!DRY) *(GAS v4u*)(Og + (size_t)row * 512 + ch * 8) = ov; else if (ov.x == 0x12345678u && ov.y == 0x9abcdef0u) *(GAS v4u*)(Og + (size_t)row * 512 + ch * 8) = ov; }
}

constexpr int A2_TILE = 64 * 128;
__device__ __forceinline__ void at2_dma(const GAS bf16* Kh, const GAS bf16* Vh, int tile, int wave, int lane, LAS unsigned char* kb, LAS unsigned char* vb) {
    const int row = 8 * wave + (lane >> 3), p = lane & 7;
    const GAS bf16* kg = Kh + (size_t)(tile * 64 + row) * 512 + ((p ^ ((row >> 1) & 7)) * 8);
    const GAS bf16* vg = Vh + (size_t)(tile * 64 + row) * 512 + ((p ^ (((row >> 1) & 1) * 4)) * 8);
    __builtin_amdgcn_global_load_lds((const unsigned*)kg, (LAS unsigned*)(kb + wave * 1024), 16, 0, 0);
    __builtin_amdgcn_global_load_lds((const unsigned*)vg, (LAS unsigned*)(vb + wave * 1024), 16, 0, 0);
}
__device__ __forceinline__ void at2_qk_m(f32x16& p0, f32x16& p1, const LAS unsigned char* kb, const LAS unsigned char* ones, const bf16x8_t (&qf)[4], const bf16x8_t mB, int r32, int hi) {
    const int f = (r32 >> 1) & 7;
    const LAS unsigned char* kp = kb + r32 * 128;
    bf16x8_t k0[5], k1[5];
#pragma unroll
    for (int s = 0; s < 4; ++s) { const int po = ((2 * s + hi) ^ f) * 16; k0[s] = *(const LAS bf16x8_t*)(kp + po); k1[s] = *(const LAS bf16x8_t*)(kp + 32 * 128 + po); }
    k0[4] = *(const LAS bf16x8_t*)ones; k1[4] = k0[4];
    asm volatile("s_waitcnt lgkmcnt(0)" : "+v"(k0[0]), "+v"(k0[1]), "+v"(k0[2]), "+v"(k0[3]), "+v"(k0[4]), "+v"(k1[0]), "+v"(k1[1]), "+v"(k1[2]), "+v"(k1[3]), "+v"(k1[4]) :: "memory");
    p0 = __builtin_amdgcn_mfma_f32_32x32x16_bf16(k0[4], mB, p0, 0, 0, 0); p1 = __builtin_amdgcn_mfma_f32_32x32x16_bf16(k1[4], mB, p1, 0, 0, 0);
#pragma unroll
    for (int s = 0; s < 4; ++s) { p0 = __builtin_amdgcn_mfma_f32_32x32x16_bf16(k0[s], qf[s], p0, 0, 0, 0); p1 = __builtin_amdgcn_mfma_f32_32x32x16_bf16(k1[s], qf[s], p1, 0, 0, 0); }
}
typedef short s16x4_t __attribute__((ext_vector_type(4)));
__device__ __forceinline__ void at2_pv(f32x16& o0, f32x16& o1, const LAS unsigned char* vb, const bf16x8_t (&pb)[4], int lane) {
    const int g = lane >> 4, q = (lane & 15) >> 2, p = lane & 3;
    const int sw = ((q >> 1) & 1) * 4, c0 = 2 * (g & 1) + (p >> 1);
    const LAS unsigned char* rowp = vb + (4 * (g >> 1) + q) * 128 + 8 * (p & 1);
    const LAS unsigned char* b0 = rowp + ((c0 ^ sw) * 16); const LAS unsigned char* b1 = rowp + (((c0 + 4) ^ sw) * 16);
    union U { bf16x8_t v; s16x4_t h[2]; }; U a0[4], a1[4];
#pragma unroll
    for (int sg = 0; sg < 4; ++sg) { const int ro = (32 * (sg >> 1) + 16 * (sg & 1)) * 128;
        a0[sg].h[0] = __builtin_amdgcn_ds_read_tr16_b64_v4i16((LAS s16x4_t*)(b0 + ro)); a0[sg].h[1] = __builtin_amdgcn_ds_read_tr16_b64_v4i16((LAS s16x4_t*)(b0 + ro + 8 * 128));
        a1[sg].h[0] = __builtin_amdgcn_ds_read_tr16_b64_v4i16((LAS s16x4_t*)(b1 + ro)); a1[sg].h[1] = __builtin_amdgcn_ds_read_tr16_b64_v4i16((LAS s16x4_t*)(b1 + ro + 8 * 128)); }
    asm volatile("s_waitcnt lgkmcnt(0)" : "+v"(a0[0].v), "+v"(a0[1].v), "+v"(a0[2].v), "+v"(a0[3].v), "+v"(a1[0].v), "+v"(a1[1].v), "+v"(a1[2].v), "+v"(a1[3].v) :: "memory");
#pragma unroll
    for (int sg = 0; sg < 4; ++sg) { o0 = __builtin_amdgcn_mfma_f32_32x32x16_bf16(a0[sg].v, pb[sg], o0, 0, 0, 0); o1 = __builtin_amdgcn_mfma_f32_32x32x16_bf16(a1[sg].v, pb[sg], o1, 0, 0, 0); }
}
constexpr int D2_K = 0, D2_V = 4 * A2_TILE, D2_ONES = 8 * A2_TILE, D2_BT = D2_ONES + 64, D2_OST = 73728;
static_assert(D2_BT + 512 <= D2_OST && D2_OST + 8 * 4096 <= RING_BYTES, "dsa2 LDS map");
template <bool DRY = false> __device__ __forceinline__ void dsa_attn2_unit(Frame& F, int b, int h, int qt, unsigned* nextq = nullptr, volatile LAS unsigned* nslot = nullptr) {
    int tid_ = F.tid; asm volatile("" : "+v"(tid_));
    const int tid = tid_, lane = tid & 63, wave = F.wave, r32 = lane & 31, hi = lane >> 5;
    LAS unsigned char* L = F.lds + RING_OFF;
    LAS float* bt = (LAS float*)(L + D2_BT);
    const size_t rowb = (size_t)b * SEQ;
    const GAS bf16* Kh = (const GAS bf16*)WSB(WS_KB) + rowb * 512 + h * 64; const GAS bf16* Vh = (const GAS bf16*)WSB(WS_VB) + rowb * 512 + h * 64;
    const int q0w = qt * 256 + wave * 32, q = q0w + r32;
    const int NS = 2 * qt + 2;
    __syncthreads();
    if (tid < 128) { const GAS float* rb = (const GAS float*)INP(I_RELB) + (8 + h); bt[tid] = (rb[t5_bucket(tid) * 16] - rb[31 * 16]) * LOG2E; }
    bf16x8_t qf[4];
    { const GAS bf16* qp = (const GAS bf16*)WSB(WS_QB) + (rowb + q) * 512 + h * 64 + hi * 8;
#pragma unroll
      for (int s = 0; s < 4; ++s) qf[s] = *(const GAS bf16x8_t*)(qp + s * 16); }
#pragma unroll
    for (int s = 0; s < 4; ++s) { union { bf16x8_t v; unsigned u[4]; } x; x.v = qf[s];
#pragma unroll
        for (int jj = 0; jj < 4; ++jj) x.u[jj] = pg8::cvt_pk_bf16(pg8::bf_lo(x.u[jj]) * AT_C2, pg8::bf_hi(x.u[jj]) * AT_C2);
        qf[s] = x.v; }
    bf16x8_t mB;
    { union { bf16x8_t v; unsigned u[4]; } x; x.u[0] = x.u[1] = x.u[2] = x.u[3] = 0u; mB = x.v; }
    if (tid == 0) { unsigned one = 0x3f80u, zz = 0u; asm volatile("" : "+v"(one), "+v"(zz)); *(LAS v4u*)(L + D2_ONES) = (v4u){one, zz, zz, zz}; }
    bool fresh = true;
    const GAS unsigned* mrow = (const GAS unsigned*)(F.ws + WS_MASK) + (rowb + q) * 512;
    auto dma2 = [&](int s) __attribute__((always_inline)) { const int set = s & 1;
        at2_dma(Kh, Vh, 2 * s, wave, lane, L + D2_K + (2 * set) * A2_TILE, L + D2_V + (2 * set) * A2_TILE);
        at2_dma(Kh, Vh, 2 * s + 1, wave, lane, L + D2_K + (2 * set + 1) * A2_TILE, L + D2_V + (2 * set + 1) * A2_TILE); };
    dma2(0);
    unsigned wc[4] = { mrow[0], mrow[1], mrow[2], mrow[3] };
    VM_WAIT(); __syncthreads();
    float m = 0.f, lsum = 0.f;
    f32x16 o0 = {0.f, 0.f, 0.f, 0.f, 0.f, 0.f, 0.f, 0.f, 0.f, 0.f, 0.f, 0.f, 0.f, 0.f, 0.f, 0.f}, o1 = o0;
    auto step = [&](int s) __attribute__((always_inline)) {
        const int set = s & 1;
        if (s + 1 < NS) dma2(s + 1);
        unsigned wn[4] = {0u, 0u, 0u, 0u};
        if (s + 1 < NS) { const GAS unsigned* mp = mrow + 4 * (s + 1); wn[0] = mp[0]; wn[1] = mp[1]; wn[2] = mp[2]; wn[3] = mp[3]; }
        if (__any((wc[0] | wc[1] | wc[2] | wc[3]) != 0u)) {
            const LAS unsigned char* kb = L + D2_K + (2 * set) * A2_TILE; const LAS unsigned char* vb = L + D2_V + (2 * set) * A2_TILE;
            f32x16 p0 = {0.f, 0.f, 0.f, 0.f, 0.f, 0.f, 0.f, 0.f, 0.f, 0.f, 0.f, 0.f, 0.f, 0.f, 0.f, 0.f}, p1 = p0, p2 = p0, p3 = p0;
            at2_qk_m(p0, p1, kb, L + D2_ONES, qf, mB, r32, hi); at2_qk_m(p2, p3, kb + A2_TILE, L + D2_ONES, qf, mB, r32, hi);
            asm volatile("s_nop 15\n\ts_nop 15" : "+v"(p0), "+v"(p1), "+v"(p2), "+v"(p3));
            const int t0 = 2 * s;
            const bool near = ((t0 + 1) * 64 + 191 > q0w);
            if (near) {
#pragma unroll
                for (int r = 0; r < 16; ++r) { const int d0 = q - (t0 * 64 + crow_(r, hi)), d1 = d0 - 32, d2 = d0 - 64, d3 = d0 - 96;
                    const float b0 = ((unsigned)d0 < 128u) ? bt[d0] : 0.f, b1 = ((unsigned)d1 < 128u) ? bt[d1] : 0.f, b2 = ((unsigned)d2 < 128u) ? bt[d2] : 0.f, b3 = ((unsigned)d3 < 128u) ? bt[d3] : 0.f;
                    p0[r] += b0; p1[r] += b1; p2[r] += b2; p3[r] += b3; }
            }
            float mx;
            { float ma = max3_(p0[0], p1[0], p2[0]), mb = max3_(p3[0], p0[1], p1[1]), mc = max3_(p2[1], p3[1], p0[2]), md = max3_(p1[2], p2[2], p3[2]);
#pragma unroll
              for (int r = 3; r < 15; r += 2) { ma = max3_(ma, p0[r], p1[r]); mb = max3_(mb, p2[r], p3[r]); mc = max3_(mc, p0[r + 1], p1[r + 1]); md = max3_(md, p2[r + 1], p3[r + 1]); }
              ma = max3_(ma, p0[15], p1[15]); mb = max3_(mb, p2[15], p3[15]); mx = max3_(ma, mb, mc); mx = max3_(mx, md, md); }
            mx = max3_(mx, __shfl_xor(mx, 32), mx);
            if (fresh || __any(mx > AT_THR)) {
                const float d = fresh ? mx : fmaxf(mx, 0.f);
                const float mn = __uint_as_float(pg8::cvt_pk_bf16(0.f, m + d) & 0xffff0000u);
                const float dl = mn - m; const float al = __builtin_amdgcn_exp2f(-dl);
                MFMA_FENCE2(o0, o1);
#pragma unroll
                for (int r = 0; r < 16; ++r) { o0[r] *= al; o1[r] *= al; p0[r] -= dl; p1[r] -= dl; p2[r] -= dl; p3[r] -= dl; }
                lsum *= al; m = mn; fresh = false;
                { union { bf16x8_t v; unsigned u[4]; } x; x.u[0] = hi == 0 ? ((__float_as_uint(m) >> 16) ^ 0x8000u) : 0u; x.u[1] = x.u[2] = x.u[3] = 0u; mB = x.v; }
            }
            const unsigned w0 = wc[0] >> (4 * hi), w1 = wc[1] >> (4 * hi), w2 = wc[2] >> (4 * hi), w3 = wc[3] >> (4 * hi);
            float lq[4] = {0.f, 0.f, 0.f, 0.f};
#pragma unroll
            for (int r = 0; r < 16; ++r) { const int cb = (r & 3) + 8 * (r >> 2);
                const float e0 = __uint_as_float(and_sel(__builtin_amdgcn_exp2f(p0[r]), w0, cb)), e1 = __uint_as_float(and_sel(__builtin_amdgcn_exp2f(p1[r]), w1, cb));
                const float e2 = __uint_as_float(and_sel(__builtin_amdgcn_exp2f(p2[r]), w2, cb)), e3 = __uint_as_float(and_sel(__builtin_amdgcn_exp2f(p3[r]), w3, cb));
                p0[r] = e0; p1[r] = e1; p2[r] = e2; p3[r] = e3; lq[0] += e0; lq[1] += e1; lq[2] += e2; lq[3] += e3; }
            lsum += (lq[0] + lq[1]) + (lq[2] + lq[3]);
            bf16x8_t pb[4], pc[4];
#pragma unroll
            for (int sg = 0; sg < 4; ++sg) { union { bf16x8_t v; unsigned u[4]; } pk, pl;
#pragma unroll
                for (int j = 0; j < 4; ++j) { const int r = 8 * (sg & 1) + 2 * j; pk.u[j] = (sg < 2) ? pg8::cvt_pk_bf16(p0[r], p0[r + 1]) : pg8::cvt_pk_bf16(p1[r], p1[r + 1]);
                    pl.u[j] = (sg < 2) ? pg8::cvt_pk_bf16(p2[r], p2[r + 1]) : pg8::cvt_pk_bf16(p3[r], p3[r + 1]); }
                pb[sg] = pk.v; pc[sg] = pl.v; }
            at2_pv(o0, o1, vb, pb, lane); at2_pv(o0, o1, vb + A2_TILE, pc, lane);
        }
        wc[0] = wn[0]; wc[1] = wn[1]; wc[2] = wn[2]; wc[3] = wn[3];
        VM_WAIT(); __syncthreads();
    };
    unsigned nxq = 0u;
#pragma unroll 1
    for (int s = 0; s < NS; ++s) { if (nextq && s == NS - 1 && tid == 0) nxq = atomicAdd(nextq, 1u); step(s); }
    if (nextq && tid == 0) *nslot = nxq;
    MFMA_FENCE2(o0, o1);
    lsum += __shfl_xor(lsum, 32);
    const float inv = 1.0f / lsum;
    LAS bf16* ost = (LAS bf16*)(L + D2_OST + wave * 4096);
#pragma unroll
    for (int r = 0; r < 16; ++r) { ost[r32 * 64 + crow_(r, hi)] = (bf16)f2bf(o0[r] * inv); ost[r32 * 64 + 32 + crow_(r, hi)] = (bf16)f2bf(o1[r] * inv); }
    LDS_WAIT(); asm volatile("" ::: "memory");
    GAS bf16* Og = (GAS bf16*)WSB(WS_QB) + (rowb + q0w) * 512 + h * 64;
#pragma unroll
    for (int i = 0; i < 4; ++i) { const int c = i * 64 + lane, row = c >> 3, ch = c & 7; const v4u ov = *(const LAS v4u*)(ost + row * 64 + ch * 8); if (!DRY) *(GAS v4u*)(Og + (size_t)row * 512 + ch * 8) = ov; else if (ov.x == 0x12345678u && ov.y == 0x9abcdef0u) *(GAS v4u*)(Og + (size_t)row * 512 + ch * 8) = ov; }
}
#ifndef IX_SMIN_V
#define IX_SMIN_V 16
#endif
#ifndef IX_ZMAX_V
#define IX_ZMAX_V 255
#endif
constexpr int IX_FSH = 18, IX_FBASE = (0x2000 | (127 << 5)) - 42 * 32, IX_SSTRIDE = 8, IX_SMIN = IX_SMIN_V, IX_SHI = 16, IX_SLO = 56, IX_STOT = 36, IX_ZMAX = IX_ZMAX_V;
constexpr int IX_CAP = 768;
constexpr int IX_HIST = 0, IX_CAND = 0, IX_BM = 98304;
constexpr int IX_W = LDSCTL_OFF + 1024;
constexpr int IX_ST = LDSCTL_OFF + 1536;
constexpr int IX_SUB = LDSCTL_OFF + 2048, IX_L2 = IX_SUB + 8 * 1024, IX_C2 = IX_L2 + 8 * 512;
static_assert(IX_C2 + 64 <= LDS_BYTES, "idx sub-histogram LDS");
static_assert(IX_BM + 16 * 512 * 4 <= RING_BYTES && 16 * IX_CAP * 8 <= IX_BM && IX_ST + 6 * 64 <= LDS_BYTES, "idx LDS map");
#define MFMA_FENCE1(a) asm volatile("s_nop 15\n\ts_nop 15" : "+v"(a))
__device__ __forceinline__ float relu_(float x, float) { float r; asm("v_max_f32 %0, 0, %1" : "=v"(r) : "v"(x)); return r; }
__device__ __forceinline__ unsigned mono_key(float s) { const unsigned u = __float_as_uint(s + 0.0f); return u ^ ((unsigned)((int)u >> 31) | 0x80000000u); }

template <int MODE, bool LEVEL0, bool LAST, int HALF> __device__ __forceinline__ void idx_vec(const f32x16 (&accs)[2], const f32x4 (&wv)[4][4], LAS unsigned* hist, LAS unsigned long long* cand, LAS unsigned* bm, LAS unsigned* st,
                                                                                    const unsigned (&psh)[8], const unsigned (&ppre)[8], const bool (&pact)[8], int key, int t0, int hi, int lane, int w32, int shn, unsigned fmask, bool allsel) {
#pragma unroll
    for (int rb = 2 * HALF; rb < 2 * HALF + 2; ++rb) {
        const f32x16 acc = accs[rb - 2 * HALF];
        const int qla = 4 * rb + 2 * hi;
        const f32x4 w0 = wv[rb][0], w1 = wv[rb][1], w2 = wv[rb][2], w3 = wv[rb][3];
        float sa = w0.x * relu_(acc[0], 0.f), sa2 = w0.y * relu_(acc[1], 0.f); sa += w0.z * relu_(acc[2], 0.f); sa2 += w0.w * relu_(acc[3], 0.f);
        sa += w1.x * relu_(acc[4], 0.f); sa2 += w1.y * relu_(acc[5], 0.f); sa += w1.z * relu_(acc[6], 0.f); sa2 += w1.w * relu_(acc[7], 0.f);
        float sb = w2.x * relu_(acc[8], 0.f), sb2 = w2.y * relu_(acc[9], 0.f); sb += w2.z * relu_(acc[10], 0.f); sb2 += w2.w * relu_(acc[11], 0.f);
        sb += w3.x * relu_(acc[12], 0.f); sb2 += w3.y * relu_(acc[13], 0.f); sb += w3.z * relu_(acc[14], 0.f); sb2 += w3.w * relu_(acc[15], 0.f);
        sa += sa2; sb += sb2;
        const unsigned ua = mono_key(sa), ub = mono_key(sb);
        const bool va = !LAST || key <= t0 + qla, vb = !LAST || key <= t0 + qla + 1;
        if (MODE == 3) {
            const int fa = (int)(ua >> IX_FSH) - IX_FBASE, fb = (int)(ub >> IX_FSH) - IX_FBASE;
            const unsigned ba = (unsigned)(fa > 2047 ? 2047 : fa), bb = (unsigned)(fb > 2047 ? 2047 : fb);
            if (fa > 0) __hip_atomic_fetch_add(hist + qla * 2048 + ba, 1u, __ATOMIC_RELAXED, __HIP_MEMORY_SCOPE_WORKGROUP);
            if (fb > 0) __hip_atomic_fetch_add(hist + (qla + 1) * 2048 + bb, 1u, __ATOMIC_RELAXED, __HIP_MEMORY_SCOPE_WORKGROUP);
        } else if (MODE == 2) {
            const unsigned pa = ua >> IX_FSH, pb = ub >> IX_FSH;
            const bool sela = va && pa > ppre[2 * rb], selb = vb && pb > ppre[2 * rb + 1];
            const bool ca = va && (ppre[2 * rb] - pa) <= psh[2 * rb], cb = vb && (ppre[2 * rb + 1] - pb) <= psh[2 * rb + 1];
            const unsigned long long bala = __ballot(sela), balb = __ballot(selb);
            if (lane == 0) { bm[(4 * rb + 0) * 512 + w32] = (unsigned)bala; bm[(4 * rb + 2) * 512 + w32] = (unsigned)(bala >> 32);
                             bm[(4 * rb + 1) * 512 + w32] = (unsigned)balb; bm[(4 * rb + 3) * 512 + w32] = (unsigned)(balb >> 32); }
            if (ca) { const unsigned slot = __hip_atomic_fetch_add(st + qla, 1u, __ATOMIC_RELAXED, __HIP_MEMORY_SCOPE_WORKGROUP);
                if (slot < (unsigned)IX_CAP) cand[qla * IX_CAP + slot] = ((unsigned long long)ua << 32) | (unsigned)(0xffff - key); }
            if (cb) { const unsigned slot = __hip_atomic_fetch_add(st + qla + 1, 1u, __ATOMIC_RELAXED, __HIP_MEMORY_SCOPE_WORKGROUP);
                if (slot < (unsigned)IX_CAP) cand[(qla + 1) * IX_CAP + slot] = ((unsigned long long)ub << 32) | (unsigned)(0xffff - key); }
        } else if (MODE == 0) {
            const bool ma = va && (LEVEL0 || (pact[2 * rb] && (ua >> psh[2 * rb]) == ppre[2 * rb]));
            const bool mb = vb && (LEVEL0 || (pact[2 * rb + 1] && (ub >> psh[2 * rb + 1]) == ppre[2 * rb + 1]));
            const unsigned ba = LEVEL0 ? (ua >> 21) : ((ua >> shn) & fmask), bb = LEVEL0 ? (ub >> 21) : ((ub >> shn) & fmask);
            if (ma) __hip_atomic_fetch_add(hist + qla * 2048 + ba, 1u, __ATOMIC_RELAXED, __HIP_MEMORY_SCOPE_WORKGROUP);
            if (mb) __hip_atomic_fetch_add(hist + (qla + 1) * 2048 + bb, 1u, __ATOMIC_RELAXED, __HIP_MEMORY_SCOPE_WORKGROUP);
        } else {
            const unsigned pa = ua >> psh[2 * rb], pb = ub >> psh[2 * rb + 1];
            const bool sela = va && (allsel || pa > ppre[2 * rb]), selb = vb && (allsel || pb > ppre[2 * rb + 1]);
            const bool ca = va && !allsel && pa == ppre[2 * rb], cb = vb && !allsel && pb == ppre[2 * rb + 1];
            const unsigned long long bala = __ballot(sela), balb = __ballot(selb);
            if (lane == 0) { bm[(4 * rb + 0) * 512 + w32] = (unsigned)bala; bm[(4 * rb + 2) * 512 + w32] = (unsigned)(bala >> 32);
                             bm[(4 * rb + 1) * 512 + w32] = (unsigned)balb; bm[(4 * rb + 3) * 512 + w32] = (unsigned)(balb >> 32); }
            if (ca) { const unsigned slot = __hip_atomic_fetch_add(st + qla, 1u, __ATOMIC_RELAXED, __HIP_MEMORY_SCOPE_WORKGROUP);
                if (slot < (unsigned)IX_CAP) cand[qla * IX_CAP + slot] = ((unsigned long long)ua << 32) | (unsigned)(0xffff - key); }
            if (cb) { const unsigned slot = __hip_atomic_fetch_add(st + qla + 1, 1u, __ATOMIC_RELAXED, __HIP_MEMORY_SCOPE_WORKGROUP);
                if (slot < (unsigned)IX_CAP) cand[(qla + 1) * IX_CAP + slot] = ((unsigned long long)ub << 32) | (unsigned)(0xffff - key); }
        }
    }
}
template <int MODE, bool LEVEL0, int STRIDE = 1> __device__ __forceinline__ void idx_pass(Frame& F, const bf16x8_t (&qa)[4][4], const GAS bf16* kib, int t0, int nst, int wave, int lane,
                                                             int shn, unsigned fmask, bool allsel) {
    const int n = lane & 31, hi = lane >> 5;
    LAS unsigned char* L = F.lds + RING_OFF;
    LAS unsigned* hist = (LAS unsigned*)(L + IX_HIST); LAS unsigned long long* cand = (LAS unsigned long long*)(L + IX_CAND); LAS unsigned* bm = (LAS unsigned*)(L + IX_BM);
    const LAS float* wl = (const LAS float*)(F.lds + IX_W); LAS unsigned* st = (LAS unsigned*)(F.lds + IX_ST);
    unsigned psh[8], ppre[8]; bool pact[8];
#pragma unroll
    for (int i = 0; i < 8; ++i) { const int ql = 4 * (i >> 1) + 2 * hi + (i & 1); psh[i] = st[16 + ql]; ppre[i] = st[32 + ql]; pact[i] = (st[80 + ql] != 0u); }
    f32x4 wv[4][4];
#pragma unroll
    for (int rb = 0; rb < 4; ++rb)
#pragma unroll
        for (int j = 0; j < 4; ++j) wv[rb][j] = *(const LAS f32x4*)(wl + (4 * rb + 2 * hi) * 8 + 4 * j);
    bf16x8_t kf[4];
    const GAS bf16* kp = kib + (size_t)(wave * 32 + n) * 64 + hi * 8;
#pragma unroll
    for (int s = 0; s < 4; ++s) kf[s] = *(const GAS bf16x8_t*)(kp + s * 16);
    const int nlim = STRIDE == 1 ? nst : nst - 1;
#pragma unroll 1
    for (int stile = 0; stile < nlim; stile += STRIDE) {
        const int key = stile * 256 + wave * 32 + n;
        const int w32 = stile * 8 + wave;
        const bool lastt = STRIDE == 1 && (stile + 1 == nst);
        const bool more = (stile + STRIDE < nlim);
        f32x16 accs[2];
#pragma unroll
        for (int rb = 0; rb < 2; ++rb) { accs[rb] = (f32x16){0.f, 0.f, 0.f, 0.f, 0.f, 0.f, 0.f, 0.f, 0.f, 0.f, 0.f, 0.f, 0.f, 0.f, 0.f, 0.f};
#pragma unroll
            for (int s = 0; s < 4; ++s) accs[rb] = __builtin_amdgcn_mfma_f32_32x32x16_bf16(qa[rb][s], kf[s], accs[rb], 0, 0, 0); }
        asm volatile("s_nop 15\n\ts_nop 15" : "+v"(accs[0]), "+v"(accs[1]));
        if (!lastt) idx_vec<MODE, LEVEL0, false, 0>(accs, wv, hist, cand, bm, st, psh, ppre, pact, key, t0, hi, lane, w32, shn, fmask, allsel);
        else idx_vec<MODE, LEVEL0, true, 0>(accs, wv, hist, cand, bm, st, psh, ppre, pact, key, t0, hi, lane, w32, shn, fmask, allsel);
#pragma unroll
        for (int rb = 0; rb < 2; ++rb) { accs[rb] = (f32x16){0.f, 0.f, 0.f, 0.f, 0.f, 0.f, 0.f, 0.f, 0.f, 0.f, 0.f, 0.f, 0.f, 0.f, 0.f, 0.f};
#pragma unroll
            for (int s = 0; s < 4; ++s) accs[rb] = __builtin_amdgcn_mfma_f32_32x32x16_bf16(qa[2 + rb][s], kf[s], accs[rb], 0, 0, 0); }
        asm volatile("s_nop 15\n\ts_nop 15" : "+v"(accs[0]), "+v"(accs[1]), "+v"(kf[0]), "+v"(kf[1]), "+v"(kf[2]), "+v"(kf[3]));
        if (more) { kp += (size_t)STRIDE * 256 * 64;
#pragma unroll
            for (int s = 0; s < 4; ++s) kf[s] = *(const GAS bf16x8_t*)(kp + s * 16); }
        if (!lastt) idx_vec<MODE, LEVEL0, false, 1>(accs, wv, hist, cand, bm, st, psh, ppre, pact, key, t0, hi, lane, w32, shn, fmask, allsel);
        else idx_vec<MODE, LEVEL0, true, 1>(accs, wv, hist, cand, bm, st, psh, ppre, pact, key, t0, hi, lane, w32, shn, fmask, allsel);
    }
}

__device__ __forceinline__ bool idx_find_bin(const LAS unsigned* hrow, int D, unsigned above, unsigned S, unsigned kneed, int lane, int& bsel, unsigned& abovebin, unsigned& cbin) {
    const unsigned long long ownm = __ballot(above < kneed && kneed <= S);
    if (ownm == 0ull) return false;
    const int Lo = __ffsll((long long)ownm) - 1;
    const unsigned aL = (unsigned)__shfl((int)above, Lo);
    const unsigned v = (lane < D) ? hrow[Lo * D + lane] : 0u;
    unsigned s = v;
#pragma unroll
    for (int o = 1; o < 32; o <<= 1) { const unsigned t = __shfl_down(s, o); if (lane + o < 64) s += t; }
    const unsigned excl = s - v;
    const unsigned long long hitm = __ballot(lane < D && aL + excl < kneed && kneed <= aL + s);
    const int H = __ffsll((long long)hitm) - 1;
    bsel = Lo * D + H; abovebin = (unsigned)__shfl((int)(aL + excl), H); cbin = (unsigned)__shfl((int)v, H);
    return hitm != 0ull;
}
__device__ __forceinline__ void idx_unit(Frame& F, int b, int t0, unsigned* nextq = nullptr, volatile LAS unsigned* nslot = nullptr) {
    int tid_ = F.tid; asm volatile("" : "+v"(tid_));
    const int tid = tid_, lane = tid & 63, wave = F.wave, r32 = lane & 31, hh = lane >> 5;
    LAS unsigned char* L = F.lds + RING_OFF;
    LAS unsigned* hist = (LAS unsigned*)(L + IX_HIST); LAS unsigned long long* cand = (LAS unsigned long long*)(L + IX_CAND); LAS unsigned* bm = (LAS unsigned*)(L + IX_BM);
    LAS float* wl = (LAS float*)(F.lds + IX_W); LAS unsigned* st = (LAS unsigned*)(F.lds + IX_ST);
    const size_t rowb = (size_t)b * SEQ; const int nst = (t0 >> 8) + 1; const bool allsel = (t0 < 256);
    const GAS bf16* kib = (const GAS bf16*)WSB(WS_KI) + rowb * 64;
    __syncthreads();
    if (tid < 128) wl[tid] = ((const GAS float*)WSF(WS_WI) + (rowb + t0) * 8)[tid];
    if (tid < 16) { st[tid] = 0u; st[16 + tid] = 21u; st[32 + tid] = 0u; st[48 + tid] = 256u; st[64 + tid] = 0u; st[80 + tid] = 1u; }
    if (tid == 0) { unsigned zz = 0u; asm volatile("" : "+v"(zz)); st[96] = zz; st[97] = zz; }
    bf16x8_t qa[4][4];
    { const int qloc = 2 * ((r32 >> 2) & 1) + (r32 >> 4), head = (r32 & 3) + 4 * ((r32 >> 3) & 1);
      const GAS bf16* qp = (const GAS bf16*)WSB(WS_QI) + (rowb + t0 + qloc) * 512 + head * 64 + hh * 8;
#pragma unroll
      for (int rb = 0; rb < 4; ++rb)
#pragma unroll
        for (int s = 0; s < 4; ++s) qa[rb][s] = *(const GAS bf16x8_t*)(qp + (size_t)rb * 4 * 512 + s * 16); }
    __syncthreads();
    bool exact = allsel || nst < IX_SMIN;
    if (!exact) {
        { unsigned zz = 0u; asm volatile("" : "+v"(zz)); const v4u z4 = {zz, zz, zz, zz};
          for (int i = tid; i < 16 * 2048 / 4; i += NWAVES * 64) ((LAS v4u*)hist)[i] = z4; }
        __syncthreads();
        idx_pass<3, true, IX_SSTRIDE>(F, qa, kib, t0, nst, wave, lane, 0, 0u, false);
        __syncthreads();
#pragma unroll 1
        for (int qq = 0; qq < 2; ++qq) { const int ql = 2 * wave + qq; const LAS unsigned* hq = hist + ql * 2048 + lane * 32;
            unsigned tot = 0u;
            for (int dd = 0; dd < 32; ++dd) tot += hq[(dd + lane) & 31];
            unsigned S = tot;
#pragma unroll
            for (int o = 1; o < 64; o <<= 1) { const unsigned v = __shfl_down(S, o); if (lane + o < 64) S += v; }
            const unsigned above = S - tot; const unsigned total = (unsigned)__shfl((int)S, 0);
            if (total < (unsigned)IX_STOT) { if (lane == 0) __hip_atomic_fetch_or(st + 96, 1u, __ATOMIC_RELAXED, __HIP_MEMORY_SCOPE_WORKGROUP); continue; }
            const unsigned slo = total < (unsigned)IX_SLO ? total : (unsigned)IX_SLO;
#pragma unroll
            for (int which = 0; which < 2; ++which) { const unsigned kneed = which == 0 ? (unsigned)IX_SHI : slo;
                int bsel = 0; unsigned ab_, cb_;
                if (idx_find_bin(hist + ql * 2048, 32, above, S, kneed, lane, bsel, ab_, cb_) && lane == 0) {
                    if (which == 0) { st[32 + ql] = (unsigned)(IX_FBASE + bsel); if (bsel >= 2047) __hip_atomic_fetch_or(st + 96, 2u, __ATOMIC_RELAXED, __HIP_MEMORY_SCOPE_WORKGROUP); }
                    else { st[64 + ql] = (unsigned)(IX_FBASE + bsel); if (bsel <= 0) __hip_atomic_fetch_or(st + 96, 4u, __ATOMIC_RELAXED, __HIP_MEMORY_SCOPE_WORKGROUP); } } }
            LDS_WAIT(); asm volatile("" ::: "memory");
            if (lane == 0) { const unsigned w = st[32 + ql] - st[64 + ql]; st[16 + ql] = w; if (w > (unsigned)IX_ZMAX) __hip_atomic_fetch_or(st + 96, 8u, __ATOMIC_RELAXED, __HIP_MEMORY_SCOPE_WORKGROUP); }
        }
        __syncthreads();
        exact = (st[96] != 0u);
        const unsigned why = st[96];
        __syncthreads();
        if (!exact) {
            idx_pass<2, false>(F, qa, kib, t0, nst, wave, lane, 0, 0u, false);
            __syncthreads();
#pragma unroll 1
            for (int qq = 0; qq < 2; ++qq) { const int ql = 2 * wave + qq;
                int members = 0;
                for (int w = lane; w < nst * 8; w += 64) members += __popc(bm[ql * 512 + w]);
#pragma unroll
                for (int o = 32; o > 0; o >>= 1) members += __shfl_xor(members, o);
                const int nct = (int)st[ql], need = 256 - members;
                const bool ok = members <= 256 && need <= nct && nct <= IX_CAP;
                if (lane == 0) { if (!ok) __hip_atomic_fetch_or(st + 96, 16u, __ATOMIC_RELAXED, __HIP_MEMORY_SCOPE_WORKGROUP); st[48 + ql] = (unsigned)(need > 0 ? need : 0); }
            }
            __syncthreads();
            exact = (st[96] != 0u);
            __syncthreads();
        }
        if (exact) {
#ifdef IX_SPIN
            if (why & IX_SPIN) { const long long w1 = wall_clock64(); while (wall_clock64() - w1 < 4000) __builtin_amdgcn_s_sleep(4); }
#endif
            if (tid < 16) { st[tid] = 0u; st[16 + tid] = 21u; st[32 + tid] = 0u; st[48 + tid] = 256u; st[64 + tid] = 0u; st[80 + tid] = 1u; }
            __syncthreads();
        }
    }
    const bool zone = !exact;
    if (exact && !allsel) {
#pragma unroll 1
        for (int level = 0; level < 3; ++level) {
            const int shn = level == 0 ? 21 : (level == 1 ? 10 : 0); const unsigned fmask = level == 2 ? 0x3ffu : 0x7ffu; const int nd = level == 2 ? 1024 : 2048;
            for (int i = tid; i < 16 * 2048 / 4; i += NWAVES * 64) ((LAS v4u*)hist)[i] = (v4u){0u, 0u, 0u, 0u};
            __syncthreads();
            { if (level == 0) idx_pass<0, true>(F, qa, kib, t0, nst, wave, lane, shn, fmask, false); else idx_pass<0, false>(F, qa, kib, t0, nst, wave, lane, shn, fmask, false); }
            __syncthreads();
            if (PROBE_SEL & 8) { for (int i = tid; i < 16 * 2048; i += NWAVES * 64) hist[i] = 0u; __syncthreads(); { if (level == 0) idx_pass<0, true>(F, qa, kib, t0, nst, wave, lane, shn, fmask, false); else idx_pass<0, false>(F, qa, kib, t0, nst, wave, lane, shn, fmask, false); } __syncthreads(); }
#pragma unroll 1
            for (int qq = 0; qq < 2; ++qq) { const int ql = 2 * wave + qq;
                if (st[80 + ql] == 0u) continue;
                const unsigned kneed = st[48 + ql]; const int D = nd >> 6; const LAS unsigned* hq = hist + ql * 2048 + lane * D;
                unsigned tot = 0u;
                for (int dd = 0; dd < D; ++dd) tot += hq[(dd + lane) & (D - 1)];
                unsigned S = tot;
#pragma unroll
                for (int o = 1; o < 64; o <<= 1) { const unsigned v = __shfl_down(S, o); if (lane + o < 64) S += v; }
                const unsigned above = S - tot;
                int bsel = 0; unsigned a = 0u, cb = 0u;
                if (idx_find_bin(hist + ql * 2048, D, above, S, kneed, lane, bsel, a, cb) && lane == 0) {
                    const unsigned opre = st[32 + ql];
                    st[32 + ql] = (level == 0) ? (unsigned)bsel : ((opre << (level == 1 ? 11 : 10)) | (unsigned)bsel);
                    st[16 + ql] = (unsigned)shn; st[48 + ql] = kneed - a; st[64 + ql] = cb;
                    st[80 + ql] = (cb > (unsigned)IX_CAP && level < 2) ? 1u : 0u; }
            }
            __syncthreads();
            unsigned more = 0u;
#pragma unroll
            for (int i = 0; i < 16; ++i) more |= st[80 + i];
            __syncthreads();
            if (more == 0u) break;
        }
    }
    if (exact) idx_pass<1, false>(F, qa, kib, t0, nst, wave, lane, 0, 0u, allsel);
    __syncthreads();
    unsigned nxq = 0u; if (nextq && tid == 0) nxq = atomicAdd(nextq, 1u);
    if (!allsel) {
#pragma unroll 1
        for (int qq = 0; qq < 2; ++qq) { const int ql = 2 * wave + qq;
            const int nc = (int)(st[ql] < (unsigned)IX_CAP ? st[ql] : (unsigned)IX_CAP); int need = (int)st[48 + ql]; const int vbits = zone ? 48 : 16 + (int)st[16 + ql];
            if (need <= 0) continue;
            if (need >= nc) {
                for (int k = lane; k < nc; k += 64) { const int key = 0xffff - (int)(cand[ql * IX_CAP + k] & 0xffffull); __hip_atomic_fetch_or(bm + ql * 512 + (key >> 5), 1u << (key & 31), __ATOMIC_RELAXED, __HIP_MEMORY_SCOPE_WORKGROUP); }
                continue; }
            const int shq = (int)st[16 + ql];
            const int zsh = (zone && st[16 + ql] <= 63u) ? 48 : 50;
            const unsigned zb = zone ? ((st[32 + ql] - st[16 + ql]) << (50 - zsh)) : 0u;
            if (zone || shq >= 8) {
                LAS unsigned* sh2 = (LAS unsigned*)(F.lds + IX_SUB + wave * 1024); LAS unsigned long long* l2 = (LAS unsigned long long*)(F.lds + IX_L2 + wave * 512); LAS unsigned* c2p = (LAS unsigned*)(F.lds + IX_C2 + wave * 4);
#pragma unroll
                for (int i = 0; i < 4; ++i) sh2[4 * lane + i] = 0u;
                if (lane == 0) *c2p = 0u;
                LDS_WAIT(); asm volatile("" ::: "memory");
                const int fsh = 32 + shq - 8;
                for (int k = lane; k < nc; k += 64) { const unsigned long long ckk = cand[ql * IX_CAP + k]; const unsigned f = zone ? (((unsigned)(ckk >> zsh) - zb) & 0xffu) : ((unsigned)(ckk >> fsh) & 0xffu); __hip_atomic_fetch_add(sh2 + f, 1u, __ATOMIC_RELAXED, __HIP_MEMORY_SCOPE_WORKGROUP); }
                LDS_WAIT(); asm volatile("" ::: "memory");
                const unsigned c0 = sh2[4 * lane], c1 = sh2[4 * lane + 1], c2 = sh2[4 * lane + 2], c3 = sh2[4 * lane + 3]; const unsigned tot = c0 + c1 + c2 + c3;
                unsigned S = tot;
#pragma unroll
                for (int o = 1; o < 64; o <<= 1) { const unsigned v = __shfl_down(S, o); if (lane + o < 64) S += v; }
                const unsigned above = S - tot; const unsigned needu = (unsigned)need;
                const bool found = above < needu && needu <= S;
                unsigned a = above; unsigned bsel = 0u, cbin = 0u;
                if (a + c3 >= needu) { bsel = 3u; cbin = c3; } else { a += c3; if (a + c2 >= needu) { bsel = 2u; cbin = c2; } else { a += c2; if (a + c1 >= needu) { bsel = 1u; cbin = c1; } else { a += c1; bsel = 0u; cbin = c0; } } }
                const int src = __ffsll((long long)__ballot(found)) - 1;
                const unsigned b2 = (unsigned)__shfl((int)(4u * lane + bsel), src), need2 = (unsigned)__shfl((int)(needu - a), src), cnt2 = (unsigned)__shfl((int)cbin, src);
                if (cnt2 <= 64u) {
                    for (int k = lane; k < nc; k += 64) { const unsigned long long ckk = cand[ql * IX_CAP + k]; const unsigned f = zone ? (((unsigned)(ckk >> zsh) - zb) & 0xffu) : ((unsigned)(ckk >> fsh) & 0xffu);
                        if (f > b2) { const int key = 0xffff - (int)(ckk & 0xffffull); __hip_atomic_fetch_or(bm + ql * 512 + (key >> 5), 1u << (key & 31), __ATOMIC_RELAXED, __HIP_MEMORY_SCOPE_WORKGROUP); }
                        else if (f == b2) { const unsigned slot = __hip_atomic_fetch_add(c2p, 1u, __ATOMIC_RELAXED, __HIP_MEMORY_SCOPE_WORKGROUP); l2[slot] = ckk; } }
                    LDS_WAIT(); asm volatile("" ::: "memory");
                    if (lane < (int)cnt2) { const unsigned long long mine = l2[lane]; unsigned rank = 0u;
                        for (unsigned j = 0; j < cnt2; ++j) rank += (l2[j] > mine) ? 1u : 0u;
                        if (rank < need2) { const int key = 0xffff - (int)(mine & 0xffffull); __hip_atomic_fetch_or(bm + ql * 512 + (key >> 5), 1u << (key & 31), __ATOMIC_RELAXED, __HIP_MEMORY_SCOPE_WORKGROUP); } }
                    LDS_WAIT(); asm volatile("" ::: "memory");
                    continue;
                }
            }
#ifdef IX_SPIN2
            if (zone) { const long long w1 = wall_clock64(); while (wall_clock64() - w1 < IX_SPIN2 * 100) __builtin_amdgcn_s_sleep(4); }
#endif
            unsigned long long ck[12]; unsigned alive = 0u, selm = 0u;
#pragma unroll
            for (int c = 0; c < 12; ++c) { const int k = c * 64 + lane; ck[c] = (k < nc) ? cand[ql * IX_CAP + k] : 0ull; if (k < nc) alive |= 1u << c; }
#pragma unroll 1
            for (int bit = vbits - 1 + 16; bit >= 0; --bit) {
                if (bit >= 16 && bit < 32) continue;
                unsigned ones = 0u; int cnt1 = 0;
#pragma unroll
                for (int c = 0; c < 12; ++c) { if (c * 64 < nc) { const bool o = ((alive >> c) & 1u) && ((ck[c] >> bit) & 1ull); cnt1 += __popcll(__ballot(o)); if (o) ones |= 1u << c; } }
                if (cnt1 >= need) alive &= ones;
                else { selm |= ones; alive &= ~ones; need -= cnt1; }
            }
            selm |= alive;
#pragma unroll
            for (int c = 0; c < 12; ++c) if ((selm >> c) & 1u) { const int key = 0xffff - (int)(ck[c] & 0xffffull); __hip_atomic_fetch_or(bm + ql * 512 + (key >> 5), 1u << (key & 31), __ATOMIC_RELAXED, __HIP_MEMORY_SCOPE_WORKGROUP); }
        }
    }
    __syncthreads();
    if (nextq && tid == 0) *nslot = nxq;
    { GAS unsigned* mg = (GAS unsigned*)(F.ws + WS_MASK) + (rowb + t0) * 512; const int nw = nst * 8;
      for (int i = tid; i < 16 * nw; i += NWAVES * 64) { const int ql = i / nw, w = i - ql * nw; mg[(size_t)ql * 512 + w] = bm[ql * 512 + w]; } }
}
typedef __bf16 bf2_t __attribute__((ext_vector_type(2)));
constexpr size_t WS_KM2 = 110 * MiB;
constexpr size_t WS_MREF = 111 * MiB;
constexpr size_t WS_LACC = 38 * MiB;
constexpr size_t WS_PO = 464 * MiB;
constexpr size_t WS_PJ0 = WS_QI, WS_PJ1 = WS_XB, WS_PJ2 = WS_XB + 32 * MiB;
__device__ __forceinline__ unsigned char* pj_base(Frame& F, int l, int j) {
    return (unsigned char*)F.out + (size_t)j * (32 * MiB);
}
constexpr size_t WS_LJ = WS_KI;
constexpr size_t WS_LISTS = 496 * MiB;
constexpr int CW_LCNT = 16384;
static_assert((CW_LCNT + 2 * 1024) * 4 <= (int)CTL_ZERO_BYTES, "list counters inside the memset region");
__device__ __forceinline__ int list_off(int n) { return 256 * (63 * n - (n * (n - 1)) / 2); }
constexpr int IT_K = 0, IT_V = 4 * AT_KBUF, IT_BT = IT_V + 4 * AT_VBUF, IT_QP = IT_BT + 512, IT_OST = 73728;
static_assert(IT_QP + 8 * 128 <= IT_OST && IT_OST + 8 * 4096 <= RING_BYTES, "item LDS map");

template <bool DRY = false> __device__ __forceinline__ void moba_own_unit(Frame& F, int l, int b, int h, int qt) {
    int tid_ = F.tid; asm volatile("" : "+v"(tid_));
    const int tid = tid_, lane = tid & 63, wave = F.wave, r32 = lane & 31, hi = lane >> 5;
    LAS unsigned char* L = F.lds + RING_OFF;
    LAS float* bt = (LAS float*)(L + AT_BT);
    const GAS bf16* Qg = (const GAS bf16*)WSB(WS_QA);
    const size_t rowb = (size_t)b * SEQ;
    const GAS bf16* Kh = (const GAS bf16*)WSB(WS_KA) + rowb * 512 + h * 64; const GAS bf16* Vh = (const GAS bf16*)WSB(WS_VA) + rowb * 512 + h * 64;
    const int q0w = qt * 256 + wave * 32, q = q0w + r32;
    __syncthreads();
    if (tid < 128) { const GAS float* rb = (const GAS float*)INP(I_RELB) + h; bt[tid] = (rb[t5_bucket(tid) * 16] - rb[31 * 16]) * LOG2E; }
    bf16x8_t qf[4];
    { const GAS bf16* qp = Qg + (rowb + q) * 512 + h * 64 + hi * 8;
#pragma unroll
      for (int s = 0; s < 4; ++s) qf[s] = *(const GAS bf16x8_t*)(qp + s * 16); }
    { const int n = tid >> 3, c8 = (tid & 7) * 8; const GAS float* km = (const GAS float*)WSF(WS_KM2) + (((size_t)b * NBLK + n) * 2) * 512 + h * 64 + c8;
      f32x4 a = *(const GAS f32x4*)km + *(const GAS f32x4*)(km + 512), c = *(const GAS f32x4*)(km + 4) + *(const GAS f32x4*)(km + 516);
      a = a * (1.0f / 256.0f); c = c * (1.0f / 256.0f);
      const unsigned h0 = pk2(a.x, a.y), h1 = pk2(a.z, a.w), h2 = pk2(c.x, c.y), h3 = pk2(c.z, c.w);
      const unsigned l0 = pk2(a.x - __uint_as_float(h0 << 16), a.y - __uint_as_float(h0 & 0xffff0000u)), l1 = pk2(a.z - __uint_as_float(h1 << 16), a.w - __uint_as_float(h1 & 0xffff0000u)),
                     l2 = pk2(c.x - __uint_as_float(h2 << 16), c.y - __uint_as_float(h2 & 0xffff0000u)), l3 = pk2(c.z - __uint_as_float(h3 << 16), c.w - __uint_as_float(h3 & 0xffff0000u));
      *(LAS v4u*)(L + AT_K0 + n * AT_KROW + (tid & 7) * 16) = (v4u){h0, h1, h2, h3}; *(LAS v4u*)(L + AT_K0 + AT_KBUF + n * AT_KROW + (tid & 7) * 16) = (v4u){l0, l1, l2, l3}; }
    __syncthreads();
    unsigned mlo = 0u, mhi = 0u;
    if (qt > 0) {
        f32x16 g0 = {0.f, 0.f, 0.f, 0.f, 0.f, 0.f, 0.f, 0.f, 0.f, 0.f, 0.f, 0.f, 0.f, 0.f, 0.f, 0.f}, g1 = g0;
        at_qk(g0, g1, L + AT_K0, qf, r32, hi); at_qk(g0, g1, L + AT_K0 + AT_KBUF, qf, r32, hi);
        MFMA_FENCE2(g0, g1);
#pragma unroll
        for (int r = 0; r < 16; ++r) { if (crow_(r, hi) >= qt) g0[r] = -INFINITY; if (32 + crow_(r, hi) >= qt) g1[r] = -INFINITY; }
#pragma unroll
        for (int it = 0; it < 3; ++it) {
            float bv = -INFINITY; int bn = 64;
#pragma unroll
            for (int r = 0; r < 16; ++r) if (g0[r] > bv) { bv = g0[r]; bn = crow_(r, hi); }
#pragma unroll
            for (int r = 0; r < 16; ++r) if (g1[r] > bv) { bv = g1[r]; bn = 32 + crow_(r, hi); }
            const float pv = __shfl_xor(bv, 32); const int pn = __shfl_xor(bn, 32);
            const bool tp = (pv > bv) || (pv == bv && pn < bn);
            const float wv = tp ? pv : bv; const int wn = tp ? pn : bn;
            if (wv > -INFINITY) { if (wn < 32) mlo |= 1u << wn; else mhi |= 1u << (wn - 32);
                if (hi == 0 && !DRY) { GAS unsigned* cnt = (GAS unsigned*)(F.ws + WS_CTL) + CW_LCNT + ((l * 2 + b) * 8 + h) * 64 + wn;
                    const unsigned slot = __hip_atomic_fetch_add(cnt, 1u, __ATOMIC_RELAXED, __HIP_MEMORY_SCOPE_AGENT);
                    ((GAS unsigned short*)(F.ws + WS_LISTS) + ((size_t)(b * 8 + h) << 19))[list_off(wn) + slot] = (unsigned short)(q | (it << 14)); } }
#pragma unroll
            for (int r = 0; r < 16; ++r) { if (crow_(r, hi) == wn) g0[r] = -INFINITY; if (32 + crow_(r, hi) == wn) g1[r] = -INFINITY; }
        }
    }
    __syncthreads();
    v4u kr, vr;
    at_load(Kh, Vh, 4 * qt, tid, kr, vr);
    at_store(L + AT_K0, L + AT_V0, tid, kr, vr);
    __syncthreads();
    float m = -1e30f, lsum = 0.f;
    f32x16 o0 = {0.f, 0.f, 0.f, 0.f, 0.f, 0.f, 0.f, 0.f, 0.f, 0.f, 0.f, 0.f, 0.f, 0.f, 0.f, 0.f}, o1 = o0;
#pragma unroll 1
    for (int tt = 0; tt < 4; ++tt) {
        const int t = 4 * qt + tt, cur = tt & 1;
        if (tt + 1 < 4) at_load(Kh, Vh, t + 1, tid, kr, vr);
        const int nall = q - t * 64 + 1;
        const unsigned wlo = nall >= 32 ? 0xffffffffu : (nall <= 0 ? 0u : ((1u << nall) - 1u)), whi = nall >= 64 ? 0xffffffffu : (nall <= 32 ? 0u : ((1u << (nall - 32)) - 1u));
        if (__any((wlo | whi) != 0u)) {
            const LAS unsigned char* kb = L + AT_K0 + cur * AT_KBUF; const LAS unsigned char* vb = L + AT_V0 + cur * AT_VBUF;
            f32x16 p0 = {0.f, 0.f, 0.f, 0.f, 0.f, 0.f, 0.f, 0.f, 0.f, 0.f, 0.f, 0.f, 0.f, 0.f, 0.f, 0.f}, p1 = p0;
            at_qk(p0, p1, kb, qf, r32, hi);
            MFMA_FENCE2(p0, p1);
#pragma unroll
            for (int r = 0; r < 16; ++r) { const int d0 = q - (t * 64 + crow_(r, hi)), d1 = d0 - 32;
                const float b0 = ((unsigned)d0 < 128u) ? bt[d0] : 0.f, b1 = ((unsigned)d1 < 128u) ? bt[d1] : 0.f;
                p0[r] = p0[r] * AT_C2 + b0; p1[r] = p1[r] * AT_C2 + b1; }
            float mx;
            { float ma = max3_(p0[0], p1[0], p0[1]), mb = max3_(p1[1], p0[2], p1[2]), mc = max3_(p0[3], p1[3], p0[4]), md = max3_(p1[4], p0[5], p1[5]);
              ma = max3_(ma, p0[6], p1[6]); mb = max3_(mb, p0[7], p1[7]); mc = max3_(mc, p0[8], p1[8]); md = max3_(md, p0[9], p1[9]);
              ma = max3_(ma, p0[10], p1[10]); mb = max3_(mb, p0[11], p1[11]); mc = max3_(mc, p0[12], p1[12]); md = max3_(md, p0[13], p1[13]);
              ma = max3_(ma, p0[14], p1[14]); mb = max3_(mb, p0[15], p1[15]); mx = max3_(ma, mb, mc); mx = max3_(mx, md, md); }
            mx = max3_(mx, __shfl_xor(mx, 32), mx);
            if (__any(mx > m + AT_THR)) {
                const float mn = fmaxf(m, mx); const float al = __builtin_amdgcn_exp2f(m - mn);
                MFMA_FENCE2(o0, o1);
#pragma unroll
                for (int r = 0; r < 16; ++r) { o0[r] *= al; o1[r] *= al; }
                lsum *= al; m = mn;
            }
            const unsigned wl = wlo >> (4 * hi), wh = whi >> (4 * hi);
            float lq[4] = {0.f, 0.f, 0.f, 0.f};
#pragma unroll
            for (int r = 0; r < 16; ++r) { const int cb = (r & 3) + 8 * (r >> 2);
                const float e0 = __uint_as_float(and_sel(__builtin_amdgcn_exp2f(p0[r] - m), wl, cb)), e1 = __uint_as_float(and_sel(__builtin_amdgcn_exp2f(p1[r] - m), wh, cb));
                p0[r] = e0; p1[r] = e1; lq[r & 1] += e0; lq[2 + (r & 1)] += e1; }
            lsum += (lq[0] + lq[1]) + (lq[2] + lq[3]);
            bf16x8_t pb[4];
#pragma unroll
            for (int sg = 0; sg < 4; ++sg) { union { bf16x8_t v; unsigned u[4]; } pk;
#pragma unroll
                for (int j = 0; j < 4; ++j) { const int r = 8 * (sg & 1) + 2 * j; pk.u[j] = (sg < 2) ? pg8::cvt_pk_bf16(p0[r], p0[r + 1]) : pg8::cvt_pk_bf16(p1[r], p1[r + 1]); }
                pb[sg] = pk.v; }
            at_pv(o0, o1, vb, pb, r32, hi);
        }
        if (tt + 1 < 4) at_store(L + AT_K0 + (cur ^ 1) * AT_KBUF, L + AT_V0 + (cur ^ 1) * AT_VBUF, tid, kr, vr);
        __syncthreads();
    }
    MFMA_FENCE2(o0, o1);
    lsum += __shfl_xor(lsum, 32);
    if (hi == 0 && !DRY) { ((GAS float*)WSF(WS_MREF))[(rowb + q) * 8 + h] = m; ((GAS float*)WSF(WS_LACC))[(rowb + q) * 8 + h] = lsum; }
    LAS bf16* ost = (LAS bf16*)(L + AT_OST + wave * 4096);
#pragma unroll
    for (int r = 0; r < 16; ++r) { ost[r32 * 64 + crow_(r, hi)] = (bf16)f2bf(o0[r]); ost[r32 * 64 + 32 + crow_(r, hi)] = (bf16)f2bf(o1[r]); }
    LDS_WAIT(); asm volatile("" ::: "memory");
    GAS bf16* Og = (GAS bf16*)WSB(WS_PO) + (rowb + q0w) * 512 + h * 64;
#pragma unroll
    for (int i = 0; i < 4; ++i) { const int c = i * 64 + lane, row = c >> 3, ch = c & 7; const v4u ov = *(const LAS v4u*)(ost + row * 64 + ch * 8); if (!DRY || (ov.x == 0x12345678u && ov.y == 0x9abcdef0u)) *(GAS v4u*)(Og + (size_t)row * 512 + ch * 8) = ov; }
}

template <bool DRY = false> __device__ __forceinline__ void moba_item_unit(Frame& F, int l, int b, int h, int n) {
    int tid_ = F.tid; asm volatile("" : "+v"(tid_));
    const int tid = tid_, lane = tid & 63, wave = F.wave, r32 = lane & 31, hi = lane >> 5;
    LAS unsigned char* L = F.lds + RING_OFF;
    LAS float* bt = (LAS float*)(L + IT_BT);
    const size_t rowb = (size_t)b * SEQ;
    const int cnt = (int)((const GAS unsigned*)(F.ws + WS_CTL))[CW_LCNT + ((l * 2 + b) * 8 + h) * 64 + n];
    if (cnt == 0) return;
    const GAS bf16* Kh = (const GAS bf16*)WSB(WS_KA) + rowb * 512 + h * 64; const GAS bf16* Vh = (const GAS bf16*)WSB(WS_VA) + rowb * 512 + h * 64;
    __syncthreads();
    if (tid < 128) { const GAS float* rb = (const GAS float*)INP(I_RELB) + h; bt[tid] = (rb[t5_bucket(tid) * 16] - rb[31 * 16]) * LOG2E; }
#pragma unroll
    for (int t = 0; t < 4; ++t) { v4u kr, vr; at_load(Kh, Vh, 4 * n + t, tid, kr, vr); at_store(L + IT_K + t * AT_KBUF, L + IT_V + t * AT_VBUF, tid, kr, vr); }
    __syncthreads();
    const GAS unsigned short* lst = (const GAS unsigned short*)(F.ws + WS_LISTS) + ((size_t)(b * 8 + h) << 19) + list_off(n);
    LAS int* qpl = (LAS int*)(L + IT_QP + wave * 128);
    LAS float* ostf = (LAS float*)(L + IT_OST + wave * 4096);
    const int ngrp = (cnt + 31) >> 5;
#pragma unroll 1
    for (int g = wave; g < ngrp; g += NWAVES) {
        const int li = g * 32 + r32; const bool valid = li < cnt;
        const int ent = valid ? (int)lst[li] : (int)lst[g * 32];
        const int q = ent & 0x3fff;
        if (hi == 0) qpl[r32] = valid ? ent : -1;
        bf16x8_t qf[4];
        { const GAS bf16* qp = (const GAS bf16*)WSB(WS_QA) + (rowb + q) * 512 + h * 64 + hi * 8;
#pragma unroll
          for (int s = 0; s < 4; ++s) qf[s] = *(const GAS bf16x8_t*)(qp + s * 16); }
        const float mref = ((const GAS float*)WSF(WS_MREF))[(rowb + q) * 8 + h];
        const bool near = __any(q < 256 * (n + 1) + 128);
        float lsum = 0.f;
        f32x16 o0 = {0.f, 0.f, 0.f, 0.f, 0.f, 0.f, 0.f, 0.f, 0.f, 0.f, 0.f, 0.f, 0.f, 0.f, 0.f, 0.f}, o1 = o0;
#pragma unroll 1
        for (int t = 0; t < 4; ++t) {
            const LAS unsigned char* kb = L + IT_K + t * AT_KBUF; const LAS unsigned char* vb = L + IT_V + t * AT_VBUF;
            f32x16 p0 = {0.f, 0.f, 0.f, 0.f, 0.f, 0.f, 0.f, 0.f, 0.f, 0.f, 0.f, 0.f, 0.f, 0.f, 0.f, 0.f}, p1 = p0;
            at_qk(p0, p1, kb, qf, r32, hi);
            MFMA_FENCE2(p0, p1);
            float lq[4] = {0.f, 0.f, 0.f, 0.f};
            if (near) {
#pragma unroll
                for (int r = 0; r < 16; ++r) { const int d0 = q - ((4 * n + t) * 64 + crow_(r, hi)), d1 = d0 - 32;
                    const float b0 = ((unsigned)d0 < 128u) ? bt[d0] : 0.f, b1 = ((unsigned)d1 < 128u) ? bt[d1] : 0.f;
                    const float e0 = __builtin_amdgcn_exp2f(fminf(__builtin_fmaf(p0[r], AT_C2, -mref) + b0, 60.f)), e1 = __builtin_amdgcn_exp2f(fminf(__builtin_fmaf(p1[r], AT_C2, -mref) + b1, 60.f));
                    p0[r] = e0; p1[r] = e1; lq[r & 1] += e0; lq[2 + (r & 1)] += e1; }
            } else {
#pragma unroll
                for (int r = 0; r < 16; ++r) { const float e0 = __builtin_amdgcn_exp2f(fminf(__builtin_fmaf(p0[r], AT_C2, -mref), 60.f)), e1 = __builtin_amdgcn_exp2f(fminf(__builtin_fmaf(p1[r], AT_C2, -mref), 60.f));
                    p0[r] = e0; p1[r] = e1; lq[r & 1] += e0; lq[2 + (r & 1)] += e1; }
            }
            lsum += (lq[0] + lq[1]) + (lq[2] + lq[3]);
            bf16x8_t pb[4];
#pragma unroll
            for (int sg = 0; sg < 4; ++sg) { union { bf16x8_t v; unsigned u[4]; } pk;
#pragma unroll
                for (int j = 0; j < 4; ++j) { const int r = 8 * (sg & 1) + 2 * j; pk.u[j] = (sg < 2) ? pg8::cvt_pk_bf16(p0[r], p0[r + 1]) : pg8::cvt_pk_bf16(p1[r], p1[r + 1]); }
                pb[sg] = pk.v; }
            at_pv(o0, o1, vb, pb, r32, hi);
        }
        MFMA_FENCE2(o0, o1);
        lsum += __shfl_xor(lsum, 32);
        if (hi == 0 && valid && !DRY) ((GAS float*)WSF(WS_LJ))[((size_t)(ent >> 14) * T + rowb + q) * 8 + h] = lsum;
        LAS bf16* ost = (LAS bf16*)ostf;
#pragma unroll
        for (int r = 0; r < 16; ++r) { ost[r32 * 64 + crow_(r, hi)] = (bf16)f2bf(o0[r]); ost[r32 * 64 + 32 + crow_(r, hi)] = (bf16)f2bf(o1[r]); }
        LDS_WAIT(); asm volatile("" ::: "memory");
#pragma unroll
        for (int i = 0; i < 4; ++i) { const int c = i * 64 + lane, row = c >> 3, ch = c & 7; const int er = qpl[row];
            if (er >= 0 && !DRY) { const int j = er >> 14; GAS bf16* pj = (GAS bf16*)pj_base(F, l, j);
                *(GAS v4u*)(pj + (rowb + (er & 0x3fff)) * 512 + h * 64 + ch * 8) = *(const LAS v4u*)(ost + row * 64 + ch * 8); } }
        LDS_WAIT(); asm volatile("" ::: "memory");
    }
}
__device__ __forceinline__ void moba_fin_row(Frame& F, int layer, int m, int lane) {
    const int nsel = ((m & (SEQ - 1)) >> 8) < 3 ? ((m & (SEQ - 1)) >> 8) : 3;
    const int hd = lane >> 3;
    float l = ((const GAS float*)WSF(WS_LACC))[(size_t)m * 8 + hd];
    v4u v = ((const GAS v4u*)((const GAS bf16*)WSB(WS_PO) + (size_t)m * 512))[lane];
    float acc[8] = { __uint_as_float(v.x << 16), __uint_as_float(v.x & 0xffff0000u), __uint_as_float(v.y << 16), __uint_as_float(v.y & 0xffff0000u),
                     __uint_as_float(v.z << 16), __uint_as_float(v.z & 0xffff0000u), __uint_as_float(v.w << 16), __uint_as_float(v.w & 0xffff0000u) };
#pragma unroll
    for (int j = 0; j < 3; ++j) if (j < nsel) {
        l += ((const GAS float*)WSF(WS_LJ))[((size_t)j * T + m) * 8 + hd];
        const v4u w = ((const GAS v4u*)((const GAS bf16*)pj_base(F, layer, j) + (size_t)m * 512))[lane];
        acc[0] += __uint_as_float(w.x << 16); acc[1] += __uint_as_float(w.x & 0xffff0000u); acc[2] += __uint_as_float(w.y << 16); acc[3] += __uint_as_float(w.y & 0xffff0000u);
        acc[4] += __uint_as_float(w.z << 16); acc[5] += __uint_as_float(w.z & 0xffff0000u); acc[6] += __uint_as_float(w.w << 16); acc[7] += __uint_as_float(w.w & 0xffff0000u); }
    const float inv = 1.0f / l;
    v4u o; o.x = pk2(acc[0] * inv, acc[1] * inv); o.y = pk2(acc[2] * inv, acc[3] * inv); o.z = pk2(acc[4] * inv, acc[5] * inv); o.w = pk2(acc[6] * inv, acc[7] * inv);
    ((GAS v4u*)((GAS bf16*)WSB(WS_QA) + (size_t)m * 512))[lane] = o;
}
__global__ void __launch_bounds__(NWAVES * 64, 2) fwd(Args args) {
    extern __shared__ __attribute__((aligned(16))) unsigned char lds[];
    Frame F;
    F.lds = (LAS unsigned char*)lds;
        F.tid = threadIdx.x; F.lane = F.tid & 63; F.wave = __builtin_amdgcn_readfirstlane(F.tid >> 6);
    F.G = gridDim.x; F.bid = blockIdx.x;
    F.a = (const __attribute__((address_space(4))) Args*)__builtin_amdgcn_kernarg_segment_ptr(); F.ws = args.ws; F.out = args.out;
    unsigned char* ws = args.ws;
    for (int u = F.tid; u < (LDS_BYTES - LDSCTL_OFF) / 4; u += NWAVES * 64) ((LAS unsigned*)(F.lds + LDSCTL_OFF))[u] = 0u;
    __syncthreads();
    {
        volatile LAS unsigned* pw = (volatile LAS unsigned*)(F.lds + MISC_OFF) + 64;
        const unsigned hw = __builtin_amdgcn_s_getreg((4 << 0) | (4 << 6) | (1 << 11));
        if (F.lane == 0) pw[F.wave] = hw & 3u;
        __syncthreads();
        const unsigned my = pw[F.wave]; unsigned cnts = 0, rank = 0;
#pragma unroll
        for (int w = 0; w < NWAVES; ++w) { const unsigned s = pw[w]; cnts += 1u << (8 * s); if (w < F.wave && s == my) ++rank; }
#ifdef BAD_ROLES
        F.gw = __builtin_amdgcn_readfirstlane((cnts == 0x02020202u) ? (int)((my >> 1) * 4 + (my & 1) * 2 + rank) : F.wave);
#else
        F.gw = __builtin_amdgcn_readfirstlane((cnts == 0x02020202u) ? (int)(rank * 4 + my) : F.wave);
#endif
        __syncthreads();
    }
    XcdBarrier bar; bar.bar = (unsigned*)(ws + WS_CTL) + CW_BAR; bar.x = 0; bar.st = nullptr;
    if (ONE_LAUNCH) bar = xcd_barrier_post((unsigned*)(ws + WS_CTL) + CW_BAR, (volatile LAS unsigned*)(F.lds + MISC_OFF) + 8);
#define GRID_BAR() do { if (ONE_LAUNCH) xcd_barrier(bar); } while (0)
    const int lo = args.ph_lo, hi = args.ph_hi;
#ifndef PH_MASK
#define PH_MASK 0xfff
#endif
#define IN(k) (((PH_MASK >> ((k) % PH_PER_LAYER == 0 && (k) == 2 * PH_PER_LAYER ? 11 : (k) % PH_PER_LAYER)) & 1) && lo <= (k) && (k) < hi)
#define BOTH(k) (IN(k) && IN((k) + 1))
#define GEMM_TID ((F.gw << 6) | F.lane)
#define DYN_CTR(k) ((unsigned*)(F.ws + WS_CTL) + CW_DYN + 32 * (k))
#define DYN_FETCH(dst, k) do { __syncthreads(); if (F.tid == 0) *((volatile LAS unsigned*)(F.lds + MISC_OFF) + 32) = atomicAdd(DYN_CTR(k), 1u); __syncthreads(); \
        dst = (int)__builtin_amdgcn_readfirstlane(*((volatile LAS unsigned*)(F.lds + MISC_OFF) + 32)); } while (0)
#define LAUNDER() do { asm volatile("" : "+v"(F.tid)); F.lane = F.tid & 63; F.wave = __builtin_amdgcn_readfirstlane(F.tid >> 6); F.ws = launder_u(F.ws); F.out = launder_u(F.out); F.a = launder_u(F.a); F.bid = launder_i(F.bid); F.G = launder_i(F.G); F.gw = launder_i(F.gw); } while (0)
    LAS unsigned char* ring = F.lds + RING_OFF;
    for (int l = 0; l < 2; ++l) {
        const int P = l * PH_PER_LAYER;
#ifdef DBG_DUMP
        if (lo == DBG_PHASE && l == 0) { for (int u = F.bid; u < T; u += F.G) { F.out[(size_t)u * DM + F.tid] = bf2f(WSB(DBG_DUMP)[(size_t)u * DBG_PITCH + F.tid]); F.out[(size_t)u * DM + 512 + F.tid] = 0.f; } }
        if (lo >= DBG_PHASE && lo < 2 * PH_PER_LAYER) continue;
#endif
        if (IN(P + 0)) { LAUNDER(); p_prologue(F, l); if (PROBE_SEL & 128) { VM_WAIT(); __syncthreads(); p_prologue(F, l); } if (BOTH(P + 0)) GRID_BAR(); }
        if (IN(P + 1)) { LAUNDER();
            pg8::Gemm g{WSB(WS_XB), WSB(WS_W_IN), T, NIN_T, DM}; pg8::StaticOrder S; S.init(T, NIN_T, F.G, F.bid);
            pg8::EpiInproj E{WSB(WS_QA), WSB(WS_KI), WSF(WS_WI), SSQ_MIX(l), WSF(WS_KM2)};
            pg8::gemm_phase<pg8::EpiInproj, pg8::StaticOrder, true, PG8_SP2>(ring, g, S, E, GEMM_TID);
            if (PROBE_SEL & 32) { VM_WAIT(); __syncthreads(); LAUNDER(); pg8::gemm_phase<pg8::EpiInproj, pg8::StaticOrder, true, PG8_SP2>(ring, g, S, E, GEMM_TID); }
            if (BOTH(P + 1)) GRID_BAR();
        }
        if (IN(P + 2)) { LAUNDER();
#ifndef FAST_DSA
#define FAST_DSA 1
#endif
            if ((PROBE_SEL & 1024) && F.bid < 256) { for (int r = 0; r < 4; ++r) { const int i = r * 256 + F.bid; moba_own_unit<true>(F, l, (i & 15) >> 3, i & 7, i >> 4); } __syncthreads(); }
            if (FAST_DSA) {
                { int i; DYN_FETCH(i, 2 * l);
                  while (i < 2048) { const int stt = 63 - (i >> 5), j = i & 31; idx_unit(F, j >> 4, stt * 256 + (j & 15) * 16, DYN_CTR(2 * l), (volatile LAS unsigned*)(F.lds + MISC_OFF) + 32);
                      __syncthreads(); i = (int)__builtin_amdgcn_readfirstlane(*((volatile LAS unsigned*)(F.lds + MISC_OFF) + 32)); } }
                __syncthreads();
            }
            if (FAST_MOBA == 2) { for (;;) { int i; DYN_FETCH(i, 24 + l); if (i >= 1024) break; moba_own_unit<false>(F, l, (i & 15) >> 3, i & 7, i >> 4); } __syncthreads(); }
            for (int rep = 0; rep < ((PROBE_SEL & 64) ? 2 : 1); ++rep)
            for (;;) { int u; DYN_FETCH(u, 26 + l + 2 * rep); if (u >= 2 * RGC) break; rg_unit<false>(F, l, u / RGC, u % RGC); }
            if (BOTH(P + 2)) GRID_BAR();
        }
        if (IN(P + 3)) { LAUNDER();
            #ifndef MIX2_SEL
#define MIX2_SEL 7
#endif
            if (FAST_MOBA == 1 && (MIX2_SEL & 2)) {
                if (PROBE_SEL & 1) { for (int r = 0; r < 4; ++r) { const int g = F.bid % 256; const int i = r * 256 + ((r & 1) ? 255 - g : g); if (F.bid >= 256) break;
                    const int qt = 63 - (i >> 4), bh = i & 15; attn_unit<0, true>(F, bh >> 3, bh & 7, qt); } }
                for (int r = 0; r < 4; ++r) { const int g = F.bid % 256; const int i = r * 256 + ((r & 1) ? 255 - g : g); if (F.bid >= 256) break;
                    const int qt = 63 - (i >> 4), bh = i & 15; attn_unit<0>(F, bh >> 3, bh & 7, qt); }
                __syncthreads();
            }
            if (FAST_DSA && (MIX2_SEL & 4)) {
                if (PROBE_SEL & 2) { for (int r = 0; r < 4; ++r) { const int g = F.bid % 256; const int i = r * 256 + ((r & 1) ? 255 - g : g); if (F.bid >= 256) break;
                    const int qt = 63 - (i >> 4), bh = i & 15; dsa_attn2_unit<true>(F, bh >> 3, bh & 7, qt); } }
                for (int xs = 0; xs < 8; ++xs) { const int xq = (F.bid + xs) & 7;
                  int i; DYN_FETCH(i, 4 + 8 * l + xq);
                  while (i < 128) { const int qt = 63 - (i & 63), bh = 2 * xq + (i >> 6);     dsa_attn2_unit<false>(F, bh >> 3, bh & 7, qt, DYN_CTR(4 + 8 * l + xq), (volatile LAS unsigned*)(F.lds + MISC_OFF) + 32);
                      __syncthreads(); i = (int)__builtin_amdgcn_readfirstlane(*((volatile LAS unsigned*)(F.lds + MISC_OFF) + 32)); } }
                __syncthreads();
            }
            if (FAST_MOBA == 2) {
                if (PROBE_SEL & 2048) for (int r = 0; r < 4; ++r) { const int g = F.bid; const int i = r * 256 + ((r & 1) ? 255 - g : g); if (F.bid < 256) moba_item_unit<true>(F, l, (i & 15) >> 3, i & 7, i >> 4); }
                for (;;) { int i; DYN_FETCH(i, 20 + l); if (i >= 1024) break; moba_item_unit<false>(F, l, (i & 15) >> 3, i & 7, i >> 4); }
                __syncthreads();
            }
            if (MIX2_SEL & 1) { for (;;) { int u; DYN_FETCH(u, 22 + l); if (u >= 2 * RGC) break; rg_unit<true>(F, l, u / RGC, u % RGC); } }
            if (!(FAST_MOBA && FAST_DSA)) for (int u = F.bid; u < T; u += F.G) { const int b = u & 1, t = u >> 1; if (FAST_MOBA == 0 && (MIX2_SEL & 2)) moba_unit(F, b, t); if (!FAST_DSA && (MIX2_SEL & 4)) dsa_unit(F, b, t); }
            for (int u = F.bid; u < T; u += F.G) { if (!(MIX2_SEL & 2)) WSB(WS_QA)[(size_t)u * 512 + F.tid] = 0; if (!(MIX2_SEL & 4)) WSB(WS_QB)[(size_t)u * 512 + F.tid] = 0; if (!(MIX2_SEL & 1)) WSB(WS_YC)[(size_t)u * 512 + F.tid] = 0; }
            if (BOTH(P + 3)) GRID_BAR();
        }

        if (IN(P + 4)) { LAUNDER();
            if (FAST_MOBA == 2) { const int gw = F.bid * NWAVES + F.wave, NGW = F.G * NWAVES;
                for (int m = gw; m < T; m += NGW) moba_fin_row(F, l, m, F.lane); }
        }
        if (IN(P + 5)) { LAUNDER();
            pg8::Gemm g{WSB(WS_XB), WSB(WS_W_G), T, 3072, DM}; pg8::StaticOrder S; S.init(T, 3072, F.G, F.bid);
            pg8::EpiGates E{WSB(WS_G), SSQ_MIX(l)};
            pg8::gemm_phase<pg8::EpiGates, pg8::StaticOrder, true, PG8_SP2>(ring, g, S, E, GEMM_TID);
            if (PROBE_SEL & 32) { VM_WAIT(); __syncthreads(); LAUNDER(); pg8::gemm_phase<pg8::EpiGates, pg8::StaticOrder, true, PG8_SP2>(ring, g, S, E, GEMM_TID); }
            if (BOTH(P + 5)) GRID_BAR();
        }
        if (IN(P + 6)) { LAUNDER();
            pg8::StaticOrder S; S.init(T, DM, F.G, F.bid);
            { pg8::Gemm g{WSB(WS_QA), WSB(WS_W_PA), T, DM, DH}; pg8::EpiMerge<true> E{WSB(WS_G), WSB(WS_MERGED)}; pg8::gemm_phase<pg8::EpiMerge<true>, pg8::StaticOrder, true, PG8_SP2>(ring, g, S, E, GEMM_TID); }
#ifndef MERGE_CALLS
#define MERGE_CALLS 3
#endif
            VM_WAIT(); __syncthreads(); LAUNDER();
            if (MERGE_CALLS >= 2) { pg8::Gemm g{WSB(WS_QB), WSB(WS_W_PB), T, DM, DH}; pg8::EpiMerge<false> E{WSB(WS_G) + (size_t)T * 1024, WSB(WS_MERGED)}; pg8::gemm_phase<pg8::EpiMerge<false>, pg8::StaticOrder, true, PG8_SP2>(ring, g, S, E, GEMM_TID); }
            VM_WAIT(); __syncthreads(); LAUNDER();
            if (MERGE_CALLS >= 3) { pg8::Gemm g{WSB(WS_YC), WSB(WS_W_PC), T, DM, DH}; pg8::EpiMerge<false> E{WSB(WS_G) + (size_t)2 * T * 1024, WSB(WS_MERGED)}; pg8::gemm_phase<pg8::EpiMerge<false>, pg8::StaticOrder, true, PG8_SP2>(ring, g, S, E, GEMM_TID); }
            if (BOTH(P + 6)) GRID_BAR();
        }
        if (IN(P + 7)) { LAUNDER();
            pg8::Gemm g{WSB(WS_MERGED), WSB(WS_W_O), T, DM, DM}; pg8::StaticOrder S; S.init(T, DM, F.G, F.bid);
            pg8::EpiResidB E{WSB(WS_XB), SSQ_MLP(l)};
            pg8::gemm_phase<pg8::EpiResidB, pg8::StaticOrder, true, PG8_SP2>(ring, g, S, E, GEMM_TID);
            if (BOTH(P + 7)) GRID_BAR();
        }
        if (IN(P + 8)) {   }
        if (IN(P + 9)) { LAUNDER();
            pg8::Gemm g{WSB(WS_XB), WSB(WS_W_UP), T, DFF, DM}; pg8::StaticOrder S; S.init(T, DFF, F.G, F.bid);
            pg8::EpiUp E{WSB(WS_H), SSQ_MLP(l)};
            pg8::gemm_phase<pg8::EpiUp, pg8::StaticOrder, true, PG8_SP2>(ring, g, S, E, GEMM_TID);
            if (PROBE_SEL & 32) { VM_WAIT(); __syncthreads(); LAUNDER(); pg8::gemm_phase<pg8::EpiUp, pg8::StaticOrder, true, PG8_SP2>(ring, g, S, E, GEMM_TID); }
            if (BOTH(P + 9)) GRID_BAR();
        }
        if (IN(P + 10)) { LAUNDER();
            pg8::Gemm g{WSB(WS_H), WSB(WS_W_DN), T, DM, DFF}; pg8::StaticOrder S; S.init(T, DM, F.G, F.bid);
            pg8::EpiResidB E{WSB(WS_XB), (l == 0) ? SSQ_CTL + T : (pg8::ssq_t*)nullptr};
            pg8::gemm_phase<pg8::EpiResidB, pg8::StaticOrder, true, PG8_SP2>(ring, g, S, E, GEMM_TID);
            if (BOTH(P + 10)) GRID_BAR();
        }
    }
    if (IN(2 * PH_PER_LAYER)) { LAUNDER(); p_final(F); }
#undef IN
#undef BOTH
#undef GRID_BAR
}

extern "C" void kernel_launch(void* const* d_in, const int* in_sizes, int n_in, void* d_out, int out_size, void* d_ws, size_t ws_size, hipStream_t stream) {
    static int grid = 0;
    if (grid == 0) {
        if (n_in != 19 || in_sizes[0] != T * DM || out_size != T * DM || ws_size < WS_END) { fprintf(stderr, "kernel_launch: unexpected shapes (n_in %d, in0 %d, out %d, ws %zu)\n", n_in, n_in > 0 ? in_sizes[0] : -1, out_size, ws_size); grid = -1; return; }
        int dev = 0, cus = 0, per_cu = 0;
        if (hipGetDevice(&dev) != hipSuccess || hipDeviceGetAttribute(&cus, hipDeviceAttributeMultiprocessorCount, dev) != hipSuccess) { grid = -1; return; }
        if (hipFuncSetAttribute((const void*)fwd, hipFuncAttributeMaxDynamicSharedMemorySize, LDS_BYTES) != hipSuccess) { fprintf(stderr, "kernel_launch: hipFuncSetAttribute failed\n"); grid = -1; return; }
        if (hipOccupancyMaxActiveBlocksPerMultiprocessor(&per_cu, (const void*)fwd, NWAVES * 64, LDS_BYTES) != hipSuccess || per_cu < 1) { fprintf(stderr, "kernel_launch: occupancy query says %d\n", per_cu); }
        (void)hipGetLastError();
        grid = cus;
    }
    if (grid < 0) return;
    if (hipMemsetAsync((char*)d_ws + WS_CTL, 0, CTL_ZERO_BYTES, stream) != hipSuccess) return;
    Args a{};
    for (int i = 0; i < 19; ++i) a.in[i] = (const float*)d_in[i];
    a.out = (float*)d_out; a.ws = (unsigned char*)d_ws;
    if (ONE_LAUNCH) { a.ph_lo = 0; a.ph_hi = N_PHASES; hipLaunchKernelGGL(fwd, dim3(grid), dim3(NWAVES * 64), LDS_BYTES, stream, a); }
    else for (int p = 0; p < N_PHASES; ++p) { a.ph_lo = p; a.ph_hi = p + 1; hipLaunchKernelGGL(fwd, dim3(grid), dim3(NWAVES * 64), LDS_BYTES, stream, a); }
}
```
